# Optimizing an MI355X kernel written in HIP

```python
import numpy as np
import jax
import jax.numpy as jnp
from jax import lax

D_MODEL = 1024
BATCH = 32
SEQ = 256
DEPTH = 2
DEC_BATCH = 2
DEC_SEQ = 4096
PAST_LEN = 512

GRID_W = 64
HEAD_DIM = 64
N_BRANCH = 4
BRANCH_W = D_MODEL // N_BRANCH
A_HQ = BRANCH_W // HEAD_DIM
A_HKV = A_HQ // 2
WINDOW = 128
Q_BLOCK = 128
LRU_W = BRANCH_W
LRU_BLOCKS = 4
LRU_BW = LRU_W // LRU_BLOCKS
LRU_C = 8.0
CONV_W = 4
CONV_LEFT = CONV_W // 2
GDN_H = 4
GDN_DK = BRANCH_W // GDN_H
GDN_DV = BRANCH_W // GDN_H
CHUNK = 64
D_HQ = BRANCH_W // HEAD_DIM
D_HKV = D_HQ // 2
D_FF = 4 * D_MODEL
ROPE_BASE = 10000.0
EPS = 1e-6
NEG = -1e30
IN_WIDTHS = (A_HQ * HEAD_DIM, A_HKV * HEAD_DIM, A_HKV * HEAD_DIM,
             LRU_W, LRU_W,
             GDN_H * GDN_DK, GDN_H * GDN_DK, GDN_H * GDN_DV, GDN_H * GDN_DV, 2 * GDN_H, 2 * GDN_H,
             D_HQ * HEAD_DIM, D_HKV * HEAD_DIM, D_HKV * HEAD_DIM)
IN_COLS = sum(IN_WIDTHS)

kernel_name = "hybrid_diffusion_prefix_step"


def split_points():
    return tuple(int(s) for s in np.cumsum(IN_WIDTHS)[:-1])


def rms_norm(x, g):
    xf = x.astype(jnp.float32)
    y = xf * lax.rsqrt(jnp.mean(xf * xf, axis=-1, keepdims=True) + EPS)
    return (y * g.astype(jnp.float32)).astype(x.dtype)


def l2_normalize(x):
    return x * lax.rsqrt(jnp.sum(x * x, axis=-1, keepdims=True) + EPS)


def modulate(x, g, shift, scale):
    return rms_norm(x, g) * (1 + scale[:, None, :]) + shift[:, None, :]


def centred_dwconv(x, w):
    T = x.shape[1]
    xp = jnp.pad(x, ((0, 0), (CONV_LEFT, CONV_W - 1 - CONV_LEFT), (0, 0)))
    return sum(xp[:, j:j + T] * w[j] for j in range(CONV_W))


def axial_rope(T):
    rows = T // GRID_W
    row = jnp.repeat(jnp.arange(rows, dtype=jnp.float32), GRID_W)
    col = jnp.tile(jnp.arange(GRID_W, dtype=jnp.float32), rows)
    n_freq = HEAD_DIM // 4
    inv = ROPE_BASE ** (-jnp.arange(n_freq, dtype=jnp.float32) / n_freq)
    ang = jnp.stack([row[:, None] * inv, col[:, None] * inv], axis=1)
    return jnp.cos(ang), jnp.sin(ang)


def apply_rope(x, cos, sin):
    T = x.shape[1]
    shp = (T,) + (1,) * (x.ndim - 3) + cos.shape[1:]
    c = cos.reshape(shp)
    s = sin.reshape(shp)
    xr = x.astype(jnp.float32).reshape(x.shape[:-1] + (2, 2, HEAD_DIM // 4))
    x1 = xr[..., 0, :]
    x2 = xr[..., 1, :]
    out = jnp.stack([x1 * c - x2 * s, x2 * c + x1 * s], axis=-2)
    return out.reshape(x.shape).astype(x.dtype)


def sink_softmax(s, sink):
    if sink is None:
        return jax.nn.softmax(s, axis=-1)
    sk = sink.astype(jnp.float32)[:, :, None, None]
    m = jnp.maximum(jnp.max(s, axis=-1, keepdims=True), sk)
    e = jnp.exp(s - m)
    return e / (jnp.sum(e, axis=-1, keepdims=True) + jnp.exp(sk - m))


def attn_heads(q, k, v, qg, kg, hq, hkv):
    B, T, _ = q.shape
    q = rms_norm(q.reshape(B, T, hkv, hq // hkv, HEAD_DIM), qg)
    k = rms_norm(k.reshape(B, T, hkv, HEAD_DIM), kg)
    return q, k, v.reshape(B, T, hkv, HEAD_DIM)


def blocked_attention(q, k, v, sink):
    B, T, HKV, G, _ = q.shape
    nb = T // Q_BLOCK
    qb = jnp.moveaxis(q.reshape(B, nb, Q_BLOCK, HKV, G, HEAD_DIM), 1, 0)
    scale = HEAD_DIM ** -0.5

    def one_block(qi):
        s = jnp.einsum("bqhgd,bkhd->bhgqk", qi, k).astype(jnp.float32) * scale
        p = sink_softmax(s, sink).astype(v.dtype)
        return jnp.einsum("bhgqk,bkhd->bqhgd", p, v)

    o = lax.map(one_block, qb)
    return jnp.moveaxis(o, 0, 1).reshape(B, T, HKV * G * HEAD_DIM)


def banded_attention(q, k, v, ck, cv, sink):
    B, T, HKV, G, _ = q.shape
    nb = T // WINDOW
    qb = q.reshape(B, nb, WINDOW, HKV, G, HEAD_DIM)

    def band(t):
        tp = jnp.pad(t, ((0, 0), (WINDOW, WINDOW), (0, 0), (0, 0))).reshape(B, nb + 2, WINDOW, HKV, HEAD_DIM)
        return jnp.concatenate([tp[:, :-2], tp[:, 1:-1], tp[:, 2:]], axis=2)

    kb, vb = band(k), band(v)
    qpos = jnp.arange(nb)[:, None] * WINDOW + jnp.arange(WINDOW)[None]
    kpos = jnp.arange(nb)[:, None] * WINDOW - WINDOW + jnp.arange(3 * WINDOW)[None]
    valid = ((kpos >= 0) & (kpos < T))[:, None, :]
    mask = valid & (jnp.abs(qpos[:, :, None] - kpos[:, None, :]) <= WINDOW)
    scale = HEAD_DIM ** -0.5
    s_loc = jnp.einsum("bnqhgd,bnkhd->bnhgqk", qb, kb).astype(jnp.float32) * scale
    s_loc = jnp.where(mask[None, :, None, None], s_loc, NEG)
    s_ctx = jnp.einsum("bnqhgd,bkhd->bnhgqk", qb, ck).astype(jnp.float32) * scale
    p = sink_softmax(jnp.concatenate([s_ctx, s_loc], axis=-1), sink).astype(v.dtype)
    C = ck.shape[1]
    o = (jnp.einsum("bnhgqk,bkhd->bnqhgd", p[..., :C], cv)
         + jnp.einsum("bnhgqk,bnkhd->bnqhgd", p[..., C:], vb))
    return o.reshape(B, T, HKV * G * HEAD_DIM)


def rglru_direction(x, wr, br, wi, bi, lam, h0):
    B, T, _ = x.shape
    xb = x.reshape(B, T, LRU_BLOCKS, LRU_BW)
    r = jax.nn.sigmoid(jnp.einsum("btnc,ncd->btnd", xb, wr).reshape(B, T, LRU_W) + br)
    i = jax.nn.sigmoid(jnp.einsum("btnc,ncd->btnd", xb, wi).reshape(B, T, LRU_W) + bi)
    log_a = -LRU_C * r * jax.nn.softplus(-lam.astype(jnp.float32))
    a = jnp.exp(log_a)
    b = jnp.sqrt(-jnp.expm1(2.0 * log_a)) * (i * x)
    a_cum, h = lax.associative_scan(lambda e1, e2: (e1[0] * e2[0], e2[0] * e1[1] + e2[1]), (a, b), axis=1)
    h = h + a_cum * h0.astype(jnp.float32)[:, None, :]
    return h, h[:, -1]


def rglru_mixer(xr, gate, lp, st0):
    x = (centred_dwconv(xr, lp["lru_conv_w"]) + lp["lru_conv_b"]).astype(jnp.float32)
    hf, sf = rglru_direction(x, lp["lru_wr"][0], lp["lru_br"][0], lp["lru_wi"][0], lp["lru_bi"][0],
                             lp["lru_lam"][0], st0[:, 0])
    hb, sb = rglru_direction(jnp.flip(x, 1), lp["lru_wr"][1], lp["lru_br"][1], lp["lru_wi"][1],
                             lp["lru_bi"][1], lp["lru_lam"][1], st0[:, 1])
    y = (hf + jnp.flip(hb, 1)) * jax.nn.gelu(gate.astype(jnp.float32))
    return y.astype(xr.dtype), jnp.stack([sf, sb], axis=1)


def gdn_chunked(q, k, v, g, beta, s0):
    B, T, H, DK = q.shape
    DV = v.shape[-1]
    N = T // CHUNK

    def chunks(t):
        return jnp.moveaxis(t.reshape((B, N, CHUNK, H) + t.shape[3:]), 3, 1)

    q, k, v, g, beta = chunks(q), chunks(k), chunks(v), chunks(g), chunks(beta)
    gc = jnp.cumsum(g, axis=-1)
    idx = jnp.arange(CHUNK)
    incl = idx[:, None] >= idx[None, :]
    strict = idx[:, None] > idx[None, :]
    decay = jnp.exp(jnp.where(incl, gc[..., :, None] - gc[..., None, :], -jnp.inf))
    kk = jnp.einsum("bhnid,bhnjd->bhnij", k, k)
    lower = jnp.eye(CHUNK, dtype=jnp.float32) + jnp.where(strict, beta[..., None] * kk * decay, 0.0)
    rhs = jnp.concatenate([v * beta[..., None], k * (beta * jnp.exp(gc))[..., None]], axis=-1)
    sol = lax.linalg.triangular_solve(lower, rhs, left_side=True, lower=True)
    u, w = sol[..., :DV], sol[..., DV:]
    qk = jnp.einsum("bhnid,bhnjd->bhnij", q, k) * decay

    def step(S, xs):
        q_i, k_i, u_i, w_i, qk_i, gc_i = xs
        v_new = u_i - jnp.einsum("bhck,bhkv->bhcv", w_i, S)
        o = (jnp.einsum("bhck,bhkv->bhcv", q_i * jnp.exp(gc_i)[..., None], S)
             + jnp.einsum("bhij,bhjv->bhiv", qk_i, v_new))
        g_last = gc_i[..., -1:]
        S = (S * jnp.exp(g_last)[..., None]
             + jnp.einsum("bhck,bhcv->bhkv", k_i * jnp.exp(g_last - gc_i)[..., None], v_new))
        return S, o

    xs = tuple(jnp.moveaxis(t, 2, 0) for t in (q, k, u, w, qk, gc))
    S, o = lax.scan(step, s0.astype(jnp.float32), xs)
    o = jnp.moveaxis(jnp.moveaxis(o, 0, 2), 1, 3).reshape(B, T, H, DV)
    return o, S


def gdn_mixer(q, k, v, z, a, bb, lp, s0):
    B, T, _ = q.shape
    qkv = jax.nn.silu(centred_dwconv(jnp.concatenate([q, k, v], axis=-1), lp["gdn_conv_w"]).astype(jnp.float32))
    q, k, v = jnp.split(qkv, (GDN_H * GDN_DK, 2 * GDN_H * GDN_DK), axis=-1)
    q = l2_normalize(q.reshape(B, T, GDN_H, GDN_DK)) * (GDN_DK ** -0.5)
    k = l2_normalize(k.reshape(B, T, GDN_H, GDN_DK))
    v = v.reshape(B, T, GDN_H, GDN_DV)
    a = a.astype(jnp.float32).reshape(B, T, 2, GDN_H)
    g = -jnp.exp(lp["gdn_a_log"].astype(jnp.float32)) * jax.nn.softplus(a + lp["gdn_dt_bias"])
    beta = jax.nn.sigmoid(bb.astype(jnp.float32).reshape(B, T, 2, GDN_H))
    of, sf = gdn_chunked(q, k, v, g[:, :, 0], beta[:, :, 0], s0[:, 0])
    fl = lambda t: jnp.flip(t, 1)
    ob, sb = gdn_chunked(fl(q), fl(k), fl(v), fl(g[:, :, 1]), fl(beta[:, :, 1]), s0[:, 1])
    o = rms_norm(of + fl(ob), lp["gdn_norm_g"]) * jax.nn.silu(z.astype(jnp.float32).reshape(B, T, GDN_H, GDN_DV))
    return o.reshape(B, T, BRANCH_W).astype(z.dtype), jnp.stack([sf, sb], axis=1)


def token_mixing(h, lp, ctx, rope):
    B, T, _ = h.shape
    (aq, ak, av, lx, lg, gq, gk, gv, gz, ga, gb, dq, dk, dv) = jnp.split(h @ lp["w_in"], split_points(), axis=-1)
    aq, ak, av = attn_heads(aq, ak, av, lp["a_qn_g"], lp["a_kn_g"], A_HQ, A_HKV)
    dq, dk, dv = attn_heads(dq, dk, dv, lp["d_qn_g"], lp["d_kn_g"], D_HQ, D_HKV)
    sink = lp["a_sink"].reshape(A_HKV, A_HQ // A_HKV)
    if ctx is None:
        o_a = blocked_attention(aq, ak, av, sink)
        o_d = blocked_attention(dq, dk, dv, None)
        lru0 = jnp.zeros((B, 2, LRU_W), jnp.float32)
        gdn0 = jnp.zeros((B, 2, GDN_H, GDN_DK, GDN_DV), jnp.float32)
    else:
        cak, cav, cdk, cdv, lru0, gdn0 = ctx
        cos, sin = rope
        o_a = banded_attention(apply_rope(aq, cos, sin), apply_rope(ak, cos, sin), av, cak, cav, sink)
        o_d = blocked_attention(apply_rope(dq, cos, sin),
                                jnp.concatenate([cdk, apply_rope(dk, cos, sin)], axis=1),
                                jnp.concatenate([cdv, dv], axis=1), None)
    o_b, lru_s = rglru_mixer(lx, lg, lp, lru0)
    o_c, gdn_s = gdn_mixer(gq, gk, gv, gz, ga, gb, lp, gdn0)
    branches = jnp.stack([o_a, o_b, o_c, o_d], axis=2)
    proj = jnp.einsum("btmc,mcd->btmd", branches, lp["w_branch"])
    gates = jax.nn.sigmoid((h @ lp["w_merge"] + lp["b_merge"]).reshape(B, T, N_BRANCH, D_MODEL))
    y = jnp.sum(gates * proj, axis=2) @ lp["w_out"]
    return y, (ak, av, dk, dv, lru_s.astype(h.dtype), gdn_s.astype(h.dtype))


def trunk_layer(x, cond, lp, ctx, rope):
    mod = jax.nn.silu(cond) @ lp["mod_w"] + lp["mod_b"]
    sh1, sc1, g1, sh2, sc2, g2 = jnp.split(mod, 6, axis=-1)
    y, new_ctx = token_mixing(modulate(x, lp["norm1_g"], sh1, sc1), lp, ctx, rope)
    x = x + g1[:, None, :] * y
    h = modulate(x, lp["norm2_g"], sh2, sc2)
    x = x + g2[:, None, :] * (jnp.square(jax.nn.relu(h @ lp["mlp_w1"])) @ lp["mlp_w2"])
    return x, new_ctx


def setup_inputs(seed: int = 0) -> dict:
    key = jax.random.key(seed)
    ks = iter(jax.random.split(key, 64))
    nrm = lambda shape, s=1.0: jax.random.normal(next(ks), shape, jnp.float32) * s
    gain = lambda shape: 1.0 + nrm(shape, 0.05)
    u = jax.random.uniform(next(ks), (DEPTH, 2, LRU_W), jnp.float32, 0.9, 0.999)
    dt = jnp.exp(jax.random.uniform(next(ks), (DEPTH, 2, GDN_H), jnp.float32, np.log(1e-3), np.log(1e-1)))
    return {
        "x_prompt": nrm((BATCH, SEQ, D_MODEL)),
        "x_sample": nrm((DEC_BATCH, DEC_SEQ, D_MODEL)),
        "c": nrm((DEC_BATCH, D_MODEL)),
        "cache_a_k": nrm((DEC_BATCH, DEPTH, PAST_LEN, A_HKV, HEAD_DIM)),
        "cache_a_v": nrm((DEC_BATCH, DEPTH, PAST_LEN, A_HKV, HEAD_DIM)),
        "cache_d_k": nrm((DEC_BATCH, DEPTH, PAST_LEN, D_HKV, HEAD_DIM)),
        "cache_d_v": nrm((DEC_BATCH, DEPTH, PAST_LEN, D_HKV, HEAD_DIM)),
        "state_lru": nrm((DEC_BATCH, DEPTH, 2, LRU_W), 0.5),
        "state_gdn": nrm((DEC_BATCH, DEPTH, 2, GDN_H, GDN_DK, GDN_DV), 0.3),
        "c_ctx": nrm((D_MODEL,)),
        "mod_w": nrm((DEPTH, D_MODEL, 6 * D_MODEL), 0.5 * D_MODEL ** -0.5),
        "mod_b": nrm((DEPTH, 6 * D_MODEL), 0.01),
        "norm1_g": gain((DEPTH, D_MODEL)),
        "norm2_g": gain((DEPTH, D_MODEL)),
        "w_in": nrm((DEPTH, D_MODEL, IN_COLS), D_MODEL ** -0.5),
        "a_qn_g": gain((DEPTH, HEAD_DIM)),
        "a_kn_g": gain((DEPTH, HEAD_DIM)),
        "a_sink": nrm((DEPTH, A_HQ)),
        "lru_conv_w": nrm((DEPTH, CONV_W, LRU_W), CONV_W ** -0.5),
        "lru_conv_b": nrm((DEPTH, LRU_W), 0.01),
        "lru_wr": nrm((DEPTH, 2, LRU_BLOCKS, LRU_BW, LRU_BW), LRU_BW ** -0.5),
        "lru_br": nrm((DEPTH, 2, LRU_W), 0.01),
        "lru_wi": nrm((DEPTH, 2, LRU_BLOCKS, LRU_BW, LRU_BW), LRU_BW ** -0.5),
        "lru_bi": nrm((DEPTH, 2, LRU_W), 0.01),
        "lru_lam": jnp.log(u) - jnp.log1p(-u),
        "gdn_conv_w": nrm((DEPTH, CONV_W, 2 * GDN_H * GDN_DK + GDN_H * GDN_DV), CONV_W ** -0.5),
        "gdn_a_log": jnp.log(jax.random.uniform(next(ks), (DEPTH, 2, GDN_H), jnp.float32, 1.0, 16.0)),
        "gdn_dt_bias": dt + jnp.log(-jnp.expm1(-dt)),
        "gdn_norm_g": gain((DEPTH, GDN_DV)),
        "d_qn_g": gain((DEPTH, HEAD_DIM)),
        "d_kn_g": gain((DEPTH, HEAD_DIM)),
        "w_branch": nrm((DEPTH, N_BRANCH, BRANCH_W, D_MODEL), BRANCH_W ** -0.5),
        "w_merge": nrm((DEPTH, D_MODEL, N_BRANCH * D_MODEL), D_MODEL ** -0.5),
        "b_merge": nrm((DEPTH, N_BRANCH * D_MODEL), 0.01),
        "w_out": nrm((DEPTH, D_MODEL, D_MODEL), D_MODEL ** -0.5),
        "mlp_w1": nrm((DEPTH, D_MODEL, D_FF), D_MODEL ** -0.5),
        "mlp_w2": nrm((DEPTH, D_FF, D_MODEL), D_FF ** -0.5),
    }


def reference(x_prompt, x_sample, c, cache_a_k, cache_a_v, cache_d_k, cache_d_v, state_lru, state_gdn,
              c_ctx, mod_w, mod_b, norm1_g, norm2_g, w_in, a_qn_g, a_kn_g, a_sink, lru_conv_w, lru_conv_b,
              lru_wr, lru_br, lru_wi, lru_bi, lru_lam, gdn_conv_w, gdn_a_log, gdn_dt_bias, gdn_norm_g,
              d_qn_g, d_kn_g, w_branch, w_merge, b_merge, w_out, mlp_w1, mlp_w2):
    def layer_params(l):
        return dict(mod_w=mod_w[l], mod_b=mod_b[l], norm1_g=norm1_g[l], norm2_g=norm2_g[l], w_in=w_in[l],
                    a_qn_g=a_qn_g[l], a_kn_g=a_kn_g[l], a_sink=a_sink[l], lru_conv_w=lru_conv_w[l],
                    lru_conv_b=lru_conv_b[l], lru_wr=lru_wr[l], lru_br=lru_br[l], lru_wi=lru_wi[l],
                    lru_bi=lru_bi[l], lru_lam=lru_lam[l], gdn_conv_w=gdn_conv_w[l], gdn_a_log=gdn_a_log[l],
                    gdn_dt_bias=gdn_dt_bias[l], gdn_norm_g=gdn_norm_g[l], d_qn_g=d_qn_g[l], d_kn_g=d_kn_g[l],
                    w_branch=w_branch[l], w_merge=w_merge[l], b_merge=b_merge[l], w_out=w_out[l],
                    mlp_w1=mlp_w1[l], mlp_w2=mlp_w2[l])

    xp = x_prompt
    ctx_tensors = []
    for l in range(DEPTH):
        xp, ctx_l = trunk_layer(xp, c_ctx[None, :], layer_params(l), None, None)
        ctx_tensors.append(ctx_l)
    new_a_k, new_a_v, new_d_k, new_d_v, new_lru, new_gdn = [jnp.stack(t, axis=1) for t in zip(*ctx_tensors)]

    rope = axial_rope(x_sample.shape[1])
    xs = x_sample
    for l in range(DEPTH):
        ctx_l = (cache_a_k[:, l], cache_a_v[:, l], cache_d_k[:, l], cache_d_v[:, l], state_lru[:, l], state_gdn[:, l])
        xs, _ = trunk_layer(xs, c, layer_params(l), ctx_l, rope)

    return (xp, xs, new_a_k, new_a_v, new_d_k, new_d_v, new_lru, new_gdn)
```

```cpp
#include <hip/hip_runtime.h>
#include <hip/hip_cooperative_groups.h>
#include <cstdio>
namespace cg = cooperative_groups;

#ifndef MULTI_LAUNCH
#define MULTI_LAUNCH 0
#endif
#ifndef PHM
#define PHM 0xFFFFFFFFu
#endif
#define PHON(b) ((PHM >> (b)) & 1u)

typedef unsigned short u16;
using bf16x8 = __attribute__((ext_vector_type(8))) short;
using f32x4 = __attribute__((ext_vector_type(4))) float;
using u32x4 = __attribute__((ext_vector_type(4))) unsigned;
#define DI __device__ __forceinline__
#define MFMA16(a, b, c) __builtin_amdgcn_mfma_f32_16x16x32_bf16((a), (b), (c), 0, 0, 0)

constexpr int NTOK = 16384;
constexpr int DM = 1024;
constexpr int LDI = 2592;
constexpr int C_AQ = 0, C_AK = 256, C_AV = 384, C_LX = 512, C_LG = 768, C_GQ = 1024, C_GK = 1280, C_GV = 1536, C_GZ = 1792,
              C_DQ = 2048, C_DK = 2304, C_DV = 2432, C_GA = 2560, C_GB = 2568;
constexpr int NIN_PAD = 2688;

constexpr size_t WS_MOD = 0;
constexpr size_t WS_CTR = WS_MOD + 2 * 3 * 6144 * 4;
constexpr size_t WS_LRUC = WS_CTR + 256;
constexpr size_t WS_KC = WS_LRUC + (size_t)512 * 2 * 2 * 256 * 4;
constexpr size_t WS_GVEC = WS_KC + (size_t)16 * 512 * 64 * 2;
constexpr size_t WS_WIN = WS_GVEC + (size_t)1024 * 2 * 256 * 4;
constexpr size_t WS_WM = WS_WIN + (size_t)NIN_PAD * 1024 * 2;
constexpr size_t WS_WB = WS_WM + (size_t)4096 * 1024 * 2;
constexpr size_t WS_WO = WS_WB + (size_t)4 * 1024 * 256 * 2;
constexpr size_t WS_W1 = WS_WO + (size_t)1024 * 1024 * 2;
constexpr size_t WS_W2 = WS_W1 + (size_t)4096 * 1024 * 2;
constexpr size_t WS_H = WS_W2 + (size_t)1024 * 4096 * 2;
constexpr size_t WS_BIG = WS_H + (size_t)NTOK * 1024 * 2;
constexpr size_t WS_INPROJ = WS_BIG;
constexpr size_t WS_BRANCH = WS_INPROJ + (size_t)NTOK * LDI * 2;
constexpr size_t WS_QHAT = WS_BRANCH + (size_t)NTOK * 1024 * 2;
constexpr size_t WS_KT = WS_QHAT + (size_t)1024 * 4096 * 2;
constexpr size_t WS_UW = WS_KT + (size_t)1024 * 4096 * 2;
constexpr size_t WS_QK = WS_UW + (size_t)1024 * 2 * 8192 * 2;
constexpr size_t WS_END = WS_QK + (size_t)1024 * 2 * 4096 * 2;
constexpr size_t WS_HIDDEN = WS_BIG;
constexpr size_t WS_MERGED = WS_BIG;
static_assert(WS_HIDDEN + (size_t)NTOK * 4096 * 2 <= WS_END, "hidden must fit");
static_assert(WS_END <= (size_t)256 * 1024 * 1024, "workspace budget");

constexpr size_t O_X = 0, O_AK = 16777216, O_AV = 18874368, O_DK = 20971520, O_DV = 23068672, O_LRU = 25165824, O_GDN = 25198592;

struct Params {
  const float* in[37];
  float* out;
  unsigned char* ws;
};

typedef const Params __attribute__((address_space(4)))* KP;
constexpr int SMEM_BYTES = 61952;

DI u16 f2bf(float x) { unsigned u = __float_as_uint(x); u += 0x7fffu + ((u >> 16) & 1u); return (u16)(u >> 16); }
DI float bf2f(u16 h) { return __uint_as_float(((unsigned)h) << 16); }
DI unsigned pack2(float a, float b) { return (unsigned)f2bf(a) | ((unsigned)f2bf(b) << 16); }
DI float bflo(unsigned u) { return __uint_as_float(u << 16); }
DI float bfhi(unsigned u) { return __uint_as_float(u & 0xffff0000u); }
DI float sigm(float x) { return 1.f / (1.f + __expf(-x)); }
DI float siluf_(float x) { return x / (1.f + __expf(-x)); }
DI float softplusf_(float x) { return x > 20.f ? x : log1pf(__expf(x)); }
DI float gelu_tanh(float x) { float u = 0.7978845608028654f * (x + 0.044715f * x * x * x); float t = 1.f - 2.f / (__expf(2.f * u) + 1.f); return 0.5f * x * (1.f + t); }
DI float wave_sum(float v) {
#pragma unroll
  for (int o = 32; o > 0; o >>= 1) v += __shfl_xor(v, o, 64);
  return v;
}
DI u32x4 mku4(unsigned a, unsigned b, unsigned c, unsigned d) { u32x4 v = {a, b, c, d}; return v; }
DI bf16x8 mk8(unsigned a, unsigned b, unsigned c, unsigned d) { u32x4 v = {a, b, c, d}; return __builtin_bit_cast(bf16x8, v); }
DI bf16x8 pack8(const f32x4& x, const f32x4& y) { return mk8(pack2(x[0], x[1]), pack2(x[2], x[3]), pack2(y[0], y[1]), pack2(y[2], y[3])); }
DI bf16x8 ld8(const u16* p) { return *(const bf16x8*)p; }
DI bf16x8 ldperm(const u16* p) { uint2 a = *(const uint2*)p; uint2 b = *(const uint2*)(p + 16); return mk8(a.x, a.y, b.x, b.y); }
DI int mod_group(int row) { return row < 8192 ? 0 : 1 + ((row - 8192) >> 12); }
DI const float* x_in_row(KP p, int l, int row) {
  if (l == 0) return row < 8192 ? p->in[0] + (size_t)row * DM : p->in[1] + (size_t)(row - 8192) * DM;
  return p->out + (size_t)row * DM;
}
DI unsigned swap16(unsigned u) { return (u >> 16) | (u << 16); }
DI u32x4 rev8(u32x4 v) { return mku4(swap16(v.w), swap16(v.z), swap16(v.y), swap16(v.x)); }

DI void mod_item(KP p, int item, unsigned char* smem) {
  float* sc = (float*)smem;
  float* sr = sc + 3072;
  const int tid = threadIdx.x;
  const int l = item / 96, cb = item % 96;
  for (int i = tid; i < 3072; i += 256) {
    int g = i >> 10, k = i & 1023;
    float c = g == 0 ? p->in[9][k] : p->in[2][(g - 1) * 1024 + k];
    sc[i] = siluf_(c);
  }
  __syncthreads();
  const int col = cb * 64 + (tid & 63), kg = tid >> 6;
  const float* W = p->in[10] + (size_t)l * 1024 * 6144;
  float a0 = 0.f, a1 = 0.f, a2 = 0.f;
  for (int k = kg * 256; k < kg * 256 + 256; ++k) {
    float w = W[(size_t)k * 6144 + col];
    a0 += sc[k] * w; a1 += sc[1024 + k] * w; a2 += sc[2048 + k] * w;
  }
  sr[(kg * 3 + 0) * 64 + (tid & 63)] = a0; sr[(kg * 3 + 1) * 64 + (tid & 63)] = a1; sr[(kg * 3 + 2) * 64 + (tid & 63)] = a2;
  __syncthreads();
  if (tid < 192) {
    int g = tid >> 6, cc = tid & 63;
    float s = p->in[11][l * 6144 + cb * 64 + cc];
    for (int q = 0; q < 4; ++q) s += sr[(q * 3 + g) * 64 + cc];
    ((float*)(p->ws + WS_MOD))[(l * 3 + g) * 6144 + cb * 64 + cc] = s;
  }
  __syncthreads();
}

DI void conv_tile(const float* src, int N, int k0, int n0, u16* dst, int K, bool perm, unsigned char* smem) {
  float* tile = (float*)smem;
  const int tid = threadIdx.x;
#pragma unroll
  for (int i = 0; i < 4; ++i) {
    int kr = (tid >> 4) + 16 * i, nc = (tid & 15) * 4;
    float4 v = make_float4(0.f, 0.f, 0.f, 0.f);
    if (n0 + nc < N) v = *(const float4*)(src + (size_t)(k0 + kr) * N + n0 + nc);
    tile[kr * 65 + nc] = v.x; tile[kr * 65 + nc + 1] = v.y; tile[kr * 65 + nc + 2] = v.z; tile[kr * 65 + nc + 3] = v.w;
  }
  __syncthreads();
#pragma unroll
  for (int i = 0; i < 2; ++i) {
    int n = (tid >> 3) + 32 * i, k8 = (tid & 7) * 8;
    int ng = n0 + n;
    if (ng < N) {
      int row = ng;
      if (perm) row = ng < 2048 ? ng : (ng < 2064 ? 2560 + (ng - 2048) : ng - 16);
      u32x4 o;
      o.x = pack2(tile[(k8 + 0) * 65 + n], tile[(k8 + 1) * 65 + n]);
      o.y = pack2(tile[(k8 + 2) * 65 + n], tile[(k8 + 3) * 65 + n]);
      o.z = pack2(tile[(k8 + 4) * 65 + n], tile[(k8 + 5) * 65 + n]);
      o.w = pack2(tile[(k8 + 6) * 65 + n], tile[(k8 + 7) * 65 + n]);
      *(u32x4*)(dst + (size_t)row * K + k0 + k8) = o;
    }
  }
  __syncthreads();
}

constexpr int CONV_ITEMS = 4241;
DI void convert_item(KP p, int l, int item, unsigned char* smem) {
  unsigned char* ws = p->ws;
  if (item < 656) { int kt = item / 41, nt = item % 41; conv_tile(p->in[14] + (size_t)l * 1024 * 2576, 2576, kt * 64, nt * 64, (u16*)(ws + WS_WIN), 1024, true, smem); return; }
  item -= 656;
  if (item < 1024) { int kt = item >> 6, nt = item & 63; conv_tile(p->in[32] + (size_t)l * 1024 * 4096, 4096, kt * 64, nt * 64, (u16*)(ws + WS_WM), 1024, false, smem); return; }
  item -= 1024;
  if (item < 256) { int m = item >> 6, r = item & 63, kt = r >> 4, nt = r & 15;
    conv_tile(p->in[31] + ((size_t)l * 4 + m) * 256 * 1024, 1024, kt * 64, nt * 64, (u16*)(ws + WS_WB) + (size_t)m * 1024 * 256, 256, false, smem); return; }
  item -= 256;
  if (item < 256) { int kt = item >> 4, nt = item & 15; conv_tile(p->in[34] + (size_t)l * 1024 * 1024, 1024, kt * 64, nt * 64, (u16*)(ws + WS_WO), 1024, false, smem); return; }
  item -= 256;
  if (item < 1024) { int kt = item >> 6, nt = item & 63; conv_tile(p->in[35] + (size_t)l * 1024 * 4096, 4096, kt * 64, nt * 64, (u16*)(ws + WS_W1), 1024, false, smem); return; }
  item -= 1024;
  if (item < 1024) { int kt = item >> 4, nt = item & 15; conv_tile(p->in[36] + (size_t)l * 4096 * 1024, 1024, kt * 64, nt * 64, (u16*)(ws + WS_W2), 4096, false, smem); return; }
  u32x4* z = (u32x4*)((u16*)(ws + WS_WIN) + (size_t)2576 * 1024);
  for (int i = threadIdx.x; i < 112 * 1024 / 8; i += 256) z[i] = mku4(0, 0, 0, 0);
}

template <int which>
DI void norm_item(KP p, int l, int item) {
  const int lane = threadIdx.x & 63, wave = threadIdx.x >> 6;
  const int row = item * 4 + wave;
  const float* x = x_in_row(p, which == 0 ? l : 2, row);
  const float* g = p->in[which == 0 ? 12 : 13] + l * 1024;
  const float* mod = (const float*)(p->ws + WS_MOD) + (l * 3 + mod_group(row)) * 6144;
  const float* sh = mod + (which == 0 ? 0 : 3072);
  const float* sc = mod + (which == 0 ? 1024 : 4096);
  f32x4 v[4]; float ss = 0.f;
#pragma unroll
  for (int i = 0; i < 4; ++i) { v[i] = *(const f32x4*)(x + i * 256 + lane * 4); ss += v[i].x * v[i].x + v[i].y * v[i].y + v[i].z * v[i].z + v[i].w * v[i].w; }
  ss = wave_sum(ss);
  const float rstd = rsqrtf(ss * (1.f / 1024.f) + 1e-6f);
  u16* H = (u16*)(p->ws + WS_H) + (size_t)row * 1024;
#pragma unroll
  for (int i = 0; i < 4; ++i) {
    int c = i * 256 + lane * 4;
    float4 gg = *(const float4*)(g + c), s1 = *(const float4*)(sc + c), s0 = *(const float4*)(sh + c);
    float y0 = v[i].x * rstd * gg.x * (1.f + s1.x) + s0.x, y1 = v[i].y * rstd * gg.y * (1.f + s1.y) + s0.y;
    float y2 = v[i].z * rstd * gg.z * (1.f + s1.z) + s0.z, y3 = v[i].w * rstd * gg.w * (1.f + s1.w) + s0.w;
    *(uint2*)(H + c) = make_uint2(pack2(y0, y1), pack2(y2, y3));
  }
}

template <int NT>
DI void gemm_acc(f32x4 (&acc)[4][NT], const u16* __restrict__ A, int lda, const u16* __restrict__ Bt, int ldb, int K, unsigned char* smem) {
  constexpr int BI = NT;
  u16* sA = (u16*)smem;
  u16* sB = sA + 128 * 72;
  const int tid = threadIdx.x, lane = tid & 63, wave = tid >> 6, wm = wave >> 1, wn = wave & 1;
  const int lr = tid >> 3, lk = (tid & 7) * 8;
  const int lq = lane & 15, quad = lane >> 4;
  u32x4 ra[4], rb[BI];
#pragma unroll
  for (int i = 0; i < 4; ++i) ra[i] = *(const u32x4*)(A + (size_t)(lr + 32 * i) * lda + lk);
#pragma unroll
  for (int i = 0; i < BI; ++i) rb[i] = *(const u32x4*)(Bt + (size_t)(lr + 32 * i) * ldb + lk);
  for (int k0 = 0; k0 < K; k0 += 64) {
    __syncthreads();
#pragma unroll
    for (int i = 0; i < 4; ++i) *(u32x4*)(sA + (lr + 32 * i) * 72 + lk) = ra[i];
#pragma unroll
    for (int i = 0; i < BI; ++i) *(u32x4*)(sB + (lr + 32 * i) * 72 + lk) = rb[i];
    __syncthreads();
    if (k0 + 64 < K) {
#pragma unroll
      for (int i = 0; i < 4; ++i) ra[i] = *(const u32x4*)(A + (size_t)(lr + 32 * i) * lda + k0 + 64 + lk);
#pragma unroll
      for (int i = 0; i < BI; ++i) rb[i] = *(const u32x4*)(Bt + (size_t)(lr + 32 * i) * ldb + k0 + 64 + lk);
    }
#pragma unroll
    for (int s = 0; s < 2; ++s) {
      bf16x8 af[4], bfr[NT];
#pragma unroll
      for (int i = 0; i < 4; ++i) af[i] = ld8(sA + (wm * 64 + i * 16 + lq) * 72 + s * 32 + quad * 8);
#pragma unroll
      for (int j = 0; j < NT; ++j) bfr[j] = ld8(sB + (wn * NT * 16 + j * 16 + lq) * 72 + s * 32 + quad * 8);
#pragma unroll
      for (int i = 0; i < 4; ++i)
#pragma unroll
        for (int j = 0; j < NT; ++j) acc[i][j] = MFMA16(af[i], bfr[j], acc[i][j]);
    }
  }
}

template <int NT> DI void zero_acc(f32x4 (&acc)[4][NT]) {
#pragma unroll
  for (int i = 0; i < 4; ++i)
#pragma unroll
    for (int j = 0; j < NT; ++j) acc[i][j] = f32x4{0.f, 0.f, 0.f, 0.f};
}

#define EPI_LOOP(NT)                                                              \
  const int lane_ = threadIdx.x & 63, wave_ = threadIdx.x >> 6;                    \
  const int wm_ = wave_ >> 1, wn_ = wave_ & 1, lq_ = lane_ & 15, quad_ = lane_ >> 4; \
  _Pragma("unroll") for (int i = 0; i < 4; ++i)                                    \
  _Pragma("unroll") for (int j = 0; j < NT; ++j)                                   \
  _Pragma("unroll") for (int r = 0; r < 4; ++r)
#define EPI_ROW(m0) ((m0) + wm_ * 64 + i * 16 + quad_ * 4 + r)
#define EPI_COL(n0, NT) ((n0) + wn_ * (NT) * 16 + j * 16 + lq_)

DI void inproj_item(KP p, int item, unsigned char* smem) {
  const int mt = item / 21, nt = item % 21, m0 = mt * 128, n0 = nt * 128;
  f32x4 acc[4][4]; zero_acc<4>(acc);
  gemm_acc<4>(acc, (const u16*)(p->ws + WS_H) + (size_t)m0 * 1024, 1024, (const u16*)(p->ws + WS_WIN) + (size_t)n0 * 1024, 1024, 1024, smem);
  u16* C = (u16*)(p->ws + WS_INPROJ);
  EPI_LOOP(4) { int row = EPI_ROW(m0), col = EPI_COL(n0, 4); if (col < LDI) C[(size_t)row * LDI + col] = f2bf(acc[i][j][r]); }
}

DI void merge_item(KP p, int l, int item, unsigned char* smem) {
  const int mt = item >> 4, nt = item & 15, m0 = mt * 128, n0 = nt * 64;
  const u16* H = (const u16*)(p->ws + WS_H) + (size_t)m0 * 1024;
  const u16* BR = (const u16*)(p->ws + WS_BRANCH) + (size_t)m0 * 1024;
  const float* bm = p->in[33] + l * 4096;
  f32x4 accm[4][2]; zero_acc<2>(accm);
  for (int m = 0; m < 4; ++m) {
    f32x4 ag[4][2], ap[4][2]; zero_acc<2>(ag); zero_acc<2>(ap);
    gemm_acc<2>(ag, H, 1024, (const u16*)(p->ws + WS_WM) + (size_t)(m * 1024 + n0) * 1024, 1024, 1024, smem);
    gemm_acc<2>(ap, BR + m * 256, 1024, (const u16*)(p->ws + WS_WB) + (size_t)(m * 1024 + n0) * 256, 256, 256, smem);
    EPI_LOOP(2) { int col = EPI_COL(n0, 2); accm[i][j][r] += sigm(ag[i][j][r] + bm[m * 1024 + col]) * ap[i][j][r]; }
  }
  u16* C = (u16*)(p->ws + WS_MERGED);
  EPI_LOOP(2) { int row = EPI_ROW(m0), col = EPI_COL(n0, 2); C[(size_t)row * 1024 + col] = f2bf(accm[i][j][r]); }
}

DI void wout_item(KP p, int l, int item, unsigned char* smem) {
  const int mt = item >> 3, nt = item & 7, m0 = mt * 128, n0 = nt * 128;
  f32x4 acc[4][4]; zero_acc<4>(acc);
  gemm_acc<4>(acc, (const u16*)(p->ws + WS_MERGED) + (size_t)m0 * 1024, 1024, (const u16*)(p->ws + WS_WO) + (size_t)n0 * 1024, 1024, 1024, smem);
  const float* g1 = (const float*)(p->ws + WS_MOD) + (l * 3 + mod_group(m0)) * 6144 + 2048;
  EPI_LOOP(4) { int row = EPI_ROW(m0), col = EPI_COL(n0, 4); p->out[(size_t)row * DM + col] = x_in_row(p, l, row)[col] + g1[col] * acc[i][j][r]; }
}

DI void w1_item(KP p, int item, unsigned char* smem) {
  const int mt = item >> 5, nt = item & 31, m0 = mt * 128, n0 = nt * 128;
  f32x4 acc[4][4]; zero_acc<4>(acc);
  gemm_acc<4>(acc, (const u16*)(p->ws + WS_H) + (size_t)m0 * 1024, 1024, (const u16*)(p->ws + WS_W1) + (size_t)n0 * 1024, 1024, 1024, smem);
  u16* C = (u16*)(p->ws + WS_HIDDEN);
  EPI_LOOP(4) { int row = EPI_ROW(m0), col = EPI_COL(n0, 4); float v = fmaxf(acc[i][j][r], 0.f); C[(size_t)row * 4096 + col] = f2bf(v * v); }
}

DI void w2_item(KP p, int l, int item, unsigned char* smem) {
  const int mt = item >> 3, nt = item & 7, m0 = mt * 128, n0 = nt * 128;
  f32x4 acc[4][4]; zero_acc<4>(acc);
  gemm_acc<4>(acc, (const u16*)(p->ws + WS_HIDDEN) + (size_t)m0 * 4096, 4096, (const u16*)(p->ws + WS_W2) + (size_t)n0 * 4096, 4096, 4096, smem);
  const float* g2 = (const float*)(p->ws + WS_MOD) + (l * 3 + mod_group(m0)) * 6144 + 5120;
  EPI_LOOP(4) { int row = EPI_ROW(m0), col = EPI_COL(n0, 4); float* o = p->out + (size_t)row * DM + col; *o = *o + g2[col] * acc[i][j][r]; }
}

DI void prep_item(KP p, int l, int item) {
  const int lane = threadIdx.x & 63, wave = threadIdx.x >> 6;
  const int row = item * 4 + wave;
  const bool lat = row >= 8192;
  u16* R = (u16*)(p->ws + WS_INPROJ) + (size_t)row * LDI;
  float cs = 1.f, sn = 0.f;
  if (lat) {
    int t = (row - 8192) & 4095;
    int pos = (lane < 32) ? (t >> 6) : (t & 63);
    float inv = __expf(-(float)(lane & 15) * (9.210340371976184f / 16.f));
    float ang = (float)pos * inv;
    cs = __cosf(ang); sn = __sinf(ang);
  }
  const int b = row >> 8, t = row & 255;
#pragma unroll
  for (int hh = 0; hh < 12; ++hh) {
    int col; const float* g;
    if (hh < 4) { col = C_AQ + hh * 64; g = p->in[15] + l * 64; }
    else if (hh < 6) { col = C_AK + (hh - 4) * 64; g = p->in[16] + l * 64; }
    else if (hh < 10) { col = C_DQ + (hh - 6) * 64; g = p->in[29] + l * 64; }
    else { col = C_DK + (hh - 10) * 64; g = p->in[30] + l * 64; }
    float v = bf2f(R[col + lane]);
    float ss = wave_sum(v * v);
    float y = v * rsqrtf(ss * (1.f / 64.f) + 1e-6f) * g[lane];
    if (lat) {
      float yp = __shfl_xor(y, 16, 64);
      y = ((lane & 31) < 16) ? (y * cs - yp * sn) : (y * cs + yp * sn);
    } else {
      if (hh == 4 || hh == 5) p->out[O_AK + ((size_t)(b * 2 + l) * 256 + t) * 128 + (hh - 4) * 64 + lane] = y;
      if (hh >= 10) p->out[O_DK + ((size_t)(b * 2 + l) * 256 + t) * 128 + (hh - 10) * 64 + lane] = y;
    }
    R[col + lane] = f2bf(y);
  }
  if (!lat) {
    size_t o = ((size_t)(b * 2 + l) * 256 + t) * 128;
    p->out[O_AV + o + lane] = bf2f(R[C_AV + lane]); p->out[O_AV + o + 64 + lane] = bf2f(R[C_AV + 64 + lane]);
    p->out[O_DV + o + lane] = bf2f(R[C_DV + lane]); p->out[O_DV + o + 64 + lane] = bf2f(R[C_DV + 64 + lane]);
  }
}

DI void kvc_item(KP p, int l, int item) {
  u16* KC = (u16*)(p->ws + WS_KC);
#pragma unroll
  for (int it = 0; it < 8; ++it) {
    int idx4 = item * 2048 + it * 256 + threadIdx.x;
    int e = idx4 * 4;
    int d = e & 63, key = (e >> 6) & 511, sel = e >> 15;
    int kv = sel & 1, kvh = (sel >> 1) & 1, b = (sel >> 2) & 1, mixer = sel >> 3;
    const float* srcb = mixer ? (kv ? p->in[6] : p->in[5]) : (kv ? p->in[4] : p->in[3]);
    const float* src = srcb + ((size_t)((b * 2 + l) * 512 + key) * 2 + kvh) * 64 + d;
    float4 v = *(const float4*)src;
    *(uint2*)(KC + e) = make_uint2(pack2(v.x, v.y), pack2(v.z, v.w));
  }
}

DI void attn_item(KP p, int l, int it, unsigned char* smem) {
  u16* sK = (u16*)smem;
  u16* sVt = sK + 64 * 72;
  const int tid = threadIdx.x, lane = tid & 63, wave = tid >> 6, lq = lane & 15, quad = lane >> 4;
  int kind, b, qh, qb;
  if (it < 512) { kind = it >> 8; int r = it & 255; b = r >> 7; qh = (r >> 5) & 3; qb = r & 31; }
  else { int r = it - 512; kind = 2 + (r >> 8); r &= 255; b = r >> 3; qh = (r >> 1) & 3; qb = r & 1; }
  const bool isD = (kind == 0 || kind == 3), lat = kind < 2;
  const int seqrow0 = lat ? 8192 + b * 4096 : b * 256;
  const int q0 = qb * 128, kvh = qh >> 1;
  const int qcol = (isD ? C_DQ : C_AQ) + qh * 64, kcol = (isD ? C_DK : C_AK) + kvh * 64, vcol = (isD ? C_DV : C_AV) + kvh * 64;
  const int ocol = (isD ? 768 : 0) + qh * 64;
  const int ncache = lat ? 8 : 0;
  int kt_lo = 0, kt_hi = lat ? 64 : 4;
  if (kind == 1) { kt_lo = max(0, 2 * qb - 2); kt_hi = min(64, 2 * qb + 4); }
  const int ntiles = ncache + kt_hi - kt_lo;
  const bool band = (kind == 1);
  const u16* INP = (const u16*)(p->ws + WS_INPROJ);
  const u16* KCk = (const u16*)(p->ws + WS_KC) + (size_t)((((isD ? 1 : 0) * 2 + b) * 2 + kvh) * 2) * 512 * 64;
  const u16* KCv = KCk + 512 * 64;
  const float sinkv = isD ? -1e30f : p->in[17][l * 4 + qh];

  bf16x8 qf[2][2];
#pragma unroll
  for (int nt = 0; nt < 2; ++nt)
#pragma unroll
    for (int s = 0; s < 2; ++s) qf[nt][s] = ld8(INP + (size_t)(seqrow0 + q0 + wave * 32 + nt * 16 + lq) * LDI + qcol + s * 32 + quad * 8);
  float mrun[2], lsum[2];
  f32x4 oacc[4][2];
#pragma unroll
  for (int nt = 0; nt < 2; ++nt) { mrun[nt] = sinkv; lsum[nt] = (!isD && quad == 0) ? 1.f : 0.f; }
#pragma unroll
  for (int dt = 0; dt < 4; ++dt)
#pragma unroll
    for (int nt = 0; nt < 2; ++nt) oacc[dt][nt] = f32x4{0.f, 0.f, 0.f, 0.f};

  const int key = tid >> 2, seg = (tid & 3) * 16;
  u32x4 rk[2], rv[2];
  auto tile_ptrs = [&](int t, const u16*& kp, const u16*& vp) {
    if (t < ncache) { kp = KCk + (size_t)(t * 64 + key) * 64 + seg; vp = KCv + (size_t)(t * 64 + key) * 64 + seg; }
    else { const u16* rowp = INP + (size_t)(seqrow0 + (kt_lo + t - ncache) * 64 + key) * LDI; kp = rowp + kcol + seg; vp = rowp + vcol + seg; }
  };
  { const u16 *kp, *vp; tile_ptrs(0, kp, vp); rk[0] = *(const u32x4*)kp; rk[1] = *(const u32x4*)(kp + 8); rv[0] = *(const u32x4*)vp; rv[1] = *(const u32x4*)(vp + 8); }
  for (int t = 0; t < ntiles; ++t) {
    __syncthreads();
    *(u32x4*)(sK + key * 72 + seg) = rk[0]; *(u32x4*)(sK + key * 72 + seg + 8) = rk[1];
    {
      unsigned vv[8] = {rv[0].x, rv[0].y, rv[0].z, rv[0].w, rv[1].x, rv[1].y, rv[1].z, rv[1].w};
#pragma unroll
      for (int e = 0; e < 8; ++e) { sVt[(seg + 2 * e) * 72 + key] = (u16)(vv[e] & 0xffffu); sVt[(seg + 2 * e + 1) * 72 + key] = (u16)(vv[e] >> 16); }
    }
    __syncthreads();
    if (t + 1 < ntiles) { const u16 *kp, *vp; tile_ptrs(t + 1, kp, vp); rk[0] = *(const u32x4*)kp; rk[1] = *(const u32x4*)(kp + 8); rv[0] = *(const u32x4*)vp; rv[1] = *(const u32x4*)(vp + 8); }
    f32x4 sacc[4][2];
#pragma unroll
    for (int mt = 0; mt < 4; ++mt) {
      sacc[mt][0] = f32x4{0.f, 0.f, 0.f, 0.f}; sacc[mt][1] = f32x4{0.f, 0.f, 0.f, 0.f};
#pragma unroll
      for (int s = 0; s < 2; ++s) {
        bf16x8 ka = ld8(sK + (mt * 16 + lq) * 72 + s * 32 + quad * 8);
        sacc[mt][0] = MFMA16(ka, qf[0][s], sacc[mt][0]);
        sacc[mt][1] = MFMA16(ka, qf[1][s], sacc[mt][1]);
      }
    }
    const bool masked_tile = band && t >= ncache;
    const int kbase = (kt_lo + t - ncache) * 64;
    bf16x8 pf[2][2];
#pragma unroll
    for (int nt = 0; nt < 2; ++nt) {
      const int qi = q0 + wave * 32 + nt * 16 + lq;
      float tmax = -1e30f;
#pragma unroll
      for (int mt = 0; mt < 4; ++mt)
#pragma unroll
        for (int r = 0; r < 4; ++r) {
          float s = sacc[mt][nt][r] * 0.125f;
          if (masked_tile) { int kj = kbase + mt * 16 + quad * 4 + r; int dlt = qi - kj; if (dlt > 128 || dlt < -128) s = -1e30f; }
          sacc[mt][nt][r] = s; tmax = fmaxf(tmax, s);
        }
      tmax = fmaxf(tmax, __shfl_xor(tmax, 16, 64)); tmax = fmaxf(tmax, __shfl_xor(tmax, 32, 64));
      const float mnew = fmaxf(mrun[nt], tmax);
      const float alpha = __expf(mrun[nt] - mnew);
      float ps = 0.f;
#pragma unroll
      for (int mt = 0; mt < 4; ++mt)
#pragma unroll
        for (int r = 0; r < 4; ++r) { float e = __expf(sacc[mt][nt][r] - mnew); sacc[mt][nt][r] = e; ps += e; }
      lsum[nt] = lsum[nt] * alpha + ps; mrun[nt] = mnew;
#pragma unroll
      for (int dt = 0; dt < 4; ++dt)
#pragma unroll
        for (int r = 0; r < 4; ++r) oacc[dt][nt][r] *= alpha;
      pf[nt][0] = pack8(sacc[0][nt], sacc[1][nt]);
      pf[nt][1] = pack8(sacc[2][nt], sacc[3][nt]);
    }
#pragma unroll
    for (int dt = 0; dt < 4; ++dt)
#pragma unroll
      for (int s2 = 0; s2 < 2; ++s2) {
        bf16x8 va = ldperm(sVt + (dt * 16 + lq) * 72 + s2 * 32 + quad * 4);
        oacc[dt][0] = MFMA16(va, pf[0][s2], oacc[dt][0]);
        oacc[dt][1] = MFMA16(va, pf[1][s2], oacc[dt][1]);
      }
  }
  u16* BR = (u16*)(p->ws + WS_BRANCH);
#pragma unroll
  for (int nt = 0; nt < 2; ++nt) {
    float lt = lsum[nt]; lt += __shfl_xor(lt, 16, 64); lt += __shfl_xor(lt, 32, 64);
    const float inv = 1.f / lt;
    const size_t row = seqrow0 + q0 + wave * 32 + nt * 16 + lq;
#pragma unroll
    for (int dt = 0; dt < 4; ++dt)
      *(uint2*)(BR + row * 1024 + ocol + dt * 16 + quad * 4) = make_uint2(pack2(oacc[dt][nt][0] * inv, oacc[dt][nt][1] * inv), pack2(oacc[dt][nt][2] * inv, oacc[dt][nt][3] * inv));
  }
  __syncthreads();
}

template <bool FINAL>
DI void lru_item(KP p, int l, int ci, unsigned char* smem) {
  float* sx = (float*)smem;
  u16* shf = (u16*)(smem + 32768);
  const int ch = threadIdx.x;
  const int r0 = ci * 32;
  const bool lat = r0 >= 8192;
  int b, T, seqrow0;
  if (!lat) { b = r0 >> 8; T = 256; seqrow0 = b * 256; } else { b = (r0 - 8192) >> 12; T = 4096; seqrow0 = 8192 + b * 4096; }
  const int t0 = r0 - seqrow0;
  const u16* INP = (const u16*)(p->ws + WS_INPROJ);
  {
    const float* cw = p->in[18] + l * 4 * 256;
    const float w0 = cw[ch], w1 = cw[256 + ch], w2 = cw[512 + ch], w3 = cw[768 + ch], cb = p->in[19][l * 256 + ch];
    auto ld = [&](int t) -> float { return (t >= 0 && t < T) ? bf2f(INP[(size_t)(seqrow0 + t) * LDI + C_LX + ch]) : 0.f; };
    float xm2 = ld(t0 - 2), xm1 = ld(t0 - 1), x0 = ld(t0);
    for (int t = 0; t < 32; ++t) {
      float xp1 = ld(t0 + t + 1);
      sx[t * 256 + ch] = xm2 * w0 + xm1 * w1 + x0 * w2 + xp1 * w3 + cb;
      xm2 = xm1; xm1 = x0; x0 = xp1;
    }
  }
  __syncthreads();
  const int n = ch >> 6, d = ch & 63;
  const int nch = T / 32, c = t0 / 32;
  float* LC = (float*)(p->ws + WS_LRUC);
  for (int dir = 0; dir < 2; ++dir) {
    float wr[64], wi[64];
    const float* WR = p->in[20] + ((size_t)((l * 2 + dir) * 4 + n) * 64) * 64 + d;
    const float* WI = p->in[22] + ((size_t)((l * 2 + dir) * 4 + n) * 64) * 64 + d;
#pragma unroll
    for (int cc = 0; cc < 64; ++cc) { wr[cc] = WR[cc * 64]; wi[cc] = WI[cc * 64]; }
    const float br = p->in[21][(l * 2 + dir) * 256 + ch], bi = p->in[23][(l * 2 + dir) * 256 + ch];
    const float sp = softplusf_(-p->in[24][(l * 2 + dir) * 256 + ch]);
    float h = 0.f, aprod = 1.f;
    if (FINAL) {
      h = lat ? p->in[7][((b * 2 + l) * 2 + dir) * 256 + ch] : 0.f;
      if (dir == 0) { for (int cc = 0; cc < c; ++cc) { const float* C = LC + ((size_t)((ci - c + cc) * 2 + dir) * 2) * 256; h = C[ch] * h + C[256 + ch]; } }
      else { for (int cc = nch - 1; cc > c; --cc) { const float* C = LC + ((size_t)((ci - c + cc) * 2 + dir) * 2) * 256; h = C[ch] * h + C[256 + ch]; } }
    }
    for (int st = 0; st < 32; ++st) {
      const int t = dir == 0 ? st : 31 - st;
      const float4* xr = (const float4*)(sx + t * 256 + n * 64);
      float ra = br, ia = bi;
#pragma unroll
      for (int q = 0; q < 16; ++q) {
        float4 xv = xr[q];
        ra += xv.x * wr[4 * q] + xv.y * wr[4 * q + 1] + xv.z * wr[4 * q + 2] + xv.w * wr[4 * q + 3];
        ia += xv.x * wi[4 * q] + xv.y * wi[4 * q + 1] + xv.z * wi[4 * q + 2] + xv.w * wi[4 * q + 3];
        if ((q & 3) == 3) asm volatile("" ::: "memory");
      }
      const float xt = sx[t * 256 + ch];
      const float la = -8.f * sigm(ra) * sp;
      const float a = __expf(la);
      const float bb = sqrtf(-expm1f(2.f * la)) * sigm(ia) * xt;
      h = a * h + bb; aprod *= a;
      if (FINAL) {
        if (dir == 0) shf[t * 256 + ch] = f2bf(h);
        else {
          float hf = bf2f(shf[t * 256 + ch]);
          float g = bf2f(INP[(size_t)(r0 + t) * LDI + C_LG + ch]);
          ((u16*)(p->ws + WS_BRANCH))[(size_t)(r0 + t) * 1024 + 256 + ch] = f2bf((hf + h) * gelu_tanh(g));
        }
      }
    }
    if (!FINAL) { float* C = LC + ((size_t)(ci * 2 + dir) * 2) * 256; C[ch] = aprod; C[256 + ch] = h; }
    else if (!lat) {
      if (dir == 0 && c == nch - 1) p->out[O_LRU + ((size_t)(b * 2 + l) * 2 + 0) * 256 + ch] = h;
      if (dir == 1 && c == 0) p->out[O_LRU + ((size_t)(b * 2 + l) * 2 + 1) * 256 + ch] = h;
    }
  }
  __syncthreads();
}

template <int DIR, bool ISW>
DI void gdn_solve(const float* L, const u16* src, const float* sb_, const float* se_, u16* UW) {
  float sol[64];
#pragma unroll
  for (int i = 0; i < 64; ++i) {
    float s = bf2f(src[(DIR == 0 ? i : 63 - i) * 72]) * sb_[i];
    if (ISW) s *= se_[i];
#pragma unroll
    for (int j4 = 0; j4 < (i + 3) / 4; ++j4) {
      float4 lv = *(const float4*)(L + i * 64 + j4 * 4);
      if (j4 * 4 + 0 < i) s -= lv.x * sol[j4 * 4 + 0];
      if (j4 * 4 + 1 < i) s -= lv.y * sol[j4 * 4 + 1];
      if (j4 * 4 + 2 < i) s -= lv.z * sol[j4 * 4 + 2];
      if (j4 * 4 + 3 < i) s -= lv.w * sol[j4 * 4 + 3];
      if ((j4 & 3) == 3) asm volatile("" ::: "memory");
    }
    sol[i] = s;
    UW[i * 128] = f2bf(s);
    asm volatile("" ::: "memory");
  }
}

DI void gdn1_item(KP p, int l, int item, unsigned char* smem) {
  const int cgi = item >> 2, hd = item & 3;
  u16* sq = (u16*)smem; u16* sk = sq + 64 * 72; u16* sv = sk + 64 * 72;
  float* sL = (float*)(smem + 27648);
  float* sgc = (float*)(smem + 60416);
  float* sbeta = sgc + 128;
  float* sge = sbeta + 128;
  const int tid = threadIdx.x, lane = tid & 63, wave = tid >> 6, lq = lane & 15, quad = lane >> 4;
  const int r0 = cgi * 64;
  const bool lat = r0 >= 8192;
  int T, seqrow0;
  if (!lat) { T = 256; seqrow0 = (r0 >> 8) * 256; } else { T = 4096; seqrow0 = 8192 + ((r0 - 8192) >> 12) * 4096; }
  const int t0 = r0 - seqrow0;
  const u16* INP = (const u16*)(p->ws + WS_INPROJ);
  u16* QHAT = (u16*)(p->ws + WS_QHAT) + (size_t)item * 4096;
  {
    const int d = lane, tb = wave * 16;
#pragma unroll
    for (int mat = 0; mat < 3; ++mat) {
      const int col = C_GQ + mat * 256 + hd * 64 + d, wc = mat * 256 + hd * 64 + d;
      const float* cw = p->in[25] + (size_t)l * 4 * 768;
      const float w0 = cw[wc], w1 = cw[768 + wc], w2 = cw[1536 + wc], w3 = cw[2304 + wc];
      auto ld = [&](int t) -> float { return (t >= 0 && t < T) ? bf2f(INP[(size_t)(seqrow0 + t) * LDI + col]) : 0.f; };
      float xm2 = ld(t0 + tb - 2), xm1 = ld(t0 + tb - 1), x0 = ld(t0 + tb);
      u16* dst = mat == 0 ? sq : (mat == 1 ? sk : sv);
      for (int t = tb; t < tb + 16; ++t) {
        float xp1 = ld(t0 + t + 1);
        float v = siluf_(xm2 * w0 + xm1 * w1 + x0 * w2 + xp1 * w3);
        xm2 = xm1; xm1 = x0; x0 = xp1;
        if (mat < 2) { float ss = wave_sum(v * v); v *= rsqrtf(ss + 1e-6f) * (mat == 0 ? 0.125f : 1.f); }
        u16 hb = f2bf(v);
        dst[t * 72 + d] = hb;
        if (mat == 0) QHAT[t * 64 + d] = hb;
      }
    }
  }
  if (tid < 128) {
    const int dir = tid >> 6, c = tid & 63;
    const int tok = dir == 0 ? c : 63 - c;
    const u16* R = INP + (size_t)(r0 + tok) * LDI;
    const float ga = bf2f(R[C_GA + dir * 4 + hd]), gb = bf2f(R[C_GB + dir * 4 + hd]);
    const float g = -__expf(p->in[26][(l * 2 + dir) * 4 + hd]) * softplusf_(ga + p->in[27][(l * 2 + dir) * 4 + hd]);
    float gc = g;
#pragma unroll
    for (int o = 1; o < 64; o <<= 1) { float tt = __shfl_up(gc, o, 64); if (lane >= o) gc += tt; }
    const float glast = __shfl(gc, 63, 64);
    sgc[dir * 64 + c] = gc; sbeta[dir * 64 + c] = sigm(gb); sge[dir * 64 + c] = __expf(gc);
    float* gv = (float*)(p->ws + WS_GVEC) + (size_t)(item * 2 + dir) * 256;
    gv[c] = __expf(gc); gv[64 + c] = __expf(glast - gc); if (c == 0) gv[128] = __expf(glast);
  }
  __syncthreads();
  {
    const int dk = tid >> 2, c0 = (tid & 3) * 16;
    unsigned w[8];
#pragma unroll
    for (int e = 0; e < 8; ++e) w[e] = (unsigned)sk[(c0 + 2 * e) * 72 + dk] | ((unsigned)sk[(c0 + 2 * e + 1) * 72 + dk] << 16);
    u16* KT = (u16*)(p->ws + WS_KT) + (size_t)item * 4096 + dk * 64 + c0;
    *(u32x4*)KT = mku4(w[0], w[1], w[2], w[3]); *(u32x4*)(KT + 8) = mku4(w[4], w[5], w[6], w[7]);
  }
  {
    const int i0 = wave * 16;
    f32x4 akk[4], aqk[4];
#pragma unroll
    for (int nt = 0; nt < 4; ++nt) { akk[nt] = f32x4{0.f, 0.f, 0.f, 0.f}; aqk[nt] = f32x4{0.f, 0.f, 0.f, 0.f}; }
#pragma unroll
    for (int s = 0; s < 2; ++s) {
      bf16x8 ak = ld8(sk + (i0 + lq) * 72 + s * 32 + quad * 8), aq = ld8(sq + (i0 + lq) * 72 + s * 32 + quad * 8);
#pragma unroll
      for (int nt = 0; nt < 4; ++nt) { bf16x8 bk = ld8(sk + (nt * 16 + lq) * 72 + s * 32 + quad * 8); akk[nt] = MFMA16(ak, bk, akk[nt]); aqk[nt] = MFMA16(aq, bk, aqk[nt]); }
    }
    u16* QKf = (u16*)(p->ws + WS_QK) + (size_t)(item * 2 + 0) * 4096;
    u16* QKb = (u16*)(p->ws + WS_QK) + (size_t)(item * 2 + 1) * 4096;
#pragma unroll
    for (int nt = 0; nt < 4; ++nt)
#pragma unroll
      for (int r = 0; r < 4; ++r) {
        const int i = i0 + quad * 4 + r, j = nt * 16 + lq, ib = 63 - i, jb = 63 - j;
        const float kkv = akk[nt][r], qkv = aqk[nt][r];
        if (j < i) sL[i * 64 + j] = sbeta[i] * kkv * __expf(sgc[i] - sgc[j]);
        if (j > i) sL[4096 + ib * 64 + jb] = sbeta[64 + ib] * kkv * __expf(sgc[64 + ib] - sgc[64 + jb]);
        QKf[i * 64 + j] = f2bf(j <= i ? qkv * __expf(sgc[i] - sgc[j]) : 0.f);
        QKb[ib * 64 + jb] = f2bf(j >= i ? qkv * __expf(sgc[64 + ib] - sgc[64 + jb]) : 0.f);
      }
  }
  __syncthreads();
  {
    const int col = tid & 127;
    u16* UW = (u16*)(p->ws + WS_UW) + (size_t)(item * 2 + (tid >> 7)) * 8192 + col;
    if (tid < 128) { if (col < 64) gdn_solve<0, false>(sL, sv + col, sbeta, sge, UW); else gdn_solve<0, true>(sL, sk + (col - 64), sbeta, sge, UW); }
    else { if (col < 64) gdn_solve<1, false>(sL + 4096, sv + col, sbeta + 64, sge + 64, UW); else gdn_solve<1, true>(sL + 4096, sk + (col - 64), sbeta + 64, sge + 64, UW); }
  }
  __syncthreads();
}

DI void gdn2_item(KP p, int l, int item, unsigned char* smem) {
  u16* sW = (u16*)smem; u16* sQ = sW + 64 * 72; u16* sQK = sQ + 64 * 72; u16* sKT = sQK + 64 * 72; u16* sU = sKT + 64 * 72;
  float* sg = (float*)(smem + 46080);
  const int tid = threadIdx.x, lane = tid & 63, wave = tid >> 6, lq = lane & 15, quad = lane >> 4;
  int b, hd, dir; bool lat;
  if (item < 16) { lat = true; b = item >> 3; hd = (item >> 1) & 3; dir = item & 1; }
  else { lat = false; int r = item - 16; b = r >> 3; hd = (r >> 1) & 3; dir = r & 1; }
  const int nch = lat ? 64 : 4, cg0 = lat ? 128 + b * 64 : b * 4;
  f32x4 st[4];
#pragma unroll
  for (int kt = 0; kt < 4; ++kt)
#pragma unroll
    for (int r = 0; r < 4; ++r)
      st[kt][r] = lat ? p->in[8][((size_t)(((b * 2 + l) * 2 + dir) * 4 + hd) * 64 + kt * 16 + quad * 4 + r) * 64 + wave * 16 + lq] : 0.f;
  const int lrow = tid >> 2, seg = (tid & 3) * 16;
  u32x4 rW[2], rQ[2], rQK[2], rKT[2], rU[2]; float rg = 0.f;
  const u16* UWb = (const u16*)(p->ws + WS_UW); const u16* QHb = (const u16*)(p->ws + WS_QHAT);
  const u16* KTb = (const u16*)(p->ws + WS_KT); u16* QKb = (u16*)(p->ws + WS_QK);
  const float* GV = (const float*)(p->ws + WS_GVEC);
  auto gload = [&](int n) {
    const int cgi = dir == 0 ? cg0 + n : cg0 + nch - 1 - n;
    const size_t prob = (size_t)cgi * 4 + hd, pd = prob * 2 + dir;
    const u16* u = UWb + (pd * 64 + lrow) * 128 + seg;
    rU[0] = *(const u32x4*)u; rU[1] = *(const u32x4*)(u + 8); rW[0] = *(const u32x4*)(u + 64); rW[1] = *(const u32x4*)(u + 72);
    const u16* q = QHb + (prob * 64 + (dir ? 63 - lrow : lrow)) * 64 + seg;
    rQ[0] = *(const u32x4*)q; rQ[1] = *(const u32x4*)(q + 8);
    const u16* qk = QKb + (pd * 64 + lrow) * 64 + seg;
    rQK[0] = *(const u32x4*)qk; rQK[1] = *(const u32x4*)(qk + 8);
    const u16* kt = KTb + (prob * 64 + lrow) * 64 + (dir ? 48 - seg : seg);
    u32x4 a = *(const u32x4*)kt, bb = *(const u32x4*)(kt + 8);
    if (dir) { rKT[0] = rev8(bb); rKT[1] = rev8(a); } else { rKT[0] = a; rKT[1] = bb; }
    rg = GV[pd * 256 + (tid & 255)];
  };
  gload(0);
  for (int n = 0; n < nch; ++n) {
    const int cgi = dir == 0 ? cg0 + n : cg0 + nch - 1 - n;
    const size_t pd = ((size_t)cgi * 4 + hd) * 2 + dir;
    __syncthreads();
    *(u32x4*)(sW + lrow * 72 + seg) = rW[0]; *(u32x4*)(sW + lrow * 72 + seg + 8) = rW[1];
    *(u32x4*)(sQ + lrow * 72 + seg) = rQ[0]; *(u32x4*)(sQ + lrow * 72 + seg + 8) = rQ[1];
    *(u32x4*)(sQK + lrow * 72 + seg) = rQK[0]; *(u32x4*)(sQK + lrow * 72 + seg + 8) = rQK[1];
    *(u32x4*)(sKT + lrow * 72 + seg) = rKT[0]; *(u32x4*)(sKT + lrow * 72 + seg + 8) = rKT[1];
    *(u32x4*)(sU + lrow * 72 + seg) = rU[0]; *(u32x4*)(sU + lrow * 72 + seg + 8) = rU[1];
    sg[tid] = rg;
    __syncthreads();
    if (n + 1 < nch) gload(n + 1);
    const float elast = sg[128];
    bf16x8 sB[2] = {pack8(st[0], st[1]), pack8(st[2], st[3])};
    f32x4 vn[4], oo[4];
#pragma unroll
    for (int mt = 0; mt < 4; ++mt) {
      f32x4 acc = {0.f, 0.f, 0.f, 0.f}, acq = {0.f, 0.f, 0.f, 0.f};
#pragma unroll
      for (int s2 = 0; s2 < 2; ++s2) {
        acc = MFMA16(ldperm(sW + (mt * 16 + lq) * 72 + s2 * 32 + quad * 4), sB[s2], acc);
        acq = MFMA16(ldperm(sQ + (mt * 16 + lq) * 72 + s2 * 32 + quad * 4), sB[s2], acq);
      }
#pragma unroll
      for (int r = 0; r < 4; ++r) {
        const int c = mt * 16 + quad * 4 + r;
        vn[mt][r] = bf2f(sU[c * 72 + wave * 16 + lq]) - acc[r];
        oo[mt][r] = acq[r] * sg[c];
      }
    }
    bf16x8 vB[2] = {pack8(vn[0], vn[1]), pack8(vn[2], vn[3])};
#pragma unroll
    for (int mt = 0; mt < 4; ++mt) {
#pragma unroll
      for (int s2 = 0; s2 < 2; ++s2) oo[mt] = MFMA16(ldperm(sQK + (mt * 16 + lq) * 72 + s2 * 32 + quad * 4), vB[s2], oo[mt]);
    }
    f32x4 vs[4];
#pragma unroll
    for (int mt = 0; mt < 4; ++mt)
#pragma unroll
      for (int r = 0; r < 4; ++r) vs[mt][r] = vn[mt][r] * sg[64 + mt * 16 + quad * 4 + r];
    bf16x8 vsB[2] = {pack8(vs[0], vs[1]), pack8(vs[2], vs[3])};
#pragma unroll
    for (int kt = 0; kt < 4; ++kt) {
      f32x4 acc = {0.f, 0.f, 0.f, 0.f};
#pragma unroll
      for (int s2 = 0; s2 < 2; ++s2) acc = MFMA16(ldperm(sKT + (kt * 16 + lq) * 72 + s2 * 32 + quad * 4), vsB[s2], acc);
#pragma unroll
      for (int r = 0; r < 4; ++r) st[kt][r] = elast * st[kt][r] + acc[r];
    }
    u16* O = QKb + pd * 4096;
#pragma unroll
    for (int mt = 0; mt < 4; ++mt)
#pragma unroll
      for (int r = 0; r < 4; ++r) O[(mt * 16 + quad * 4 + r) * 64 + wave * 16 + lq] = f2bf(oo[mt][r]);
  }
  if (!lat) {
#pragma unroll
    for (int kt = 0; kt < 4; ++kt)
#pragma unroll
      for (int r = 0; r < 4; ++r)
        p->out[O_GDN + ((size_t)(((b * 2 + l) * 2 + dir) * 4 + hd) * 64 + kt * 16 + quad * 4 + r) * 64 + wave * 16 + lq] = st[kt][r];
  }
  __syncthreads();
}

DI void gdnfin_item(KP p, int l, int item) {
  const int cgi = item >> 2, hd = item & 3;
  const int lane = threadIdx.x & 63, wave = threadIdx.x >> 6;
  const u16* Of = (const u16*)(p->ws + WS_QK) + (size_t)(item * 2 + 0) * 4096;
  const u16* Ob = (const u16*)(p->ws + WS_QK) + (size_t)(item * 2 + 1) * 4096;
  const float gn = p->in[28][l * 64 + lane];
  for (int c = wave * 16; c < wave * 16 + 16; ++c) {
    const size_t row = (size_t)cgi * 64 + c;
    float o = bf2f(Of[c * 64 + lane]) + bf2f(Ob[(63 - c) * 64 + lane]);
    float ss = wave_sum(o * o);
    float z = bf2f(((const u16*)(p->ws + WS_INPROJ))[row * LDI + C_GZ + hd * 64 + lane]);
    float y = o * rsqrtf(ss * (1.f / 64.f) + 1e-6f) * gn * siluf_(z);
    ((u16*)(p->ws + WS_BRANCH))[row * 1024 + 512 + hd * 64 + lane] = f2bf(y);
  }
}

constexpr int NPHASE = 21;
__global__ void __launch_bounds__(256, 1) mk(Params p_unused, int ph_lo, int ph_hi) {
  __shared__ __attribute__((aligned(16))) unsigned char smem[SMEM_BYTES];
  __shared__ int s_item;
  const int G = gridDim.x, B = blockIdx.x;
  for (int ph = ph_lo; ph < ph_hi; ++ph) {
    KP p = (KP)__builtin_amdgcn_kernarg_segment_ptr();
    asm volatile("" : "+s"(p));
    if (ph == 0) {
      if (B == 0 && threadIdx.x < 64) ((int*)(p->ws + WS_CTR))[threadIdx.x] = 0;
      for (int it = B; it < 192 + CONV_ITEMS; it += G) { if (it < 192) { if (PHON(0)) mod_item(p, it, smem); } else if (PHON(1)) convert_item(p, 0, it - 192, smem); }
    } else {
      const int l = (ph - 1) / 10, sub = (ph - 1) % 10;
      switch (sub) {
        case 0:
          for (int it = B; it < 4096 + (l ? CONV_ITEMS : 0); it += G) { if (it < 4096) { if (PHON(2)) norm_item<0>(p, l, it); } else if (PHON(1)) convert_item(p, l, it - 4096, smem); }
          break;
        case 1: for (int it = B; it < 128 * 21; it += G) if (PHON(3)) inproj_item(p, it, smem); break;
        case 2:
          for (int it = B; it < 1024 + 512 + 64 + 4096; it += G) {
            if (it < 1024) { if (PHON(4)) gdn1_item(p, l, it, smem); }
            else if (it < 1536) { if (PHON(5)) lru_item<false>(p, l, it - 1024, smem); }
            else if (it < 1600) { if (PHON(6)) kvc_item(p, l, it - 1536); }
            else if (PHON(6)) prep_item(p, l, it - 1600);
          }
          break;
        case 3: {
          int* ctr = (int*)(p->ws + WS_CTR) + l;
          for (;;) {
            __syncthreads();
            if (threadIdx.x == 0) s_item = atomicAdd(ctr, 1);
            __syncthreads();
            const int it = s_item;
            if (it >= 16 + 256 + 256 + 256 + 512 + 512) break;
            if (it < 16) { if (PHON(7)) gdn2_item(p, l, it, smem); }
            else if (it < 272) { if (PHON(8)) attn_item(p, l, it - 16, smem); }
            else if (it < 528) { if (PHON(7)) gdn2_item(p, l, it - 272 + 16, smem); }
            else if (it < 784) { if (PHON(8)) attn_item(p, l, it - 528 + 256, smem); }
            else if (it < 1296) { if (PHON(9)) lru_item<true>(p, l, it - 784, smem); }
            else if (PHON(8)) attn_item(p, l, it - 1296 + 512, smem);
          }
        } break;
        case 4: for (int it = B; it < 1024; it += G) if (PHON(10)) gdnfin_item(p, l, it); break;
        case 5: for (int it = B; it < 128 * 16; it += G) if (PHON(11)) merge_item(p, l, it, smem); break;
        case 6: for (int it = B; it < 128 * 8; it += G) if (PHON(12)) wout_item(p, l, it, smem); break;
        case 7: for (int it = B; it < 4096; it += G) if (PHON(2)) norm_item<1>(p, l, it); break;
        case 8: for (int it = B; it < 128 * 32; it += G) if (PHON(13)) w1_item(p, it, smem); break;
        case 9: for (int it = B; it < 128 * 8; it += G) if (PHON(14)) w2_item(p, l, it, smem); break;
      }
    }
    if (ph + 1 < ph_hi) cg::this_grid().sync();
  }
}

extern "C" void kernel_launch(void* const* d_in, const int* in_sizes, int n_in, void* d_out, int out_size, void* d_ws, size_t ws_size, hipStream_t stream) {
  static int grid_blocks = 0;
  if (!grid_blocks) {
    int dev = 0, cus = 0, per_cu = 0;
    hipGetDevice(&dev);
    hipDeviceGetAttribute(&cus, hipDeviceAttributeMultiprocessorCount, dev);
    hipOccupancyMaxActiveBlocksPerMultiprocessor(&per_cu, mk, 256, 0);
    if (per_cu < 1) per_cu = 1;
    if (per_cu > 2) per_cu = 2;
    grid_blocks = cus * per_cu;
    if (ws_size < WS_END) fprintf(stderr, "kernel_launch: workspace too small: %zu < %zu\n", ws_size, (size_t)WS_END);
  }
  Params p{};
  for (int i = 0; i < 37; ++i) p.in[i] = (const float*)d_in[i];
  p.out = (float*)d_out; p.ws = (unsigned char*)d_ws;
#if MULTI_LAUNCH
  for (int ph = 0; ph < NPHASE; ++ph) hipLaunchKernelGGL(mk, dim3(grid_blocks), dim3(256), 0, stream, p, ph, ph + 1);
#else
  int lo = 0, hi = NPHASE;
  void* args[] = {&p, &lo, &hi};
  hipError_t e = hipLaunchCooperativeKernel((void*)mk, dim3(grid_blocks), dim3(256), args, 0, stream);
  if (e != hipSuccess) fprintf(stderr, "cooperative launch failed: %s (grid %d)\n", hipGetErrorString(e), grid_blocks);
#endif
}
```

```cpp
#include <hip/hip_runtime.h>
#include <hip/hip_cooperative_groups.h>
#include <cstdio>
namespace cg = cooperative_groups;

#ifndef MULTI_LAUNCH
#define MULTI_LAUNCH 0
#endif
#ifndef PHM
#define PHM 0xFFFFFFFFu
#endif
#define PHON(b) ((PHM >> (b)) & 1u)

typedef unsigned short u16;
using bf16x8 = __attribute__((ext_vector_type(8))) short;
using f32x4 = __attribute__((ext_vector_type(4))) float;
using u32x4 = __attribute__((ext_vector_type(4))) unsigned;
#define DI __device__ __forceinline__
#define MFMA16(a, b, c) __builtin_amdgcn_mfma_f32_16x16x32_bf16((a), (b), (c), 0, 0, 0)

constexpr int NTOK = 16384;
constexpr int DM = 1024;
constexpr int LDI = 2592;
constexpr int C_AQ = 0, C_AK = 256, C_AV = 384, C_LX = 512, C_LG = 768, C_GQ = 1024, C_GK = 1280, C_GV = 1536, C_GZ = 1792,
              C_DQ = 2048, C_DK = 2304, C_DV = 2432, C_GA = 2560, C_GB = 2568;
constexpr int NIN_PAD = 2688;

constexpr size_t WS_MOD = 0;
constexpr size_t WS_CTR = WS_MOD + 2 * 3 * 6144 * 4;
constexpr size_t WS_BAR = WS_CTR + 256;
constexpr size_t WS_LRUC = WS_BAR + 3456 * 4 + 256;
constexpr size_t WS_KC = WS_LRUC + (size_t)512 * 2 * 2 * 256 * 4;
constexpr size_t WS_GVEC = WS_KC + (size_t)16 * 512 * 64 * 2;
constexpr size_t WS_WIN = WS_GVEC + (size_t)1024 * 2 * 256 * 4;
constexpr size_t WS_WM = WS_WIN + (size_t)NIN_PAD * 1024 * 2;
constexpr size_t WS_WB = WS_WM + (size_t)4096 * 1024 * 2;
constexpr size_t WS_WO = WS_WB + (size_t)4 * 1024 * 256 * 2;
constexpr size_t WS_W1 = WS_WO + (size_t)1024 * 1024 * 2;
constexpr size_t WS_W2 = WS_W1 + (size_t)4096 * 1024 * 2;
constexpr size_t WS_H = WS_W2 + (size_t)1024 * 4096 * 2;
constexpr size_t WS_BIG = WS_H + (size_t)NTOK * 1024 * 2;
constexpr size_t WS_INPROJ = WS_BIG;
constexpr size_t WS_BRANCH = WS_INPROJ + (size_t)NTOK * LDI * 2;
constexpr size_t WS_QHAT = WS_BRANCH + (size_t)NTOK * 1024 * 2;
constexpr size_t WS_KT = WS_QHAT + (size_t)1024 * 4096 * 2;
constexpr size_t WS_UW = WS_KT + (size_t)1024 * 4096 * 2;
constexpr size_t WS_QK = WS_UW + (size_t)1024 * 2 * 8192 * 2;
constexpr size_t WS_END = WS_QK + (size_t)1024 * 2 * 4096 * 2;
constexpr size_t WS_HIDDEN = WS_BIG;
constexpr size_t WS_MERGED = WS_BIG;
static_assert(WS_HIDDEN + (size_t)NTOK * 4096 * 2 <= WS_END, "hidden must fit");
static_assert(WS_END <= (size_t)256 * 1024 * 1024, "workspace budget");

constexpr size_t O_X = 0, O_AK = 16777216, O_AV = 18874368, O_DK = 20971520, O_DV = 23068672, O_LRU = 25165824, O_GDN = 25198592;

struct Params {
  const float* in[37];
  float* out;
  unsigned char* ws;
};

typedef const Params __attribute__((address_space(4)))* KP;
constexpr int SMEM_BYTES = 61952;

DI int ltid() { int t = threadIdx.x; asm volatile("" : "+v"(t)); return t; }
DI u16 f2bf(float x) { unsigned u = __float_as_uint(x); u += 0x7fffu + ((u >> 16) & 1u); return (u16)(u >> 16); }
DI float bf2f(u16 h) { return __uint_as_float(((unsigned)h) << 16); }
DI unsigned pack2(float a, float b) { return (unsigned)f2bf(a) | ((unsigned)f2bf(b) << 16); }
DI float bflo(unsigned u) { return __uint_as_float(u << 16); }
DI float bfhi(unsigned u) { return __uint_as_float(u & 0xffff0000u); }
DI float sigm(float x) { return 1.f / (1.f + __expf(-x)); }
DI float siluf_(float x) { return x / (1.f + __expf(-x)); }
DI float softplusf_(float x) { return x > 20.f ? x : log1pf(__expf(x)); }
DI float gelu_tanh(float x) { float u = 0.7978845608028654f * (x + 0.044715f * x * x * x); float t = 1.f - 2.f / (__expf(2.f * u) + 1.f); return 0.5f * x * (1.f + t); }
DI float wave_sum(float v) {
#pragma unroll
  for (int o = 32; o > 0; o >>= 1) v += __shfl_xor(v, o, 64);
  return v;
}
DI u32x4 mku4(unsigned a, unsigned b, unsigned c, unsigned d) { u32x4 v = {a, b, c, d}; return v; }
DI bf16x8 mk8(unsigned a, unsigned b, unsigned c, unsigned d) { u32x4 v = {a, b, c, d}; return __builtin_bit_cast(bf16x8, v); }
DI bf16x8 pack8(const f32x4& x, const f32x4& y) { return mk8(pack2(x[0], x[1]), pack2(x[2], x[3]), pack2(y[0], y[1]), pack2(y[2], y[3])); }
DI bf16x8 ld8(const u16* p) { return *(const bf16x8*)p; }
DI bf16x8 ldperm(const u16* p) { uint2 a = *(const uint2*)p; uint2 b = *(const uint2*)(p + 16); return mk8(a.x, a.y, b.x, b.y); }
DI int mod_group(int row) { return row < 8192 ? 0 : 1 + ((row - 8192) >> 12); }
DI const float* x_in_row(KP p, int l, int row) {
  if (l == 0) return row < 8192 ? p->in[0] + (size_t)row * DM : p->in[1] + (size_t)(row - 8192) * DM;
  return p->out + (size_t)row * DM;
}
DI unsigned swap16(unsigned u) { return (u >> 16) | (u << 16); }
DI u32x4 rev8(u32x4 v) { return mku4(swap16(v.w), swap16(v.z), swap16(v.y), swap16(v.x)); }

DI void mod_item(KP p, int item, unsigned char* smem) {
  float* sc = (float*)smem;
  float* sr = sc + 3072;
  const int tid = ltid();
  const int l = item / 96, cb = item % 96;
  for (int i = tid; i < 3072; i += 256) {
    int g = i >> 10, k = i & 1023;
    float c = g == 0 ? p->in[9][k] : p->in[2][(g - 1) * 1024 + k];
    sc[i] = siluf_(c);
  }
  __syncthreads();
  const int col = cb * 64 + (tid & 63), kg = tid >> 6;
  const float* W = p->in[10] + (size_t)l * 1024 * 6144;
  float a0 = 0.f, a1 = 0.f, a2 = 0.f;
  for (int k = kg * 256; k < kg * 256 + 256; ++k) {
    float w = W[(size_t)k * 6144 + col];
    a0 += sc[k] * w; a1 += sc[1024 + k] * w; a2 += sc[2048 + k] * w;
  }
  sr[(kg * 3 + 0) * 64 + (tid & 63)] = a0; sr[(kg * 3 + 1) * 64 + (tid & 63)] = a1; sr[(kg * 3 + 2) * 64 + (tid & 63)] = a2;
  __syncthreads();
  if (tid < 192) {
    int g = tid >> 6, cc = tid & 63;
    float s = p->in[11][l * 6144 + cb * 64 + cc];
    for (int q = 0; q < 4; ++q) s += sr[(q * 3 + g) * 64 + cc];
    ((float*)(p->ws + WS_MOD))[(l * 3 + g) * 6144 + cb * 64 + cc] = s;
  }
  __syncthreads();
}

DI void conv_tile(const float* src, int N, int k0, int n0, u16* dst, int K, bool perm, unsigned char* smem) {
  float* tile = (float*)smem;
  const int tid = ltid();
#pragma unroll
  for (int i = 0; i < 4; ++i) {
    int kr = (tid >> 4) + 16 * i, nc = (tid & 15) * 4;
    float4 v = make_float4(0.f, 0.f, 0.f, 0.f);
    if (n0 + nc < N) v = *(const float4*)(src + (size_t)(k0 + kr) * N + n0 + nc);
    tile[kr * 65 + nc] = v.x; tile[kr * 65 + nc + 1] = v.y; tile[kr * 65 + nc + 2] = v.z; tile[kr * 65 + nc + 3] = v.w;
  }
  __syncthreads();
#pragma unroll
  for (int i = 0; i < 2; ++i) {
    int n = (tid >> 3) + 32 * i, k8 = (tid & 7) * 8;
    int ng = n0 + n;
    if (ng < N) {
      int row = ng;
      if (perm) row = ng < 2048 ? ng : (ng < 2064 ? 2560 + (ng - 2048) : ng - 16);
      u32x4 o;
      o.x = pack2(tile[(k8 + 0) * 65 + n], tile[(k8 + 1) * 65 + n]);
      o.y = pack2(tile[(k8 + 2) * 65 + n], tile[(k8 + 3) * 65 + n]);
      o.z = pack2(tile[(k8 + 4) * 65 + n], tile[(k8 + 5) * 65 + n]);
      o.w = pack2(tile[(k8 + 6) * 65 + n], tile[(k8 + 7) * 65 + n]);
      *(u32x4*)(dst + (size_t)row * K + k0 + k8) = o;
    }
  }
  __syncthreads();
}

constexpr int CONV_ITEMS = 4241;
DI void convert_item(KP p, int l, int item, unsigned char* smem) {
  unsigned char* ws = p->ws;
  if (item < 656) { int kt = item / 41, nt = item % 41; conv_tile(p->in[14] + (size_t)l * 1024 * 2576, 2576, kt * 64, nt * 64, (u16*)(ws + WS_WIN), 1024, true, smem); return; }
  item -= 656;
  if (item < 1024) { int kt = item >> 6, nt = item & 63; conv_tile(p->in[32] + (size_t)l * 1024 * 4096, 4096, kt * 64, nt * 64, (u16*)(ws + WS_WM), 1024, false, smem); return; }
  item -= 1024;
  if (item < 256) { int m = item >> 6, r = item & 63, kt = r >> 4, nt = r & 15;
    conv_tile(p->in[31] + ((size_t)l * 4 + m) * 256 * 1024, 1024, kt * 64, nt * 64, (u16*)(ws + WS_WB) + (size_t)m * 1024 * 256, 256, false, smem); return; }
  item -= 256;
  if (item < 256) { int kt = item >> 4, nt = item & 15; conv_tile(p->in[34] + (size_t)l * 1024 * 1024, 1024, kt * 64, nt * 64, (u16*)(ws + WS_WO), 1024, false, smem); return; }
  item -= 256;
  if (item < 1024) { int kt = item >> 6, nt = item & 63; conv_tile(p->in[35] + (size_t)l * 1024 * 4096, 4096, kt * 64, nt * 64, (u16*)(ws + WS_W1), 1024, false, smem); return; }
  item -= 1024;
  if (item < 1024) { int kt = item >> 4, nt = item & 15; conv_tile(p->in[36] + (size_t)l * 4096 * 1024, 1024, kt * 64, nt * 64, (u16*)(ws + WS_W2), 4096, false, smem); return; }
  u32x4* z = (u32x4*)((u16*)(ws + WS_WIN) + (size_t)2576 * 1024);
  for (int i = ltid(); i < 112 * 1024 / 8; i += 256) z[i] = mku4(0, 0, 0, 0);
}

template <int which>
DI void norm_item(KP p, int l, int item) {
  const int lane = ltid() & 63, wave = ltid() >> 6;
  const int row = item * 4 + wave;
  const float* x = x_in_row(p, which == 0 ? l : 2, row);
  const float* g = p->in[which == 0 ? 12 : 13] + l * 1024;
  const float* mod = (const float*)(p->ws + WS_MOD) + (l * 3 + mod_group(row)) * 6144;
  const float* sh = mod + (which == 0 ? 0 : 3072);
  const float* sc = mod + (which == 0 ? 1024 : 4096);
  f32x4 v[4]; float ss = 0.f;
#pragma unroll
  for (int i = 0; i < 4; ++i) { v[i] = *(const f32x4*)(x + i * 256 + lane * 4); ss += v[i].x * v[i].x + v[i].y * v[i].y + v[i].z * v[i].z + v[i].w * v[i].w; }
  ss = wave_sum(ss);
  const float rstd = rsqrtf(ss * (1.f / 1024.f) + 1e-6f);
  u16* H = (u16*)(p->ws + WS_H) + (size_t)row * 1024;
#pragma unroll
  for (int i = 0; i < 4; ++i) {
    int c = i * 256 + lane * 4;
    float4 gg = *(const float4*)(g + c), s1 = *(const float4*)(sc + c), s0 = *(const float4*)(sh + c);
    float y0 = v[i].x * rstd * gg.x * (1.f + s1.x) + s0.x, y1 = v[i].y * rstd * gg.y * (1.f + s1.y) + s0.y;
    float y2 = v[i].z * rstd * gg.z * (1.f + s1.z) + s0.z, y3 = v[i].w * rstd * gg.w * (1.f + s1.w) + s0.w;
    *(uint2*)(H + c) = make_uint2(pack2(y0, y1), pack2(y2, y3));
  }
}

template <int NT>
DI void gemm_acc(f32x4 (&acc)[4][NT], const u16* __restrict__ A, int lda, const u16* __restrict__ Bt, int ldb, int K, unsigned char* smem) {
  constexpr int BI = NT;
  u16* sA = (u16*)smem;
  u16* sB = sA + 128 * 72;
  const int tid = ltid(), lane = tid & 63, wave = tid >> 6, wm = wave >> 1, wn = wave & 1;
  const int lr = tid >> 3, lk = (tid & 7) * 8;
  const int lq = lane & 15, quad = lane >> 4;
  u32x4 ra[4], rb[BI];
#pragma unroll
  for (int i = 0; i < 4; ++i) ra[i] = *(const u32x4*)(A + (size_t)(lr + 32 * i) * lda + lk);
#pragma unroll
  for (int i = 0; i < BI; ++i) rb[i] = *(const u32x4*)(Bt + (size_t)(lr + 32 * i) * ldb + lk);
  for (int k0 = 0; k0 < K; k0 += 64) {
    __syncthreads();
#pragma unroll
    for (int i = 0; i < 4; ++i) *(u32x4*)(sA + (lr + 32 * i) * 72 + lk) = ra[i];
#pragma unroll
    for (int i = 0; i < BI; ++i) *(u32x4*)(sB + (lr + 32 * i) * 72 + lk) = rb[i];
    __syncthreads();
    if (k0 + 64 < K) {
#pragma unroll
      for (int i = 0; i < 4; ++i) ra[i] = *(const u32x4*)(A + (size_t)(lr + 32 * i) * lda + k0 + 64 + lk);
#pragma unroll
      for (int i = 0; i < BI; ++i) rb[i] = *(const u32x4*)(Bt + (size_t)(lr + 32 * i) * ldb + k0 + 64 + lk);
    }
#pragma unroll
    for (int s = 0; s < 2; ++s) {
      bf16x8 af[4], bfr[NT];
#pragma unroll
      for (int i = 0; i < 4; ++i) af[i] = ld8(sA + (wm * 64 + i * 16 + lq) * 72 + s * 32 + quad * 8);
#pragma unroll
      for (int j = 0; j < NT; ++j) bfr[j] = ld8(sB + (wn * NT * 16 + j * 16 + lq) * 72 + s * 32 + quad * 8);
#pragma unroll
      for (int i = 0; i < 4; ++i)
#pragma unroll
        for (int j = 0; j < NT; ++j) acc[i][j] = MFMA16(af[i], bfr[j], acc[i][j]);
    }
  }
}

template <int NT> DI void zero_acc(f32x4 (&acc)[4][NT]) {
#pragma unroll
  for (int i = 0; i < 4; ++i)
#pragma unroll
    for (int j = 0; j < NT; ++j) acc[i][j] = f32x4{0.f, 0.f, 0.f, 0.f};
}

#define EPI_LOOP(NT)                                                              \
  const int lane_ = ltid() & 63, wave_ = ltid() >> 6;                    \
  const int wm_ = wave_ >> 1, wn_ = wave_ & 1, lq_ = lane_ & 15, quad_ = lane_ >> 4; \
  _Pragma("unroll") for (int i = 0; i < 4; ++i)                                    \
  _Pragma("unroll") for (int j = 0; j < NT; ++j)                                   \
  _Pragma("unroll") for (int r = 0; r < 4; ++r)
#define EPI_ROW(m0) ((m0) + wm_ * 64 + i * 16 + quad_ * 4 + r)
#define EPI_COL(n0, NT) ((n0) + wn_ * (NT) * 16 + j * 16 + lq_)

DI void inproj_item(KP p, int item, unsigned char* smem) {
  const int mt = item / 21, nt = item % 21, m0 = mt * 128, n0 = nt * 128;
  f32x4 acc[4][4]; zero_acc<4>(acc);
  gemm_acc<4>(acc, (const u16*)(p->ws + WS_H) + (size_t)m0 * 1024, 1024, (const u16*)(p->ws + WS_WIN) + (size_t)n0 * 1024, 1024, 1024, smem);
  u16* C = (u16*)(p->ws + WS_INPROJ);
  EPI_LOOP(4) { int row = EPI_ROW(m0), col = EPI_COL(n0, 4); if (col < LDI) C[(size_t)row * LDI + col] = f2bf(acc[i][j][r]); }
}

DI void merge_item(KP p, int l, int item, unsigned char* smem) {
  const int mt = item >> 4, nt = item & 15, m0 = mt * 128, n0 = nt * 64;
  const u16* H = (const u16*)(p->ws + WS_H) + (size_t)m0 * 1024;
  const u16* BR = (const u16*)(p->ws + WS_BRANCH) + (size_t)m0 * 1024;
  const float* bm = p->in[33] + l * 4096;
  f32x4 accm[4][2]; zero_acc<2>(accm);
  for (int m = 0; m < 4; ++m) {
    f32x4 ag[4][2], ap[4][2]; zero_acc<2>(ag); zero_acc<2>(ap);
    gemm_acc<2>(ag, H, 1024, (const u16*)(p->ws + WS_WM) + (size_t)(m * 1024 + n0) * 1024, 1024, 1024, smem);
    gemm_acc<2>(ap, BR + m * 256, 1024, (const u16*)(p->ws + WS_WB) + (size_t)(m * 1024 + n0) * 256, 256, 256, smem);
    EPI_LOOP(2) { int col = EPI_COL(n0, 2); accm[i][j][r] += sigm(ag[i][j][r] + bm[m * 1024 + col]) * ap[i][j][r]; }
  }
  u16* C = (u16*)(p->ws + WS_MERGED);
  EPI_LOOP(2) { int row = EPI_ROW(m0), col = EPI_COL(n0, 2); C[(size_t)row * 1024 + col] = f2bf(accm[i][j][r]); }
}

DI void wout_item(KP p, int l, int item, unsigned char* smem) {
  const int mt = item >> 3, nt = item & 7, m0 = mt * 128, n0 = nt * 128;
  f32x4 acc[4][4]; zero_acc<4>(acc);
  gemm_acc<4>(acc, (const u16*)(p->ws + WS_MERGED) + (size_t)m0 * 1024, 1024, (const u16*)(p->ws + WS_WO) + (size_t)n0 * 1024, 1024, 1024, smem);
  const float* g1 = (const float*)(p->ws + WS_MOD) + (l * 3 + mod_group(m0)) * 6144 + 2048;
  EPI_LOOP(4) { int row = EPI_ROW(m0), col = EPI_COL(n0, 4); p->out[(size_t)row * DM + col] = x_in_row(p, l, row)[col] + g1[col] * acc[i][j][r]; }
}

DI void w1_item(KP p, int item, unsigned char* smem) {
  const int mt = item >> 5, nt = item & 31, m0 = mt * 128, n0 = nt * 128;
  f32x4 acc[4][4]; zero_acc<4>(acc);
  gemm_acc<4>(acc, (const u16*)(p->ws + WS_H) + (size_t)m0 * 1024, 1024, (const u16*)(p->ws + WS_W1) + (size_t)n0 * 1024, 1024, 1024, smem);
  u16* C = (u16*)(p->ws + WS_HIDDEN);
  EPI_LOOP(4) { int row = EPI_ROW(m0), col = EPI_COL(n0, 4); float v = fmaxf(acc[i][j][r], 0.f); C[(size_t)row * 4096 + col] = f2bf(v * v); }
}

DI void w2_item(KP p, int l, int item, unsigned char* smem) {
  const int mt = item >> 3, nt = item & 7, m0 = mt * 128, n0 = nt * 128;
  f32x4 acc[4][4]; zero_acc<4>(acc);
  gemm_acc<4>(acc, (const u16*)(p->ws + WS_HIDDEN) + (size_t)m0 * 4096, 4096, (const u16*)(p->ws + WS_W2) + (size_t)n0 * 4096, 4096, 4096, smem);
  const float* g2 = (const float*)(p->ws + WS_MOD) + (l * 3 + mod_group(m0)) * 6144 + 5120;
  EPI_LOOP(4) { int row = EPI_ROW(m0), col = EPI_COL(n0, 4); float* o = p->out + (size_t)row * DM + col; *o = *o + g2[col] * acc[i][j][r]; }
}

DI void prep_item(KP p, int l, int item) {
  const int lane = ltid() & 63, wave = ltid() >> 6;
  const int row = item * 4 + wave;
  const bool lat = row >= 8192;
  u16* R = (u16*)(p->ws + WS_INPROJ) + (size_t)row * LDI;
  float cs = 1.f, sn = 0.f;
  if (lat) {
    int t = (row - 8192) & 4095;
    int pos = (lane < 32) ? (t >> 6) : (t & 63);
    float inv = __expf(-(float)(lane & 15) * (9.210340371976184f / 16.f));
    float ang = (float)pos * inv;
    cs = __cosf(ang); sn = __sinf(ang);
  }
  const int b = row >> 8, t = row & 255;
#pragma unroll
  for (int hh = 0; hh < 12; ++hh) {
    int col; const float* g;
    if (hh < 4) { col = C_AQ + hh * 64; g = p->in[15] + l * 64; }
    else if (hh < 6) { col = C_AK + (hh - 4) * 64; g = p->in[16] + l * 64; }
    else if (hh < 10) { col = C_DQ + (hh - 6) * 64; g = p->in[29] + l * 64; }
    else { col = C_DK + (hh - 10) * 64; g = p->in[30] + l * 64; }
    float v = bf2f(R[col + lane]);
    float ss = wave_sum(v * v);
    float y = v * rsqrtf(ss * (1.f / 64.f) + 1e-6f) * g[lane];
    if (lat) {
      float yp = __shfl_xor(y, 16, 64);
      y = ((lane & 31) < 16) ? (y * cs - yp * sn) : (y * cs + yp * sn);
    } else {
      if (hh == 4 || hh == 5) p->out[O_AK + ((size_t)(b * 2 + l) * 256 + t) * 128 + (hh - 4) * 64 + lane] = y;
      if (hh >= 10) p->out[O_DK + ((size_t)(b * 2 + l) * 256 + t) * 128 + (hh - 10) * 64 + lane] = y;
    }
    R[col + lane] = f2bf(y);
  }
  if (!lat) {
    size_t o = ((size_t)(b * 2 + l) * 256 + t) * 128;
    p->out[O_AV + o + lane] = bf2f(R[C_AV + lane]); p->out[O_AV + o + 64 + lane] = bf2f(R[C_AV + 64 + lane]);
    p->out[O_DV + o + lane] = bf2f(R[C_DV + lane]); p->out[O_DV + o + 64 + lane] = bf2f(R[C_DV + 64 + lane]);
  }
}

DI void kvc_item(KP p, int l, int item) {
  u16* KC = (u16*)(p->ws + WS_KC);
#pragma unroll
  for (int it = 0; it < 8; ++it) {
    int idx4 = item * 2048 + it * 256 + ltid();
    int e = idx4 * 4;
    int d = e & 63, key = (e >> 6) & 511, sel = e >> 15;
    int kv = sel & 1, kvh = (sel >> 1) & 1, b = (sel >> 2) & 1, mixer = sel >> 3;
    const float* srcb = mixer ? (kv ? p->in[6] : p->in[5]) : (kv ? p->in[4] : p->in[3]);
    const float* src = srcb + ((size_t)((b * 2 + l) * 512 + key) * 2 + kvh) * 64 + d;
    float4 v = *(const float4*)src;
    *(uint2*)(KC + e) = make_uint2(pack2(v.x, v.y), pack2(v.z, v.w));
  }
}

DI void attn_item(KP p, int l, int it, unsigned char* smem) {
  u16* sK = (u16*)smem;
  u16* sVt = sK + 64 * 72;
  const int tid = ltid(), lane = tid & 63, wave = tid >> 6, lq = lane & 15, quad = lane >> 4;
  int kind, b, qh, qb;
  if (it < 512) { kind = it >> 8; int r = it & 255; b = r >> 7; qh = (r >> 5) & 3; qb = r & 31; }
  else { int r = it - 512; kind = 2 + (r >> 8); r &= 255; b = r >> 3; qh = (r >> 1) & 3; qb = r & 1; }
  const bool isD = (kind == 0 || kind == 3), lat = kind < 2;
  const int seqrow0 = lat ? 8192 + b * 4096 : b * 256;
  const int q0 = qb * 128, kvh = qh >> 1;
  const int qcol = (isD ? C_DQ : C_AQ) + qh * 64, kcol = (isD ? C_DK : C_AK) + kvh * 64, vcol = (isD ? C_DV : C_AV) + kvh * 64;
  const int ocol = (isD ? 768 : 0) + qh * 64;
  const int ncache = lat ? 8 : 0;
  int kt_lo = 0, kt_hi = lat ? 64 : 4;
  if (kind == 1) { kt_lo = max(0, 2 * qb - 2); kt_hi = min(64, 2 * qb + 4); }
  const int ntiles = ncache + kt_hi - kt_lo;
  const bool band = (kind == 1);
  const u16* INP = (const u16*)(p->ws + WS_INPROJ);
  const u16* KCk = (const u16*)(p->ws + WS_KC) + (size_t)((((isD ? 1 : 0) * 2 + b) * 2 + kvh) * 2) * 512 * 64;
  const u16* KCv = KCk + 512 * 64;
  const float sinkv = isD ? -1e30f : p->in[17][l * 4 + qh];

  bf16x8 qf[2][2];
#pragma unroll
  for (int nt = 0; nt < 2; ++nt)
#pragma unroll
    for (int s = 0; s < 2; ++s) qf[nt][s] = ld8(INP + (size_t)(seqrow0 + q0 + wave * 32 + nt * 16 + lq) * LDI + qcol + s * 32 + quad * 8);
  float mrun[2], lsum[2];
  f32x4 oacc[4][2];
#pragma unroll
  for (int nt = 0; nt < 2; ++nt) { mrun[nt] = sinkv; lsum[nt] = (!isD && quad == 0) ? 1.f : 0.f; }
#pragma unroll
  for (int dt = 0; dt < 4; ++dt)
#pragma unroll
    for (int nt = 0; nt < 2; ++nt) oacc[dt][nt] = f32x4{0.f, 0.f, 0.f, 0.f};

  const int key = tid >> 2, seg = (tid & 3) * 16;
  u32x4 rk[2], rv[2];
  auto tile_ptrs = [&](int t, const u16*& kp, const u16*& vp) {
    if (t < ncache) { kp = KCk + (size_t)(t * 64 + key) * 64 + seg; vp = KCv + (size_t)(t * 64 + key) * 64 + seg; }
    else { const u16* rowp = INP + (size_t)(seqrow0 + (kt_lo + t - ncache) * 64 + key) * LDI; kp = rowp + kcol + seg; vp = rowp + vcol + seg; }
  };
  { const u16 *kp, *vp; tile_ptrs(0, kp, vp); rk[0] = *(const u32x4*)kp; rk[1] = *(const u32x4*)(kp + 8); rv[0] = *(const u32x4*)vp; rv[1] = *(const u32x4*)(vp + 8); }
  for (int t = 0; t < ntiles; ++t) {
    __syncthreads();
    *(u32x4*)(sK + key * 72 + seg) = rk[0]; *(u32x4*)(sK + key * 72 + seg + 8) = rk[1];
    {
      unsigned vv[8] = {rv[0].x, rv[0].y, rv[0].z, rv[0].w, rv[1].x, rv[1].y, rv[1].z, rv[1].w};
#pragma unroll
      for (int e = 0; e < 8; ++e) { sVt[(seg + 2 * e) * 72 + key] = (u16)(vv[e] & 0xffffu); sVt[(seg + 2 * e + 1) * 72 + key] = (u16)(vv[e] >> 16); }
    }
    __syncthreads();
    if (t + 1 < ntiles) { const u16 *kp, *vp; tile_ptrs(t + 1, kp, vp); rk[0] = *(const u32x4*)kp; rk[1] = *(const u32x4*)(kp + 8); rv[0] = *(const u32x4*)vp; rv[1] = *(const u32x4*)(vp + 8); }
    f32x4 sacc[4][2];
#pragma unroll
    for (int mt = 0; mt < 4; ++mt) {
      sacc[mt][0] = f32x4{0.f, 0.f, 0.f, 0.f}; sacc[mt][1] = f32x4{0.f, 0.f, 0.f, 0.f};
#pragma unroll
      for (int s = 0; s < 2; ++s) {
        bf16x8 ka = ld8(sK + (mt * 16 + lq) * 72 + s * 32 + quad * 8);
        sacc[mt][0] = MFMA16(ka, qf[0][s], sacc[mt][0]);
        sacc[mt][1] = MFMA16(ka, qf[1][s], sacc[mt][1]);
      }
    }
    const bool masked_tile = band && t >= ncache;
    const int kbase = (kt_lo + t - ncache) * 64;
    bf16x8 pf[2][2];
#pragma unroll
    for (int nt = 0; nt < 2; ++nt) {
      const int qi = q0 + wave * 32 + nt * 16 + lq;
      float tmax = -1e30f;
#pragma unroll
      for (int mt = 0; mt < 4; ++mt)
#pragma unroll
        for (int r = 0; r < 4; ++r) {
          float s = sacc[mt][nt][r] * 0.125f;
          if (masked_tile) { int kj = kbase + mt * 16 + quad * 4 + r; int dlt = qi - kj; if (dlt > 128 || dlt < -128) s = -1e30f; }
          sacc[mt][nt][r] = s; tmax = fmaxf(tmax, s);
        }
      tmax = fmaxf(tmax, __shfl_xor(tmax, 16, 64)); tmax = fmaxf(tmax, __shfl_xor(tmax, 32, 64));
      const float mnew = fmaxf(mrun[nt], tmax);
      const float alpha = __expf(mrun[nt] - mnew);
      float ps = 0.f;
#pragma unroll
      for (int mt = 0; mt < 4; ++mt)
#pragma unroll
        for (int r = 0; r < 4; ++r) { float e = __expf(sacc[mt][nt][r] - mnew); sacc[mt][nt][r] = e; ps += e; }
      lsum[nt] = lsum[nt] * alpha + ps; mrun[nt] = mnew;
#pragma unroll
      for (int dt = 0; dt < 4; ++dt)
#pragma unroll
        for (int r = 0; r < 4; ++r) oacc[dt][nt][r] *= alpha;
      pf[nt][0] = pack8(sacc[0][nt], sacc[1][nt]);
      pf[nt][1] = pack8(sacc[2][nt], sacc[3][nt]);
    }
#pragma unroll
    for (int dt = 0; dt < 4; ++dt)
#pragma unroll
      for (int s2 = 0; s2 < 2; ++s2) {
        bf16x8 va = ldperm(sVt + (dt * 16 + lq) * 72 + s2 * 32 + quad * 4);
        oacc[dt][0] = MFMA16(va, pf[0][s2], oacc[dt][0]);
        oacc[dt][1] = MFMA16(va, pf[1][s2], oacc[dt][1]);
      }
  }
  u16* BR = (u16*)(p->ws + WS_BRANCH);
#pragma unroll
  for (int nt = 0; nt < 2; ++nt) {
    float lt = lsum[nt]; lt += __shfl_xor(lt, 16, 64); lt += __shfl_xor(lt, 32, 64);
    const float inv = 1.f / lt;
    const size_t row = seqrow0 + q0 + wave * 32 + nt * 16 + lq;
#pragma unroll
    for (int dt = 0; dt < 4; ++dt)
      *(uint2*)(BR + row * 1024 + ocol + dt * 16 + quad * 4) = make_uint2(pack2(oacc[dt][nt][0] * inv, oacc[dt][nt][1] * inv), pack2(oacc[dt][nt][2] * inv, oacc[dt][nt][3] * inv));
  }
  __syncthreads();
}

template <bool FINAL>
DI void lru_item(KP p, int l, int ci, unsigned char* smem) {
  float* sx = (float*)smem;
  u16* shf = (u16*)(smem + 32768);
  const int ch = ltid();
  const int r0 = ci * 32;
  const bool lat = r0 >= 8192;
  int b, T, seqrow0;
  if (!lat) { b = r0 >> 8; T = 256; seqrow0 = b * 256; } else { b = (r0 - 8192) >> 12; T = 4096; seqrow0 = 8192 + b * 4096; }
  const int t0 = r0 - seqrow0;
  const u16* INP = (const u16*)(p->ws + WS_INPROJ);
  {
    const float* cw = p->in[18] + l * 4 * 256;
    const float w0 = cw[ch], w1 = cw[256 + ch], w2 = cw[512 + ch], w3 = cw[768 + ch], cb = p->in[19][l * 256 + ch];
    auto ld = [&](int t) -> float { return (t >= 0 && t < T) ? bf2f(INP[(size_t)(seqrow0 + t) * LDI + C_LX + ch]) : 0.f; };
    float xm2 = ld(t0 - 2), xm1 = ld(t0 - 1), x0 = ld(t0);
    for (int t = 0; t < 32; ++t) {
      float xp1 = ld(t0 + t + 1);
      sx[t * 256 + ch] = xm2 * w0 + xm1 * w1 + x0 * w2 + xp1 * w3 + cb;
      xm2 = xm1; xm1 = x0; x0 = xp1;
    }
  }
  __syncthreads();
  const int n = ch >> 6, d = ch & 63;
  const int nch = T / 32, c = t0 / 32;
  float* LC = (float*)(p->ws + WS_LRUC);
  for (int dir = 0; dir < 2; ++dir) {
    float wr[64], wi[64];
    const float* WR = p->in[20] + ((size_t)((l * 2 + dir) * 4 + n) * 64) * 64 + d;
    const float* WI = p->in[22] + ((size_t)((l * 2 + dir) * 4 + n) * 64) * 64 + d;
#pragma unroll
    for (int cc = 0; cc < 64; ++cc) { wr[cc] = WR[cc * 64]; wi[cc] = WI[cc * 64]; }
    const float br = p->in[21][(l * 2 + dir) * 256 + ch], bi = p->in[23][(l * 2 + dir) * 256 + ch];
    const float sp = softplusf_(-p->in[24][(l * 2 + dir) * 256 + ch]);
    float h = 0.f, aprod = 1.f;
    if (FINAL) {
      h = lat ? p->in[7][((b * 2 + l) * 2 + dir) * 256 + ch] : 0.f;
      if (dir == 0) { for (int cc = 0; cc < c; ++cc) { const float* C = LC + ((size_t)((ci - c + cc) * 2 + dir) * 2) * 256; h = C[ch] * h + C[256 + ch]; } }
      else { for (int cc = nch - 1; cc > c; --cc) { const float* C = LC + ((size_t)((ci - c + cc) * 2 + dir) * 2) * 256; h = C[ch] * h + C[256 + ch]; } }
    }
    for (int st = 0; st < 32; ++st) {
      const int t = dir == 0 ? st : 31 - st;
      const float4* xr = (const float4*)(sx + t * 256 + n * 64);
      float ra = br, ia = bi;
#pragma unroll
      for (int q = 0; q < 16; ++q) {
        float4 xv = xr[q];
        ra += xv.x * wr[4 * q] + xv.y * wr[4 * q + 1] + xv.z * wr[4 * q + 2] + xv.w * wr[4 * q + 3];
        ia += xv.x * wi[4 * q] + xv.y * wi[4 * q + 1] + xv.z * wi[4 * q + 2] + xv.w * wi[4 * q + 3];
        if ((q & 3) == 3) asm volatile("" ::: "memory");
      }
      const float xt = sx[t * 256 + ch];
      const float la = -8.f * sigm(ra) * sp;
      const float a = __expf(la);
      const float bb = sqrtf(-expm1f(2.f * la)) * sigm(ia) * xt;
      h = a * h + bb; aprod *= a;
      if (FINAL) {
        if (dir == 0) shf[t * 256 + ch] = f2bf(h);
        else {
          float hf = bf2f(shf[t * 256 + ch]);
          float g = bf2f(INP[(size_t)(r0 + t) * LDI + C_LG + ch]);
          ((u16*)(p->ws + WS_BRANCH))[(size_t)(r0 + t) * 1024 + 256 + ch] = f2bf((hf + h) * gelu_tanh(g));
        }
      }
    }
    if (!FINAL) { float* C = LC + ((size_t)(ci * 2 + dir) * 2) * 256; C[ch] = aprod; C[256 + ch] = h; }
    else if (!lat) {
      if (dir == 0 && c == nch - 1) p->out[O_LRU + ((size_t)(b * 2 + l) * 2 + 0) * 256 + ch] = h;
      if (dir == 1 && c == 0) p->out[O_LRU + ((size_t)(b * 2 + l) * 2 + 1) * 256 + ch] = h;
    }
  }
  __syncthreads();
}

template <int DIR, bool ISW>
DI void gdn_solve(const float* L, const u16* src, const float* sb_, const float* se_, u16* UW) {
  float sol[64];
#pragma unroll
  for (int i = 0; i < 64; ++i) {
    float s = bf2f(src[(DIR == 0 ? i : 63 - i) * 72]) * sb_[i];
    if (ISW) s *= se_[i];
#pragma unroll
    for (int j4 = 0; j4 < (i + 3) / 4; ++j4) {
      float4 lv = *(const float4*)(L + i * 64 + j4 * 4);
      if (j4 * 4 + 0 < i) s -= lv.x * sol[j4 * 4 + 0];
      if (j4 * 4 + 1 < i) s -= lv.y * sol[j4 * 4 + 1];
      if (j4 * 4 + 2 < i) s -= lv.z * sol[j4 * 4 + 2];
      if (j4 * 4 + 3 < i) s -= lv.w * sol[j4 * 4 + 3];
      if ((j4 & 3) == 3) asm volatile("" ::: "memory");
    }
    sol[i] = s;
    UW[i * 128] = f2bf(s);
    asm volatile("" ::: "memory");
  }
}

DI void gdn1_item(KP p, int l, int item, unsigned char* smem) {
  const int cgi = item >> 2, hd = item & 3;
  u16* sq = (u16*)smem; u16* sk = sq + 64 * 72; u16* sv = sk + 64 * 72;
  float* sL = (float*)(smem + 27648);
  float* sgc = (float*)(smem + 60416);
  float* sbeta = sgc + 128;
  float* sge = sbeta + 128;
  const int tid = ltid(), lane = tid & 63, wave = tid >> 6, lq = lane & 15, quad = lane >> 4;
  const int r0 = cgi * 64;
  const bool lat = r0 >= 8192;
  int T, seqrow0;
  if (!lat) { T = 256; seqrow0 = (r0 >> 8) * 256; } else { T = 4096; seqrow0 = 8192 + ((r0 - 8192) >> 12) * 4096; }
  const int t0 = r0 - seqrow0;
  const u16* INP = (const u16*)(p->ws + WS_INPROJ);
  u16* QHAT = (u16*)(p->ws + WS_QHAT) + (size_t)item * 4096;
  {
    const int d = lane, tb = wave * 16;
#pragma unroll
    for (int mat = 0; mat < 3; ++mat) {
      const int col = C_GQ + mat * 256 + hd * 64 + d, wc = mat * 256 + hd * 64 + d;
      const float* cw = p->in[25] + (size_t)l * 4 * 768;
      const float w0 = cw[wc], w1 = cw[768 + wc], w2 = cw[1536 + wc], w3 = cw[2304 + wc];
      auto ld = [&](int t) -> float { return (t >= 0 && t < T) ? bf2f(INP[(size_t)(seqrow0 + t) * LDI + col]) : 0.f; };
      float xm2 = ld(t0 + tb - 2), xm1 = ld(t0 + tb - 1), x0 = ld(t0 + tb);
      u16* dst = mat == 0 ? sq : (mat == 1 ? sk : sv);
      for (int t = tb; t < tb + 16; ++t) {
        float xp1 = ld(t0 + t + 1);
        float v = siluf_(xm2 * w0 + xm1 * w1 + x0 * w2 + xp1 * w3);
        xm2 = xm1; xm1 = x0; x0 = xp1;
        if (mat < 2) { float ss = wave_sum(v * v); v *= rsqrtf(ss + 1e-6f) * (mat == 0 ? 0.125f : 1.f); }
        u16 hb = f2bf(v);
        dst[t * 72 + d] = hb;
        if (mat == 0) QHAT[t * 64 + d] = hb;
      }
    }
  }
  if (tid < 128) {
    const int dir = tid >> 6, c = tid & 63;
    const int tok = dir == 0 ? c : 63 - c;
    const u16* R = INP + (size_t)(r0 + tok) * LDI;
    const float ga = bf2f(R[C_GA + dir * 4 + hd]), gb = bf2f(R[C_GB + dir * 4 + hd]);
    const float g = -__expf(p->in[26][(l * 2 + dir) * 4 + hd]) * softplusf_(ga + p->in[27][(l * 2 + dir) * 4 + hd]);
    float gc = g;
#pragma unroll
    for (int o = 1; o < 64; o <<= 1) { float tt = __shfl_up(gc, o, 64); if (lane >= o) gc += tt; }
    const float glast = __shfl(gc, 63, 64);
    sgc[dir * 64 + c] = gc; sbeta[dir * 64 + c] = sigm(gb); sge[dir * 64 + c] = __expf(gc);
    float* gv = (float*)(p->ws + WS_GVEC) + (size_t)(item * 2 + dir) * 256;
    gv[c] = __expf(gc); gv[64 + c] = __expf(glast - gc); if (c == 0) gv[128] = __expf(glast);
  }
  __syncthreads();
  {
    const int dk = tid >> 2, c0 = (tid & 3) * 16;
    unsigned w[8];
#pragma unroll
    for (int e = 0; e < 8; ++e) w[e] = (unsigned)sk[(c0 + 2 * e) * 72 + dk] | ((unsigned)sk[(c0 + 2 * e + 1) * 72 + dk] << 16);
    u16* KT = (u16*)(p->ws + WS_KT) + (size_t)item * 4096 + dk * 64 + c0;
    *(u32x4*)KT = mku4(w[0], w[1], w[2], w[3]); *(u32x4*)(KT + 8) = mku4(w[4], w[5], w[6], w[7]);
  }
  {
    const int i0 = wave * 16;
    f32x4 akk[4], aqk[4];
#pragma unroll
    for (int nt = 0; nt < 4; ++nt) { akk[nt] = f32x4{0.f, 0.f, 0.f, 0.f}; aqk[nt] = f32x4{0.f, 0.f, 0.f, 0.f}; }
#pragma unroll
    for (int s = 0; s < 2; ++s) {
      bf16x8 ak = ld8(sk + (i0 + lq) * 72 + s * 32 + quad * 8), aq = ld8(sq + (i0 + lq) * 72 + s * 32 + quad * 8);
#pragma unroll
      for (int nt = 0; nt < 4; ++nt) { bf16x8 bk = ld8(sk + (nt * 16 + lq) * 72 + s * 32 + quad * 8); akk[nt] = MFMA16(ak, bk, akk[nt]); aqk[nt] = MFMA16(aq, bk, aqk[nt]); }
    }
    u16* QKf = (u16*)(p->ws + WS_QK) + (size_t)(item * 2 + 0) * 4096;
    u16* QKb = (u16*)(p->ws + WS_QK) + (size_t)(item * 2 + 1) * 4096;
#pragma unroll
    for (int nt = 0; nt < 4; ++nt)
#pragma unroll
      for (int r = 0; r < 4; ++r) {
        const int i = i0 + quad * 4 + r, j = nt * 16 + lq, ib = 63 - i, jb = 63 - j;
        const float kkv = akk[nt][r], qkv = aqk[nt][r];
        if (j < i) sL[i * 64 + j] = sbeta[i] * kkv * __expf(sgc[i] - sgc[j]);
        if (j > i) sL[4096 + ib * 64 + jb] = sbeta[64 + ib] * kkv * __expf(sgc[64 + ib] - sgc[64 + jb]);
        QKf[i * 64 + j] = f2bf(j <= i ? qkv * __expf(sgc[i] - sgc[j]) : 0.f);
        QKb[ib * 64 + jb] = f2bf(j >= i ? qkv * __expf(sgc[64 + ib] - sgc[64 + jb]) : 0.f);
      }
  }
  __syncthreads();
  {
    const int col = tid & 127;
    u16* UW = (u16*)(p->ws + WS_UW) + (size_t)(item * 2 + (tid >> 7)) * 8192 + col;
    if (tid < 128) { if (col < 64) gdn_solve<0, false>(sL, sv + col, sbeta, sge, UW); else gdn_solve<0, true>(sL, sk + (col - 64), sbeta, sge, UW); }
    else { if (col < 64) gdn_solve<1, false>(sL + 4096, sv + col, sbeta + 64, sge + 64, UW); else gdn_solve<1, true>(sL + 4096, sk + (col - 64), sbeta + 64, sge + 64, UW); }
  }
  __syncthreads();
}

DI void gdn2_item(KP p, int l, int item, unsigned char* smem) {
  u16* sW = (u16*)smem; u16* sQ = sW + 64 * 72; u16* sQK = sQ + 64 * 72; u16* sKT = sQK + 64 * 72; u16* sU = sKT + 64 * 72;
  float* sg = (float*)(smem + 46080);
  const int tid = ltid(), lane = tid & 63, wave = tid >> 6, lq = lane & 15, quad = lane >> 4;
  int b, hd, dir; bool lat;
  if (item < 16) { lat = true; b = item >> 3; hd = (item >> 1) & 3; dir = item & 1; }
  else { lat = false; int r = item - 16; b = r >> 3; hd = (r >> 1) & 3; dir = r & 1; }
  const int nch = lat ? 64 : 4, cg0 = lat ? 128 + b * 64 : b * 4;
  f32x4 st[4];
#pragma unroll
  for (int kt = 0; kt < 4; ++kt)
#pragma unroll
    for (int r = 0; r < 4; ++r)
      st[kt][r] = lat ? p->in[8][((size_t)(((b * 2 + l) * 2 + dir) * 4 + hd) * 64 + kt * 16 + quad * 4 + r) * 64 + wave * 16 + lq] : 0.f;
  const int lrow = tid >> 2, seg = (tid & 3) * 16;
  u32x4 rW[2], rQ[2], rQK[2], rKT[2], rU[2]; float rg = 0.f;
  const u16* UWb = (const u16*)(p->ws + WS_UW); const u16* QHb = (const u16*)(p->ws + WS_QHAT);
  const u16* KTb = (const u16*)(p->ws + WS_KT); u16* QKb = (u16*)(p->ws + WS_QK);
  const float* GV = (const float*)(p->ws + WS_GVEC);
  auto gload = [&](int n) {
    const int cgi = dir == 0 ? cg0 + n : cg0 + nch - 1 - n;
    const size_t prob = (size_t)cgi * 4 + hd, pd = prob * 2 + dir;
    const u16* u = UWb + (pd * 64 + lrow) * 128 + seg;
    rU[0] = *(const u32x4*)u; rU[1] = *(const u32x4*)(u + 8); rW[0] = *(const u32x4*)(u + 64); rW[1] = *(const u32x4*)(u + 72);
    const u16* q = QHb + (prob * 64 + (dir ? 63 - lrow : lrow)) * 64 + seg;
    rQ[0] = *(const u32x4*)q; rQ[1] = *(const u32x4*)(q + 8);
    const u16* qk = QKb + (pd * 64 + lrow) * 64 + seg;
    rQK[0] = *(const u32x4*)qk; rQK[1] = *(const u32x4*)(qk + 8);
    const u16* kt = KTb + (prob * 64 + lrow) * 64 + (dir ? 48 - seg : seg);
    u32x4 a = *(const u32x4*)kt, bb = *(const u32x4*)(kt + 8);
    if (dir) { rKT[0] = rev8(bb); rKT[1] = rev8(a); } else { rKT[0] = a; rKT[1] = bb; }
    rg = GV[pd * 256 + (tid & 255)];
  };
  gload(0);
  for (int n = 0; n < nch; ++n) {
    const int cgi = dir == 0 ? cg0 + n : cg0 + nch - 1 - n;
    const size_t pd = ((size_t)cgi * 4 + hd) * 2 + dir;
    __syncthreads();
    *(u32x4*)(sW + lrow * 72 + seg) = rW[0]; *(u32x4*)(sW + lrow * 72 + seg + 8) = rW[1];
    *(u32x4*)(sQ + lrow * 72 + seg) = rQ[0]; *(u32x4*)(sQ + lrow * 72 + seg + 8) = rQ[1];
    *(u32x4*)(sQK + lrow * 72 + seg) = rQK[0]; *(u32x4*)(sQK + lrow * 72 + seg + 8) = rQK[1];
    *(u32x4*)(sKT + lrow * 72 + seg) = rKT[0]; *(u32x4*)(sKT + lrow * 72 + seg + 8) = rKT[1];
    *(u32x4*)(sU + lrow * 72 + seg) = rU[0]; *(u32x4*)(sU + lrow * 72 + seg + 8) = rU[1];
    sg[tid] = rg;
    __syncthreads();
    if (n + 1 < nch) gload(n + 1);
    const float elast = sg[128];
    bf16x8 sB[2] = {pack8(st[0], st[1]), pack8(st[2], st[3])};
    f32x4 vn[4], oo[4];
#pragma unroll
    for (int mt = 0; mt < 4; ++mt) {
      f32x4 acc = {0.f, 0.f, 0.f, 0.f}, acq = {0.f, 0.f, 0.f, 0.f};
#pragma unroll
      for (int s2 = 0; s2 < 2; ++s2) {
        acc = MFMA16(ldperm(sW + (mt * 16 + lq) * 72 + s2 * 32 + quad * 4), sB[s2], acc);
        acq = MFMA16(ldperm(sQ + (mt * 16 + lq) * 72 + s2 * 32 + quad * 4), sB[s2], acq);
      }
#pragma unroll
      for (int r = 0; r < 4; ++r) {
        const int c = mt * 16 + quad * 4 + r;
        vn[mt][r] = bf2f(sU[c * 72 + wave * 16 + lq]) - acc[r];
        oo[mt][r] = acq[r] * sg[c];
      }
    }
    bf16x8 vB[2] = {pack8(vn[0], vn[1]), pack8(vn[2], vn[3])};
#pragma unroll
    for (int mt = 0; mt < 4; ++mt) {
#pragma unroll
      for (int s2 = 0; s2 < 2; ++s2) oo[mt] = MFMA16(ldperm(sQK + (mt * 16 + lq) * 72 + s2 * 32 + quad * 4), vB[s2], oo[mt]);
    }
    f32x4 vs[4];
#pragma unroll
    for (int mt = 0; mt < 4; ++mt)
#pragma unroll
      for (int r = 0; r < 4; ++r) vs[mt][r] = vn[mt][r] * sg[64 + mt * 16 + quad * 4 + r];
    bf16x8 vsB[2] = {pack8(vs[0], vs[1]), pack8(vs[2], vs[3])};
#pragma unroll
    for (int kt = 0; kt < 4; ++kt) {
      f32x4 acc = {0.f, 0.f, 0.f, 0.f};
#pragma unroll
      for (int s2 = 0; s2 < 2; ++s2) acc = MFMA16(ldperm(sKT + (kt * 16 + lq) * 72 + s2 * 32 + quad * 4), vsB[s2], acc);
#pragma unroll
      for (int r = 0; r < 4; ++r) st[kt][r] = elast * st[kt][r] + acc[r];
    }
    u16* O = QKb + pd * 4096;
#pragma unroll
    for (int mt = 0; mt < 4; ++mt)
#pragma unroll
      for (int r = 0; r < 4; ++r) O[(mt * 16 + quad * 4 + r) * 64 + wave * 16 + lq] = f2bf(oo[mt][r]);
  }
  if (!lat) {
#pragma unroll
    for (int kt = 0; kt < 4; ++kt)
#pragma unroll
      for (int r = 0; r < 4; ++r)
        p->out[O_GDN + ((size_t)(((b * 2 + l) * 2 + dir) * 4 + hd) * 64 + kt * 16 + quad * 4 + r) * 64 + wave * 16 + lq] = st[kt][r];
  }
  __syncthreads();
}

DI void gdnfin_item(KP p, int l, int item) {
  const int cgi = item >> 2, hd = item & 3;
  const int lane = ltid() & 63, wave = ltid() >> 6;
  const u16* Of = (const u16*)(p->ws + WS_QK) + (size_t)(item * 2 + 0) * 4096;
  const u16* Ob = (const u16*)(p->ws + WS_QK) + (size_t)(item * 2 + 1) * 4096;
  const float gn = p->in[28][l * 64 + lane];
  for (int c = wave * 16; c < wave * 16 + 16; ++c) {
    const size_t row = (size_t)cgi * 64 + c;
    float o = bf2f(Of[c * 64 + lane]) + bf2f(Ob[(63 - c) * 64 + lane]);
    float ss = wave_sum(o * o);
    float z = bf2f(((const u16*)(p->ws + WS_INPROJ))[row * LDI + C_GZ + hd * 64 + lane]);
    float y = o * rsqrtf(ss * (1.f / 64.f) + 1e-6f) * gn * siluf_(z);
    ((u16*)(p->ws + WS_BRANCH))[row * 1024 + 512 + hd * 64 + lane] = f2bf(y);
  }
}


#define XB_TMO      128
#define XB_XCNT(j)  (256  + 64 * (j))
#define XB_XSUB(j)  (1280 + 64 * (j))
#define XB_XGEN(j)  (2304 + 64 * (j))
#define XB_TOP      3328
#define XB_TOPGEN   3392
#define XB_SPIN_CAP (1u << 20)
#define LAS __attribute__((address_space(3)))
DI unsigned xb_ld(unsigned* q) { return __hip_atomic_load(q, __ATOMIC_RELAXED, __HIP_MEMORY_SCOPE_AGENT); }
DI unsigned xb_add(unsigned* q, unsigned v) { return __hip_atomic_fetch_add(q, v, __ATOMIC_RELAXED, __HIP_MEMORY_SCOPE_AGENT); }
DI unsigned xb_xcc_id() { return (unsigned)__builtin_amdgcn_s_getreg((3 << 11) | 20) & 0xFu; }
#define XB_SPIN(cond, bar) do { unsigned _sp = 0; while (cond) { __builtin_amdgcn_s_sleep(1); \
    if ((++_sp & 255u) == 0u) { if (xb_ld(&(bar)[XB_TMO])) break; if (_sp > XB_SPIN_CAP) { atomicAdd(&(bar)[XB_TMO], 1u); break; } } } } while (0)
DI void xcd_barrier_complete(unsigned* bar, unsigned x, unsigned& nloc, unsigned& nx) {
  const unsigned G = gridDim.x;
  unsigned sum, cnt, mine, sp = 0u;
  for (;;) {
    sum = 0u; cnt = 0u; mine = 0u;
#pragma unroll
    for (unsigned j = 0; j < 16; ++j) { const unsigned c = xb_ld(&bar[XB_XCNT(j)]); sum += c; cnt += (c > 0u) ? 1u : 0u; mine = (j == x) ? c : mine; }
    if (sum == G) break;
    __builtin_amdgcn_s_sleep(1);
    if ((++sp & 255u) == 0u) { if (xb_ld(&bar[XB_TMO])) break; if (sp > XB_SPIN_CAP) { atomicAdd(&bar[XB_TMO], 1u); break; } }
  }
  nloc = mine > 0u ? mine : 1u; nx = cnt > 0u ? cnt : 1u;
}
DI void xcd_barrier(unsigned* bar, volatile LAS unsigned* st) {
  asm volatile("s_waitcnt vmcnt(0)" ::: "memory");
  __syncthreads();
  if (ltid() == 0) {
    const unsigned x = xb_xcc_id();
    __builtin_amdgcn_s_waitcnt(0);
    unsigned nloc = st[0], nx = st[1];
    if (nloc == 0u) { xcd_barrier_complete(bar, x, nloc, nx); st[0] = nloc; st[1] = nx; }
    const unsigned old = xb_add(&bar[XB_XSUB(x)], 1u);
    const unsigned gen = old / nloc;
    if (old + 1u == (gen + 1u) * nloc) {
      __builtin_amdgcn_fence(__ATOMIC_RELEASE, "agent");
      asm volatile("s_waitcnt vmcnt(0)" ::: "memory");
      const unsigned og = xb_add(&bar[XB_TOP], 1u);
      const unsigned tg = og / nx;
      if (og + 1u == (tg + 1u) * nx) xb_add(&bar[XB_TOPGEN], 1u);
      else XB_SPIN(xb_ld(&bar[XB_TOPGEN]) == tg, bar);
      __builtin_amdgcn_fence(__ATOMIC_ACQUIRE, "agent");
      xb_add(&bar[XB_XGEN(x)], 1u);
      asm volatile("s_waitcnt vmcnt(0)" ::: "memory");
    } else {
      XB_SPIN(xb_ld(&bar[XB_XGEN(x)]) == gen, bar);
      __builtin_amdgcn_fence(__ATOMIC_ACQUIRE, "agent");
      asm volatile("s_waitcnt vmcnt(0)" ::: "memory");
    }
  }
  __syncthreads();
}

constexpr int NPHASE = 21;
__global__ void __launch_bounds__(256, 2) mk(Params p_unused, int ph_lo, int ph_hi) {
  __shared__ __attribute__((aligned(16))) unsigned char smem[SMEM_BYTES];
  __shared__ int s_item;
  __shared__ u32x4 xb_words;
  const int G = gridDim.x, B = blockIdx.x;
  const bool fused = ph_hi - ph_lo > 1;
  if (fused) {
    if (ltid() == 0) { xb_words = u32x4{0u, 0u, 0u, 0u}; (void)xb_add(&((unsigned*)(((KP)__builtin_amdgcn_kernarg_segment_ptr())->ws + WS_BAR))[XB_XCNT(xb_xcc_id())], 1u); }
    __syncthreads();
  }
  for (int ph = ph_lo; ph < ph_hi; ++ph) {
    KP p = (KP)__builtin_amdgcn_kernarg_segment_ptr();
    asm volatile("" : "+s"(p));
    if (ph == 0) {
      for (int it = B; it < 192 + CONV_ITEMS; it += G) { if (it < 192) { if (PHON(0)) mod_item(p, it, smem); } else if (PHON(1)) convert_item(p, 0, it - 192, smem); }
    } else {
      const int l = (ph - 1) / 10, sub = (ph - 1) % 10;
      switch (sub) {
        case 0:
          for (int it = B; it < 4096 + (l ? CONV_ITEMS : 0); it += G) { if (it < 4096) { if (PHON(2)) norm_item<0>(p, l, it); } else if (PHON(1)) convert_item(p, l, it - 4096, smem); }
          break;
        case 1: for (int it = B; it < 128 * 21; it += G) if (PHON(3)) inproj_item(p, it, smem); break;
        case 2:
          for (int it = B; it < 1024 + 512 + 64 + 4096; it += G) {
            if (it < 1024) { if (PHON(4)) gdn1_item(p, l, it, smem); }
            else if (it < 1536) { if (PHON(5)) lru_item<false>(p, l, it - 1024, smem); }
            else if (it < 1600) { if (PHON(6)) kvc_item(p, l, it - 1536); }
            else if (PHON(6)) prep_item(p, l, it - 1600);
          }
          break;
        case 3: {
          int* ctr = (int*)(p->ws + WS_CTR) + l;
          for (;;) {
            __syncthreads();
            if (ltid() == 0) s_item = atomicAdd(ctr, 1);
            __syncthreads();
            const int it = s_item;
            if (it >= 16 + 256 + 256 + 256 + 512 + 512) break;
            if (it < 16) { if (PHON(7)) gdn2_item(p, l, it, smem); }
            else if (it < 272) { if (PHON(8)) attn_item(p, l, it - 16, smem); }
            else if (it < 528) { if (PHON(7)) gdn2_item(p, l, it - 272 + 16, smem); }
            else if (it < 784) { if (PHON(8)) attn_item(p, l, it - 528 + 256, smem); }
            else if (it < 1296) { if (PHON(9)) lru_item<true>(p, l, it - 784, smem); }
            else if (PHON(8)) attn_item(p, l, it - 1296 + 512, smem);
          }
        } break;
        case 4: for (int it = B; it < 1024; it += G) if (PHON(10)) gdnfin_item(p, l, it); break;
        case 5: for (int it = B; it < 128 * 16; it += G) if (PHON(11)) merge_item(p, l, it, smem); break;
        case 6: for (int it = B; it < 128 * 8; it += G) if (PHON(12)) wout_item(p, l, it, smem); break;
        case 7: for (int it = B; it < 4096; it += G) if (PHON(2)) norm_item<1>(p, l, it); break;
        case 8: for (int it = B; it < 128 * 32; it += G) if (PHON(13)) w1_item(p, it, smem); break;
        case 9: for (int it = B; it < 128 * 8; it += G) if (PHON(14)) w2_item(p, l, it, smem); break;
      }
    }
    if (ph + 1 < ph_hi) {
      if (ph == ph_lo) cg::this_grid().sync();
      else xcd_barrier((unsigned*)(p->ws + WS_BAR), (volatile LAS unsigned*)&xb_words);
    }
  }
}

extern "C" void kernel_launch(void* const* d_in, const int* in_sizes, int n_in, void* d_out, int out_size, void* d_ws, size_t ws_size, hipStream_t stream) {
  static int grid_blocks = 0;
  if (!grid_blocks) {
    int dev = 0, cus = 0, per_cu = 0;
    (void)hipGetDevice(&dev);
    (void)hipDeviceGetAttribute(&cus, hipDeviceAttributeMultiprocessorCount, dev);
    (void)hipOccupancyMaxActiveBlocksPerMultiprocessor(&per_cu, mk, 256, 0);
    if (per_cu < 1) per_cu = 1;
    if (per_cu > 2) per_cu = 2;
    grid_blocks = cus * per_cu;
    if (ws_size < WS_END) fprintf(stderr, "kernel_launch: workspace too small: %zu < %zu\n", ws_size, (size_t)WS_END);
  }
  if (hipMemsetAsync((char*)d_ws + WS_CTR, 0, 256 + 3456 * 4 + 256, stream) != hipSuccess) fprintf(stderr, "kernel_launch: memset failed\n");
  Params p{};
  for (int i = 0; i < 37; ++i) p.in[i] = (const float*)d_in[i];
  p.out = (float*)d_out; p.ws = (unsigned char*)d_ws;
#if MULTI_LAUNCH
  for (int ph = 0; ph < NPHASE; ++ph) hipLaunchKernelGGL(mk, dim3(grid_blocks), dim3(256), 0, stream, p, ph, ph + 1);
#else
  int lo = 0, hi = NPHASE;
  void* args[] = {&p, &lo, &hi};
  hipError_t e = hipLaunchCooperativeKernel((void*)mk, dim3(grid_blocks), dim3(256), args, 0, stream);
  if (e != hipSuccess) fprintf(stderr, "cooperative launch failed: %s (grid %d)\n", hipGetErrorString(e), grid_blocks);
#endif
}
```

```cpp
#include <hip/hip_runtime.h>
#include <hip/hip_cooperative_groups.h>
#include <cstdio>
namespace cg = cooperative_groups;

#ifndef MULTI_LAUNCH
#define MULTI_LAUNCH 0
#endif
#ifndef PHM
#define PHM 0xFFFFFFFFu
#endif
#define PHON(b) ((PHM >> (b)) & 1u)
#ifndef DUPM
#define DUPM 0u
#endif
#define NREP(b) (1 + ((DUPM >> (b)) & 1u))

typedef unsigned short u16;
using bf16x8 = __attribute__((ext_vector_type(8))) short;
using f32x4 = __attribute__((ext_vector_type(4))) float;
using u32x4 = __attribute__((ext_vector_type(4))) unsigned;
#define DI __device__ __forceinline__
#define MFMA16(a, b, c) __builtin_amdgcn_mfma_f32_16x16x32_bf16((a), (b), (c), 0, 0, 0)

constexpr int NTOK = 16384;
constexpr int DM = 1024;
constexpr int LDI = 2592;
constexpr int C_AQ = 0, C_AK = 256, C_AV = 384, C_LX = 512, C_LG = 768, C_GQ = 1024, C_GK = 1280, C_GV = 1536, C_GZ = 1792,
              C_DQ = 2048, C_DK = 2304, C_DV = 2432, C_GA = 2560, C_GB = 2568;
constexpr int NIN_PAD = 2688;

constexpr size_t WS_MOD = 0;
constexpr size_t WS_CTR = WS_MOD + 2 * 3 * 6144 * 4;
constexpr size_t WS_BAR = WS_CTR + 256;
constexpr size_t WS_LRUC = WS_BAR + 3456 * 4 + 256;
constexpr size_t WS_KC = WS_LRUC + (size_t)512 * 2 * 2 * 256 * 4;
constexpr size_t WS_GVEC = WS_KC + (size_t)16 * 512 * 64 * 2;
constexpr size_t WS_WIN = WS_GVEC + (size_t)1024 * 2 * 256 * 4;
constexpr size_t WS_WM = WS_WIN + (size_t)NIN_PAD * 1024 * 2;
constexpr size_t WS_WB = WS_WM + (size_t)4096 * 1024 * 2;
constexpr size_t WS_WO = WS_WB + (size_t)4 * 1024 * 256 * 2;
constexpr size_t WS_W1 = WS_WO + (size_t)1024 * 1024 * 2;
constexpr size_t WS_W2 = WS_W1 + (size_t)4096 * 1024 * 2;
constexpr size_t WS_H = WS_W2 + (size_t)1024 * 4096 * 2;
constexpr size_t WS_BIG = WS_H + (size_t)NTOK * 1024 * 2;
constexpr size_t WS_INPROJ = WS_BIG;
constexpr size_t WS_BRANCH = WS_INPROJ + (size_t)NTOK * LDI * 2;
constexpr size_t WS_QHAT = WS_BRANCH + (size_t)NTOK * 1024 * 2;
constexpr size_t WS_KT = WS_QHAT + (size_t)1024 * 4096 * 2;
constexpr size_t WS_UW = WS_KT + (size_t)1024 * 4096 * 2;
constexpr size_t WS_QK = WS_UW + (size_t)1024 * 2 * 8192 * 2;
constexpr size_t WS_END = WS_QK + (size_t)1024 * 2 * 4096 * 2;
constexpr size_t WS_HIDDEN = WS_BIG;
constexpr size_t WS_MERGED = WS_BIG;
static_assert(WS_HIDDEN + (size_t)NTOK * 4096 * 2 <= WS_END, "hidden must fit");
static_assert(WS_END <= (size_t)256 * 1024 * 1024, "workspace budget");

constexpr size_t O_X = 0, O_AK = 16777216, O_AV = 18874368, O_DK = 20971520, O_DV = 23068672, O_LRU = 25165824, O_GDN = 25198592;

struct Params {
  const float* in[37];
  float* out;
  unsigned char* ws;
};

typedef const Params __attribute__((address_space(4)))* KP;
constexpr int SMEM_BYTES = 65536;
constexpr int DYN_LDS = SMEM_BYTES + 64;

DI int ltid() { int t = threadIdx.x; asm volatile("" : "+v"(t)); return t; }
DI u16 f2bf(float x) { unsigned u = __float_as_uint(x); u += 0x7fffu + ((u >> 16) & 1u); return (u16)(u >> 16); }
DI float bf2f(u16 h) { return __uint_as_float(((unsigned)h) << 16); }
DI unsigned pack2(float a, float b) { return (unsigned)f2bf(a) | ((unsigned)f2bf(b) << 16); }
DI float bflo(unsigned u) { return __uint_as_float(u << 16); }
DI float bfhi(unsigned u) { return __uint_as_float(u & 0xffff0000u); }
DI float sigm(float x) { return 1.f / (1.f + __expf(-x)); }
DI float siluf_(float x) { return x / (1.f + __expf(-x)); }
DI float softplusf_(float x) { return x > 20.f ? x : log1pf(__expf(x)); }
DI float gelu_tanh(float x) { float u = 0.7978845608028654f * (x + 0.044715f * x * x * x); float t = 1.f - 2.f / (__expf(2.f * u) + 1.f); return 0.5f * x * (1.f + t); }
DI float wave_sum(float v) {
#pragma unroll
  for (int o = 32; o > 0; o >>= 1) v += __shfl_xor(v, o, 64);
  return v;
}
DI u32x4 mku4(unsigned a, unsigned b, unsigned c, unsigned d) { u32x4 v = {a, b, c, d}; return v; }
DI bf16x8 mk8(unsigned a, unsigned b, unsigned c, unsigned d) { u32x4 v = {a, b, c, d}; return __builtin_bit_cast(bf16x8, v); }
DI bf16x8 pack8(const f32x4& x, const f32x4& y) { return mk8(pack2(x[0], x[1]), pack2(x[2], x[3]), pack2(y[0], y[1]), pack2(y[2], y[3])); }
DI bf16x8 ld8(const u16* p) { return *(const bf16x8*)p; }
DI bf16x8 ldperm(const u16* p) { uint2 a = *(const uint2*)p; uint2 b = *(const uint2*)(p + 16); return mk8(a.x, a.y, b.x, b.y); }
DI int mod_group(int row) { return row < 8192 ? 0 : 1 + ((row - 8192) >> 12); }
DI const float* x_in_row(KP p, int l, int row) {
  if (l == 0) return row < 8192 ? p->in[0] + (size_t)row * DM : p->in[1] + (size_t)(row - 8192) * DM;
  return p->out + (size_t)row * DM;
}
DI unsigned swap16(unsigned u) { return (u >> 16) | (u << 16); }
DI u32x4 rev8(u32x4 v) { return mku4(swap16(v.w), swap16(v.z), swap16(v.y), swap16(v.x)); }

DI void mod_item(KP p, int item, unsigned char* smem) {
  float* sc = (float*)smem;
  float* sr = sc + 3072;
  const int tid = ltid();
  const int l = item / 96, cb = item % 96;
  for (int i = tid; i < 3072; i += 256) {
    int g = i >> 10, k = i & 1023;
    float c = g == 0 ? p->in[9][k] : p->in[2][(g - 1) * 1024 + k];
    sc[i] = siluf_(c);
  }
  __syncthreads();
  const int col = cb * 64 + (tid & 63), kg = tid >> 6;
  const float* W = p->in[10] + (size_t)l * 1024 * 6144;
  float a0 = 0.f, a1 = 0.f, a2 = 0.f;
  for (int k = kg * 256; k < kg * 256 + 256; ++k) {
    float w = W[(size_t)k * 6144 + col];
    a0 += sc[k] * w; a1 += sc[1024 + k] * w; a2 += sc[2048 + k] * w;
  }
  sr[(kg * 3 + 0) * 64 + (tid & 63)] = a0; sr[(kg * 3 + 1) * 64 + (tid & 63)] = a1; sr[(kg * 3 + 2) * 64 + (tid & 63)] = a2;
  __syncthreads();
  if (tid < 192) {
    int g = tid >> 6, cc = tid & 63;
    float s = p->in[11][l * 6144 + cb * 64 + cc];
    for (int q = 0; q < 4; ++q) s += sr[(q * 3 + g) * 64 + cc];
    ((float*)(p->ws + WS_MOD))[(l * 3 + g) * 6144 + cb * 64 + cc] = s;
  }
  __syncthreads();
}

DI void conv_tile(const float* src, int N, int k0, int n0, u16* dst, int K, bool perm, unsigned char* smem) {
  float* tile = (float*)smem;
  const int tid = ltid();
#pragma unroll
  for (int i = 0; i < 4; ++i) {
    int kr = (tid >> 4) + 16 * i, nc = (tid & 15) * 4;
    float4 v = make_float4(0.f, 0.f, 0.f, 0.f);
    if (n0 + nc < N) v = *(const float4*)(src + (size_t)(k0 + kr) * N + n0 + nc);
    tile[kr * 65 + nc] = v.x; tile[kr * 65 + nc + 1] = v.y; tile[kr * 65 + nc + 2] = v.z; tile[kr * 65 + nc + 3] = v.w;
  }
  __syncthreads();
#pragma unroll
  for (int i = 0; i < 2; ++i) {
    int n = (tid >> 3) + 32 * i, k8 = (tid & 7) * 8;
    int ng = n0 + n;
    if (ng < N) {
      int row = ng;
      if (perm) row = ng < 2048 ? ng : (ng < 2064 ? 2560 + (ng - 2048) : ng - 16);
      u32x4 o;
      o.x = pack2(tile[(k8 + 0) * 65 + n], tile[(k8 + 1) * 65 + n]);
      o.y = pack2(tile[(k8 + 2) * 65 + n], tile[(k8 + 3) * 65 + n]);
      o.z = pack2(tile[(k8 + 4) * 65 + n], tile[(k8 + 5) * 65 + n]);
      o.w = pack2(tile[(k8 + 6) * 65 + n], tile[(k8 + 7) * 65 + n]);
      *(u32x4*)(dst + (size_t)row * K + k0 + k8) = o;
    }
  }
  __syncthreads();
}

constexpr int CONV_ITEMS = 4241;
DI void convert_item(KP p, int l, int item, unsigned char* smem) {
  unsigned char* ws = p->ws;
  if (item < 656) { int kt = item / 41, nt = item % 41; conv_tile(p->in[14] + (size_t)l * 1024 * 2576, 2576, kt * 64, nt * 64, (u16*)(ws + WS_WIN), 1024, true, smem); return; }
  item -= 656;
  if (item < 1024) { int kt = item >> 6, nt = item & 63; conv_tile(p->in[32] + (size_t)l * 1024 * 4096, 4096, kt * 64, nt * 64, (u16*)(ws + WS_WM), 1024, false, smem); return; }
  item -= 1024;
  if (item < 256) { int m = item >> 6, r = item & 63, kt = r >> 4, nt = r & 15;
    conv_tile(p->in[31] + ((size_t)l * 4 + m) * 256 * 1024, 1024, kt * 64, nt * 64, (u16*)(ws + WS_WB) + (size_t)m * 1024 * 256, 256, false, smem); return; }
  item -= 256;
  if (item < 256) { int kt = item >> 4, nt = item & 15; conv_tile(p->in[34] + (size_t)l * 1024 * 1024, 1024, kt * 64, nt * 64, (u16*)(ws + WS_WO), 1024, false, smem); return; }
  item -= 256;
  if (item < 1024) { int kt = item >> 6, nt = item & 63; conv_tile(p->in[35] + (size_t)l * 1024 * 4096, 4096, kt * 64, nt * 64, (u16*)(ws + WS_W1), 1024, false, smem); return; }
  item -= 1024;
  if (item < 1024) { int kt = item >> 4, nt = item & 15; conv_tile(p->in[36] + (size_t)l * 4096 * 1024, 1024, kt * 64, nt * 64, (u16*)(ws + WS_W2), 4096, false, smem); return; }
  u32x4* z = (u32x4*)((u16*)(ws + WS_WIN) + (size_t)2576 * 1024);
  for (int i = ltid(); i < 112 * 1024 / 8; i += 256) z[i] = mku4(0, 0, 0, 0);
}

template <int which>
DI void norm_item(KP p, int l, int item) {
  const int lane = ltid() & 63, wave = ltid() >> 6;
  const int row = item * 4 + wave;
  const float* x = x_in_row(p, which == 0 ? l : 2, row);
  const float* g = p->in[which == 0 ? 12 : 13] + l * 1024;
  const float* mod = (const float*)(p->ws + WS_MOD) + (l * 3 + mod_group(row)) * 6144;
  const float* sh = mod + (which == 0 ? 0 : 3072);
  const float* sc = mod + (which == 0 ? 1024 : 4096);
  f32x4 v[4]; float ss = 0.f;
#pragma unroll
  for (int i = 0; i < 4; ++i) { v[i] = *(const f32x4*)(x + i * 256 + lane * 4); ss += v[i].x * v[i].x + v[i].y * v[i].y + v[i].z * v[i].z + v[i].w * v[i].w; }
  ss = wave_sum(ss);
  const float rstd = rsqrtf(ss * (1.f / 1024.f) + 1e-6f);
  u16* H = (u16*)(p->ws + WS_H) + (size_t)row * 1024;
#pragma unroll
  for (int i = 0; i < 4; ++i) {
    int c = i * 256 + lane * 4;
    float4 gg = *(const float4*)(g + c), s1 = *(const float4*)(sc + c), s0 = *(const float4*)(sh + c);
    float y0 = v[i].x * rstd * gg.x * (1.f + s1.x) + s0.x, y1 = v[i].y * rstd * gg.y * (1.f + s1.y) + s0.y;
    float y2 = v[i].z * rstd * gg.z * (1.f + s1.z) + s0.z, y3 = v[i].w * rstd * gg.w * (1.f + s1.w) + s0.w;
    *(uint2*)(H + c) = make_uint2(pack2(y0, y1), pack2(y2, y3));
  }
}

DI int lds_byte(int r, int c) {
  int st = (r >> 4) * 2 + (c >> 5), ob = (r & 15) * 64 + (c & 31) * 2;
  return st * 1024 + (ob ^ (((ob >> 9) & 1) << 5));
}
DI void stage_rc(int b, int& R, int& C) {
  int st = b >> 10, sb = b & 1023, swz = sb ^ (((sb >> 9) & 1) << 5);
  R = (st >> 1) * 16 + (swz >> 6);
  C = (st & 1) * 32 + ((swz & 63) >> 1);
}
template <int MT, int NT>
DI void gemm_acc(f32x4 (&acc)[MT][NT], const u16* __restrict__ A, int lda, const u16* __restrict__ Bt, int ldb, int K, unsigned char* smem) {
  constexpr int TA = MT * 32 * 128, TB = NT * 32 * 128, STAGE = TA + TB;
  static_assert(2 * STAGE <= 65536, "LDS");
  const int tid = ltid(), lane = tid & 63, wid = tid >> 6, wm = wid >> 1, wn = wid & 1;
  const int fr = lane & 15, fq = lane >> 4;
  const u16* ga[MT]; const u16* gb[NT];
#pragma unroll
  for (int i = 0; i < MT; ++i) { int R, C; stage_rc(wid * 1024 + i * 4096 + lane * 16, R, C); ga[i] = A + (size_t)R * lda + C; }
#pragma unroll
  for (int i = 0; i < NT; ++i) { int R, C; stage_rc(wid * 1024 + i * 4096 + lane * 16, R, C); gb[i] = Bt + (size_t)R * ldb + C; }
#define GLDS_STAGE(buf, k0)                                                                                                        \
  do {                                                                                                                             \
    _Pragma("unroll") for (int i = 0; i < MT; ++i)                                                                                 \
      __builtin_amdgcn_global_load_lds((const unsigned*)(ga[i] + (k0)), (unsigned*)(smem + (buf) * STAGE + wid * 1024 + i * 4096), 16, 0, 0); \
    _Pragma("unroll") for (int i = 0; i < NT; ++i)                                                                                 \
      __builtin_amdgcn_global_load_lds((const unsigned*)(gb[i] + (k0)), (unsigned*)(smem + (buf) * STAGE + TA + wid * 1024 + i * 4096), 16, 0, 0); \
  } while (0)
  __syncthreads();
  GLDS_STAGE(0, 0);
  asm volatile("s_waitcnt vmcnt(0)" ::: "memory");
  __syncthreads();
  const int nt = K >> 6;
  for (int t = 0; t < nt; ++t) {
    const int cur = t & 1;
    if (t + 1 < nt) GLDS_STAGE(cur ^ 1, (t + 1) * 64);
    const unsigned char* sA = smem + cur * STAGE;
    const unsigned char* sB = sA + TA;
#pragma unroll
    for (int s = 0; s < 2; ++s) {
      bf16x8 bfr[NT];
#pragma unroll
      for (int j = 0; j < NT; ++j) bfr[j] = *(const bf16x8*)(sB + lds_byte(wn * NT * 16 + j * 16 + fr, s * 32 + fq * 8));
#pragma unroll
      for (int i = 0; i < MT; ++i) {
        bf16x8 af = *(const bf16x8*)(sA + lds_byte(wm * MT * 16 + i * 16 + fr, s * 32 + fq * 8));
#pragma unroll
        for (int j = 0; j < NT; ++j) acc[i][j] = MFMA16(af, bfr[j], acc[i][j]);
      }
    }
    asm volatile("s_waitcnt vmcnt(0)" ::: "memory");
    __syncthreads();
  }
#undef GLDS_STAGE
}

template <int MT, int NT> DI void zero_acc(f32x4 (&acc)[MT][NT]) {
#pragma unroll
  for (int i = 0; i < MT; ++i)
#pragma unroll
    for (int j = 0; j < NT; ++j) acc[i][j] = f32x4{0.f, 0.f, 0.f, 0.f};
}

#define EPI_LOOP(MT, NT)                                                          \
  const int tid_ = ltid(), lane_ = tid_ & 63, wave_ = tid_ >> 6;                   \
  const int wm_ = wave_ >> 1, wn_ = wave_ & 1, lq_ = lane_ & 15, quad_ = lane_ >> 4; \
  _Pragma("unroll") for (int i = 0; i < MT; ++i)                                   \
  _Pragma("unroll") for (int j = 0; j < NT; ++j)                                   \
  _Pragma("unroll") for (int r = 0; r < 4; ++r)
#define EPI_ROW(m0, MT) ((m0) + wm_ * (MT) * 16 + i * 16 + quad_ * 4 + r)
#define EPI_COL(n0, NT) ((n0) + wn_ * (NT) * 16 + j * 16 + lq_)

constexpr int GMT = 4;
DI void inproj_item(KP p, int mt, int nt, unsigned char* smem) {
  const int m0 = mt * (GMT * 32), n0 = nt * 128;
  f32x4 acc[GMT][4]; zero_acc<GMT, 4>(acc);
  gemm_acc<GMT, 4>(acc, (const u16*)(p->ws + WS_H) + (size_t)m0 * 1024, 1024, (const u16*)(p->ws + WS_WIN) + (size_t)n0 * 1024, 1024, 1024, smem);
  u16* C = (u16*)(p->ws + WS_INPROJ);
  EPI_LOOP(GMT, 4) { int row = EPI_ROW(m0, GMT), col = EPI_COL(n0, 4); if (col < LDI) C[(size_t)row * LDI + col] = f2bf(acc[i][j][r]); }
}

DI void merge_item(KP p, int l, int mt, int nt, unsigned char* smem) {
  const int m0 = mt * 128, n0 = nt * 64;
  const u16* H = (const u16*)(p->ws + WS_H) + (size_t)m0 * 1024;
  const u16* BR = (const u16*)(p->ws + WS_BRANCH) + (size_t)m0 * 1024;
  const float* bm = p->in[33] + l * 4096;
  f32x4 accm[4][2]; zero_acc<4, 2>(accm);
  for (int m = 0; m < 4; ++m) {
    f32x4 ag[4][2], ap[4][2]; zero_acc<4, 2>(ag); zero_acc<4, 2>(ap);
    gemm_acc<4, 2>(ag, H, 1024, (const u16*)(p->ws + WS_WM) + (size_t)(m * 1024 + n0) * 1024, 1024, 1024, smem);
    gemm_acc<4, 2>(ap, BR + m * 256, 1024, (const u16*)(p->ws + WS_WB) + (size_t)(m * 1024 + n0) * 256, 256, 256, smem);
    EPI_LOOP(4, 2) { int col = EPI_COL(n0, 2); accm[i][j][r] += sigm(ag[i][j][r] + bm[m * 1024 + col]) * ap[i][j][r]; }
  }
  u16* C = (u16*)(p->ws + WS_MERGED);
  EPI_LOOP(4, 2) { int row = EPI_ROW(m0, 4), col = EPI_COL(n0, 2); C[(size_t)row * 1024 + col] = f2bf(accm[i][j][r]); }
}

DI void wout_item(KP p, int l, int mt, int nt, unsigned char* smem) {
  const int m0 = mt * (GMT * 32), n0 = nt * 128;
  f32x4 acc[GMT][4]; zero_acc<GMT, 4>(acc);
  gemm_acc<GMT, 4>(acc, (const u16*)(p->ws + WS_MERGED) + (size_t)m0 * 1024, 1024, (const u16*)(p->ws + WS_WO) + (size_t)n0 * 1024, 1024, 1024, smem);
  const float* g1 = (const float*)(p->ws + WS_MOD) + (l * 3 + mod_group(m0)) * 6144 + 2048;
  EPI_LOOP(GMT, 4) { int row = EPI_ROW(m0, GMT), col = EPI_COL(n0, 4); p->out[(size_t)row * DM + col] = x_in_row(p, l, row)[col] + g1[col] * acc[i][j][r]; }
}

DI void w1_item(KP p, int mt, int nt, unsigned char* smem) {
  const int m0 = mt * (GMT * 32), n0 = nt * 128;
  f32x4 acc[GMT][4]; zero_acc<GMT, 4>(acc);
  gemm_acc<GMT, 4>(acc, (const u16*)(p->ws + WS_H) + (size_t)m0 * 1024, 1024, (const u16*)(p->ws + WS_W1) + (size_t)n0 * 1024, 1024, 1024, smem);
  u16* C = (u16*)(p->ws + WS_HIDDEN);
  EPI_LOOP(GMT, 4) { int row = EPI_ROW(m0, GMT), col = EPI_COL(n0, 4); float v = fmaxf(acc[i][j][r], 0.f); C[(size_t)row * 4096 + col] = f2bf(v * v); }
}

DI void w2_item(KP p, int l, int mt, int nt, unsigned char* smem) {
  const int m0 = mt * (GMT * 32), n0 = nt * 128;
  f32x4 acc[GMT][4]; zero_acc<GMT, 4>(acc);
  gemm_acc<GMT, 4>(acc, (const u16*)(p->ws + WS_HIDDEN) + (size_t)m0 * 4096, 4096, (const u16*)(p->ws + WS_W2) + (size_t)n0 * 4096, 4096, 4096, smem);
  const float* g2 = (const float*)(p->ws + WS_MOD) + (l * 3 + mod_group(m0)) * 6144 + 5120;
  EPI_LOOP(GMT, 4) { int row = EPI_ROW(m0, GMT), col = EPI_COL(n0, 4); float* o = p->out + (size_t)row * DM + col; *o = *o + g2[col] * acc[i][j][r]; }
}

DI void prep_item(KP p, int l, int item) {
  const int lane = ltid() & 63, wave = ltid() >> 6;
  const int row = item * 4 + wave;
  const bool lat = row >= 8192;
  u16* R = (u16*)(p->ws + WS_INPROJ) + (size_t)row * LDI;
  float cs = 1.f, sn = 0.f;
  if (lat) {
    int t = (row - 8192) & 4095;
    int pos = (lane < 32) ? (t >> 6) : (t & 63);
    float inv = __expf(-(float)(lane & 15) * (9.210340371976184f / 16.f));
    float ang = (float)pos * inv;
    cs = __cosf(ang); sn = __sinf(ang);
  }
  const int b = row >> 8, t = row & 255;
#pragma unroll
  for (int hh = 0; hh < 12; ++hh) {
    int col; const float* g;
    if (hh < 4) { col = C_AQ + hh * 64; g = p->in[15] + l * 64; }
    else if (hh < 6) { col = C_AK + (hh - 4) * 64; g = p->in[16] + l * 64; }
    else if (hh < 10) { col = C_DQ + (hh - 6) * 64; g = p->in[29] + l * 64; }
    else { col = C_DK + (hh - 10) * 64; g = p->in[30] + l * 64; }
    float v = bf2f(R[col + lane]);
    float ss = wave_sum(v * v);
    float y = v * rsqrtf(ss * (1.f / 64.f) + 1e-6f) * g[lane];
    if (lat) {
      float yp = __shfl_xor(y, 16, 64);
      y = ((lane & 31) < 16) ? (y * cs - yp * sn) : (y * cs + yp * sn);
    } else {
      if (hh == 4 || hh == 5) p->out[O_AK + ((size_t)(b * 2 + l) * 256 + t) * 128 + (hh - 4) * 64 + lane] = y;
      if (hh >= 10) p->out[O_DK + ((size_t)(b * 2 + l) * 256 + t) * 128 + (hh - 10) * 64 + lane] = y;
    }
    R[col + lane] = f2bf(y);
  }
  if (!lat) {
    size_t o = ((size_t)(b * 2 + l) * 256 + t) * 128;
    p->out[O_AV + o + lane] = bf2f(R[C_AV + lane]); p->out[O_AV + o + 64 + lane] = bf2f(R[C_AV + 64 + lane]);
    p->out[O_DV + o + lane] = bf2f(R[C_DV + lane]); p->out[O_DV + o + 64 + lane] = bf2f(R[C_DV + 64 + lane]);
  }
}

DI void kvc_item(KP p, int l, int item) {
  u16* KC = (u16*)(p->ws + WS_KC);
#pragma unroll
  for (int it = 0; it < 8; ++it) {
    int idx4 = item * 2048 + it * 256 + ltid();
    int e = idx4 * 4;
    int d = e & 63, key = (e >> 6) & 511, sel = e >> 15;
    int kv = sel & 1, kvh = (sel >> 1) & 1, b = (sel >> 2) & 1, mixer = sel >> 3;
    const float* srcb = mixer ? (kv ? p->in[6] : p->in[5]) : (kv ? p->in[4] : p->in[3]);
    const float* src = srcb + ((size_t)((b * 2 + l) * 512 + key) * 2 + kvh) * 64 + d;
    float4 v = *(const float4*)src;
    *(uint2*)(KC + e) = make_uint2(pack2(v.x, v.y), pack2(v.z, v.w));
  }
}

DI void attn_item(KP p, int l, int it, unsigned char* smem) {
  u16* sK = (u16*)smem;
  u16* sVt = sK + 64 * 72;
  const int tid = ltid(), lane = tid & 63, wave = tid >> 6, lq = lane & 15, quad = lane >> 4;
  int kind, b, qh, qb;
  if (it < 512) { kind = it >> 8; int r = it & 255; b = r >> 7; qh = (r >> 5) & 3; qb = r & 31; }
  else { int r = it - 512; kind = 2 + (r >> 8); r &= 255; b = r >> 3; qh = (r >> 1) & 3; qb = r & 1; }
  const bool isD = (kind == 0 || kind == 3), lat = kind < 2;
  const int seqrow0 = lat ? 8192 + b * 4096 : b * 256;
  const int q0 = qb * 128, kvh = qh >> 1;
  const int qcol = (isD ? C_DQ : C_AQ) + qh * 64, kcol = (isD ? C_DK : C_AK) + kvh * 64, vcol = (isD ? C_DV : C_AV) + kvh * 64;
  const int ocol = (isD ? 768 : 0) + qh * 64;
  const int ncache = lat ? 8 : 0;
  int kt_lo = 0, kt_hi = lat ? 64 : 4;
  if (kind == 1) { kt_lo = max(0, 2 * qb - 2); kt_hi = min(64, 2 * qb + 4); }
  const int ntiles = ncache + kt_hi - kt_lo;
  const bool band = (kind == 1);
  const u16* INP = (const u16*)(p->ws + WS_INPROJ);
  const u16* KCk = (const u16*)(p->ws + WS_KC) + (size_t)((((isD ? 1 : 0) * 2 + b) * 2 + kvh) * 2) * 512 * 64;
  const u16* KCv = KCk + 512 * 64;
  const float sinkv = isD ? -1e30f : p->in[17][l * 4 + qh];

  bf16x8 qf[2][2];
#pragma unroll
  for (int nt = 0; nt < 2; ++nt)
#pragma unroll
    for (int s = 0; s < 2; ++s) qf[nt][s] = ld8(INP + (size_t)(seqrow0 + q0 + wave * 32 + nt * 16 + lq) * LDI + qcol + s * 32 + quad * 8);
  float mrun[2], lsum[2];
  f32x4 oacc[4][2];
#pragma unroll
  for (int nt = 0; nt < 2; ++nt) { mrun[nt] = sinkv; lsum[nt] = (!isD && quad == 0) ? 1.f : 0.f; }
#pragma unroll
  for (int dt = 0; dt < 4; ++dt)
#pragma unroll
    for (int nt = 0; nt < 2; ++nt) oacc[dt][nt] = f32x4{0.f, 0.f, 0.f, 0.f};

  const int key = tid >> 2, seg = (tid & 3) * 16;
  u32x4 rk[2], rv[2];
  auto tile_ptrs = [&](int t, const u16*& kp, const u16*& vp) {
    if (t < ncache) { kp = KCk + (size_t)(t * 64 + key) * 64 + seg; vp = KCv + (size_t)(t * 64 + key) * 64 + seg; }
    else { const u16* rowp = INP + (size_t)(seqrow0 + (kt_lo + t - ncache) * 64 + key) * LDI; kp = rowp + kcol + seg; vp = rowp + vcol + seg; }
  };
  { const u16 *kp, *vp; tile_ptrs(0, kp, vp); rk[0] = *(const u32x4*)kp; rk[1] = *(const u32x4*)(kp + 8); rv[0] = *(const u32x4*)vp; rv[1] = *(const u32x4*)(vp + 8); }
  for (int t = 0; t < ntiles; ++t) {
    __syncthreads();
    *(u32x4*)(sK + key * 72 + seg) = rk[0]; *(u32x4*)(sK + key * 72 + seg + 8) = rk[1];
    {
      unsigned vv[8] = {rv[0].x, rv[0].y, rv[0].z, rv[0].w, rv[1].x, rv[1].y, rv[1].z, rv[1].w};
#pragma unroll
      for (int e = 0; e < 8; ++e) { sVt[(seg + 2 * e) * 72 + key] = (u16)(vv[e] & 0xffffu); sVt[(seg + 2 * e + 1) * 72 + key] = (u16)(vv[e] >> 16); }
    }
    __syncthreads();
    if (t + 1 < ntiles) { const u16 *kp, *vp; tile_ptrs(t + 1, kp, vp); rk[0] = *(const u32x4*)kp; rk[1] = *(const u32x4*)(kp + 8); rv[0] = *(const u32x4*)vp; rv[1] = *(const u32x4*)(vp + 8); }
    f32x4 sacc[4][2];
#pragma unroll
    for (int mt = 0; mt < 4; ++mt) {
      sacc[mt][0] = f32x4{0.f, 0.f, 0.f, 0.f}; sacc[mt][1] = f32x4{0.f, 0.f, 0.f, 0.f};
#pragma unroll
      for (int s = 0; s < 2; ++s) {
        bf16x8 ka = ld8(sK + (mt * 16 + lq) * 72 + s * 32 + quad * 8);
        sacc[mt][0] = MFMA16(ka, qf[0][s], sacc[mt][0]);
        sacc[mt][1] = MFMA16(ka, qf[1][s], sacc[mt][1]);
      }
    }
    const bool masked_tile = band && t >= ncache;
    const int kbase = (kt_lo + t - ncache) * 64;
    bf16x8 pf[2][2];
#pragma unroll
    for (int nt = 0; nt < 2; ++nt) {
      const int qi = q0 + wave * 32 + nt * 16 + lq;
      float tmax = -1e30f;
#pragma unroll
      for (int mt = 0; mt < 4; ++mt)
#pragma unroll
        for (int r = 0; r < 4; ++r) {
          float s = sacc[mt][nt][r] * 0.125f;
          if (masked_tile) { int kj = kbase + mt * 16 + quad * 4 + r; int dlt = qi - kj; if (dlt > 128 || dlt < -128) s = -1e30f; }
          sacc[mt][nt][r] = s; tmax = fmaxf(tmax, s);
        }
      tmax = fmaxf(tmax, __shfl_xor(tmax, 16, 64)); tmax = fmaxf(tmax, __shfl_xor(tmax, 32, 64));
      const float mnew = fmaxf(mrun[nt], tmax);
      const float alpha = __expf(mrun[nt] - mnew);
      float ps = 0.f;
#pragma unroll
      for (int mt = 0; mt < 4; ++mt)
#pragma unroll
        for (int r = 0; r < 4; ++r) { float e = __expf(sacc[mt][nt][r] - mnew); sacc[mt][nt][r] = e; ps += e; }
      lsum[nt] = lsum[nt] * alpha + ps; mrun[nt] = mnew;
#pragma unroll
      for (int dt = 0; dt < 4; ++dt)
#pragma unroll
        for (int r = 0; r < 4; ++r) oacc[dt][nt][r] *= alpha;
      pf[nt][0] = pack8(sacc[0][nt], sacc[1][nt]);
      pf[nt][1] = pack8(sacc[2][nt], sacc[3][nt]);
    }
#pragma unroll
    for (int dt = 0; dt < 4; ++dt)
#pragma unroll
      for (int s2 = 0; s2 < 2; ++s2) {
        bf16x8 va = ldperm(sVt + (dt * 16 + lq) * 72 + s2 * 32 + quad * 4);
        oacc[dt][0] = MFMA16(va, pf[0][s2], oacc[dt][0]);
        oacc[dt][1] = MFMA16(va, pf[1][s2], oacc[dt][1]);
      }
  }
  u16* BR = (u16*)(p->ws + WS_BRANCH);
#pragma unroll
  for (int nt = 0; nt < 2; ++nt) {
    float lt = lsum[nt]; lt += __shfl_xor(lt, 16, 64); lt += __shfl_xor(lt, 32, 64);
    const float inv = 1.f / lt;
    const size_t row = seqrow0 + q0 + wave * 32 + nt * 16 + lq;
#pragma unroll
    for (int dt = 0; dt < 4; ++dt)
      *(uint2*)(BR + row * 1024 + ocol + dt * 16 + quad * 4) = make_uint2(pack2(oacc[dt][nt][0] * inv, oacc[dt][nt][1] * inv), pack2(oacc[dt][nt][2] * inv, oacc[dt][nt][3] * inv));
  }
  __syncthreads();
}

template <bool FINAL>
DI void lru_item(KP p, int l, int ci, unsigned char* smem) {
  float* sx = (float*)smem;
  u16* shf = (u16*)(smem + 32768);
  const int ch = ltid();
  const int r0 = ci * 32;
  const bool lat = r0 >= 8192;
  int b, T, seqrow0;
  if (!lat) { b = r0 >> 8; T = 256; seqrow0 = b * 256; } else { b = (r0 - 8192) >> 12; T = 4096; seqrow0 = 8192 + b * 4096; }
  const int t0 = r0 - seqrow0;
  const u16* INP = (const u16*)(p->ws + WS_INPROJ);
  {
    const float* cw = p->in[18] + l * 4 * 256;
    const float w0 = cw[ch], w1 = cw[256 + ch], w2 = cw[512 + ch], w3 = cw[768 + ch], cb = p->in[19][l * 256 + ch];
    auto ld = [&](int t) -> float { return (t >= 0 && t < T) ? bf2f(INP[(size_t)(seqrow0 + t) * LDI + C_LX + ch]) : 0.f; };
    float xm2 = ld(t0 - 2), xm1 = ld(t0 - 1), x0 = ld(t0);
    for (int t = 0; t < 32; ++t) {
      float xp1 = ld(t0 + t + 1);
      sx[t * 256 + ch] = xm2 * w0 + xm1 * w1 + x0 * w2 + xp1 * w3 + cb;
      xm2 = xm1; xm1 = x0; x0 = xp1;
    }
  }
  __syncthreads();
  const int n = ch >> 6, d = ch & 63;
  const int nch = T / 32, c = t0 / 32;
  float* LC = (float*)(p->ws + WS_LRUC);
  for (int dir = 0; dir < 2; ++dir) {
    float wr[64], wi[64];
    const float* WR = p->in[20] + ((size_t)((l * 2 + dir) * 4 + n) * 64) * 64 + d;
    const float* WI = p->in[22] + ((size_t)((l * 2 + dir) * 4 + n) * 64) * 64 + d;
#pragma unroll
    for (int cc = 0; cc < 64; ++cc) { wr[cc] = WR[cc * 64]; wi[cc] = WI[cc * 64]; }
    const float br = p->in[21][(l * 2 + dir) * 256 + ch], bi = p->in[23][(l * 2 + dir) * 256 + ch];
    const float sp = softplusf_(-p->in[24][(l * 2 + dir) * 256 + ch]);
    float h = 0.f, aprod = 1.f;
    if (FINAL) {
      h = lat ? p->in[7][((b * 2 + l) * 2 + dir) * 256 + ch] : 0.f;
      if (dir == 0) { for (int cc = 0; cc < c; ++cc) { const float* C = LC + ((size_t)((ci - c + cc) * 2 + dir) * 2) * 256; h = C[ch] * h + C[256 + ch]; } }
      else { for (int cc = nch - 1; cc > c; --cc) { const float* C = LC + ((size_t)((ci - c + cc) * 2 + dir) * 2) * 256; h = C[ch] * h + C[256 + ch]; } }
    }
    for (int st = 0; st < 32; ++st) {
      const int t = dir == 0 ? st : 31 - st;
      const float4* xr = (const float4*)(sx + t * 256 + n * 64);
      float ra = br, ia = bi;
#pragma unroll
      for (int q = 0; q < 16; ++q) {
        float4 xv = xr[q];
        ra += xv.x * wr[4 * q] + xv.y * wr[4 * q + 1] + xv.z * wr[4 * q + 2] + xv.w * wr[4 * q + 3];
        ia += xv.x * wi[4 * q] + xv.y * wi[4 * q + 1] + xv.z * wi[4 * q + 2] + xv.w * wi[4 * q + 3];
        if ((q & 3) == 3) asm volatile("" ::: "memory");
      }
      const float xt = sx[t * 256 + ch];
      const float la = -8.f * sigm(ra) * sp;
      const float a = __expf(la);
      const float bb = sqrtf(-expm1f(2.f * la)) * sigm(ia) * xt;
      h = a * h + bb; aprod *= a;
      if (FINAL) {
        if (dir == 0) shf[t * 256 + ch] = f2bf(h);
        else {
          float hf = bf2f(shf[t * 256 + ch]);
          float g = bf2f(INP[(size_t)(r0 + t) * LDI + C_LG + ch]);
          ((u16*)(p->ws + WS_BRANCH))[(size_t)(r0 + t) * 1024 + 256 + ch] = f2bf((hf + h) * gelu_tanh(g));
        }
      }
    }
    if (!FINAL) { float* C = LC + ((size_t)(ci * 2 + dir) * 2) * 256; C[ch] = aprod; C[256 + ch] = h; }
    else if (!lat) {
      if (dir == 0 && c == nch - 1) p->out[O_LRU + ((size_t)(b * 2 + l) * 2 + 0) * 256 + ch] = h;
      if (dir == 1 && c == 0) p->out[O_LRU + ((size_t)(b * 2 + l) * 2 + 1) * 256 + ch] = h;
    }
  }
  __syncthreads();
}

template <int DIR, bool ISW>
DI void gdn_solve(const float* L, const u16* src, const float* sb_, const float* se_, u16* UW) {
  float sol[64];
#pragma unroll
  for (int i = 0; i < 64; ++i) {
    float s = bf2f(src[(DIR == 0 ? i : 63 - i) * 72]) * sb_[i];
    if (ISW) s *= se_[i];
#pragma unroll
    for (int j4 = 0; j4 < (i + 3) / 4; ++j4) {
      float4 lv = *(const float4*)(L + i * 64 + j4 * 4);
      if (j4 * 4 + 0 < i) s -= lv.x * sol[j4 * 4 + 0];
      if (j4 * 4 + 1 < i) s -= lv.y * sol[j4 * 4 + 1];
      if (j4 * 4 + 2 < i) s -= lv.z * sol[j4 * 4 + 2];
      if (j4 * 4 + 3 < i) s -= lv.w * sol[j4 * 4 + 3];
      if ((j4 & 3) == 3) asm volatile("" ::: "memory");
    }
    sol[i] = s;
    UW[i * 128] = f2bf(s);
    asm volatile("" ::: "memory");
  }
}

DI void gdn1_item(KP p, int l, int item, unsigned char* smem) {
  const int cgi = item >> 2, hd = item & 3;
  u16* sq = (u16*)smem; u16* sk = sq + 64 * 72; u16* sv = sk + 64 * 72;
  float* sL = (float*)(smem + 27648);
  float* sgc = (float*)(smem + 60416);
  float* sbeta = sgc + 128;
  float* sge = sbeta + 128;
  const int tid = ltid(), lane = tid & 63, wave = tid >> 6, lq = lane & 15, quad = lane >> 4;
  const int r0 = cgi * 64;
  const bool lat = r0 >= 8192;
  int T, seqrow0;
  if (!lat) { T = 256; seqrow0 = (r0 >> 8) * 256; } else { T = 4096; seqrow0 = 8192 + ((r0 - 8192) >> 12) * 4096; }
  const int t0 = r0 - seqrow0;
  const u16* INP = (const u16*)(p->ws + WS_INPROJ);
  u16* QHAT = (u16*)(p->ws + WS_QHAT) + (size_t)item * 4096;
  {
    const int d = lane, tb = wave * 16;
#pragma unroll
    for (int mat = 0; mat < 3; ++mat) {
      const int col = C_GQ + mat * 256 + hd * 64 + d, wc = mat * 256 + hd * 64 + d;
      const float* cw = p->in[25] + (size_t)l * 4 * 768;
      const float w0 = cw[wc], w1 = cw[768 + wc], w2 = cw[1536 + wc], w3 = cw[2304 + wc];
      auto ld = [&](int t) -> float { return (t >= 0 && t < T) ? bf2f(INP[(size_t)(seqrow0 + t) * LDI + col]) : 0.f; };
      float xm2 = ld(t0 + tb - 2), xm1 = ld(t0 + tb - 1), x0 = ld(t0 + tb);
      u16* dst = mat == 0 ? sq : (mat == 1 ? sk : sv);
      for (int t = tb; t < tb + 16; ++t) {
        float xp1 = ld(t0 + t + 1);
        float v = siluf_(xm2 * w0 + xm1 * w1 + x0 * w2 + xp1 * w3);
        xm2 = xm1; xm1 = x0; x0 = xp1;
        if (mat < 2) { float ss = wave_sum(v * v); v *= rsqrtf(ss + 1e-6f) * (mat == 0 ? 0.125f : 1.f); }
        u16 hb = f2bf(v);
        dst[t * 72 + d] = hb;
        if (mat == 0) QHAT[t * 64 + d] = hb;
      }
    }
  }
  if (tid < 128) {
    const int dir = tid >> 6, c = tid & 63;
    const int tok = dir == 0 ? c : 63 - c;
    const u16* R = INP + (size_t)(r0 + tok) * LDI;
    const float ga = bf2f(R[C_GA + dir * 4 + hd]), gb = bf2f(R[C_GB + dir * 4 + hd]);
    const float g = -__expf(p->in[26][(l * 2 + dir) * 4 + hd]) * softplusf_(ga + p->in[27][(l * 2 + dir) * 4 + hd]);
    float gc = g;
#pragma unroll
    for (int o = 1; o < 64; o <<= 1) { float tt = __shfl_up(gc, o, 64); if (lane >= o) gc += tt; }
    const float glast = __shfl(gc, 63, 64);
    sgc[dir * 64 + c] = gc; sbeta[dir * 64 + c] = sigm(gb); sge[dir * 64 + c] = __expf(gc);
    float* gv = (float*)(p->ws + WS_GVEC) + (size_t)(item * 2 + dir) * 256;
    gv[c] = __expf(gc); gv[64 + c] = __expf(glast - gc); if (c == 0) gv[128] = __expf(glast);
  }
  __syncthreads();
  {
    const int dk = tid >> 2, c0 = (tid & 3) * 16;
    unsigned w[8];
#pragma unroll
    for (int e = 0; e < 8; ++e) w[e] = (unsigned)sk[(c0 + 2 * e) * 72 + dk] | ((unsigned)sk[(c0 + 2 * e + 1) * 72 + dk] << 16);
    u16* KT = (u16*)(p->ws + WS_KT) + (size_t)item * 4096 + dk * 64 + c0;
    *(u32x4*)KT = mku4(w[0], w[1], w[2], w[3]); *(u32x4*)(KT + 8) = mku4(w[4], w[5], w[6], w[7]);
  }
  {
    const int i0 = wave * 16;
    f32x4 akk[4], aqk[4];
#pragma unroll
    for (int nt = 0; nt < 4; ++nt) { akk[nt] = f32x4{0.f, 0.f, 0.f, 0.f}; aqk[nt] = f32x4{0.f, 0.f, 0.f, 0.f}; }
#pragma unroll
    for (int s = 0; s < 2; ++s) {
      bf16x8 ak = ld8(sk + (i0 + lq) * 72 + s * 32 + quad * 8), aq = ld8(sq + (i0 + lq) * 72 + s * 32 + quad * 8);
#pragma unroll
      for (int nt = 0; nt < 4; ++nt) { bf16x8 bk = ld8(sk + (nt * 16 + lq) * 72 + s * 32 + quad * 8); akk[nt] = MFMA16(ak, bk, akk[nt]); aqk[nt] = MFMA16(aq, bk, aqk[nt]); }
    }
    u16* QKf = (u16*)(p->ws + WS_QK) + (size_t)(item * 2 + 0) * 4096;
    u16* QKb = (u16*)(p->ws + WS_QK) + (size_t)(item * 2 + 1) * 4096;
#pragma unroll
    for (int nt = 0; nt < 4; ++nt)
#pragma unroll
      for (int r = 0; r < 4; ++r) {
        const int i = i0 + quad * 4 + r, j = nt * 16 + lq, ib = 63 - i, jb = 63 - j;
        const float kkv = akk[nt][r], qkv = aqk[nt][r];
        if (j < i) sL[i * 64 + j] = sbeta[i] * kkv * __expf(sgc[i] - sgc[j]);
        if (j > i) sL[4096 + ib * 64 + jb] = sbeta[64 + ib] * kkv * __expf(sgc[64 + ib] - sgc[64 + jb]);
        QKf[i * 64 + j] = f2bf(j <= i ? qkv * __expf(sgc[i] - sgc[j]) : 0.f);
        QKb[ib * 64 + jb] = f2bf(j >= i ? qkv * __expf(sgc[64 + ib] - sgc[64 + jb]) : 0.f);
      }
  }
  __syncthreads();
  {
    const int col = tid & 127;
    u16* UW = (u16*)(p->ws + WS_UW) + (size_t)(item * 2 + (tid >> 7)) * 8192 + col;
    if (tid < 128) { if (col < 64) gdn_solve<0, false>(sL, sv + col, sbeta, sge, UW); else gdn_solve<0, true>(sL, sk + (col - 64), sbeta, sge, UW); }
    else { if (col < 64) gdn_solve<1, false>(sL + 4096, sv + col, sbeta + 64, sge + 64, UW); else gdn_solve<1, true>(sL + 4096, sk + (col - 64), sbeta + 64, sge + 64, UW); }
  }
  __syncthreads();
}

DI void gdn2_item(KP p, int l, int item, unsigned char* smem) {
  u16* sW = (u16*)smem; u16* sQ = sW + 64 * 72; u16* sQK = sQ + 64 * 72; u16* sKT = sQK + 64 * 72; u16* sU = sKT + 64 * 72;
  float* sg = (float*)(smem + 46080);
  const int tid = ltid(), lane = tid & 63, wave = tid >> 6, lq = lane & 15, quad = lane >> 4;
  int b, hd, dir; bool lat;
  if (item < 16) { lat = true; b = item >> 3; hd = (item >> 1) & 3; dir = item & 1; }
  else { lat = false; int r = item - 16; b = r >> 3; hd = (r >> 1) & 3; dir = r & 1; }
  const int nch = lat ? 64 : 4, cg0 = lat ? 128 + b * 64 : b * 4;
  f32x4 st[4];
#pragma unroll
  for (int kt = 0; kt < 4; ++kt)
#pragma unroll
    for (int r = 0; r < 4; ++r)
      st[kt][r] = lat ? p->in[8][((size_t)(((b * 2 + l) * 2 + dir) * 4 + hd) * 64 + kt * 16 + quad * 4 + r) * 64 + wave * 16 + lq] : 0.f;
  const int lrow = tid >> 2, seg = (tid & 3) * 16;
  u32x4 rW[2], rQ[2], rQK[2], rKT[2], rU[2]; float rg = 0.f;
  const u16* UWb = (const u16*)(p->ws + WS_UW); const u16* QHb = (const u16*)(p->ws + WS_QHAT);
  const u16* KTb = (const u16*)(p->ws + WS_KT); u16* QKb = (u16*)(p->ws + WS_QK);
  const float* GV = (const float*)(p->ws + WS_GVEC);
  auto gload = [&](int n) {
    const int cgi = dir == 0 ? cg0 + n : cg0 + nch - 1 - n;
    const size_t prob = (size_t)cgi * 4 + hd, pd = prob * 2 + dir;
    const u16* u = UWb + (pd * 64 + lrow) * 128 + seg;
    rU[0] = *(const u32x4*)u; rU[1] = *(const u32x4*)(u + 8); rW[0] = *(const u32x4*)(u + 64); rW[1] = *(const u32x4*)(u + 72);
    const u16* q = QHb + (prob * 64 + (dir ? 63 - lrow : lrow)) * 64 + seg;
    rQ[0] = *(const u32x4*)q; rQ[1] = *(const u32x4*)(q + 8);
    const u16* qk = QKb + (pd * 64 + lrow) * 64 + seg;
    rQK[0] = *(const u32x4*)qk; rQK[1] = *(const u32x4*)(qk + 8);
    const u16* kt = KTb + (prob * 64 + lrow) * 64 + (dir ? 48 - seg : seg);
    u32x4 a = *(const u32x4*)kt, bb = *(const u32x4*)(kt + 8);
    if (dir) { rKT[0] = rev8(bb); rKT[1] = rev8(a); } else { rKT[0] = a; rKT[1] = bb; }
    rg = GV[pd * 256 + (tid & 255)];
  };
  gload(0);
  for (int n = 0; n < nch; ++n) {
    const int cgi = dir == 0 ? cg0 + n : cg0 + nch - 1 - n;
    const size_t pd = ((size_t)cgi * 4 + hd) * 2 + dir;
    __syncthreads();
    *(u32x4*)(sW + lrow * 72 + seg) = rW[0]; *(u32x4*)(sW + lrow * 72 + seg + 8) = rW[1];
    *(u32x4*)(sQ + lrow * 72 + seg) = rQ[0]; *(u32x4*)(sQ + lrow * 72 + seg + 8) = rQ[1];
    *(u32x4*)(sQK + lrow * 72 + seg) = rQK[0]; *(u32x4*)(sQK + lrow * 72 + seg + 8) = rQK[1];
    *(u32x4*)(sKT + lrow * 72 + seg) = rKT[0]; *(u32x4*)(sKT + lrow * 72 + seg + 8) = rKT[1];
    *(u32x4*)(sU + lrow * 72 + seg) = rU[0]; *(u32x4*)(sU + lrow * 72 + seg + 8) = rU[1];
    sg[tid] = rg;
    __syncthreads();
    if (n + 1 < nch) gload(n + 1);
    const float elast = sg[128];
    bf16x8 sB[2] = {pack8(st[0], st[1]), pack8(st[2], st[3])};
    f32x4 vn[4], oo[4];
#pragma unroll
    for (int mt = 0; mt < 4; ++mt) {
      f32x4 acc = {0.f, 0.f, 0.f, 0.f}, acq = {0.f, 0.f, 0.f, 0.f};
#pragma unroll
      for (int s2 = 0; s2 < 2; ++s2) {
        acc = MFMA16(ldperm(sW + (mt * 16 + lq) * 72 + s2 * 32 + quad * 4), sB[s2], acc);
        acq = MFMA16(ldperm(sQ + (mt * 16 + lq) * 72 + s2 * 32 + quad * 4), sB[s2], acq);
      }
#pragma unroll
      for (int r = 0; r < 4; ++r) {
        const int c = mt * 16 + quad * 4 + r;
        vn[mt][r] = bf2f(sU[c * 72 + wave * 16 + lq]) - acc[r];
        oo[mt][r] = acq[r] * sg[c];
      }
    }
    bf16x8 vB[2] = {pack8(vn[0], vn[1]), pack8(vn[2], vn[3])};
#pragma unroll
    for (int mt = 0; mt < 4; ++mt) {
#pragma unroll
      for (int s2 = 0; s2 < 2; ++s2) oo[mt] = MFMA16(ldperm(sQK + (mt * 16 + lq) * 72 + s2 * 32 + quad * 4), vB[s2], oo[mt]);
    }
    f32x4 vs[4];
#pragma unroll
    for (int mt = 0; mt < 4; ++mt)
#pragma unroll
      for (int r = 0; r < 4; ++r) vs[mt][r] = vn[mt][r] * sg[64 + mt * 16 + quad * 4 + r];
    bf16x8 vsB[2] = {pack8(vs[0], vs[1]), pack8(vs[2], vs[3])};
#pragma unroll
    for (int kt = 0; kt < 4; ++kt) {
      f32x4 acc = {0.f, 0.f, 0.f, 0.f};
#pragma unroll
      for (int s2 = 0; s2 < 2; ++s2) acc = MFMA16(ldperm(sKT + (kt * 16 + lq) * 72 + s2 * 32 + quad * 4), vsB[s2], acc);
#pragma unroll
      for (int r = 0; r < 4; ++r) st[kt][r] = elast * st[kt][r] + acc[r];
    }
    u16* O = QKb + pd * 4096;
#pragma unroll
    for (int mt = 0; mt < 4; ++mt)
#pragma unroll
      for (int r = 0; r < 4; ++r) O[(mt * 16 + quad * 4 + r) * 64 + wave * 16 + lq] = f2bf(oo[mt][r]);
  }
  if (!lat) {
#pragma unroll
    for (int kt = 0; kt < 4; ++kt)
#pragma unroll
      for (int r = 0; r < 4; ++r)
        p->out[O_GDN + ((size_t)(((b * 2 + l) * 2 + dir) * 4 + hd) * 64 + kt * 16 + quad * 4 + r) * 64 + wave * 16 + lq] = st[kt][r];
  }
  __syncthreads();
}

DI void gdnfin_item(KP p, int l, int item) {
  const int cgi = item >> 2, hd = item & 3;
  const int lane = ltid() & 63, wave = ltid() >> 6;
  const u16* Of = (const u16*)(p->ws + WS_QK) + (size_t)(item * 2 + 0) * 4096;
  const u16* Ob = (const u16*)(p->ws + WS_QK) + (size_t)(item * 2 + 1) * 4096;
  const float gn = p->in[28][l * 64 + lane];
  for (int c = wave * 16; c < wave * 16 + 16; ++c) {
    const size_t row = (size_t)cgi * 64 + c;
    float o = bf2f(Of[c * 64 + lane]) + bf2f(Ob[(63 - c) * 64 + lane]);
    float ss = wave_sum(o * o);
    float z = bf2f(((const u16*)(p->ws + WS_INPROJ))[row * LDI + C_GZ + hd * 64 + lane]);
    float y = o * rsqrtf(ss * (1.f / 64.f) + 1e-6f) * gn * siluf_(z);
    ((u16*)(p->ws + WS_BRANCH))[row * 1024 + 512 + hd * 64 + lane] = f2bf(y);
  }
}


#define XB_TMO      128
#define XB_XCNT(j)  (256  + 64 * (j))
#define XB_XSUB(j)  (1280 + 64 * (j))
#define XB_XGEN(j)  (2304 + 64 * (j))
#define XB_TOP      3328
#define XB_TOPGEN   3392
#define XB_SPIN_CAP (1u << 20)
#define LAS __attribute__((address_space(3)))
DI unsigned xb_ld(unsigned* q) { return __hip_atomic_load(q, __ATOMIC_RELAXED, __HIP_MEMORY_SCOPE_AGENT); }
DI unsigned xb_add(unsigned* q, unsigned v) { return __hip_atomic_fetch_add(q, v, __ATOMIC_RELAXED, __HIP_MEMORY_SCOPE_AGENT); }
DI unsigned xb_xcc_id() { return (unsigned)__builtin_amdgcn_s_getreg((3 << 11) | 20) & 0xFu; }
#define XB_SPIN(cond, bar) do { unsigned _sp = 0; while (cond) { __builtin_amdgcn_s_sleep(1); \
    if ((++_sp & 255u) == 0u) { if (xb_ld(&(bar)[XB_TMO])) break; if (_sp > XB_SPIN_CAP) { atomicAdd(&(bar)[XB_TMO], 1u); break; } } } } while (0)
DI void xcd_barrier_complete(unsigned* bar, unsigned x, unsigned& nloc, unsigned& nx) {
  const unsigned G = gridDim.x;
  unsigned sum, cnt, mine, sp = 0u;
  for (;;) {
    sum = 0u; cnt = 0u; mine = 0u;
#pragma unroll
    for (unsigned j = 0; j < 16; ++j) { const unsigned c = xb_ld(&bar[XB_XCNT(j)]); sum += c; cnt += (c > 0u) ? 1u : 0u; mine = (j == x) ? c : mine; }
    if (sum == G) break;
    __builtin_amdgcn_s_sleep(1);
    if ((++sp & 255u) == 0u) { if (xb_ld(&bar[XB_TMO])) break; if (sp > XB_SPIN_CAP) { atomicAdd(&bar[XB_TMO], 1u); break; } }
  }
  nloc = mine > 0u ? mine : 1u; nx = cnt > 0u ? cnt : 1u;
}
DI void xcd_barrier(unsigned* bar, volatile LAS unsigned* st) {
  asm volatile("s_waitcnt vmcnt(0)" ::: "memory");
  __syncthreads();
  if (ltid() == 0) {
    const unsigned x = xb_xcc_id();
    __builtin_amdgcn_s_waitcnt(0);
    unsigned nloc = st[0], nx = st[1];
    if (nloc == 0u) { xcd_barrier_complete(bar, x, nloc, nx); st[0] = nloc; st[1] = nx; }
    const unsigned old = xb_add(&bar[XB_XSUB(x)], 1u);
    const unsigned gen = old / nloc;
    if (old + 1u == (gen + 1u) * nloc) {
      __builtin_amdgcn_fence(__ATOMIC_RELEASE, "agent");
      asm volatile("s_waitcnt vmcnt(0)" ::: "memory");
      const unsigned og = xb_add(&bar[XB_TOP], 1u);
      const unsigned tg = og / nx;
      if (og + 1u == (tg + 1u) * nx) xb_add(&bar[XB_TOPGEN], 1u);
      else XB_SPIN(xb_ld(&bar[XB_TOPGEN]) == tg, bar);
      __builtin_amdgcn_fence(__ATOMIC_ACQUIRE, "agent");
      xb_add(&bar[XB_XGEN(x)], 1u);
      asm volatile("s_waitcnt vmcnt(0)" ::: "memory");
    } else {
      XB_SPIN(xb_ld(&bar[XB_XGEN(x)]) == gen, bar);
      __builtin_amdgcn_fence(__ATOMIC_ACQUIRE, "agent");
      asm volatile("s_waitcnt vmcnt(0)" ::: "memory");
    }
  }
  __syncthreads();
}


#define FOR_TILES(MTI, NTI, SM, SN, CALL)                                                      \
  do {                                                                                         \
    if (G % 8 != 0) { for (int it_ = B; it_ < (MTI) * (NTI); it_ += G) { const int mt = it_ / (NTI), nt = it_ % (NTI); CALL; } } \
    else {                                                                                     \
      const int xcd_ = B & 7, j_ = B >> 3, J_ = G >> 3;                                        \
      const int nsm_ = ((MTI) + (SM) - 1) / (SM), nsn_ = ((NTI) + (SN) - 1) / (SN);            \
      for (int s_ = xcd_; s_ < nsm_ * nsn_; s_ += 8) {                                         \
        const int sm_ = s_ / nsn_, sn_ = s_ % nsn_;                                            \
        for (int t_ = j_; t_ < (SM) * (SN); t_ += J_) {                                        \
          const int mt = sm_ * (SM) + t_ / (SN), nt = sn_ * (SN) + t_ % (SN);                  \
          if (mt < (MTI) && nt < (NTI)) { CALL; }                                              \
        }                                                                                      \
      }                                                                                        \
    }                                                                                          \
  } while (0)

constexpr int NPHASE = 21;
__global__ void __launch_bounds__(256, 2) mk(Params p_unused, int ph_lo, int ph_hi) {
  extern __shared__ __attribute__((aligned(1024))) unsigned char smem[];
  int& s_item = *(int*)(smem + SMEM_BYTES);
  u32x4& xb_words = *(u32x4*)(smem + SMEM_BYTES + 16);
  const int G = gridDim.x, B = blockIdx.x;
  const bool fused = ph_hi - ph_lo > 1;
  if (fused) {
    if (ltid() == 0) { xb_words = u32x4{0u, 0u, 0u, 0u}; (void)xb_add(&((unsigned*)(((KP)__builtin_amdgcn_kernarg_segment_ptr())->ws + WS_BAR))[XB_XCNT(xb_xcc_id())], 1u); }
    __syncthreads();
  }
  for (int ph = ph_lo; ph < ph_hi; ++ph) {
    KP p = (KP)__builtin_amdgcn_kernarg_segment_ptr();
    asm volatile("" : "+s"(p));
    if (ph == 0) {
      for (int it = B; it < 192 + CONV_ITEMS; it += G) { if (it < 192) { if (PHON(0)) mod_item(p, it, smem); } else if (PHON(1)) convert_item(p, 0, it - 192, smem); }
    } else {
      const int l = (ph - 1) / 10, sub = (ph - 1) % 10;
      switch (sub) {
        case 0:
          for (int it = B; it < 4096 + (l ? CONV_ITEMS : 0); it += G) { if (it < 4096) { if (PHON(2)) norm_item<0>(p, l, it); } else if (PHON(1)) convert_item(p, l, it - 4096, smem); }
          break;
        case 1: FOR_TILES(128, 21, 8, 7, inproj_item(p, mt, nt, smem)); break;
        case 2:
          for (int it = B; it < 1024 + 512 + 64 + 4096; it += G) {
            if (it < 1024) { for (int rep = 0; rep < NREP(4); ++rep) gdn1_item(p, l, it, smem); }
            else if (it < 1536) { for (int rep = 0; rep < NREP(5); ++rep) lru_item<false>(p, l, it - 1024, smem); }
            else if (it < 1600) { if (PHON(6)) kvc_item(p, l, it - 1536); }
            else if (PHON(6)) prep_item(p, l, it - 1600);
          }
          break;
        case 3: {
          int* ctr = (int*)(p->ws + WS_CTR) + l;
          for (;;) {
            __syncthreads();
            if (ltid() == 0) s_item = atomicAdd(ctr, 1);
            __syncthreads();
            const int it = s_item;
            if (it >= 16 + 256 + 256 + 256 + 512 + 512) break;
            if (it < 16) { if (PHON(7)) gdn2_item(p, l, it, smem); }
            else if (it < 272) { for (int rep = 0; rep < NREP(8); ++rep) attn_item(p, l, it - 16, smem); }
            else if (it < 528) { if (PHON(7)) gdn2_item(p, l, it - 272 + 16, smem); }
            else if (it < 784) { for (int rep = 0; rep < NREP(8); ++rep) attn_item(p, l, it - 528 + 256, smem); }
            else if (it < 1296) { for (int rep = 0; rep < NREP(9); ++rep) lru_item<true>(p, l, it - 784, smem); }
            else for (int rep = 0; rep < NREP(8); ++rep) attn_item(p, l, it - 1296 + 512, smem);
          }
        } break;
        case 4: for (int it = B; it < 1024; it += G) if (PHON(10)) gdnfin_item(p, l, it); break;
        case 5: FOR_TILES(128, 16, 8, 8, merge_item(p, l, mt, nt, smem)); break;
        case 6: FOR_TILES(128, 8, 8, 8, wout_item(p, l, mt, nt, smem)); break;
        case 7: for (int it = B; it < 4096; it += G) if (PHON(2)) norm_item<1>(p, l, it); break;
        case 8: FOR_TILES(128, 32, 8, 8, w1_item(p, mt, nt, smem)); break;
        case 9: FOR_TILES(128, 8, 8, 8, w2_item(p, l, mt, nt, smem)); break;
      }
    }
    if (ph + 1 < ph_hi) {
      if (ph == ph_lo) cg::this_grid().sync();
      else xcd_barrier((unsigned*)(p->ws + WS_BAR), (volatile LAS unsigned*)&xb_words);
    }
  }
}

extern "C" void kernel_launch(void* const* d_in, const int* in_sizes, int n_in, void* d_out, int out_size, void* d_ws, size_t ws_size, hipStream_t stream) {
  static int grid_blocks = 0;
  if (!grid_blocks) {
    int dev = 0, cus = 0, per_cu = 0;
    (void)hipGetDevice(&dev);
    (void)hipDeviceGetAttribute(&cus, hipDeviceAttributeMultiprocessorCount, dev);
    if (hipFuncSetAttribute((const void*)mk, hipFuncAttributeMaxDynamicSharedMemorySize, DYN_LDS) != hipSuccess) fprintf(stderr, "kernel_launch: hipFuncSetAttribute failed\n");
    (void)hipOccupancyMaxActiveBlocksPerMultiprocessor(&per_cu, mk, 256, DYN_LDS);
    if (per_cu < 1) per_cu = 1;
    if (per_cu > 2) per_cu = 2;
    grid_blocks = cus * per_cu;
    if (ws_size < WS_END) fprintf(stderr, "kernel_launch: workspace too small: %zu < %zu\n", ws_size, (size_t)WS_END);
  }
  if (hipMemsetAsync((char*)d_ws + WS_CTR, 0, 256 + 3456 * 4 + 256, stream) != hipSuccess) fprintf(stderr, "kernel_launch: memset failed\n");
  Params p{};
  for (int i = 0; i < 37; ++i) p.in[i] = (const float*)d_in[i];
  p.out = (float*)d_out; p.ws = (unsigned char*)d_ws;
#if MULTI_LAUNCH
  for (int ph = 0; ph < NPHASE; ++ph) hipLaunchKernelGGL(mk, dim3(grid_blocks), dim3(256), DYN_LDS, stream, p, ph, ph + 1);
#else
  int lo = 0, hi = NPHASE;
  void* args[] = {&p, &lo, &hi};
  hipError_t e = hipLaunchCooperativeKernel((void*)mk, dim3(grid_blocks), dim3(256), args, DYN_LDS, stream);
  if (e != hipSuccess) fprintf(stderr, "cooperative launch failed: %s (grid %d)\n", hipGetErrorString(e), grid_blocks);
#endif
}
```

```cpp
#include <hip/hip_runtime.h>
#include <hip/hip_cooperative_groups.h>
#include <cstdio>
namespace cg = cooperative_groups;

#ifndef MULTI_LAUNCH
#define MULTI_LAUNCH 0
#endif
#ifndef PHM
#define PHM 0xFFFFFFFFu
#endif
#define PHON(b) ((PHM >> (b)) & 1u)
#ifndef DUPM
#define DUPM 0u
#endif
#define NREP(b) (1 + ((DUPM >> (b)) & 1u))

typedef unsigned short u16;
using bf16x8 = __attribute__((ext_vector_type(8))) short;
using f32x4 = __attribute__((ext_vector_type(4))) float;
using u32x4 = __attribute__((ext_vector_type(4))) unsigned;
#define DI __device__ __forceinline__
#define MFMA16(a, b, c) __builtin_amdgcn_mfma_f32_16x16x32_bf16((a), (b), (c), 0, 0, 0)

constexpr int NTOK = 16384;
constexpr int DM = 1024;
constexpr int LDI = 2592;
constexpr int C_AQ = 0, C_AK = 256, C_AV = 384, C_LX = 512, C_LG = 768, C_GQ = 1024, C_GK = 1280, C_GV = 1536, C_GZ = 1792,
              C_DQ = 2048, C_DK = 2304, C_DV = 2432, C_GA = 2560, C_GB = 2568;
constexpr int NIN_PAD = 2688;

constexpr size_t WS_MOD = 0;
constexpr size_t WS_CTR = WS_MOD + 2 * 3 * 6144 * 4;
constexpr size_t WS_BAR = WS_CTR + 256;
constexpr size_t WS_LRUC = WS_BAR + 3456 * 4 + 256;
constexpr size_t WS_KC = WS_LRUC + (size_t)512 * 2 * 2 * 256 * 4;
constexpr size_t WS_GVEC = WS_KC + (size_t)16 * 512 * 64 * 2;
constexpr size_t WS_LRUW = WS_GVEC + (size_t)1024 * 2 * 256 * 4;
constexpr size_t WS_WIN = WS_LRUW + (size_t)256 * 64 * 16;
constexpr size_t WS_WM = WS_WIN + (size_t)NIN_PAD * 1024 * 2;
constexpr size_t WS_WB = WS_WM + (size_t)4096 * 1024 * 2;
constexpr size_t WS_WO = WS_WB + (size_t)4 * 1024 * 256 * 2;
constexpr size_t WS_W1 = WS_WO + (size_t)1024 * 1024 * 2;
constexpr size_t WS_W2 = WS_W1 + (size_t)4096 * 1024 * 2;
constexpr size_t WS_H = WS_W2 + (size_t)1024 * 4096 * 2;
constexpr size_t WS_BIG = WS_H + (size_t)NTOK * 1024 * 2;
constexpr size_t WS_INPROJ = WS_BIG;
constexpr size_t WS_BRANCH = WS_INPROJ + (size_t)NTOK * LDI * 2;
constexpr size_t WS_QHAT = WS_BRANCH + (size_t)NTOK * 1024 * 2;
constexpr size_t WS_KT = WS_QHAT + (size_t)1024 * 4096 * 2;
constexpr size_t WS_UW = WS_KT + (size_t)1024 * 4096 * 2;
constexpr size_t WS_QK = WS_UW + (size_t)1024 * 2 * 8192 * 2;
constexpr size_t WS_END = WS_QK + (size_t)1024 * 2 * 4096 * 2;
constexpr size_t WS_HIDDEN = WS_BIG;
constexpr size_t WS_MERGED = WS_BIG;
static_assert(WS_HIDDEN + (size_t)NTOK * 4096 * 2 <= WS_END, "hidden must fit");
static_assert(WS_END <= (size_t)256 * 1024 * 1024, "workspace budget");

constexpr size_t O_X = 0, O_AK = 16777216, O_AV = 18874368, O_DK = 20971520, O_DV = 23068672, O_LRU = 25165824, O_GDN = 25198592;

struct Params {
  const float* in[37];
  float* out;
  unsigned char* ws;
};

typedef const Params __attribute__((address_space(4)))* KP;
constexpr int SMEM_BYTES = 65536;
constexpr int DYN_LDS = SMEM_BYTES + 64;

DI int ltid() { int t = threadIdx.x; asm volatile("" : "+v"(t)); return t; }
DI u16 f2bf(float x) { unsigned u = __float_as_uint(x); u += 0x7fffu + ((u >> 16) & 1u); return (u16)(u >> 16); }
DI float bf2f(u16 h) { return __uint_as_float(((unsigned)h) << 16); }
DI unsigned pack2(float a, float b) { return (unsigned)f2bf(a) | ((unsigned)f2bf(b) << 16); }
DI float bflo(unsigned u) { return __uint_as_float(u << 16); }
DI float bfhi(unsigned u) { return __uint_as_float(u & 0xffff0000u); }
DI float sigm(float x) { return 1.f / (1.f + __expf(-x)); }
DI float siluf_(float x) { return x / (1.f + __expf(-x)); }
DI float softplusf_(float x) { return x > 20.f ? x : log1pf(__expf(x)); }
DI float gelu_tanh(float x) { float u = 0.7978845608028654f * (x + 0.044715f * x * x * x); float t = 1.f - 2.f / (__expf(2.f * u) + 1.f); return 0.5f * x * (1.f + t); }
DI float wave_sum(float v) {
#pragma unroll
  for (int o = 32; o > 0; o >>= 1) v += __shfl_xor(v, o, 64);
  return v;
}
DI u32x4 mku4(unsigned a, unsigned b, unsigned c, unsigned d) { u32x4 v = {a, b, c, d}; return v; }
DI bf16x8 mk8(unsigned a, unsigned b, unsigned c, unsigned d) { u32x4 v = {a, b, c, d}; return __builtin_bit_cast(bf16x8, v); }
DI bf16x8 pack8(const f32x4& x, const f32x4& y) { return mk8(pack2(x[0], x[1]), pack2(x[2], x[3]), pack2(y[0], y[1]), pack2(y[2], y[3])); }
DI bf16x8 ld8(const u16* p) { return *(const bf16x8*)p; }
DI bf16x8 ldperm(const u16* p) { uint2 a = *(const uint2*)p; uint2 b = *(const uint2*)(p + 16); return mk8(a.x, a.y, b.x, b.y); }
DI int mod_group(int row) { return row < 8192 ? 0 : 1 + ((row - 8192) >> 12); }
DI const float* x_in_row(KP p, int l, int row) {
  if (l == 0) return row < 8192 ? p->in[0] + (size_t)row * DM : p->in[1] + (size_t)(row - 8192) * DM;
  return p->out + (size_t)row * DM;
}
DI unsigned swap16(unsigned u) { return (u >> 16) | (u << 16); }
DI u32x4 rev8(u32x4 v) { return mku4(swap16(v.w), swap16(v.z), swap16(v.y), swap16(v.x)); }

DI void mod_item(KP p, int item, unsigned char* smem) {
  float* sc = (float*)smem;
  float* sr = sc + 3072;
  const int tid = ltid();
  const int l = item / 96, cb = item % 96;
  for (int i = tid; i < 3072; i += 256) {
    int g = i >> 10, k = i & 1023;
    float c = g == 0 ? p->in[9][k] : p->in[2][(g - 1) * 1024 + k];
    sc[i] = siluf_(c);
  }
  __syncthreads();
  const int col = cb * 64 + (tid & 63), kg = tid >> 6;
  const float* W = p->in[10] + (size_t)l * 1024 * 6144;
  float a0 = 0.f, a1 = 0.f, a2 = 0.f;
  for (int k = kg * 256; k < kg * 256 + 256; ++k) {
    float w = W[(size_t)k * 6144 + col];
    a0 += sc[k] * w; a1 += sc[1024 + k] * w; a2 += sc[2048 + k] * w;
  }
  sr[(kg * 3 + 0) * 64 + (tid & 63)] = a0; sr[(kg * 3 + 1) * 64 + (tid & 63)] = a1; sr[(kg * 3 + 2) * 64 + (tid & 63)] = a2;
  __syncthreads();
  if (tid < 192) {
    int g = tid >> 6, cc = tid & 63;
    float s = p->in[11][l * 6144 + cb * 64 + cc];
    for (int q = 0; q < 4; ++q) s += sr[(q * 3 + g) * 64 + cc];
    ((float*)(p->ws + WS_MOD))[(l * 3 + g) * 6144 + cb * 64 + cc] = s;
  }
  __syncthreads();
}

DI void conv_tile(const float* src, int N, int k0, int n0, u16* dst, int K, bool perm, unsigned char* smem) {
  float* tile = (float*)smem;
  const int tid = ltid();
#pragma unroll
  for (int i = 0; i < 4; ++i) {
    int kr = (tid >> 4) + 16 * i, nc = (tid & 15) * 4;
    float4 v = make_float4(0.f, 0.f, 0.f, 0.f);
    if (n0 + nc < N) v = *(const float4*)(src + (size_t)(k0 + kr) * N + n0 + nc);
    tile[kr * 65 + nc] = v.x; tile[kr * 65 + nc + 1] = v.y; tile[kr * 65 + nc + 2] = v.z; tile[kr * 65 + nc + 3] = v.w;
  }
  __syncthreads();
#pragma unroll
  for (int i = 0; i < 2; ++i) {
    int n = (tid >> 3) + 32 * i, k8 = (tid & 7) * 8;
    int ng = n0 + n;
    if (ng < N) {
      int row = ng;
      if (perm) row = ng < 2048 ? ng : (ng < 2064 ? 2560 + (ng - 2048) : ng - 16);
      u32x4 o;
      o.x = pack2(tile[(k8 + 0) * 65 + n], tile[(k8 + 1) * 65 + n]);
      o.y = pack2(tile[(k8 + 2) * 65 + n], tile[(k8 + 3) * 65 + n]);
      o.z = pack2(tile[(k8 + 4) * 65 + n], tile[(k8 + 5) * 65 + n]);
      o.w = pack2(tile[(k8 + 6) * 65 + n], tile[(k8 + 7) * 65 + n]);
      *(u32x4*)(dst + (size_t)row * K + k0 + k8) = o;
    }
  }
  __syncthreads();
}

constexpr int CONV_ITEMS = 4241;
DI void convert_item(KP p, int l, int item, unsigned char* smem) {
  unsigned char* ws = p->ws;
  if (item < 656) { int kt = item / 41, nt = item % 41; conv_tile(p->in[14] + (size_t)l * 1024 * 2576, 2576, kt * 64, nt * 64, (u16*)(ws + WS_WIN), 1024, true, smem); return; }
  item -= 656;
  if (item < 1024) { int kt = item >> 6, nt = item & 63; conv_tile(p->in[32] + (size_t)l * 1024 * 4096, 4096, kt * 64, nt * 64, (u16*)(ws + WS_WM), 1024, false, smem); return; }
  item -= 1024;
  if (item < 256) { int m = item >> 6, r = item & 63, kt = r >> 4, nt = r & 15;
    conv_tile(p->in[31] + ((size_t)l * 4 + m) * 256 * 1024, 1024, kt * 64, nt * 64, (u16*)(ws + WS_WB) + (size_t)m * 1024 * 256, 256, false, smem); return; }
  item -= 256;
  if (item < 256) { int kt = item >> 4, nt = item & 15; conv_tile(p->in[34] + (size_t)l * 1024 * 1024, 1024, kt * 64, nt * 64, (u16*)(ws + WS_WO), 1024, false, smem); return; }
  item -= 256;
  if (item < 1024) { int kt = item >> 6, nt = item & 63; conv_tile(p->in[35] + (size_t)l * 1024 * 4096, 4096, kt * 64, nt * 64, (u16*)(ws + WS_W1), 1024, false, smem); return; }
  item -= 1024;
  if (item < 1024) { int kt = item >> 4, nt = item & 15; conv_tile(p->in[36] + (size_t)l * 4096 * 1024, 1024, kt * 64, nt * 64, (u16*)(ws + WS_W2), 4096, false, smem); return; }
  u32x4* z = (u32x4*)((u16*)(ws + WS_WIN) + (size_t)2576 * 1024);
  for (int i = ltid(); i < 112 * 1024 / 8; i += 256) z[i] = mku4(0, 0, 0, 0);
}

DI void lruw_item(KP p, int item) {
  const int gid = item * 256 + ltid();
  const int lane = gid & 63, fg = gid >> 6;
  const int s2 = fg & 1, j = (fg >> 1) & 3, n = (fg >> 3) & 3, g = (fg >> 5) & 1, ld_ = fg >> 6;
  const int lq = lane & 15, quad = lane >> 4;
  const float* W = (g == 0 ? p->in[20] : p->in[22]) + ((size_t)(ld_ * 4 + n) * 64) * 64 + (size_t)(s2 * 32 + quad * 8) * 64 + j * 16 + lq;
  u32x4 o = {pack2(W[0], W[64]), pack2(W[128], W[192]), pack2(W[256], W[320]), pack2(W[384], W[448])};
  ((u32x4*)(p->ws + WS_LRUW))[gid] = o;
}

template <int which>
DI void norm_item(KP p, int l, int item) {
  const int lane = ltid() & 63, wave = ltid() >> 6;
  const int row = item * 4 + wave;
  const float* x = x_in_row(p, which == 0 ? l : 2, row);
  const float* g = p->in[which == 0 ? 12 : 13] + l * 1024;
  const float* mod = (const float*)(p->ws + WS_MOD) + (l * 3 + mod_group(row)) * 6144;
  const float* sh = mod + (which == 0 ? 0 : 3072);
  const float* sc = mod + (which == 0 ? 1024 : 4096);
  f32x4 v[4]; float ss = 0.f;
#pragma unroll
  for (int i = 0; i < 4; ++i) { v[i] = *(const f32x4*)(x + i * 256 + lane * 4); ss += v[i].x * v[i].x + v[i].y * v[i].y + v[i].z * v[i].z + v[i].w * v[i].w; }
  ss = wave_sum(ss);
  const float rstd = rsqrtf(ss * (1.f / 1024.f) + 1e-6f);
  u16* H = (u16*)(p->ws + WS_H) + (size_t)row * 1024;
#pragma unroll
  for (int i = 0; i < 4; ++i) {
    int c = i * 256 + lane * 4;
    float4 gg = *(const float4*)(g + c), s1 = *(const float4*)(sc + c), s0 = *(const float4*)(sh + c);
    float y0 = v[i].x * rstd * gg.x * (1.f + s1.x) + s0.x, y1 = v[i].y * rstd * gg.y * (1.f + s1.y) + s0.y;
    float y2 = v[i].z * rstd * gg.z * (1.f + s1.z) + s0.z, y3 = v[i].w * rstd * gg.w * (1.f + s1.w) + s0.w;
    *(uint2*)(H + c) = make_uint2(pack2(y0, y1), pack2(y2, y3));
  }
}

DI int lds_byte(int r, int c) {
  int st = (r >> 4) * 2 + (c >> 5), ob = (r & 15) * 64 + (c & 31) * 2;
  return st * 1024 + (ob ^ (((ob >> 9) & 1) << 5));
}
DI void stage_rc(int b, int& R, int& C) {
  int st = b >> 10, sb = b & 1023, swz = sb ^ (((sb >> 9) & 1) << 5);
  R = (st >> 1) * 16 + (swz >> 6);
  C = (st & 1) * 32 + ((swz & 63) >> 1);
}
template <int MT, int NT>
DI void gemm_acc(f32x4 (&acc)[MT][NT], const u16* __restrict__ A, int lda, const u16* __restrict__ Bt, int ldb, int K, unsigned char* smem) {
  constexpr int TA = MT * 32 * 128, TB = NT * 32 * 128, STAGE = TA + TB;
  static_assert(2 * STAGE <= 65536, "LDS");
  const int tid = ltid(), lane = tid & 63, wid = tid >> 6, wm = wid >> 1, wn = wid & 1;
  const int fr = lane & 15, fq = lane >> 4;
  const u16* ga[MT]; const u16* gb[NT];
#pragma unroll
  for (int i = 0; i < MT; ++i) { int R, C; stage_rc(wid * 1024 + i * 4096 + lane * 16, R, C); ga[i] = A + (size_t)R * lda + C; }
#pragma unroll
  for (int i = 0; i < NT; ++i) { int R, C; stage_rc(wid * 1024 + i * 4096 + lane * 16, R, C); gb[i] = Bt + (size_t)R * ldb + C; }
#define GLDS_STAGE(buf, k0)                                                                                                        \
  do {                                                                                                                             \
    _Pragma("unroll") for (int i = 0; i < MT; ++i)                                                                                 \
      __builtin_amdgcn_global_load_lds((const unsigned*)(ga[i] + (k0)), (unsigned*)(smem + (buf) * STAGE + wid * 1024 + i * 4096), 16, 0, 0); \
    _Pragma("unroll") for (int i = 0; i < NT; ++i)                                                                                 \
      __builtin_amdgcn_global_load_lds((const unsigned*)(gb[i] + (k0)), (unsigned*)(smem + (buf) * STAGE + TA + wid * 1024 + i * 4096), 16, 0, 0); \
  } while (0)
  __syncthreads();
  GLDS_STAGE(0, 0);
  asm volatile("s_waitcnt vmcnt(0)" ::: "memory");
  __syncthreads();
  const int nt = K >> 6;
  for (int t = 0; t < nt; ++t) {
    const int cur = t & 1;
    if (t + 1 < nt) GLDS_STAGE(cur ^ 1, (t + 1) * 64);
    const unsigned char* sA = smem + cur * STAGE;
    const unsigned char* sB = sA + TA;
#pragma unroll
    for (int s = 0; s < 2; ++s) {
      bf16x8 bfr[NT];
#pragma unroll
      for (int j = 0; j < NT; ++j) bfr[j] = *(const bf16x8*)(sB + lds_byte(wn * NT * 16 + j * 16 + fr, s * 32 + fq * 8));
#pragma unroll
      for (int i = 0; i < MT; ++i) {
        bf16x8 af = *(const bf16x8*)(sA + lds_byte(wm * MT * 16 + i * 16 + fr, s * 32 + fq * 8));
#pragma unroll
        for (int j = 0; j < NT; ++j) acc[i][j] = MFMA16(af, bfr[j], acc[i][j]);
      }
    }
    asm volatile("s_waitcnt vmcnt(0)" ::: "memory");
    __syncthreads();
  }
#undef GLDS_STAGE
}

template <int MT, int NT> DI void zero_acc(f32x4 (&acc)[MT][NT]) {
#pragma unroll
  for (int i = 0; i < MT; ++i)
#pragma unroll
    for (int j = 0; j < NT; ++j) acc[i][j] = f32x4{0.f, 0.f, 0.f, 0.f};
}

#define EPI_LOOP(MT, NT)                                                          \
  const int tid_ = ltid(), lane_ = tid_ & 63, wave_ = tid_ >> 6;                   \
  const int wm_ = wave_ >> 1, wn_ = wave_ & 1, lq_ = lane_ & 15, quad_ = lane_ >> 4; \
  _Pragma("unroll") for (int i = 0; i < MT; ++i)                                   \
  _Pragma("unroll") for (int j = 0; j < NT; ++j)                                   \
  _Pragma("unroll") for (int r = 0; r < 4; ++r)
#define EPI_ROW(m0, MT) ((m0) + wm_ * (MT) * 16 + i * 16 + quad_ * 4 + r)
#define EPI_COL(n0, NT) ((n0) + wn_ * (NT) * 16 + j * 16 + lq_)

constexpr int GMT = 4;
DI void inproj_item(KP p, int mt, int nt, unsigned char* smem) {
  const int m0 = mt * (GMT * 32), n0 = nt * 128;
  f32x4 acc[GMT][4]; zero_acc<GMT, 4>(acc);
  gemm_acc<GMT, 4>(acc, (const u16*)(p->ws + WS_H) + (size_t)m0 * 1024, 1024, (const u16*)(p->ws + WS_WIN) + (size_t)n0 * 1024, 1024, 1024, smem);
  u16* C = (u16*)(p->ws + WS_INPROJ);
  EPI_LOOP(GMT, 4) { int row = EPI_ROW(m0, GMT), col = EPI_COL(n0, 4); if (col < LDI) C[(size_t)row * LDI + col] = f2bf(acc[i][j][r]); }
}

DI void merge_item(KP p, int l, int mt, int nt, unsigned char* smem) {
  const int m0 = mt * 128, n0 = nt * 64;
  const u16* H = (const u16*)(p->ws + WS_H) + (size_t)m0 * 1024;
  const u16* BR = (const u16*)(p->ws + WS_BRANCH) + (size_t)m0 * 1024;
  const float* bm = p->in[33] + l * 4096;
  f32x4 accm[4][2]; zero_acc<4, 2>(accm);
  for (int m = 0; m < 4; ++m) {
    f32x4 ag[4][2], ap[4][2]; zero_acc<4, 2>(ag); zero_acc<4, 2>(ap);
    gemm_acc<4, 2>(ag, H, 1024, (const u16*)(p->ws + WS_WM) + (size_t)(m * 1024 + n0) * 1024, 1024, 1024, smem);
    gemm_acc<4, 2>(ap, BR + m * 256, 1024, (const u16*)(p->ws + WS_WB) + (size_t)(m * 1024 + n0) * 256, 256, 256, smem);
    EPI_LOOP(4, 2) { int col = EPI_COL(n0, 2); accm[i][j][r] += sigm(ag[i][j][r] + bm[m * 1024 + col]) * ap[i][j][r]; }
  }
  u16* C = (u16*)(p->ws + WS_MERGED);
  EPI_LOOP(4, 2) { int row = EPI_ROW(m0, 4), col = EPI_COL(n0, 2); C[(size_t)row * 1024 + col] = f2bf(accm[i][j][r]); }
}

DI void wout_item(KP p, int l, int mt, int nt, unsigned char* smem) {
  const int m0 = mt * (GMT * 32), n0 = nt * 128;
  f32x4 acc[GMT][4]; zero_acc<GMT, 4>(acc);
  gemm_acc<GMT, 4>(acc, (const u16*)(p->ws + WS_MERGED) + (size_t)m0 * 1024, 1024, (const u16*)(p->ws + WS_WO) + (size_t)n0 * 1024, 1024, 1024, smem);
  const float* g1 = (const float*)(p->ws + WS_MOD) + (l * 3 + mod_group(m0)) * 6144 + 2048;
  EPI_LOOP(GMT, 4) { int row = EPI_ROW(m0, GMT), col = EPI_COL(n0, 4); p->out[(size_t)row * DM + col] = x_in_row(p, l, row)[col] + g1[col] * acc[i][j][r]; }
}

DI void w1_item(KP p, int mt, int nt, unsigned char* smem) {
  const int m0 = mt * (GMT * 32), n0 = nt * 128;
  f32x4 acc[GMT][4]; zero_acc<GMT, 4>(acc);
  gemm_acc<GMT, 4>(acc, (const u16*)(p->ws + WS_H) + (size_t)m0 * 1024, 1024, (const u16*)(p->ws + WS_W1) + (size_t)n0 * 1024, 1024, 1024, smem);
  u16* C = (u16*)(p->ws + WS_HIDDEN);
  EPI_LOOP(GMT, 4) { int row = EPI_ROW(m0, GMT), col = EPI_COL(n0, 4); float v = fmaxf(acc[i][j][r], 0.f); C[(size_t)row * 4096 + col] = f2bf(v * v); }
}

DI void w2_item(KP p, int l, int mt, int nt, unsigned char* smem) {
  const int m0 = mt * (GMT * 32), n0 = nt * 128;
  f32x4 acc[GMT][4]; zero_acc<GMT, 4>(acc);
  gemm_acc<GMT, 4>(acc, (const u16*)(p->ws + WS_HIDDEN) + (size_t)m0 * 4096, 4096, (const u16*)(p->ws + WS_W2) + (size_t)n0 * 4096, 4096, 4096, smem);
  const float* g2 = (const float*)(p->ws + WS_MOD) + (l * 3 + mod_group(m0)) * 6144 + 5120;
  EPI_LOOP(GMT, 4) { int row = EPI_ROW(m0, GMT), col = EPI_COL(n0, 4); float* o = p->out + (size_t)row * DM + col; *o = *o + g2[col] * acc[i][j][r]; }
}

DI void prep_item(KP p, int l, int item) {
  const int lane = ltid() & 63, wave = ltid() >> 6;
  const int row = item * 4 + wave;
  const bool lat = row >= 8192;
  u16* R = (u16*)(p->ws + WS_INPROJ) + (size_t)row * LDI;
  float cs = 1.f, sn = 0.f;
  if (lat) {
    int t = (row - 8192) & 4095;
    int pos = (lane < 32) ? (t >> 6) : (t & 63);
    float inv = __expf(-(float)(lane & 15) * (9.210340371976184f / 16.f));
    float ang = (float)pos * inv;
    cs = __cosf(ang); sn = __sinf(ang);
  }
  const int b = row >> 8, t = row & 255;
  float hv[12], vv4[4];
#pragma unroll
  for (int hh = 0; hh < 12; ++hh) {
    const int col = hh < 4 ? C_AQ + hh * 64 : (hh < 6 ? C_AK + (hh - 4) * 64 : (hh < 10 ? C_DQ + (hh - 6) * 64 : C_DK + (hh - 10) * 64));
    hv[hh] = bf2f(R[col + lane]);
  }
  vv4[0] = bf2f(R[C_AV + lane]); vv4[1] = bf2f(R[C_AV + 64 + lane]); vv4[2] = bf2f(R[C_DV + lane]); vv4[3] = bf2f(R[C_DV + 64 + lane]);
#pragma unroll
  for (int hh = 0; hh < 12; ++hh) {
    int col; const float* g;
    if (hh < 4) { col = C_AQ + hh * 64; g = p->in[15] + l * 64; }
    else if (hh < 6) { col = C_AK + (hh - 4) * 64; g = p->in[16] + l * 64; }
    else if (hh < 10) { col = C_DQ + (hh - 6) * 64; g = p->in[29] + l * 64; }
    else { col = C_DK + (hh - 10) * 64; g = p->in[30] + l * 64; }
    float v = hv[hh];
    float ss = wave_sum(v * v);
    float y = v * rsqrtf(ss * (1.f / 64.f) + 1e-6f) * g[lane];
    if (lat) {
      float yp = __shfl_xor(y, 16, 64);
      y = ((lane & 31) < 16) ? (y * cs - yp * sn) : (y * cs + yp * sn);
    } else {
      if (hh == 4 || hh == 5) p->out[O_AK + ((size_t)(b * 2 + l) * 256 + t) * 128 + (hh - 4) * 64 + lane] = y;
      if (hh >= 10) p->out[O_DK + ((size_t)(b * 2 + l) * 256 + t) * 128 + (hh - 10) * 64 + lane] = y;
    }
    R[col + lane] = f2bf(y);
  }
  if (!lat) {
    size_t o = ((size_t)(b * 2 + l) * 256 + t) * 128;
    p->out[O_AV + o + lane] = vv4[0]; p->out[O_AV + o + 64 + lane] = vv4[1];
    p->out[O_DV + o + lane] = vv4[2]; p->out[O_DV + o + 64 + lane] = vv4[3];
  }
}

DI void kvc_item(KP p, int l, int item) {
  u16* KC = (u16*)(p->ws + WS_KC);
#pragma unroll
  for (int it = 0; it < 8; ++it) {
    int idx4 = item * 2048 + it * 256 + ltid();
    int e = idx4 * 4;
    int d = e & 63, key = (e >> 6) & 511, sel = e >> 15;
    int kv = sel & 1, kvh = (sel >> 1) & 1, b = (sel >> 2) & 1, mixer = sel >> 3;
    const float* srcb = mixer ? (kv ? p->in[6] : p->in[5]) : (kv ? p->in[4] : p->in[3]);
    const float* src = srcb + ((size_t)((b * 2 + l) * 512 + key) * 2 + kvh) * 64 + d;
    float4 v = *(const float4*)src;
    *(uint2*)(KC + e) = make_uint2(pack2(v.x, v.y), pack2(v.z, v.w));
  }
}

DI void attn_item(KP p, int l, int it, unsigned char* smem) {
  u16* sK = (u16*)smem;
  u16* sVt = sK + 64 * 72;
  const int tid = ltid(), lane = tid & 63, wave = tid >> 6, lq = lane & 15, quad = lane >> 4;
  int kind, b, qh, qb;
  if (it < 512) { kind = it >> 8; int r = it & 255; b = r >> 7; qh = (r >> 5) & 3; qb = r & 31; }
  else { int r = it - 512; kind = 2 + (r >> 8); r &= 255; b = r >> 3; qh = (r >> 1) & 3; qb = r & 1; }
  const bool isD = (kind == 0 || kind == 3), lat = kind < 2;
  const int seqrow0 = lat ? 8192 + b * 4096 : b * 256;
  const int q0 = qb * 128, kvh = qh >> 1;
  const int qcol = (isD ? C_DQ : C_AQ) + qh * 64, kcol = (isD ? C_DK : C_AK) + kvh * 64, vcol = (isD ? C_DV : C_AV) + kvh * 64;
  const int ocol = (isD ? 768 : 0) + qh * 64;
  const int ncache = lat ? 8 : 0;
  int kt_lo = 0, kt_hi = lat ? 64 : 4;
  if (kind == 1) { kt_lo = max(0, 2 * qb - 2); kt_hi = min(64, 2 * qb + 4); }
  const int ntiles = ncache + kt_hi - kt_lo;
  const bool band = (kind == 1);
  const u16* INP = (const u16*)(p->ws + WS_INPROJ);
  const u16* KCk = (const u16*)(p->ws + WS_KC) + (size_t)((((isD ? 1 : 0) * 2 + b) * 2 + kvh) * 2) * 512 * 64;
  const u16* KCv = KCk + 512 * 64;
  const float sinkv = isD ? -1e30f : p->in[17][l * 4 + qh];

  bf16x8 qf[2][2];
#pragma unroll
  for (int nt = 0; nt < 2; ++nt)
#pragma unroll
    for (int s = 0; s < 2; ++s) qf[nt][s] = ld8(INP + (size_t)(seqrow0 + q0 + wave * 32 + nt * 16 + lq) * LDI + qcol + s * 32 + quad * 8);
  float mrun[2], lsum[2];
  f32x4 oacc[4][2];
#pragma unroll
  for (int nt = 0; nt < 2; ++nt) { mrun[nt] = sinkv; lsum[nt] = (!isD && quad == 0) ? 1.f : 0.f; }
#pragma unroll
  for (int dt = 0; dt < 4; ++dt)
#pragma unroll
    for (int nt = 0; nt < 2; ++nt) oacc[dt][nt] = f32x4{0.f, 0.f, 0.f, 0.f};

  const int key = tid >> 2, seg = (tid & 3) * 16;
  u32x4 rk[2], rv[2];
  auto tile_ptrs = [&](int t, const u16*& kp, const u16*& vp) {
    if (t < ncache) { kp = KCk + (size_t)(t * 64 + key) * 64 + seg; vp = KCv + (size_t)(t * 64 + key) * 64 + seg; }
    else { const u16* rowp = INP + (size_t)(seqrow0 + (kt_lo + t - ncache) * 64 + key) * LDI; kp = rowp + kcol + seg; vp = rowp + vcol + seg; }
  };
  { const u16 *kp, *vp; tile_ptrs(0, kp, vp); rk[0] = *(const u32x4*)kp; rk[1] = *(const u32x4*)(kp + 8); rv[0] = *(const u32x4*)vp; rv[1] = *(const u32x4*)(vp + 8); }
  for (int t = 0; t < ntiles; ++t) {
    __syncthreads();
    *(u32x4*)(sK + key * 72 + seg) = rk[0]; *(u32x4*)(sK + key * 72 + seg + 8) = rk[1];
    {
      unsigned vv[8] = {rv[0].x, rv[0].y, rv[0].z, rv[0].w, rv[1].x, rv[1].y, rv[1].z, rv[1].w};
#pragma unroll
      for (int e = 0; e < 8; ++e) { sVt[(seg + 2 * e) * 72 + key] = (u16)(vv[e] & 0xffffu); sVt[(seg + 2 * e + 1) * 72 + key] = (u16)(vv[e] >> 16); }
    }
    __syncthreads();
    if (t + 1 < ntiles) { const u16 *kp, *vp; tile_ptrs(t + 1, kp, vp); rk[0] = *(const u32x4*)kp; rk[1] = *(const u32x4*)(kp + 8); rv[0] = *(const u32x4*)vp; rv[1] = *(const u32x4*)(vp + 8); }
    f32x4 sacc[4][2];
#pragma unroll
    for (int mt = 0; mt < 4; ++mt) {
      sacc[mt][0] = f32x4{0.f, 0.f, 0.f, 0.f}; sacc[mt][1] = f32x4{0.f, 0.f, 0.f, 0.f};
#pragma unroll
      for (int s = 0; s < 2; ++s) {
        bf16x8 ka = ld8(sK + (mt * 16 + lq) * 72 + s * 32 + quad * 8);
        sacc[mt][0] = MFMA16(ka, qf[0][s], sacc[mt][0]);
        sacc[mt][1] = MFMA16(ka, qf[1][s], sacc[mt][1]);
      }
    }
    const bool masked_tile = band && t >= ncache;
    const int kbase = (kt_lo + t - ncache) * 64;
    bf16x8 pf[2][2];
#pragma unroll
    for (int nt = 0; nt < 2; ++nt) {
      const int qi = q0 + wave * 32 + nt * 16 + lq;
      float tmax = -1e30f;
#pragma unroll
      for (int mt = 0; mt < 4; ++mt)
#pragma unroll
        for (int r = 0; r < 4; ++r) {
          float s = sacc[mt][nt][r] * 0.125f;
          if (masked_tile) { int kj = kbase + mt * 16 + quad * 4 + r; int dlt = qi - kj; if (dlt > 128 || dlt < -128) s = -1e30f; }
          sacc[mt][nt][r] = s; tmax = fmaxf(tmax, s);
        }
      tmax = fmaxf(tmax, __shfl_xor(tmax, 16, 64)); tmax = fmaxf(tmax, __shfl_xor(tmax, 32, 64));
      const float mnew = fmaxf(mrun[nt], tmax);
      const float alpha = __expf(mrun[nt] - mnew);
      float ps = 0.f;
#pragma unroll
      for (int mt = 0; mt < 4; ++mt)
#pragma unroll
        for (int r = 0; r < 4; ++r) { float e = __expf(sacc[mt][nt][r] - mnew); sacc[mt][nt][r] = e; ps += e; }
      lsum[nt] = lsum[nt] * alpha + ps; mrun[nt] = mnew;
#pragma unroll
      for (int dt = 0; dt < 4; ++dt)
#pragma unroll
        for (int r = 0; r < 4; ++r) oacc[dt][nt][r] *= alpha;
      pf[nt][0] = pack8(sacc[0][nt], sacc[1][nt]);
      pf[nt][1] = pack8(sacc[2][nt], sacc[3][nt]);
    }
#pragma unroll
    for (int dt = 0; dt < 4; ++dt)
#pragma unroll
      for (int s2 = 0; s2 < 2; ++s2) {
        bf16x8 va = ldperm(sVt + (dt * 16 + lq) * 72 + s2 * 32 + quad * 4);
        oacc[dt][0] = MFMA16(va, pf[0][s2], oacc[dt][0]);
        oacc[dt][1] = MFMA16(va, pf[1][s2], oacc[dt][1]);
      }
  }
  u16* BR = (u16*)(p->ws + WS_BRANCH);
#pragma unroll
  for (int nt = 0; nt < 2; ++nt) {
    float lt = lsum[nt]; lt += __shfl_xor(lt, 16, 64); lt += __shfl_xor(lt, 32, 64);
    const float inv = 1.f / lt;
    const size_t row = seqrow0 + q0 + wave * 32 + nt * 16 + lq;
#pragma unroll
    for (int dt = 0; dt < 4; ++dt)
      *(uint2*)(BR + row * 1024 + ocol + dt * 16 + quad * 4) = make_uint2(pack2(oacc[dt][nt][0] * inv, oacc[dt][nt][1] * inv), pack2(oacc[dt][nt][2] * inv, oacc[dt][nt][3] * inv));
  }
  __syncthreads();
}

DI int lru_xoff(int t, int c) { return t * 256 + (c ^ ((t & 7) << 3)); }
template <bool FINAL>
DI void lru_item(KP p, int l, int ci, unsigned char* smem) {
  u16* sxb = (u16*)smem;
  u16* sla = sxb + 32 * 256;
  u16* sbv = sla + 32 * 256;
  u16* shf = sbv + 32 * 256;
  const int tid = ltid(), ch = tid, lane = tid & 63, n = tid >> 6, lq = lane & 15, quad = lane >> 4;
  const int r0 = ci * 32;
  const bool lat = r0 >= 8192;
  int b, T, seqrow0;
  if (!lat) { b = r0 >> 8; T = 256; seqrow0 = b * 256; } else { b = (r0 - 8192) >> 12; T = 4096; seqrow0 = 8192 + b * 4096; }
  const int t0 = r0 - seqrow0;
  const u16* INP = (const u16*)(p->ws + WS_INPROJ);
  __syncthreads();
  {
    const float* cw = p->in[18] + l * 4 * 256;
    const float w0 = cw[ch], w1 = cw[256 + ch], w2 = cw[512 + ch], w3 = cw[768 + ch], cb = p->in[19][l * 256 + ch];
    auto ld = [&](int t) -> float { return (t >= 0 && t < T) ? bf2f(INP[(size_t)(seqrow0 + t) * LDI + C_LX + ch]) : 0.f; };
    float xin[35];
#pragma unroll
    for (int q = 0; q < 35; ++q) xin[q] = ld(t0 - 2 + q);
#pragma unroll
    for (int t = 0; t < 32; ++t) sxb[lru_xoff(t, ch)] = f2bf(xin[t] * w0 + xin[t + 1] * w1 + xin[t + 2] * w2 + xin[t + 3] * w3 + cb);
  }
  __syncthreads();
  const int nch = T / 32, c = t0 / 32;
  float* LC = (float*)(p->ws + WS_LRUC);
  bf16x8 af[2][2];
#pragma unroll
  for (int mt = 0; mt < 2; ++mt)
#pragma unroll
    for (int s2 = 0; s2 < 2; ++s2) af[mt][s2] = ld8(sxb + lru_xoff(mt * 16 + lq, n * 64 + s2 * 32 + quad * 8));
  for (int dir = 0; dir < 2; ++dir) {
    bf16x8 wf[2][4][2];
    {
      const u32x4* WF = (const u32x4*)(p->ws + WS_LRUW);
#pragma unroll
      for (int g = 0; g < 2; ++g)
#pragma unroll
        for (int j = 0; j < 4; ++j)
#pragma unroll
          for (int s2 = 0; s2 < 2; ++s2)
            wf[g][j][s2] = __builtin_bit_cast(bf16x8, WF[(size_t)((((((l * 2 + dir) * 2 + g) * 4 + n) * 4 + j) * 2 + s2)) * 64 + lane]);
    }
#pragma unroll
    for (int j = 0; j < 4; ++j) {
      f32x4 acc[2][2];
#pragma unroll
      for (int g = 0; g < 2; ++g) {
        f32x4 a0 = {0.f, 0.f, 0.f, 0.f}, a1 = {0.f, 0.f, 0.f, 0.f};
#pragma unroll
        for (int s2 = 0; s2 < 2; ++s2) { a0 = MFMA16(af[0][s2], wf[g][j][s2], a0); a1 = MFMA16(af[1][s2], wf[g][j][s2], a1); }
        acc[g][0] = a0; acc[g][1] = a1;
      }
      const int cc = n * 64 + j * 16 + lq;
      const float br = p->in[21][(l * 2 + dir) * 256 + cc], bi = p->in[23][(l * 2 + dir) * 256 + cc];
      const float sp = softplusf_(-p->in[24][(l * 2 + dir) * 256 + cc]);
#pragma unroll
      for (int mt = 0; mt < 2; ++mt)
#pragma unroll
        for (int r = 0; r < 4; ++r) {
          const int t = mt * 16 + quad * 4 + r;
          const float la = -8.f * sigm(acc[0][mt][r] + br) * sp;
          const float xt = bf2f(sxb[lru_xoff(t, cc)]);
          const float bb = sqrtf(-expm1f(2.f * la)) * sigm(acc[1][mt][r] + bi) * xt;
          sla[t * 256 + cc] = f2bf(la); sbv[t * 256 + cc] = f2bf(bb);
        }
    }
    __syncthreads();
    float h = 0.f, lasum = 0.f;
    if (FINAL) {
      h = lat ? p->in[7][((b * 2 + l) * 2 + dir) * 256 + ch] : 0.f;
      const int ncar = dir == 0 ? c : nch - 1 - c;
      const int cstart = dir == 0 ? ci - c : ci - c + nch - 1, cstep = dir == 0 ? 1 : -1;
      for (int q0 = 0; q0 < ncar; q0 += 16) {
        float ca[16], chh[16];
#pragma unroll
        for (int q = 0; q < 16; ++q) {
          const int qq = q0 + q < ncar ? q0 + q : ncar - 1;
          const float* C = LC + ((size_t)((cstart + cstep * qq) * 2 + dir) * 2) * 256;
          ca[q] = C[ch]; chh[q] = C[256 + ch];
        }
#pragma unroll
        for (int q = 0; q < 16; ++q) if (q0 + q < ncar) h = ca[q] * h + chh[q];
      }
    }
#pragma unroll 1
    for (int s8 = 0; s8 < 32; s8 += 16) {
      float gv[16];
      if (FINAL && dir == 1) {
#pragma unroll
        for (int q = 0; q < 16; ++q) gv[q] = bf2f(INP[(size_t)(r0 + 31 - s8 - q) * LDI + C_LG + ch]);
      }
#pragma unroll
      for (int q = 0; q < 16; ++q) {
        const int st = s8 + q;
        const int t = dir == 0 ? st : 31 - st;
        const float la = bf2f(sla[t * 256 + ch]);
        h = __expf(la) * h + bf2f(sbv[t * 256 + ch]);
        lasum += la;
        if (FINAL) {
          if (dir == 0) shf[t * 256 + ch] = f2bf(h);
          else ((u16*)(p->ws + WS_BRANCH))[(size_t)(r0 + t) * 1024 + 256 + ch] = f2bf((bf2f(shf[t * 256 + ch]) + h) * gelu_tanh(gv[q]));
        }
      }
    }
    if (!FINAL) { float* C = LC + ((size_t)(ci * 2 + dir) * 2) * 256; C[ch] = __expf(lasum); C[256 + ch] = h; }
    else if (!lat) {
      if (dir == 0 && c == nch - 1) p->out[O_LRU + ((size_t)(b * 2 + l) * 2 + 0) * 256 + ch] = h;
      if (dir == 1 && c == 0) p->out[O_LRU + ((size_t)(b * 2 + l) * 2 + 1) * 256 + ch] = h;
    }
    __syncthreads();
  }
}

template <int DIR, bool ISW>
DI void gdn_solve(const float* L, const u16* src, const float* sb_, const float* se_, u16* UW) {
  float sol[64];
#pragma unroll
  for (int i = 0; i < 64; ++i) {
    float s = bf2f(src[(DIR == 0 ? i : 63 - i) * 72]) * sb_[i];
    if (ISW) s *= se_[i];
    float s0 = 0.f, s1 = 0.f, s2 = 0.f, s3 = 0.f;
#pragma unroll
    for (int j4 = 0; j4 < (i + 3) / 4; ++j4) {
      float4 lv = *(const float4*)(L + i * 64 + j4 * 4);
      if (j4 * 4 + 0 < i) s0 += lv.x * sol[j4 * 4 + 0];
      if (j4 * 4 + 1 < i) s1 += lv.y * sol[j4 * 4 + 1];
      if (j4 * 4 + 2 < i) s2 += lv.z * sol[j4 * 4 + 2];
      if (j4 * 4 + 3 < i) s3 += lv.w * sol[j4 * 4 + 3];
      if ((j4 & 3) == 3) asm volatile("" ::: "memory");
    }
    s -= (s0 + s1) + (s2 + s3);
    sol[i] = s;
    UW[i * 128] = f2bf(s);
    asm volatile("" ::: "memory");
  }
}

DI void gdn1_item(KP p, int l, int item, unsigned char* smem) {
  const int cgi = item >> 2, hd = item & 3;
  u16* sq = (u16*)smem; u16* sk = sq + 64 * 72; u16* sv = sk + 64 * 72;
  float* sL = (float*)(smem + 27648);
  float* sgc = (float*)(smem + 60416);
  float* sbeta = sgc + 128;
  float* sge = sbeta + 128;
  const int tid = ltid(), lane = tid & 63, wave = tid >> 6, lq = lane & 15, quad = lane >> 4;
  const int r0 = cgi * 64;
  const bool lat = r0 >= 8192;
  int T, seqrow0;
  if (!lat) { T = 256; seqrow0 = (r0 >> 8) * 256; } else { T = 4096; seqrow0 = 8192 + ((r0 - 8192) >> 12) * 4096; }
  const int t0 = r0 - seqrow0;
  const u16* INP = (const u16*)(p->ws + WS_INPROJ);
  u16* QHAT = (u16*)(p->ws + WS_QHAT) + (size_t)item * 4096;
  {
    const int d = lane, tb = wave * 16;
#pragma unroll
    for (int mat = 0; mat < 3; ++mat) {
      const int col = C_GQ + mat * 256 + hd * 64 + d, wc = mat * 256 + hd * 64 + d;
      const float* cw = p->in[25] + (size_t)l * 4 * 768;
      const float w0 = cw[wc], w1 = cw[768 + wc], w2 = cw[1536 + wc], w3 = cw[2304 + wc];
      auto ld = [&](int t) -> float { return (t >= 0 && t < T) ? bf2f(INP[(size_t)(seqrow0 + t) * LDI + col]) : 0.f; };
      float xin[19];
#pragma unroll
      for (int q = 0; q < 19; ++q) xin[q] = ld(t0 + tb - 2 + q);
      u16* dst = mat == 0 ? sq : (mat == 1 ? sk : sv);
#pragma unroll
      for (int tt = 0; tt < 16; ++tt) {
        const int t = tb + tt;
        float v = siluf_(xin[tt] * w0 + xin[tt + 1] * w1 + xin[tt + 2] * w2 + xin[tt + 3] * w3);
        if (mat < 2) { float ss = wave_sum(v * v); v *= rsqrtf(ss + 1e-6f) * (mat == 0 ? 0.125f : 1.f); }
        u16 hb = f2bf(v);
        dst[t * 72 + d] = hb;
        if (mat == 0) QHAT[t * 64 + d] = hb;
      }
    }
  }
  if (tid < 128) {
    const int dir = tid >> 6, c = tid & 63;
    const int tok = dir == 0 ? c : 63 - c;
    const u16* R = INP + (size_t)(r0 + tok) * LDI;
    const float ga = bf2f(R[C_GA + dir * 4 + hd]), gb = bf2f(R[C_GB + dir * 4 + hd]);
    const float g = -__expf(p->in[26][(l * 2 + dir) * 4 + hd]) * softplusf_(ga + p->in[27][(l * 2 + dir) * 4 + hd]);
    float gc = g;
#pragma unroll
    for (int o = 1; o < 64; o <<= 1) { float tt = __shfl_up(gc, o, 64); if (lane >= o) gc += tt; }
    const float glast = __shfl(gc, 63, 64);
    sgc[dir * 64 + c] = gc; sbeta[dir * 64 + c] = sigm(gb); sge[dir * 64 + c] = __expf(gc);
    float* gv = (float*)(p->ws + WS_GVEC) + (size_t)(item * 2 + dir) * 256;
    gv[c] = __expf(gc); gv[64 + c] = __expf(glast - gc); if (c == 0) gv[128] = __expf(glast);
  }
  __syncthreads();
  {
    const int dk = tid >> 2, c0 = (tid & 3) * 16;
    unsigned w[8];
#pragma unroll
    for (int e = 0; e < 8; ++e) w[e] = (unsigned)sk[(c0 + 2 * e) * 72 + dk] | ((unsigned)sk[(c0 + 2 * e + 1) * 72 + dk] << 16);
    u16* KT = (u16*)(p->ws + WS_KT) + (size_t)item * 4096 + dk * 64 + c0;
    *(u32x4*)KT = mku4(w[0], w[1], w[2], w[3]); *(u32x4*)(KT + 8) = mku4(w[4], w[5], w[6], w[7]);
  }
  {
    const int i0 = wave * 16;
    f32x4 akk[4], aqk[4];
#pragma unroll
    for (int nt = 0; nt < 4; ++nt) { akk[nt] = f32x4{0.f, 0.f, 0.f, 0.f}; aqk[nt] = f32x4{0.f, 0.f, 0.f, 0.f}; }
#pragma unroll
    for (int s = 0; s < 2; ++s) {
      bf16x8 ak = ld8(sk + (i0 + lq) * 72 + s * 32 + quad * 8), aq = ld8(sq + (i0 + lq) * 72 + s * 32 + quad * 8);
#pragma unroll
      for (int nt = 0; nt < 4; ++nt) { bf16x8 bk = ld8(sk + (nt * 16 + lq) * 72 + s * 32 + quad * 8); akk[nt] = MFMA16(ak, bk, akk[nt]); aqk[nt] = MFMA16(aq, bk, aqk[nt]); }
    }
    u16* QKf = (u16*)(p->ws + WS_QK) + (size_t)(item * 2 + 0) * 4096;
    u16* QKb = (u16*)(p->ws + WS_QK) + (size_t)(item * 2 + 1) * 4096;
#pragma unroll
    for (int nt = 0; nt < 4; ++nt)
#pragma unroll
      for (int r = 0; r < 4; ++r) {
        const int i = i0 + quad * 4 + r, j = nt * 16 + lq, ib = 63 - i, jb = 63 - j;
        const float kkv = akk[nt][r], qkv = aqk[nt][r];
        if (j < i) sL[i * 64 + j] = sbeta[i] * kkv * __expf(sgc[i] - sgc[j]);
        if (j > i) sL[4096 + ib * 64 + jb] = sbeta[64 + ib] * kkv * __expf(sgc[64 + ib] - sgc[64 + jb]);
        QKf[i * 64 + j] = f2bf(j <= i ? qkv * __expf(sgc[i] - sgc[j]) : 0.f);
        QKb[ib * 64 + jb] = f2bf(j >= i ? qkv * __expf(sgc[64 + ib] - sgc[64 + jb]) : 0.f);
      }
  }
  __syncthreads();
  {
    const int col = tid & 127;
    u16* UW = (u16*)(p->ws + WS_UW) + (size_t)(item * 2 + (tid >> 7)) * 8192 + col;
    if (tid < 128) { if (col < 64) gdn_solve<0, false>(sL, sv + col, sbeta, sge, UW); else gdn_solve<0, true>(sL, sk + (col - 64), sbeta, sge, UW); }
    else { if (col < 64) gdn_solve<1, false>(sL + 4096, sv + col, sbeta + 64, sge + 64, UW); else gdn_solve<1, true>(sL + 4096, sk + (col - 64), sbeta + 64, sge + 64, UW); }
  }
  __syncthreads();
}

DI void gdn2_item(KP p, int l, int item, unsigned char* smem) {
  u16* sW = (u16*)smem; u16* sQ = sW + 64 * 72; u16* sQK = sQ + 64 * 72; u16* sKT = sQK + 64 * 72; u16* sU = sKT + 64 * 72;
  float* sg = (float*)(smem + 46080);
  const int tid = ltid(), lane = tid & 63, wave = tid >> 6, lq = lane & 15, quad = lane >> 4;
  int b, hd, dir; bool lat;
  if (item < 16) { lat = true; b = item >> 3; hd = (item >> 1) & 3; dir = item & 1; }
  else { lat = false; int r = item - 16; b = r >> 3; hd = (r >> 1) & 3; dir = r & 1; }
  const int nch = lat ? 64 : 4, cg0 = lat ? 128 + b * 64 : b * 4;
  f32x4 st[4];
#pragma unroll
  for (int kt = 0; kt < 4; ++kt)
#pragma unroll
    for (int r = 0; r < 4; ++r)
      st[kt][r] = lat ? p->in[8][((size_t)(((b * 2 + l) * 2 + dir) * 4 + hd) * 64 + kt * 16 + quad * 4 + r) * 64 + wave * 16 + lq] : 0.f;
  const int lrow = tid >> 2, seg = (tid & 3) * 16;
  u32x4 rW[2], rQ[2], rQK[2], rKT[2], rU[2]; float rg = 0.f;
  const u16* UWb = (const u16*)(p->ws + WS_UW); const u16* QHb = (const u16*)(p->ws + WS_QHAT);
  const u16* KTb = (const u16*)(p->ws + WS_KT); u16* QKb = (u16*)(p->ws + WS_QK);
  const float* GV = (const float*)(p->ws + WS_GVEC);
  auto gload = [&](int n) {
    const int cgi = dir == 0 ? cg0 + n : cg0 + nch - 1 - n;
    const size_t prob = (size_t)cgi * 4 + hd, pd = prob * 2 + dir;
    const u16* u = UWb + (pd * 64 + lrow) * 128 + seg;
    rU[0] = *(const u32x4*)u; rU[1] = *(const u32x4*)(u + 8); rW[0] = *(const u32x4*)(u + 64); rW[1] = *(const u32x4*)(u + 72);
    const u16* q = QHb + (prob * 64 + (dir ? 63 - lrow : lrow)) * 64 + seg;
    rQ[0] = *(const u32x4*)q; rQ[1] = *(const u32x4*)(q + 8);
    const u16* qk = QKb + (pd * 64 + lrow) * 64 + seg;
    rQK[0] = *(const u32x4*)qk; rQK[1] = *(const u32x4*)(qk + 8);
    const u16* kt = KTb + (prob * 64 + lrow) * 64 + (dir ? 48 - seg : seg);
    u32x4 a = *(const u32x4*)kt, bb = *(const u32x4*)(kt + 8);
    if (dir) { rKT[0] = rev8(bb); rKT[1] = rev8(a); } else { rKT[0] = a; rKT[1] = bb; }
    rg = GV[pd * 256 + (tid & 255)];
  };
  gload(0);
  for (int n = 0; n < nch; ++n) {
    const int cgi = dir == 0 ? cg0 + n : cg0 + nch - 1 - n;
    const size_t pd = ((size_t)cgi * 4 + hd) * 2 + dir;
    __syncthreads();
    *(u32x4*)(sW + lrow * 72 + seg) = rW[0]; *(u32x4*)(sW + lrow * 72 + seg + 8) = rW[1];
    *(u32x4*)(sQ + lrow * 72 + seg) = rQ[0]; *(u32x4*)(sQ + lrow * 72 + seg + 8) = rQ[1];
    *(u32x4*)(sQK + lrow * 72 + seg) = rQK[0]; *(u32x4*)(sQK + lrow * 72 + seg + 8) = rQK[1];
    *(u32x4*)(sKT + lrow * 72 + seg) = rKT[0]; *(u32x4*)(sKT + lrow * 72 + seg + 8) = rKT[1];
    *(u32x4*)(sU + lrow * 72 + seg) = rU[0]; *(u32x4*)(sU + lrow * 72 + seg + 8) = rU[1];
    sg[tid] = rg;
    __syncthreads();
    if (n + 1 < nch) gload(n + 1);
    const float elast = sg[128];
    bf16x8 sB[2] = {pack8(st[0], st[1]), pack8(st[2], st[3])};
    f32x4 vn[4], oo[4];
#pragma unroll
    for (int mt = 0; mt < 4; ++mt) {
      f32x4 acc = {0.f, 0.f, 0.f, 0.f}, acq = {0.f, 0.f, 0.f, 0.f};
#pragma unroll
      for (int s2 = 0; s2 < 2; ++s2) {
        acc = MFMA16(ldperm(sW + (mt * 16 + lq) * 72 + s2 * 32 + quad * 4), sB[s2], acc);
        acq = MFMA16(ldperm(sQ + (mt * 16 + lq) * 72 + s2 * 32 + quad * 4), sB[s2], acq);
      }
#pragma unroll
      for (int r = 0; r < 4; ++r) {
        const int c = mt * 16 + quad * 4 + r;
        vn[mt][r] = bf2f(sU[c * 72 + wave * 16 + lq]) - acc[r];
        oo[mt][r] = acq[r] * sg[c];
      }
    }
    bf16x8 vB[2] = {pack8(vn[0], vn[1]), pack8(vn[2], vn[3])};
#pragma unroll
    for (int mt = 0; mt < 4; ++mt) {
#pragma unroll
      for (int s2 = 0; s2 < 2; ++s2) oo[mt] = MFMA16(ldperm(sQK + (mt * 16 + lq) * 72 + s2 * 32 + quad * 4), vB[s2], oo[mt]);
    }
    f32x4 vs[4];
#pragma unroll
    for (int mt = 0; mt < 4; ++mt)
#pragma unroll
      for (int r = 0; r < 4; ++r) vs[mt][r] = vn[mt][r] * sg[64 + mt * 16 + quad * 4 + r];
    bf16x8 vsB[2] = {pack8(vs[0], vs[1]), pack8(vs[2], vs[3])};
#pragma unroll
    for (int kt = 0; kt < 4; ++kt) {
      f32x4 acc = {0.f, 0.f, 0.f, 0.f};
#pragma unroll
      for (int s2 = 0; s2 < 2; ++s2) acc = MFMA16(ldperm(sKT + (kt * 16 + lq) * 72 + s2 * 32 + quad * 4), vsB[s2], acc);
#pragma unroll
      for (int r = 0; r < 4; ++r) st[kt][r] = elast * st[kt][r] + acc[r];
    }
    u16* O = QKb + pd * 4096;
#pragma unroll
    for (int mt = 0; mt < 4; ++mt)
#pragma unroll
      for (int r = 0; r < 4; ++r) O[(mt * 16 + quad * 4 + r) * 64 + wave * 16 + lq] = f2bf(oo[mt][r]);
  }
  if (!lat) {
#pragma unroll
    for (int kt = 0; kt < 4; ++kt)
#pragma unroll
      for (int r = 0; r < 4; ++r)
        p->out[O_GDN + ((size_t)(((b * 2 + l) * 2 + dir) * 4 + hd) * 64 + kt * 16 + quad * 4 + r) * 64 + wave * 16 + lq] = st[kt][r];
  }
  __syncthreads();
}

DI void gdnfin_item(KP p, int l, int item) {
  const int cgi = item >> 2, hd = item & 3;
  const int lane = ltid() & 63, wave = ltid() >> 6;
  const u16* Of = (const u16*)(p->ws + WS_QK) + (size_t)(item * 2 + 0) * 4096;
  const u16* Ob = (const u16*)(p->ws + WS_QK) + (size_t)(item * 2 + 1) * 4096;
  const float gn = p->in[28][l * 64 + lane];
  float ov[16], zv[16];
#pragma unroll
  for (int q = 0; q < 16; ++q) {
    const int c = wave * 16 + q;
    ov[q] = bf2f(Of[c * 64 + lane]) + bf2f(Ob[(63 - c) * 64 + lane]);
    zv[q] = bf2f(((const u16*)(p->ws + WS_INPROJ))[((size_t)cgi * 64 + c) * LDI + C_GZ + hd * 64 + lane]);
  }
#pragma unroll
  for (int q = 0; q < 16; ++q) {
    const int c = wave * 16 + q;
    const size_t row = (size_t)cgi * 64 + c;
    float o = ov[q];
    float ss = wave_sum(o * o);
    float z = zv[q];
    float y = o * rsqrtf(ss * (1.f / 64.f) + 1e-6f) * gn * siluf_(z);
    ((u16*)(p->ws + WS_BRANCH))[row * 1024 + 512 + hd * 64 + lane] = f2bf(y);
  }
}


#define XB_TMO      128
#define XB_XCNT(j)  (256  + 64 * (j))
#define XB_XSUB(j)  (1280 + 64 * (j))
#define XB_XGEN(j)  (2304 + 64 * (j))
#define XB_TOP      3328
#define XB_TOPGEN   3392
#define XB_SPIN_CAP (1u << 20)
#define LAS __attribute__((address_space(3)))
DI unsigned xb_ld(unsigned* q) { return __hip_atomic_load(q, __ATOMIC_RELAXED, __HIP_MEMORY_SCOPE_AGENT); }
DI unsigned xb_add(unsigned* q, unsigned v) { return __hip_atomic_fetch_add(q, v, __ATOMIC_RELAXED, __HIP_MEMORY_SCOPE_AGENT); }
DI unsigned xb_xcc_id() { return (unsigned)__builtin_amdgcn_s_getreg((3 << 11) | 20) & 0xFu; }
#define XB_SPIN(cond, bar) do { unsigned _sp = 0; while (cond) { __builtin_amdgcn_s_sleep(1); \
    if ((++_sp & 255u) == 0u) { if (xb_ld(&(bar)[XB_TMO])) break; if (_sp > XB_SPIN_CAP) { atomicAdd(&(bar)[XB_TMO], 1u); break; } } } } while (0)
DI void xcd_barrier_complete(unsigned* bar, unsigned x, unsigned& nloc, unsigned& nx) {
  const unsigned G = gridDim.x;
  unsigned sum, cnt, mine, sp = 0u;
  for (;;) {
    sum = 0u; cnt = 0u; mine = 0u;
#pragma unroll
    for (unsigned j = 0; j < 16; ++j) { const unsigned c = xb_ld(&bar[XB_XCNT(j)]); sum += c; cnt += (c > 0u) ? 1u : 0u; mine = (j == x) ? c : mine; }
    if (sum == G) break;
    __builtin_amdgcn_s_sleep(1);
    if ((++sp & 255u) == 0u) { if (xb_ld(&bar[XB_TMO])) break; if (sp > XB_SPIN_CAP) { atomicAdd(&bar[XB_TMO], 1u); break; } }
  }
  nloc = mine > 0u ? mine : 1u; nx = cnt > 0u ? cnt : 1u;
}
DI void xcd_barrier(unsigned* bar, volatile LAS unsigned* st) {
  asm volatile("s_waitcnt vmcnt(0)" ::: "memory");
  __syncthreads();
  if (ltid() == 0) {
    const unsigned x = xb_xcc_id();
    __builtin_amdgcn_s_waitcnt(0);
    unsigned nloc = st[0], nx = st[1];
    if (nloc == 0u) { xcd_barrier_complete(bar, x, nloc, nx); st[0] = nloc; st[1] = nx; }
    const unsigned old = xb_add(&bar[XB_XSUB(x)], 1u);
    const unsigned gen = old / nloc;
    if (old + 1u == (gen + 1u) * nloc) {
      __builtin_amdgcn_fence(__ATOMIC_RELEASE, "agent");
      asm volatile("s_waitcnt vmcnt(0)" ::: "memory");
      const unsigned og = xb_add(&bar[XB_TOP], 1u);
      const unsigned tg = og / nx;
      if (og + 1u == (tg + 1u) * nx) xb_add(&bar[XB_TOPGEN], 1u);
      else XB_SPIN(xb_ld(&bar[XB_TOPGEN]) == tg, bar);
      __builtin_amdgcn_fence(__ATOMIC_ACQUIRE, "agent");
      xb_add(&bar[XB_XGEN(x)], 1u);
      asm volatile("s_waitcnt vmcnt(0)" ::: "memory");
    } else {
      XB_SPIN(xb_ld(&bar[XB_XGEN(x)]) == gen, bar);
      __builtin_amdgcn_fence(__ATOMIC_ACQUIRE, "agent");
      asm volatile("s_waitcnt vmcnt(0)" ::: "memory");
    }
  }
  __syncthreads();
}


#define FOR_TILES(MTI, NTI, SM, SN, CALL)                                                      \
  do {                                                                                         \
    if (G % 8 != 0) { for (int it_ = B; it_ < (MTI) * (NTI); it_ += G) { const int mt = it_ / (NTI), nt = it_ % (NTI); CALL; } } \
    else {                                                                                     \
      const int xcd_ = B & 7, j_ = B >> 3, J_ = G >> 3;                                        \
      const int nsm_ = ((MTI) + (SM) - 1) / (SM), nsn_ = ((NTI) + (SN) - 1) / (SN);            \
      for (int s_ = xcd_; s_ < nsm_ * nsn_; s_ += 8) {                                         \
        const int sm_ = s_ / nsn_, sn_ = s_ % nsn_;                                            \
        for (int t_ = j_; t_ < (SM) * (SN); t_ += J_) {                                        \
          const int mt = sm_ * (SM) + t_ / (SN), nt = sn_ * (SN) + t_ % (SN);                  \
          if (mt < (MTI) && nt < (NTI)) { CALL; }                                              \
        }                                                                                      \
      }                                                                                        \
    }                                                                                          \
  } while (0)

constexpr int NPHASE = 21;
__global__ void __launch_bounds__(256, 2) mk(Params p_unused, int ph_lo, int ph_hi) {
  extern __shared__ __attribute__((aligned(1024))) unsigned char smem[];
  int& s_item = *(int*)(smem + SMEM_BYTES);
  u32x4& xb_words = *(u32x4*)(smem + SMEM_BYTES + 16);
  const int G = gridDim.x, B = blockIdx.x;
  const bool fused = ph_hi - ph_lo > 1;
  if (fused) {
    if (ltid() == 0) { xb_words = u32x4{0u, 0u, 0u, 0u}; (void)xb_add(&((unsigned*)(((KP)__builtin_amdgcn_kernarg_segment_ptr())->ws + WS_BAR))[XB_XCNT(xb_xcc_id())], 1u); }
    __syncthreads();
  }
  for (int ph = ph_lo; ph < ph_hi; ++ph) {
    KP p = (KP)__builtin_amdgcn_kernarg_segment_ptr();
    asm volatile("" : "+s"(p));
    if (ph == 0) {
      for (int it = B; it < 192 + CONV_ITEMS + 64; it += G) { for (int rep = 0; rep < NREP(0); ++rep) { if (it < 192) mod_item(p, it, smem); else if (it < 192 + CONV_ITEMS) convert_item(p, 0, it - 192, smem); else lruw_item(p, it - 192 - CONV_ITEMS); } }
    } else {
      const int l = (ph - 1) / 10, sub = (ph - 1) % 10;
      switch (sub) {
        case 0:
          for (int it = B; it < 4096 + (l ? CONV_ITEMS : 0); it += G) { for (int rep = 0; rep < NREP(0); ++rep) { if (it < 4096) norm_item<0>(p, l, it); else convert_item(p, l, it - 4096, smem); } }
          break;
        case 1: FOR_TILES(128, 21, 8, 7, inproj_item(p, mt, nt, smem)); break;
        case 2:
          for (int it = B; it < 1024 + 512 + 64 + 4096; it += G) {
            if (it < 1024) { for (int rep = 0; rep < NREP(4); ++rep) gdn1_item(p, l, it, smem); }
            else if (it < 1536) { for (int rep = 0; rep < NREP(5); ++rep) lru_item<false>(p, l, it - 1024, smem); }
            else if (it < 1600) { if (PHON(6)) kvc_item(p, l, it - 1536); }
            else if (PHON(6)) prep_item(p, l, it - 1600);
          }
          break;
        case 3: {
          int* ctr = (int*)(p->ws + WS_CTR) + l;
          for (;;) {
            __syncthreads();
            if (ltid() == 0) s_item = atomicAdd(ctr, 1);
            __syncthreads();
            const int it = s_item;
            if (it >= 16 + 256 + 256 + 256 + 512 + 512) break;
            if (it < 16) { if (PHON(7)) gdn2_item(p, l, it, smem); }
            else if (it < 272) { for (int rep = 0; rep < NREP(8); ++rep) attn_item(p, l, it - 16, smem); }
            else if (it < 528) { if (PHON(7)) gdn2_item(p, l, it - 272 + 16, smem); }
            else if (it < 784) { for (int rep = 0; rep < NREP(8); ++rep) attn_item(p, l, it - 528 + 256, smem); }
            else if (it < 1296) { for (int rep = 0; rep < NREP(9); ++rep) lru_item<true>(p, l, it - 784, smem); }
            else for (int rep = 0; rep < NREP(8); ++rep) attn_item(p, l, it - 1296 + 512, smem);
          }
        } break;
        case 4: for (int it = B; it < 1024; it += G) for (int rep = 0; rep < NREP(0); ++rep) gdnfin_item(p, l, it); break;
        case 5: FOR_TILES(128, 16, 8, 8, merge_item(p, l, mt, nt, smem)); break;
        case 6: FOR_TILES(128, 8, 8, 8, wout_item(p, l, mt, nt, smem)); break;
        case 7: for (int it = B; it < 4096; it += G) for (int rep = 0; rep < NREP(0); ++rep) norm_item<1>(p, l, it); break;
        case 8: FOR_TILES(128, 32, 8, 8, w1_item(p, mt, nt, smem)); break;
        case 9: FOR_TILES(128, 8, 8, 8, w2_item(p, l, mt, nt, smem)); break;
      }
    }
    if (ph + 1 < ph_hi) {
      if (ph == ph_lo) cg::this_grid().sync();
      else for (int rep = 0; rep < NREP(1); ++rep) xcd_barrier((unsigned*)(p->ws + WS_BAR), (volatile LAS unsigned*)&xb_words);
    }
  }
}

extern "C" void kernel_launch(void* const* d_in, const int* in_sizes, int n_in, void* d_out, int out_size, void* d_ws, size_t ws_size, hipStream_t stream) {
  static int grid_blocks = 0;
  if (!grid_blocks) {
    int dev = 0, cus = 0, per_cu = 0;
    (void)hipGetDevice(&dev);
    (void)hipDeviceGetAttribute(&cus, hipDeviceAttributeMultiprocessorCount, dev);
    if (hipFuncSetAttribute((const void*)mk, hipFuncAttributeMaxDynamicSharedMemorySize, DYN_LDS) != hipSuccess) fprintf(stderr, "kernel_launch: hipFuncSetAttribute failed\n");
    (void)hipOccupancyMaxActiveBlocksPerMultiprocessor(&per_cu, mk, 256, DYN_LDS);
    if (per_cu < 1) per_cu = 1;
    if (per_cu > 2) per_cu = 2;
    grid_blocks = cus * per_cu;
    if (ws_size < WS_END) fprintf(stderr, "kernel_launch: workspace too small: %zu < %zu\n", ws_size, (size_t)WS_END);
  }
  if (hipMemsetAsync((char*)d_ws + WS_CTR, 0, 256 + 3456 * 4 + 256, stream) != hipSuccess) fprintf(stderr, "kernel_launch: memset failed\n");
  Params p{};
  for (int i = 0; i < 37; ++i) p.in[i] = (const float*)d_in[i];
  p.out = (float*)d_out; p.ws = (unsigned char*)d_ws;
#if MULTI_LAUNCH
  for (int ph = 0; ph < NPHASE; ++ph) hipLaunchKernelGGL(mk, dim3(grid_blocks), dim3(256), DYN_LDS, stream, p, ph, ph + 1);
#else
  int lo = 0, hi = NPHASE;
  void* args[] = {&p, &lo, &hi};
  hipError_t e = hipLaunchCooperativeKernel((void*)mk, dim3(grid_blocks), dim3(256), args, DYN_LDS, stream);
  if (e != hipSuccess) fprintf(stderr, "cooperative launch failed: %s (grid %d)\n", hipGetErrorString(e), grid_blocks);
#endif
}
```

```cpp
#include <hip/hip_runtime.h>
#include <hip/hip_cooperative_groups.h>
#include <cstdio>
namespace cg = cooperative_groups;

#ifndef MULTI_LAUNCH
#define MULTI_LAUNCH 0
#endif
#ifndef PHM
#define PHM 0xFFFFFFFFu
#endif
#define PHON(b) ((PHM >> (b)) & 1u)
#ifndef DUPM
#define DUPM 0u
#endif
#define NREP(b) (1 + ((DUPM >> (b)) & 1u))

typedef unsigned short u16;
using bf16x8 = __attribute__((ext_vector_type(8))) short;
using f32x4 = __attribute__((ext_vector_type(4))) float;
using u32x4 = __attribute__((ext_vector_type(4))) unsigned;
#define DI __device__ __forceinline__
#define MFMA16(a, b, c) __builtin_amdgcn_mfma_f32_16x16x32_bf16((a), (b), (c), 0, 0, 0)

constexpr int NTOK = 16384;
constexpr int DM = 1024;
constexpr int LDI = 2592;
constexpr int C_AQ = 0, C_AK = 256, C_AV = 384, C_LX = 512, C_LG = 768, C_GQ = 1024, C_GK = 1280, C_GV = 1536, C_GZ = 1792,
              C_DQ = 2048, C_DK = 2304, C_DV = 2432, C_GA = 2560, C_GB = 2568;
constexpr int NIN_PAD = 2688;

constexpr size_t WS_MOD = 0;
constexpr size_t WS_CTR = WS_MOD + 2 * 3 * 6144 * 4;
constexpr size_t WS_BAR = WS_CTR + 256;
constexpr size_t WS_LRUC = WS_BAR + 3456 * 4 + 256;
constexpr size_t WS_KC = WS_LRUC + (size_t)512 * 2 * 2 * 256 * 4;
constexpr size_t WS_GVEC = WS_KC + (size_t)16 * 512 * 64 * 2;
constexpr size_t WS_LRUW = WS_GVEC + (size_t)1024 * 2 * 256 * 4;
constexpr size_t WS_WIN = WS_LRUW + (size_t)256 * 64 * 16;
constexpr size_t WS_WM = WS_WIN + (size_t)NIN_PAD * 1024 * 2;
constexpr size_t WS_WB = WS_WM + (size_t)4096 * 1024 * 2;
constexpr size_t WS_WO = WS_WB + (size_t)4 * 1024 * 256 * 2;
constexpr size_t WS_W1 = WS_WO + (size_t)1024 * 1024 * 2;
constexpr size_t WS_W2 = WS_W1 + (size_t)4096 * 1024 * 2;
constexpr size_t WS_H = WS_W2 + (size_t)1024 * 4096 * 2;
constexpr size_t WS_BIG = WS_H + (size_t)NTOK * 1024 * 2;
constexpr size_t WS_INPROJ = WS_BIG;
constexpr size_t WS_BRANCH = WS_INPROJ + (size_t)NTOK * LDI * 2;
constexpr size_t WS_QHAT = WS_BRANCH + (size_t)NTOK * 1024 * 2;
constexpr size_t WS_KT = WS_QHAT + (size_t)1024 * 4096 * 2;
constexpr size_t WS_UW = WS_KT + (size_t)1024 * 4096 * 2;
constexpr size_t WS_QK = WS_UW + (size_t)1024 * 2 * 8192 * 2;
constexpr size_t WS_END = WS_QK + (size_t)1024 * 2 * 4096 * 2;
constexpr size_t WS_HIDDEN = WS_BIG;
constexpr size_t WS_MERGED = WS_BIG;
static_assert(WS_HIDDEN + (size_t)NTOK * 4096 * 2 <= WS_END, "hidden must fit");
static_assert(WS_END <= (size_t)256 * 1024 * 1024, "workspace budget");

constexpr size_t O_X = 0, O_AK = 16777216, O_AV = 18874368, O_DK = 20971520, O_DV = 23068672, O_LRU = 25165824, O_GDN = 25198592;

struct Params {
  const float* in[37];
  float* out;
  unsigned char* ws;
};

typedef const Params __attribute__((address_space(4)))* KP;
constexpr int SMEM_BYTES = 65536;
constexpr int DYN_LDS = SMEM_BYTES + 64;

DI int ltid() { int t = threadIdx.x; asm volatile("" : "+v"(t)); return t; }
typedef __bf16 bf16v2 __attribute__((ext_vector_type(2)));
DI u16 f2bf(float x) { __bf16 h = (__bf16)x; return __builtin_bit_cast(u16, h); }
DI float bf2f(u16 h) { return __uint_as_float(((unsigned)h) << 16); }
DI unsigned pack2(float a, float b) { bf16v2 v = {(__bf16)a, (__bf16)b}; return __builtin_bit_cast(unsigned, v); }
DI float bflo(unsigned u) { return __uint_as_float(u << 16); }
DI float bfhi(unsigned u) { return __uint_as_float(u & 0xffff0000u); }
DI float sigm(float x) { return 1.f / (1.f + __expf(-x)); }
DI float siluf_(float x) { return x / (1.f + __expf(-x)); }
DI float softplusf_(float x) { return x > 20.f ? x : log1pf(__expf(x)); }
DI float gelu_tanh(float x) { float u = 0.7978845608028654f * (x + 0.044715f * x * x * x); float t = 1.f - 2.f / (__expf(2.f * u) + 1.f); return 0.5f * x * (1.f + t); }
DI float wave_sum(float v) {
#pragma unroll
  for (int o = 32; o > 0; o >>= 1) v += __shfl_xor(v, o, 64);
  return v;
}
DI u32x4 mku4(unsigned a, unsigned b, unsigned c, unsigned d) { u32x4 v = {a, b, c, d}; return v; }
DI bf16x8 mk8(unsigned a, unsigned b, unsigned c, unsigned d) { u32x4 v = {a, b, c, d}; return __builtin_bit_cast(bf16x8, v); }
DI bf16x8 pack8(const f32x4& x, const f32x4& y) { return mk8(pack2(x[0], x[1]), pack2(x[2], x[3]), pack2(y[0], y[1]), pack2(y[2], y[3])); }
DI bf16x8 ld8(const u16* p) { return *(const bf16x8*)p; }
DI bf16x8 ldperm(const u16* p) { uint2 a = *(const uint2*)p; uint2 b = *(const uint2*)(p + 16); return mk8(a.x, a.y, b.x, b.y); }
DI int mod_group(int row) { return row < 8192 ? 0 : 1 + ((row - 8192) >> 12); }
DI const float* x_in_row(KP p, int l, int row) {
  if (l == 0) return row < 8192 ? p->in[0] + (size_t)row * DM : p->in[1] + (size_t)(row - 8192) * DM;
  return p->out + (size_t)row * DM;
}
DI unsigned swap16(unsigned u) { return (u >> 16) | (u << 16); }
DI u32x4 rev8(u32x4 v) { return mku4(swap16(v.w), swap16(v.z), swap16(v.y), swap16(v.x)); }

DI void mod_item(KP p, int item, unsigned char* smem) {
  float* sc = (float*)smem;
  float* sr = sc + 3072;
  const int tid = ltid();
  const int l = item / 96, cb = item % 96;
  for (int i = tid; i < 3072; i += 256) {
    int g = i >> 10, k = i & 1023;
    float c = g == 0 ? p->in[9][k] : p->in[2][(g - 1) * 1024 + k];
    sc[i] = siluf_(c);
  }
  __syncthreads();
  const int col = cb * 64 + (tid & 63), kg = tid >> 6;
  const float* W = p->in[10] + (size_t)l * 1024 * 6144;
  float a0 = 0.f, a1 = 0.f, a2 = 0.f;
  for (int k = kg * 256; k < kg * 256 + 256; ++k) {
    float w = W[(size_t)k * 6144 + col];
    a0 += sc[k] * w; a1 += sc[1024 + k] * w; a2 += sc[2048 + k] * w;
  }
  sr[(kg * 3 + 0) * 64 + (tid & 63)] = a0; sr[(kg * 3 + 1) * 64 + (tid & 63)] = a1; sr[(kg * 3 + 2) * 64 + (tid & 63)] = a2;
  __syncthreads();
  if (tid < 192) {
    int g = tid >> 6, cc = tid & 63;
    float s = p->in[11][l * 6144 + cb * 64 + cc];
    for (int q = 0; q < 4; ++q) s += sr[(q * 3 + g) * 64 + cc];
    ((float*)(p->ws + WS_MOD))[(l * 3 + g) * 6144 + cb * 64 + cc] = s;
  }
  __syncthreads();
}

DI void conv_tile(const float* src, int N, int k0, int n0, u16* dst, int K, bool perm, unsigned char* smem) {
  float* tile = (float*)smem;
  const int tid = ltid();
#pragma unroll
  for (int i = 0; i < 4; ++i) {
    int kr = (tid >> 4) + 16 * i, nc = (tid & 15) * 4;
    float4 v = make_float4(0.f, 0.f, 0.f, 0.f);
    if (n0 + nc < N) v = *(const float4*)(src + (size_t)(k0 + kr) * N + n0 + nc);
    tile[kr * 65 + nc] = v.x; tile[kr * 65 + nc + 1] = v.y; tile[kr * 65 + nc + 2] = v.z; tile[kr * 65 + nc + 3] = v.w;
  }
  __syncthreads();
#pragma unroll
  for (int i = 0; i < 2; ++i) {
    int n = (tid >> 3) + 32 * i, k8 = (tid & 7) * 8;
    int ng = n0 + n;
    if (ng < N) {
      int row = ng;
      if (perm) row = ng < 2048 ? ng : (ng < 2064 ? 2560 + (ng - 2048) : ng - 16);
      u32x4 o;
      o.x = pack2(tile[(k8 + 0) * 65 + n], tile[(k8 + 1) * 65 + n]);
      o.y = pack2(tile[(k8 + 2) * 65 + n], tile[(k8 + 3) * 65 + n]);
      o.z = pack2(tile[(k8 + 4) * 65 + n], tile[(k8 + 5) * 65 + n]);
      o.w = pack2(tile[(k8 + 6) * 65 + n], tile[(k8 + 7) * 65 + n]);
      *(u32x4*)(dst + (size_t)row * K + k0 + k8) = o;
    }
  }
  __syncthreads();
}

constexpr int CONV_ITEMS = 4241;
DI void convert_item(KP p, int l, int item, unsigned char* smem) {
  unsigned char* ws = p->ws;
  if (item < 656) { int kt = item / 41, nt = item % 41; conv_tile(p->in[14] + (size_t)l * 1024 * 2576, 2576, kt * 64, nt * 64, (u16*)(ws + WS_WIN), 1024, true, smem); return; }
  item -= 656;
  if (item < 1024) { int kt = item >> 6, nt = item & 63; conv_tile(p->in[32] + (size_t)l * 1024 * 4096, 4096, kt * 64, nt * 64, (u16*)(ws + WS_WM), 1024, false, smem); return; }
  item -= 1024;
  if (item < 256) { int m = item >> 6, r = item & 63, kt = r >> 4, nt = r & 15;
    conv_tile(p->in[31] + ((size_t)l * 4 + m) * 256 * 1024, 1024, kt * 64, nt * 64, (u16*)(ws + WS_WB) + (size_t)m * 1024 * 256, 256, false, smem); return; }
  item -= 256;
  if (item < 256) { int kt = item >> 4, nt = item & 15; conv_tile(p->in[34] + (size_t)l * 1024 * 1024, 1024, kt * 64, nt * 64, (u16*)(ws + WS_WO), 1024, false, smem); return; }
  item -= 256;
  if (item < 1024) { int kt = item >> 6, nt = item & 63; conv_tile(p->in[35] + (size_t)l * 1024 * 4096, 4096, kt * 64, nt * 64, (u16*)(ws + WS_W1), 1024, false, smem); return; }
  item -= 1024;
  if (item < 1024) { int kt = item >> 4, nt = item & 15; conv_tile(p->in[36] + (size_t)l * 4096 * 1024, 1024, kt * 64, nt * 64, (u16*)(ws + WS_W2), 4096, false, smem); return; }
  u32x4* z = (u32x4*)((u16*)(ws + WS_WIN) + (size_t)2576 * 1024);
  for (int i = ltid(); i < 112 * 1024 / 8; i += 256) z[i] = mku4(0, 0, 0, 0);
}

DI void lruw_item(KP p, int item) {
  const int gid = item * 256 + ltid();
  const int lane = gid & 63, fg = gid >> 6;
  const int s2 = fg & 1, j = (fg >> 1) & 3, n = (fg >> 3) & 3, g = (fg >> 5) & 1, ld_ = fg >> 6;
  const int lq = lane & 15, quad = lane >> 4;
  const float* W = (g == 0 ? p->in[20] : p->in[22]) + ((size_t)(ld_ * 4 + n) * 64) * 64 + (size_t)(s2 * 32 + quad * 8) * 64 + j * 16 + lq;
  u32x4 o = {pack2(W[0], W[64]), pack2(W[128], W[192]), pack2(W[256], W[320]), pack2(W[384], W[448])};
  ((u32x4*)(p->ws + WS_LRUW))[gid] = o;
}

template <int which>
DI void norm_item(KP p, int l, int item) {
  const int lane = ltid() & 63, wave = ltid() >> 6;
  const int row = item * 4 + wave;
  const float* x = x_in_row(p, which == 0 ? l : 2, row);
  const float* g = p->in[which == 0 ? 12 : 13] + l * 1024;
  const float* mod = (const float*)(p->ws + WS_MOD) + (l * 3 + mod_group(row)) * 6144;
  const float* sh = mod + (which == 0 ? 0 : 3072);
  const float* sc = mod + (which == 0 ? 1024 : 4096);
  f32x4 v[4]; float ss = 0.f;
#pragma unroll
  for (int i = 0; i < 4; ++i) { v[i] = *(const f32x4*)(x + i * 256 + lane * 4); ss += v[i].x * v[i].x + v[i].y * v[i].y + v[i].z * v[i].z + v[i].w * v[i].w; }
  ss = wave_sum(ss);
  const float rstd = rsqrtf(ss * (1.f / 1024.f) + 1e-6f);
  u16* H = (u16*)(p->ws + WS_H) + (size_t)row * 1024;
#pragma unroll
  for (int i = 0; i < 4; ++i) {
    int c = i * 256 + lane * 4;
    float4 gg = *(const float4*)(g + c), s1 = *(const float4*)(sc + c), s0 = *(const float4*)(sh + c);
    float y0 = v[i].x * rstd * gg.x * (1.f + s1.x) + s0.x, y1 = v[i].y * rstd * gg.y * (1.f + s1.y) + s0.y;
    float y2 = v[i].z * rstd * gg.z * (1.f + s1.z) + s0.z, y3 = v[i].w * rstd * gg.w * (1.f + s1.w) + s0.w;
    *(uint2*)(H + c) = make_uint2(pack2(y0, y1), pack2(y2, y3));
  }
}

DI int lds_byte(int r, int c) {
  int st = (r >> 4) * 2 + (c >> 5), ob = (r & 15) * 64 + (c & 31) * 2;
  return st * 1024 + (ob ^ (((ob >> 9) & 1) << 5));
}
DI void stage_rc(int b, int& R, int& C) {
  int st = b >> 10, sb = b & 1023, swz = sb ^ (((sb >> 9) & 1) << 5);
  R = (st >> 1) * 16 + (swz >> 6);
  C = (st & 1) * 32 + ((swz & 63) >> 1);
}
template <int MT, int NT>
DI void gemm_acc(f32x4 (&acc)[MT][NT], const u16* __restrict__ A, int lda, const u16* __restrict__ Bt, int ldb, int K, unsigned char* smem) {
  constexpr int TA = MT * 32 * 128, TB = NT * 32 * 128, STAGE = TA + TB;
  static_assert(2 * STAGE <= 65536, "LDS");
  const int tid = ltid(), lane = tid & 63, wid = tid >> 6, wm = wid >> 1, wn = wid & 1;
  const int fr = lane & 15, fq = lane >> 4;
  const u16* ga[MT]; const u16* gb[NT];
#pragma unroll
  for (int i = 0; i < MT; ++i) { int R, C; stage_rc(wid * 1024 + i * 4096 + lane * 16, R, C); ga[i] = A + (size_t)R * lda + C; }
#pragma unroll
  for (int i = 0; i < NT; ++i) { int R, C; stage_rc(wid * 1024 + i * 4096 + lane * 16, R, C); gb[i] = Bt + (size_t)R * ldb + C; }
#define GLDS_STAGE(buf, k0)                                                                                                        \
  do {                                                                                                                             \
    _Pragma("unroll") for (int i = 0; i < MT; ++i)                                                                                 \
      __builtin_amdgcn_global_load_lds((const unsigned*)(ga[i] + (k0)), (unsigned*)(smem + (buf) * STAGE + wid * 1024 + i * 4096), 16, 0, 0); \
    _Pragma("unroll") for (int i = 0; i < NT; ++i)                                                                                 \
      __builtin_amdgcn_global_load_lds((const unsigned*)(gb[i] + (k0)), (unsigned*)(smem + (buf) * STAGE + TA + wid * 1024 + i * 4096), 16, 0, 0); \
  } while (0)
  __syncthreads();
  GLDS_STAGE(0, 0);
  asm volatile("s_waitcnt vmcnt(0)" ::: "memory");
  __syncthreads();
  const int nt = K >> 6;
  for (int t = 0; t < nt; ++t) {
    const int cur = t & 1;
    if (t + 1 < nt) GLDS_STAGE(cur ^ 1, (t + 1) * 64);
    const unsigned char* sA = smem + cur * STAGE;
    const unsigned char* sB = sA + TA;
#pragma unroll
    for (int s = 0; s < 2; ++s) {
      bf16x8 bfr[NT];
#pragma unroll
      for (int j = 0; j < NT; ++j) bfr[j] = *(const bf16x8*)(sB + lds_byte(wn * NT * 16 + j * 16 + fr, s * 32 + fq * 8));
#pragma unroll
      for (int i = 0; i < MT; ++i) {
        bf16x8 af = *(const bf16x8*)(sA + lds_byte(wm * MT * 16 + i * 16 + fr, s * 32 + fq * 8));
#pragma unroll
        for (int j = 0; j < NT; ++j) acc[i][j] = MFMA16(af, bfr[j], acc[i][j]);
      }
    }
    asm volatile("s_waitcnt vmcnt(0)" ::: "memory");
    __syncthreads();
  }
#undef GLDS_STAGE
}

template <int MT, int NT> DI void zero_acc(f32x4 (&acc)[MT][NT]) {
#pragma unroll
  for (int i = 0; i < MT; ++i)
#pragma unroll
    for (int j = 0; j < NT; ++j) acc[i][j] = f32x4{0.f, 0.f, 0.f, 0.f};
}

#define EPI_LOOP(MT, NT)                                                          \
  const int tid_ = ltid(), lane_ = tid_ & 63, wave_ = tid_ >> 6;                   \
  const int wm_ = wave_ >> 1, wn_ = wave_ & 1, lq_ = lane_ & 15, quad_ = lane_ >> 4; \
  _Pragma("unroll") for (int i = 0; i < MT; ++i)                                   \
  _Pragma("unroll") for (int j = 0; j < NT; ++j)                                   \
  _Pragma("unroll") for (int r = 0; r < 4; ++r)
#define EPI_ROW(m0, MT) ((m0) + wm_ * (MT) * 16 + i * 16 + quad_ * 4 + r)
#define EPI_COL(n0, NT) ((n0) + wn_ * (NT) * 16 + j * 16 + lq_)

constexpr int GMT = 4;
DI void inproj_item(KP p, int mt, int nt, unsigned char* smem) {
  const int m0 = mt * (GMT * 32), n0 = nt * 128;
  f32x4 acc[GMT][4]; zero_acc<GMT, 4>(acc);
  gemm_acc<GMT, 4>(acc, (const u16*)(p->ws + WS_H) + (size_t)m0 * 1024, 1024, (const u16*)(p->ws + WS_WIN) + (size_t)n0 * 1024, 1024, 1024, smem);
  u16* C = (u16*)(p->ws + WS_INPROJ);
  EPI_LOOP(GMT, 4) { int row = EPI_ROW(m0, GMT), col = EPI_COL(n0, 4); if (col < LDI) C[(size_t)row * LDI + col] = f2bf(acc[i][j][r]); }
}

DI void merge_item(KP p, int l, int mt, int nt, unsigned char* smem) {
  const int m0 = mt * 128, n0 = nt * 64;
  const u16* H = (const u16*)(p->ws + WS_H) + (size_t)m0 * 1024;
  const u16* BR = (const u16*)(p->ws + WS_BRANCH) + (size_t)m0 * 1024;
  const float* bm = p->in[33] + l * 4096;
  f32x4 accm[4][2]; zero_acc<4, 2>(accm);
  for (int m = 0; m < 4; ++m) {
    f32x4 ag[4][2], ap[4][2]; zero_acc<4, 2>(ag); zero_acc<4, 2>(ap);
    gemm_acc<4, 2>(ag, H, 1024, (const u16*)(p->ws + WS_WM) + (size_t)(m * 1024 + n0) * 1024, 1024, 1024, smem);
    gemm_acc<4, 2>(ap, BR + m * 256, 1024, (const u16*)(p->ws + WS_WB) + (size_t)(m * 1024 + n0) * 256, 256, 256, smem);
    EPI_LOOP(4, 2) { int col = EPI_COL(n0, 2); accm[i][j][r] += sigm(ag[i][j][r] + bm[m * 1024 + col]) * ap[i][j][r]; }
  }
  u16* C = (u16*)(p->ws + WS_MERGED);
  EPI_LOOP(4, 2) { int row = EPI_ROW(m0, 4), col = EPI_COL(n0, 2); C[(size_t)row * 1024 + col] = f2bf(accm[i][j][r]); }
}

DI void wout_item(KP p, int l, int mt, int nt, unsigned char* smem) {
  const int m0 = mt * (GMT * 32), n0 = nt * 128;
  f32x4 acc[GMT][4]; zero_acc<GMT, 4>(acc);
  gemm_acc<GMT, 4>(acc, (const u16*)(p->ws + WS_MERGED) + (size_t)m0 * 1024, 1024, (const u16*)(p->ws + WS_WO) + (size_t)n0 * 1024, 1024, 1024, smem);
  const float* g1 = (const float*)(p->ws + WS_MOD) + (l * 3 + mod_group(m0)) * 6144 + 2048;
  EPI_LOOP(GMT, 4) { int row = EPI_ROW(m0, GMT), col = EPI_COL(n0, 4); p->out[(size_t)row * DM + col] = x_in_row(p, l, row)[col] + g1[col] * acc[i][j][r]; }
}

DI void w1_item(KP p, int mt, int nt, unsigned char* smem) {
  const int m0 = mt * (GMT * 32), n0 = nt * 128;
  f32x4 acc[GMT][4]; zero_acc<GMT, 4>(acc);
  gemm_acc<GMT, 4>(acc, (const u16*)(p->ws + WS_H) + (size_t)m0 * 1024, 1024, (const u16*)(p->ws + WS_W1) + (size_t)n0 * 1024, 1024, 1024, smem);
  u16* C = (u16*)(p->ws + WS_HIDDEN);
  EPI_LOOP(GMT, 4) { int row = EPI_ROW(m0, GMT), col = EPI_COL(n0, 4); float v = fmaxf(acc[i][j][r], 0.f); C[(size_t)row * 4096 + col] = f2bf(v * v); }
}

DI void w2_item(KP p, int l, int mt, int nt, unsigned char* smem) {
  const int m0 = mt * (GMT * 32), n0 = nt * 128;
  f32x4 acc[GMT][4]; zero_acc<GMT, 4>(acc);
  gemm_acc<GMT, 4>(acc, (const u16*)(p->ws + WS_HIDDEN) + (size_t)m0 * 4096, 4096, (const u16*)(p->ws + WS_W2) + (size_t)n0 * 4096, 4096, 4096, smem);
  const float* g2 = (const float*)(p->ws + WS_MOD) + (l * 3 + mod_group(m0)) * 6144 + 5120;
  EPI_LOOP(GMT, 4) { int row = EPI_ROW(m0, GMT), col = EPI_COL(n0, 4); float* o = p->out + (size_t)row * DM + col; *o = *o + g2[col] * acc[i][j][r]; }
}

DI void prep_item(KP p, int l, int item) {
  const int lane = ltid() & 63, wave = ltid() >> 6;
  const int row = item * 4 + wave;
  const bool lat = row >= 8192;
  u16* R = (u16*)(p->ws + WS_INPROJ) + (size_t)row * LDI;
  float cs = 1.f, sn = 0.f;
  if (lat) {
    int t = (row - 8192) & 4095;
    int pos = (lane < 32) ? (t >> 6) : (t & 63);
    float inv = __expf(-(float)(lane & 15) * (9.210340371976184f / 16.f));
    float ang = (float)pos * inv;
    cs = __cosf(ang); sn = __sinf(ang);
  }
  const int b = row >> 8, t = row & 255;
  float hv[12], vv4[4];
#pragma unroll
  for (int hh = 0; hh < 12; ++hh) {
    const int col = hh < 4 ? C_AQ + hh * 64 : (hh < 6 ? C_AK + (hh - 4) * 64 : (hh < 10 ? C_DQ + (hh - 6) * 64 : C_DK + (hh - 10) * 64));
    hv[hh] = bf2f(R[col + lane]);
  }
  vv4[0] = bf2f(R[C_AV + lane]); vv4[1] = bf2f(R[C_AV + 64 + lane]); vv4[2] = bf2f(R[C_DV + lane]); vv4[3] = bf2f(R[C_DV + 64 + lane]);
#pragma unroll
  for (int hh = 0; hh < 12; ++hh) {
    int col; const float* g;
    if (hh < 4) { col = C_AQ + hh * 64; g = p->in[15] + l * 64; }
    else if (hh < 6) { col = C_AK + (hh - 4) * 64; g = p->in[16] + l * 64; }
    else if (hh < 10) { col = C_DQ + (hh - 6) * 64; g = p->in[29] + l * 64; }
    else { col = C_DK + (hh - 10) * 64; g = p->in[30] + l * 64; }
    float v = hv[hh];
    float ss = wave_sum(v * v);
    float y = v * rsqrtf(ss * (1.f / 64.f) + 1e-6f) * g[lane];
    if (lat) {
      float yp = __shfl_xor(y, 16, 64);
      y = ((lane & 31) < 16) ? (y * cs - yp * sn) : (y * cs + yp * sn);
    } else {
      if (hh == 4 || hh == 5) p->out[O_AK + ((size_t)(b * 2 + l) * 256 + t) * 128 + (hh - 4) * 64 + lane] = y;
      if (hh >= 10) p->out[O_DK + ((size_t)(b * 2 + l) * 256 + t) * 128 + (hh - 10) * 64 + lane] = y;
    }
    R[col + lane] = f2bf(y);
  }
  if (!lat) {
    size_t o = ((size_t)(b * 2 + l) * 256 + t) * 128;
    p->out[O_AV + o + lane] = vv4[0]; p->out[O_AV + o + 64 + lane] = vv4[1];
    p->out[O_DV + o + lane] = vv4[2]; p->out[O_DV + o + 64 + lane] = vv4[3];
  }
}

DI void kvc_item(KP p, int l, int item) {
  u16* KC = (u16*)(p->ws + WS_KC);
#pragma unroll
  for (int it = 0; it < 8; ++it) {
    int idx4 = item * 2048 + it * 256 + ltid();
    int e = idx4 * 4;
    int d = e & 63, key = (e >> 6) & 511, sel = e >> 15;
    int kv = sel & 1, kvh = (sel >> 1) & 1, b = (sel >> 2) & 1, mixer = sel >> 3;
    const float* srcb = mixer ? (kv ? p->in[6] : p->in[5]) : (kv ? p->in[4] : p->in[3]);
    const float* src = srcb + ((size_t)((b * 2 + l) * 512 + key) * 2 + kvh) * 64 + d;
    float4 v = *(const float4*)src;
    *(uint2*)(KC + e) = make_uint2(pack2(v.x, v.y), pack2(v.z, v.w));
  }
}

DI void attn_item(KP p, int l, int it, unsigned char* smem) {
  u16* sK = (u16*)smem;
  u16* sVt = sK + 64 * 72;
  const int tid = ltid(), lane = tid & 63, wave = tid >> 6, lq = lane & 15, quad = lane >> 4;
  int kind, b, qh, qb;
  if (it < 512) { kind = it >> 8; int r = it & 255; b = r >> 7; qh = (r >> 5) & 3; qb = r & 31; }
  else { int r = it - 512; kind = 2 + (r >> 8); r &= 255; b = r >> 3; qh = (r >> 1) & 3; qb = r & 1; }
  const bool isD = (kind == 0 || kind == 3), lat = kind < 2;
  const int seqrow0 = lat ? 8192 + b * 4096 : b * 256;
  const int q0 = qb * 128, kvh = qh >> 1;
  const int qcol = (isD ? C_DQ : C_AQ) + qh * 64, kcol = (isD ? C_DK : C_AK) + kvh * 64, vcol = (isD ? C_DV : C_AV) + kvh * 64;
  const int ocol = (isD ? 768 : 0) + qh * 64;
  const int ncache = lat ? 8 : 0;
  int kt_lo = 0, kt_hi = lat ? 64 : 4;
  if (kind == 1) { kt_lo = max(0, 2 * qb - 2); kt_hi = min(64, 2 * qb + 4); }
  const int ntiles = ncache + kt_hi - kt_lo;
  const bool band = (kind == 1);
  const u16* INP = (const u16*)(p->ws + WS_INPROJ);
  const u16* KCk = (const u16*)(p->ws + WS_KC) + (size_t)((((isD ? 1 : 0) * 2 + b) * 2 + kvh) * 2) * 512 * 64;
  const u16* KCv = KCk + 512 * 64;
  const float sinkv = isD ? -1e30f : p->in[17][l * 4 + qh];

  bf16x8 qf[2][2];
#pragma unroll
  for (int nt = 0; nt < 2; ++nt)
#pragma unroll
    for (int s = 0; s < 2; ++s) qf[nt][s] = ld8(INP + (size_t)(seqrow0 + q0 + wave * 32 + nt * 16 + lq) * LDI + qcol + s * 32 + quad * 8);
  float mrun[2], lsum[2];
  f32x4 oacc[4][2];
#pragma unroll
  for (int nt = 0; nt < 2; ++nt) { mrun[nt] = sinkv; lsum[nt] = (!isD && quad == 0) ? 1.f : 0.f; }
#pragma unroll
  for (int dt = 0; dt < 4; ++dt)
#pragma unroll
    for (int nt = 0; nt < 2; ++nt) oacc[dt][nt] = f32x4{0.f, 0.f, 0.f, 0.f};

  const int key = tid >> 2, seg = (tid & 3) * 16;
  u32x4 rk[2], rv[2];
  auto tile_ptrs = [&](int t, const u16*& kp, const u16*& vp) {
    if (t < ncache) { kp = KCk + (size_t)(t * 64 + key) * 64 + seg; vp = KCv + (size_t)(t * 64 + key) * 64 + seg; }
    else { const u16* rowp = INP + (size_t)(seqrow0 + (kt_lo + t - ncache) * 64 + key) * LDI; kp = rowp + kcol + seg; vp = rowp + vcol + seg; }
  };
  { const u16 *kp, *vp; tile_ptrs(0, kp, vp); rk[0] = *(const u32x4*)kp; rk[1] = *(const u32x4*)(kp + 8); rv[0] = *(const u32x4*)vp; rv[1] = *(const u32x4*)(vp + 8); }
  for (int t = 0; t < ntiles; ++t) {
    __syncthreads();
    *(u32x4*)(sK + key * 72 + seg) = rk[0]; *(u32x4*)(sK + key * 72 + seg + 8) = rk[1];
    {
      unsigned vv[8] = {rv[0].x, rv[0].y, rv[0].z, rv[0].w, rv[1].x, rv[1].y, rv[1].z, rv[1].w};
#pragma unroll
      for (int e = 0; e < 8; ++e) { sVt[(seg + 2 * e) * 72 + key] = (u16)(vv[e] & 0xffffu); sVt[(seg + 2 * e + 1) * 72 + key] = (u16)(vv[e] >> 16); }
    }
    __syncthreads();
    if (t + 1 < ntiles) { const u16 *kp, *vp; tile_ptrs(t + 1, kp, vp); rk[0] = *(const u32x4*)kp; rk[1] = *(const u32x4*)(kp + 8); rv[0] = *(const u32x4*)vp; rv[1] = *(const u32x4*)(vp + 8); }
    f32x4 sacc[4][2];
#pragma unroll
    for (int mt = 0; mt < 4; ++mt) {
      sacc[mt][0] = f32x4{0.f, 0.f, 0.f, 0.f}; sacc[mt][1] = f32x4{0.f, 0.f, 0.f, 0.f};
#pragma unroll
      for (int s = 0; s < 2; ++s) {
        bf16x8 ka = ld8(sK + (mt * 16 + lq) * 72 + s * 32 + quad * 8);
        sacc[mt][0] = MFMA16(ka, qf[0][s], sacc[mt][0]);
        sacc[mt][1] = MFMA16(ka, qf[1][s], sacc[mt][1]);
      }
    }
    const bool masked_tile = band && t >= ncache;
    const int kbase = (kt_lo + t - ncache) * 64;
    bf16x8 pf[2][2];
#pragma unroll
    for (int nt = 0; nt < 2; ++nt) {
      const int qi = q0 + wave * 32 + nt * 16 + lq;
      float tmax = -1e30f;
#pragma unroll
      for (int mt = 0; mt < 4; ++mt)
#pragma unroll
        for (int r = 0; r < 4; ++r) {
          float s = sacc[mt][nt][r] * 0.125f;
          if (masked_tile) { int kj = kbase + mt * 16 + quad * 4 + r; int dlt = qi - kj; if (dlt > 128 || dlt < -128) s = -1e30f; }
          sacc[mt][nt][r] = s; tmax = fmaxf(tmax, s);
        }
      tmax = fmaxf(tmax, __shfl_xor(tmax, 16, 64)); tmax = fmaxf(tmax, __shfl_xor(tmax, 32, 64));
      const float mnew = fmaxf(mrun[nt], tmax);
      const float alpha = __expf(mrun[nt] - mnew);
      float ps = 0.f;
#pragma unroll
      for (int mt = 0; mt < 4; ++mt)
#pragma unroll
        for (int r = 0; r < 4; ++r) { float e = __expf(sacc[mt][nt][r] - mnew); sacc[mt][nt][r] = e; ps += e; }
      lsum[nt] = lsum[nt] * alpha + ps; mrun[nt] = mnew;
#pragma unroll
      for (int dt = 0; dt < 4; ++dt)
#pragma unroll
        for (int r = 0; r < 4; ++r) oacc[dt][nt][r] *= alpha;
      pf[nt][0] = pack8(sacc[0][nt], sacc[1][nt]);
      pf[nt][1] = pack8(sacc[2][nt], sacc[3][nt]);
    }
#pragma unroll
    for (int dt = 0; dt < 4; ++dt)
#pragma unroll
      for (int s2 = 0; s2 < 2; ++s2) {
        bf16x8 va = ldperm(sVt + (dt * 16 + lq) * 72 + s2 * 32 + quad * 4);
        oacc[dt][0] = MFMA16(va, pf[0][s2], oacc[dt][0]);
        oacc[dt][1] = MFMA16(va, pf[1][s2], oacc[dt][1]);
      }
  }
  u16* BR = (u16*)(p->ws + WS_BRANCH);
#pragma unroll
  for (int nt = 0; nt < 2; ++nt) {
    float lt = lsum[nt]; lt += __shfl_xor(lt, 16, 64); lt += __shfl_xor(lt, 32, 64);
    const float inv = 1.f / lt;
    const size_t row = seqrow0 + q0 + wave * 32 + nt * 16 + lq;
#pragma unroll
    for (int dt = 0; dt < 4; ++dt)
      *(uint2*)(BR + row * 1024 + ocol + dt * 16 + quad * 4) = make_uint2(pack2(oacc[dt][nt][0] * inv, oacc[dt][nt][1] * inv), pack2(oacc[dt][nt][2] * inv, oacc[dt][nt][3] * inv));
  }
  __syncthreads();
}

DI int lru_xoff(int t, int c) { return t * 256 + (c ^ ((t & 7) << 3)); }
template <bool FINAL>
DI void lru_item(KP p, int l, int ci, unsigned char* smem) {
  u16* sxb = (u16*)smem;
  u16* sla = sxb + 32 * 256;
  u16* sbv = sla + 32 * 256;
  u16* shf = sbv + 32 * 256;
  const int tid = ltid(), ch = tid, lane = tid & 63, n = tid >> 6, lq = lane & 15, quad = lane >> 4;
  const int r0 = ci * 32;
  const bool lat = r0 >= 8192;
  int b, T, seqrow0;
  if (!lat) { b = r0 >> 8; T = 256; seqrow0 = b * 256; } else { b = (r0 - 8192) >> 12; T = 4096; seqrow0 = 8192 + b * 4096; }
  const int t0 = r0 - seqrow0;
  const u16* INP = (const u16*)(p->ws + WS_INPROJ);
  __syncthreads();
  {
    const float* cw = p->in[18] + l * 4 * 256;
    const float w0 = cw[ch], w1 = cw[256 + ch], w2 = cw[512 + ch], w3 = cw[768 + ch], cb = p->in[19][l * 256 + ch];
    auto ld = [&](int t) -> float { return (t >= 0 && t < T) ? bf2f(INP[(size_t)(seqrow0 + t) * LDI + C_LX + ch]) : 0.f; };
    float xin[35];
#pragma unroll
    for (int q = 0; q < 35; ++q) xin[q] = ld(t0 - 2 + q);
#pragma unroll
    for (int t = 0; t < 32; ++t) sxb[lru_xoff(t, ch)] = f2bf(xin[t] * w0 + xin[t + 1] * w1 + xin[t + 2] * w2 + xin[t + 3] * w3 + cb);
  }
  __syncthreads();
  const int nch = T / 32, c = t0 / 32;
  float* LC = (float*)(p->ws + WS_LRUC);
  bf16x8 af[2][2];
#pragma unroll
  for (int mt = 0; mt < 2; ++mt)
#pragma unroll
    for (int s2 = 0; s2 < 2; ++s2) af[mt][s2] = ld8(sxb + lru_xoff(mt * 16 + lq, n * 64 + s2 * 32 + quad * 8));
  for (int dir = 0; dir < 2; ++dir) {
    bf16x8 wf[2][4][2];
    {
      const u32x4* WF = (const u32x4*)(p->ws + WS_LRUW);
#pragma unroll
      for (int g = 0; g < 2; ++g)
#pragma unroll
        for (int j = 0; j < 4; ++j)
#pragma unroll
          for (int s2 = 0; s2 < 2; ++s2)
            wf[g][j][s2] = __builtin_bit_cast(bf16x8, WF[(size_t)((((((l * 2 + dir) * 2 + g) * 4 + n) * 4 + j) * 2 + s2)) * 64 + lane]);
    }
#pragma unroll
    for (int j = 0; j < 4; ++j) {
      f32x4 acc[2][2];
#pragma unroll
      for (int g = 0; g < 2; ++g) {
        f32x4 a0 = {0.f, 0.f, 0.f, 0.f}, a1 = {0.f, 0.f, 0.f, 0.f};
#pragma unroll
        for (int s2 = 0; s2 < 2; ++s2) { a0 = MFMA16(af[0][s2], wf[g][j][s2], a0); a1 = MFMA16(af[1][s2], wf[g][j][s2], a1); }
        acc[g][0] = a0; acc[g][1] = a1;
      }
      const int cc = n * 64 + j * 16 + lq;
      const float br = p->in[21][(l * 2 + dir) * 256 + cc], bi = p->in[23][(l * 2 + dir) * 256 + cc];
      const float sp = softplusf_(-p->in[24][(l * 2 + dir) * 256 + cc]);
#pragma unroll
      for (int mt = 0; mt < 2; ++mt)
#pragma unroll
        for (int r = 0; r < 4; ++r) {
          const int t = mt * 16 + quad * 4 + r;
          const float la = -8.f * sigm(acc[0][mt][r] + br) * sp;
          const float xt = bf2f(sxb[lru_xoff(t, cc)]);
          const float bb = sqrtf(-expm1f(2.f * la)) * sigm(acc[1][mt][r] + bi) * xt;
          sla[t * 256 + cc] = f2bf(la); sbv[t * 256 + cc] = f2bf(bb);
        }
    }
    __syncthreads();
    float h = 0.f, lasum = 0.f;
    if (FINAL) {
      h = lat ? p->in[7][((b * 2 + l) * 2 + dir) * 256 + ch] : 0.f;
      const int ncar = dir == 0 ? c : nch - 1 - c;
      const int cstart = dir == 0 ? ci - c : ci - c + nch - 1, cstep = dir == 0 ? 1 : -1;
      for (int q0 = 0; q0 < ncar; q0 += 16) {
        float ca[16], chh[16];
#pragma unroll
        for (int q = 0; q < 16; ++q) {
          const int qq = q0 + q < ncar ? q0 + q : ncar - 1;
          const float* C = LC + ((size_t)((cstart + cstep * qq) * 2 + dir) * 2) * 256;
          ca[q] = C[ch]; chh[q] = C[256 + ch];
        }
#pragma unroll
        for (int q = 0; q < 16; ++q) if (q0 + q < ncar) h = ca[q] * h + chh[q];
      }
    }
#pragma unroll 1
    for (int s8 = 0; s8 < 32; s8 += 16) {
      float gv[16];
      if (FINAL && dir == 1) {
#pragma unroll
        for (int q = 0; q < 16; ++q) gv[q] = bf2f(INP[(size_t)(r0 + 31 - s8 - q) * LDI + C_LG + ch]);
      }
#pragma unroll
      for (int q = 0; q < 16; ++q) {
        const int st = s8 + q;
        const int t = dir == 0 ? st : 31 - st;
        const float la = bf2f(sla[t * 256 + ch]);
        h = __expf(la) * h + bf2f(sbv[t * 256 + ch]);
        lasum += la;
        if (FINAL) {
          if (dir == 0) shf[t * 256 + ch] = f2bf(h);
          else ((u16*)(p->ws + WS_BRANCH))[(size_t)(r0 + t) * 1024 + 256 + ch] = f2bf((bf2f(shf[t * 256 + ch]) + h) * gelu_tanh(gv[q]));
        }
      }
    }
    if (!FINAL) { float* C = LC + ((size_t)(ci * 2 + dir) * 2) * 256; C[ch] = __expf(lasum); C[256 + ch] = h; }
    else if (!lat) {
      if (dir == 0 && c == nch - 1) p->out[O_LRU + ((size_t)(b * 2 + l) * 2 + 0) * 256 + ch] = h;
      if (dir == 1 && c == 0) p->out[O_LRU + ((size_t)(b * 2 + l) * 2 + 1) * 256 + ch] = h;
    }
    __syncthreads();
  }
}

template <int DIR, bool ISW>
DI void gdn_solve(const float* L, const u16* src, const float* sb_, const float* se_, u16* UW) {
  float sol[64];
#pragma unroll
  for (int i = 0; i < 64; ++i) {
    float s = bf2f(src[(DIR == 0 ? i : 63 - i) * 72]) * sb_[i];
    if (ISW) s *= se_[i];
    float s0 = 0.f, s1 = 0.f, s2 = 0.f, s3 = 0.f;
#pragma unroll
    for (int j4 = 0; j4 < (i + 3) / 4; ++j4) {
      float4 lv = *(const float4*)(L + i * 64 + j4 * 4);
      if (j4 * 4 + 0 < i) s0 += lv.x * sol[j4 * 4 + 0];
      if (j4 * 4 + 1 < i) s1 += lv.y * sol[j4 * 4 + 1];
      if (j4 * 4 + 2 < i) s2 += lv.z * sol[j4 * 4 + 2];
      if (j4 * 4 + 3 < i) s3 += lv.w * sol[j4 * 4 + 3];
      if ((j4 & 3) == 3) asm volatile("" ::: "memory");
    }
    s -= (s0 + s1) + (s2 + s3);
    sol[i] = s;
    UW[i * 128] = f2bf(s);
    asm volatile("" ::: "memory");
  }
}

DI void gdn1_item(KP p, int l, int item, unsigned char* smem) {
  const int cgi = item >> 2, hd = item & 3;
  u16* sq = (u16*)smem; u16* sk = sq + 64 * 72; u16* sv = sk + 64 * 72;
  float* sL = (float*)(smem + 27648);
  float* sgc = (float*)(smem + 60416);
  float* sbeta = sgc + 128;
  float* sge = sbeta + 128;
  const int tid = ltid(), lane = tid & 63, wave = tid >> 6, lq = lane & 15, quad = lane >> 4;
  const int r0 = cgi * 64;
  const bool lat = r0 >= 8192;
  int T, seqrow0;
  if (!lat) { T = 256; seqrow0 = (r0 >> 8) * 256; } else { T = 4096; seqrow0 = 8192 + ((r0 - 8192) >> 12) * 4096; }
  const int t0 = r0 - seqrow0;
  const u16* INP = (const u16*)(p->ws + WS_INPROJ);
  u16* QHAT = (u16*)(p->ws + WS_QHAT) + (size_t)item * 4096;
  {
    const int d = lane, tb = wave * 16;
#pragma unroll
    for (int mat = 0; mat < 3; ++mat) {
      const int col = C_GQ + mat * 256 + hd * 64 + d, wc = mat * 256 + hd * 64 + d;
      const float* cw = p->in[25] + (size_t)l * 4 * 768;
      const float w0 = cw[wc], w1 = cw[768 + wc], w2 = cw[1536 + wc], w3 = cw[2304 + wc];
      auto ld = [&](int t) -> float { return (t >= 0 && t < T) ? bf2f(INP[(size_t)(seqrow0 + t) * LDI + col]) : 0.f; };
      float xin[19];
#pragma unroll
      for (int q = 0; q < 19; ++q) xin[q] = ld(t0 + tb - 2 + q);
      u16* dst = mat == 0 ? sq : (mat == 1 ? sk : sv);
#pragma unroll
      for (int tt = 0; tt < 16; ++tt) {
        const int t = tb + tt;
        float v = siluf_(xin[tt] * w0 + xin[tt + 1] * w1 + xin[tt + 2] * w2 + xin[tt + 3] * w3);
        if (mat < 2) { float ss = wave_sum(v * v); v *= rsqrtf(ss + 1e-6f) * (mat == 0 ? 0.125f : 1.f); }
        u16 hb = f2bf(v);
        dst[t * 72 + d] = hb;
        if (mat == 0) QHAT[t * 64 + d] = hb;
      }
    }
  }
  if (tid < 128) {
    const int dir = tid >> 6, c = tid & 63;
    const int tok = dir == 0 ? c : 63 - c;
    const u16* R = INP + (size_t)(r0 + tok) * LDI;
    const float ga = bf2f(R[C_GA + dir * 4 + hd]), gb = bf2f(R[C_GB + dir * 4 + hd]);
    const float g = -__expf(p->in[26][(l * 2 + dir) * 4 + hd]) * softplusf_(ga + p->in[27][(l * 2 + dir) * 4 + hd]);
    float gc = g;
#pragma unroll
    for (int o = 1; o < 64; o <<= 1) { float tt = __shfl_up(gc, o, 64); if (lane >= o) gc += tt; }
    const float glast = __shfl(gc, 63, 64);
    sgc[dir * 64 + c] = gc; sbeta[dir * 64 + c] = sigm(gb); sge[dir * 64 + c] = __expf(gc);
    float* gv = (float*)(p->ws + WS_GVEC) + (size_t)(item * 2 + dir) * 256;
    gv[c] = __expf(gc); gv[64 + c] = __expf(glast - gc); if (c == 0) gv[128] = __expf(glast);
  }
  __syncthreads();
  {
    const int dk = tid >> 2, c0 = (tid & 3) * 16;
    unsigned w[8];
#pragma unroll
    for (int e = 0; e < 8; ++e) w[e] = (unsigned)sk[(c0 + 2 * e) * 72 + dk] | ((unsigned)sk[(c0 + 2 * e + 1) * 72 + dk] << 16);
    u16* KT = (u16*)(p->ws + WS_KT) + (size_t)item * 4096 + dk * 64 + c0;
    *(u32x4*)KT = mku4(w[0], w[1], w[2], w[3]); *(u32x4*)(KT + 8) = mku4(w[4], w[5], w[6], w[7]);
  }
  {
    const int i0 = wave * 16;
    f32x4 akk[4], aqk[4];
#pragma unroll
    for (int nt = 0; nt < 4; ++nt) { akk[nt] = f32x4{0.f, 0.f, 0.f, 0.f}; aqk[nt] = f32x4{0.f, 0.f, 0.f, 0.f}; }
#pragma unroll
    for (int s = 0; s < 2; ++s) {
      bf16x8 ak = ld8(sk + (i0 + lq) * 72 + s * 32 + quad * 8), aq = ld8(sq + (i0 + lq) * 72 + s * 32 + quad * 8);
#pragma unroll
      for (int nt = 0; nt < 4; ++nt) { bf16x8 bk = ld8(sk + (nt * 16 + lq) * 72 + s * 32 + quad * 8); akk[nt] = MFMA16(ak, bk, akk[nt]); aqk[nt] = MFMA16(aq, bk, aqk[nt]); }
    }
    u16* QKf = (u16*)(p->ws + WS_QK) + (size_t)(item * 2 + 0) * 4096;
    u16* QKb = (u16*)(p->ws + WS_QK) + (size_t)(item * 2 + 1) * 4096;
#pragma unroll
    for (int nt = 0; nt < 4; ++nt)
#pragma unroll
      for (int r = 0; r < 4; ++r) {
        const int i = i0 + quad * 4 + r, j = nt * 16 + lq, ib = 63 - i, jb = 63 - j;
        const float kkv = akk[nt][r], qkv = aqk[nt][r];
        if (j < i) sL[i * 64 + j] = sbeta[i] * kkv * __expf(sgc[i] - sgc[j]);
        if (j > i) sL[4096 + ib * 64 + jb] = sbeta[64 + ib] * kkv * __expf(sgc[64 + ib] - sgc[64 + jb]);
        QKf[i * 64 + j] = f2bf(j <= i ? qkv * __expf(sgc[i] - sgc[j]) : 0.f);
        QKb[ib * 64 + jb] = f2bf(j >= i ? qkv * __expf(sgc[64 + ib] - sgc[64 + jb]) : 0.f);
      }
  }
  __syncthreads();
  {
    const int col = tid & 127;
    u16* UW = (u16*)(p->ws + WS_UW) + (size_t)(item * 2 + (tid >> 7)) * 8192 + col;
    if (tid < 128) { if (col < 64) gdn_solve<0, false>(sL, sv + col, sbeta, sge, UW); else gdn_solve<0, true>(sL, sk + (col - 64), sbeta, sge, UW); }
    else { if (col < 64) gdn_solve<1, false>(sL + 4096, sv + col, sbeta + 64, sge + 64, UW); else gdn_solve<1, true>(sL + 4096, sk + (col - 64), sbeta + 64, sge + 64, UW); }
  }
  __syncthreads();
}

DI void gdn2_item(KP p, int l, int item, unsigned char* smem, bool dostore) {
  u16* sW = (u16*)smem; u16* sQ = sW + 64 * 72; u16* sQK = sQ + 64 * 72; u16* sKT = sQK + 64 * 72; u16* sU = sKT + 64 * 72;
  float* sg = (float*)(smem + 46080);
  const int tid = ltid(), lane = tid & 63, wave = tid >> 6, lq = lane & 15, quad = lane >> 4;
  int b, hd, dir; bool lat;
  if (item < 16) { lat = true; b = item >> 3; hd = (item >> 1) & 3; dir = item & 1; }
  else { lat = false; int r = item - 16; b = r >> 3; hd = (r >> 1) & 3; dir = r & 1; }
  const int nch = lat ? 64 : 4, cg0 = lat ? 128 + b * 64 : b * 4;
  f32x4 st[4];
#pragma unroll
  for (int kt = 0; kt < 4; ++kt)
#pragma unroll
    for (int r = 0; r < 4; ++r)
      st[kt][r] = lat ? p->in[8][((size_t)(((b * 2 + l) * 2 + dir) * 4 + hd) * 64 + kt * 16 + quad * 4 + r) * 64 + wave * 16 + lq] : 0.f;
  const int lrow = tid >> 2, seg = (tid & 3) * 16;
  u32x4 rW[2], rQ[2], rQK[2], rKT[2], rU[2]; float rg = 0.f;
  const u16* UWb = (const u16*)(p->ws + WS_UW); const u16* QHb = (const u16*)(p->ws + WS_QHAT);
  const u16* KTb = (const u16*)(p->ws + WS_KT); u16* QKb = (u16*)(p->ws + WS_QK);
  const float* GV = (const float*)(p->ws + WS_GVEC);
  auto gload = [&](int n) {
    const int cgi = dir == 0 ? cg0 + n : cg0 + nch - 1 - n;
    const size_t prob = (size_t)cgi * 4 + hd, pd = prob * 2 + dir;
    const u16* u = UWb + (pd * 64 + lrow) * 128 + seg;
    rU[0] = *(const u32x4*)u; rU[1] = *(const u32x4*)(u + 8); rW[0] = *(const u32x4*)(u + 64); rW[1] = *(const u32x4*)(u + 72);
    const u16* q = QHb + (prob * 64 + (dir ? 63 - lrow : lrow)) * 64 + seg;
    rQ[0] = *(const u32x4*)q; rQ[1] = *(const u32x4*)(q + 8);
    const u16* qk = QKb + (pd * 64 + lrow) * 64 + seg;
    rQK[0] = *(const u32x4*)qk; rQK[1] = *(const u32x4*)(qk + 8);
    const u16* kt = KTb + (prob * 64 + lrow) * 64 + (dir ? 48 - seg : seg);
    u32x4 a = *(const u32x4*)kt, bb = *(const u32x4*)(kt + 8);
    if (dir) { rKT[0] = rev8(bb); rKT[1] = rev8(a); } else { rKT[0] = a; rKT[1] = bb; }
    rg = GV[pd * 256 + (tid & 255)];
  };
  gload(0);
  for (int n = 0; n < nch; ++n) {
    const int cgi = dir == 0 ? cg0 + n : cg0 + nch - 1 - n;
    const size_t pd = ((size_t)cgi * 4 + hd) * 2 + dir;
    __syncthreads();
    *(u32x4*)(sW + lrow * 72 + seg) = rW[0]; *(u32x4*)(sW + lrow * 72 + seg + 8) = rW[1];
    *(u32x4*)(sQ + lrow * 72 + seg) = rQ[0]; *(u32x4*)(sQ + lrow * 72 + seg + 8) = rQ[1];
    *(u32x4*)(sQK + lrow * 72 + seg) = rQK[0]; *(u32x4*)(sQK + lrow * 72 + seg + 8) = rQK[1];
    *(u32x4*)(sKT + lrow * 72 + seg) = rKT[0]; *(u32x4*)(sKT + lrow * 72 + seg + 8) = rKT[1];
    *(u32x4*)(sU + lrow * 72 + seg) = rU[0]; *(u32x4*)(sU + lrow * 72 + seg + 8) = rU[1];
    sg[tid] = rg;
    __syncthreads();
    if (n + 1 < nch) gload(n + 1);
    const float elast = sg[128];
    bf16x8 sB[2] = {pack8(st[0], st[1]), pack8(st[2], st[3])};
    f32x4 vn[4], oo[4];
#pragma unroll
    for (int mt = 0; mt < 4; ++mt) {
      f32x4 acc = {0.f, 0.f, 0.f, 0.f}, acq = {0.f, 0.f, 0.f, 0.f};
#pragma unroll
      for (int s2 = 0; s2 < 2; ++s2) {
        acc = MFMA16(ldperm(sW + (mt * 16 + lq) * 72 + s2 * 32 + quad * 4), sB[s2], acc);
        acq = MFMA16(ldperm(sQ + (mt * 16 + lq) * 72 + s2 * 32 + quad * 4), sB[s2], acq);
      }
#pragma unroll
      for (int r = 0; r < 4; ++r) {
        const int c = mt * 16 + quad * 4 + r;
        vn[mt][r] = bf2f(sU[c * 72 + wave * 16 + lq]) - acc[r];
        oo[mt][r] = acq[r] * sg[c];
      }
    }
    bf16x8 vB[2] = {pack8(vn[0], vn[1]), pack8(vn[2], vn[3])};
#pragma unroll
    for (int mt = 0; mt < 4; ++mt) {
#pragma unroll
      for (int s2 = 0; s2 < 2; ++s2) oo[mt] = MFMA16(ldperm(sQK + (mt * 16 + lq) * 72 + s2 * 32 + quad * 4), vB[s2], oo[mt]);
    }
    f32x4 vs[4];
#pragma unroll
    for (int mt = 0; mt < 4; ++mt)
#pragma unroll
      for (int r = 0; r < 4; ++r) vs[mt][r] = vn[mt][r] * sg[64 + mt * 16 + quad * 4 + r];
    bf16x8 vsB[2] = {pack8(vs[0], vs[1]), pack8(vs[2], vs[3])};
#pragma unroll
    for (int kt = 0; kt < 4; ++kt) {
      f32x4 acc = {0.f, 0.f, 0.f, 0.f};
#pragma unroll
      for (int s2 = 0; s2 < 2; ++s2) acc = MFMA16(ldperm(sKT + (kt * 16 + lq) * 72 + s2 * 32 + quad * 4), vsB[s2], acc);
#pragma unroll
      for (int r = 0; r < 4; ++r) st[kt][r] = elast * st[kt][r] + acc[r];
    }
    u16* O = QKb + pd * 4096;
    if (dostore) {
#pragma unroll
    for (int mt = 0; mt < 4; ++mt)
#pragma unroll
      for (int r = 0; r < 4; ++r) O[(mt * 16 + quad * 4 + r) * 64 + wave * 16 + lq] = f2bf(oo[mt][r]);
    }
  }
  if (!lat && dostore) {
#pragma unroll
    for (int kt = 0; kt < 4; ++kt)
#pragma unroll
      for (int r = 0; r < 4; ++r)
        p->out[O_GDN + ((size_t)(((b * 2 + l) * 2 + dir) * 4 + hd) * 64 + kt * 16 + quad * 4 + r) * 64 + wave * 16 + lq] = st[kt][r];
  }
  __syncthreads();
}

DI void gdnfin_item(KP p, int l, int item) {
  const int cgi = item >> 2, hd = item & 3;
  const int lane = ltid() & 63, wave = ltid() >> 6;
  const u16* Of = (const u16*)(p->ws + WS_QK) + (size_t)(item * 2 + 0) * 4096;
  const u16* Ob = (const u16*)(p->ws + WS_QK) + (size_t)(item * 2 + 1) * 4096;
  const float gn = p->in[28][l * 64 + lane];
  float ov[16], zv[16];
#pragma unroll
  for (int q = 0; q < 16; ++q) {
    const int c = wave * 16 + q;
    ov[q] = bf2f(Of[c * 64 + lane]) + bf2f(Ob[(63 - c) * 64 + lane]);
    zv[q] = bf2f(((const u16*)(p->ws + WS_INPROJ))[((size_t)cgi * 64 + c) * LDI + C_GZ + hd * 64 + lane]);
  }
#pragma unroll
  for (int q = 0; q < 16; ++q) {
    const int c = wave * 16 + q;
    const size_t row = (size_t)cgi * 64 + c;
    float o = ov[q];
    float ss = wave_sum(o * o);
    float z = zv[q];
    float y = o * rsqrtf(ss * (1.f / 64.f) + 1e-6f) * gn * siluf_(z);
    ((u16*)(p->ws + WS_BRANCH))[row * 1024 + 512 + hd * 64 + lane] = f2bf(y);
  }
}


#define XB_TMO      128
#define XB_XCNT(j)  (256  + 64 * (j))
#define XB_XSUB(j)  (1280 + 64 * (j))
#define XB_XGEN(j)  (2304 + 64 * (j))
#define XB_TOP      3328
#define XB_TOPGEN   3392
#define XB_SPIN_CAP (1u << 20)
#define LAS __attribute__((address_space(3)))
DI unsigned xb_ld(unsigned* q) { return __hip_atomic_load(q, __ATOMIC_RELAXED, __HIP_MEMORY_SCOPE_AGENT); }
DI unsigned xb_add(unsigned* q, unsigned v) { return __hip_atomic_fetch_add(q, v, __ATOMIC_RELAXED, __HIP_MEMORY_SCOPE_AGENT); }
DI unsigned xb_xcc_id() { return (unsigned)__builtin_amdgcn_s_getreg((3 << 11) | 20) & 0xFu; }
#define XB_SPIN(cond, bar) do { unsigned _sp = 0; while (cond) { __builtin_amdgcn_s_sleep(1); \
    if ((++_sp & 255u) == 0u) { if (xb_ld(&(bar)[XB_TMO])) break; if (_sp > XB_SPIN_CAP) { atomicAdd(&(bar)[XB_TMO], 1u); break; } } } } while (0)
DI void xcd_barrier_complete(unsigned* bar, unsigned x, unsigned& nloc, unsigned& nx) {
  const unsigned G = gridDim.x;
  unsigned sum, cnt, mine, sp = 0u;
  for (;;) {
    sum = 0u; cnt = 0u; mine = 0u;
#pragma unroll
    for (unsigned j = 0; j < 16; ++j) { const unsigned c = xb_ld(&bar[XB_XCNT(j)]); sum += c; cnt += (c > 0u) ? 1u : 0u; mine = (j == x) ? c : mine; }
    if (sum == G) break;
    __builtin_amdgcn_s_sleep(1);
    if ((++sp & 255u) == 0u) { if (xb_ld(&bar[XB_TMO])) break; if (sp > XB_SPIN_CAP) { atomicAdd(&bar[XB_TMO], 1u); break; } }
  }
  nloc = mine > 0u ? mine : 1u; nx = cnt > 0u ? cnt : 1u;
}
DI void xcd_barrier(unsigned* bar, volatile LAS unsigned* st) {
  asm volatile("s_waitcnt vmcnt(0)" ::: "memory");
  __syncthreads();
  if (ltid() == 0) {
    const unsigned x = xb_xcc_id();
    __builtin_amdgcn_s_waitcnt(0);
    unsigned nloc = st[0], nx = st[1];
    if (nloc == 0u) { xcd_barrier_complete(bar, x, nloc, nx); st[0] = nloc; st[1] = nx; }
    const unsigned old = xb_add(&bar[XB_XSUB(x)], 1u);
    const unsigned gen = old / nloc;
    if (old + 1u == (gen + 1u) * nloc) {
      __builtin_amdgcn_fence(__ATOMIC_RELEASE, "agent");
      asm volatile("s_waitcnt vmcnt(0)" ::: "memory");
      const unsigned og = xb_add(&bar[XB_TOP], 1u);
      const unsigned tg = og / nx;
      if (og + 1u == (tg + 1u) * nx) xb_add(&bar[XB_TOPGEN], 1u);
      else XB_SPIN(xb_ld(&bar[XB_TOPGEN]) == tg, bar);
      __builtin_amdgcn_fence(__ATOMIC_ACQUIRE, "agent");
      xb_add(&bar[XB_XGEN(x)], 1u);
      asm volatile("s_waitcnt vmcnt(0)" ::: "memory");
    } else {
      XB_SPIN(xb_ld(&bar[XB_XGEN(x)]) == gen, bar);
      __builtin_amdgcn_fence(__ATOMIC_ACQUIRE, "agent");
      asm volatile("s_waitcnt vmcnt(0)" ::: "memory");
    }
  }
  __syncthreads();
}


#define FOR_TILES(MTI, NTI, SM, SN, CALL)                                                      \
  do {                                                                                         \
    if (G % 8 != 0) { for (int it_ = B; it_ < (MTI) * (NTI); it_ += G) { const int mt = it_ / (NTI), nt = it_ % (NTI); CALL; } } \
    else {                                                                                     \
      const int xcd_ = B & 7, j_ = B >> 3, J_ = G >> 3;                                        \
      const int nsm_ = ((MTI) + (SM) - 1) / (SM), nsn_ = ((NTI) + (SN) - 1) / (SN);            \
      for (int s_ = xcd_; s_ < nsm_ * nsn_; s_ += 8) {                                         \
        const int sm_ = s_ / nsn_, sn_ = s_ % nsn_;                                            \
        for (int t_ = j_; t_ < (SM) * (SN); t_ += J_) {                                        \
          const int mt = sm_ * (SM) + t_ / (SN), nt = sn_ * (SN) + t_ % (SN);                  \
          if (mt < (MTI) && nt < (NTI)) { CALL; }                                              \
        }                                                                                      \
      }                                                                                        \
    }                                                                                          \
  } while (0)

constexpr int NPHASE = 21;
__global__ void __launch_bounds__(256, 2) mk(Params p_unused, int ph_lo, int ph_hi) {
  extern __shared__ __attribute__((aligned(1024))) unsigned char smem[];
  int& s_item = *(int*)(smem + SMEM_BYTES);
  u32x4& xb_words = *(u32x4*)(smem + SMEM_BYTES + 16);
  const int G = gridDim.x, B = blockIdx.x;
  const bool fused = ph_hi - ph_lo > 1;
  if (fused) {
    if (ltid() == 0) { xb_words = u32x4{0u, 0u, 0u, 0u}; (void)xb_add(&((unsigned*)(((KP)__builtin_amdgcn_kernarg_segment_ptr())->ws + WS_BAR))[XB_XCNT(xb_xcc_id())], 1u); }
    __syncthreads();
  }
  for (int ph = ph_lo; ph < ph_hi; ++ph) {
    KP p = (KP)__builtin_amdgcn_kernarg_segment_ptr();
    asm volatile("" : "+s"(p));
    if (ph == 0) {
      for (int it = B; it < 192 + CONV_ITEMS + 64; it += G) { for (int rep = 0; rep < NREP(0); ++rep) { if (it < 192) mod_item(p, it, smem); else if (it < 192 + CONV_ITEMS) convert_item(p, 0, it - 192, smem); else lruw_item(p, it - 192 - CONV_ITEMS); } }
    } else {
      const int l = (ph - 1) / 10, sub = (ph - 1) % 10;
      switch (sub) {
        case 0:
          for (int it = B; it < 4096 + (l ? CONV_ITEMS : 0); it += G) { for (int rep = 0; rep < NREP(0); ++rep) { if (it < 4096) norm_item<0>(p, l, it); else convert_item(p, l, it - 4096, smem); } }
          break;
        case 1: FOR_TILES(128, 21, 8, 7, inproj_item(p, mt, nt, smem)); break;
        case 2:
          for (int it = B; it < 1024 + 512 + 64 + 4096; it += G) {
            if (it < 1024) { for (int rep = 0; rep < NREP(4); ++rep) gdn1_item(p, l, it, smem); }
            else if (it < 1536) { for (int rep = 0; rep < NREP(5); ++rep) lru_item<false>(p, l, it - 1024, smem); }
            else if (it < 1600) { if (PHON(6)) kvc_item(p, l, it - 1536); }
            else if (PHON(6)) prep_item(p, l, it - 1600);
          }
          break;
        case 3: {
          int* ctr = (int*)(p->ws + WS_CTR) + l;
          for (;;) {
            __syncthreads();
            if (ltid() == 0) s_item = atomicAdd(ctr, 1);
            __syncthreads();
            const int it = s_item;
            if (it >= 16 + 256 + 256 + 256 + 512 + 512) break;
            if (it < 16) { for (int rep = 0; rep < NREP(7); ++rep) gdn2_item(p, l, it, smem, rep == NREP(7) - 1); }
            else if (it < 272) { for (int rep = 0; rep < NREP(8); ++rep) attn_item(p, l, it - 16, smem); }
            else if (it < 528) { for (int rep = 0; rep < NREP(6); ++rep) gdn2_item(p, l, it - 272 + 16, smem, rep == NREP(6) - 1); }
            else if (it < 784) { for (int rep = 0; rep < NREP(8); ++rep) attn_item(p, l, it - 528 + 256, smem); }
            else if (it < 1296) { for (int rep = 0; rep < NREP(9); ++rep) lru_item<true>(p, l, it - 784, smem); }
            else for (int rep = 0; rep < NREP(8); ++rep) attn_item(p, l, it - 1296 + 512, smem);
          }
        } break;
        case 4: for (int it = B; it < 1024; it += G) for (int rep = 0; rep < NREP(0); ++rep) gdnfin_item(p, l, it); break;
        case 5: FOR_TILES(128, 16, 8, 8, merge_item(p, l, mt, nt, smem)); break;
        case 6: FOR_TILES(128, 8, 8, 8, wout_item(p, l, mt, nt, smem)); break;
        case 7: for (int it = B; it < 4096; it += G) for (int rep = 0; rep < NREP(0); ++rep) norm_item<1>(p, l, it); break;
        case 8: FOR_TILES(128, 32, 8, 8, w1_item(p, mt, nt, smem)); break;
        case 9: FOR_TILES(128, 8, 8, 8, w2_item(p, l, mt, nt, smem)); break;
      }
    }
    if (ph + 1 < ph_hi) {
      if (ph == ph_lo) cg::this_grid().sync();
      else for (int rep = 0; rep < NREP(1); ++rep) xcd_barrier((unsigned*)(p->ws + WS_BAR), (volatile LAS unsigned*)&xb_words);
    }
  }
}

extern "C" void kernel_launch(void* const* d_in, const int* in_sizes, int n_in, void* d_out, int out_size, void* d_ws, size_t ws_size, hipStream_t stream) {
  static int grid_blocks = 0;
  if (!grid_blocks) {
    int dev = 0, cus = 0, per_cu = 0;
    (void)hipGetDevice(&dev);
    (void)hipDeviceGetAttribute(&cus, hipDeviceAttributeMultiprocessorCount, dev);
    if (hipFuncSetAttribute((const void*)mk, hipFuncAttributeMaxDynamicSharedMemorySize, DYN_LDS) != hipSuccess) fprintf(stderr, "kernel_launch: hipFuncSetAttribute failed\n");
    (void)hipOccupancyMaxActiveBlocksPerMultiprocessor(&per_cu, mk, 256, DYN_LDS);
    if (per_cu < 1) per_cu = 1;
    if (per_cu > 2) per_cu = 2;
    grid_blocks = cus * per_cu;
    if (ws_size < WS_END) fprintf(stderr, "kernel_launch: workspace too small: %zu < %zu\n", ws_size, (size_t)WS_END);
  }
  if (hipMemsetAsync((char*)d_ws + WS_CTR, 0, 256 + 3456 * 4 + 256, stream) != hipSuccess) fprintf(stderr, "kernel_launch: memset failed\n");
  Params p{};
  for (int i = 0; i < 37; ++i) p.in[i] = (const float*)d_in[i];
  p.out = (float*)d_out; p.ws = (unsigned char*)d_ws;
#if MULTI_LAUNCH
  for (int ph = 0; ph < NPHASE; ++ph) hipLaunchKernelGGL(mk, dim3(grid_blocks), dim3(256), DYN_LDS, stream, p, ph, ph + 1);
#else
  int lo = 0, hi = NPHASE;
  void* args[] = {&p, &lo, &hi};
  hipError_t e = hipLaunchCooperativeKernel((void*)mk, dim3(grid_blocks), dim3(256), args, DYN_LDS, stream);
  if (e != hipSuccess) fprintf(stderr, "cooperative launch failed: %s (grid %d)\n", hipGetErrorString(e), grid_blocks);
#endif
}
```

```cpp
#include <hip/hip_runtime.h>
#include <hip/hip_cooperative_groups.h>
#include <cstdio>
namespace cg = cooperative_groups;

#ifndef MULTI_LAUNCH
#define MULTI_LAUNCH 0
#endif
#ifndef PHM
#define PHM 0xFFFFFFFFu
#endif
#define PHON(b) ((PHM >> (b)) & 1u)
#ifndef DUPM
#define DUPM 0u
#endif
#define NREP(b) (1 + ((DUPM >> (b)) & 1u))

typedef unsigned short u16;
using bf16x8 = __attribute__((ext_vector_type(8))) short;
using f32x4 = __attribute__((ext_vector_type(4))) float;
using u32x4 = __attribute__((ext_vector_type(4))) unsigned;
#define DI __device__ __forceinline__
#define MFMA16(a, b, c) __builtin_amdgcn_mfma_f32_16x16x32_bf16((a), (b), (c), 0, 0, 0)

constexpr int NTOK = 16384;
constexpr int DM = 1024;
constexpr int LDI = 2592;
constexpr int C_AQ = 0, C_AK = 256, C_AV = 384, C_LX = 512, C_LG = 768, C_GQ = 1024, C_GK = 1280, C_GV = 1536, C_GZ = 1792,
              C_DQ = 2048, C_DK = 2304, C_DV = 2432, C_GA = 2560, C_GB = 2568;
constexpr int NIN_PAD = 2688;

constexpr size_t WS_MOD = 0;
constexpr size_t WS_CTR = WS_MOD + 2 * 3 * 6144 * 4;
constexpr size_t WS_BAR = WS_CTR + 256;
constexpr size_t WS_LRUC = WS_BAR + 3456 * 4 + 256;
constexpr size_t WS_KC = WS_LRUC + (size_t)512 * 2 * 2 * 256 * 4;
constexpr size_t WS_GVEC = WS_KC + (size_t)16 * 512 * 64 * 2;
constexpr size_t WS_LRUW = WS_GVEC + (size_t)1024 * 2 * 256 * 4;
constexpr size_t WS_WIN = WS_LRUW + (size_t)256 * 64 * 16;
constexpr size_t WS_WM = WS_WIN + (size_t)NIN_PAD * 1024 * 2;
constexpr size_t WS_WB = WS_WM + (size_t)4096 * 1024 * 2;
constexpr size_t WS_WO = WS_WB + (size_t)4 * 1024 * 256 * 2;
constexpr size_t WS_W1 = WS_WO + (size_t)1024 * 1024 * 2;
constexpr size_t WS_W2 = WS_W1 + (size_t)4096 * 1024 * 2;
constexpr size_t WS_H = WS_W2 + (size_t)1024 * 4096 * 2;
constexpr size_t WS_BIG = WS_H + (size_t)NTOK * 1024 * 2;
constexpr size_t WS_INPROJ = WS_BIG;
constexpr size_t WS_BRANCH = WS_INPROJ + (size_t)NTOK * LDI * 2;
constexpr size_t WS_QHAT = WS_BRANCH + (size_t)NTOK * 1024 * 2;
constexpr size_t WS_KT = WS_QHAT + (size_t)1024 * 4096 * 2;
constexpr size_t WS_UW = WS_KT + (size_t)1024 * 4096 * 2;
constexpr size_t WS_QK = WS_UW + (size_t)1024 * 2 * 8192 * 2;
constexpr size_t WS_END = WS_QK + (size_t)1024 * 2 * 4096 * 2;
constexpr size_t WS_HIDDEN = WS_BIG;
constexpr size_t WS_MERGED = WS_BIG;
static_assert(WS_HIDDEN + (size_t)NTOK * 4096 * 2 <= WS_END, "hidden must fit");
static_assert(WS_END <= (size_t)256 * 1024 * 1024, "workspace budget");

constexpr size_t O_X = 0, O_AK = 16777216, O_AV = 18874368, O_DK = 20971520, O_DV = 23068672, O_LRU = 25165824, O_GDN = 25198592;

struct Params {
  const float* in[37];
  float* out;
  unsigned char* ws;
};

typedef const Params __attribute__((address_space(4)))* KP;
constexpr int SMEM_BYTES = 65536;
constexpr int DYN_LDS = SMEM_BYTES + 64;

DI int ltid() { int t = threadIdx.x; asm volatile("" : "+v"(t)); return t; }
typedef __bf16 bf16v2 __attribute__((ext_vector_type(2)));
DI u16 f2bf(float x) { __bf16 h = (__bf16)x; return __builtin_bit_cast(u16, h); }
DI float bf2f(u16 h) { return __uint_as_float(((unsigned)h) << 16); }
DI unsigned pack2(float a, float b) { bf16v2 v = {(__bf16)a, (__bf16)b}; return __builtin_bit_cast(unsigned, v); }
DI float bflo(unsigned u) { return __uint_as_float(u << 16); }
DI float bfhi(unsigned u) { return __uint_as_float(u & 0xffff0000u); }
DI float sigm(float x) { return 1.f / (1.f + __expf(-x)); }
DI float siluf_(float x) { return x / (1.f + __expf(-x)); }
DI float softplusf_(float x) { return x > 20.f ? x : log1pf(__expf(x)); }
DI float gelu_tanh(float x) { float u = 0.7978845608028654f * (x + 0.044715f * x * x * x); float t = 1.f - 2.f / (__expf(2.f * u) + 1.f); return 0.5f * x * (1.f + t); }
DI float wave_sum(float v) {
#pragma unroll
  for (int o = 32; o > 0; o >>= 1) v += __shfl_xor(v, o, 64);
  return v;
}
DI u32x4 mku4(unsigned a, unsigned b, unsigned c, unsigned d) { u32x4 v = {a, b, c, d}; return v; }
DI bf16x8 mk8(unsigned a, unsigned b, unsigned c, unsigned d) { u32x4 v = {a, b, c, d}; return __builtin_bit_cast(bf16x8, v); }
DI bf16x8 pack8(const f32x4& x, const f32x4& y) { return mk8(pack2(x[0], x[1]), pack2(x[2], x[3]), pack2(y[0], y[1]), pack2(y[2], y[3])); }
DI bf16x8 ld8(const u16* p) { return *(const bf16x8*)p; }
DI bf16x8 ldperm(const u16* p) { uint2 a = *(const uint2*)p; uint2 b = *(const uint2*)(p + 16); return mk8(a.x, a.y, b.x, b.y); }
DI int mod_group(int row) { return row < 8192 ? 0 : 1 + ((row - 8192) >> 12); }
DI const float* x_in_row(KP p, int l, int row) {
  if (l == 0) return row < 8192 ? p->in[0] + (size_t)row * DM : p->in[1] + (size_t)(row - 8192) * DM;
  return p->out + (size_t)row * DM;
}
DI unsigned swap16(unsigned u) { return (u >> 16) | (u << 16); }
DI u32x4 rev8(u32x4 v) { return mku4(swap16(v.w), swap16(v.z), swap16(v.y), swap16(v.x)); }

DI void mod_item(KP p, int item, unsigned char* smem) {
  float* sc = (float*)smem;
  float* sr = sc + 3072;
  const int tid = ltid();
  const int l = item / 96, cb = item % 96;
  for (int i = tid; i < 3072; i += 256) {
    int g = i >> 10, k = i & 1023;
    float c = g == 0 ? p->in[9][k] : p->in[2][(g - 1) * 1024 + k];
    sc[i] = siluf_(c);
  }
  __syncthreads();
  const int col = cb * 64 + (tid & 63), kg = tid >> 6;
  const float* W = p->in[10] + (size_t)l * 1024 * 6144;
  float a0 = 0.f, a1 = 0.f, a2 = 0.f;
  for (int k = kg * 256; k < kg * 256 + 256; ++k) {
    float w = W[(size_t)k * 6144 + col];
    a0 += sc[k] * w; a1 += sc[1024 + k] * w; a2 += sc[2048 + k] * w;
  }
  sr[(kg * 3 + 0) * 64 + (tid & 63)] = a0; sr[(kg * 3 + 1) * 64 + (tid & 63)] = a1; sr[(kg * 3 + 2) * 64 + (tid & 63)] = a2;
  __syncthreads();
  if (tid < 192) {
    int g = tid >> 6, cc = tid & 63;
    float s = p->in[11][l * 6144 + cb * 64 + cc];
    for (int q = 0; q < 4; ++q) s += sr[(q * 3 + g) * 64 + cc];
    ((float*)(p->ws + WS_MOD))[(l * 3 + g) * 6144 + cb * 64 + cc] = s;
  }
  __syncthreads();
}

DI void conv_tile(const float* src, int N, int k0, int n0, u16* dst, int K, bool perm, unsigned char* smem) {
  float* tile = (float*)smem;
  const int tid = ltid();
#pragma unroll
  for (int i = 0; i < 4; ++i) {
    int kr = (tid >> 4) + 16 * i, nc = (tid & 15) * 4;
    float4 v = make_float4(0.f, 0.f, 0.f, 0.f);
    if (n0 + nc < N) v = *(const float4*)(src + (size_t)(k0 + kr) * N + n0 + nc);
    tile[kr * 65 + nc] = v.x; tile[kr * 65 + nc + 1] = v.y; tile[kr * 65 + nc + 2] = v.z; tile[kr * 65 + nc + 3] = v.w;
  }
  __syncthreads();
#pragma unroll
  for (int i = 0; i < 2; ++i) {
    int n = (tid >> 3) + 32 * i, k8 = (tid & 7) * 8;
    int ng = n0 + n;
    if (ng < N) {
      int row = ng;
      if (perm) row = ng < 2048 ? ng : (ng < 2064 ? 2560 + (ng - 2048) : ng - 16);
      u32x4 o;
      o.x = pack2(tile[(k8 + 0) * 65 + n], tile[(k8 + 1) * 65 + n]);
      o.y = pack2(tile[(k8 + 2) * 65 + n], tile[(k8 + 3) * 65 + n]);
      o.z = pack2(tile[(k8 + 4) * 65 + n], tile[(k8 + 5) * 65 + n]);
      o.w = pack2(tile[(k8 + 6) * 65 + n], tile[(k8 + 7) * 65 + n]);
      *(u32x4*)(dst + (size_t)row * K + k0 + k8) = o;
    }
  }
  __syncthreads();
}

constexpr int CONV_ITEMS = 4241;
DI void convert_item(KP p, int l, int item, unsigned char* smem) {
  unsigned char* ws = p->ws;
  if (item < 656) { int kt = item / 41, nt = item % 41; conv_tile(p->in[14] + (size_t)l * 1024 * 2576, 2576, kt * 64, nt * 64, (u16*)(ws + WS_WIN), 1024, true, smem); return; }
  item -= 656;
  if (item < 1024) { int kt = item >> 6, nt = item & 63; conv_tile(p->in[32] + (size_t)l * 1024 * 4096, 4096, kt * 64, nt * 64, (u16*)(ws + WS_WM), 1024, false, smem); return; }
  item -= 1024;
  if (item < 256) { int m = item >> 6, r = item & 63, kt = r >> 4, nt = r & 15;
    conv_tile(p->in[31] + ((size_t)l * 4 + m) * 256 * 1024, 1024, kt * 64, nt * 64, (u16*)(ws + WS_WB) + (size_t)m * 1024 * 256, 256, false, smem); return; }
  item -= 256;
  if (item < 256) { int kt = item >> 4, nt = item & 15; conv_tile(p->in[34] + (size_t)l * 1024 * 1024, 1024, kt * 64, nt * 64, (u16*)(ws + WS_WO), 1024, false, smem); return; }
  item -= 256;
  if (item < 1024) { int kt = item >> 6, nt = item & 63; conv_tile(p->in[35] + (size_t)l * 1024 * 4096, 4096, kt * 64, nt * 64, (u16*)(ws + WS_W1), 1024, false, smem); return; }
  item -= 1024;
  if (item < 1024) { int kt = item >> 4, nt = item & 15; conv_tile(p->in[36] + (size_t)l * 4096 * 1024, 1024, kt * 64, nt * 64, (u16*)(ws + WS_W2), 4096, false, smem); return; }
  u32x4* z = (u32x4*)((u16*)(ws + WS_WIN) + (size_t)2576 * 1024);
  for (int i = ltid(); i < 112 * 1024 / 8; i += 256) z[i] = mku4(0, 0, 0, 0);
}

DI void lruw_item(KP p, int item) {
  const int gid = item * 256 + ltid();
  const int lane = gid & 63, fg = gid >> 6;
  const int s2 = fg & 1, j = (fg >> 1) & 3, n = (fg >> 3) & 3, g = (fg >> 5) & 1, ld_ = fg >> 6;
  const int lq = lane & 15, quad = lane >> 4;
  const float* W = (g == 0 ? p->in[20] : p->in[22]) + ((size_t)(ld_ * 4 + n) * 64) * 64 + (size_t)(s2 * 32 + quad * 8) * 64 + j * 16 + lq;
  u32x4 o = {pack2(W[0], W[64]), pack2(W[128], W[192]), pack2(W[256], W[320]), pack2(W[384], W[448])};
  ((u32x4*)(p->ws + WS_LRUW))[gid] = o;
}

template <int which>
DI void norm_item(KP p, int l, int item) {
  const int lane = ltid() & 63, wave = ltid() >> 6;
  const int row = item * 4 + wave;
  const float* x = x_in_row(p, which == 0 ? l : 2, row);
  const float* g = p->in[which == 0 ? 12 : 13] + l * 1024;
  const float* mod = (const float*)(p->ws + WS_MOD) + (l * 3 + mod_group(row)) * 6144;
  const float* sh = mod + (which == 0 ? 0 : 3072);
  const float* sc = mod + (which == 0 ? 1024 : 4096);
  f32x4 v[4]; float ss = 0.f;
#pragma unroll
  for (int i = 0; i < 4; ++i) { v[i] = *(const f32x4*)(x + i * 256 + lane * 4); ss += v[i].x * v[i].x + v[i].y * v[i].y + v[i].z * v[i].z + v[i].w * v[i].w; }
  ss = wave_sum(ss);
  const float rstd = rsqrtf(ss * (1.f / 1024.f) + 1e-6f);
  u16* H = (u16*)(p->ws + WS_H) + (size_t)row * 1024;
#pragma unroll
  for (int i = 0; i < 4; ++i) {
    int c = i * 256 + lane * 4;
    float4 gg = *(const float4*)(g + c), s1 = *(const float4*)(sc + c), s0 = *(const float4*)(sh + c);
    float y0 = v[i].x * rstd * gg.x * (1.f + s1.x) + s0.x, y1 = v[i].y * rstd * gg.y * (1.f + s1.y) + s0.y;
    float y2 = v[i].z * rstd * gg.z * (1.f + s1.z) + s0.z, y3 = v[i].w * rstd * gg.w * (1.f + s1.w) + s0.w;
    *(uint2*)(H + c) = make_uint2(pack2(y0, y1), pack2(y2, y3));
  }
}

DI int lds_byte(int r, int c) {
  int st = (r >> 4) * 2 + (c >> 5), ob = (r & 15) * 64 + (c & 31) * 2;
  return st * 1024 + (ob ^ (((ob >> 9) & 1) << 5));
}
DI void stage_rc(int b, int& R, int& C) {
  int st = b >> 10, sb = b & 1023, swz = sb ^ (((sb >> 9) & 1) << 5);
  R = (st >> 1) * 16 + (swz >> 6);
  C = (st & 1) * 32 + ((swz & 63) >> 1);
}
template <int MT, int NT, bool pre = false>
DI void gemm_acc(f32x4 (&acc)[MT][NT], const u16* __restrict__ A, int lda, const u16* __restrict__ Bt, int ldb, int K, unsigned char* smem,
                 const u16* nxtA = nullptr, int nlda = 0, const u16* nxtB = nullptr, int nldb = 0) {
  constexpr int TA = MT * 32 * 128, TB = NT * 32 * 128, STAGE = TA + TB;
  static_assert(2 * STAGE <= 65536, "LDS");
  const int tid = ltid(), lane = tid & 63, wid = tid >> 6, wm = wid >> 1, wn = wid & 1;
  const int fr = lane & 15, fq = lane >> 4;
  const u16* ga[MT]; const u16* gb[NT];
#pragma unroll
  for (int i = 0; i < MT; ++i) { int R, C; stage_rc(wid * 1024 + i * 4096 + lane * 16, R, C); ga[i] = A + (size_t)R * lda + C; }
#pragma unroll
  for (int i = 0; i < NT; ++i) { int R, C; stage_rc(wid * 1024 + i * 4096 + lane * 16, R, C); gb[i] = Bt + (size_t)R * ldb + C; }
#define GLDS_STAGE(buf, k0)                                                                                                        \
  do {                                                                                                                             \
    _Pragma("unroll") for (int i = 0; i < MT; ++i)                                                                                 \
      __builtin_amdgcn_global_load_lds((const unsigned*)(ga[i] + (k0)), (unsigned*)(smem + (buf) * STAGE + wid * 1024 + i * 4096), 16, 0, 0); \
    _Pragma("unroll") for (int i = 0; i < NT; ++i)                                                                                 \
      __builtin_amdgcn_global_load_lds((const unsigned*)(gb[i] + (k0)), (unsigned*)(smem + (buf) * STAGE + TA + wid * 1024 + i * 4096), 16, 0, 0); \
  } while (0)
  if (!pre) {
    __syncthreads();
    GLDS_STAGE(0, 0);
  }
  asm volatile("s_waitcnt vmcnt(0)" ::: "memory");
  __syncthreads();
  const int nt = K >> 6;
  for (int t = 0; t < nt; ++t) {
    const int cur = t & 1;
    if (t + 1 < nt) GLDS_STAGE(cur ^ 1, (t + 1) * 64);
    const unsigned char* sA = smem + cur * STAGE;
    const unsigned char* sB = sA + TA;
#pragma unroll
    for (int s = 0; s < 2; ++s) {
      bf16x8 bfr[NT];
#pragma unroll
      for (int j = 0; j < NT; ++j) bfr[j] = *(const bf16x8*)(sB + lds_byte(wn * NT * 16 + j * 16 + fr, s * 32 + fq * 8));
#pragma unroll
      for (int i = 0; i < MT; ++i) {
        bf16x8 af = *(const bf16x8*)(sA + lds_byte(wm * MT * 16 + i * 16 + fr, s * 32 + fq * 8));
#pragma unroll
        for (int j = 0; j < NT; ++j) acc[i][j] = MFMA16(af, bfr[j], acc[i][j]);
      }
    }
    asm volatile("s_waitcnt vmcnt(0)" ::: "memory");
    __syncthreads();
  }
  if (nxtA) {
#pragma unroll
    for (int i = 0; i < MT; ++i) { int R, C; stage_rc(wid * 1024 + i * 4096 + lane * 16, R, C);
      __builtin_amdgcn_global_load_lds((const unsigned*)(nxtA + (unsigned)(R * nlda + C)), (unsigned*)(smem + wid * 1024 + i * 4096), 16, 0, 0); }
#pragma unroll
    for (int i = 0; i < NT; ++i) { int R, C; stage_rc(wid * 1024 + i * 4096 + lane * 16, R, C);
      __builtin_amdgcn_global_load_lds((const unsigned*)(nxtB + (unsigned)(R * nldb + C)), (unsigned*)(smem + TA + wid * 1024 + i * 4096), 16, 0, 0); }
  }
#undef GLDS_STAGE
}

template <int MT, int NT>
DI void gemm_prefetch(const u16* A, int lda, const u16* Bt, int ldb, unsigned char* smem) {
  constexpr int TA = MT * 32 * 128;
  const int tid = ltid(), lane = tid & 63, wid = tid >> 6;
  __syncthreads();
#pragma unroll
  for (int i = 0; i < MT; ++i) { int R, C; stage_rc(wid * 1024 + i * 4096 + lane * 16, R, C);
    __builtin_amdgcn_global_load_lds((const unsigned*)(A + (unsigned)(R * lda + C)), (unsigned*)(smem + wid * 1024 + i * 4096), 16, 0, 0); }
#pragma unroll
  for (int i = 0; i < NT; ++i) { int R, C; stage_rc(wid * 1024 + i * 4096 + lane * 16, R, C);
    __builtin_amdgcn_global_load_lds((const unsigned*)(Bt + (unsigned)(R * ldb + C)), (unsigned*)(smem + TA + wid * 1024 + i * 4096), 16, 0, 0); }
}

template <int MT, int NT> DI void zero_acc(f32x4 (&acc)[MT][NT]) {
#pragma unroll
  for (int i = 0; i < MT; ++i)
#pragma unroll
    for (int j = 0; j < NT; ++j) acc[i][j] = f32x4{0.f, 0.f, 0.f, 0.f};
}

#define EPI_LOOP(MT, NT)                                                          \
  const int tid_ = ltid(), lane_ = tid_ & 63, wave_ = tid_ >> 6;                   \
  const int wm_ = wave_ >> 1, wn_ = wave_ & 1, lq_ = lane_ & 15, quad_ = lane_ >> 4; \
  _Pragma("unroll") for (int i = 0; i < MT; ++i)                                   \
  _Pragma("unroll") for (int j = 0; j < NT; ++j)                                   \
  _Pragma("unroll") for (int r = 0; r < 4; ++r)
#define EPI_ROW(m0, MT) ((m0) + wm_ * (MT) * 16 + i * 16 + quad_ * 4 + r)
#define EPI_COL(n0, NT) ((n0) + wn_ * (NT) * 16 + j * 16 + lq_)

constexpr int GMT = 4;
DI void inproj_item(KP p, int mt, int nt, unsigned char* smem) {
  const int m0 = mt * (GMT * 32), n0 = nt * 128;
  f32x4 acc[GMT][4]; zero_acc<GMT, 4>(acc);
  gemm_acc<GMT, 4>(acc, (const u16*)(p->ws + WS_H) + (size_t)m0 * 1024, 1024, (const u16*)(p->ws + WS_WIN) + (size_t)n0 * 1024, 1024, 1024, smem);
  u16* C = (u16*)(p->ws + WS_INPROJ);
  EPI_LOOP(GMT, 4) { int row = EPI_ROW(m0, GMT), col = EPI_COL(n0, 4); if (col < LDI) C[(size_t)row * LDI + col] = f2bf(acc[i][j][r]); }
}

DI void merge_item(KP p, int l, int mt, int nt, unsigned char* smem) {
  const int m0 = mt * 128, n0 = nt * 128;
  const u16* H = (const u16*)(p->ws + WS_H) + (size_t)m0 * 1024;
  const u16* BR = (const u16*)(p->ws + WS_BRANCH) + (size_t)m0 * 1024;
  const float* bm = p->in[33] + l * 4096;
  const u16* WM = (const u16*)(p->ws + WS_WM) + (size_t)n0 * 1024;
  const u16* WB = (const u16*)(p->ws + WS_WB) + (size_t)n0 * 256;
  unsigned am[4][4][2];
#pragma unroll
  for (int i = 0; i < 4; ++i)
#pragma unroll
    for (int j = 0; j < 4; ++j) { am[i][j][0] = 0u; am[i][j][1] = 0u; }
  gemm_prefetch<4, 4>(BR, 1024, WB, 256, smem);
#pragma unroll 1
  for (int m = 0; m < 4; ++m) {
    f32x4 acc[4][4]; zero_acc<4, 4>(acc);
    gemm_acc<4, 4, true>(acc, BR + m * 256, 1024, WB + (size_t)m * 1024 * 256, 256, 256, smem, H, 1024, WM + (size_t)m * 1024 * 1024, 1024);
    unsigned pp[4][4][2];
#pragma unroll
    for (int i = 0; i < 4; ++i)
#pragma unroll
      for (int j = 0; j < 4; ++j) { pp[i][j][0] = pack2(acc[i][j][0], acc[i][j][1]); pp[i][j][1] = pack2(acc[i][j][2], acc[i][j][3]); }
    zero_acc<4, 4>(acc);
    gemm_acc<4, 4, true>(acc, H, 1024, WM + (size_t)m * 1024 * 1024, 1024, 1024, smem,
                         m < 3 ? BR + (m + 1) * 256 : nullptr, 1024, WB + (size_t)(m + 1) * 1024 * 256, 256);
    {
      const int tid_ = ltid(), wn_ = (tid_ >> 6) & 1, lq_ = tid_ & 15;
      float bias4[4];
#pragma unroll
      for (int j = 0; j < 4; ++j) bias4[j] = bm[m * 1024 + n0 + wn_ * 64 + j * 16 + lq_];
#pragma unroll
      for (int i = 0; i < 4; ++i) {
#pragma unroll
        for (int j = 0; j < 4; ++j) {
          float v0 = bflo(am[i][j][0]) + sigm(acc[i][j][0] + bias4[j]) * bflo(pp[i][j][0]);
          float v1 = bfhi(am[i][j][0]) + sigm(acc[i][j][1] + bias4[j]) * bfhi(pp[i][j][0]);
          float v2 = bflo(am[i][j][1]) + sigm(acc[i][j][2] + bias4[j]) * bflo(pp[i][j][1]);
          float v3 = bfhi(am[i][j][1]) + sigm(acc[i][j][3] + bias4[j]) * bfhi(pp[i][j][1]);
          am[i][j][0] = pack2(v0, v1); am[i][j][1] = pack2(v2, v3);
          asm volatile("" : "+v"(am[i][j][0]), "+v"(am[i][j][1]));
          __builtin_amdgcn_sched_barrier(0);
        }
      }
    }
  }
  u16* C = (u16*)(p->ws + WS_MERGED);
  EPI_LOOP(4, 4) { int row = EPI_ROW(m0, 4), col = EPI_COL(n0, 4); const unsigned w = am[i][j][r >> 1]; C[(size_t)row * 1024 + col] = (u16)((r & 1) ? (w >> 16) : (w & 0xffffu)); }
}

DI void wout_item(KP p, int l, int mt, int nt, unsigned char* smem) {
  const int m0 = mt * (GMT * 32), n0 = nt * 128;
  f32x4 acc[GMT][4]; zero_acc<GMT, 4>(acc);
  gemm_acc<GMT, 4>(acc, (const u16*)(p->ws + WS_MERGED) + (size_t)m0 * 1024, 1024, (const u16*)(p->ws + WS_WO) + (size_t)n0 * 1024, 1024, 1024, smem);
  const float* g1 = (const float*)(p->ws + WS_MOD) + (l * 3 + mod_group(m0)) * 6144 + 2048;
  EPI_LOOP(GMT, 4) { int row = EPI_ROW(m0, GMT), col = EPI_COL(n0, 4); p->out[(size_t)row * DM + col] = x_in_row(p, l, row)[col] + g1[col] * acc[i][j][r]; }
}

DI void w1_item(KP p, int mt, int nt, unsigned char* smem) {
  const int m0 = mt * (GMT * 32), n0 = nt * 128;
  f32x4 acc[GMT][4]; zero_acc<GMT, 4>(acc);
  gemm_acc<GMT, 4>(acc, (const u16*)(p->ws + WS_H) + (size_t)m0 * 1024, 1024, (const u16*)(p->ws + WS_W1) + (size_t)n0 * 1024, 1024, 1024, smem);
  u16* C = (u16*)(p->ws + WS_HIDDEN);
  EPI_LOOP(GMT, 4) { int row = EPI_ROW(m0, GMT), col = EPI_COL(n0, 4); float v = fmaxf(acc[i][j][r], 0.f); C[(size_t)row * 4096 + col] = f2bf(v * v); }
}

DI void w2_item(KP p, int l, int mt, int nt, unsigned char* smem) {
  const int m0 = mt * (GMT * 32), n0 = nt * 128;
  f32x4 acc[GMT][4]; zero_acc<GMT, 4>(acc);
  gemm_acc<GMT, 4>(acc, (const u16*)(p->ws + WS_HIDDEN) + (size_t)m0 * 4096, 4096, (const u16*)(p->ws + WS_W2) + (size_t)n0 * 4096, 4096, 4096, smem);
  const float* g2 = (const float*)(p->ws + WS_MOD) + (l * 3 + mod_group(m0)) * 6144 + 5120;
  EPI_LOOP(GMT, 4) { int row = EPI_ROW(m0, GMT), col = EPI_COL(n0, 4); float* o = p->out + (size_t)row * DM + col; *o = *o + g2[col] * acc[i][j][r]; }
}

DI void prep_item(KP p, int l, int item) {
  const int lane = ltid() & 63, wave = ltid() >> 6;
  const int row = item * 4 + wave;
  const bool lat = row >= 8192;
  u16* R = (u16*)(p->ws + WS_INPROJ) + (size_t)row * LDI;
  float cs = 1.f, sn = 0.f;
  if (lat) {
    int t = (row - 8192) & 4095;
    int pos = (lane < 32) ? (t >> 6) : (t & 63);
    float inv = __expf(-(float)(lane & 15) * (9.210340371976184f / 16.f));
    float ang = (float)pos * inv;
    cs = __cosf(ang); sn = __sinf(ang);
  }
  const int b = row >> 8, t = row & 255;
  float hv[12], vv4[4];
#pragma unroll
  for (int hh = 0; hh < 12; ++hh) {
    const int col = hh < 4 ? C_AQ + hh * 64 : (hh < 6 ? C_AK + (hh - 4) * 64 : (hh < 10 ? C_DQ + (hh - 6) * 64 : C_DK + (hh - 10) * 64));
    hv[hh] = bf2f(R[col + lane]);
  }
  vv4[0] = bf2f(R[C_AV + lane]); vv4[1] = bf2f(R[C_AV + 64 + lane]); vv4[2] = bf2f(R[C_DV + lane]); vv4[3] = bf2f(R[C_DV + 64 + lane]);
#pragma unroll
  for (int hh = 0; hh < 12; ++hh) {
    int col; const float* g;
    if (hh < 4) { col = C_AQ + hh * 64; g = p->in[15] + l * 64; }
    else if (hh < 6) { col = C_AK + (hh - 4) * 64; g = p->in[16] + l * 64; }
    else if (hh < 10) { col = C_DQ + (hh - 6) * 64; g = p->in[29] + l * 64; }
    else { col = C_DK + (hh - 10) * 64; g = p->in[30] + l * 64; }
    float v = hv[hh];
    float ss = wave_sum(v * v);
    float y = v * rsqrtf(ss * (1.f / 64.f) + 1e-6f) * g[lane];
    if (lat) {
      float yp = __shfl_xor(y, 16, 64);
      y = ((lane & 31) < 16) ? (y * cs - yp * sn) : (y * cs + yp * sn);
    } else {
      if (hh == 4 || hh == 5) p->out[O_AK + ((size_t)(b * 2 + l) * 256 + t) * 128 + (hh - 4) * 64 + lane] = y;
      if (hh >= 10) p->out[O_DK + ((size_t)(b * 2 + l) * 256 + t) * 128 + (hh - 10) * 64 + lane] = y;
    }
    R[col + lane] = f2bf(y);
  }
  if (!lat) {
    size_t o = ((size_t)(b * 2 + l) * 256 + t) * 128;
    p->out[O_AV + o + lane] = vv4[0]; p->out[O_AV + o + 64 + lane] = vv4[1];
    p->out[O_DV + o + lane] = vv4[2]; p->out[O_DV + o + 64 + lane] = vv4[3];
  }
}

DI void kvc_item(KP p, int l, int item) {
  u16* KC = (u16*)(p->ws + WS_KC);
#pragma unroll
  for (int it = 0; it < 8; ++it) {
    int idx4 = item * 2048 + it * 256 + ltid();
    int e = idx4 * 4;
    int d = e & 63, key = (e >> 6) & 511, sel = e >> 15;
    int kv = sel & 1, kvh = (sel >> 1) & 1, b = (sel >> 2) & 1, mixer = sel >> 3;
    const float* srcb = mixer ? (kv ? p->in[6] : p->in[5]) : (kv ? p->in[4] : p->in[3]);
    const float* src = srcb + ((size_t)((b * 2 + l) * 512 + key) * 2 + kvh) * 64 + d;
    float4 v = *(const float4*)src;
    *(uint2*)(KC + e) = make_uint2(pack2(v.x, v.y), pack2(v.z, v.w));
  }
}

DI void attn_item(KP p, int l, int it, unsigned char* smem) {
  u16* sK = (u16*)smem;
  u16* sVt = sK + 64 * 72;
  const int tid = ltid(), lane = tid & 63, wave = tid >> 6, lq = lane & 15, quad = lane >> 4;
  int kind, b, qh, qb;
  if (it < 512) { kind = it >> 8; int r = it & 255; b = r >> 7; qh = (r >> 5) & 3; qb = r & 31; }
  else { int r = it - 512; kind = 2 + (r >> 8); r &= 255; b = r >> 3; qh = (r >> 1) & 3; qb = r & 1; }
  const bool isD = (kind == 0 || kind == 3), lat = kind < 2;
  const int seqrow0 = lat ? 8192 + b * 4096 : b * 256;
  const int q0 = qb * 128, kvh = qh >> 1;
  const int qcol = (isD ? C_DQ : C_AQ) + qh * 64, kcol = (isD ? C_DK : C_AK) + kvh * 64, vcol = (isD ? C_DV : C_AV) + kvh * 64;
  const int ocol = (isD ? 768 : 0) + qh * 64;
  const int ncache = lat ? 8 : 0;
  int kt_lo = 0, kt_hi = lat ? 64 : 4;
  if (kind == 1) { kt_lo = max(0, 2 * qb - 2); kt_hi = min(64, 2 * qb + 4); }
  const int ntiles = ncache + kt_hi - kt_lo;
  const bool band = (kind == 1);
  const u16* INP = (const u16*)(p->ws + WS_INPROJ);
  const u16* KCk = (const u16*)(p->ws + WS_KC) + (size_t)((((isD ? 1 : 0) * 2 + b) * 2 + kvh) * 2) * 512 * 64;
  const u16* KCv = KCk + 512 * 64;
  const float sinkv = isD ? -1e30f : p->in[17][l * 4 + qh];

  bf16x8 qf[2][2];
#pragma unroll
  for (int nt = 0; nt < 2; ++nt)
#pragma unroll
    for (int s = 0; s < 2; ++s) qf[nt][s] = ld8(INP + (size_t)(seqrow0 + q0 + wave * 32 + nt * 16 + lq) * LDI + qcol + s * 32 + quad * 8);
  float mrun[2], lsum[2];
  f32x4 oacc[4][2];
#pragma unroll
  for (int nt = 0; nt < 2; ++nt) { mrun[nt] = sinkv; lsum[nt] = (!isD && quad == 0) ? 1.f : 0.f; }
#pragma unroll
  for (int dt = 0; dt < 4; ++dt)
#pragma unroll
    for (int nt = 0; nt < 2; ++nt) oacc[dt][nt] = f32x4{0.f, 0.f, 0.f, 0.f};

  const int key = tid >> 2, seg = (tid & 3) * 16;
  u32x4 rk[2], rv[2];
  auto tile_ptrs = [&](int t, const u16*& kp, const u16*& vp) {
    if (t < ncache) { kp = KCk + (size_t)(t * 64 + key) * 64 + seg; vp = KCv + (size_t)(t * 64 + key) * 64 + seg; }
    else { const u16* rowp = INP + (size_t)(seqrow0 + (kt_lo + t - ncache) * 64 + key) * LDI; kp = rowp + kcol + seg; vp = rowp + vcol + seg; }
  };
  { const u16 *kp, *vp; tile_ptrs(0, kp, vp); rk[0] = *(const u32x4*)kp; rk[1] = *(const u32x4*)(kp + 8); rv[0] = *(const u32x4*)vp; rv[1] = *(const u32x4*)(vp + 8); }
  for (int t = 0; t < ntiles; ++t) {
    __syncthreads();
    *(u32x4*)(sK + key * 72 + seg) = rk[0]; *(u32x4*)(sK + key * 72 + seg + 8) = rk[1];
    {
      unsigned vv[8] = {rv[0].x, rv[0].y, rv[0].z, rv[0].w, rv[1].x, rv[1].y, rv[1].z, rv[1].w};
#pragma unroll
      for (int e = 0; e < 8; ++e) { sVt[(seg + 2 * e) * 72 + key] = (u16)(vv[e] & 0xffffu); sVt[(seg + 2 * e + 1) * 72 + key] = (u16)(vv[e] >> 16); }
    }
    __syncthreads();
    if (t + 1 < ntiles) { const u16 *kp, *vp; tile_ptrs(t + 1, kp, vp); rk[0] = *(const u32x4*)kp; rk[1] = *(const u32x4*)(kp + 8); rv[0] = *(const u32x4*)vp; rv[1] = *(const u32x4*)(vp + 8); }
    f32x4 sacc[4][2];
#pragma unroll
    for (int mt = 0; mt < 4; ++mt) {
      sacc[mt][0] = f32x4{0.f, 0.f, 0.f, 0.f}; sacc[mt][1] = f32x4{0.f, 0.f, 0.f, 0.f};
#pragma unroll
      for (int s = 0; s < 2; ++s) {
        bf16x8 ka = ld8(sK + (mt * 16 + lq) * 72 + s * 32 + quad * 8);
        sacc[mt][0] = MFMA16(ka, qf[0][s], sacc[mt][0]);
        sacc[mt][1] = MFMA16(ka, qf[1][s], sacc[mt][1]);
      }
    }
    const bool masked_tile = band && t >= ncache;
    const int kbase = (kt_lo + t - ncache) * 64;
    bf16x8 pf[2][2];
#pragma unroll
    for (int nt = 0; nt < 2; ++nt) {
      const int qi = q0 + wave * 32 + nt * 16 + lq;
      float tmax = -1e30f;
#pragma unroll
      for (int mt = 0; mt < 4; ++mt)
#pragma unroll
        for (int r = 0; r < 4; ++r) {
          float s = sacc[mt][nt][r] * 0.125f;
          if (masked_tile) { int kj = kbase + mt * 16 + quad * 4 + r; int dlt = qi - kj; if (dlt > 128 || dlt < -128) s = -1e30f; }
          sacc[mt][nt][r] = s; tmax = fmaxf(tmax, s);
        }
      tmax = fmaxf(tmax, __shfl_xor(tmax, 16, 64)); tmax = fmaxf(tmax, __shfl_xor(tmax, 32, 64));
      const float mnew = fmaxf(mrun[nt], tmax);
      const float alpha = __expf(mrun[nt] - mnew);
      float ps = 0.f;
#pragma unroll
      for (int mt = 0; mt < 4; ++mt)
#pragma unroll
        for (int r = 0; r < 4; ++r) { float e = __expf(sacc[mt][nt][r] - mnew); sacc[mt][nt][r] = e; ps += e; }
      lsum[nt] = lsum[nt] * alpha + ps; mrun[nt] = mnew;
#pragma unroll
      for (int dt = 0; dt < 4; ++dt)
#pragma unroll
        for (int r = 0; r < 4; ++r) oacc[dt][nt][r] *= alpha;
      pf[nt][0] = pack8(sacc[0][nt], sacc[1][nt]);
      pf[nt][1] = pack8(sacc[2][nt], sacc[3][nt]);
    }
#pragma unroll
    for (int dt = 0; dt < 4; ++dt)
#pragma unroll
      for (int s2 = 0; s2 < 2; ++s2) {
        bf16x8 va = ldperm(sVt + (dt * 16 + lq) * 72 + s2 * 32 + quad * 4);
        oacc[dt][0] = MFMA16(va, pf[0][s2], oacc[dt][0]);
        oacc[dt][1] = MFMA16(va, pf[1][s2], oacc[dt][1]);
      }
  }
  u16* BR = (u16*)(p->ws + WS_BRANCH);
#pragma unroll
  for (int nt = 0; nt < 2; ++nt) {
    float lt = lsum[nt]; lt += __shfl_xor(lt, 16, 64); lt += __shfl_xor(lt, 32, 64);
    const float inv = 1.f / lt;
    const size_t row = seqrow0 + q0 + wave * 32 + nt * 16 + lq;
#pragma unroll
    for (int dt = 0; dt < 4; ++dt)
      *(uint2*)(BR + row * 1024 + ocol + dt * 16 + quad * 4) = make_uint2(pack2(oacc[dt][nt][0] * inv, oacc[dt][nt][1] * inv), pack2(oacc[dt][nt][2] * inv, oacc[dt][nt][3] * inv));
  }
  __syncthreads();
}

DI int lru_xoff(int t, int c) { return t * 256 + (c ^ ((t & 7) << 3)); }
template <bool FINAL>
DI void lru_item(KP p, int l, int ci, unsigned char* smem) {
  u16* sxb = (u16*)smem;
  u16* sla = sxb + 32 * 256;
  u16* sbv = sla + 32 * 256;
  u16* shf = sbv + 32 * 256;
  const int tid = ltid(), ch = tid, lane = tid & 63, n = tid >> 6, lq = lane & 15, quad = lane >> 4;
  const int r0 = ci * 32;
  const bool lat = r0 >= 8192;
  int b, T, seqrow0;
  if (!lat) { b = r0 >> 8; T = 256; seqrow0 = b * 256; } else { b = (r0 - 8192) >> 12; T = 4096; seqrow0 = 8192 + b * 4096; }
  const int t0 = r0 - seqrow0;
  const u16* INP = (const u16*)(p->ws + WS_INPROJ);
  __syncthreads();
  {
    const float* cw = p->in[18] + l * 4 * 256;
    const float w0 = cw[ch], w1 = cw[256 + ch], w2 = cw[512 + ch], w3 = cw[768 + ch], cb = p->in[19][l * 256 + ch];
    auto ld = [&](int t) -> float { return (t >= 0 && t < T) ? bf2f(INP[(size_t)(seqrow0 + t) * LDI + C_LX + ch]) : 0.f; };
    float xin[35];
#pragma unroll
    for (int q = 0; q < 35; ++q) xin[q] = ld(t0 - 2 + q);
#pragma unroll
    for (int t = 0; t < 32; ++t) sxb[lru_xoff(t, ch)] = f2bf(xin[t] * w0 + xin[t + 1] * w1 + xin[t + 2] * w2 + xin[t + 3] * w3 + cb);
  }
  __syncthreads();
  const int nch = T / 32, c = t0 / 32;
  float* LC = (float*)(p->ws + WS_LRUC);
  bf16x8 af[2][2];
#pragma unroll
  for (int mt = 0; mt < 2; ++mt)
#pragma unroll
    for (int s2 = 0; s2 < 2; ++s2) af[mt][s2] = ld8(sxb + lru_xoff(mt * 16 + lq, n * 64 + s2 * 32 + quad * 8));
  for (int dir = 0; dir < 2; ++dir) {
    bf16x8 wf[2][4][2];
    {
      const u32x4* WF = (const u32x4*)(p->ws + WS_LRUW);
#pragma unroll
      for (int g = 0; g < 2; ++g)
#pragma unroll
        for (int j = 0; j < 4; ++j)
#pragma unroll
          for (int s2 = 0; s2 < 2; ++s2)
            wf[g][j][s2] = __builtin_bit_cast(bf16x8, WF[(size_t)((((((l * 2 + dir) * 2 + g) * 4 + n) * 4 + j) * 2 + s2)) * 64 + lane]);
    }
#pragma unroll
    for (int j = 0; j < 4; ++j) {
      f32x4 acc[2][2];
#pragma unroll
      for (int g = 0; g < 2; ++g) {
        f32x4 a0 = {0.f, 0.f, 0.f, 0.f}, a1 = {0.f, 0.f, 0.f, 0.f};
#pragma unroll
        for (int s2 = 0; s2 < 2; ++s2) { a0 = MFMA16(af[0][s2], wf[g][j][s2], a0); a1 = MFMA16(af[1][s2], wf[g][j][s2], a1); }
        acc[g][0] = a0; acc[g][1] = a1;
      }
      const int cc = n * 64 + j * 16 + lq;
      const float br = p->in[21][(l * 2 + dir) * 256 + cc], bi = p->in[23][(l * 2 + dir) * 256 + cc];
      const float sp = softplusf_(-p->in[24][(l * 2 + dir) * 256 + cc]);
#pragma unroll
      for (int mt = 0; mt < 2; ++mt)
#pragma unroll
        for (int r = 0; r < 4; ++r) {
          const int t = mt * 16 + quad * 4 + r;
          const float la = -8.f * sigm(acc[0][mt][r] + br) * sp;
          const float xt = bf2f(sxb[lru_xoff(t, cc)]);
          const float bb = sqrtf(-expm1f(2.f * la)) * sigm(acc[1][mt][r] + bi) * xt;
          sla[t * 256 + cc] = f2bf(la); sbv[t * 256 + cc] = f2bf(bb);
        }
    }
    __syncthreads();
    float h = 0.f, lasum = 0.f;
    if (FINAL) {
      h = lat ? p->in[7][((b * 2 + l) * 2 + dir) * 256 + ch] : 0.f;
      const int ncar = dir == 0 ? c : nch - 1 - c;
      const int cstart = dir == 0 ? ci - c : ci - c + nch - 1, cstep = dir == 0 ? 1 : -1;
      for (int q0 = 0; q0 < ncar; q0 += 16) {
        float ca[16], chh[16];
#pragma unroll
        for (int q = 0; q < 16; ++q) {
          const int qq = q0 + q < ncar ? q0 + q : ncar - 1;
          const float* C = LC + ((size_t)((cstart + cstep * qq) * 2 + dir) * 2) * 256;
          ca[q] = C[ch]; chh[q] = C[256 + ch];
        }
#pragma unroll
        for (int q = 0; q < 16; ++q) if (q0 + q < ncar) h = ca[q] * h + chh[q];
      }
    }
#pragma unroll 1
    for (int s8 = 0; s8 < 32; s8 += 16) {
      float gv[16];
      if (FINAL && dir == 1) {
#pragma unroll
        for (int q = 0; q < 16; ++q) gv[q] = bf2f(INP[(size_t)(r0 + 31 - s8 - q) * LDI + C_LG + ch]);
      }
#pragma unroll
      for (int q = 0; q < 16; ++q) {
        const int st = s8 + q;
        const int t = dir == 0 ? st : 31 - st;
        const float la = bf2f(sla[t * 256 + ch]);
        h = __expf(la) * h + bf2f(sbv[t * 256 + ch]);
        lasum += la;
        if (FINAL) {
          if (dir == 0) shf[t * 256 + ch] = f2bf(h);
          else ((u16*)(p->ws + WS_BRANCH))[(size_t)(r0 + t) * 1024 + 256 + ch] = f2bf((bf2f(shf[t * 256 + ch]) + h) * gelu_tanh(gv[q]));
        }
      }
    }
    if (!FINAL) { float* C = LC + ((size_t)(ci * 2 + dir) * 2) * 256; C[ch] = __expf(lasum); C[256 + ch] = h; }
    else if (!lat) {
      if (dir == 0 && c == nch - 1) p->out[O_LRU + ((size_t)(b * 2 + l) * 2 + 0) * 256 + ch] = h;
      if (dir == 1 && c == 0) p->out[O_LRU + ((size_t)(b * 2 + l) * 2 + 1) * 256 + ch] = h;
    }
    __syncthreads();
  }
}

template <int DIR, bool ISW>
DI void gdn_solve(const float* L, const u16* src, const float* sb_, const float* se_, u16* UW) {
  float sol[64];
#pragma unroll
  for (int i = 0; i < 64; ++i) {
    float s = bf2f(src[(DIR == 0 ? i : 63 - i) * 72]) * sb_[i];
    if (ISW) s *= se_[i];
    float s0 = 0.f, s1 = 0.f, s2 = 0.f, s3 = 0.f;
#pragma unroll
    for (int j4 = 0; j4 < (i + 3) / 4; ++j4) {
      float4 lv = *(const float4*)(L + i * 64 + j4 * 4);
      if (j4 * 4 + 0 < i) s0 += lv.x * sol[j4 * 4 + 0];
      if (j4 * 4 + 1 < i) s1 += lv.y * sol[j4 * 4 + 1];
      if (j4 * 4 + 2 < i) s2 += lv.z * sol[j4 * 4 + 2];
      if (j4 * 4 + 3 < i) s3 += lv.w * sol[j4 * 4 + 3];
      if ((j4 & 3) == 3) asm volatile("" ::: "memory");
    }
    s -= (s0 + s1) + (s2 + s3);
    sol[i] = s;
    UW[i * 128] = f2bf(s);
    asm volatile("" ::: "memory");
  }
}

DI void gdn1_item(KP p, int l, int item, unsigned char* smem) {
  const int cgi = item >> 2, hd = item & 3;
  u16* sq = (u16*)smem; u16* sk = sq + 64 * 72; u16* sv = sk + 64 * 72;
  float* sL = (float*)(smem + 27648);
  float* sgc = (float*)(smem + 60416);
  float* sbeta = sgc + 128;
  float* sge = sbeta + 128;
  const int tid = ltid(), lane = tid & 63, wave = tid >> 6, lq = lane & 15, quad = lane >> 4;
  const int r0 = cgi * 64;
  const bool lat = r0 >= 8192;
  int T, seqrow0;
  if (!lat) { T = 256; seqrow0 = (r0 >> 8) * 256; } else { T = 4096; seqrow0 = 8192 + ((r0 - 8192) >> 12) * 4096; }
  const int t0 = r0 - seqrow0;
  const u16* INP = (const u16*)(p->ws + WS_INPROJ);
  u16* QHAT = (u16*)(p->ws + WS_QHAT) + (size_t)item * 4096;
  {
    const int d = lane, tb = wave * 16;
#pragma unroll
    for (int mat = 0; mat < 3; ++mat) {
      const int col = C_GQ + mat * 256 + hd * 64 + d, wc = mat * 256 + hd * 64 + d;
      const float* cw = p->in[25] + (size_t)l * 4 * 768;
      const float w0 = cw[wc], w1 = cw[768 + wc], w2 = cw[1536 + wc], w3 = cw[2304 + wc];
      auto ld = [&](int t) -> float { return (t >= 0 && t < T) ? bf2f(INP[(size_t)(seqrow0 + t) * LDI + col]) : 0.f; };
      float xin[19];
#pragma unroll
      for (int q = 0; q < 19; ++q) xin[q] = ld(t0 + tb - 2 + q);
      u16* dst = mat == 0 ? sq : (mat == 1 ? sk : sv);
#pragma unroll
      for (int tt = 0; tt < 16; ++tt) {
        const int t = tb + tt;
        float v = siluf_(xin[tt] * w0 + xin[tt + 1] * w1 + xin[tt + 2] * w2 + xin[tt + 3] * w3);
        if (mat < 2) { float ss = wave_sum(v * v); v *= rsqrtf(ss + 1e-6f) * (mat == 0 ? 0.125f : 1.f); }
        u16 hb = f2bf(v);
        dst[t * 72 + d] = hb;
        if (mat == 0) QHAT[t * 64 + d] = hb;
      }
    }
  }
  if (tid < 128) {
    const int dir = tid >> 6, c = tid & 63;
    const int tok = dir == 0 ? c : 63 - c;
    const u16* R = INP + (size_t)(r0 + tok) * LDI;
    const float ga = bf2f(R[C_GA + dir * 4 + hd]), gb = bf2f(R[C_GB + dir * 4 + hd]);
    const float g = -__expf(p->in[26][(l * 2 + dir) * 4 + hd]) * softplusf_(ga + p->in[27][(l * 2 + dir) * 4 + hd]);
    float gc = g;
#pragma unroll
    for (int o = 1; o < 64; o <<= 1) { float tt = __shfl_up(gc, o, 64); if (lane >= o) gc += tt; }
    const float glast = __shfl(gc, 63, 64);
    sgc[dir * 64 + c] = gc; sbeta[dir * 64 + c] = sigm(gb); sge[dir * 64 + c] = __expf(gc);
    float* gv = (float*)(p->ws + WS_GVEC) + (size_t)(item * 2 + dir) * 256;
    gv[c] = __expf(gc); gv[64 + c] = __expf(glast - gc); if (c == 0) gv[128] = __expf(glast);
  }
  __syncthreads();
  {
    const int dk = tid >> 2, c0 = (tid & 3) * 16;
    unsigned w[8];
#pragma unroll
    for (int e = 0; e < 8; ++e) w[e] = (unsigned)sk[(c0 + 2 * e) * 72 + dk] | ((unsigned)sk[(c0 + 2 * e + 1) * 72 + dk] << 16);
    u16* KT = (u16*)(p->ws + WS_KT) + (size_t)item * 4096 + dk * 64 + c0;
    *(u32x4*)KT = mku4(w[0], w[1], w[2], w[3]); *(u32x4*)(KT + 8) = mku4(w[4], w[5], w[6], w[7]);
  }
  {
    const int i0 = wave * 16;
    f32x4 akk[4], aqk[4];
#pragma unroll
    for (int nt = 0; nt < 4; ++nt) { akk[nt] = f32x4{0.f, 0.f, 0.f, 0.f}; aqk[nt] = f32x4{0.f, 0.f, 0.f, 0.f}; }
#pragma unroll
    for (int s = 0; s < 2; ++s) {
      bf16x8 ak = ld8(sk + (i0 + lq) * 72 + s * 32 + quad * 8), aq = ld8(sq + (i0 + lq) * 72 + s * 32 + quad * 8);
#pragma unroll
      for (int nt = 0; nt < 4; ++nt) { bf16x8 bk = ld8(sk + (nt * 16 + lq) * 72 + s * 32 + quad * 8); akk[nt] = MFMA16(ak, bk, akk[nt]); aqk[nt] = MFMA16(aq, bk, aqk[nt]); }
    }
    u16* QKf = (u16*)(p->ws + WS_QK) + (size_t)(item * 2 + 0) * 4096;
    u16* QKb = (u16*)(p->ws + WS_QK) + (size_t)(item * 2 + 1) * 4096;
#pragma unroll
    for (int nt = 0; nt < 4; ++nt)
#pragma unroll
      for (int r = 0; r < 4; ++r) {
        const int i = i0 + quad * 4 + r, j = nt * 16 + lq, ib = 63 - i, jb = 63 - j;
        const float kkv = akk[nt][r], qkv = aqk[nt][r];
        if (j < i) sL[i * 64 + j] = sbeta[i] * kkv * __expf(sgc[i] - sgc[j]);
        if (j > i) sL[4096 + ib * 64 + jb] = sbeta[64 + ib] * kkv * __expf(sgc[64 + ib] - sgc[64 + jb]);
        QKf[i * 64 + j] = f2bf(j <= i ? qkv * __expf(sgc[i] - sgc[j]) : 0.f);
        QKb[ib * 64 + jb] = f2bf(j >= i ? qkv * __expf(sgc[64 + ib] - sgc[64 + jb]) : 0.f);
      }
  }
  __syncthreads();
  {
    const int col = tid & 127;
    u16* UW = (u16*)(p->ws + WS_UW) + (size_t)(item * 2 + (tid >> 7)) * 8192 + col;
    if (tid < 128) { if (col < 64) gdn_solve<0, false>(sL, sv + col, sbeta, sge, UW); else gdn_solve<0, true>(sL, sk + (col - 64), sbeta, sge, UW); }
    else { if (col < 64) gdn_solve<1, false>(sL + 4096, sv + col, sbeta + 64, sge + 64, UW); else gdn_solve<1, true>(sL + 4096, sk + (col - 64), sbeta + 64, sge + 64, UW); }
  }
  __syncthreads();
}

DI void gdn2_item(KP p, int l, int item, unsigned char* smem, bool dostore) {
  u16* sW = (u16*)smem; u16* sQ = sW + 64 * 72; u16* sQK = sQ + 64 * 72; u16* sKT = sQK + 64 * 72; u16* sU = sKT + 64 * 72;
  float* sg = (float*)(smem + 46080);
  const int tid = ltid(), lane = tid & 63, wave = tid >> 6, lq = lane & 15, quad = lane >> 4;
  int b, hd, dir; bool lat;
  if (item < 16) { lat = true; b = item >> 3; hd = (item >> 1) & 3; dir = item & 1; }
  else { lat = false; int r = item - 16; b = r >> 3; hd = (r >> 1) & 3; dir = r & 1; }
  const int nch = lat ? 64 : 4, cg0 = lat ? 128 + b * 64 : b * 4;
  f32x4 st[4];
#pragma unroll
  for (int kt = 0; kt < 4; ++kt)
#pragma unroll
    for (int r = 0; r < 4; ++r)
      st[kt][r] = lat ? p->in[8][((size_t)(((b * 2 + l) * 2 + dir) * 4 + hd) * 64 + kt * 16 + quad * 4 + r) * 64 + wave * 16 + lq] : 0.f;
  const int lrow = tid >> 2, seg = (tid & 3) * 16;
  u32x4 rW[2], rQ[2], rQK[2], rKT[2], rU[2]; float rg = 0.f;
  const u16* UWb = (const u16*)(p->ws + WS_UW); const u16* QHb = (const u16*)(p->ws + WS_QHAT);
  const u16* KTb = (const u16*)(p->ws + WS_KT); u16* QKb = (u16*)(p->ws + WS_QK);
  const float* GV = (const float*)(p->ws + WS_GVEC);
  auto gload = [&](int n) {
    const int cgi = dir == 0 ? cg0 + n : cg0 + nch - 1 - n;
    const size_t prob = (size_t)cgi * 4 + hd, pd = prob * 2 + dir;
    const u16* u = UWb + (pd * 64 + lrow) * 128 + seg;
    rU[0] = *(const u32x4*)u; rU[1] = *(const u32x4*)(u + 8); rW[0] = *(const u32x4*)(u + 64); rW[1] = *(const u32x4*)(u + 72);
    const u16* q = QHb + (prob * 64 + (dir ? 63 - lrow : lrow)) * 64 + seg;
    rQ[0] = *(const u32x4*)q; rQ[1] = *(const u32x4*)(q + 8);
    const u16* qk = QKb + (pd * 64 + lrow) * 64 + seg;
    rQK[0] = *(const u32x4*)qk; rQK[1] = *(const u32x4*)(qk + 8);
    const u16* kt = KTb + (prob * 64 + lrow) * 64 + (dir ? 48 - seg : seg);
    u32x4 a = *(const u32x4*)kt, bb = *(const u32x4*)(kt + 8);
    if (dir) { rKT[0] = rev8(bb); rKT[1] = rev8(a); } else { rKT[0] = a; rKT[1] = bb; }
    rg = GV[pd * 256 + (tid & 255)];
  };
  gload(0);
  for (int n = 0; n < nch; ++n) {
    const int cgi = dir == 0 ? cg0 + n : cg0 + nch - 1 - n;
    const size_t pd = ((size_t)cgi * 4 + hd) * 2 + dir;
    __syncthreads();
    *(u32x4*)(sW + lrow * 72 + seg) = rW[0]; *(u32x4*)(sW + lrow * 72 + seg + 8) = rW[1];
    *(u32x4*)(sQ + lrow * 72 + seg) = rQ[0]; *(u32x4*)(sQ + lrow * 72 + seg + 8) = rQ[1];
    *(u32x4*)(sQK + lrow * 72 + seg) = rQK[0]; *(u32x4*)(sQK + lrow * 72 + seg + 8) = rQK[1];
    *(u32x4*)(sKT + lrow * 72 + seg) = rKT[0]; *(u32x4*)(sKT + lrow * 72 + seg + 8) = rKT[1];
    *(u32x4*)(sU + lrow * 72 + seg) = rU[0]; *(u32x4*)(sU + lrow * 72 + seg + 8) = rU[1];
    sg[tid] = rg;
    __syncthreads();
    if (n + 1 < nch) gload(n + 1);
    const float elast = sg[128];
    bf16x8 sB[2] = {pack8(st[0], st[1]), pack8(st[2], st[3])};
    f32x4 vn[4], oo[4];
#pragma unroll
    for (int mt = 0; mt < 4; ++mt) {
      f32x4 acc = {0.f, 0.f, 0.f, 0.f}, acq = {0.f, 0.f, 0.f, 0.f};
#pragma unroll
      for (int s2 = 0; s2 < 2; ++s2) {
        acc = MFMA16(ldperm(sW + (mt * 16 + lq) * 72 + s2 * 32 + quad * 4), sB[s2], acc);
        acq = MFMA16(ldperm(sQ + (mt * 16 + lq) * 72 + s2 * 32 + quad * 4), sB[s2], acq);
      }
#pragma unroll
      for (int r = 0; r < 4; ++r) {
        const int c = mt * 16 + quad * 4 + r;
        vn[mt][r] = bf2f(sU[c * 72 + wave * 16 + lq]) - acc[r];
        oo[mt][r] = acq[r] * sg[c];
      }
    }
    bf16x8 vB[2] = {pack8(vn[0], vn[1]), pack8(vn[2], vn[3])};
#pragma unroll
    for (int mt = 0; mt < 4; ++mt) {
#pragma unroll
      for (int s2 = 0; s2 < 2; ++s2) oo[mt] = MFMA16(ldperm(sQK + (mt * 16 + lq) * 72 + s2 * 32 + quad * 4), vB[s2], oo[mt]);
    }
    f32x4 vs[4];
#pragma unroll
    for (int mt = 0; mt < 4; ++mt)
#pragma unroll
      for (int r = 0; r < 4; ++r) vs[mt][r] = vn[mt][r] * sg[64 + mt * 16 + quad * 4 + r];
    bf16x8 vsB[2] = {pack8(vs[0], vs[1]), pack8(vs[2], vs[3])};
#pragma unroll
    for (int kt = 0; kt < 4; ++kt) {
      f32x4 acc = {0.f, 0.f, 0.f, 0.f};
#pragma unroll
      for (int s2 = 0; s2 < 2; ++s2) acc = MFMA16(ldperm(sKT + (kt * 16 + lq) * 72 + s2 * 32 + quad * 4), vsB[s2], acc);
#pragma unroll
      for (int r = 0; r < 4; ++r) st[kt][r] = elast * st[kt][r] + acc[r];
    }
    u16* O = QKb + pd * 4096;
    if (dostore) {
#pragma unroll
    for (int mt = 0; mt < 4; ++mt)
#pragma unroll
      for (int r = 0; r < 4; ++r) O[(mt * 16 + quad * 4 + r) * 64 + wave * 16 + lq] = f2bf(oo[mt][r]);
    }
  }
  if (!lat && dostore) {
#pragma unroll
    for (int kt = 0; kt < 4; ++kt)
#pragma unroll
      for (int r = 0; r < 4; ++r)
        p->out[O_GDN + ((size_t)(((b * 2 + l) * 2 + dir) * 4 + hd) * 64 + kt * 16 + quad * 4 + r) * 64 + wave * 16 + lq] = st[kt][r];
  }
  __syncthreads();
}

DI void gdnfin_item(KP p, int l, int item) {
  const int cgi = item >> 2, hd = item & 3;
  const int lane = ltid() & 63, wave = ltid() >> 6;
  const u16* Of = (const u16*)(p->ws + WS_QK) + (size_t)(item * 2 + 0) * 4096;
  const u16* Ob = (const u16*)(p->ws + WS_QK) + (size_t)(item * 2 + 1) * 4096;
  const float gn = p->in[28][l * 64 + lane];
  float ov[16], zv[16];
#pragma unroll
  for (int q = 0; q < 16; ++q) {
    const int c = wave * 16 + q;
    ov[q] = bf2f(Of[c * 64 + lane]) + bf2f(Ob[(63 - c) * 64 + lane]);
    zv[q] = bf2f(((const u16*)(p->ws + WS_INPROJ))[((size_t)cgi * 64 + c) * LDI + C_GZ + hd * 64 + lane]);
  }
#pragma unroll
  for (int q = 0; q < 16; ++q) {
    const int c = wave * 16 + q;
    const size_t row = (size_t)cgi * 64 + c;
    float o = ov[q];
    float ss = wave_sum(o * o);
    float z = zv[q];
    float y = o * rsqrtf(ss * (1.f / 64.f) + 1e-6f) * gn * siluf_(z);
    ((u16*)(p->ws + WS_BRANCH))[row * 1024 + 512 + hd * 64 + lane] = f2bf(y);
  }
}


#define XB_TMO      128
#define XB_XCNT(j)  (256  + 64 * (j))
#define XB_XSUB(j)  (1280 + 64 * (j))
#define XB_XGEN(j)  (2304 + 64 * (j))
#define XB_TOP      3328
#define XB_TOPGEN   3392
#define XB_SPIN_CAP (1u << 20)
#define LAS __attribute__((address_space(3)))
DI unsigned xb_ld(unsigned* q) { return __hip_atomic_load(q, __ATOMIC_RELAXED, __HIP_MEMORY_SCOPE_AGENT); }
DI unsigned xb_add(unsigned* q, unsigned v) { return __hip_atomic_fetch_add(q, v, __ATOMIC_RELAXED, __HIP_MEMORY_SCOPE_AGENT); }
DI unsigned xb_xcc_id() { return (unsigned)__builtin_amdgcn_s_getreg((3 << 11) | 20) & 0xFu; }
#define XB_SPIN(cond, bar) do { unsigned _sp = 0; while (cond) { __builtin_amdgcn_s_sleep(1); \
    if ((++_sp & 255u) == 0u) { if (xb_ld(&(bar)[XB_TMO])) break; if (_sp > XB_SPIN_CAP) { atomicAdd(&(bar)[XB_TMO], 1u); break; } } } } while (0)
DI void xcd_barrier_complete(unsigned* bar, unsigned x, unsigned& nloc, unsigned& nx) {
  const unsigned G = gridDim.x;
  unsigned sum, cnt, mine, sp = 0u;
  for (;;) {
    sum = 0u; cnt = 0u; mine = 0u;
#pragma unroll
    for (unsigned j = 0; j < 16; ++j) { const unsigned c = xb_ld(&bar[XB_XCNT(j)]); sum += c; cnt += (c > 0u) ? 1u : 0u; mine = (j == x) ? c : mine; }
    if (sum == G) break;
    __builtin_amdgcn_s_sleep(1);
    if ((++sp & 255u) == 0u) { if (xb_ld(&bar[XB_TMO])) break; if (sp > XB_SPIN_CAP) { atomicAdd(&bar[XB_TMO], 1u); break; } }
  }
  nloc = mine > 0u ? mine : 1u; nx = cnt > 0u ? cnt : 1u;
}
DI void xcd_barrier(unsigned* bar, volatile LAS unsigned* st) {
  asm volatile("s_waitcnt vmcnt(0)" ::: "memory");
  __syncthreads();
  if (ltid() == 0) {
    const unsigned x = xb_xcc_id();
    __builtin_amdgcn_s_waitcnt(0);
    unsigned nloc = st[0], nx = st[1];
    if (nloc == 0u) { xcd_barrier_complete(bar, x, nloc, nx); st[0] = nloc; st[1] = nx; }
    const unsigned old = xb_add(&bar[XB_XSUB(x)], 1u);
    const unsigned gen = old / nloc;
    if (old + 1u == (gen + 1u) * nloc) {
      __builtin_amdgcn_fence(__ATOMIC_RELEASE, "agent");
      asm volatile("s_waitcnt vmcnt(0)" ::: "memory");
      const unsigned og = xb_add(&bar[XB_TOP], 1u);
      const unsigned tg = og / nx;
      if (og + 1u == (tg + 1u) * nx) xb_add(&bar[XB_TOPGEN], 1u);
      else XB_SPIN(xb_ld(&bar[XB_TOPGEN]) == tg, bar);
      __builtin_amdgcn_fence(__ATOMIC_ACQUIRE, "agent");
      xb_add(&bar[XB_XGEN(x)], 1u);
      asm volatile("s_waitcnt vmcnt(0)" ::: "memory");
    } else {
      XB_SPIN(xb_ld(&bar[XB_XGEN(x)]) == gen, bar);
      __builtin_amdgcn_fence(__ATOMIC_ACQUIRE, "agent");
      asm volatile("s_waitcnt vmcnt(0)" ::: "memory");
    }
  }
  __syncthreads();
}


#define FOR_TILES(MTI, NTI, SM, SN, CALL)                                                      \
  do {                                                                                         \
    if (G % 8 != 0) { for (int it_ = B; it_ < (MTI) * (NTI); it_ += G) { const int mt = it_ / (NTI), nt = it_ % (NTI); CALL; } } \
    else {                                                                                     \
      const int xcd_ = B & 7, j_ = B >> 3, J_ = G >> 3;                                        \
      const int nsm_ = ((MTI) + (SM) - 1) / (SM), nsn_ = ((NTI) + (SN) - 1) / (SN);            \
      for (int s_ = xcd_; s_ < nsm_ * nsn_; s_ += 8) {                                         \
        const int sm_ = s_ / nsn_, sn_ = s_ % nsn_;                                            \
        for (int t_ = j_; t_ < (SM) * (SN); t_ += J_) {                                        \
          const int mt = sm_ * (SM) + t_ / (SN), nt = sn_ * (SN) + t_ % (SN);                  \
          if (mt < (MTI) && nt < (NTI)) { CALL; }                                              \
        }                                                                                      \
      }                                                                                        \
    }                                                                                          \
  } while (0)

constexpr int NPHASE = 21;
__global__ void __launch_bounds__(256, 2) mk(Params p_unused, int ph_lo, int ph_hi) {
  extern __shared__ __attribute__((aligned(1024))) unsigned char smem[];
  int& s_item = *(int*)(smem + SMEM_BYTES);
  u32x4& xb_words = *(u32x4*)(smem + SMEM_BYTES + 16);
  const int G = gridDim.x, B = blockIdx.x;
  const bool fused = ph_hi - ph_lo > 1;
  if (fused) {
    if (ltid() == 0) { xb_words = u32x4{0u, 0u, 0u, 0u}; (void)xb_add(&((unsigned*)(((KP)__builtin_amdgcn_kernarg_segment_ptr())->ws + WS_BAR))[XB_XCNT(xb_xcc_id())], 1u); }
    __syncthreads();
  }
  for (int ph = ph_lo; ph < ph_hi; ++ph) {
    KP p = (KP)__builtin_amdgcn_kernarg_segment_ptr();
    asm volatile("" : "+s"(p));
    if (ph == 0) {
      for (int it = B; it < 192 + CONV_ITEMS + 64; it += G) { for (int rep = 0; rep < NREP(0); ++rep) { if (it < 192) mod_item(p, it, smem); else if (it < 192 + CONV_ITEMS) convert_item(p, 0, it - 192, smem); else lruw_item(p, it - 192 - CONV_ITEMS); } }
    } else {
      const int l = (ph - 1) / 10, sub = (ph - 1) % 10;
      switch (sub) {
        case 0:
          for (int it = B; it < 4096 + (l ? CONV_ITEMS : 0); it += G) { for (int rep = 0; rep < NREP(0); ++rep) { if (it < 4096) norm_item<0>(p, l, it); else convert_item(p, l, it - 4096, smem); } }
          break;
        case 1: FOR_TILES(128, 21, 8, 7, inproj_item(p, mt, nt, smem)); break;
        case 2:
          for (int it = B; it < 1024 + 512 + 64 + 4096; it += G) {
            if (it < 1024) { for (int rep = 0; rep < NREP(4); ++rep) gdn1_item(p, l, it, smem); }
            else if (it < 1536) { for (int rep = 0; rep < NREP(5); ++rep) lru_item<false>(p, l, it - 1024, smem); }
            else if (it < 1600) { if (PHON(6)) kvc_item(p, l, it - 1536); }
            else if (PHON(6)) prep_item(p, l, it - 1600);
          }
          break;
        case 3: {
          int* ctr = (int*)(p->ws + WS_CTR) + l;
          for (;;) {
            __syncthreads();
            if (ltid() == 0) s_item = atomicAdd(ctr, 1);
            __syncthreads();
            const int it = s_item;
            if (it >= 16 + 256 + 256 + 256 + 512 + 512) break;
            if (it < 16) { for (int rep = 0; rep < NREP(7); ++rep) gdn2_item(p, l, it, smem, rep == NREP(7) - 1); }
            else if (it < 272) { for (int rep = 0; rep < NREP(8); ++rep) attn_item(p, l, it - 16, smem); }
            else if (it < 528) { for (int rep = 0; rep < NREP(6); ++rep) gdn2_item(p, l, it - 272 + 16, smem, rep == NREP(6) - 1); }
            else if (it < 784) { for (int rep = 0; rep < NREP(8); ++rep) attn_item(p, l, it - 528 + 256, smem); }
            else if (it < 1296) { for (int rep = 0; rep < NREP(9); ++rep) lru_item<true>(p, l, it - 784, smem); }
            else for (int rep = 0; rep < NREP(8); ++rep) attn_item(p, l, it - 1296 + 512, smem);
          }
        } break;
        case 4: for (int it = B; it < 1024; it += G) for (int rep = 0; rep < NREP(0); ++rep) gdnfin_item(p, l, it); break;
        case 5: FOR_TILES(128, 8, 8, 8, merge_item(p, l, mt, nt, smem)); break;
        case 6: FOR_TILES(128, 8, 8, 8, wout_item(p, l, mt, nt, smem)); break;
        case 7: for (int it = B; it < 4096; it += G) for (int rep = 0; rep < NREP(0); ++rep) norm_item<1>(p, l, it); break;
        case 8: FOR_TILES(128, 32, 8, 8, w1_item(p, mt, nt, smem)); break;
        case 9: FOR_TILES(128, 8, 8, 8, w2_item(p, l, mt, nt, smem)); break;
      }
    }
    if (ph + 1 < ph_hi) {
      if (ph == ph_lo) cg::this_grid().sync();
      else for (int rep = 0; rep < NREP(1); ++rep) xcd_barrier((unsigned*)(p->ws + WS_BAR), (volatile LAS unsigned*)&xb_words);
    }
  }
}

extern "C" void kernel_launch(void* const* d_in, const int* in_sizes, int n_in, void* d_out, int out_size, void* d_ws, size_t ws_size, hipStream_t stream) {
  static int grid_blocks = 0;
  if (!grid_blocks) {
    int dev = 0, cus = 0, per_cu = 0;
    (void)hipGetDevice(&dev);
    (void)hipDeviceGetAttribute(&cus, hipDeviceAttributeMultiprocessorCount, dev);
    if (hipFuncSetAttribute((const void*)mk, hipFuncAttributeMaxDynamicSharedMemorySize, DYN_LDS) != hipSuccess) fprintf(stderr, "kernel_launch: hipFuncSetAttribute failed\n");
    (void)hipOccupancyMaxActiveBlocksPerMultiprocessor(&per_cu, mk, 256, DYN_LDS);
    if (per_cu < 1) per_cu = 1;
    if (per_cu > 2) per_cu = 2;
    grid_blocks = cus * per_cu;
    if (ws_size < WS_END) fprintf(stderr, "kernel_launch: workspace too small: %zu < %zu\n", ws_size, (size_t)WS_END);
  }
  if (hipMemsetAsync((char*)d_ws + WS_CTR, 0, 256 + 3456 * 4 + 256, stream) != hipSuccess) fprintf(stderr, "kernel_launch: memset failed\n");
  Params p{};
  for (int i = 0; i < 37; ++i) p.in[i] = (const float*)d_in[i];
  p.out = (float*)d_out; p.ws = (unsigned char*)d_ws;
#if MULTI_LAUNCH
  for (int ph = 0; ph < NPHASE; ++ph) hipLaunchKernelGGL(mk, dim3(grid_blocks), dim3(256), DYN_LDS, stream, p, ph, ph + 1);
#else
  int lo = 0, hi = NPHASE;
  void* args[] = {&p, &lo, &hi};
  hipError_t e = hipLaunchCooperativeKernel((void*)mk, dim3(grid_blocks), dim3(256), args, DYN_LDS, stream);
  if (e != hipSuccess) fprintf(stderr, "cooperative launch failed: %s (grid %d)\n", hipGetErrorString(e), grid_blocks);
#endif
}
```

```cpp
#include <hip/hip_runtime.h>
#include <hip/hip_cooperative_groups.h>
#include <cstdio>
namespace cg = cooperative_groups;

#ifndef MULTI_LAUNCH
#define MULTI_LAUNCH 0
#endif
#ifndef PHM
#define PHM 0xFFFFFFFFu
#endif
#define PHON(b) ((PHM >> (b)) & 1u)
#ifndef DUPM
#define DUPM 0u
#endif
#define NREP(b) (1 + ((DUPM >> (b)) & 1u))

typedef unsigned short u16;
using bf16x8 = __attribute__((ext_vector_type(8))) short;
using f32x4 = __attribute__((ext_vector_type(4))) float;
using u32x4 = __attribute__((ext_vector_type(4))) unsigned;
#define DI __device__ __forceinline__
#define MFMA16(a, b, c) __builtin_amdgcn_mfma_f32_16x16x32_bf16((a), (b), (c), 0, 0, 0)

constexpr int NTOK = 16384;
constexpr int DM = 1024;
constexpr int LDI = 2592;
constexpr int C_AQ = 0, C_AK = 256, C_AV = 384, C_LX = 512, C_LG = 768, C_GQ = 1024, C_GK = 1280, C_GV = 1536, C_GZ = 1792,
              C_DQ = 2048, C_DK = 2304, C_DV = 2432, C_GA = 2560, C_GB = 2568;
constexpr int NIN_PAD = 2688;

constexpr size_t WS_MOD = 0;
constexpr size_t WS_CTR = WS_MOD + 2 * 3 * 6144 * 4;
constexpr size_t WS_BAR = WS_CTR + 256;
constexpr size_t WS_LRUC = WS_BAR + 3456 * 4 + 256;
constexpr size_t WS_KC = WS_LRUC + (size_t)512 * 2 * 2 * 256 * 4;
constexpr size_t WS_GVEC = WS_KC + (size_t)16 * 512 * 64 * 2;
constexpr size_t WS_LRUW = WS_GVEC + (size_t)1024 * 2 * 256 * 4;
constexpr size_t WS_VT = WS_LRUW + (size_t)256 * 64 * 16;
constexpr size_t WS_WIN = WS_VT + (size_t)8 * 64 * 4608 * 2;
constexpr size_t WS_WM = WS_WIN + (size_t)NIN_PAD * 1024 * 2;
constexpr size_t WS_WB = WS_WM + (size_t)4096 * 1024 * 2;
constexpr size_t WS_WO = WS_WB + (size_t)4 * 1024 * 256 * 2;
constexpr size_t WS_W1 = WS_WO + (size_t)1024 * 1024 * 2;
constexpr size_t WS_W2 = WS_W1 + (size_t)4096 * 1024 * 2;
constexpr size_t WS_H = WS_W2 + (size_t)1024 * 4096 * 2;
constexpr size_t WS_BIG = WS_H + (size_t)NTOK * 1024 * 2;
constexpr size_t WS_INPROJ = WS_BIG;
constexpr size_t WS_BRANCH = WS_INPROJ + (size_t)NTOK * LDI * 2;
constexpr size_t WS_QHAT = WS_BRANCH + (size_t)NTOK * 1024 * 2;
constexpr size_t WS_KT = WS_QHAT + (size_t)1024 * 4096 * 2;
constexpr size_t WS_UW = WS_KT + (size_t)1024 * 4096 * 2;
constexpr size_t WS_QK = WS_UW + (size_t)1024 * 2 * 8192 * 2;
constexpr size_t WS_END = WS_QK + (size_t)1024 * 2 * 4096 * 2;
constexpr size_t WS_HIDDEN = WS_BIG;
constexpr size_t WS_MERGED = WS_BIG;
static_assert(WS_HIDDEN + (size_t)NTOK * 4096 * 2 <= WS_END, "hidden must fit");
static_assert(WS_END <= (size_t)256 * 1024 * 1024, "workspace budget");

constexpr size_t O_X = 0, O_AK = 16777216, O_AV = 18874368, O_DK = 20971520, O_DV = 23068672, O_LRU = 25165824, O_GDN = 25198592;

struct Params {
  const float* in[37];
  float* out;
  unsigned char* ws;
};

typedef const Params __attribute__((address_space(4)))* KP;
constexpr int SMEM_BYTES = 65536;
constexpr int DYN_LDS = SMEM_BYTES + 64;

DI int ltid() { int t = threadIdx.x; asm volatile("" : "+v"(t)); return t; }
typedef __bf16 bf16v2 __attribute__((ext_vector_type(2)));
DI u16 f2bf(float x) { __bf16 h = (__bf16)x; return __builtin_bit_cast(u16, h); }
DI float bf2f(u16 h) { return __uint_as_float(((unsigned)h) << 16); }
DI unsigned pack2(float a, float b) { bf16v2 v = {(__bf16)a, (__bf16)b}; return __builtin_bit_cast(unsigned, v); }
DI float bflo(unsigned u) { return __uint_as_float(u << 16); }
DI float bfhi(unsigned u) { return __uint_as_float(u & 0xffff0000u); }
DI float sigm(float x) { return 1.f / (1.f + __expf(-x)); }
DI float siluf_(float x) { return x / (1.f + __expf(-x)); }
DI float softplusf_(float x) { return x > 20.f ? x : log1pf(__expf(x)); }
DI float gelu_tanh(float x) { float u = 0.7978845608028654f * (x + 0.044715f * x * x * x); float t = 1.f - 2.f / (__expf(2.f * u) + 1.f); return 0.5f * x * (1.f + t); }
DI float wave_sum(float v) {
#pragma unroll
  for (int o = 32; o > 0; o >>= 1) v += __shfl_xor(v, o, 64);
  return v;
}
DI u32x4 mku4(unsigned a, unsigned b, unsigned c, unsigned d) { u32x4 v = {a, b, c, d}; return v; }
DI bf16x8 mk8(unsigned a, unsigned b, unsigned c, unsigned d) { u32x4 v = {a, b, c, d}; return __builtin_bit_cast(bf16x8, v); }
DI bf16x8 pack8(const f32x4& x, const f32x4& y) { return mk8(pack2(x[0], x[1]), pack2(x[2], x[3]), pack2(y[0], y[1]), pack2(y[2], y[3])); }
DI bf16x8 ld8(const u16* p) { return *(const bf16x8*)p; }
DI bf16x8 ldperm(const u16* p) { uint2 a = *(const uint2*)p; uint2 b = *(const uint2*)(p + 16); return mk8(a.x, a.y, b.x, b.y); }
DI int mod_group(int row) { return row < 8192 ? 0 : 1 + ((row - 8192) >> 12); }
DI const float* x_in_row(KP p, int l, int row) {
  if (l == 0) return row < 8192 ? p->in[0] + (size_t)row * DM : p->in[1] + (size_t)(row - 8192) * DM;
  return p->out + (size_t)row * DM;
}
DI unsigned swap16(unsigned u) { return (u >> 16) | (u << 16); }
DI u32x4 rev8(u32x4 v) { return mku4(swap16(v.w), swap16(v.z), swap16(v.y), swap16(v.x)); }

DI void mod_item(KP p, int item, unsigned char* smem) {
  float* sc = (float*)smem;
  float* sr = sc + 3072;
  const int tid = ltid();
  const int l = item / 96, cb = item % 96;
  for (int i = tid; i < 3072; i += 256) {
    int g = i >> 10, k = i & 1023;
    float c = g == 0 ? p->in[9][k] : p->in[2][(g - 1) * 1024 + k];
    sc[i] = siluf_(c);
  }
  __syncthreads();
  const int col = cb * 64 + (tid & 63), kg = tid >> 6;
  const float* W = p->in[10] + (size_t)l * 1024 * 6144;
  float a0 = 0.f, a1 = 0.f, a2 = 0.f;
  for (int k = kg * 256; k < kg * 256 + 256; ++k) {
    float w = W[(size_t)k * 6144 + col];
    a0 += sc[k] * w; a1 += sc[1024 + k] * w; a2 += sc[2048 + k] * w;
  }
  sr[(kg * 3 + 0) * 64 + (tid & 63)] = a0; sr[(kg * 3 + 1) * 64 + (tid & 63)] = a1; sr[(kg * 3 + 2) * 64 + (tid & 63)] = a2;
  __syncthreads();
  if (tid < 192) {
    int g = tid >> 6, cc = tid & 63;
    float s = p->in[11][l * 6144 + cb * 64 + cc];
    for (int q = 0; q < 4; ++q) s += sr[(q * 3 + g) * 64 + cc];
    ((float*)(p->ws + WS_MOD))[(l * 3 + g) * 6144 + cb * 64 + cc] = s;
  }
  __syncthreads();
}

DI void conv_tile(const float* src, int N, int k0, int n0, u16* dst, int K, bool perm, unsigned char* smem) {
  float* tile = (float*)smem;
  const int tid = ltid();
#pragma unroll
  for (int i = 0; i < 4; ++i) {
    int kr = (tid >> 4) + 16 * i, nc = (tid & 15) * 4;
    float4 v = make_float4(0.f, 0.f, 0.f, 0.f);
    if (n0 + nc < N) v = *(const float4*)(src + (size_t)(k0 + kr) * N + n0 + nc);
    tile[kr * 65 + nc] = v.x; tile[kr * 65 + nc + 1] = v.y; tile[kr * 65 + nc + 2] = v.z; tile[kr * 65 + nc + 3] = v.w;
  }
  __syncthreads();
#pragma unroll
  for (int i = 0; i < 2; ++i) {
    int n = (tid >> 3) + 32 * i, k8 = (tid & 7) * 8;
    int ng = n0 + n;
    if (ng < N) {
      int row = ng;
      if (perm) row = ng < 2048 ? ng : (ng < 2064 ? 2560 + (ng - 2048) : ng - 16);
      u32x4 o;
      o.x = pack2(tile[(k8 + 0) * 65 + n], tile[(k8 + 1) * 65 + n]);
      o.y = pack2(tile[(k8 + 2) * 65 + n], tile[(k8 + 3) * 65 + n]);
      o.z = pack2(tile[(k8 + 4) * 65 + n], tile[(k8 + 5) * 65 + n]);
      o.w = pack2(tile[(k8 + 6) * 65 + n], tile[(k8 + 7) * 65 + n]);
      *(u32x4*)(dst + (size_t)row * K + k0 + k8) = o;
    }
  }
  __syncthreads();
}

constexpr int CONV_ITEMS = 4241;
DI void convert_item(KP p, int l, int item, unsigned char* smem) {
  unsigned char* ws = p->ws;
  if (item < 656) { int kt = item / 41, nt = item % 41; conv_tile(p->in[14] + (size_t)l * 1024 * 2576, 2576, kt * 64, nt * 64, (u16*)(ws + WS_WIN), 1024, true, smem); return; }
  item -= 656;
  if (item < 1024) { int kt = item >> 6, nt = item & 63; conv_tile(p->in[32] + (size_t)l * 1024 * 4096, 4096, kt * 64, nt * 64, (u16*)(ws + WS_WM), 1024, false, smem); return; }
  item -= 1024;
  if (item < 256) { int m = item >> 6, r = item & 63, kt = r >> 4, nt = r & 15;
    conv_tile(p->in[31] + ((size_t)l * 4 + m) * 256 * 1024, 1024, kt * 64, nt * 64, (u16*)(ws + WS_WB) + (size_t)m * 1024 * 256, 256, false, smem); return; }
  item -= 256;
  if (item < 256) { int kt = item >> 4, nt = item & 15; conv_tile(p->in[34] + (size_t)l * 1024 * 1024, 1024, kt * 64, nt * 64, (u16*)(ws + WS_WO), 1024, false, smem); return; }
  item -= 256;
  if (item < 1024) { int kt = item >> 6, nt = item & 63; conv_tile(p->in[35] + (size_t)l * 1024 * 4096, 4096, kt * 64, nt * 64, (u16*)(ws + WS_W1), 1024, false, smem); return; }
  item -= 1024;
  if (item < 1024) { int kt = item >> 4, nt = item & 15; conv_tile(p->in[36] + (size_t)l * 4096 * 1024, 1024, kt * 64, nt * 64, (u16*)(ws + WS_W2), 4096, false, smem); return; }
  u32x4* z = (u32x4*)((u16*)(ws + WS_WIN) + (size_t)2576 * 1024);
  for (int i = ltid(); i < 112 * 1024 / 8; i += 256) z[i] = mku4(0, 0, 0, 0);
}

DI void lruw_item(KP p, int item) {
  const int gid = item * 256 + ltid();
  const int lane = gid & 63, fg = gid >> 6;
  const int s2 = fg & 1, j = (fg >> 1) & 3, n = (fg >> 3) & 3, g = (fg >> 5) & 1, ld_ = fg >> 6;
  const int lq = lane & 15, quad = lane >> 4;
  const float* W = (g == 0 ? p->in[20] : p->in[22]) + ((size_t)(ld_ * 4 + n) * 64) * 64 + (size_t)(s2 * 32 + quad * 8) * 64 + j * 16 + lq;
  u32x4 o = {pack2(W[0], W[64]), pack2(W[128], W[192]), pack2(W[256], W[320]), pack2(W[384], W[448])};
  ((u32x4*)(p->ws + WS_LRUW))[gid] = o;
}

template <int which>
DI void norm_item(KP p, int l, int item) {
  const int tid = ltid(), lane = tid & 63, wave = tid >> 6;
  const float* g = p->in[which == 0 ? 12 : 13] + l * 1024;
  f32x4 v[2][4]; float ss[2] = {0.f, 0.f};
#pragma unroll
  for (int h = 0; h < 2; ++h) {
    const int row = item * 8 + wave * 2 + h;
    const float* x = x_in_row(p, which == 0 ? l : 2, row);
#pragma unroll
    for (int i = 0; i < 4; ++i) v[h][i] = *(const f32x4*)(x + i * 256 + lane * 4);
  }
#pragma unroll
  for (int h = 0; h < 2; ++h) {
#pragma unroll
    for (int i = 0; i < 4; ++i) ss[h] += v[h][i].x * v[h][i].x + v[h][i].y * v[h][i].y + v[h][i].z * v[h][i].z + v[h][i].w * v[h][i].w;
    ss[h] = wave_sum(ss[h]);
  }
#pragma unroll
  for (int h = 0; h < 2; ++h) {
    const int row = item * 8 + wave * 2 + h;
    const float* mod = (const float*)(p->ws + WS_MOD) + (l * 3 + mod_group(row)) * 6144;
    const float* sh = mod + (which == 0 ? 0 : 3072);
    const float* sc = mod + (which == 0 ? 1024 : 4096);
    const float rstd = rsqrtf(ss[h] * (1.f / 1024.f) + 1e-6f);
    u16* H = (u16*)(p->ws + WS_H) + (size_t)row * 1024;
#pragma unroll
    for (int i = 0; i < 4; ++i) {
      int c = i * 256 + lane * 4;
      float4 gg = *(const float4*)(g + c), s1 = *(const float4*)(sc + c), s0 = *(const float4*)(sh + c);
      float y0 = v[h][i].x * rstd * gg.x * (1.f + s1.x) + s0.x, y1 = v[h][i].y * rstd * gg.y * (1.f + s1.y) + s0.y;
      float y2 = v[h][i].z * rstd * gg.z * (1.f + s1.z) + s0.z, y3 = v[h][i].w * rstd * gg.w * (1.f + s1.w) + s0.w;
      *(uint2*)(H + c) = make_uint2(pack2(y0, y1), pack2(y2, y3));
    }
  }
}

DI int lds_byte(int r, int c) {
  int st = (r >> 4) * 2 + (c >> 5), ob = (r & 15) * 64 + (c & 31) * 2;
  return st * 1024 + (ob ^ (((ob >> 9) & 1) << 5));
}
DI void stage_rc(int b, int& R, int& C) {
  int st = b >> 10, sb = b & 1023, swz = sb ^ (((sb >> 9) & 1) << 5);
  R = (st >> 1) * 16 + (swz >> 6);
  C = (st & 1) * 32 + ((swz & 63) >> 1);
}
template <int MT, int NT, bool pre = false>
DI void gemm_acc(f32x4 (&acc)[MT][NT], const u16* __restrict__ A, int lda, const u16* __restrict__ Bt, int ldb, int K, unsigned char* smem,
                 const u16* nxtA = nullptr, int nlda = 0, const u16* nxtB = nullptr, int nldb = 0) {
  constexpr int TA = MT * 32 * 128, TB = NT * 32 * 128, STAGE = TA + TB;
  static_assert(2 * STAGE <= 65536, "LDS");
  const int tid = ltid(), lane = tid & 63, wid = tid >> 6, wm = wid >> 1, wn = wid & 1;
  const int fr = lane & 15, fq = lane >> 4;
  const u16* ga[MT]; const u16* gb[NT];
#pragma unroll
  for (int i = 0; i < MT; ++i) { int R, C; stage_rc(wid * 1024 + i * 4096 + lane * 16, R, C); ga[i] = A + (size_t)R * lda + C; }
#pragma unroll
  for (int i = 0; i < NT; ++i) { int R, C; stage_rc(wid * 1024 + i * 4096 + lane * 16, R, C); gb[i] = Bt + (size_t)R * ldb + C; }
#define GLDS_STAGE(buf, k0)                                                                                                        \
  do {                                                                                                                             \
    _Pragma("unroll") for (int i = 0; i < MT; ++i)                                                                                 \
      __builtin_amdgcn_global_load_lds((const unsigned*)(ga[i] + (k0)), (unsigned*)(smem + (buf) * STAGE + wid * 1024 + i * 4096), 16, 0, 0); \
    _Pragma("unroll") for (int i = 0; i < NT; ++i)                                                                                 \
      __builtin_amdgcn_global_load_lds((const unsigned*)(gb[i] + (k0)), (unsigned*)(smem + (buf) * STAGE + TA + wid * 1024 + i * 4096), 16, 0, 0); \
  } while (0)
  if (!pre) {
    __syncthreads();
    GLDS_STAGE(0, 0);
  }
  asm volatile("s_waitcnt vmcnt(0)" ::: "memory");
  __syncthreads();
  const int nt = K >> 6;
  for (int t = 0; t < nt; ++t) {
    const int cur = t & 1;
    if (t + 1 < nt) GLDS_STAGE(cur ^ 1, (t + 1) * 64);
    const unsigned char* sA = smem + cur * STAGE;
    const unsigned char* sB = sA + TA;
#pragma unroll
    for (int s = 0; s < 2; ++s) {
      bf16x8 bfr[NT];
#pragma unroll
      for (int j = 0; j < NT; ++j) bfr[j] = *(const bf16x8*)(sB + lds_byte(wn * NT * 16 + j * 16 + fr, s * 32 + fq * 8));
#pragma unroll
      for (int i = 0; i < MT; ++i) {
        bf16x8 af = *(const bf16x8*)(sA + lds_byte(wm * MT * 16 + i * 16 + fr, s * 32 + fq * 8));
#pragma unroll
        for (int j = 0; j < NT; ++j) acc[i][j] = MFMA16(af, bfr[j], acc[i][j]);
      }
    }
    asm volatile("s_waitcnt vmcnt(0)" ::: "memory");
    __syncthreads();
  }
  if (nxtA) {
#pragma unroll
    for (int i = 0; i < MT; ++i) { int R, C; stage_rc(wid * 1024 + i * 4096 + lane * 16, R, C);
      __builtin_amdgcn_global_load_lds((const unsigned*)(nxtA + (unsigned)(R * nlda + C)), (unsigned*)(smem + wid * 1024 + i * 4096), 16, 0, 0); }
#pragma unroll
    for (int i = 0; i < NT; ++i) { int R, C; stage_rc(wid * 1024 + i * 4096 + lane * 16, R, C);
      __builtin_amdgcn_global_load_lds((const unsigned*)(nxtB + (unsigned)(R * nldb + C)), (unsigned*)(smem + TA + wid * 1024 + i * 4096), 16, 0, 0); }
  }
#undef GLDS_STAGE
}

template <int MT, int NT>
DI void gemm_prefetch(const u16* A, int lda, const u16* Bt, int ldb, unsigned char* smem) {
  constexpr int TA = MT * 32 * 128;
  const int tid = ltid(), lane = tid & 63, wid = tid >> 6;
  __syncthreads();
#pragma unroll
  for (int i = 0; i < MT; ++i) { int R, C; stage_rc(wid * 1024 + i * 4096 + lane * 16, R, C);
    __builtin_amdgcn_global_load_lds((const unsigned*)(A + (unsigned)(R * lda + C)), (unsigned*)(smem + wid * 1024 + i * 4096), 16, 0, 0); }
#pragma unroll
  for (int i = 0; i < NT; ++i) { int R, C; stage_rc(wid * 1024 + i * 4096 + lane * 16, R, C);
    __builtin_amdgcn_global_load_lds((const unsigned*)(Bt + (unsigned)(R * ldb + C)), (unsigned*)(smem + TA + wid * 1024 + i * 4096), 16, 0, 0); }
}

template <int MT, int NT> DI void zero_acc(f32x4 (&acc)[MT][NT]) {
#pragma unroll
  for (int i = 0; i < MT; ++i)
#pragma unroll
    for (int j = 0; j < NT; ++j) acc[i][j] = f32x4{0.f, 0.f, 0.f, 0.f};
}

#define EPI_LOOP(MT, NT)                                                          \
  const int tid_ = ltid(), lane_ = tid_ & 63, wave_ = tid_ >> 6;                   \
  const int wm_ = wave_ >> 1, wn_ = wave_ & 1, lq_ = lane_ & 15, quad_ = lane_ >> 4; \
  _Pragma("unroll") for (int i = 0; i < MT; ++i)                                   \
  _Pragma("unroll") for (int j = 0; j < NT; ++j)                                   \
  _Pragma("unroll") for (int r = 0; r < 4; ++r)
#define EPI_ROW(m0, MT) ((m0) + wm_ * (MT) * 16 + i * 16 + quad_ * 4 + r)
#define EPI_COL(n0, NT) ((n0) + wn_ * (NT) * 16 + j * 16 + lq_)

constexpr int GMT = 4;
DI void inproj_item(KP p, int mt, int nt, unsigned char* smem) {
  const int m0 = mt * (GMT * 32), n0 = nt * 128;
  f32x4 acc[GMT][4]; zero_acc<GMT, 4>(acc);
  gemm_acc<GMT, 4>(acc, (const u16*)(p->ws + WS_H) + (size_t)m0 * 1024, 1024, (const u16*)(p->ws + WS_WIN) + (size_t)n0 * 1024, 1024, 1024, smem);
  u16* C = (u16*)(p->ws + WS_INPROJ);
  EPI_LOOP(GMT, 4) { int row = EPI_ROW(m0, GMT), col = EPI_COL(n0, 4); if (col < LDI) C[(size_t)row * LDI + col] = f2bf(acc[i][j][r]); }
}

DI void merge_item(KP p, int l, int mt, int nt, unsigned char* smem) {
  const int m0 = mt * 128, n0 = nt * 128;
  const u16* H = (const u16*)(p->ws + WS_H) + (size_t)m0 * 1024;
  const u16* BR = (const u16*)(p->ws + WS_BRANCH) + (size_t)m0 * 1024;
  const float* bm = p->in[33] + l * 4096;
  const u16* WM = (const u16*)(p->ws + WS_WM) + (size_t)n0 * 1024;
  const u16* WB = (const u16*)(p->ws + WS_WB) + (size_t)n0 * 256;
  unsigned am[4][4][2];
#pragma unroll
  for (int i = 0; i < 4; ++i)
#pragma unroll
    for (int j = 0; j < 4; ++j) { am[i][j][0] = 0u; am[i][j][1] = 0u; }
  gemm_prefetch<4, 4>(BR, 1024, WB, 256, smem);
#pragma unroll 1
  for (int m = 0; m < 4; ++m) {
    f32x4 acc[4][4]; zero_acc<4, 4>(acc);
    gemm_acc<4, 4, true>(acc, BR + m * 256, 1024, WB + (size_t)m * 1024 * 256, 256, 256, smem, H, 1024, WM + (size_t)m * 1024 * 1024, 1024);
    unsigned pp[4][4][2];
#pragma unroll
    for (int i = 0; i < 4; ++i)
#pragma unroll
      for (int j = 0; j < 4; ++j) { pp[i][j][0] = pack2(acc[i][j][0], acc[i][j][1]); pp[i][j][1] = pack2(acc[i][j][2], acc[i][j][3]); }
    zero_acc<4, 4>(acc);
    gemm_acc<4, 4, true>(acc, H, 1024, WM + (size_t)m * 1024 * 1024, 1024, 1024, smem,
                         m < 3 ? BR + (m + 1) * 256 : nullptr, 1024, WB + (size_t)(m + 1) * 1024 * 256, 256);
    {
      const int tid_ = ltid(), wn_ = (tid_ >> 6) & 1, lq_ = tid_ & 15;
      float bias4[4];
#pragma unroll
      for (int j = 0; j < 4; ++j) bias4[j] = bm[m * 1024 + n0 + wn_ * 64 + j * 16 + lq_];
#pragma unroll
      for (int i = 0; i < 4; ++i) {
#pragma unroll
        for (int j = 0; j < 4; ++j) {
          float v0 = bflo(am[i][j][0]) + sigm(acc[i][j][0] + bias4[j]) * bflo(pp[i][j][0]);
          float v1 = bfhi(am[i][j][0]) + sigm(acc[i][j][1] + bias4[j]) * bfhi(pp[i][j][0]);
          float v2 = bflo(am[i][j][1]) + sigm(acc[i][j][2] + bias4[j]) * bflo(pp[i][j][1]);
          float v3 = bfhi(am[i][j][1]) + sigm(acc[i][j][3] + bias4[j]) * bfhi(pp[i][j][1]);
          am[i][j][0] = pack2(v0, v1); am[i][j][1] = pack2(v2, v3);
          asm volatile("" : "+v"(am[i][j][0]), "+v"(am[i][j][1]));
          __builtin_amdgcn_sched_barrier(0);
        }
      }
    }
  }
  u16* C = (u16*)(p->ws + WS_MERGED);
  EPI_LOOP(4, 4) { int row = EPI_ROW(m0, 4), col = EPI_COL(n0, 4); const unsigned w = am[i][j][r >> 1]; C[(size_t)row * 1024 + col] = (u16)((r & 1) ? (w >> 16) : (w & 0xffffu)); }
}

DI void wout_item(KP p, int l, int mt, int nt, unsigned char* smem) {
  const int m0 = mt * (GMT * 32), n0 = nt * 128;
  f32x4 acc[GMT][4]; zero_acc<GMT, 4>(acc);
  gemm_acc<GMT, 4>(acc, (const u16*)(p->ws + WS_MERGED) + (size_t)m0 * 1024, 1024, (const u16*)(p->ws + WS_WO) + (size_t)n0 * 1024, 1024, 1024, smem);
  const float* g1 = (const float*)(p->ws + WS_MOD) + (l * 3 + mod_group(m0)) * 6144 + 2048;
  EPI_LOOP(GMT, 4) { int row = EPI_ROW(m0, GMT), col = EPI_COL(n0, 4); p->out[(size_t)row * DM + col] = x_in_row(p, l, row)[col] + g1[col] * acc[i][j][r]; }
}

DI void w1_item(KP p, int mt, int nt, unsigned char* smem) {
  const int m0 = mt * (GMT * 32), n0 = nt * 128;
  f32x4 acc[GMT][4]; zero_acc<GMT, 4>(acc);
  gemm_acc<GMT, 4>(acc, (const u16*)(p->ws + WS_H) + (size_t)m0 * 1024, 1024, (const u16*)(p->ws + WS_W1) + (size_t)n0 * 1024, 1024, 1024, smem);
  u16* C = (u16*)(p->ws + WS_HIDDEN);
  EPI_LOOP(GMT, 4) { int row = EPI_ROW(m0, GMT), col = EPI_COL(n0, 4); float v = fmaxf(acc[i][j][r], 0.f); C[(size_t)row * 4096 + col] = f2bf(v * v); }
}

DI void w2_item(KP p, int l, int mt, int nt, unsigned char* smem) {
  const int m0 = mt * (GMT * 32), n0 = nt * 128;
  f32x4 acc[GMT][4]; zero_acc<GMT, 4>(acc);
  gemm_acc<GMT, 4>(acc, (const u16*)(p->ws + WS_HIDDEN) + (size_t)m0 * 4096, 4096, (const u16*)(p->ws + WS_W2) + (size_t)n0 * 4096, 4096, 4096, smem);
  const float* g2 = (const float*)(p->ws + WS_MOD) + (l * 3 + mod_group(m0)) * 6144 + 5120;
  EPI_LOOP(GMT, 4) { int row = EPI_ROW(m0, GMT), col = EPI_COL(n0, 4); float* o = p->out + (size_t)row * DM + col; *o = *o + g2[col] * acc[i][j][r]; }
}

DI void prep_load(const u16* R, int lane, float (&hv)[12], float (&vv4)[4]) {
#pragma unroll
  for (int hh = 0; hh < 12; ++hh) {
    const int col = hh < 4 ? C_AQ + hh * 64 : (hh < 6 ? C_AK + (hh - 4) * 64 : (hh < 10 ? C_DQ + (hh - 6) * 64 : C_DK + (hh - 10) * 64));
    hv[hh] = bf2f(R[col + lane]);
  }
  vv4[0] = bf2f(R[C_AV + lane]); vv4[1] = bf2f(R[C_AV + 64 + lane]); vv4[2] = bf2f(R[C_DV + lane]); vv4[3] = bf2f(R[C_DV + 64 + lane]);
}
DI void prep_token(KP p, int l, int row, int lane, u16* R, const float (&hv)[12], const float (&vv4)[4]) {
  const bool lat = row >= 8192;
  float cs = 1.f, sn = 0.f;
  if (lat) {
    int t = (row - 8192) & 4095;
    int pos = (lane < 32) ? (t >> 6) : (t & 63);
    float inv = __expf(-(float)(lane & 15) * (9.210340371976184f / 16.f));
    float ang = (float)pos * inv;
    cs = __cosf(ang); sn = __sinf(ang);
  }
  const int b = row >> 8, t = row & 255;
#pragma unroll
  for (int hh = 0; hh < 12; ++hh) {
    int col; const float* g;
    if (hh < 4) { col = C_AQ + hh * 64; g = p->in[15] + l * 64; }
    else if (hh < 6) { col = C_AK + (hh - 4) * 64; g = p->in[16] + l * 64; }
    else if (hh < 10) { col = C_DQ + (hh - 6) * 64; g = p->in[29] + l * 64; }
    else { col = C_DK + (hh - 10) * 64; g = p->in[30] + l * 64; }
    float v = hv[hh];
    float ss = wave_sum(v * v);
    float y = v * rsqrtf(ss * (1.f / 64.f) + 1e-6f) * g[lane];
    if (lat) {
      float yp = __shfl_xor(y, 16, 64);
      y = ((lane & 31) < 16) ? (y * cs - yp * sn) : (y * cs + yp * sn);
    } else {
      if (hh == 4 || hh == 5) p->out[O_AK + ((size_t)(b * 2 + l) * 256 + t) * 128 + (hh - 4) * 64 + lane] = y;
      if (hh >= 10) p->out[O_DK + ((size_t)(b * 2 + l) * 256 + t) * 128 + (hh - 10) * 64 + lane] = y;
    }
    R[col + lane] = f2bf(y);
  }
  if (lat) {
    const int bl = (row - 8192) >> 12, tl = (row - 8192) & 4095;
    u16* VT = (u16*)(p->ws + WS_VT) + (size_t)lane * 4608 + 512 + tl;
#pragma unroll
    for (int q = 0; q < 4; ++q)
      VT[(size_t)(((q >> 1) * 2 + bl) * 2 + (q & 1)) * 64 * 4608] = f2bf(vv4[q]);
  }
  if (!lat) {
    size_t o = ((size_t)(b * 2 + l) * 256 + t) * 128;
    p->out[O_AV + o + lane] = vv4[0]; p->out[O_AV + o + 64 + lane] = vv4[1];
    p->out[O_DV + o + lane] = vv4[2]; p->out[O_DV + o + 64 + lane] = vv4[3];
  }
}
DI void prep_item(KP p, int l, int item) {
  const int tid = ltid(), lane = tid & 63, wave = tid >> 6;
  const int row0 = item * 8 + wave * 2;
  u16* R0 = (u16*)(p->ws + WS_INPROJ) + (size_t)row0 * LDI;
  u16* R1 = R0 + LDI;
  float hv0[12], vv0[4], hv1[12], vv1[4];
  prep_load(R0, lane, hv0, vv0); prep_load(R1, lane, hv1, vv1);
  prep_token(p, l, row0, lane, R0, hv0, vv0);
  prep_token(p, l, row0 + 1, lane, R1, hv1, vv1);
}

DI void kvc_item(KP p, int l, int item) {
  u16* KC = (u16*)(p->ws + WS_KC);
#pragma unroll
  for (int it = 0; it < 8; ++it) {
    int idx4 = item * 2048 + it * 256 + ltid();
    int e = idx4 * 4;
    int d = e & 63, key = (e >> 6) & 511, sel = e >> 15;
    int kv = sel & 1, kvh = (sel >> 1) & 1, b = (sel >> 2) & 1, mixer = sel >> 3;
    const float* srcb = mixer ? (kv ? p->in[6] : p->in[5]) : (kv ? p->in[4] : p->in[3]);
    const float* src = srcb + ((size_t)((b * 2 + l) * 512 + key) * 2 + kvh) * 64 + d;
    float4 v = *(const float4*)src;
    *(uint2*)(KC + e) = make_uint2(pack2(v.x, v.y), pack2(v.z, v.w));
    if (kv) {
      u16* VT = (u16*)(p->ws + WS_VT) + ((size_t)((mixer * 2 + b) * 2 + kvh) * 64 + d) * 4608 + key;
      VT[0] = f2bf(v.x); VT[4608] = f2bf(v.y); VT[2 * 4608] = f2bf(v.z); VT[3 * 4608] = f2bf(v.w);
    }
  }
}

DI void attn_item(KP p, int l, int it, unsigned char* smem) {
  u16* sK = (u16*)smem;
  u16* sVt = sK + 64 * 72;
  const int tid = ltid(), lane = tid & 63, wave = tid >> 6, lq = lane & 15, quad = lane >> 4;
  int kind, b, qh, qb;
  if (it < 512) { kind = it >> 8; int r = it & 255; b = r >> 7; qh = (r >> 5) & 3; qb = r & 31; }
  else { int r = it - 512; kind = 2 + (r >> 8); r &= 255; b = r >> 3; qh = (r >> 1) & 3; qb = r & 1; }
  const bool isD = (kind == 0 || kind == 3), lat = kind < 2;
  const int seqrow0 = lat ? 8192 + b * 4096 : b * 256;
  const int q0 = qb * 128, kvh = qh >> 1;
  const int qcol = (isD ? C_DQ : C_AQ) + qh * 64, kcol = (isD ? C_DK : C_AK) + kvh * 64, vcol = (isD ? C_DV : C_AV) + kvh * 64;
  const int ocol = (isD ? 768 : 0) + qh * 64;
  const int ncache = lat ? 8 : 0;
  int kt_lo = 0, kt_hi = lat ? 64 : 4;
  if (kind == 1) { kt_lo = max(0, 2 * qb - 2); kt_hi = min(64, 2 * qb + 4); }
  const int ntiles = ncache + kt_hi - kt_lo;
  const bool band = (kind == 1);
  const u16* INP = (const u16*)(p->ws + WS_INPROJ);
  const u16* KCk = (const u16*)(p->ws + WS_KC) + (size_t)((((isD ? 1 : 0) * 2 + b) * 2 + kvh) * 2) * 512 * 64;
  const u16* KCv = KCk + 512 * 64;
  const float sinkv = isD ? -1e30f : p->in[17][l * 4 + qh];

  bf16x8 qf[2][2];
#pragma unroll
  for (int nt = 0; nt < 2; ++nt)
#pragma unroll
    for (int s = 0; s < 2; ++s) qf[nt][s] = ld8(INP + (size_t)(seqrow0 + q0 + wave * 32 + nt * 16 + lq) * LDI + qcol + s * 32 + quad * 8);
  float mrun[2], lsum[2];
  f32x4 oacc[4][2];
#pragma unroll
  for (int nt = 0; nt < 2; ++nt) { mrun[nt] = sinkv; lsum[nt] = (!isD && quad == 0) ? 1.f : 0.f; }
#pragma unroll
  for (int dt = 0; dt < 4; ++dt)
#pragma unroll
    for (int nt = 0; nt < 2; ++nt) oacc[dt][nt] = f32x4{0.f, 0.f, 0.f, 0.f};

  const int key = tid >> 2, seg = (tid & 3) * 16;
  u32x4 rk[2], rv[2];
  const u16* VTp = (const u16*)(p->ws + WS_VT) + ((size_t)(((isD ? 1 : 0) * 2 + b) * 2 + kvh) * 64 + key) * 4608 + seg;
  auto tile_ptrs = [&](int t, const u16*& kp, const u16*& vp) {
    if (t < ncache) { kp = KCk + (size_t)(t * 64 + key) * 64 + seg; vp = VTp + t * 64; }
    else {
      const u16* rowp = INP + (size_t)(seqrow0 + (kt_lo + t - ncache) * 64 + key) * LDI; kp = rowp + kcol + seg;
      vp = lat ? VTp + 512 + (kt_lo + t - ncache) * 64 : rowp + vcol + seg;
    }
  };
  { const u16 *kp, *vp; tile_ptrs(0, kp, vp); rk[0] = *(const u32x4*)kp; rk[1] = *(const u32x4*)(kp + 8); rv[0] = *(const u32x4*)vp; rv[1] = *(const u32x4*)(vp + 8); }
  for (int t = 0; t < ntiles; ++t) {
    __syncthreads();
    *(u32x4*)(sK + key * 72 + seg) = rk[0]; *(u32x4*)(sK + key * 72 + seg + 8) = rk[1];
    if (lat) {
      *(u32x4*)(sVt + key * 72 + seg) = rv[0]; *(u32x4*)(sVt + key * 72 + seg + 8) = rv[1];
    } else {
      unsigned vv[8] = {rv[0].x, rv[0].y, rv[0].z, rv[0].w, rv[1].x, rv[1].y, rv[1].z, rv[1].w};
#pragma unroll
      for (int e = 0; e < 8; ++e) { sVt[(seg + 2 * e) * 72 + key] = (u16)(vv[e] & 0xffffu); sVt[(seg + 2 * e + 1) * 72 + key] = (u16)(vv[e] >> 16); }
    }
    __syncthreads();
    if (t + 1 < ntiles) { const u16 *kp, *vp; tile_ptrs(t + 1, kp, vp); rk[0] = *(const u32x4*)kp; rk[1] = *(const u32x4*)(kp + 8); rv[0] = *(const u32x4*)vp; rv[1] = *(const u32x4*)(vp + 8); }
    f32x4 sacc[4][2];
#pragma unroll
    for (int mt = 0; mt < 4; ++mt) {
      sacc[mt][0] = f32x4{0.f, 0.f, 0.f, 0.f}; sacc[mt][1] = f32x4{0.f, 0.f, 0.f, 0.f};
#pragma unroll
      for (int s = 0; s < 2; ++s) {
        bf16x8 ka = ld8(sK + (mt * 16 + lq) * 72 + s * 32 + quad * 8);
        sacc[mt][0] = MFMA16(ka, qf[0][s], sacc[mt][0]);
        sacc[mt][1] = MFMA16(ka, qf[1][s], sacc[mt][1]);
      }
    }
    const bool masked_tile = band && t >= ncache;
    const int kbase = (kt_lo + t - ncache) * 64;
    bf16x8 pf[2][2];
#pragma unroll
    for (int nt = 0; nt < 2; ++nt) {
      const int qi = q0 + wave * 32 + nt * 16 + lq;
      float tmax = -1e30f;
#pragma unroll
      for (int mt = 0; mt < 4; ++mt)
#pragma unroll
        for (int r = 0; r < 4; ++r) {
          float s = sacc[mt][nt][r] * 0.125f;
          if (masked_tile) { int kj = kbase + mt * 16 + quad * 4 + r; int dlt = qi - kj; if (dlt > 128 || dlt < -128) s = -1e30f; }
          sacc[mt][nt][r] = s; tmax = fmaxf(tmax, s);
        }
      tmax = fmaxf(tmax, __shfl_xor(tmax, 16, 64)); tmax = fmaxf(tmax, __shfl_xor(tmax, 32, 64));
      const float mnew = fmaxf(mrun[nt], tmax);
      const float alpha = __expf(mrun[nt] - mnew);
      float ps = 0.f;
#pragma unroll
      for (int mt = 0; mt < 4; ++mt)
#pragma unroll
        for (int r = 0; r < 4; ++r) { float e = __expf(sacc[mt][nt][r] - mnew); sacc[mt][nt][r] = e; ps += e; }
      lsum[nt] = lsum[nt] * alpha + ps; mrun[nt] = mnew;
#pragma unroll
      for (int dt = 0; dt < 4; ++dt)
#pragma unroll
        for (int r = 0; r < 4; ++r) oacc[dt][nt][r] *= alpha;
      pf[nt][0] = pack8(sacc[0][nt], sacc[1][nt]);
      pf[nt][1] = pack8(sacc[2][nt], sacc[3][nt]);
    }
#pragma unroll
    for (int dt = 0; dt < 4; ++dt)
#pragma unroll
      for (int s2 = 0; s2 < 2; ++s2) {
        bf16x8 va = ldperm(sVt + (dt * 16 + lq) * 72 + s2 * 32 + quad * 4);
        oacc[dt][0] = MFMA16(va, pf[0][s2], oacc[dt][0]);
        oacc[dt][1] = MFMA16(va, pf[1][s2], oacc[dt][1]);
      }
  }
  u16* BR = (u16*)(p->ws + WS_BRANCH);
#pragma unroll
  for (int nt = 0; nt < 2; ++nt) {
    float lt = lsum[nt]; lt += __shfl_xor(lt, 16, 64); lt += __shfl_xor(lt, 32, 64);
    const float inv = 1.f / lt;
    const size_t row = seqrow0 + q0 + wave * 32 + nt * 16 + lq;
#pragma unroll
    for (int dt = 0; dt < 4; ++dt)
      *(uint2*)(BR + row * 1024 + ocol + dt * 16 + quad * 4) = make_uint2(pack2(oacc[dt][nt][0] * inv, oacc[dt][nt][1] * inv), pack2(oacc[dt][nt][2] * inv, oacc[dt][nt][3] * inv));
  }
  __syncthreads();
}

DI int lru_xoff(int t, int c) { return t * 256 + (c ^ ((t & 7) << 3)); }
template <bool FINAL>
DI void lru_item(KP p, int l, int ci, unsigned char* smem) {
  u16* sxb = (u16*)smem;
  u16* sla = sxb + 32 * 256;
  u16* sbv = sla + 32 * 256;
  u16* shf = sbv + 32 * 256;
  const int tid = ltid(), ch = tid, lane = tid & 63, n = tid >> 6, lq = lane & 15, quad = lane >> 4;
  const int r0 = ci * 32;
  const bool lat = r0 >= 8192;
  int b, T, seqrow0;
  if (!lat) { b = r0 >> 8; T = 256; seqrow0 = b * 256; } else { b = (r0 - 8192) >> 12; T = 4096; seqrow0 = 8192 + b * 4096; }
  const int t0 = r0 - seqrow0;
  const u16* INP = (const u16*)(p->ws + WS_INPROJ);
  __syncthreads();
  {
    const float* cw = p->in[18] + l * 4 * 256;
    const float w0 = cw[ch], w1 = cw[256 + ch], w2 = cw[512 + ch], w3 = cw[768 + ch], cb = p->in[19][l * 256 + ch];
    auto ld = [&](int t) -> float { return (t >= 0 && t < T) ? bf2f(INP[(size_t)(seqrow0 + t) * LDI + C_LX + ch]) : 0.f; };
    float xin[35];
#pragma unroll
    for (int q = 0; q < 35; ++q) xin[q] = ld(t0 - 2 + q);
#pragma unroll
    for (int t = 0; t < 32; ++t) sxb[lru_xoff(t, ch)] = f2bf(xin[t] * w0 + xin[t + 1] * w1 + xin[t + 2] * w2 + xin[t + 3] * w3 + cb);
  }
  __syncthreads();
  const int nch = T / 32, c = t0 / 32;
  float* LC = (float*)(p->ws + WS_LRUC);
  bf16x8 af[2][2];
#pragma unroll
  for (int mt = 0; mt < 2; ++mt)
#pragma unroll
    for (int s2 = 0; s2 < 2; ++s2) af[mt][s2] = ld8(sxb + lru_xoff(mt * 16 + lq, n * 64 + s2 * 32 + quad * 8));
  for (int dir = 0; dir < 2; ++dir) {
    bf16x8 wf[2][4][2];
    {
      const u32x4* WF = (const u32x4*)(p->ws + WS_LRUW);
#pragma unroll
      for (int g = 0; g < 2; ++g)
#pragma unroll
        for (int j = 0; j < 4; ++j)
#pragma unroll
          for (int s2 = 0; s2 < 2; ++s2)
            wf[g][j][s2] = __builtin_bit_cast(bf16x8, WF[(size_t)((((((l * 2 + dir) * 2 + g) * 4 + n) * 4 + j) * 2 + s2)) * 64 + lane]);
    }
#pragma unroll
    for (int j = 0; j < 4; ++j) {
      f32x4 acc[2][2];
#pragma unroll
      for (int g = 0; g < 2; ++g) {
        f32x4 a0 = {0.f, 0.f, 0.f, 0.f}, a1 = {0.f, 0.f, 0.f, 0.f};
#pragma unroll
        for (int s2 = 0; s2 < 2; ++s2) { a0 = MFMA16(af[0][s2], wf[g][j][s2], a0); a1 = MFMA16(af[1][s2], wf[g][j][s2], a1); }
        acc[g][0] = a0; acc[g][1] = a1;
      }
      const int cc = n * 64 + j * 16 + lq;
      const float br = p->in[21][(l * 2 + dir) * 256 + cc], bi = p->in[23][(l * 2 + dir) * 256 + cc];
      const float sp = softplusf_(-p->in[24][(l * 2 + dir) * 256 + cc]);
#pragma unroll
      for (int mt = 0; mt < 2; ++mt)
#pragma unroll
        for (int r = 0; r < 4; ++r) {
          const int t = mt * 16 + quad * 4 + r;
          const float la = -8.f * sigm(acc[0][mt][r] + br) * sp;
          const float xt = bf2f(sxb[lru_xoff(t, cc)]);
          const float bb = sqrtf(-expm1f(2.f * la)) * sigm(acc[1][mt][r] + bi) * xt;
          sla[t * 256 + cc] = f2bf(la); sbv[t * 256 + cc] = f2bf(bb);
        }
    }
    __syncthreads();
    float h = 0.f, lasum = 0.f;
    if (FINAL) {
      h = lat ? p->in[7][((b * 2 + l) * 2 + dir) * 256 + ch] : 0.f;
      const int ncar = dir == 0 ? c : nch - 1 - c;
      const int cstart = dir == 0 ? ci - c : ci - c + nch - 1, cstep = dir == 0 ? 1 : -1;
      for (int q0 = 0; q0 < ncar; q0 += 16) {
        float ca[16], chh[16];
#pragma unroll
        for (int q = 0; q < 16; ++q) {
          const int qq = q0 + q < ncar ? q0 + q : ncar - 1;
          const float* C = LC + ((size_t)((cstart + cstep * qq) * 2 + dir) * 2) * 256;
          ca[q] = C[ch]; chh[q] = C[256 + ch];
        }
#pragma unroll
        for (int q = 0; q < 16; ++q) if (q0 + q < ncar) h = ca[q] * h + chh[q];
      }
    }
#pragma unroll 1
    for (int s8 = 0; s8 < 32; s8 += 16) {
      float gv[16];
      if (FINAL && dir == 1) {
#pragma unroll
        for (int q = 0; q < 16; ++q) gv[q] = bf2f(INP[(size_t)(r0 + 31 - s8 - q) * LDI + C_LG + ch]);
      }
#pragma unroll
      for (int q = 0; q < 16; ++q) {
        const int st = s8 + q;
        const int t = dir == 0 ? st : 31 - st;
        const float la = bf2f(sla[t * 256 + ch]);
        h = __expf(la) * h + bf2f(sbv[t * 256 + ch]);
        lasum += la;
        if (FINAL) {
          if (dir == 0) shf[t * 256 + ch] = f2bf(h);
          else ((u16*)(p->ws + WS_BRANCH))[(size_t)(r0 + t) * 1024 + 256 + ch] = f2bf((bf2f(shf[t * 256 + ch]) + h) * gelu_tanh(gv[q]));
        }
      }
    }
    if (!FINAL) { float* C = LC + ((size_t)(ci * 2 + dir) * 2) * 256; C[ch] = __expf(lasum); C[256 + ch] = h; }
    else if (!lat) {
      if (dir == 0 && c == nch - 1) p->out[O_LRU + ((size_t)(b * 2 + l) * 2 + 0) * 256 + ch] = h;
      if (dir == 1 && c == 0) p->out[O_LRU + ((size_t)(b * 2 + l) * 2 + 1) * 256 + ch] = h;
    }
    __syncthreads();
  }
}

template <int DIR, bool ISW>
DI void gdn_solve(const float* L, const u16* src, const float* sb_, const float* se_, u16* UW) {
  float sol[64];
#pragma unroll
  for (int i = 0; i < 64; ++i) {
    float s = bf2f(src[(DIR == 0 ? i : 63 - i) * 72]) * sb_[i];
    if (ISW) s *= se_[i];
    float s0 = 0.f, s1 = 0.f, s2 = 0.f, s3 = 0.f;
#pragma unroll
    for (int j4 = 0; j4 < (i + 3) / 4; ++j4) {
      float4 lv = *(const float4*)(L + i * 64 + j4 * 4);
      if (j4 * 4 + 0 < i) s0 += lv.x * sol[j4 * 4 + 0];
      if (j4 * 4 + 1 < i) s1 += lv.y * sol[j4 * 4 + 1];
      if (j4 * 4 + 2 < i) s2 += lv.z * sol[j4 * 4 + 2];
      if (j4 * 4 + 3 < i) s3 += lv.w * sol[j4 * 4 + 3];
      if ((j4 & 3) == 3) asm volatile("" ::: "memory");
    }
    s -= (s0 + s1) + (s2 + s3);
    sol[i] = s;
    UW[i * 128] = f2bf(s);
    asm volatile("" ::: "memory");
  }
}

DI void gdn1_item(KP p, int l, int item, unsigned char* smem) {
  const int cgi = item >> 2, hd = item & 3;
  u16* sq = (u16*)smem; u16* sk = sq + 64 * 72; u16* sv = sk + 64 * 72;
  float* sL = (float*)(smem + 27648);
  float* sgc = (float*)(smem + 60416);
  float* sbeta = sgc + 128;
  float* sge = sbeta + 128;
  const int tid = ltid(), lane = tid & 63, wave = tid >> 6, lq = lane & 15, quad = lane >> 4;
  const int r0 = cgi * 64;
  const bool lat = r0 >= 8192;
  int T, seqrow0;
  if (!lat) { T = 256; seqrow0 = (r0 >> 8) * 256; } else { T = 4096; seqrow0 = 8192 + ((r0 - 8192) >> 12) * 4096; }
  const int t0 = r0 - seqrow0;
  const u16* INP = (const u16*)(p->ws + WS_INPROJ);
  u16* QHAT = (u16*)(p->ws + WS_QHAT) + (size_t)item * 4096;
  {
    const int d = lane, tb = wave * 16;
#pragma unroll
    for (int mat = 0; mat < 3; ++mat) {
      const int col = C_GQ + mat * 256 + hd * 64 + d, wc = mat * 256 + hd * 64 + d;
      const float* cw = p->in[25] + (size_t)l * 4 * 768;
      const float w0 = cw[wc], w1 = cw[768 + wc], w2 = cw[1536 + wc], w3 = cw[2304 + wc];
      auto ld = [&](int t) -> float { return (t >= 0 && t < T) ? bf2f(INP[(size_t)(seqrow0 + t) * LDI + col]) : 0.f; };
      float xin[19];
#pragma unroll
      for (int q = 0; q < 19; ++q) xin[q] = ld(t0 + tb - 2 + q);
      u16* dst = mat == 0 ? sq : (mat == 1 ? sk : sv);
#pragma unroll
      for (int tt = 0; tt < 16; ++tt) {
        const int t = tb + tt;
        float v = siluf_(xin[tt] * w0 + xin[tt + 1] * w1 + xin[tt + 2] * w2 + xin[tt + 3] * w3);
        if (mat < 2) { float ss = wave_sum(v * v); v *= rsqrtf(ss + 1e-6f) * (mat == 0 ? 0.125f : 1.f); }
        u16 hb = f2bf(v);
        dst[t * 72 + d] = hb;
        if (mat == 0) QHAT[t * 64 + d] = hb;
      }
    }
  }
  if (tid < 128) {
    const int dir = tid >> 6, c = tid & 63;
    const int tok = dir == 0 ? c : 63 - c;
    const u16* R = INP + (size_t)(r0 + tok) * LDI;
    const float ga = bf2f(R[C_GA + dir * 4 + hd]), gb = bf2f(R[C_GB + dir * 4 + hd]);
    const float g = -__expf(p->in[26][(l * 2 + dir) * 4 + hd]) * softplusf_(ga + p->in[27][(l * 2 + dir) * 4 + hd]);
    float gc = g;
#pragma unroll
    for (int o = 1; o < 64; o <<= 1) { float tt = __shfl_up(gc, o, 64); if (lane >= o) gc += tt; }
    const float glast = __shfl(gc, 63, 64);
    sgc[dir * 64 + c] = gc; sbeta[dir * 64 + c] = sigm(gb); sge[dir * 64 + c] = __expf(gc);
    float* gv = (float*)(p->ws + WS_GVEC) + (size_t)(item * 2 + dir) * 256;
    gv[c] = __expf(gc); gv[64 + c] = __expf(glast - gc); if (c == 0) gv[128] = __expf(glast);
  }
  __syncthreads();
  {
    const int dk = tid >> 2, c0 = (tid & 3) * 16;
    unsigned w[8];
#pragma unroll
    for (int e = 0; e < 8; ++e) w[e] = (unsigned)sk[(c0 + 2 * e) * 72 + dk] | ((unsigned)sk[(c0 + 2 * e + 1) * 72 + dk] << 16);
    u16* KT = (u16*)(p->ws + WS_KT) + (size_t)item * 4096 + dk * 64 + c0;
    *(u32x4*)KT = mku4(w[0], w[1], w[2], w[3]); *(u32x4*)(KT + 8) = mku4(w[4], w[5], w[6], w[7]);
  }
  {
    const int i0 = wave * 16;
    f32x4 akk[4], aqk[4];
#pragma unroll
    for (int nt = 0; nt < 4; ++nt) { akk[nt] = f32x4{0.f, 0.f, 0.f, 0.f}; aqk[nt] = f32x4{0.f, 0.f, 0.f, 0.f}; }
#pragma unroll
    for (int s = 0; s < 2; ++s) {
      bf16x8 ak = ld8(sk + (i0 + lq) * 72 + s * 32 + quad * 8), aq = ld8(sq + (i0 + lq) * 72 + s * 32 + quad * 8);
#pragma unroll
      for (int nt = 0; nt < 4; ++nt) { bf16x8 bk = ld8(sk + (nt * 16 + lq) * 72 + s * 32 + quad * 8); akk[nt] = MFMA16(ak, bk, akk[nt]); aqk[nt] = MFMA16(aq, bk, aqk[nt]); }
    }
    u16* QKf = (u16*)(p->ws + WS_QK) + (size_t)(item * 2 + 0) * 4096;
    u16* QKb = (u16*)(p->ws + WS_QK) + (size_t)(item * 2 + 1) * 4096;
#pragma unroll
    for (int nt = 0; nt < 4; ++nt)
#pragma unroll
      for (int r = 0; r < 4; ++r) {
        const int i = i0 + quad * 4 + r, j = nt * 16 + lq, ib = 63 - i, jb = 63 - j;
        const float kkv = akk[nt][r], qkv = aqk[nt][r];
        if (j < i) sL[i * 64 + j] = sbeta[i] * kkv * __expf(sgc[i] - sgc[j]);
        if (j > i) sL[4096 + ib * 64 + jb] = sbeta[64 + ib] * kkv * __expf(sgc[64 + ib] - sgc[64 + jb]);
        QKf[i * 64 + j] = f2bf(j <= i ? qkv * __expf(sgc[i] - sgc[j]) : 0.f);
        QKb[ib * 64 + jb] = f2bf(j >= i ? qkv * __expf(sgc[64 + ib] - sgc[64 + jb]) : 0.f);
      }
  }
  __syncthreads();
  {
    const int col = tid & 127;
    u16* UW = (u16*)(p->ws + WS_UW) + (size_t)(item * 2 + (tid >> 7)) * 8192 + col;
    for (int rep = 0; rep < NREP(2); ++rep) {
    if (tid < 128) { if (col < 64) gdn_solve<0, false>(sL, sv + col, sbeta, sge, UW); else gdn_solve<0, true>(sL, sk + (col - 64), sbeta, sge, UW); }
    else { if (col < 64) gdn_solve<1, false>(sL + 4096, sv + col, sbeta + 64, sge + 64, UW); else gdn_solve<1, true>(sL + 4096, sk + (col - 64), sbeta + 64, sge + 64, UW); }
    }
  }
  __syncthreads();
}

DI void gdn2_item(KP p, int l, int item, unsigned char* smem) {
  u16* sW = (u16*)smem; u16* sKT = sW + 64 * 72; u16* sU = sKT + 64 * 72;
  float* sg = (float*)(smem + 27648);
  const int tid = ltid(), lane = tid & 63, wave = tid >> 6, lq = lane & 15, quad = lane >> 4;
  int b, hd, dir; bool lat;
  if (item < 16) { lat = true; b = item >> 3; hd = (item >> 1) & 3; dir = item & 1; }
  else { lat = false; int r = item - 16; b = r >> 3; hd = (r >> 1) & 3; dir = r & 1; }
  const int nch = lat ? 64 : 4, cg0 = lat ? 128 + b * 64 : b * 4;
  f32x4 st[4];
#pragma unroll
  for (int kt = 0; kt < 4; ++kt)
#pragma unroll
    for (int r = 0; r < 4; ++r)
      st[kt][r] = lat ? p->in[8][((size_t)(((b * 2 + l) * 2 + dir) * 4 + hd) * 64 + kt * 16 + quad * 4 + r) * 64 + wave * 16 + lq] : 0.f;
  const int lrow = tid >> 2, seg = (tid & 3) * 16;
  struct GReg { u32x4 U[2], W[2], KT[2]; float g; };
  GReg R0, R1;
  u16* UWb = (u16*)(p->ws + WS_UW);
  const u16* KTb = (const u16*)(p->ws + WS_KT);
  const float* GV = (const float*)(p->ws + WS_GVEC);
  auto gload = [&](int n, GReg& R) {
    const int cgi = dir == 0 ? cg0 + n : cg0 + nch - 1 - n;
    const size_t prob = (size_t)cgi * 4 + hd, pd = prob * 2 + dir;
    const u16* u = UWb + (pd * 64 + lrow) * 128 + seg;
    R.U[0] = *(const u32x4*)u; R.U[1] = *(const u32x4*)(u + 8); R.W[0] = *(const u32x4*)(u + 64); R.W[1] = *(const u32x4*)(u + 72);
    const u16* kt = KTb + (prob * 64 + lrow) * 64 + (dir ? 48 - seg : seg);
    u32x4 a = *(const u32x4*)kt, bb = *(const u32x4*)(kt + 8);
    if (dir) { R.KT[0] = rev8(bb); R.KT[1] = rev8(a); } else { R.KT[0] = a; R.KT[1] = bb; }
    R.g = GV[pd * 256 + (tid & 255)];
  };
  gload(0, R0); gload(1, R1);
  auto step = [&](int n, GReg& R) {
    const int cgi = dir == 0 ? cg0 + n : cg0 + nch - 1 - n;
    const size_t pd = ((size_t)cgi * 4 + hd) * 2 + dir;
    __syncthreads();
    *(u32x4*)(sW + lrow * 72 + seg) = R.W[0]; *(u32x4*)(sW + lrow * 72 + seg + 8) = R.W[1];
    *(u32x4*)(sKT + lrow * 72 + seg) = R.KT[0]; *(u32x4*)(sKT + lrow * 72 + seg + 8) = R.KT[1];
    *(u32x4*)(sU + lrow * 72 + seg) = R.U[0]; *(u32x4*)(sU + lrow * 72 + seg + 8) = R.U[1];
    sg[tid] = R.g;
    __syncthreads();
    if (n + 2 < nch) gload(n + 2, R);
    u32x4* FR = (u32x4*)(UWb + pd * 8192);
    const float elast = sg[128];
    bf16x8 sB[2] = {pack8(st[0], st[1]), pack8(st[2], st[3])};
    FR[(0 * 4 + wave) * 64 + lane] = __builtin_bit_cast(u32x4, sB[0]);
    FR[(1 * 4 + wave) * 64 + lane] = __builtin_bit_cast(u32x4, sB[1]);
    f32x4 vn[4];
#pragma unroll
    for (int mt = 0; mt < 4; ++mt) {
      f32x4 acc = {0.f, 0.f, 0.f, 0.f};
#pragma unroll
      for (int s2 = 0; s2 < 2; ++s2) acc = MFMA16(ldperm(sW + (mt * 16 + lq) * 72 + s2 * 32 + quad * 4), sB[s2], acc);
#pragma unroll
      for (int r = 0; r < 4; ++r) vn[mt][r] = bf2f(sU[(mt * 16 + quad * 4 + r) * 72 + wave * 16 + lq]) - acc[r];
    }
    bf16x8 vB[2] = {pack8(vn[0], vn[1]), pack8(vn[2], vn[3])};
    FR[512 + (0 * 4 + wave) * 64 + lane] = __builtin_bit_cast(u32x4, vB[0]);
    FR[512 + (1 * 4 + wave) * 64 + lane] = __builtin_bit_cast(u32x4, vB[1]);
#pragma unroll
    for (int mt = 0; mt < 4; ++mt)
#pragma unroll
      for (int r = 0; r < 4; ++r) vn[mt][r] *= sg[64 + mt * 16 + quad * 4 + r];
    bf16x8 vsB[2] = {pack8(vn[0], vn[1]), pack8(vn[2], vn[3])};
#pragma unroll
    for (int kt = 0; kt < 4; ++kt) {
      f32x4 acc = {0.f, 0.f, 0.f, 0.f};
#pragma unroll
      for (int s2 = 0; s2 < 2; ++s2) acc = MFMA16(ldperm(sKT + (kt * 16 + lq) * 72 + s2 * 32 + quad * 4), vsB[s2], acc);
#pragma unroll
      for (int r = 0; r < 4; ++r) st[kt][r] = elast * st[kt][r] + acc[r];
    }
  };
  for (int n = 0; n < nch; n += 2) { step(n, R0); step(n + 1, R1); }
  if (!lat) {
#pragma unroll
    for (int kt = 0; kt < 4; ++kt)
#pragma unroll
      for (int r = 0; r < 4; ++r)
        p->out[O_GDN + ((size_t)(((b * 2 + l) * 2 + dir) * 4 + hd) * 64 + kt * 16 + quad * 4 + r) * 64 + wave * 16 + lq] = st[kt][r];
  }
  __syncthreads();
}

DI void gdnfin_item(KP p, int l, int item, unsigned char* smem) {
  u16* sQ = (u16*)smem; u16* sQK = sQ + 64 * 72;
  float* so = (float*)(smem + 3 * 64 * 72 * 2);
  float* seg_ = so + 64 * 65;
  const int cgi = item >> 2, hd = item & 3;
  const int tid = ltid(), lane = tid & 63, wave = tid >> 6, lq = lane & 15, quad = lane >> 4;
  const int lrow = tid >> 2, seg = (tid & 3) * 16;
  __syncthreads();
  {
    const u16* q = (const u16*)(p->ws + WS_QHAT) + ((size_t)item * 64 + lrow) * 64 + seg;
    *(u32x4*)(sQ + lrow * 72 + seg) = *(const u32x4*)q; *(u32x4*)(sQ + lrow * 72 + seg + 8) = *(const u32x4*)(q + 8);
#pragma unroll
    for (int dir = 0; dir < 2; ++dir) {
      const u16* qk = (const u16*)(p->ws + WS_QK) + ((size_t)(item * 2 + dir) * 64 + lrow) * 64 + seg;
      *(u32x4*)(sQK + (dir * 64 + lrow) * 72 + seg) = *(const u32x4*)qk; *(u32x4*)(sQK + (dir * 64 + lrow) * 72 + seg + 8) = *(const u32x4*)(qk + 8);
    }
    if (tid < 128) seg_[tid] = ((const float*)(p->ws + WS_GVEC))[(size_t)(item * 2 + (tid >> 6)) * 256 + (tid & 63)];
  }
  __syncthreads();
#pragma unroll
  for (int dir = 0; dir < 2; ++dir) {
    const u32x4* FR = (const u32x4*)((const u16*)(p->ws + WS_UW) + (size_t)(item * 2 + dir) * 8192);
    bf16x8 sfr[2], vfr[2];
#pragma unroll
    for (int s2 = 0; s2 < 2; ++s2) {
      sfr[s2] = __builtin_bit_cast(bf16x8, FR[(s2 * 4 + wave) * 64 + lane]);
      vfr[s2] = __builtin_bit_cast(bf16x8, FR[512 + (s2 * 4 + wave) * 64 + lane]);
    }
#pragma unroll
    for (int mt = 0; mt < 4; ++mt) {
      f32x4 acc = {0.f, 0.f, 0.f, 0.f};
      const int qrow = dir ? 63 - (mt * 16 + lq) : mt * 16 + lq;
#pragma unroll
      for (int s2 = 0; s2 < 2; ++s2) acc = MFMA16(ldperm(sQ + qrow * 72 + s2 * 32 + quad * 4), sfr[s2], acc);
#pragma unroll
      for (int r = 0; r < 4; ++r) acc[r] *= seg_[dir * 64 + mt * 16 + quad * 4 + r];
#pragma unroll
      for (int s2 = 0; s2 < 2; ++s2) acc = MFMA16(ldperm(sQK + (dir * 64 + mt * 16 + lq) * 72 + s2 * 32 + quad * 4), vfr[s2], acc);
#pragma unroll
      for (int r = 0; r < 4; ++r) {
        const int c = mt * 16 + quad * 4 + r;
        const int tk = dir ? 63 - c : c;
        float* d = so + tk * 65 + wave * 16 + lq;
        if (dir == 0) *d = acc[r]; else *d += acc[r];
      }
    }
    __syncthreads();
  }
  const float gn = p->in[28][l * 64 + lane];
  float zv[16];
#pragma unroll
  for (int q = 0; q < 16; ++q)
    zv[q] = bf2f(((const u16*)(p->ws + WS_INPROJ))[((size_t)cgi * 64 + wave * 16 + q) * LDI + C_GZ + hd * 64 + lane]);
#pragma unroll
  for (int q = 0; q < 16; ++q) {
    const int c = wave * 16 + q;
    const size_t row = (size_t)cgi * 64 + c;
    float o = so[c * 65 + lane];
    float ss = wave_sum(o * o);
    float y = o * rsqrtf(ss * (1.f / 64.f) + 1e-6f) * gn * siluf_(zv[q]);
    ((u16*)(p->ws + WS_BRANCH))[row * 1024 + 512 + hd * 64 + lane] = f2bf(y);
  }
}

#define XB_TMO      128
#define XB_XCNT(j)  (256  + 64 * (j))
#define XB_XSUB(j)  (1280 + 64 * (j))
#define XB_XGEN(j)  (2304 + 64 * (j))
#define XB_TOP      3328
#define XB_TOPGEN   3392
#define XB_SPIN_CAP (1u << 20)
#define LAS __attribute__((address_space(3)))
DI unsigned xb_ld(unsigned* q) { return __hip_atomic_load(q, __ATOMIC_RELAXED, __HIP_MEMORY_SCOPE_AGENT); }
DI unsigned xb_add(unsigned* q, unsigned v) { return __hip_atomic_fetch_add(q, v, __ATOMIC_RELAXED, __HIP_MEMORY_SCOPE_AGENT); }
DI unsigned xb_xcc_id() { return (unsigned)__builtin_amdgcn_s_getreg((3 << 11) | 20) & 0xFu; }
#define XB_SPIN(cond, bar) do { unsigned _sp = 0; while (cond) { __builtin_amdgcn_s_sleep(1); \
    if ((++_sp & 255u) == 0u) { if (xb_ld(&(bar)[XB_TMO])) break; if (_sp > XB_SPIN_CAP) { atomicAdd(&(bar)[XB_TMO], 1u); break; } } } } while (0)
DI void xcd_barrier_complete(unsigned* bar, unsigned x, unsigned& nloc, unsigned& nx) {
  const unsigned G = gridDim.x;
  unsigned sum, cnt, mine, sp = 0u;
  for (;;) {
    sum = 0u; cnt = 0u; mine = 0u;
#pragma unroll
    for (unsigned j = 0; j < 16; ++j) { const unsigned c = xb_ld(&bar[XB_XCNT(j)]); sum += c; cnt += (c > 0u) ? 1u : 0u; mine = (j == x) ? c : mine; }
    if (sum == G) break;
    __builtin_amdgcn_s_sleep(1);
    if ((++sp & 255u) == 0u) { if (xb_ld(&bar[XB_TMO])) break; if (sp > XB_SPIN_CAP) { atomicAdd(&bar[XB_TMO], 1u); break; } }
  }
  nloc = mine > 0u ? mine : 1u; nx = cnt > 0u ? cnt : 1u;
}
DI void xcd_barrier(unsigned* bar, volatile LAS unsigned* st) {
  asm volatile("s_waitcnt vmcnt(0)" ::: "memory");
  __syncthreads();
  if (ltid() == 0) {
    const unsigned x = xb_xcc_id();
    __builtin_amdgcn_s_waitcnt(0);
    unsigned nloc = st[0], nx = st[1];
    if (nloc == 0u) { xcd_barrier_complete(bar, x, nloc, nx); st[0] = nloc; st[1] = nx; }
    const unsigned old = xb_add(&bar[XB_XSUB(x)], 1u);
    const unsigned gen = old / nloc;
    if (old + 1u == (gen + 1u) * nloc) {
      __builtin_amdgcn_fence(__ATOMIC_RELEASE, "agent");
      asm volatile("s_waitcnt vmcnt(0)" ::: "memory");
      const unsigned og = xb_add(&bar[XB_TOP], 1u);
      const unsigned tg = og / nx;
      if (og + 1u == (tg + 1u) * nx) xb_add(&bar[XB_TOPGEN], 1u);
      else XB_SPIN(xb_ld(&bar[XB_TOPGEN]) == tg, bar);
      __builtin_amdgcn_fence(__ATOMIC_ACQUIRE, "agent");
      xb_add(&bar[XB_XGEN(x)], 1u);
      asm volatile("s_waitcnt vmcnt(0)" ::: "memory");
    } else {
      XB_SPIN(xb_ld(&bar[XB_XGEN(x)]) == gen, bar);
      __builtin_amdgcn_fence(__ATOMIC_ACQUIRE, "agent");
      asm volatile("s_waitcnt vmcnt(0)" ::: "memory");
    }
  }
  __syncthreads();
}


#define FOR_TILES(MTI, NTI, SM, SN, CALL)                                                      \
  do {                                                                                         \
    if (G % 8 != 0) { for (int it_ = B; it_ < (MTI) * (NTI); it_ += G) { const int mt = it_ / (NTI), nt = it_ % (NTI); CALL; } } \
    else {                                                                                     \
      const int xcd_ = B & 7, j_ = B >> 3, J_ = G >> 3;                                        \
      const int nsm_ = ((MTI) + (SM) - 1) / (SM), nsn_ = ((NTI) + (SN) - 1) / (SN);            \
      for (int s_ = xcd_; s_ < nsm_ * nsn_; s_ += 8) {                                         \
        const int sm_ = s_ / nsn_, sn_ = s_ % nsn_;                                            \
        for (int t_ = j_; t_ < (SM) * (SN); t_ += J_) {                                        \
          const int mt = sm_ * (SM) + t_ / (SN), nt = sn_ * (SN) + t_ % (SN);                  \
          if (mt < (MTI) && nt < (NTI)) { CALL; }                                              \
        }                                                                                      \
      }                                                                                        \
    }                                                                                          \
  } while (0)

constexpr int NPHASE = 21;
__global__ void __launch_bounds__(256, 2) mk(Params p_unused, int ph_lo, int ph_hi) {
  extern __shared__ __attribute__((aligned(1024))) unsigned char smem[];
  int& s_item = *(int*)(smem + SMEM_BYTES);
  u32x4& xb_words = *(u32x4*)(smem + SMEM_BYTES + 16);
  const int G = gridDim.x, B = blockIdx.x;
  const bool fused = ph_hi - ph_lo > 1;
  if (fused) {
    if (ltid() == 0) { xb_words = u32x4{0u, 0u, 0u, 0u}; (void)xb_add(&((unsigned*)(((KP)__builtin_amdgcn_kernarg_segment_ptr())->ws + WS_BAR))[XB_XCNT(xb_xcc_id())], 1u); }
    __syncthreads();
  }
  for (int ph = ph_lo; ph < ph_hi; ++ph) {
    KP p = (KP)__builtin_amdgcn_kernarg_segment_ptr();
    asm volatile("" : "+s"(p));
    if (ph == 0) {
      for (int it = B; it < 192 + CONV_ITEMS + 64; it += G) { for (int rep = 0; rep < NREP(0); ++rep) { if (it < 192) mod_item(p, it, smem); else if (it < 192 + CONV_ITEMS) convert_item(p, 0, it - 192, smem); else lruw_item(p, it - 192 - CONV_ITEMS); } }
    } else {
      const int l = (ph - 1) / 10, sub = (ph - 1) % 10;
      switch (sub) {
        case 0:
          for (int it = B; it < 2048 + (l ? CONV_ITEMS : 0); it += G) { if (it < 2048) norm_item<0>(p, l, it); else convert_item(p, l, it - 2048, smem); }
          break;
        case 1: FOR_TILES(128, 21, 8, 7, inproj_item(p, mt, nt, smem)); break;
        case 2:
          for (int it = B; it < 1024 + 512 + 64 + 2048; it += G) {
            if (it < 1024) { for (int rep = 0; rep < NREP(4); ++rep) gdn1_item(p, l, it, smem); }
            else if (it < 1536) { for (int rep = 0; rep < NREP(5); ++rep) lru_item<false>(p, l, it - 1024, smem); }
            else if (it < 1600) { if (PHON(6)) kvc_item(p, l, it - 1536); }
            else if (PHON(6)) prep_item(p, l, it - 1600);
          }
          break;
        case 3: {
          int* ctr = (int*)(p->ws + WS_CTR) + l;
          for (;;) {
            __syncthreads();
            if (ltid() == 0) s_item = atomicAdd(ctr, 1);
            __syncthreads();
            const int it = s_item;
            if (it >= 16 + 256 + 256 + 256 + 512 + 512) break;
            if (it < 16) gdn2_item(p, l, it, smem);
            else if (it < 272) { for (int rep = 0; rep < NREP(8); ++rep) attn_item(p, l, it - 16, smem); }
            else if (it < 528) gdn2_item(p, l, it - 272 + 16, smem);
            else if (it < 784) { for (int rep = 0; rep < NREP(8); ++rep) attn_item(p, l, it - 528 + 256, smem); }
            else if (it < 1296) { for (int rep = 0; rep < NREP(9); ++rep) lru_item<true>(p, l, it - 784, smem); }
            else for (int rep = 0; rep < NREP(8); ++rep) attn_item(p, l, it - 1296 + 512, smem);
          }
        } break;
        case 4: for (int it = B; it < 1024; it += G) gdnfin_item(p, l, it, smem); break;
        case 5: FOR_TILES(128, 8, 8, 8, merge_item(p, l, mt, nt, smem)); break;
        case 6: FOR_TILES(128, 8, 8, 8, wout_item(p, l, mt, nt, smem)); break;
        case 7: for (int it = B; it < 2048; it += G) norm_item<1>(p, l, it); break;
        case 8: FOR_TILES(128, 32, 8, 8, w1_item(p, mt, nt, smem)); break;
        case 9: FOR_TILES(128, 8, 8, 8, w2_item(p, l, mt, nt, smem)); break;
      }
    }
    if (ph + 1 < ph_hi) {
      if (ph == ph_lo) cg::this_grid().sync();
      else for (int rep = 0; rep < NREP(1); ++rep) xcd_barrier((unsigned*)(p->ws + WS_BAR), (volatile LAS unsigned*)&xb_words);
    }
  }
}

extern "C" void kernel_launch(void* const* d_in, const int* in_sizes, int n_in, void* d_out, int out_size, void* d_ws, size_t ws_size, hipStream_t stream) {
  static int grid_blocks = 0;
  if (!grid_blocks) {
    int dev = 0, cus = 0, per_cu = 0;
    (void)hipGetDevice(&dev);
    (void)hipDeviceGetAttribute(&cus, hipDeviceAttributeMultiprocessorCount, dev);
    if (hipFuncSetAttribute((const void*)mk, hipFuncAttributeMaxDynamicSharedMemorySize, DYN_LDS) != hipSuccess) fprintf(stderr, "kernel_launch: hipFuncSetAttribute failed\n");
    (void)hipOccupancyMaxActiveBlocksPerMultiprocessor(&per_cu, mk, 256, DYN_LDS);
    if (per_cu < 1) per_cu = 1;
    if (per_cu > 2) per_cu = 2;
    grid_blocks = cus * per_cu;
    if (ws_size < WS_END) fprintf(stderr, "kernel_launch: workspace too small: %zu < %zu\n", ws_size, (size_t)WS_END);
  }
  if (hipMemsetAsync((char*)d_ws + WS_CTR, 0, 256 + 3456 * 4 + 256, stream) != hipSuccess) fprintf(stderr, "kernel_launch: memset failed\n");
  Params p{};
  for (int i = 0; i < 37; ++i) p.in[i] = (const float*)d_in[i];
  p.out = (float*)d_out; p.ws = (unsigned char*)d_ws;
#if MULTI_LAUNCH
  for (int ph = 0; ph < NPHASE; ++ph) hipLaunchKernelGGL(mk, dim3(grid_blocks), dim3(256), DYN_LDS, stream, p, ph, ph + 1);
#else
  int lo = 0, hi = NPHASE;
  void* args[] = {&p, &lo, &hi};
  hipError_t e = hipLaunchCooperativeKernel((void*)mk, dim3(grid_blocks), dim3(256), args, DYN_LDS, stream);
  if (e != hipSuccess) fprintf(stderr, "cooperative launch failed: %s (grid %d)\n", hipGetErrorString(e), grid_blocks);
#endif
}
```

```cpp
#include <hip/hip_runtime.h>
#include <hip/hip_cooperative_groups.h>
#include <cstdio>
namespace cg = cooperative_groups;

#ifndef MULTI_LAUNCH
#define MULTI_LAUNCH 0
#endif
#ifndef PHM
#define PHM 0xFFFFFFFFu
#endif
#define PHON(b) ((PHM >> (b)) & 1u)
#ifndef DUPM
#define DUPM 0u
#endif
#define NREP(b) (1 + ((DUPM >> (b)) & 1u))

typedef unsigned short u16;
using bf16x8 = __attribute__((ext_vector_type(8))) short;
using f32x4 = __attribute__((ext_vector_type(4))) float;
using u32x4 = __attribute__((ext_vector_type(4))) unsigned;
#define DI __device__ __forceinline__
#define MFMA16(a, b, c) __builtin_amdgcn_mfma_f32_16x16x32_bf16((a), (b), (c), 0, 0, 0)

constexpr int NTOK = 16384;
constexpr int DM = 1024;
constexpr int LDI = 2592;
constexpr int C_AQ = 0, C_AK = 256, C_AV = 384, C_LX = 512, C_LG = 768, C_GQ = 1024, C_GK = 1280, C_GV = 1536, C_GZ = 1792,
              C_DQ = 2048, C_DK = 2304, C_DV = 2432, C_GA = 2560, C_GB = 2568;
constexpr int NIN_PAD = 2688;

constexpr size_t WS_MOD = 0;
constexpr size_t WS_CTR = WS_MOD + 2 * 3 * 6144 * 4;
constexpr size_t WS_BAR = WS_CTR + 256;
constexpr size_t WS_LRUC = WS_BAR + 3456 * 4 + 256;
constexpr size_t WS_KC = WS_LRUC + (size_t)512 * 2 * 2 * 256 * 4;
constexpr size_t WS_GVEC = WS_KC + (size_t)16 * 512 * 64 * 2;
constexpr size_t WS_LRUW = WS_GVEC + (size_t)1024 * 2 * 256 * 4;
constexpr size_t WS_VT = WS_LRUW + (size_t)256 * 64 * 16;
constexpr size_t WS_WIN = WS_VT + (size_t)8 * 64 * 4608 * 2;
constexpr size_t WS_WM = WS_WIN + (size_t)NIN_PAD * 1024 * 2;
constexpr size_t WS_WB = WS_WM + (size_t)4096 * 1024 * 2;
constexpr size_t WS_WO = WS_WB + (size_t)4 * 1024 * 256 * 2;
constexpr size_t WS_W1 = WS_WO + (size_t)1024 * 1024 * 2;
constexpr size_t WS_W2 = WS_W1 + (size_t)4096 * 1024 * 2;
constexpr size_t WS_H = WS_W2 + (size_t)1024 * 4096 * 2;
constexpr size_t WS_BIG = WS_H + (size_t)NTOK * 1024 * 2;
constexpr size_t WS_INPROJ = WS_BIG;
constexpr size_t WS_BRANCH = WS_INPROJ + (size_t)NTOK * LDI * 2;
constexpr size_t WS_QHAT = WS_BRANCH + (size_t)NTOK * 1024 * 2;
constexpr size_t WS_KT = WS_QHAT + (size_t)1024 * 4096 * 2;
constexpr size_t WS_UW = WS_KT + (size_t)1024 * 4096 * 2;
constexpr size_t WS_QK = WS_UW + (size_t)1024 * 2 * 8192 * 2;
constexpr size_t WS_END = WS_QK + (size_t)1024 * 2 * 4096 * 2;
constexpr size_t WS_HIDDEN = WS_BIG;
constexpr size_t WS_MERGED = WS_BIG;
static_assert(WS_HIDDEN + (size_t)NTOK * 4096 * 2 <= WS_END, "hidden must fit");
static_assert(WS_END <= (size_t)256 * 1024 * 1024, "workspace budget");

constexpr size_t O_X = 0, O_AK = 16777216, O_AV = 18874368, O_DK = 20971520, O_DV = 23068672, O_LRU = 25165824, O_GDN = 25198592;

struct Params {
  const float* in[37];
  float* out;
  unsigned char* ws;
};

typedef const Params __attribute__((address_space(4)))* KP;
constexpr int SMEM_BYTES = 65536;
constexpr int DYN_LDS = SMEM_BYTES + 64;

DI int ltid() { int t = threadIdx.x; asm volatile("" : "+v"(t)); return t; }
typedef __bf16 bf16v2 __attribute__((ext_vector_type(2)));
DI u16 f2bf(float x) { __bf16 h = (__bf16)x; return __builtin_bit_cast(u16, h); }
DI float bf2f(u16 h) { return __uint_as_float(((unsigned)h) << 16); }
DI unsigned pack2(float a, float b) { bf16v2 v = {(__bf16)a, (__bf16)b}; return __builtin_bit_cast(unsigned, v); }
DI float bflo(unsigned u) { return __uint_as_float(u << 16); }
DI float bfhi(unsigned u) { return __uint_as_float(u & 0xffff0000u); }
DI float sigm(float x) { return 1.f / (1.f + __expf(-x)); }
DI float siluf_(float x) { return x / (1.f + __expf(-x)); }
DI float softplusf_(float x) { return x > 20.f ? x : log1pf(__expf(x)); }
DI float gelu_tanh(float x) { float u = 0.7978845608028654f * (x + 0.044715f * x * x * x); float t = 1.f - 2.f / (__expf(2.f * u) + 1.f); return 0.5f * x * (1.f + t); }
DI float wave_sum(float v) {
#pragma unroll
  for (int o = 32; o > 0; o >>= 1) v += __shfl_xor(v, o, 64);
  return v;
}
DI u32x4 mku4(unsigned a, unsigned b, unsigned c, unsigned d) { u32x4 v = {a, b, c, d}; return v; }
DI bf16x8 mk8(unsigned a, unsigned b, unsigned c, unsigned d) { u32x4 v = {a, b, c, d}; return __builtin_bit_cast(bf16x8, v); }
DI bf16x8 pack8(const f32x4& x, const f32x4& y) { return mk8(pack2(x[0], x[1]), pack2(x[2], x[3]), pack2(y[0], y[1]), pack2(y[2], y[3])); }
DI bf16x8 ld8(const u16* p) { return *(const bf16x8*)p; }
DI bf16x8 ldperm(const u16* p) { uint2 a = *(const uint2*)p; uint2 b = *(const uint2*)(p + 16); return mk8(a.x, a.y, b.x, b.y); }
DI int mod_group(int row) { return row < 8192 ? 0 : 1 + ((row - 8192) >> 12); }
DI const float* x_in_row(KP p, int l, int row) {
  if (l == 0) return row < 8192 ? p->in[0] + (size_t)row * DM : p->in[1] + (size_t)(row - 8192) * DM;
  return p->out + (size_t)row * DM;
}
DI unsigned swap16(unsigned u) { return (u >> 16) | (u << 16); }
DI u32x4 rev8(u32x4 v) { return mku4(swap16(v.w), swap16(v.z), swap16(v.y), swap16(v.x)); }

DI void mod_item(KP p, int item, unsigned char* smem) {
  float* sc = (float*)smem;
  float* sr = sc + 3072;
  const int tid = ltid();
  const int l = item / 96, cb = item % 96;
  for (int i = tid; i < 3072; i += 256) {
    int g = i >> 10, k = i & 1023;
    float c = g == 0 ? p->in[9][k] : p->in[2][(g - 1) * 1024 + k];
    sc[i] = siluf_(c);
  }
  __syncthreads();
  const int col = cb * 64 + (tid & 63), kg = tid >> 6;
  const float* W = p->in[10] + (size_t)l * 1024 * 6144;
  float a0 = 0.f, a1 = 0.f, a2 = 0.f;
  for (int k = kg * 256; k < kg * 256 + 256; ++k) {
    float w = W[(size_t)k * 6144 + col];
    a0 += sc[k] * w; a1 += sc[1024 + k] * w; a2 += sc[2048 + k] * w;
  }
  sr[(kg * 3 + 0) * 64 + (tid & 63)] = a0; sr[(kg * 3 + 1) * 64 + (tid & 63)] = a1; sr[(kg * 3 + 2) * 64 + (tid & 63)] = a2;
  __syncthreads();
  if (tid < 192) {
    int g = tid >> 6, cc = tid & 63;
    float s = p->in[11][l * 6144 + cb * 64 + cc];
    for (int q = 0; q < 4; ++q) s += sr[(q * 3 + g) * 64 + cc];
    ((float*)(p->ws + WS_MOD))[(l * 3 + g) * 6144 + cb * 64 + cc] = s;
  }
  __syncthreads();
}

DI void conv_tile(const float* src, int N, int k0, int n0, u16* dst, int K, bool perm, unsigned char* smem) {
  float* tile = (float*)smem;
  const int tid = ltid();
#pragma unroll
  for (int i = 0; i < 4; ++i) {
    int kr = (tid >> 4) + 16 * i, nc = (tid & 15) * 4;
    float4 v = make_float4(0.f, 0.f, 0.f, 0.f);
    if (n0 + nc < N) v = *(const float4*)(src + (size_t)(k0 + kr) * N + n0 + nc);
    tile[kr * 65 + nc] = v.x; tile[kr * 65 + nc + 1] = v.y; tile[kr * 65 + nc + 2] = v.z; tile[kr * 65 + nc + 3] = v.w;
  }
  __syncthreads();
#pragma unroll
  for (int i = 0; i < 2; ++i) {
    int n = (tid >> 3) + 32 * i, k8 = (tid & 7) * 8;
    int ng = n0 + n;
    if (ng < N) {
      int row = ng;
      if (perm) row = ng < 2048 ? ng : (ng < 2064 ? 2560 + (ng - 2048) : ng - 16);
      u32x4 o;
      o.x = pack2(tile[(k8 + 0) * 65 + n], tile[(k8 + 1) * 65 + n]);
      o.y = pack2(tile[(k8 + 2) * 65 + n], tile[(k8 + 3) * 65 + n]);
      o.z = pack2(tile[(k8 + 4) * 65 + n], tile[(k8 + 5) * 65 + n]);
      o.w = pack2(tile[(k8 + 6) * 65 + n], tile[(k8 + 7) * 65 + n]);
      *(u32x4*)(dst + (size_t)row * K + k0 + k8) = o;
    }
  }
  __syncthreads();
}

constexpr int CONV_ITEMS = 4241;
DI void convert_item(KP p, int l, int item, unsigned char* smem) {
  unsigned char* ws = p->ws;
  if (item < 656) { int kt = item / 41, nt = item % 41; conv_tile(p->in[14] + (size_t)l * 1024 * 2576, 2576, kt * 64, nt * 64, (u16*)(ws + WS_WIN), 1024, true, smem); return; }
  item -= 656;
  if (item < 1024) { int kt = item >> 6, nt = item & 63; conv_tile(p->in[32] + (size_t)l * 1024 * 4096, 4096, kt * 64, nt * 64, (u16*)(ws + WS_WM), 1024, false, smem); return; }
  item -= 1024;
  if (item < 256) { int m = item >> 6, r = item & 63, kt = r >> 4, nt = r & 15;
    conv_tile(p->in[31] + ((size_t)l * 4 + m) * 256 * 1024, 1024, kt * 64, nt * 64, (u16*)(ws + WS_WB) + (size_t)m * 1024 * 256, 256, false, smem); return; }
  item -= 256;
  if (item < 256) { int kt = item >> 4, nt = item & 15; conv_tile(p->in[34] + (size_t)l * 1024 * 1024, 1024, kt * 64, nt * 64, (u16*)(ws + WS_WO), 1024, false, smem); return; }
  item -= 256;
  if (item < 1024) { int kt = item >> 6, nt = item & 63; conv_tile(p->in[35] + (size_t)l * 1024 * 4096, 4096, kt * 64, nt * 64, (u16*)(ws + WS_W1), 1024, false, smem); return; }
  item -= 1024;
  if (item < 1024) { int kt = item >> 4, nt = item & 15; conv_tile(p->in[36] + (size_t)l * 4096 * 1024, 1024, kt * 64, nt * 64, (u16*)(ws + WS_W2), 4096, false, smem); return; }
  u32x4* z = (u32x4*)((u16*)(ws + WS_WIN) + (size_t)2576 * 1024);
  for (int i = ltid(); i < 112 * 1024 / 8; i += 256) z[i] = mku4(0, 0, 0, 0);
}

DI void lruw_item(KP p, int item) {
  const int gid = item * 256 + ltid();
  const int lane = gid & 63, fg = gid >> 6;
  const int s2 = fg & 1, j = (fg >> 1) & 3, n = (fg >> 3) & 3, g = (fg >> 5) & 1, ld_ = fg >> 6;
  const int lq = lane & 15, quad = lane >> 4;
  const float* W = (g == 0 ? p->in[20] : p->in[22]) + ((size_t)(ld_ * 4 + n) * 64) * 64 + (size_t)(s2 * 32 + quad * 8) * 64 + j * 16 + lq;
  u32x4 o = {pack2(W[0], W[64]), pack2(W[128], W[192]), pack2(W[256], W[320]), pack2(W[384], W[448])};
  ((u32x4*)(p->ws + WS_LRUW))[gid] = o;
}

template <int which>
DI void norm_item(KP p, int l, int item) {
  const int tid = ltid(), lane = tid & 63, wave = tid >> 6;
  const float* g = p->in[which == 0 ? 12 : 13] + l * 1024;
  f32x4 v[2][4]; float ss[2] = {0.f, 0.f};
#pragma unroll
  for (int h = 0; h < 2; ++h) {
    const int row = item * 8 + wave * 2 + h;
    const float* x = x_in_row(p, which == 0 ? l : 2, row);
#pragma unroll
    for (int i = 0; i < 4; ++i) v[h][i] = *(const f32x4*)(x + i * 256 + lane * 4);
  }
#pragma unroll
  for (int h = 0; h < 2; ++h) {
#pragma unroll
    for (int i = 0; i < 4; ++i) ss[h] += v[h][i].x * v[h][i].x + v[h][i].y * v[h][i].y + v[h][i].z * v[h][i].z + v[h][i].w * v[h][i].w;
    ss[h] = wave_sum(ss[h]);
  }
#pragma unroll
  for (int h = 0; h < 2; ++h) {
    const int row = item * 8 + wave * 2 + h;
    const float* mod = (const float*)(p->ws + WS_MOD) + (l * 3 + mod_group(row)) * 6144;
    const float* sh = mod + (which == 0 ? 0 : 3072);
    const float* sc = mod + (which == 0 ? 1024 : 4096);
    const float rstd = rsqrtf(ss[h] * (1.f / 1024.f) + 1e-6f);
    u16* H = (u16*)(p->ws + WS_H) + (size_t)row * 1024;
#pragma unroll
    for (int i = 0; i < 4; ++i) {
      int c = i * 256 + lane * 4;
      float4 gg = *(const float4*)(g + c), s1 = *(const float4*)(sc + c), s0 = *(const float4*)(sh + c);
      float y0 = v[h][i].x * rstd * gg.x * (1.f + s1.x) + s0.x, y1 = v[h][i].y * rstd * gg.y * (1.f + s1.y) + s0.y;
      float y2 = v[h][i].z * rstd * gg.z * (1.f + s1.z) + s0.z, y3 = v[h][i].w * rstd * gg.w * (1.f + s1.w) + s0.w;
      *(uint2*)(H + c) = make_uint2(pack2(y0, y1), pack2(y2, y3));
    }
  }
}

DI int lds_byte(int r, int c) {
  int st = (r >> 4) * 2 + (c >> 5), ob = (r & 15) * 64 + (c & 31) * 2;
  return st * 1024 + (ob ^ (((ob >> 9) & 1) << 5));
}
DI void stage_rc(int b, int& R, int& C) {
  int st = b >> 10, sb = b & 1023, swz = sb ^ (((sb >> 9) & 1) << 5);
  R = (st >> 1) * 16 + (swz >> 6);
  C = (st & 1) * 32 + ((swz & 63) >> 1);
}
template <int MT, int NT, bool pre = false>
DI void gemm_acc(f32x4 (&acc)[MT][NT], const u16* __restrict__ A, int lda, const u16* __restrict__ Bt, int ldb, int K, unsigned char* smem,
                 const u16* nxtA = nullptr, int nlda = 0, const u16* nxtB = nullptr, int nldb = 0) {
  constexpr int TA = MT * 32 * 128, TB = NT * 32 * 128, STAGE = TA + TB;
  static_assert(2 * STAGE <= 65536, "LDS");
  const int tid = ltid(), lane = tid & 63, wid = tid >> 6, wm = wid >> 1, wn = wid & 1;
  const int fr = lane & 15, fq = lane >> 4;
  const u16* ga[MT]; const u16* gb[NT];
#pragma unroll
  for (int i = 0; i < MT; ++i) { int R, C; stage_rc(wid * 1024 + i * 4096 + lane * 16, R, C); ga[i] = A + (size_t)R * lda + C; }
#pragma unroll
  for (int i = 0; i < NT; ++i) { int R, C; stage_rc(wid * 1024 + i * 4096 + lane * 16, R, C); gb[i] = Bt + (size_t)R * ldb + C; }
#define GLDS_STAGE(buf, k0)                                                                                                        \
  do {                                                                                                                             \
    _Pragma("unroll") for (int i = 0; i < MT; ++i)                                                                                 \
      __builtin_amdgcn_global_load_lds((const unsigned*)(ga[i] + (k0)), (unsigned*)(smem + (buf) * STAGE + wid * 1024 + i * 4096), 16, 0, 0); \
    _Pragma("unroll") for (int i = 0; i < NT; ++i)                                                                                 \
      __builtin_amdgcn_global_load_lds((const unsigned*)(gb[i] + (k0)), (unsigned*)(smem + (buf) * STAGE + TA + wid * 1024 + i * 4096), 16, 0, 0); \
  } while (0)
  if (!pre) {
    __syncthreads();
    GLDS_STAGE(0, 0);
  }
  asm volatile("s_waitcnt vmcnt(0)" ::: "memory");
  __syncthreads();
  const int nt = K >> 6;
  for (int t = 0; t < nt; ++t) {
    const int cur = t & 1;
    if (t + 1 < nt) GLDS_STAGE(cur ^ 1, (t + 1) * 64);
    const unsigned char* sA = smem + cur * STAGE;
    const unsigned char* sB = sA + TA;
#pragma unroll
    for (int s = 0; s < 2; ++s) {
      bf16x8 bfr[NT];
#pragma unroll
      for (int j = 0; j < NT; ++j) bfr[j] = *(const bf16x8*)(sB + lds_byte(wn * NT * 16 + j * 16 + fr, s * 32 + fq * 8));
#pragma unroll
      for (int i = 0; i < MT; ++i) {
        bf16x8 af = *(const bf16x8*)(sA + lds_byte(wm * MT * 16 + i * 16 + fr, s * 32 + fq * 8));
#pragma unroll
        for (int j = 0; j < NT; ++j) acc[i][j] = MFMA16(af, bfr[j], acc[i][j]);
      }
    }
    asm volatile("s_waitcnt vmcnt(0)" ::: "memory");
    __syncthreads();
  }
  if (nxtA) {
#pragma unroll
    for (int i = 0; i < MT; ++i) { int R, C; stage_rc(wid * 1024 + i * 4096 + lane * 16, R, C);
      __builtin_amdgcn_global_load_lds((const unsigned*)(nxtA + (unsigned)(R * nlda + C)), (unsigned*)(smem + wid * 1024 + i * 4096), 16, 0, 0); }
#pragma unroll
    for (int i = 0; i < NT; ++i) { int R, C; stage_rc(wid * 1024 + i * 4096 + lane * 16, R, C);
      __builtin_amdgcn_global_load_lds((const unsigned*)(nxtB + (unsigned)(R * nldb + C)), (unsigned*)(smem + TA + wid * 1024 + i * 4096), 16, 0, 0); }
  }
#undef GLDS_STAGE
}

template <int MT, int NT>
DI void gemm_prefetch(const u16* A, int lda, const u16* Bt, int ldb, unsigned char* smem) {
  constexpr int TA = MT * 32 * 128;
  const int tid = ltid(), lane = tid & 63, wid = tid >> 6;
  __syncthreads();
#pragma unroll
  for (int i = 0; i < MT; ++i) { int R, C; stage_rc(wid * 1024 + i * 4096 + lane * 16, R, C);
    __builtin_amdgcn_global_load_lds((const unsigned*)(A + (unsigned)(R * lda + C)), (unsigned*)(smem + wid * 1024 + i * 4096), 16, 0, 0); }
#pragma unroll
  for (int i = 0; i < NT; ++i) { int R, C; stage_rc(wid * 1024 + i * 4096 + lane * 16, R, C);
    __builtin_amdgcn_global_load_lds((const unsigned*)(Bt + (unsigned)(R * ldb + C)), (unsigned*)(smem + TA + wid * 1024 + i * 4096), 16, 0, 0); }
}

template <int MT, int NT> DI void zero_acc(f32x4 (&acc)[MT][NT]) {
#pragma unroll
  for (int i = 0; i < MT; ++i)
#pragma unroll
    for (int j = 0; j < NT; ++j) acc[i][j] = f32x4{0.f, 0.f, 0.f, 0.f};
}

#define EPI_LOOP(MT, NT)                                                          \
  const int tid_ = ltid(), lane_ = tid_ & 63, wave_ = tid_ >> 6;                   \
  const int wm_ = wave_ >> 1, wn_ = wave_ & 1, lq_ = lane_ & 15, quad_ = lane_ >> 4; \
  _Pragma("unroll") for (int i = 0; i < MT; ++i)                                   \
  _Pragma("unroll") for (int j = 0; j < NT; ++j)                                   \
  _Pragma("unroll") for (int r = 0; r < 4; ++r)
#define EPI_ROW(m0, MT) ((m0) + wm_ * (MT) * 16 + i * 16 + quad_ * 4 + r)
#define EPI_COL(n0, NT) ((n0) + wn_ * (NT) * 16 + j * 16 + lq_)

constexpr int GMT = 4;
DI void inproj_item(KP p, int mt, int nt, unsigned char* smem) {
  const int m0 = mt * (GMT * 32), n0 = nt * 128;
  f32x4 acc[GMT][4]; zero_acc<GMT, 4>(acc);
  gemm_acc<GMT, 4>(acc, (const u16*)(p->ws + WS_H) + (size_t)m0 * 1024, 1024, (const u16*)(p->ws + WS_WIN) + (size_t)n0 * 1024, 1024, 1024, smem);
  u16* C = (u16*)(p->ws + WS_INPROJ);
  EPI_LOOP(GMT, 4) { int row = EPI_ROW(m0, GMT), col = EPI_COL(n0, 4); if (col < LDI) C[(size_t)row * LDI + col] = f2bf(acc[i][j][r]); }
}

DI void merge_item(KP p, int l, int mt, int nt, unsigned char* smem) {
  const int m0 = mt * 128, n0 = nt * 128;
  const u16* H = (const u16*)(p->ws + WS_H) + (size_t)m0 * 1024;
  const u16* BR = (const u16*)(p->ws + WS_BRANCH) + (size_t)m0 * 1024;
  const float* bm = p->in[33] + l * 4096;
  const u16* WM = (const u16*)(p->ws + WS_WM) + (size_t)n0 * 1024;
  const u16* WB = (const u16*)(p->ws + WS_WB) + (size_t)n0 * 256;
  unsigned am[4][4][2];
#pragma unroll
  for (int i = 0; i < 4; ++i)
#pragma unroll
    for (int j = 0; j < 4; ++j) { am[i][j][0] = 0u; am[i][j][1] = 0u; }
  gemm_prefetch<4, 4>(BR, 1024, WB, 256, smem);
#pragma unroll 1
  for (int m = 0; m < 4; ++m) {
    f32x4 acc[4][4]; zero_acc<4, 4>(acc);
    gemm_acc<4, 4, true>(acc, BR + m * 256, 1024, WB + (size_t)m * 1024 * 256, 256, 256, smem, H, 1024, WM + (size_t)m * 1024 * 1024, 1024);
    unsigned pp[4][4][2];
#pragma unroll
    for (int i = 0; i < 4; ++i)
#pragma unroll
      for (int j = 0; j < 4; ++j) { pp[i][j][0] = pack2(acc[i][j][0], acc[i][j][1]); pp[i][j][1] = pack2(acc[i][j][2], acc[i][j][3]); }
    zero_acc<4, 4>(acc);
    gemm_acc<4, 4, true>(acc, H, 1024, WM + (size_t)m * 1024 * 1024, 1024, 1024, smem,
                         m < 3 ? BR + (m + 1) * 256 : nullptr, 1024, WB + (size_t)(m + 1) * 1024 * 256, 256);
    {
      const int tid_ = ltid(), wn_ = (tid_ >> 6) & 1, lq_ = tid_ & 15;
      float bias4[4];
#pragma unroll
      for (int j = 0; j < 4; ++j) bias4[j] = bm[m * 1024 + n0 + wn_ * 64 + j * 16 + lq_];
#pragma unroll
      for (int i = 0; i < 4; ++i) {
#pragma unroll
        for (int j = 0; j < 4; ++j) {
          float v0 = bflo(am[i][j][0]) + sigm(acc[i][j][0] + bias4[j]) * bflo(pp[i][j][0]);
          float v1 = bfhi(am[i][j][0]) + sigm(acc[i][j][1] + bias4[j]) * bfhi(pp[i][j][0]);
          float v2 = bflo(am[i][j][1]) + sigm(acc[i][j][2] + bias4[j]) * bflo(pp[i][j][1]);
          float v3 = bfhi(am[i][j][1]) + sigm(acc[i][j][3] + bias4[j]) * bfhi(pp[i][j][1]);
          am[i][j][0] = pack2(v0, v1); am[i][j][1] = pack2(v2, v3);
          asm volatile("" : "+v"(am[i][j][0]), "+v"(am[i][j][1]));
          __builtin_amdgcn_sched_barrier(0);
        }
      }
    }
  }
  u16* C = (u16*)(p->ws + WS_MERGED);
  EPI_LOOP(4, 4) { int row = EPI_ROW(m0, 4), col = EPI_COL(n0, 4); const unsigned w = am[i][j][r >> 1]; C[(size_t)row * 1024 + col] = (u16)((r & 1) ? (w >> 16) : (w & 0xffffu)); }
}

DI void wout_item(KP p, int l, int mt, int nt, unsigned char* smem) {
  const int m0 = mt * (GMT * 32), n0 = nt * 128;
  f32x4 acc[GMT][4]; zero_acc<GMT, 4>(acc);
  gemm_acc<GMT, 4>(acc, (const u16*)(p->ws + WS_MERGED) + (size_t)m0 * 1024, 1024, (const u16*)(p->ws + WS_WO) + (size_t)n0 * 1024, 1024, 1024, smem);
  const float* g1 = (const float*)(p->ws + WS_MOD) + (l * 3 + mod_group(m0)) * 6144 + 2048;
  EPI_LOOP(GMT, 4) { int row = EPI_ROW(m0, GMT), col = EPI_COL(n0, 4); p->out[(size_t)row * DM + col] = x_in_row(p, l, row)[col] + g1[col] * acc[i][j][r]; }
}

DI void w1_item(KP p, int mt, int nt, unsigned char* smem) {
  const int m0 = mt * (GMT * 32), n0 = nt * 128;
  f32x4 acc[GMT][4]; zero_acc<GMT, 4>(acc);
  gemm_acc<GMT, 4>(acc, (const u16*)(p->ws + WS_H) + (size_t)m0 * 1024, 1024, (const u16*)(p->ws + WS_W1) + (size_t)n0 * 1024, 1024, 1024, smem);
  u16* C = (u16*)(p->ws + WS_HIDDEN);
  EPI_LOOP(GMT, 4) { int row = EPI_ROW(m0, GMT), col = EPI_COL(n0, 4); float v = fmaxf(acc[i][j][r], 0.f); C[(size_t)row * 4096 + col] = f2bf(v * v); }
}

DI void w2_item(KP p, int l, int mt, int nt, unsigned char* smem) {
  const int m0 = mt * (GMT * 32), n0 = nt * 128;
  f32x4 acc[GMT][4]; zero_acc<GMT, 4>(acc);
  gemm_acc<GMT, 4>(acc, (const u16*)(p->ws + WS_HIDDEN) + (size_t)m0 * 4096, 4096, (const u16*)(p->ws + WS_W2) + (size_t)n0 * 4096, 4096, 4096, smem);
  const float* g2 = (const float*)(p->ws + WS_MOD) + (l * 3 + mod_group(m0)) * 6144 + 5120;
  EPI_LOOP(GMT, 4) { int row = EPI_ROW(m0, GMT), col = EPI_COL(n0, 4); float* o = p->out + (size_t)row * DM + col; *o = *o + g2[col] * acc[i][j][r]; }
}

DI void prep_load(const u16* R, int lane, float (&hv)[12], float (&vv4)[4]) {
#pragma unroll
  for (int hh = 0; hh < 12; ++hh) {
    const int col = hh < 4 ? C_AQ + hh * 64 : (hh < 6 ? C_AK + (hh - 4) * 64 : (hh < 10 ? C_DQ + (hh - 6) * 64 : C_DK + (hh - 10) * 64));
    hv[hh] = bf2f(R[col + lane]);
  }
  vv4[0] = bf2f(R[C_AV + lane]); vv4[1] = bf2f(R[C_AV + 64 + lane]); vv4[2] = bf2f(R[C_DV + lane]); vv4[3] = bf2f(R[C_DV + 64 + lane]);
}
DI void prep_token(KP p, int l, int row, int lane, u16* R, const float (&hv)[12], const float (&vv4)[4]) {
  const bool lat = row >= 8192;
  float cs = 1.f, sn = 0.f;
  if (lat) {
    int t = (row - 8192) & 4095;
    int pos = (lane < 32) ? (t >> 6) : (t & 63);
    float inv = __expf(-(float)(lane & 15) * (9.210340371976184f / 16.f));
    float ang = (float)pos * inv;
    cs = __cosf(ang); sn = __sinf(ang);
  }
  const int b = row >> 8, t = row & 255;
#pragma unroll
  for (int hh = 0; hh < 12; ++hh) {
    int col; const float* g;
    if (hh < 4) { col = C_AQ + hh * 64; g = p->in[15] + l * 64; }
    else if (hh < 6) { col = C_AK + (hh - 4) * 64; g = p->in[16] + l * 64; }
    else if (hh < 10) { col = C_DQ + (hh - 6) * 64; g = p->in[29] + l * 64; }
    else { col = C_DK + (hh - 10) * 64; g = p->in[30] + l * 64; }
    float v = hv[hh];
    float ss = wave_sum(v * v);
    float y = v * rsqrtf(ss * (1.f / 64.f) + 1e-6f) * g[lane];
    if (lat) {
      float yp = __shfl_xor(y, 16, 64);
      y = ((lane & 31) < 16) ? (y * cs - yp * sn) : (y * cs + yp * sn);
    } else {
      if (hh == 4 || hh == 5) p->out[O_AK + ((size_t)(b * 2 + l) * 256 + t) * 128 + (hh - 4) * 64 + lane] = y;
      if (hh >= 10) p->out[O_DK + ((size_t)(b * 2 + l) * 256 + t) * 128 + (hh - 10) * 64 + lane] = y;
    }
    R[col + lane] = f2bf(y);
  }
  if (lat) {
    const int bl = (row - 8192) >> 12, tl = (row - 8192) & 4095;
    u16* VT = (u16*)(p->ws + WS_VT) + (size_t)lane * 4608 + 512 + tl;
#pragma unroll
    for (int q = 0; q < 4; ++q)
      VT[(size_t)(((q >> 1) * 2 + bl) * 2 + (q & 1)) * 64 * 4608] = f2bf(vv4[q]);
  }
  if (!lat) {
    size_t o = ((size_t)(b * 2 + l) * 256 + t) * 128;
    p->out[O_AV + o + lane] = vv4[0]; p->out[O_AV + o + 64 + lane] = vv4[1];
    p->out[O_DV + o + lane] = vv4[2]; p->out[O_DV + o + 64 + lane] = vv4[3];
  }
}
DI void prep_item(KP p, int l, int item) {
  const int tid = ltid(), lane = tid & 63, wave = tid >> 6;
  const int row0 = item * 8 + wave * 2;
  u16* R0 = (u16*)(p->ws + WS_INPROJ) + (size_t)row0 * LDI;
  u16* R1 = R0 + LDI;
  float hv0[12], vv0[4], hv1[12], vv1[4];
  prep_load(R0, lane, hv0, vv0); prep_load(R1, lane, hv1, vv1);
  prep_token(p, l, row0, lane, R0, hv0, vv0);
  prep_token(p, l, row0 + 1, lane, R1, hv1, vv1);
}

DI void kvc_item(KP p, int l, int item) {
  u16* KC = (u16*)(p->ws + WS_KC);
#pragma unroll
  for (int it = 0; it < 8; ++it) {
    int idx4 = item * 2048 + it * 256 + ltid();
    int e = idx4 * 4;
    int d = e & 63, key = (e >> 6) & 511, sel = e >> 15;
    int kv = sel & 1, kvh = (sel >> 1) & 1, b = (sel >> 2) & 1, mixer = sel >> 3;
    const float* srcb = mixer ? (kv ? p->in[6] : p->in[5]) : (kv ? p->in[4] : p->in[3]);
    const float* src = srcb + ((size_t)((b * 2 + l) * 512 + key) * 2 + kvh) * 64 + d;
    float4 v = *(const float4*)src;
    *(uint2*)(KC + e) = make_uint2(pack2(v.x, v.y), pack2(v.z, v.w));
    if (kv) {
      u16* VT = (u16*)(p->ws + WS_VT) + ((size_t)((mixer * 2 + b) * 2 + kvh) * 64 + d) * 4608 + key;
      VT[0] = f2bf(v.x); VT[4608] = f2bf(v.y); VT[2 * 4608] = f2bf(v.z); VT[3 * 4608] = f2bf(v.w);
    }
  }
}

DI void attn_item(KP p, int l, int it, unsigned char* smem) {
  u16* sK = (u16*)smem;
  u16* sVt = sK + 64 * 72;
  const int tid = ltid(), lane = tid & 63, wave = tid >> 6, lq = lane & 15, quad = lane >> 4;
  int kind, b, qh, qb;
  if (it < 512) { kind = it >> 8; int r = it & 255; b = r >> 7; qh = (r >> 5) & 3; qb = r & 31; }
  else { int r = it - 512; kind = 2 + (r >> 8); r &= 255; b = r >> 3; qh = (r >> 1) & 3; qb = r & 1; }
  const bool isD = (kind == 0 || kind == 3), lat = kind < 2;
  const int seqrow0 = lat ? 8192 + b * 4096 : b * 256;
  const int q0 = qb * 128, kvh = qh >> 1;
  const int qcol = (isD ? C_DQ : C_AQ) + qh * 64, kcol = (isD ? C_DK : C_AK) + kvh * 64, vcol = (isD ? C_DV : C_AV) + kvh * 64;
  const int ocol = (isD ? 768 : 0) + qh * 64;
  const int ncache = lat ? 8 : 0;
  int kt_lo = 0, kt_hi = lat ? 64 : 4;
  if (kind == 1) { kt_lo = max(0, 2 * qb - 2); kt_hi = min(64, 2 * qb + 4); }
  const int ntiles = ncache + kt_hi - kt_lo;
  const bool band = (kind == 1);
  const u16* INP = (const u16*)(p->ws + WS_INPROJ);
  const u16* KCk = (const u16*)(p->ws + WS_KC) + (size_t)((((isD ? 1 : 0) * 2 + b) * 2 + kvh) * 2) * 512 * 64;
  const u16* KCv = KCk + 512 * 64;
  constexpr float SC2 = 0.125f * 1.4426950408889634f;
  const float sinkv = isD ? -1e30f : p->in[17][l * 4 + qh] * 1.4426950408889634f;

  bf16x8 qf[2][2];
#pragma unroll
  for (int nt = 0; nt < 2; ++nt)
#pragma unroll
    for (int s = 0; s < 2; ++s) qf[nt][s] = ld8(INP + (size_t)(seqrow0 + q0 + wave * 32 + nt * 16 + lq) * LDI + qcol + s * 32 + quad * 8);
  float mrun[2], lsum[2];
  f32x4 oacc[4][2];
#pragma unroll
  for (int nt = 0; nt < 2; ++nt) { mrun[nt] = sinkv; lsum[nt] = (!isD && quad == 0) ? 1.f : 0.f; }
#pragma unroll
  for (int dt = 0; dt < 4; ++dt)
#pragma unroll
    for (int nt = 0; nt < 2; ++nt) oacc[dt][nt] = f32x4{0.f, 0.f, 0.f, 0.f};

  const int key = tid >> 2, seg = (tid & 3) * 16;
  struct KVReg { u32x4 k[2], v[2]; };
  KVReg R0, R1;
  const u16* VTp = (const u16*)(p->ws + WS_VT) + ((size_t)(((isD ? 1 : 0) * 2 + b) * 2 + kvh) * 64 + key) * 4608 + seg;
  auto tile_ptrs = [&](int t, const u16*& kp, const u16*& vp) {
    if (t < ncache) { kp = KCk + (size_t)(t * 64 + key) * 64 + seg; vp = VTp + t * 64; }
    else {
      const u16* rowp = INP + (size_t)(seqrow0 + (kt_lo + t - ncache) * 64 + key) * LDI; kp = rowp + kcol + seg;
      vp = lat ? VTp + 512 + (kt_lo + t - ncache) * 64 : rowp + vcol + seg;
    }
  };
  auto kvload = [&](int t, KVReg& R) {
    const u16 *kp, *vp; tile_ptrs(t, kp, vp);
    R.k[0] = *(const u32x4*)kp; R.k[1] = *(const u32x4*)(kp + 8); R.v[0] = *(const u32x4*)vp; R.v[1] = *(const u32x4*)(vp + 8);
  };
  kvload(0, R0);
  if (ntiles > 1) kvload(1, R1);
  auto step = [&](int t, KVReg& R) {
    __syncthreads();
    *(u32x4*)(sK + key * 72 + seg) = R.k[0]; *(u32x4*)(sK + key * 72 + seg + 8) = R.k[1];
    if (lat) {
      *(u32x4*)(sVt + key * 72 + seg) = R.v[0]; *(u32x4*)(sVt + key * 72 + seg + 8) = R.v[1];
    } else {
      unsigned vv[8] = {R.v[0].x, R.v[0].y, R.v[0].z, R.v[0].w, R.v[1].x, R.v[1].y, R.v[1].z, R.v[1].w};
#pragma unroll
      for (int e = 0; e < 8; ++e) { sVt[(seg + 2 * e) * 72 + key] = (u16)(vv[e] & 0xffffu); sVt[(seg + 2 * e + 1) * 72 + key] = (u16)(vv[e] >> 16); }
    }
    __syncthreads();
    if (t + 2 < ntiles) kvload(t + 2, R);
    f32x4 sacc[4][2];
#pragma unroll
    for (int mt = 0; mt < 4; ++mt) {
      sacc[mt][0] = f32x4{0.f, 0.f, 0.f, 0.f}; sacc[mt][1] = f32x4{0.f, 0.f, 0.f, 0.f};
#pragma unroll
      for (int s = 0; s < 2; ++s) {
        bf16x8 ka = ld8(sK + (mt * 16 + lq) * 72 + s * 32 + quad * 8);
        sacc[mt][0] = MFMA16(ka, qf[0][s], sacc[mt][0]);
        sacc[mt][1] = MFMA16(ka, qf[1][s], sacc[mt][1]);
      }
    }
    const bool masked_tile = band && t >= ncache;
    const int kbase = (kt_lo + t - ncache) * 64;
    bf16x8 pf[2][2];
#pragma unroll
    for (int nt = 0; nt < 2; ++nt) {
      const int qi = q0 + wave * 32 + nt * 16 + lq;
      float tmax = -1e30f;
#pragma unroll
      for (int mt = 0; mt < 4; ++mt)
#pragma unroll
        for (int r = 0; r < 4; ++r) {
          float sv_ = sacc[mt][nt][r] * SC2;
          if (masked_tile) { int kj = kbase + mt * 16 + quad * 4 + r; int dlt = qi - kj; if (dlt > 128 || dlt < -128) sv_ = -1e30f; }
          sacc[mt][nt][r] = sv_; tmax = fmaxf(tmax, sv_);
        }
      tmax = fmaxf(tmax, __shfl_xor(tmax, 16, 64)); tmax = fmaxf(tmax, __shfl_xor(tmax, 32, 64));
      const float mold = mrun[nt];
      const float mnew = fmaxf(mold, tmax);
      float ps = 0.f;
#pragma unroll
      for (int mt = 0; mt < 4; ++mt)
#pragma unroll
        for (int r = 0; r < 4; ++r) { float e = __builtin_amdgcn_exp2f(sacc[mt][nt][r] - mnew); sacc[mt][nt][r] = e; ps += e; }
      if (__any(mnew != mold)) {
        const float alpha = __builtin_amdgcn_exp2f(mold - mnew);
        lsum[nt] *= alpha;
#pragma unroll
        for (int dt = 0; dt < 4; ++dt)
#pragma unroll
          for (int r = 0; r < 4; ++r) oacc[dt][nt][r] *= alpha;
      }
      lsum[nt] += ps; mrun[nt] = mnew;
      pf[nt][0] = pack8(sacc[0][nt], sacc[1][nt]);
      pf[nt][1] = pack8(sacc[2][nt], sacc[3][nt]);
    }
#pragma unroll
    for (int dt = 0; dt < 4; ++dt)
#pragma unroll
      for (int s2 = 0; s2 < 2; ++s2) {
        bf16x8 va = ldperm(sVt + (dt * 16 + lq) * 72 + s2 * 32 + quad * 4);
        oacc[dt][0] = MFMA16(va, pf[0][s2], oacc[dt][0]);
        oacc[dt][1] = MFMA16(va, pf[1][s2], oacc[dt][1]);
      }
  };
  for (int t = 0; t < ntiles; t += 2) { step(t, R0); if (t + 1 < ntiles) step(t + 1, R1); }
  u16* BR = (u16*)(p->ws + WS_BRANCH);
#pragma unroll
  for (int nt = 0; nt < 2; ++nt) {
    float lt = lsum[nt]; lt += __shfl_xor(lt, 16, 64); lt += __shfl_xor(lt, 32, 64);
    const float inv = 1.f / lt;
    const size_t row = seqrow0 + q0 + wave * 32 + nt * 16 + lq;
#pragma unroll
    for (int dt = 0; dt < 4; ++dt)
      *(uint2*)(BR + row * 1024 + ocol + dt * 16 + quad * 4) = make_uint2(pack2(oacc[dt][nt][0] * inv, oacc[dt][nt][1] * inv), pack2(oacc[dt][nt][2] * inv, oacc[dt][nt][3] * inv));
  }
  __syncthreads();
}

DI int lru_xoff(int t, int c) { return t * 256 + (c ^ ((t & 7) << 3)); }
template <bool FINAL>
DI void lru_item(KP p, int l, int ci, unsigned char* smem) {
  u16* sxb = (u16*)smem;
  u16* sla = sxb + 32 * 256;
  u16* sbv = sla + 32 * 256;
  u16* shf = sbv + 32 * 256;
  const int tid = ltid(), ch = tid, lane = tid & 63, n = tid >> 6, lq = lane & 15, quad = lane >> 4;
  const int r0 = ci * 32;
  const bool lat = r0 >= 8192;
  int b, T, seqrow0;
  if (!lat) { b = r0 >> 8; T = 256; seqrow0 = b * 256; } else { b = (r0 - 8192) >> 12; T = 4096; seqrow0 = 8192 + b * 4096; }
  const int t0 = r0 - seqrow0;
  const u16* INP = (const u16*)(p->ws + WS_INPROJ);
  __syncthreads();
  {
    const float* cw = p->in[18] + l * 4 * 256;
    const float w0 = cw[ch], w1 = cw[256 + ch], w2 = cw[512 + ch], w3 = cw[768 + ch], cb = p->in[19][l * 256 + ch];
    auto ld = [&](int t) -> float { return (t >= 0 && t < T) ? bf2f(INP[(size_t)(seqrow0 + t) * LDI + C_LX + ch]) : 0.f; };
    float xin[35];
#pragma unroll
    for (int q = 0; q < 35; ++q) xin[q] = ld(t0 - 2 + q);
#pragma unroll
    for (int t = 0; t < 32; ++t) sxb[lru_xoff(t, ch)] = f2bf(xin[t] * w0 + xin[t + 1] * w1 + xin[t + 2] * w2 + xin[t + 3] * w3 + cb);
  }
  __syncthreads();
  const int nch = T / 32, c = t0 / 32;
  float* LC = (float*)(p->ws + WS_LRUC);
  bf16x8 af[2][2];
#pragma unroll
  for (int mt = 0; mt < 2; ++mt)
#pragma unroll
    for (int s2 = 0; s2 < 2; ++s2) af[mt][s2] = ld8(sxb + lru_xoff(mt * 16 + lq, n * 64 + s2 * 32 + quad * 8));
  for (int dir = 0; dir < 2; ++dir) {
    bf16x8 wf[2][4][2];
    {
      const u32x4* WF = (const u32x4*)(p->ws + WS_LRUW);
#pragma unroll
      for (int g = 0; g < 2; ++g)
#pragma unroll
        for (int j = 0; j < 4; ++j)
#pragma unroll
          for (int s2 = 0; s2 < 2; ++s2)
            wf[g][j][s2] = __builtin_bit_cast(bf16x8, WF[(size_t)((((((l * 2 + dir) * 2 + g) * 4 + n) * 4 + j) * 2 + s2)) * 64 + lane]);
    }
#pragma unroll
    for (int j = 0; j < 4; ++j) {
      f32x4 acc[2][2];
#pragma unroll
      for (int g = 0; g < 2; ++g) {
        f32x4 a0 = {0.f, 0.f, 0.f, 0.f}, a1 = {0.f, 0.f, 0.f, 0.f};
#pragma unroll
        for (int s2 = 0; s2 < 2; ++s2) { a0 = MFMA16(af[0][s2], wf[g][j][s2], a0); a1 = MFMA16(af[1][s2], wf[g][j][s2], a1); }
        acc[g][0] = a0; acc[g][1] = a1;
      }
      const int cc = n * 64 + j * 16 + lq;
      const float br = p->in[21][(l * 2 + dir) * 256 + cc], bi = p->in[23][(l * 2 + dir) * 256 + cc];
      const float sp = softplusf_(-p->in[24][(l * 2 + dir) * 256 + cc]);
#pragma unroll
      for (int mt = 0; mt < 2; ++mt)
#pragma unroll
        for (int r = 0; r < 4; ++r) {
          const int t = mt * 16 + quad * 4 + r;
          const float la = -8.f * sigm(acc[0][mt][r] + br) * sp;
          const float xt = bf2f(sxb[lru_xoff(t, cc)]);
          const float bb = sqrtf(-expm1f(2.f * la)) * sigm(acc[1][mt][r] + bi) * xt;
          sla[t * 256 + cc] = f2bf(la); sbv[t * 256 + cc] = f2bf(bb);
        }
    }
    __syncthreads();
    float h = 0.f, lasum = 0.f;
    if (FINAL) {
      h = lat ? p->in[7][((b * 2 + l) * 2 + dir) * 256 + ch] : 0.f;
      const int ncar = dir == 0 ? c : nch - 1 - c;
      const int cstart = dir == 0 ? ci - c : ci - c + nch - 1, cstep = dir == 0 ? 1 : -1;
      for (int q0 = 0; q0 < ncar; q0 += 16) {
        float ca[16], chh[16];
#pragma unroll
        for (int q = 0; q < 16; ++q) {
          const int qq = q0 + q < ncar ? q0 + q : ncar - 1;
          const float* C = LC + ((size_t)((cstart + cstep * qq) * 2 + dir) * 2) * 256;
          ca[q] = C[ch]; chh[q] = C[256 + ch];
        }
#pragma unroll
        for (int q = 0; q < 16; ++q) if (q0 + q < ncar) h = ca[q] * h + chh[q];
      }
    }
#pragma unroll 1
    for (int s8 = 0; s8 < 32; s8 += 16) {
      float gv[16];
      if (FINAL && dir == 1) {
#pragma unroll
        for (int q = 0; q < 16; ++q) gv[q] = bf2f(INP[(size_t)(r0 + 31 - s8 - q) * LDI + C_LG + ch]);
      }
#pragma unroll
      for (int q = 0; q < 16; ++q) {
        const int st = s8 + q;
        const int t = dir == 0 ? st : 31 - st;
        const float la = bf2f(sla[t * 256 + ch]);
        h = __expf(la) * h + bf2f(sbv[t * 256 + ch]);
        lasum += la;
        if (FINAL) {
          if (dir == 0) shf[t * 256 + ch] = f2bf(h);
          else ((u16*)(p->ws + WS_BRANCH))[(size_t)(r0 + t) * 1024 + 256 + ch] = f2bf((bf2f(shf[t * 256 + ch]) + h) * gelu_tanh(gv[q]));
        }
      }
    }
    if (!FINAL) { float* C = LC + ((size_t)(ci * 2 + dir) * 2) * 256; C[ch] = __expf(lasum); C[256 + ch] = h; }
    else if (!lat) {
      if (dir == 0 && c == nch - 1) p->out[O_LRU + ((size_t)(b * 2 + l) * 2 + 0) * 256 + ch] = h;
      if (dir == 1 && c == 0) p->out[O_LRU + ((size_t)(b * 2 + l) * 2 + 1) * 256 + ch] = h;
    }
    __syncthreads();
  }
}

template <int DIR, bool ISW>
DI void gdn_solve(const float* L, const u16* src, const float* sb_, const float* se_, u16* UW) {
  float sol[64];
#pragma unroll
  for (int i = 0; i < 64; ++i) {
    float s = bf2f(src[(DIR == 0 ? i : 63 - i) * 72]) * sb_[i];
    if (ISW) s *= se_[i];
    float s0 = 0.f, s1 = 0.f, s2 = 0.f, s3 = 0.f;
#pragma unroll
    for (int j4 = 0; j4 < (i + 3) / 4; ++j4) {
      float4 lv = *(const float4*)(L + i * 64 + j4 * 4);
      if (j4 * 4 + 0 < i) s0 += lv.x * sol[j4 * 4 + 0];
      if (j4 * 4 + 1 < i) s1 += lv.y * sol[j4 * 4 + 1];
      if (j4 * 4 + 2 < i) s2 += lv.z * sol[j4 * 4 + 2];
      if (j4 * 4 + 3 < i) s3 += lv.w * sol[j4 * 4 + 3];
      if ((j4 & 3) == 3) asm volatile("" ::: "memory");
    }
    s -= (s0 + s1) + (s2 + s3);
    sol[i] = s;
    UW[i * 128] = f2bf(s);
    asm volatile("" ::: "memory");
  }
}

DI void gdn1_item(KP p, int l, int item, unsigned char* smem) {
  const int cgi = item >> 2, hd = item & 3;
  u16* sq = (u16*)smem; u16* sk = sq + 64 * 72; u16* sv = sk + 64 * 72;
  float* sL = (float*)(smem + 27648);
  float* sgc = (float*)(smem + 60416);
  float* sbeta = sgc + 128;
  float* sge = sbeta + 128;
  const int tid = ltid(), lane = tid & 63, wave = tid >> 6, lq = lane & 15, quad = lane >> 4;
  const int r0 = cgi * 64;
  const bool lat = r0 >= 8192;
  int T, seqrow0;
  if (!lat) { T = 256; seqrow0 = (r0 >> 8) * 256; } else { T = 4096; seqrow0 = 8192 + ((r0 - 8192) >> 12) * 4096; }
  const int t0 = r0 - seqrow0;
  const u16* INP = (const u16*)(p->ws + WS_INPROJ);
  u16* QHAT = (u16*)(p->ws + WS_QHAT) + (size_t)item * 4096;
  {
    const int d = lane, tb = wave * 16;
#pragma unroll
    for (int mat = 0; mat < 3; ++mat) {
      const int col = C_GQ + mat * 256 + hd * 64 + d, wc = mat * 256 + hd * 64 + d;
      const float* cw = p->in[25] + (size_t)l * 4 * 768;
      const float w0 = cw[wc], w1 = cw[768 + wc], w2 = cw[1536 + wc], w3 = cw[2304 + wc];
      auto ld = [&](int t) -> float { return (t >= 0 && t < T) ? bf2f(INP[(size_t)(seqrow0 + t) * LDI + col]) : 0.f; };
      float xin[19];
#pragma unroll
      for (int q = 0; q < 19; ++q) xin[q] = ld(t0 + tb - 2 + q);
      u16* dst = mat == 0 ? sq : (mat == 1 ? sk : sv);
#pragma unroll
      for (int tt = 0; tt < 16; ++tt) {
        const int t = tb + tt;
        float v = siluf_(xin[tt] * w0 + xin[tt + 1] * w1 + xin[tt + 2] * w2 + xin[tt + 3] * w3);
        if (mat < 2) { float ss = wave_sum(v * v); v *= rsqrtf(ss + 1e-6f) * (mat == 0 ? 0.125f : 1.f); }
        u16 hb = f2bf(v);
        dst[t * 72 + d] = hb;
        if (mat == 0) QHAT[t * 64 + d] = hb;
      }
    }
  }
  if (tid < 128) {
    const int dir = tid >> 6, c = tid & 63;
    const int tok = dir == 0 ? c : 63 - c;
    const u16* R = INP + (size_t)(r0 + tok) * LDI;
    const float ga = bf2f(R[C_GA + dir * 4 + hd]), gb = bf2f(R[C_GB + dir * 4 + hd]);
    const float g = -__expf(p->in[26][(l * 2 + dir) * 4 + hd]) * softplusf_(ga + p->in[27][(l * 2 + dir) * 4 + hd]);
    float gc = g;
#pragma unroll
    for (int o = 1; o < 64; o <<= 1) { float tt = __shfl_up(gc, o, 64); if (lane >= o) gc += tt; }
    const float glast = __shfl(gc, 63, 64);
    sgc[dir * 64 + c] = gc; sbeta[dir * 64 + c] = sigm(gb); sge[dir * 64 + c] = __expf(gc);
    float* gv = (float*)(p->ws + WS_GVEC) + (size_t)(item * 2 + dir) * 256;
    gv[c] = __expf(gc); gv[64 + c] = __expf(glast - gc); if (c == 0) gv[128] = __expf(glast);
  }
  __syncthreads();
  {
    const int dk = tid >> 2, c0 = (tid & 3) * 16;
    unsigned w[8];
#pragma unroll
    for (int e = 0; e < 8; ++e) w[e] = (unsigned)sk[(c0 + 2 * e) * 72 + dk] | ((unsigned)sk[(c0 + 2 * e + 1) * 72 + dk] << 16);
    u16* KT = (u16*)(p->ws + WS_KT) + (size_t)item * 4096 + dk * 64 + c0;
    *(u32x4*)KT = mku4(w[0], w[1], w[2], w[3]); *(u32x4*)(KT + 8) = mku4(w[4], w[5], w[6], w[7]);
  }
  {
    const int i0 = wave * 16;
    f32x4 akk[4], aqk[4];
#pragma unroll
    for (int nt = 0; nt < 4; ++nt) { akk[nt] = f32x4{0.f, 0.f, 0.f, 0.f}; aqk[nt] = f32x4{0.f, 0.f, 0.f, 0.f}; }
#pragma unroll
    for (int s = 0; s < 2; ++s) {
      bf16x8 ak = ld8(sk + (i0 + lq) * 72 + s * 32 + quad * 8), aq = ld8(sq + (i0 + lq) * 72 + s * 32 + quad * 8);
#pragma unroll
      for (int nt = 0; nt < 4; ++nt) { bf16x8 bk = ld8(sk + (nt * 16 + lq) * 72 + s * 32 + quad * 8); akk[nt] = MFMA16(ak, bk, akk[nt]); aqk[nt] = MFMA16(aq, bk, aqk[nt]); }
    }
    u16* QKf = (u16*)(p->ws + WS_QK) + (size_t)(item * 2 + 0) * 4096;
    u16* QKb = (u16*)(p->ws + WS_QK) + (size_t)(item * 2 + 1) * 4096;
#pragma unroll
    for (int nt = 0; nt < 4; ++nt)
#pragma unroll
      for (int r = 0; r < 4; ++r) {
        const int i = i0 + quad * 4 + r, j = nt * 16 + lq, ib = 63 - i, jb = 63 - j;
        const float kkv = akk[nt][r], qkv = aqk[nt][r];
        if (j < i) sL[i * 64 + j] = sbeta[i] * kkv * __expf(sgc[i] - sgc[j]);
        if (j > i) sL[4096 + ib * 64 + jb] = sbeta[64 + ib] * kkv * __expf(sgc[64 + ib] - sgc[64 + jb]);
        QKf[i * 64 + j] = f2bf(j <= i ? qkv * __expf(sgc[i] - sgc[j]) : 0.f);
        QKb[ib * 64 + jb] = f2bf(j >= i ? qkv * __expf(sgc[64 + ib] - sgc[64 + jb]) : 0.f);
      }
  }
  __syncthreads();
  {
    const int col = tid & 127;
    u16* UW = (u16*)(p->ws + WS_UW) + (size_t)(item * 2 + (tid >> 7)) * 8192 + col;
    for (int rep = 0; rep < NREP(2); ++rep) {
    if (tid < 128) { if (col < 64) gdn_solve<0, false>(sL, sv + col, sbeta, sge, UW); else gdn_solve<0, true>(sL, sk + (col - 64), sbeta, sge, UW); }
    else { if (col < 64) gdn_solve<1, false>(sL + 4096, sv + col, sbeta + 64, sge + 64, UW); else gdn_solve<1, true>(sL + 4096, sk + (col - 64), sbeta + 64, sge + 64, UW); }
    }
  }
  __syncthreads();
}

DI void gdn2_item(KP p, int l, int item, unsigned char* smem) {
  u16* sW = (u16*)smem; u16* sKT = sW + 64 * 72; u16* sU = sKT + 64 * 72;
  float* sg = (float*)(smem + 27648);
  const int tid = ltid(), lane = tid & 63, wave = tid >> 6, lq = lane & 15, quad = lane >> 4;
  int b, hd, dir; bool lat;
  if (item < 16) { lat = true; b = item >> 3; hd = (item >> 1) & 3; dir = item & 1; }
  else { lat = false; int r = item - 16; b = r >> 3; hd = (r >> 1) & 3; dir = r & 1; }
  const int nch = lat ? 64 : 4, cg0 = lat ? 128 + b * 64 : b * 4;
  f32x4 st[4];
#pragma unroll
  for (int kt = 0; kt < 4; ++kt)
#pragma unroll
    for (int r = 0; r < 4; ++r)
      st[kt][r] = lat ? p->in[8][((size_t)(((b * 2 + l) * 2 + dir) * 4 + hd) * 64 + kt * 16 + quad * 4 + r) * 64 + wave * 16 + lq] : 0.f;
  const int lrow = tid >> 2, seg = (tid & 3) * 16;
  struct GReg { u32x4 U[2], W[2], KT[2]; float g; };
  GReg R0, R1;
  u16* UWb = (u16*)(p->ws + WS_UW);
  const u16* KTb = (const u16*)(p->ws + WS_KT);
  const float* GV = (const float*)(p->ws + WS_GVEC);
  auto gload = [&](int n, GReg& R) {
    const int cgi = dir == 0 ? cg0 + n : cg0 + nch - 1 - n;
    const size_t prob = (size_t)cgi * 4 + hd, pd = prob * 2 + dir;
    const u16* u = UWb + (pd * 64 + lrow) * 128 + seg;
    R.U[0] = *(const u32x4*)u; R.U[1] = *(const u32x4*)(u + 8); R.W[0] = *(const u32x4*)(u + 64); R.W[1] = *(const u32x4*)(u + 72);
    const u16* kt = KTb + (prob * 64 + lrow) * 64 + (dir ? 48 - seg : seg);
    u32x4 a = *(const u32x4*)kt, bb = *(const u32x4*)(kt + 8);
    if (dir) { R.KT[0] = rev8(bb); R.KT[1] = rev8(a); } else { R.KT[0] = a; R.KT[1] = bb; }
    R.g = GV[pd * 256 + (tid & 255)];
  };
  gload(0, R0); gload(1, R1);
  auto step = [&](int n, GReg& R) {
    const int cgi = dir == 0 ? cg0 + n : cg0 + nch - 1 - n;
    const size_t pd = ((size_t)cgi * 4 + hd) * 2 + dir;
    __syncthreads();
    *(u32x4*)(sW + lrow * 72 + seg) = R.W[0]; *(u32x4*)(sW + lrow * 72 + seg + 8) = R.W[1];
    *(u32x4*)(sKT + lrow * 72 + seg) = R.KT[0]; *(u32x4*)(sKT + lrow * 72 + seg + 8) = R.KT[1];
    *(u32x4*)(sU + lrow * 72 + seg) = R.U[0]; *(u32x4*)(sU + lrow * 72 + seg + 8) = R.U[1];
    sg[tid] = R.g;
    __syncthreads();
    if (n + 2 < nch) gload(n + 2, R);
    u32x4* FR = (u32x4*)(UWb + pd * 8192);
    const float elast = sg[128];
    bf16x8 sB[2] = {pack8(st[0], st[1]), pack8(st[2], st[3])};
    FR[(0 * 4 + wave) * 64 + lane] = __builtin_bit_cast(u32x4, sB[0]);
    FR[(1 * 4 + wave) * 64 + lane] = __builtin_bit_cast(u32x4, sB[1]);
    f32x4 vn[4];
#pragma unroll
    for (int mt = 0; mt < 4; ++mt) {
      f32x4 acc = {0.f, 0.f, 0.f, 0.f};
#pragma unroll
      for (int s2 = 0; s2 < 2; ++s2) acc = MFMA16(ldperm(sW + (mt * 16 + lq) * 72 + s2 * 32 + quad * 4), sB[s2], acc);
#pragma unroll
      for (int r = 0; r < 4; ++r) vn[mt][r] = bf2f(sU[(mt * 16 + quad * 4 + r) * 72 + wave * 16 + lq]) - acc[r];
    }
    bf16x8 vB[2] = {pack8(vn[0], vn[1]), pack8(vn[2], vn[3])};
    FR[512 + (0 * 4 + wave) * 64 + lane] = __builtin_bit_cast(u32x4, vB[0]);
    FR[512 + (1 * 4 + wave) * 64 + lane] = __builtin_bit_cast(u32x4, vB[1]);
#pragma unroll
    for (int mt = 0; mt < 4; ++mt)
#pragma unroll
      for (int r = 0; r < 4; ++r) vn[mt][r] *= sg[64 + mt * 16 + quad * 4 + r];
    bf16x8 vsB[2] = {pack8(vn[0], vn[1]), pack8(vn[2], vn[3])};
#pragma unroll
    for (int kt = 0; kt < 4; ++kt) {
      f32x4 acc = {0.f, 0.f, 0.f, 0.f};
#pragma unroll
      for (int s2 = 0; s2 < 2; ++s2) acc = MFMA16(ldperm(sKT + (kt * 16 + lq) * 72 + s2 * 32 + quad * 4), vsB[s2], acc);
#pragma unroll
      for (int r = 0; r < 4; ++r) st[kt][r] = elast * st[kt][r] + acc[r];
    }
  };
  for (int n = 0; n < nch; n += 2) { step(n, R0); step(n + 1, R1); }
  if (!lat) {
#pragma unroll
    for (int kt = 0; kt < 4; ++kt)
#pragma unroll
      for (int r = 0; r < 4; ++r)
        p->out[O_GDN + ((size_t)(((b * 2 + l) * 2 + dir) * 4 + hd) * 64 + kt * 16 + quad * 4 + r) * 64 + wave * 16 + lq] = st[kt][r];
  }
  __syncthreads();
}

DI void gdnfin_item(KP p, int l, int item, unsigned char* smem) {
  u16* sQ = (u16*)smem; u16* sQK = sQ + 64 * 72;
  float* so = (float*)(smem + 3 * 64 * 72 * 2);
  float* seg_ = so + 64 * 65;
  const int cgi = item >> 2, hd = item & 3;
  const int tid = ltid(), lane = tid & 63, wave = tid >> 6, lq = lane & 15, quad = lane >> 4;
  const int lrow = tid >> 2, seg = (tid & 3) * 16;
  __syncthreads();
  {
    const u16* q = (const u16*)(p->ws + WS_QHAT) + ((size_t)item * 64 + lrow) * 64 + seg;
    *(u32x4*)(sQ + lrow * 72 + seg) = *(const u32x4*)q; *(u32x4*)(sQ + lrow * 72 + seg + 8) = *(const u32x4*)(q + 8);
#pragma unroll
    for (int dir = 0; dir < 2; ++dir) {
      const u16* qk = (const u16*)(p->ws + WS_QK) + ((size_t)(item * 2 + dir) * 64 + lrow) * 64 + seg;
      *(u32x4*)(sQK + (dir * 64 + lrow) * 72 + seg) = *(const u32x4*)qk; *(u32x4*)(sQK + (dir * 64 + lrow) * 72 + seg + 8) = *(const u32x4*)(qk + 8);
    }
    if (tid < 128) seg_[tid] = ((const float*)(p->ws + WS_GVEC))[(size_t)(item * 2 + (tid >> 6)) * 256 + (tid & 63)];
  }
  __syncthreads();
#pragma unroll
  for (int dir = 0; dir < 2; ++dir) {
    const u32x4* FR = (const u32x4*)((const u16*)(p->ws + WS_UW) + (size_t)(item * 2 + dir) * 8192);
    bf16x8 sfr[2], vfr[2];
#pragma unroll
    for (int s2 = 0; s2 < 2; ++s2) {
      sfr[s2] = __builtin_bit_cast(bf16x8, FR[(s2 * 4 + wave) * 64 + lane]);
      vfr[s2] = __builtin_bit_cast(bf16x8, FR[512 + (s2 * 4 + wave) * 64 + lane]);
    }
#pragma unroll
    for (int mt = 0; mt < 4; ++mt) {
      f32x4 acc = {0.f, 0.f, 0.f, 0.f};
      const int qrow = dir ? 63 - (mt * 16 + lq) : mt * 16 + lq;
#pragma unroll
      for (int s2 = 0; s2 < 2; ++s2) acc = MFMA16(ldperm(sQ + qrow * 72 + s2 * 32 + quad * 4), sfr[s2], acc);
#pragma unroll
      for (int r = 0; r < 4; ++r) acc[r] *= seg_[dir * 64 + mt * 16 + quad * 4 + r];
#pragma unroll
      for (int s2 = 0; s2 < 2; ++s2) acc = MFMA16(ldperm(sQK + (dir * 64 + mt * 16 + lq) * 72 + s2 * 32 + quad * 4), vfr[s2], acc);
#pragma unroll
      for (int r = 0; r < 4; ++r) {
        const int c = mt * 16 + quad * 4 + r;
        const int tk = dir ? 63 - c : c;
        float* d = so + tk * 65 + wave * 16 + lq;
        if (dir == 0) *d = acc[r]; else *d += acc[r];
      }
    }
    __syncthreads();
  }
  const float gn = p->in[28][l * 64 + lane];
  float zv[16];
#pragma unroll
  for (int q = 0; q < 16; ++q)
    zv[q] = bf2f(((const u16*)(p->ws + WS_INPROJ))[((size_t)cgi * 64 + wave * 16 + q) * LDI + C_GZ + hd * 64 + lane]);
#pragma unroll
  for (int q = 0; q < 16; ++q) {
    const int c = wave * 16 + q;
    const size_t row = (size_t)cgi * 64 + c;
    float o = so[c * 65 + lane];
    float ss = wave_sum(o * o);
    float y = o * rsqrtf(ss * (1.f / 64.f) + 1e-6f) * gn * siluf_(zv[q]);
    ((u16*)(p->ws + WS_BRANCH))[row * 1024 + 512 + hd * 64 + lane] = f2bf(y);
  }
}

#define XB_TMO      128
#define XB_XCNT(j)  (256  + 64 * (j))
#define XB_XSUB(j)  (1280 + 64 * (j))
#define XB_XGEN(j)  (2304 + 64 * (j))
#define XB_TOP      3328
#define XB_TOPGEN   3392
#define XB_SPIN_CAP (1u << 20)
#define LAS __attribute__((address_space(3)))
DI unsigned xb_ld(unsigned* q) { return __hip_atomic_load(q, __ATOMIC_RELAXED, __HIP_MEMORY_SCOPE_AGENT); }
DI unsigned xb_add(unsigned* q, unsigned v) { return __hip_atomic_fetch_add(q, v, __ATOMIC_RELAXED, __HIP_MEMORY_SCOPE_AGENT); }
DI unsigned xb_xcc_id() { return (unsigned)__builtin_amdgcn_s_getreg((3 << 11) | 20) & 0xFu; }
#define XB_SPIN(cond, bar) do { unsigned _sp = 0; while (cond) { __builtin_amdgcn_s_sleep(1); \
    if ((++_sp & 255u) == 0u) { if (xb_ld(&(bar)[XB_TMO])) break; if (_sp > XB_SPIN_CAP) { atomicAdd(&(bar)[XB_TMO], 1u); break; } } } } while (0)
DI void xcd_barrier_complete(unsigned* bar, unsigned x, unsigned& nloc, unsigned& nx) {
  const unsigned G = gridDim.x;
  unsigned sum, cnt, mine, sp = 0u;
  for (;;) {
    sum = 0u; cnt = 0u; mine = 0u;
#pragma unroll
    for (unsigned j = 0; j < 16; ++j) { const unsigned c = xb_ld(&bar[XB_XCNT(j)]); sum += c; cnt += (c > 0u) ? 1u : 0u; mine = (j == x) ? c : mine; }
    if (sum == G) break;
    __builtin_amdgcn_s_sleep(1);
    if ((++sp & 255u) == 0u) { if (xb_ld(&bar[XB_TMO])) break; if (sp > XB_SPIN_CAP) { atomicAdd(&bar[XB_TMO], 1u); break; } }
  }
  nloc = mine > 0u ? mine : 1u; nx = cnt > 0u ? cnt : 1u;
}
DI void xcd_barrier(unsigned* bar, volatile LAS unsigned* st) {
  asm volatile("s_waitcnt vmcnt(0)" ::: "memory");
  __syncthreads();
  if (ltid() == 0) {
    const unsigned x = xb_xcc_id();
    __builtin_amdgcn_s_waitcnt(0);
    unsigned nloc = st[0], nx = st[1];
    if (nloc == 0u) { xcd_barrier_complete(bar, x, nloc, nx); st[0] = nloc; st[1] = nx; }
    const unsigned old = xb_add(&bar[XB_XSUB(x)], 1u);
    const unsigned gen = old / nloc;
    if (old + 1u == (gen + 1u) * nloc) {
      __builtin_amdgcn_fence(__ATOMIC_RELEASE, "agent");
      asm volatile("s_waitcnt vmcnt(0)" ::: "memory");
      const unsigned og = xb_add(&bar[XB_TOP], 1u);
      const unsigned tg = og / nx;
      if (og + 1u == (tg + 1u) * nx) xb_add(&bar[XB_TOPGEN], 1u);
      else XB_SPIN(xb_ld(&bar[XB_TOPGEN]) == tg, bar);
      __builtin_amdgcn_fence(__ATOMIC_ACQUIRE, "agent");
      xb_add(&bar[XB_XGEN(x)], 1u);
      asm volatile("s_waitcnt vmcnt(0)" ::: "memory");
    } else {
      XB_SPIN(xb_ld(&bar[XB_XGEN(x)]) == gen, bar);
      __builtin_amdgcn_fence(__ATOMIC_ACQUIRE, "agent");
      asm volatile("s_waitcnt vmcnt(0)" ::: "memory");
    }
  }
  __syncthreads();
}


#define FOR_TILES(MTI, NTI, SM, SN, CALL)                                                      \
  do {                                                                                         \
    if (G % 8 != 0) { for (int it_ = B; it_ < (MTI) * (NTI); it_ += G) { const int mt = it_ / (NTI), nt = it_ % (NTI); CALL; } } \
    else {                                                                                     \
      const int xcd_ = B & 7, j_ = B >> 3, J_ = G >> 3;                                        \
      const int nsm_ = ((MTI) + (SM) - 1) / (SM), nsn_ = ((NTI) + (SN) - 1) / (SN);            \
      for (int s_ = xcd_; s_ < nsm_ * nsn_; s_ += 8) {                                         \
        const int sm_ = s_ / nsn_, sn_ = s_ % nsn_;                                            \
        for (int t_ = j_; t_ < (SM) * (SN); t_ += J_) {                                        \
          const int mt = sm_ * (SM) + t_ / (SN), nt = sn_ * (SN) + t_ % (SN);                  \
          if (mt < (MTI) && nt < (NTI)) { CALL; }                                              \
        }                                                                                      \
      }                                                                                        \
    }                                                                                          \
  } while (0)

constexpr int NPHASE = 21;
__global__ void __launch_bounds__(256, 2) mk(Params p_unused, int ph_lo, int ph_hi) {
  extern __shared__ __attribute__((aligned(1024))) unsigned char smem[];
  int& s_item = *(int*)(smem + SMEM_BYTES);
  u32x4& xb_words = *(u32x4*)(smem + SMEM_BYTES + 16);
  const int G = gridDim.x, B = blockIdx.x;
  const bool fused = ph_hi - ph_lo > 1;
  if (fused) {
    if (ltid() == 0) { xb_words = u32x4{0u, 0u, 0u, 0u}; (void)xb_add(&((unsigned*)(((KP)__builtin_amdgcn_kernarg_segment_ptr())->ws + WS_BAR))[XB_XCNT(xb_xcc_id())], 1u); }
    __syncthreads();
  }
  for (int ph = ph_lo; ph < ph_hi; ++ph) {
    KP p = (KP)__builtin_amdgcn_kernarg_segment_ptr();
    asm volatile("" : "+s"(p));
    if (ph == 0) {
      for (int it = B; it < 192 + CONV_ITEMS + 64; it += G) { for (int rep = 0; rep < NREP(0); ++rep) { if (it < 192) mod_item(p, it, smem); else if (it < 192 + CONV_ITEMS) convert_item(p, 0, it - 192, smem); else lruw_item(p, it - 192 - CONV_ITEMS); } }
    } else {
      const int l = (ph - 1) / 10, sub = (ph - 1) % 10;
      switch (sub) {
        case 0:
          for (int it = B; it < 2048 + (l ? CONV_ITEMS : 0); it += G) { if (it < 2048) norm_item<0>(p, l, it); else convert_item(p, l, it - 2048, smem); }
          break;
        case 1: FOR_TILES(128, 21, 8, 7, inproj_item(p, mt, nt, smem)); break;
        case 2:
          for (int it = B; it < 1024 + 512 + 64 + 2048; it += G) {
            if (it < 1024) { for (int rep = 0; rep < NREP(4); ++rep) gdn1_item(p, l, it, smem); }
            else if (it < 1536) { for (int rep = 0; rep < NREP(5); ++rep) lru_item<false>(p, l, it - 1024, smem); }
            else if (it < 1600) { if (PHON(6)) kvc_item(p, l, it - 1536); }
            else if (PHON(6)) prep_item(p, l, it - 1600);
          }
          break;
        case 3: {
          int* ctr = (int*)(p->ws + WS_CTR) + l;
          for (;;) {
            __syncthreads();
            if (ltid() == 0) s_item = atomicAdd(ctr, 1);
            __syncthreads();
            const int it = s_item;
            if (it >= 16 + 256 + 256 + 256 + 512 + 512) break;
            if (it < 16) gdn2_item(p, l, it, smem);
            else if (it < 272) { for (int rep = 0; rep < NREP(8); ++rep) attn_item(p, l, it - 16, smem); }
            else if (it < 528) gdn2_item(p, l, it - 272 + 16, smem);
            else if (it < 784) { for (int rep = 0; rep < NREP(8); ++rep) attn_item(p, l, it - 528 + 256, smem); }
            else if (it < 1296) { for (int rep = 0; rep < NREP(9); ++rep) lru_item<true>(p, l, it - 784, smem); }
            else for (int rep = 0; rep < NREP(8); ++rep) attn_item(p, l, it - 1296 + 512, smem);
          }
        } break;
        case 4: for (int it = B; it < 1024; it += G) gdnfin_item(p, l, it, smem); break;
        case 5: for (int rep = 0; rep < NREP(11); ++rep) FOR_TILES(128, 8, 8, 8, merge_item(p, l, mt, nt, smem)); break;
        case 6: FOR_TILES(128, 8, 8, 8, wout_item(p, l, mt, nt, smem)); break;
        case 7: for (int it = B; it < 2048; it += G) norm_item<1>(p, l, it); break;
        case 8: FOR_TILES(128, 32, 8, 8, w1_item(p, mt, nt, smem)); break;
        case 9: FOR_TILES(128, 8, 8, 8, w2_item(p, l, mt, nt, smem)); break;
      }
    }
    if (ph + 1 < ph_hi) {
      if (ph == ph_lo) cg::this_grid().sync();
      else for (int rep = 0; rep < NREP(1); ++rep) xcd_barrier((unsigned*)(p->ws + WS_BAR), (volatile LAS unsigned*)&xb_words);
    }
  }
}

extern "C" void kernel_launch(void* const* d_in, const int* in_sizes, int n_in, void* d_out, int out_size, void* d_ws, size_t ws_size, hipStream_t stream) {
  static int grid_blocks = 0;
  if (!grid_blocks) {
    int dev = 0, cus = 0, per_cu = 0;
    (void)hipGetDevice(&dev);
    (void)hipDeviceGetAttribute(&cus, hipDeviceAttributeMultiprocessorCount, dev);
    if (hipFuncSetAttribute((const void*)mk, hipFuncAttributeMaxDynamicSharedMemorySize, DYN_LDS) != hipSuccess) fprintf(stderr, "kernel_launch: hipFuncSetAttribute failed\n");
    (void)hipOccupancyMaxActiveBlocksPerMultiprocessor(&per_cu, mk, 256, DYN_LDS);
    if (per_cu < 1) per_cu = 1;
    if (per_cu > 2) per_cu = 2;
    grid_blocks = cus * per_cu;
    if (ws_size < WS_END) fprintf(stderr, "kernel_launch: workspace too small: %zu < %zu\n", ws_size, (size_t)WS_END);
  }
  if (hipMemsetAsync((char*)d_ws + WS_CTR, 0, 256 + 3456 * 4 + 256, stream) != hipSuccess) fprintf(stderr, "kernel_launch: memset failed\n");
  Params p{};
  for (int i = 0; i < 37; ++i) p.in[i] = (const float*)d_in[i];
  p.out = (float*)d_out; p.ws = (unsigned char*)d_ws;
#if MULTI_LAUNCH
  for (int ph = 0; ph < NPHASE; ++ph) hipLaunchKernelGGL(mk, dim3(grid_blocks), dim3(256), DYN_LDS, stream, p, ph, ph + 1);
#else
  int lo = 0, hi = NPHASE;
  void* args[] = {&p, &lo, &hi};
  hipError_t e = hipLaunchCooperativeKernel((void*)mk, dim3(grid_blocks), dim3(256), args, DYN_LDS, stream);
  if (e != hipSuccess) fprintf(stderr, "cooperative launch failed: %s (grid %d)\n", hipGetErrorString(e), grid_blocks);
#endif
}
```

```cpp
#include <hip/hip_runtime.h>
#include <hip/hip_cooperative_groups.h>
#include <cstdio>
namespace cg = cooperative_groups;

#ifndef MULTI_LAUNCH
#define MULTI_LAUNCH 0
#endif
#ifndef PHM
#define PHM 0xFFFFFFFFu
#endif
#define PHON(b) ((PHM >> (b)) & 1u)
#ifndef DUPM
#define DUPM 0u
#endif
#define NREP(b) (1 + ((DUPM >> (b)) & 1u))

typedef unsigned short u16;
using bf16x8 = __attribute__((ext_vector_type(8))) short;
using f32x4 = __attribute__((ext_vector_type(4))) float;
using u32x4 = __attribute__((ext_vector_type(4))) unsigned;
#define DI __device__ __forceinline__
#define MFMA16(a, b, c) __builtin_amdgcn_mfma_f32_16x16x32_bf16((a), (b), (c), 0, 0, 0)

constexpr int NTOK = 16384;
constexpr int DM = 1024;
constexpr int LDI = 2592;
constexpr int C_AQ = 0, C_AK = 256, C_AV = 384, C_LX = 512, C_LG = 768, C_GQ = 1024, C_GK = 1280, C_GV = 1536, C_GZ = 1792,
              C_DQ = 2048, C_DK = 2304, C_DV = 2432, C_GA = 2560, C_GB = 2568;
constexpr int NIN_PAD = 2688;

constexpr size_t WS_MOD = 0;
constexpr size_t WS_CTR = WS_MOD + 2 * 3 * 6144 * 4;
constexpr size_t WS_BAR = WS_CTR + 256;
constexpr size_t WS_LRUC = WS_BAR + 3456 * 4 + 256;
constexpr size_t WS_KC = WS_LRUC + (size_t)512 * 2 * 2 * 256 * 4;
constexpr size_t WS_GVEC = WS_KC + (size_t)16 * 512 * 64 * 2;
constexpr size_t WS_LRUW = WS_GVEC + (size_t)1024 * 2 * 256 * 4;
constexpr size_t WS_VT = WS_LRUW + (size_t)256 * 64 * 16;
constexpr size_t WS_WIN = WS_VT + (size_t)8 * 64 * 4608 * 2;
constexpr size_t WS_WM = WS_WIN + (size_t)NIN_PAD * 1024 * 2;
constexpr size_t WS_WB = WS_WM + (size_t)4096 * 1024 * 2;
constexpr size_t WS_WO = WS_WB + (size_t)4 * 1024 * 256 * 2;
constexpr size_t WS_W1 = WS_WO + (size_t)1024 * 1024 * 2;
constexpr size_t WS_W2 = WS_W1 + (size_t)4096 * 1024 * 2;
constexpr size_t WS_H = WS_W2 + (size_t)1024 * 4096 * 2;
constexpr size_t WS_BIG = WS_H + (size_t)NTOK * 1024 * 2;
constexpr size_t WS_INPROJ = WS_BIG;
constexpr size_t WS_BRANCH = WS_INPROJ + (size_t)NTOK * LDI * 2;
constexpr size_t WS_QHAT = WS_BRANCH + (size_t)NTOK * 1024 * 2;
constexpr size_t WS_KT = WS_QHAT + (size_t)1024 * 4096 * 2;
constexpr size_t WS_UW = WS_KT + (size_t)1024 * 4096 * 2;
constexpr size_t WS_QK = WS_UW + (size_t)1024 * 2 * 8192 * 2;
constexpr size_t WS_END = WS_QK + (size_t)1024 * 2 * 4096 * 2;
constexpr size_t WS_HIDDEN = WS_BIG;
constexpr size_t WS_MERGED = WS_BIG;
static_assert(WS_HIDDEN + (size_t)NTOK * 4096 * 2 <= WS_END, "hidden must fit");
static_assert(WS_END <= (size_t)256 * 1024 * 1024, "workspace budget");

constexpr size_t O_X = 0, O_AK = 16777216, O_AV = 18874368, O_DK = 20971520, O_DV = 23068672, O_LRU = 25165824, O_GDN = 25198592;

struct Params {
  const float* in[37];
  float* out;
  unsigned char* ws;
};

typedef const Params __attribute__((address_space(4)))* KP;
constexpr int SMEM_BYTES = 65536;
constexpr int DYN_LDS = SMEM_BYTES + 64;

DI int ltid() { int t = threadIdx.x; asm volatile("" : "+v"(t)); return t; }
typedef __bf16 bf16v2 __attribute__((ext_vector_type(2)));
DI u16 f2bf(float x) { __bf16 h = (__bf16)x; return __builtin_bit_cast(u16, h); }
DI float bf2f(u16 h) { return __uint_as_float(((unsigned)h) << 16); }
DI unsigned pack2(float a, float b) { bf16v2 v = {(__bf16)a, (__bf16)b}; return __builtin_bit_cast(unsigned, v); }
DI float bflo(unsigned u) { return __uint_as_float(u << 16); }
DI float bfhi(unsigned u) { return __uint_as_float(u & 0xffff0000u); }
DI float sigm(float x) { return 1.f / (1.f + __expf(-x)); }
DI float siluf_(float x) { return x / (1.f + __expf(-x)); }
DI float softplusf_(float x) { return x > 20.f ? x : log1pf(__expf(x)); }
DI float gelu_tanh(float x) { float u = 0.7978845608028654f * (x + 0.044715f * x * x * x); float t = 1.f - 2.f / (__expf(2.f * u) + 1.f); return 0.5f * x * (1.f + t); }
DI float wave_sum(float v) {
#pragma unroll
  for (int o = 32; o > 0; o >>= 1) v += __shfl_xor(v, o, 64);
  return v;
}
DI u32x4 mku4(unsigned a, unsigned b, unsigned c, unsigned d) { u32x4 v = {a, b, c, d}; return v; }
DI bf16x8 mk8(unsigned a, unsigned b, unsigned c, unsigned d) { u32x4 v = {a, b, c, d}; return __builtin_bit_cast(bf16x8, v); }
DI bf16x8 pack8(const f32x4& x, const f32x4& y) { return mk8(pack2(x[0], x[1]), pack2(x[2], x[3]), pack2(y[0], y[1]), pack2(y[2], y[3])); }
DI bf16x8 ld8(const u16* p) { return *(const bf16x8*)p; }
DI bf16x8 ldperm(const u16* p) { uint2 a = *(const uint2*)p; uint2 b = *(const uint2*)(p + 16); return mk8(a.x, a.y, b.x, b.y); }
DI int mod_group(int row) { return row < 8192 ? 0 : 1 + ((row - 8192) >> 12); }
DI const float* x_in_row(KP p, int l, int row) {
  if (l == 0) return row < 8192 ? p->in[0] + (size_t)row * DM : p->in[1] + (size_t)(row - 8192) * DM;
  return p->out + (size_t)row * DM;
}
DI unsigned swap16(unsigned u) { return (u >> 16) | (u << 16); }
DI u32x4 rev8(u32x4 v) { return mku4(swap16(v.w), swap16(v.z), swap16(v.y), swap16(v.x)); }

DI void mod_item(KP p, int item, unsigned char* smem) {
  float* sc = (float*)smem;
  float* sr = sc + 3072;
  const int tid = ltid();
  const int l = item / 96, cb = item % 96;
  for (int i = tid; i < 3072; i += 256) {
    int g = i >> 10, k = i & 1023;
    float c = g == 0 ? p->in[9][k] : p->in[2][(g - 1) * 1024 + k];
    sc[i] = siluf_(c);
  }
  __syncthreads();
  const int col = cb * 64 + (tid & 63), kg = tid >> 6;
  const float* W = p->in[10] + (size_t)l * 1024 * 6144;
  float a0 = 0.f, a1 = 0.f, a2 = 0.f;
  for (int k = kg * 256; k < kg * 256 + 256; ++k) {
    float w = W[(size_t)k * 6144 + col];
    a0 += sc[k] * w; a1 += sc[1024 + k] * w; a2 += sc[2048 + k] * w;
  }
  sr[(kg * 3 + 0) * 64 + (tid & 63)] = a0; sr[(kg * 3 + 1) * 64 + (tid & 63)] = a1; sr[(kg * 3 + 2) * 64 + (tid & 63)] = a2;
  __syncthreads();
  if (tid < 192) {
    int g = tid >> 6, cc = tid & 63;
    float s = p->in[11][l * 6144 + cb * 64 + cc];
    for (int q = 0; q < 4; ++q) s += sr[(q * 3 + g) * 64 + cc];
    ((float*)(p->ws + WS_MOD))[(l * 3 + g) * 6144 + cb * 64 + cc] = s;
  }
  __syncthreads();
}

DI void conv_tile(const float* src, int N, int k0, int n0, u16* dst, int K, bool perm, unsigned char* smem) {
  float* tile = (float*)smem;
  const int tid = ltid();
#pragma unroll
  for (int i = 0; i < 4; ++i) {
    int kr = (tid >> 4) + 16 * i, nc = (tid & 15) * 4;
    float4 v = make_float4(0.f, 0.f, 0.f, 0.f);
    if (n0 + nc < N) v = *(const float4*)(src + (size_t)(k0 + kr) * N + n0 + nc);
    tile[kr * 65 + nc] = v.x; tile[kr * 65 + nc + 1] = v.y; tile[kr * 65 + nc + 2] = v.z; tile[kr * 65 + nc + 3] = v.w;
  }
  __syncthreads();
#pragma unroll
  for (int i = 0; i < 2; ++i) {
    int n = (tid >> 3) + 32 * i, k8 = (tid & 7) * 8;
    int ng = n0 + n;
    if (ng < N) {
      int row = ng;
      if (perm) row = ng < 2048 ? ng : (ng < 2064 ? 2560 + (ng - 2048) : ng - 16);
      u32x4 o;
      o.x = pack2(tile[(k8 + 0) * 65 + n], tile[(k8 + 1) * 65 + n]);
      o.y = pack2(tile[(k8 + 2) * 65 + n], tile[(k8 + 3) * 65 + n]);
      o.z = pack2(tile[(k8 + 4) * 65 + n], tile[(k8 + 5) * 65 + n]);
      o.w = pack2(tile[(k8 + 6) * 65 + n], tile[(k8 + 7) * 65 + n]);
      *(u32x4*)(dst + (size_t)row * K + k0 + k8) = o;
    }
  }
  __syncthreads();
}

constexpr int CONV_ITEMS = 4241;
DI void convert_item(KP p, int l, int item, unsigned char* smem) {
  unsigned char* ws = p->ws;
  if (item < 656) { int kt = item / 41, nt = item % 41; conv_tile(p->in[14] + (size_t)l * 1024 * 2576, 2576, kt * 64, nt * 64, (u16*)(ws + WS_WIN), 1024, true, smem); return; }
  item -= 656;
  if (item < 1024) { int kt = item >> 6, nt = item & 63; conv_tile(p->in[32] + (size_t)l * 1024 * 4096, 4096, kt * 64, nt * 64, (u16*)(ws + WS_WM), 1024, false, smem); return; }
  item -= 1024;
  if (item < 256) { int m = item >> 6, r = item & 63, kt = r >> 4, nt = r & 15;
    conv_tile(p->in[31] + ((size_t)l * 4 + m) * 256 * 1024, 1024, kt * 64, nt * 64, (u16*)(ws + WS_WB) + (size_t)m * 1024 * 256, 256, false, smem); return; }
  item -= 256;
  if (item < 256) { int kt = item >> 4, nt = item & 15; conv_tile(p->in[34] + (size_t)l * 1024 * 1024, 1024, kt * 64, nt * 64, (u16*)(ws + WS_WO), 1024, false, smem); return; }
  item -= 256;
  if (item < 1024) { int kt = item >> 6, nt = item & 63; conv_tile(p->in[35] + (size_t)l * 1024 * 4096, 4096, kt * 64, nt * 64, (u16*)(ws + WS_W1), 1024, false, smem); return; }
  item -= 1024;
  if (item < 1024) { int kt = item >> 4, nt = item & 15; conv_tile(p->in[36] + (size_t)l * 4096 * 1024, 1024, kt * 64, nt * 64, (u16*)(ws + WS_W2), 4096, false, smem); return; }
  u32x4* z = (u32x4*)((u16*)(ws + WS_WIN) + (size_t)2576 * 1024);
  for (int i = ltid(); i < 112 * 1024 / 8; i += 256) z[i] = mku4(0, 0, 0, 0);
}

DI void lruw_item(KP p, int item) {
  const int gid = item * 256 + ltid();
  const int lane = gid & 63, fg = gid >> 6;
  const int s2 = fg & 1, j = (fg >> 1) & 3, n = (fg >> 3) & 3, g = (fg >> 5) & 1, ld_ = fg >> 6;
  const int lq = lane & 15, quad = lane >> 4;
  const float* W = (g == 0 ? p->in[20] : p->in[22]) + ((size_t)(ld_ * 4 + n) * 64) * 64 + (size_t)(s2 * 32 + quad * 8) * 64 + j * 16 + lq;
  u32x4 o = {pack2(W[0], W[64]), pack2(W[128], W[192]), pack2(W[256], W[320]), pack2(W[384], W[448])};
  ((u32x4*)(p->ws + WS_LRUW))[gid] = o;
}

template <int which>
DI void norm_item(KP p, int l, int item) {
  const int tid = ltid(), lane = tid & 63, wave = tid >> 6;
  const float* g = p->in[which == 0 ? 12 : 13] + l * 1024;
  f32x4 v[2][4]; float ss[2] = {0.f, 0.f};
#pragma unroll
  for (int h = 0; h < 2; ++h) {
    const int row = item * 8 + wave * 2 + h;
    const float* x = x_in_row(p, which == 0 ? l : 2, row);
#pragma unroll
    for (int i = 0; i < 4; ++i) v[h][i] = *(const f32x4*)(x + i * 256 + lane * 4);
  }
#pragma unroll
  for (int h = 0; h < 2; ++h) {
#pragma unroll
    for (int i = 0; i < 4; ++i) ss[h] += v[h][i].x * v[h][i].x + v[h][i].y * v[h][i].y + v[h][i].z * v[h][i].z + v[h][i].w * v[h][i].w;
    ss[h] = wave_sum(ss[h]);
  }
#pragma unroll
  for (int h = 0; h < 2; ++h) {
    const int row = item * 8 + wave * 2 + h;
    const float* mod = (const float*)(p->ws + WS_MOD) + (l * 3 + mod_group(row)) * 6144;
    const float* sh = mod + (which == 0 ? 0 : 3072);
    const float* sc = mod + (which == 0 ? 1024 : 4096);
    const float rstd = rsqrtf(ss[h] * (1.f / 1024.f) + 1e-6f);
    u16* H = (u16*)(p->ws + WS_H) + (size_t)row * 1024;
#pragma unroll
    for (int i = 0; i < 4; ++i) {
      int c = i * 256 + lane * 4;
      float4 gg = *(const float4*)(g + c), s1 = *(const float4*)(sc + c), s0 = *(const float4*)(sh + c);
      float y0 = v[h][i].x * rstd * gg.x * (1.f + s1.x) + s0.x, y1 = v[h][i].y * rstd * gg.y * (1.f + s1.y) + s0.y;
      float y2 = v[h][i].z * rstd * gg.z * (1.f + s1.z) + s0.z, y3 = v[h][i].w * rstd * gg.w * (1.f + s1.w) + s0.w;
      *(uint2*)(H + c) = make_uint2(pack2(y0, y1), pack2(y2, y3));
    }
  }
}

DI int lds_byte(int r, int c) {
  int st = (r >> 4) * 2 + (c >> 5), ob = (r & 15) * 64 + (c & 31) * 2;
  return st * 1024 + (ob ^ (((ob >> 9) & 1) << 5));
}
DI void stage_rc(int b, int& R, int& C) {
  int st = b >> 10, sb = b & 1023, swz = sb ^ (((sb >> 9) & 1) << 5);
  R = (st >> 1) * 16 + (swz >> 6);
  C = (st & 1) * 32 + ((swz & 63) >> 1);
}
template <int MT, int NT, bool pre = false>
DI void gemm_acc(f32x4 (&acc)[MT][NT], const u16* __restrict__ A, int lda, const u16* __restrict__ Bt, int ldb, int K, unsigned char* smem,
                 const u16* nxtA = nullptr, int nlda = 0, const u16* nxtB = nullptr, int nldb = 0) {
  constexpr int TA = MT * 32 * 128, TB = NT * 32 * 128, STAGE = TA + TB;
  static_assert(2 * STAGE <= 65536, "LDS");
  const int tid = ltid(), lane = tid & 63, wid = tid >> 6, wm = wid >> 1, wn = wid & 1;
  const int fr = lane & 15, fq = lane >> 4;
  const u16* ga[MT]; const u16* gb[NT];
#pragma unroll
  for (int i = 0; i < MT; ++i) { int R, C; stage_rc(wid * 1024 + i * 4096 + lane * 16, R, C); ga[i] = A + (size_t)R * lda + C; }
#pragma unroll
  for (int i = 0; i < NT; ++i) { int R, C; stage_rc(wid * 1024 + i * 4096 + lane * 16, R, C); gb[i] = Bt + (size_t)R * ldb + C; }
#define GLDS_STAGE(buf, k0)                                                                                                        \
  do {                                                                                                                             \
    _Pragma("unroll") for (int i = 0; i < MT; ++i)                                                                                 \
      __builtin_amdgcn_global_load_lds((const unsigned*)(ga[i] + (k0)), (unsigned*)(smem + (buf) * STAGE + wid * 1024 + i * 4096), 16, 0, 0); \
    _Pragma("unroll") for (int i = 0; i < NT; ++i)                                                                                 \
      __builtin_amdgcn_global_load_lds((const unsigned*)(gb[i] + (k0)), (unsigned*)(smem + (buf) * STAGE + TA + wid * 1024 + i * 4096), 16, 0, 0); \
  } while (0)
  if (!pre) {
    __syncthreads();
    GLDS_STAGE(0, 0);
  }
  asm volatile("s_waitcnt vmcnt(0)" ::: "memory");
  __syncthreads();
  const int nt = K >> 6;
  for (int t = 0; t < nt; ++t) {
    const int cur = t & 1;
    if (t + 1 < nt) GLDS_STAGE(cur ^ 1, (t + 1) * 64);
    const unsigned char* sA = smem + cur * STAGE;
    const unsigned char* sB = sA + TA;
#pragma unroll
    for (int s = 0; s < 2; ++s) {
      bf16x8 bfr[NT], af[MT];
#pragma unroll
      for (int j = 0; j < NT; ++j) bfr[j] = *(const bf16x8*)(sB + lds_byte(wn * NT * 16 + j * 16 + fr, s * 32 + fq * 8));
#pragma unroll
      for (int i = 0; i < MT; ++i) af[i] = *(const bf16x8*)(sA + lds_byte(wm * MT * 16 + i * 16 + fr, s * 32 + fq * 8));
#pragma unroll
      for (int i = 0; i < MT; ++i)
#pragma unroll
        for (int j = 0; j < NT; ++j) acc[i][j] = MFMA16(af[i], bfr[j], acc[i][j]);
    }
    asm volatile("s_waitcnt vmcnt(0)" ::: "memory");
    __syncthreads();
  }
  if (nxtA) {
#pragma unroll
    for (int i = 0; i < MT; ++i) { int R, C; stage_rc(wid * 1024 + i * 4096 + lane * 16, R, C);
      __builtin_amdgcn_global_load_lds((const unsigned*)(nxtA + (unsigned)(R * nlda + C)), (unsigned*)(smem + wid * 1024 + i * 4096), 16, 0, 0); }
#pragma unroll
    for (int i = 0; i < NT; ++i) { int R, C; stage_rc(wid * 1024 + i * 4096 + lane * 16, R, C);
      __builtin_amdgcn_global_load_lds((const unsigned*)(nxtB + (unsigned)(R * nldb + C)), (unsigned*)(smem + TA + wid * 1024 + i * 4096), 16, 0, 0); }
  }
#undef GLDS_STAGE
}

template <int MT, int NT>
DI void gemm_prefetch(const u16* A, int lda, const u16* Bt, int ldb, unsigned char* smem) {
  constexpr int TA = MT * 32 * 128;
  const int tid = ltid(), lane = tid & 63, wid = tid >> 6;
  __syncthreads();
#pragma unroll
  for (int i = 0; i < MT; ++i) { int R, C; stage_rc(wid * 1024 + i * 4096 + lane * 16, R, C);
    __builtin_amdgcn_global_load_lds((const unsigned*)(A + (unsigned)(R * lda + C)), (unsigned*)(smem + wid * 1024 + i * 4096), 16, 0, 0); }
#pragma unroll
  for (int i = 0; i < NT; ++i) { int R, C; stage_rc(wid * 1024 + i * 4096 + lane * 16, R, C);
    __builtin_amdgcn_global_load_lds((const unsigned*)(Bt + (unsigned)(R * ldb + C)), (unsigned*)(smem + TA + wid * 1024 + i * 4096), 16, 0, 0); }
}

template <int MT, int NT> DI void zero_acc(f32x4 (&acc)[MT][NT]) {
#pragma unroll
  for (int i = 0; i < MT; ++i)
#pragma unroll
    for (int j = 0; j < NT; ++j) acc[i][j] = f32x4{0.f, 0.f, 0.f, 0.f};
}

#define EPI_LOOP(MT, NT)                                                          \
  const int tid_ = ltid(), lane_ = tid_ & 63, wave_ = tid_ >> 6;                   \
  const int wm_ = wave_ >> 1, wn_ = wave_ & 1, lq_ = lane_ & 15, quad_ = lane_ >> 4; \
  _Pragma("unroll") for (int i = 0; i < MT; ++i)                                   \
  _Pragma("unroll") for (int j = 0; j < NT; ++j)                                   \
  _Pragma("unroll") for (int r = 0; r < 4; ++r)
#define EPI_ROW(m0, MT) ((m0) + wm_ * (MT) * 16 + i * 16 + quad_ * 4 + r)
#define EPI_COL(n0, NT) ((n0) + wn_ * (NT) * 16 + j * 16 + lq_)

constexpr int GMT = 4;
DI void inproj_item(KP p, int mt, int nt, unsigned char* smem) {
  const int m0 = mt * (GMT * 32), n0 = nt * 128;
  f32x4 acc[GMT][4]; zero_acc<GMT, 4>(acc);
  gemm_acc<GMT, 4>(acc, (const u16*)(p->ws + WS_H) + (size_t)m0 * 1024, 1024, (const u16*)(p->ws + WS_WIN) + (size_t)n0 * 1024, 1024, 1024, smem);
  u16* C = (u16*)(p->ws + WS_INPROJ);
  EPI_LOOP(GMT, 4) { int row = EPI_ROW(m0, GMT), col = EPI_COL(n0, 4); if (col < LDI) C[(size_t)row * LDI + col] = f2bf(acc[i][j][r]); }
}

DI void merge_item(KP p, int l, int mt, int nt, unsigned char* smem) {
  const int m0 = mt * 128, n0 = nt * 128;
  const u16* H = (const u16*)(p->ws + WS_H) + (size_t)m0 * 1024;
  const u16* BR = (const u16*)(p->ws + WS_BRANCH) + (size_t)m0 * 1024;
  const float* bm = p->in[33] + l * 4096;
  const u16* WM = (const u16*)(p->ws + WS_WM) + (size_t)n0 * 1024;
  const u16* WB = (const u16*)(p->ws + WS_WB) + (size_t)n0 * 256;
  unsigned am[4][4][2];
#pragma unroll
  for (int i = 0; i < 4; ++i)
#pragma unroll
    for (int j = 0; j < 4; ++j) { am[i][j][0] = 0u; am[i][j][1] = 0u; }
  gemm_prefetch<4, 4>(BR, 1024, WB, 256, smem);
#pragma unroll 1
  for (int m = 0; m < 4; ++m) {
    f32x4 acc[4][4]; zero_acc<4, 4>(acc);
    gemm_acc<4, 4, true>(acc, BR + m * 256, 1024, WB + (size_t)m * 1024 * 256, 256, 256, smem, H, 1024, WM + (size_t)m * 1024 * 1024, 1024);
    unsigned pp[4][4][2];
#pragma unroll
    for (int i = 0; i < 4; ++i)
#pragma unroll
      for (int j = 0; j < 4; ++j) { pp[i][j][0] = pack2(acc[i][j][0], acc[i][j][1]); pp[i][j][1] = pack2(acc[i][j][2], acc[i][j][3]); }
    zero_acc<4, 4>(acc);
    gemm_acc<4, 4, true>(acc, H, 1024, WM + (size_t)m * 1024 * 1024, 1024, 1024, smem,
                         m < 3 ? BR + (m + 1) * 256 : nullptr, 1024, WB + (size_t)(m + 1) * 1024 * 256, 256);
    {
      const int tid_ = ltid(), wn_ = (tid_ >> 6) & 1, lq_ = tid_ & 15;
      float bias4[4];
#pragma unroll
      for (int j = 0; j < 4; ++j) bias4[j] = bm[m * 1024 + n0 + wn_ * 64 + j * 16 + lq_];
#pragma unroll
      for (int i = 0; i < 4; ++i) {
#pragma unroll
        for (int j = 0; j < 4; ++j) {
          float v0 = bflo(am[i][j][0]) + sigm(acc[i][j][0] + bias4[j]) * bflo(pp[i][j][0]);
          float v1 = bfhi(am[i][j][0]) + sigm(acc[i][j][1] + bias4[j]) * bfhi(pp[i][j][0]);
          float v2 = bflo(am[i][j][1]) + sigm(acc[i][j][2] + bias4[j]) * bflo(pp[i][j][1]);
          float v3 = bfhi(am[i][j][1]) + sigm(acc[i][j][3] + bias4[j]) * bfhi(pp[i][j][1]);
          am[i][j][0] = pack2(v0, v1); am[i][j][1] = pack2(v2, v3);
          asm volatile("" : "+v"(am[i][j][0]), "+v"(am[i][j][1]));
          __builtin_amdgcn_sched_barrier(0);
        }
      }
    }
  }
  u16* C = (u16*)(p->ws + WS_MERGED);
  EPI_LOOP(4, 4) { int row = EPI_ROW(m0, 4), col = EPI_COL(n0, 4); const unsigned w = am[i][j][r >> 1]; C[(size_t)row * 1024 + col] = (u16)((r & 1) ? (w >> 16) : (w & 0xffffu)); }
}

DI void wout_item(KP p, int l, int mt, int nt, unsigned char* smem) {
  const int m0 = mt * (GMT * 32), n0 = nt * 128;
  f32x4 acc[GMT][4]; zero_acc<GMT, 4>(acc);
  gemm_acc<GMT, 4>(acc, (const u16*)(p->ws + WS_MERGED) + (size_t)m0 * 1024, 1024, (const u16*)(p->ws + WS_WO) + (size_t)n0 * 1024, 1024, 1024, smem);
  const float* g1 = (const float*)(p->ws + WS_MOD) + (l * 3 + mod_group(m0)) * 6144 + 2048;
  EPI_LOOP(GMT, 4) { int row = EPI_ROW(m0, GMT), col = EPI_COL(n0, 4); p->out[(size_t)row * DM + col] = x_in_row(p, l, row)[col] + g1[col] * acc[i][j][r]; }
}

DI void w1_item(KP p, int mt, int nt, unsigned char* smem) {
  const int m0 = mt * (GMT * 32), n0 = nt * 128;
  f32x4 acc[GMT][4]; zero_acc<GMT, 4>(acc);
  gemm_acc<GMT, 4>(acc, (const u16*)(p->ws + WS_H) + (size_t)m0 * 1024, 1024, (const u16*)(p->ws + WS_W1) + (size_t)n0 * 1024, 1024, 1024, smem);
  u16* C = (u16*)(p->ws + WS_HIDDEN);
  EPI_LOOP(GMT, 4) { int row = EPI_ROW(m0, GMT), col = EPI_COL(n0, 4); float v = fmaxf(acc[i][j][r], 0.f); C[(size_t)row * 4096 + col] = f2bf(v * v); }
}

DI void w2_item(KP p, int l, int mt, int nt, unsigned char* smem) {
  const int m0 = mt * (GMT * 32), n0 = nt * 128;
  f32x4 acc[GMT][4]; zero_acc<GMT, 4>(acc);
  gemm_acc<GMT, 4>(acc, (const u16*)(p->ws + WS_HIDDEN) + (size_t)m0 * 4096, 4096, (const u16*)(p->ws + WS_W2) + (size_t)n0 * 4096, 4096, 4096, smem);
  const float* g2 = (const float*)(p->ws + WS_MOD) + (l * 3 + mod_group(m0)) * 6144 + 5120;
  EPI_LOOP(GMT, 4) { int row = EPI_ROW(m0, GMT), col = EPI_COL(n0, 4); float* o = p->out + (size_t)row * DM + col; *o = *o + g2[col] * acc[i][j][r]; }
}

DI void prep_load(const u16* R, int lane, float (&hv)[12], float (&vv4)[4]) {
#pragma unroll
  for (int hh = 0; hh < 12; ++hh) {
    const int col = hh < 4 ? C_AQ + hh * 64 : (hh < 6 ? C_AK + (hh - 4) * 64 : (hh < 10 ? C_DQ + (hh - 6) * 64 : C_DK + (hh - 10) * 64));
    hv[hh] = bf2f(R[col + lane]);
  }
  vv4[0] = bf2f(R[C_AV + lane]); vv4[1] = bf2f(R[C_AV + 64 + lane]); vv4[2] = bf2f(R[C_DV + lane]); vv4[3] = bf2f(R[C_DV + 64 + lane]);
}
DI void prep_token(KP p, int l, int row, int lane, u16* R, const float (&hv)[12], const float (&vv4)[4]) {
  const bool lat = row >= 8192;
  float cs = 1.f, sn = 0.f;
  if (lat) {
    int t = (row - 8192) & 4095;
    int pos = (lane < 32) ? (t >> 6) : (t & 63);
    float inv = __expf(-(float)(lane & 15) * (9.210340371976184f / 16.f));
    float ang = (float)pos * inv;
    cs = __cosf(ang); sn = __sinf(ang);
  }
  const int b = row >> 8, t = row & 255;
#pragma unroll
  for (int hh = 0; hh < 12; ++hh) {
    int col; const float* g;
    if (hh < 4) { col = C_AQ + hh * 64; g = p->in[15] + l * 64; }
    else if (hh < 6) { col = C_AK + (hh - 4) * 64; g = p->in[16] + l * 64; }
    else if (hh < 10) { col = C_DQ + (hh - 6) * 64; g = p->in[29] + l * 64; }
    else { col = C_DK + (hh - 10) * 64; g = p->in[30] + l * 64; }
    float v = hv[hh];
    float ss = wave_sum(v * v);
    float y = v * rsqrtf(ss * (1.f / 64.f) + 1e-6f) * g[lane];
    if (lat) {
      float yp = __shfl_xor(y, 16, 64);
      y = ((lane & 31) < 16) ? (y * cs - yp * sn) : (y * cs + yp * sn);
    } else {
      if (hh == 4 || hh == 5) p->out[O_AK + ((size_t)(b * 2 + l) * 256 + t) * 128 + (hh - 4) * 64 + lane] = y;
      if (hh >= 10) p->out[O_DK + ((size_t)(b * 2 + l) * 256 + t) * 128 + (hh - 10) * 64 + lane] = y;
    }
    R[col + lane] = f2bf(y);
  }
  if (lat) {
    const int bl = (row - 8192) >> 12, tl = (row - 8192) & 4095;
    u16* VT = (u16*)(p->ws + WS_VT) + (size_t)lane * 4608 + 512 + tl;
#pragma unroll
    for (int q = 0; q < 4; ++q)
      VT[(size_t)(((q >> 1) * 2 + bl) * 2 + (q & 1)) * 64 * 4608] = f2bf(vv4[q]);
  }
  if (!lat) {
    size_t o = ((size_t)(b * 2 + l) * 256 + t) * 128;
    p->out[O_AV + o + lane] = vv4[0]; p->out[O_AV + o + 64 + lane] = vv4[1];
    p->out[O_DV + o + lane] = vv4[2]; p->out[O_DV + o + 64 + lane] = vv4[3];
  }
}
DI void prep_item(KP p, int l, int item) {
  const int tid = ltid(), lane = tid & 63, wave = tid >> 6;
  const int row0 = item * 8 + wave * 2;
  u16* R0 = (u16*)(p->ws + WS_INPROJ) + (size_t)row0 * LDI;
  u16* R1 = R0 + LDI;
  float hv0[12], vv0[4], hv1[12], vv1[4];
  prep_load(R0, lane, hv0, vv0); prep_load(R1, lane, hv1, vv1);
  prep_token(p, l, row0, lane, R0, hv0, vv0);
  prep_token(p, l, row0 + 1, lane, R1, hv1, vv1);
}

DI void kvc_item(KP p, int l, int item) {
  u16* KC = (u16*)(p->ws + WS_KC);
#pragma unroll
  for (int it = 0; it < 8; ++it) {
    int idx4 = item * 2048 + it * 256 + ltid();
    int e = idx4 * 4;
    int d = e & 63, key = (e >> 6) & 511, sel = e >> 15;
    int kv = sel & 1, kvh = (sel >> 1) & 1, b = (sel >> 2) & 1, mixer = sel >> 3;
    const float* srcb = mixer ? (kv ? p->in[6] : p->in[5]) : (kv ? p->in[4] : p->in[3]);
    const float* src = srcb + ((size_t)((b * 2 + l) * 512 + key) * 2 + kvh) * 64 + d;
    float4 v = *(const float4*)src;
    *(uint2*)(KC + e) = make_uint2(pack2(v.x, v.y), pack2(v.z, v.w));
    if (kv) {
      u16* VT = (u16*)(p->ws + WS_VT) + ((size_t)((mixer * 2 + b) * 2 + kvh) * 64 + d) * 4608 + key;
      VT[0] = f2bf(v.x); VT[4608] = f2bf(v.y); VT[2 * 4608] = f2bf(v.z); VT[3 * 4608] = f2bf(v.w);
    }
  }
}

DI void attn_item(KP p, int l, int it, unsigned char* smem) {
  u16* sK = (u16*)smem;
  u16* sVt = sK + 64 * 72;
  const int tid = ltid(), lane = tid & 63, wave = tid >> 6, lq = lane & 15, quad = lane >> 4;
  int kind, b, qh, qb;
  if (it < 512) { kind = it >> 8; int r = it & 255; b = r >> 7; qh = (r >> 5) & 3; qb = r & 31; }
  else { int r = it - 512; kind = 2 + (r >> 8); r &= 255; b = r >> 3; qh = (r >> 1) & 3; qb = r & 1; }
  const bool isD = (kind == 0 || kind == 3), lat = kind < 2;
  const int seqrow0 = lat ? 8192 + b * 4096 : b * 256;
  const int q0 = qb * 128, kvh = qh >> 1;
  const int qcol = (isD ? C_DQ : C_AQ) + qh * 64, kcol = (isD ? C_DK : C_AK) + kvh * 64, vcol = (isD ? C_DV : C_AV) + kvh * 64;
  const int ocol = (isD ? 768 : 0) + qh * 64;
  const int ncache = lat ? 8 : 0;
  int kt_lo = 0, kt_hi = lat ? 64 : 4;
  if (kind == 1) { kt_lo = max(0, 2 * qb - 2); kt_hi = min(64, 2 * qb + 4); }
  const int ntiles = ncache + kt_hi - kt_lo;
  const bool band = (kind == 1);
  const u16* INP = (const u16*)(p->ws + WS_INPROJ);
  const u16* KCk = (const u16*)(p->ws + WS_KC) + (size_t)((((isD ? 1 : 0) * 2 + b) * 2 + kvh) * 2) * 512 * 64;
  const u16* KCv = KCk + 512 * 64;
  constexpr float SC2 = 0.125f * 1.4426950408889634f;
  const float sinkv = isD ? -1e30f : p->in[17][l * 4 + qh] * 1.4426950408889634f;

  bf16x8 qf[2][2];
#pragma unroll
  for (int nt = 0; nt < 2; ++nt)
#pragma unroll
    for (int s = 0; s < 2; ++s) qf[nt][s] = ld8(INP + (size_t)(seqrow0 + q0 + wave * 32 + nt * 16 + lq) * LDI + qcol + s * 32 + quad * 8);
  float mrun[2], lsum[2];
  f32x4 oacc[4][2];
#pragma unroll
  for (int nt = 0; nt < 2; ++nt) { mrun[nt] = sinkv; lsum[nt] = (!isD && quad == 0) ? 1.f : 0.f; }
#pragma unroll
  for (int dt = 0; dt < 4; ++dt)
#pragma unroll
    for (int nt = 0; nt < 2; ++nt) oacc[dt][nt] = f32x4{0.f, 0.f, 0.f, 0.f};

  const int key = tid >> 2, seg = (tid & 3) * 16;
  struct KVReg { u32x4 k[2], v[2]; };
  KVReg R0, R1;
  const u16* VTp = (const u16*)(p->ws + WS_VT) + ((size_t)(((isD ? 1 : 0) * 2 + b) * 2 + kvh) * 64 + key) * 4608 + seg;
  auto tile_ptrs = [&](int t, const u16*& kp, const u16*& vp) {
    if (t < ncache) { kp = KCk + (size_t)(t * 64 + key) * 64 + seg; vp = VTp + t * 64; }
    else {
      const u16* rowp = INP + (size_t)(seqrow0 + (kt_lo + t - ncache) * 64 + key) * LDI; kp = rowp + kcol + seg;
      vp = lat ? VTp + 512 + (kt_lo + t - ncache) * 64 : rowp + vcol + seg;
    }
  };
  auto kvload = [&](int t, KVReg& R) {
    const u16 *kp, *vp; tile_ptrs(t, kp, vp);
    R.k[0] = *(const u32x4*)kp; R.k[1] = *(const u32x4*)(kp + 8); R.v[0] = *(const u32x4*)vp; R.v[1] = *(const u32x4*)(vp + 8);
  };
  kvload(0, R0);
  if (ntiles > 1) kvload(1, R1);
  auto step = [&](int t, KVReg& R) {
    __syncthreads();
    *(u32x4*)(sK + key * 72 + seg) = R.k[0]; *(u32x4*)(sK + key * 72 + seg + 8) = R.k[1];
    if (lat) {
      *(u32x4*)(sVt + key * 72 + seg) = R.v[0]; *(u32x4*)(sVt + key * 72 + seg + 8) = R.v[1];
    } else {
      unsigned vv[8] = {R.v[0].x, R.v[0].y, R.v[0].z, R.v[0].w, R.v[1].x, R.v[1].y, R.v[1].z, R.v[1].w};
#pragma unroll
      for (int e = 0; e < 8; ++e) { sVt[(seg + 2 * e) * 72 + key] = (u16)(vv[e] & 0xffffu); sVt[(seg + 2 * e + 1) * 72 + key] = (u16)(vv[e] >> 16); }
    }
    __syncthreads();
    if (t + 2 < ntiles) kvload(t + 2, R);
    f32x4 sacc[4][2];
#pragma unroll
    for (int mt = 0; mt < 4; ++mt) {
      sacc[mt][0] = f32x4{0.f, 0.f, 0.f, 0.f}; sacc[mt][1] = f32x4{0.f, 0.f, 0.f, 0.f};
#pragma unroll
      for (int s = 0; s < 2; ++s) {
        bf16x8 ka = ld8(sK + (mt * 16 + lq) * 72 + s * 32 + quad * 8);
        sacc[mt][0] = MFMA16(ka, qf[0][s], sacc[mt][0]);
        sacc[mt][1] = MFMA16(ka, qf[1][s], sacc[mt][1]);
      }
    }
    const bool masked_tile = band && t >= ncache;
    const int kbase = (kt_lo + t - ncache) * 64;
    bf16x8 pf[2][2];
#pragma unroll
    for (int nt = 0; nt < 2; ++nt) {
      const int qi = q0 + wave * 32 + nt * 16 + lq;
      float tmax = -1e30f;
#pragma unroll
      for (int mt = 0; mt < 4; ++mt)
#pragma unroll
        for (int r = 0; r < 4; ++r) {
          float sv_ = sacc[mt][nt][r] * SC2;
          if (masked_tile) { int kj = kbase + mt * 16 + quad * 4 + r; int dlt = qi - kj; if (dlt > 128 || dlt < -128) sv_ = -1e30f; }
          sacc[mt][nt][r] = sv_; tmax = fmaxf(tmax, sv_);
        }
      tmax = fmaxf(tmax, __shfl_xor(tmax, 16, 64)); tmax = fmaxf(tmax, __shfl_xor(tmax, 32, 64));
      const float mold = mrun[nt];
      const float mnew = fmaxf(mold, tmax);
      float ps = 0.f;
#pragma unroll
      for (int mt = 0; mt < 4; ++mt)
#pragma unroll
        for (int r = 0; r < 4; ++r) { float e = __builtin_amdgcn_exp2f(sacc[mt][nt][r] - mnew); sacc[mt][nt][r] = e; ps += e; }
      if (__any(mnew != mold)) {
        const float alpha = __builtin_amdgcn_exp2f(mold - mnew);
        lsum[nt] *= alpha;
#pragma unroll
        for (int dt = 0; dt < 4; ++dt)
#pragma unroll
          for (int r = 0; r < 4; ++r) oacc[dt][nt][r] *= alpha;
      }
      lsum[nt] += ps; mrun[nt] = mnew;
      pf[nt][0] = pack8(sacc[0][nt], sacc[1][nt]);
      pf[nt][1] = pack8(sacc[2][nt], sacc[3][nt]);
    }
#pragma unroll
    for (int dt = 0; dt < 4; ++dt)
#pragma unroll
      for (int s2 = 0; s2 < 2; ++s2) {
        bf16x8 va = ldperm(sVt + (dt * 16 + lq) * 72 + s2 * 32 + quad * 4);
        oacc[dt][0] = MFMA16(va, pf[0][s2], oacc[dt][0]);
        oacc[dt][1] = MFMA16(va, pf[1][s2], oacc[dt][1]);
      }
  };
  for (int t = 0; t < ntiles; t += 2) { step(t, R0); if (t + 1 < ntiles) step(t + 1, R1); }
  u16* BR = (u16*)(p->ws + WS_BRANCH);
#pragma unroll
  for (int nt = 0; nt < 2; ++nt) {
    float lt = lsum[nt]; lt += __shfl_xor(lt, 16, 64); lt += __shfl_xor(lt, 32, 64);
    const float inv = 1.f / lt;
    const size_t row = seqrow0 + q0 + wave * 32 + nt * 16 + lq;
#pragma unroll
    for (int dt = 0; dt < 4; ++dt)
      *(uint2*)(BR + row * 1024 + ocol + dt * 16 + quad * 4) = make_uint2(pack2(oacc[dt][nt][0] * inv, oacc[dt][nt][1] * inv), pack2(oacc[dt][nt][2] * inv, oacc[dt][nt][3] * inv));
  }
  __syncthreads();
}

DI int lru_xoff(int t, int c) { return t * 256 + (c ^ ((t & 7) << 3)); }
template <bool FINAL>
DI void lru_item(KP p, int l, int ci, unsigned char* smem) {
  u16* sxb = (u16*)smem;
  u16* sla = sxb + 32 * 256;
  u16* sbv = sla + 32 * 256;
  u16* shf = sbv + 32 * 256;
  const int tid = ltid(), ch = tid, lane = tid & 63, n = tid >> 6, lq = lane & 15, quad = lane >> 4;
  const int r0 = ci * 32;
  const bool lat = r0 >= 8192;
  int b, T, seqrow0;
  if (!lat) { b = r0 >> 8; T = 256; seqrow0 = b * 256; } else { b = (r0 - 8192) >> 12; T = 4096; seqrow0 = 8192 + b * 4096; }
  const int t0 = r0 - seqrow0;
  const u16* INP = (const u16*)(p->ws + WS_INPROJ);
  __syncthreads();
  {
    const float* cw = p->in[18] + l * 4 * 256;
    const float w0 = cw[ch], w1 = cw[256 + ch], w2 = cw[512 + ch], w3 = cw[768 + ch], cb = p->in[19][l * 256 + ch];
    auto ld = [&](int t) -> float { return (t >= 0 && t < T) ? bf2f(INP[(size_t)(seqrow0 + t) * LDI + C_LX + ch]) : 0.f; };
    float xin[35];
#pragma unroll
    for (int q = 0; q < 35; ++q) xin[q] = ld(t0 - 2 + q);
#pragma unroll
    for (int t = 0; t < 32; ++t) sxb[lru_xoff(t, ch)] = f2bf(xin[t] * w0 + xin[t + 1] * w1 + xin[t + 2] * w2 + xin[t + 3] * w3 + cb);
  }
  __syncthreads();
  const int nch = T / 32, c = t0 / 32;
  float* LC = (float*)(p->ws + WS_LRUC);
  bf16x8 af[2][2];
#pragma unroll
  for (int mt = 0; mt < 2; ++mt)
#pragma unroll
    for (int s2 = 0; s2 < 2; ++s2) af[mt][s2] = ld8(sxb + lru_xoff(mt * 16 + lq, n * 64 + s2 * 32 + quad * 8));
  for (int dir = 0; dir < 2; ++dir) {
    bf16x8 wf[2][4][2];
    {
      const u32x4* WF = (const u32x4*)(p->ws + WS_LRUW);
#pragma unroll
      for (int g = 0; g < 2; ++g)
#pragma unroll
        for (int j = 0; j < 4; ++j)
#pragma unroll
          for (int s2 = 0; s2 < 2; ++s2)
            wf[g][j][s2] = __builtin_bit_cast(bf16x8, WF[(size_t)((((((l * 2 + dir) * 2 + g) * 4 + n) * 4 + j) * 2 + s2)) * 64 + lane]);
    }
#pragma unroll
    for (int j = 0; j < 4; ++j) {
      f32x4 acc[2][2];
#pragma unroll
      for (int g = 0; g < 2; ++g) {
        f32x4 a0 = {0.f, 0.f, 0.f, 0.f}, a1 = {0.f, 0.f, 0.f, 0.f};
#pragma unroll
        for (int s2 = 0; s2 < 2; ++s2) { a0 = MFMA16(af[0][s2], wf[g][j][s2], a0); a1 = MFMA16(af[1][s2], wf[g][j][s2], a1); }
        acc[g][0] = a0; acc[g][1] = a1;
      }
      const int cc = n * 64 + j * 16 + lq;
      const float br = p->in[21][(l * 2 + dir) * 256 + cc], bi = p->in[23][(l * 2 + dir) * 256 + cc];
      const float sp = softplusf_(-p->in[24][(l * 2 + dir) * 256 + cc]);
#pragma unroll
      for (int mt = 0; mt < 2; ++mt)
#pragma unroll
        for (int r = 0; r < 4; ++r) {
          const int t = mt * 16 + quad * 4 + r;
          const float la = -8.f * sigm(acc[0][mt][r] + br) * sp;
          const float xt = bf2f(sxb[lru_xoff(t, cc)]);
          const float bb = sqrtf(-expm1f(2.f * la)) * sigm(acc[1][mt][r] + bi) * xt;
          sla[t * 256 + cc] = f2bf(la); sbv[t * 256 + cc] = f2bf(bb);
        }
    }
    __syncthreads();
    float h = 0.f, lasum = 0.f;
    if (FINAL) {
      h = lat ? p->in[7][((b * 2 + l) * 2 + dir) * 256 + ch] : 0.f;
      const int ncar = dir == 0 ? c : nch - 1 - c;
      const int cstart = dir == 0 ? ci - c : ci - c + nch - 1, cstep = dir == 0 ? 1 : -1;
      for (int q0 = 0; q0 < ncar; q0 += 16) {
        float ca[16], chh[16];
#pragma unroll
        for (int q = 0; q < 16; ++q) {
          const int qq = q0 + q < ncar ? q0 + q : ncar - 1;
          const float* C = LC + ((size_t)((cstart + cstep * qq) * 2 + dir) * 2) * 256;
          ca[q] = C[ch]; chh[q] = C[256 + ch];
        }
#pragma unroll
        for (int q = 0; q < 16; ++q) if (q0 + q < ncar) h = ca[q] * h + chh[q];
      }
    }
#pragma unroll 1
    for (int s8 = 0; s8 < 32; s8 += 16) {
      float gv[16];
      if (FINAL && dir == 1) {
#pragma unroll
        for (int q = 0; q < 16; ++q) gv[q] = bf2f(INP[(size_t)(r0 + 31 - s8 - q) * LDI + C_LG + ch]);
      }
#pragma unroll
      for (int q = 0; q < 16; ++q) {
        const int st = s8 + q;
        const int t = dir == 0 ? st : 31 - st;
        const float la = bf2f(sla[t * 256 + ch]);
        h = __expf(la) * h + bf2f(sbv[t * 256 + ch]);
        lasum += la;
        if (FINAL) {
          if (dir == 0) shf[t * 256 + ch] = f2bf(h);
          else ((u16*)(p->ws + WS_BRANCH))[(size_t)(r0 + t) * 1024 + 256 + ch] = f2bf((bf2f(shf[t * 256 + ch]) + h) * gelu_tanh(gv[q]));
        }
      }
    }
    if (!FINAL) { float* C = LC + ((size_t)(ci * 2 + dir) * 2) * 256; C[ch] = __expf(lasum); C[256 + ch] = h; }
    else if (!lat) {
      if (dir == 0 && c == nch - 1) p->out[O_LRU + ((size_t)(b * 2 + l) * 2 + 0) * 256 + ch] = h;
      if (dir == 1 && c == 0) p->out[O_LRU + ((size_t)(b * 2 + l) * 2 + 1) * 256 + ch] = h;
    }
    __syncthreads();
  }
}

template <int DIR, bool ISW>
DI void gdn_solve(const float* L, const u16* src, const float* sb_, const float* se_, u16* UW) {
  float sol[64];
#pragma unroll
  for (int i = 0; i < 64; ++i) {
    float s = bf2f(src[(DIR == 0 ? i : 63 - i) * 72]) * sb_[i];
    if (ISW) s *= se_[i];
    float s0 = 0.f, s1 = 0.f, s2 = 0.f, s3 = 0.f;
#pragma unroll
    for (int j4 = 0; j4 < (i + 3) / 4; ++j4) {
      float4 lv = *(const float4*)(L + i * 64 + j4 * 4);
      if (j4 * 4 + 0 < i) s0 += lv.x * sol[j4 * 4 + 0];
      if (j4 * 4 + 1 < i) s1 += lv.y * sol[j4 * 4 + 1];
      if (j4 * 4 + 2 < i) s2 += lv.z * sol[j4 * 4 + 2];
      if (j4 * 4 + 3 < i) s3 += lv.w * sol[j4 * 4 + 3];
      if ((j4 & 3) == 3) asm volatile("" ::: "memory");
    }
    s -= (s0 + s1) + (s2 + s3);
    sol[i] = s;
    UW[i * 128] = f2bf(s);
    asm volatile("" ::: "memory");
  }
}

DI void gdn1_item(KP p, int l, int item, unsigned char* smem) {
  const int cgi = item >> 2, hd = item & 3;
  u16* sq = (u16*)smem; u16* sk = sq + 64 * 72; u16* sv = sk + 64 * 72;
  float* sL = (float*)(smem + 27648);
  float* sgc = (float*)(smem + 60416);
  float* sbeta = sgc + 128;
  float* sge = sbeta + 128;
  const int tid = ltid(), lane = tid & 63, wave = tid >> 6, lq = lane & 15, quad = lane >> 4;
  const int r0 = cgi * 64;
  const bool lat = r0 >= 8192;
  int T, seqrow0;
  if (!lat) { T = 256; seqrow0 = (r0 >> 8) * 256; } else { T = 4096; seqrow0 = 8192 + ((r0 - 8192) >> 12) * 4096; }
  const int t0 = r0 - seqrow0;
  const u16* INP = (const u16*)(p->ws + WS_INPROJ);
  u16* QHAT = (u16*)(p->ws + WS_QHAT) + (size_t)item * 4096;
  {
    const int d = lane, tb = wave * 16;
#pragma unroll
    for (int mat = 0; mat < 3; ++mat) {
      const int col = C_GQ + mat * 256 + hd * 64 + d, wc = mat * 256 + hd * 64 + d;
      const float* cw = p->in[25] + (size_t)l * 4 * 768;
      const float w0 = cw[wc], w1 = cw[768 + wc], w2 = cw[1536 + wc], w3 = cw[2304 + wc];
      auto ld = [&](int t) -> float { return (t >= 0 && t < T) ? bf2f(INP[(size_t)(seqrow0 + t) * LDI + col]) : 0.f; };
      float xin[19];
#pragma unroll
      for (int q = 0; q < 19; ++q) xin[q] = ld(t0 + tb - 2 + q);
      u16* dst = mat == 0 ? sq : (mat == 1 ? sk : sv);
#pragma unroll
      for (int tt = 0; tt < 16; ++tt) {
        const int t = tb + tt;
        float v = siluf_(xin[tt] * w0 + xin[tt + 1] * w1 + xin[tt + 2] * w2 + xin[tt + 3] * w3);
        if (mat < 2) { float ss = wave_sum(v * v); v *= rsqrtf(ss + 1e-6f) * (mat == 0 ? 0.125f : 1.f); }
        u16 hb = f2bf(v);
        dst[t * 72 + d] = hb;
        if (mat == 0) QHAT[t * 64 + d] = hb;
      }
    }
  }
  if (tid < 128) {
    const int dir = tid >> 6, c = tid & 63;
    const int tok = dir == 0 ? c : 63 - c;
    const u16* R = INP + (size_t)(r0 + tok) * LDI;
    const float ga = bf2f(R[C_GA + dir * 4 + hd]), gb = bf2f(R[C_GB + dir * 4 + hd]);
    const float g = -__expf(p->in[26][(l * 2 + dir) * 4 + hd]) * softplusf_(ga + p->in[27][(l * 2 + dir) * 4 + hd]);
    float gc = g;
#pragma unroll
    for (int o = 1; o < 64; o <<= 1) { float tt = __shfl_up(gc, o, 64); if (lane >= o) gc += tt; }
    const float glast = __shfl(gc, 63, 64);
    sgc[dir * 64 + c] = gc; sbeta[dir * 64 + c] = sigm(gb); sge[dir * 64 + c] = __expf(gc);
    float* gv = (float*)(p->ws + WS_GVEC) + (size_t)(item * 2 + dir) * 256;
    gv[c] = __expf(gc); gv[64 + c] = __expf(glast - gc); if (c == 0) gv[128] = __expf(glast);
  }
  __syncthreads();
  {
    const int dk = tid >> 2, c0 = (tid & 3) * 16;
    unsigned w[8];
#pragma unroll
    for (int e = 0; e < 8; ++e) w[e] = (unsigned)sk[(c0 + 2 * e) * 72 + dk] | ((unsigned)sk[(c0 + 2 * e + 1) * 72 + dk] << 16);
    u16* KT = (u16*)(p->ws + WS_KT) + (size_t)item * 4096 + dk * 64 + c0;
    *(u32x4*)KT = mku4(w[0], w[1], w[2], w[3]); *(u32x4*)(KT + 8) = mku4(w[4], w[5], w[6], w[7]);
  }
  {
    const int i0 = wave * 16;
    f32x4 akk[4], aqk[4];
#pragma unroll
    for (int nt = 0; nt < 4; ++nt) { akk[nt] = f32x4{0.f, 0.f, 0.f, 0.f}; aqk[nt] = f32x4{0.f, 0.f, 0.f, 0.f}; }
#pragma unroll
    for (int s = 0; s < 2; ++s) {
      bf16x8 ak = ld8(sk + (i0 + lq) * 72 + s * 32 + quad * 8), aq = ld8(sq + (i0 + lq) * 72 + s * 32 + quad * 8);
#pragma unroll
      for (int nt = 0; nt < 4; ++nt) { bf16x8 bk = ld8(sk + (nt * 16 + lq) * 72 + s * 32 + quad * 8); akk[nt] = MFMA16(ak, bk, akk[nt]); aqk[nt] = MFMA16(aq, bk, aqk[nt]); }
    }
    u16* QKf = (u16*)(p->ws + WS_QK) + (size_t)(item * 2 + 0) * 4096;
    u16* QKb = (u16*)(p->ws + WS_QK) + (size_t)(item * 2 + 1) * 4096;
#pragma unroll
    for (int nt = 0; nt < 4; ++nt)
#pragma unroll
      for (int r = 0; r < 4; ++r) {
        const int i = i0 + quad * 4 + r, j = nt * 16 + lq, ib = 63 - i, jb = 63 - j;
        const float kkv = akk[nt][r], qkv = aqk[nt][r];
        if (j < i) sL[i * 64 + j] = sbeta[i] * kkv * __expf(sgc[i] - sgc[j]);
        if (j > i) sL[4096 + ib * 64 + jb] = sbeta[64 + ib] * kkv * __expf(sgc[64 + ib] - sgc[64 + jb]);
        QKf[i * 64 + j] = f2bf(j <= i ? qkv * __expf(sgc[i] - sgc[j]) : 0.f);
        QKb[ib * 64 + jb] = f2bf(j >= i ? qkv * __expf(sgc[64 + ib] - sgc[64 + jb]) : 0.f);
      }
  }
  __syncthreads();
  {
    const int col = tid & 127;
    u16* UW = (u16*)(p->ws + WS_UW) + (size_t)(item * 2 + (tid >> 7)) * 8192 + col;
    for (int rep = 0; rep < NREP(2); ++rep) {
    if (tid < 128) { if (col < 64) gdn_solve<0, false>(sL, sv + col, sbeta, sge, UW); else gdn_solve<0, true>(sL, sk + (col - 64), sbeta, sge, UW); }
    else { if (col < 64) gdn_solve<1, false>(sL + 4096, sv + col, sbeta + 64, sge + 64, UW); else gdn_solve<1, true>(sL + 4096, sk + (col - 64), sbeta + 64, sge + 64, UW); }
    }
  }
  __syncthreads();
}

DI void gdn2_item(KP p, int l, int item, unsigned char* smem) {
  u16* sW = (u16*)smem; u16* sKT = sW + 64 * 72; u16* sU = sKT + 64 * 72;
  float* sg = (float*)(smem + 27648);
  const int tid = ltid(), lane = tid & 63, wave = tid >> 6, lq = lane & 15, quad = lane >> 4;
  int b, hd, dir; bool lat;
  if (item < 16) { lat = true; b = item >> 3; hd = (item >> 1) & 3; dir = item & 1; }
  else { lat = false; int r = item - 16; b = r >> 3; hd = (r >> 1) & 3; dir = r & 1; }
  const int nch = lat ? 64 : 4, cg0 = lat ? 128 + b * 64 : b * 4;
  f32x4 st[4];
#pragma unroll
  for (int kt = 0; kt < 4; ++kt)
#pragma unroll
    for (int r = 0; r < 4; ++r)
      st[kt][r] = lat ? p->in[8][((size_t)(((b * 2 + l) * 2 + dir) * 4 + hd) * 64 + kt * 16 + quad * 4 + r) * 64 + wave * 16 + lq] : 0.f;
  const int lrow = tid >> 2, seg = (tid & 3) * 16;
  struct GReg { u32x4 U[2], W[2], KT[2]; float g; };
  GReg R0, R1;
  u16* UWb = (u16*)(p->ws + WS_UW);
  const u16* KTb = (const u16*)(p->ws + WS_KT);
  const float* GV = (const float*)(p->ws + WS_GVEC);
  auto gload = [&](int n, GReg& R) {
    const int cgi = dir == 0 ? cg0 + n : cg0 + nch - 1 - n;
    const size_t prob = (size_t)cgi * 4 + hd, pd = prob * 2 + dir;
    const u16* u = UWb + (pd * 64 + lrow) * 128 + seg;
    R.U[0] = *(const u32x4*)u; R.U[1] = *(const u32x4*)(u + 8); R.W[0] = *(const u32x4*)(u + 64); R.W[1] = *(const u32x4*)(u + 72);
    const u16* kt = KTb + (prob * 64 + lrow) * 64 + (dir ? 48 - seg : seg);
    u32x4 a = *(const u32x4*)kt, bb = *(const u32x4*)(kt + 8);
    if (dir) { R.KT[0] = rev8(bb); R.KT[1] = rev8(a); } else { R.KT[0] = a; R.KT[1] = bb; }
    R.g = GV[pd * 256 + (tid & 255)];
  };
  gload(0, R0); gload(1, R1);
  auto step = [&](int n, GReg& R) {
    const int cgi = dir == 0 ? cg0 + n : cg0 + nch - 1 - n;
    const size_t pd = ((size_t)cgi * 4 + hd) * 2 + dir;
    __syncthreads();
    *(u32x4*)(sW + lrow * 72 + seg) = R.W[0]; *(u32x4*)(sW + lrow * 72 + seg + 8) = R.W[1];
    *(u32x4*)(sKT + lrow * 72 + seg) = R.KT[0]; *(u32x4*)(sKT + lrow * 72 + seg + 8) = R.KT[1];
    *(u32x4*)(sU + lrow * 72 + seg) = R.U[0]; *(u32x4*)(sU + lrow * 72 + seg + 8) = R.U[1];
    sg[tid] = R.g;
    __syncthreads();
    if (n + 2 < nch) gload(n + 2, R);
    u32x4* FR = (u32x4*)(UWb + pd * 8192);
    const float elast = sg[128];
    bf16x8 sB[2] = {pack8(st[0], st[1]), pack8(st[2], st[3])};
    FR[(0 * 4 + wave) * 64 + lane] = __builtin_bit_cast(u32x4, sB[0]);
    FR[(1 * 4 + wave) * 64 + lane] = __builtin_bit_cast(u32x4, sB[1]);
    f32x4 vn[4];
#pragma unroll
    for (int mt = 0; mt < 4; ++mt) {
      f32x4 acc = {0.f, 0.f, 0.f, 0.f};
#pragma unroll
      for (int s2 = 0; s2 < 2; ++s2) acc = MFMA16(ldperm(sW + (mt * 16 + lq) * 72 + s2 * 32 + quad * 4), sB[s2], acc);
#pragma unroll
      for (int r = 0; r < 4; ++r) vn[mt][r] = bf2f(sU[(mt * 16 + quad * 4 + r) * 72 + wave * 16 + lq]) - acc[r];
    }
    bf16x8 vB[2] = {pack8(vn[0], vn[1]), pack8(vn[2], vn[3])};
    FR[512 + (0 * 4 + wave) * 64 + lane] = __builtin_bit_cast(u32x4, vB[0]);
    FR[512 + (1 * 4 + wave) * 64 + lane] = __builtin_bit_cast(u32x4, vB[1]);
#pragma unroll
    for (int mt = 0; mt < 4; ++mt)
#pragma unroll
      for (int r = 0; r < 4; ++r) vn[mt][r] *= sg[64 + mt * 16 + quad * 4 + r];
    bf16x8 vsB[2] = {pack8(vn[0], vn[1]), pack8(vn[2], vn[3])};
#pragma unroll
    for (int kt = 0; kt < 4; ++kt) {
      f32x4 acc = {0.f, 0.f, 0.f, 0.f};
#pragma unroll
      for (int s2 = 0; s2 < 2; ++s2) acc = MFMA16(ldperm(sKT + (kt * 16 + lq) * 72 + s2 * 32 + quad * 4), vsB[s2], acc);
#pragma unroll
      for (int r = 0; r < 4; ++r) st[kt][r] = elast * st[kt][r] + acc[r];
    }
  };
  for (int n = 0; n < nch; n += 2) { step(n, R0); step(n + 1, R1); }
  if (!lat) {
#pragma unroll
    for (int kt = 0; kt < 4; ++kt)
#pragma unroll
      for (int r = 0; r < 4; ++r)
        p->out[O_GDN + ((size_t)(((b * 2 + l) * 2 + dir) * 4 + hd) * 64 + kt * 16 + quad * 4 + r) * 64 + wave * 16 + lq] = st[kt][r];
  }
  __syncthreads();
}

DI void gdnfin_item(KP p, int l, int item, unsigned char* smem) {
  u16* sQ = (u16*)smem; u16* sQK = sQ + 64 * 72;
  float* so = (float*)(smem + 3 * 64 * 72 * 2);
  float* seg_ = so + 64 * 65;
  const int cgi = item >> 2, hd = item & 3;
  const int tid = ltid(), lane = tid & 63, wave = tid >> 6, lq = lane & 15, quad = lane >> 4;
  const int lrow = tid >> 2, seg = (tid & 3) * 16;
  __syncthreads();
  {
    const u16* q = (const u16*)(p->ws + WS_QHAT) + ((size_t)item * 64 + lrow) * 64 + seg;
    *(u32x4*)(sQ + lrow * 72 + seg) = *(const u32x4*)q; *(u32x4*)(sQ + lrow * 72 + seg + 8) = *(const u32x4*)(q + 8);
#pragma unroll
    for (int dir = 0; dir < 2; ++dir) {
      const u16* qk = (const u16*)(p->ws + WS_QK) + ((size_t)(item * 2 + dir) * 64 + lrow) * 64 + seg;
      *(u32x4*)(sQK + (dir * 64 + lrow) * 72 + seg) = *(const u32x4*)qk; *(u32x4*)(sQK + (dir * 64 + lrow) * 72 + seg + 8) = *(const u32x4*)(qk + 8);
    }
    if (tid < 128) seg_[tid] = ((const float*)(p->ws + WS_GVEC))[(size_t)(item * 2 + (tid >> 6)) * 256 + (tid & 63)];
  }
  __syncthreads();
#pragma unroll
  for (int dir = 0; dir < 2; ++dir) {
    const u32x4* FR = (const u32x4*)((const u16*)(p->ws + WS_UW) + (size_t)(item * 2 + dir) * 8192);
    bf16x8 sfr[2], vfr[2];
#pragma unroll
    for (int s2 = 0; s2 < 2; ++s2) {
      sfr[s2] = __builtin_bit_cast(bf16x8, FR[(s2 * 4 + wave) * 64 + lane]);
      vfr[s2] = __builtin_bit_cast(bf16x8, FR[512 + (s2 * 4 + wave) * 64 + lane]);
    }
#pragma unroll
    for (int mt = 0; mt < 4; ++mt) {
      f32x4 acc = {0.f, 0.f, 0.f, 0.f};
      const int qrow = dir ? 63 - (mt * 16 + lq) : mt * 16 + lq;
#pragma unroll
      for (int s2 = 0; s2 < 2; ++s2) acc = MFMA16(ldperm(sQ + qrow * 72 + s2 * 32 + quad * 4), sfr[s2], acc);
#pragma unroll
      for (int r = 0; r < 4; ++r) acc[r] *= seg_[dir * 64 + mt * 16 + quad * 4 + r];
#pragma unroll
      for (int s2 = 0; s2 < 2; ++s2) acc = MFMA16(ldperm(sQK + (dir * 64 + mt * 16 + lq) * 72 + s2 * 32 + quad * 4), vfr[s2], acc);
#pragma unroll
      for (int r = 0; r < 4; ++r) {
        const int c = mt * 16 + quad * 4 + r;
        const int tk = dir ? 63 - c : c;
        float* d = so + tk * 65 + wave * 16 + lq;
        if (dir == 0) *d = acc[r]; else *d += acc[r];
      }
    }
    __syncthreads();
  }
  const float gn = p->in[28][l * 64 + lane];
  float zv[16];
#pragma unroll
  for (int q = 0; q < 16; ++q)
    zv[q] = bf2f(((const u16*)(p->ws + WS_INPROJ))[((size_t)cgi * 64 + wave * 16 + q) * LDI + C_GZ + hd * 64 + lane]);
#pragma unroll
  for (int q = 0; q < 16; ++q) {
    const int c = wave * 16 + q;
    const size_t row = (size_t)cgi * 64 + c;
    float o = so[c * 65 + lane];
    float ss = wave_sum(o * o);
    float y = o * rsqrtf(ss * (1.f / 64.f) + 1e-6f) * gn * siluf_(zv[q]);
    ((u16*)(p->ws + WS_BRANCH))[row * 1024 + 512 + hd * 64 + lane] = f2bf(y);
  }
}

#define XB_TMO      128
#define XB_XCNT(j)  (256  + 64 * (j))
#define XB_XSUB(j)  (1280 + 64 * (j))
#define XB_XGEN(j)  (2304 + 64 * (j))
#define XB_TOP      3328
#define XB_TOPGEN   3392
#define XB_SPIN_CAP (1u << 20)
#define LAS __attribute__((address_space(3)))
DI unsigned xb_ld(unsigned* q) { return __hip_atomic_load(q, __ATOMIC_RELAXED, __HIP_MEMORY_SCOPE_AGENT); }
DI unsigned xb_add(unsigned* q, unsigned v) { return __hip_atomic_fetch_add(q, v, __ATOMIC_RELAXED, __HIP_MEMORY_SCOPE_AGENT); }
DI unsigned xb_xcc_id() { return (unsigned)__builtin_amdgcn_s_getreg((3 << 11) | 20) & 0xFu; }
#define XB_SPIN(cond, bar) do { unsigned _sp = 0; while (cond) { __builtin_amdgcn_s_sleep(1); \
    if ((++_sp & 255u) == 0u) { if (xb_ld(&(bar)[XB_TMO])) break; if (_sp > XB_SPIN_CAP) { atomicAdd(&(bar)[XB_TMO], 1u); break; } } } } while (0)
DI void xcd_barrier_complete(unsigned* bar, unsigned x, unsigned& nloc, unsigned& nx) {
  const unsigned G = gridDim.x;
  unsigned sum, cnt, mine, sp = 0u;
  for (;;) {
    sum = 0u; cnt = 0u; mine = 0u;
#pragma unroll
    for (unsigned j = 0; j < 16; ++j) { const unsigned c = xb_ld(&bar[XB_XCNT(j)]); sum += c; cnt += (c > 0u) ? 1u : 0u; mine = (j == x) ? c : mine; }
    if (sum == G) break;
    __builtin_amdgcn_s_sleep(1);
    if ((++sp & 255u) == 0u) { if (xb_ld(&bar[XB_TMO])) break; if (sp > XB_SPIN_CAP) { atomicAdd(&bar[XB_TMO], 1u); break; } }
  }
  nloc = mine > 0u ? mine : 1u; nx = cnt > 0u ? cnt : 1u;
}
DI void xcd_barrier(unsigned* bar, volatile LAS unsigned* st) {
  asm volatile("s_waitcnt vmcnt(0)" ::: "memory");
  __syncthreads();
  if (ltid() == 0) {
    const unsigned x = xb_xcc_id();
    __builtin_amdgcn_s_waitcnt(0);
    unsigned nloc = st[0], nx = st[1];
    if (nloc == 0u) { xcd_barrier_complete(bar, x, nloc, nx); st[0] = nloc; st[1] = nx; }
    const unsigned old = xb_add(&bar[XB_XSUB(x)], 1u);
    const unsigned gen = old / nloc;
    if (old + 1u == (gen + 1u) * nloc) {
      __builtin_amdgcn_fence(__ATOMIC_RELEASE, "agent");
      asm volatile("s_waitcnt vmcnt(0)" ::: "memory");
      const unsigned og = xb_add(&bar[XB_TOP], 1u);
      const unsigned tg = og / nx;
      if (og + 1u == (tg + 1u) * nx) xb_add(&bar[XB_TOPGEN], 1u);
      else XB_SPIN(xb_ld(&bar[XB_TOPGEN]) == tg, bar);
      __builtin_amdgcn_fence(__ATOMIC_ACQUIRE, "agent");
      xb_add(&bar[XB_XGEN(x)], 1u);
      asm volatile("s_waitcnt vmcnt(0)" ::: "memory");
    } else {
      XB_SPIN(xb_ld(&bar[XB_XGEN(x)]) == gen, bar);
      __builtin_amdgcn_fence(__ATOMIC_ACQUIRE, "agent");
      asm volatile("s_waitcnt vmcnt(0)" ::: "memory");
    }
  }
  __syncthreads();
}


#define FOR_TILES(MTI, NTI, SM, SN, CALL)                                                      \
  do {                                                                                         \
    if (G % 8 != 0) { for (int it_ = B; it_ < (MTI) * (NTI); it_ += G) { const int mt = it_ / (NTI), nt = it_ % (NTI); CALL; } } \
    else {                                                                                     \
      const int xcd_ = B & 7, j_ = B >> 3, J_ = G >> 3;                                        \
      const int nsm_ = ((MTI) + (SM) - 1) / (SM), nsn_ = ((NTI) + (SN) - 1) / (SN);            \
      for (int s_ = xcd_; s_ < nsm_ * nsn_; s_ += 8) {                                         \
        const int sm_ = s_ / nsn_, sn_ = s_ % nsn_;                                            \
        for (int t_ = j_; t_ < (SM) * (SN); t_ += J_) {                                        \
          const int mt = sm_ * (SM) + t_ / (SN), nt = sn_ * (SN) + t_ % (SN);                  \
          if (mt < (MTI) && nt < (NTI)) { CALL; }                                              \
        }                                                                                      \
      }                                                                                        \
    }                                                                                          \
  } while (0)

constexpr int NPHASE = 21;
__global__ void __launch_bounds__(256, 2) mk(Params p_unused, int ph_lo, int ph_hi) {
  extern __shared__ __attribute__((aligned(1024))) unsigned char smem[];
  int& s_item = *(int*)(smem + SMEM_BYTES);
  u32x4& xb_words = *(u32x4*)(smem + SMEM_BYTES + 16);
  const int G = gridDim.x, B = blockIdx.x;
  const bool fused = ph_hi - ph_lo > 1;
  if (fused) {
    if (ltid() == 0) { xb_words = u32x4{0u, 0u, 0u, 0u}; (void)xb_add(&((unsigned*)(((KP)__builtin_amdgcn_kernarg_segment_ptr())->ws + WS_BAR))[XB_XCNT(xb_xcc_id())], 1u); }
    __syncthreads();
  }
  for (int ph = ph_lo; ph < ph_hi; ++ph) {
    KP p = (KP)__builtin_amdgcn_kernarg_segment_ptr();
    asm volatile("" : "+s"(p));
    if (ph == 0) {
      for (int it = B; it < 192 + CONV_ITEMS + 64; it += G) { for (int rep = 0; rep < NREP(0); ++rep) { if (it < 192) mod_item(p, it, smem); else if (it < 192 + CONV_ITEMS) convert_item(p, 0, it - 192, smem); else lruw_item(p, it - 192 - CONV_ITEMS); } }
    } else {
      const int l = (ph - 1) / 10, sub = (ph - 1) % 10;
      switch (sub) {
        case 0:
          for (int it = B; it < 2048 + (l ? CONV_ITEMS : 0); it += G) { if (it < 2048) norm_item<0>(p, l, it); else convert_item(p, l, it - 2048, smem); }
          break;
        case 1: FOR_TILES(128, 21, 8, 7, inproj_item(p, mt, nt, smem)); break;
        case 2:
          for (int it = B; it < 1024 + 512 + 64 + 2048; it += G) {
            if (it < 1024) { for (int rep = 0; rep < NREP(4); ++rep) gdn1_item(p, l, it, smem); }
            else if (it < 1536) { for (int rep = 0; rep < NREP(5); ++rep) lru_item<false>(p, l, it - 1024, smem); }
            else if (it < 1600) { if (PHON(6)) kvc_item(p, l, it - 1536); }
            else if (PHON(6)) prep_item(p, l, it - 1600);
          }
          break;
        case 3: {
          int* ctr = (int*)(p->ws + WS_CTR) + l;
          for (;;) {
            __syncthreads();
            if (ltid() == 0) s_item = atomicAdd(ctr, 1);
            __syncthreads();
            const int it = s_item;
            if (it >= 16 + 256 + 256 + 256 + 512 + 512) break;
            if (it < 16) gdn2_item(p, l, it, smem);
            else if (it < 272) { for (int rep = 0; rep < NREP(8); ++rep) attn_item(p, l, it - 16, smem); }
            else if (it < 528) gdn2_item(p, l, it - 272 + 16, smem);
            else if (it < 784) { for (int rep = 0; rep < NREP(8); ++rep) attn_item(p, l, it - 528 + 256, smem); }
            else if (it < 1296) { for (int rep = 0; rep < NREP(9); ++rep) lru_item<true>(p, l, it - 784, smem); }
            else for (int rep = 0; rep < NREP(8); ++rep) attn_item(p, l, it - 1296 + 512, smem);
          }
        } break;
        case 4: for (int it = B; it < 1024; it += G) gdnfin_item(p, l, it, smem); break;
        case 5: for (int rep = 0; rep < NREP(11); ++rep) FOR_TILES(128, 8, 8, 8, merge_item(p, l, mt, nt, smem)); break;
        case 6: FOR_TILES(128, 8, 8, 8, wout_item(p, l, mt, nt, smem)); break;
        case 7: for (int it = B; it < 2048; it += G) norm_item<1>(p, l, it); break;
        case 8: FOR_TILES(128, 32, 8, 8, w1_item(p, mt, nt, smem)); break;
        case 9: FOR_TILES(128, 8, 8, 8, w2_item(p, l, mt, nt, smem)); break;
      }
    }
    if (ph + 1 < ph_hi) {
      if (ph == ph_lo) cg::this_grid().sync();
      else for (int rep = 0; rep < NREP(1); ++rep) xcd_barrier((unsigned*)(p->ws + WS_BAR), (volatile LAS unsigned*)&xb_words);
    }
  }
}

extern "C" void kernel_launch(void* const* d_in, const int* in_sizes, int n_in, void* d_out, int out_size, void* d_ws, size_t ws_size, hipStream_t stream) {
  static int grid_blocks = 0;
  if (!grid_blocks) {
    int dev = 0, cus = 0, per_cu = 0;
    (void)hipGetDevice(&dev);
    (void)hipDeviceGetAttribute(&cus, hipDeviceAttributeMultiprocessorCount, dev);
    if (hipFuncSetAttribute((const void*)mk, hipFuncAttributeMaxDynamicSharedMemorySize, DYN_LDS) != hipSuccess) fprintf(stderr, "kernel_launch: hipFuncSetAttribute failed\n");
    (void)hipOccupancyMaxActiveBlocksPerMultiprocessor(&per_cu, mk, 256, DYN_LDS);
    if (per_cu < 1) per_cu = 1;
    if (per_cu > 2) per_cu = 2;
    grid_blocks = cus * per_cu;
    if (ws_size < WS_END) fprintf(stderr, "kernel_launch: workspace too small: %zu < %zu\n", ws_size, (size_t)WS_END);
  }
  if (hipMemsetAsync((char*)d_ws + WS_CTR, 0, 256 + 3456 * 4 + 256, stream) != hipSuccess) fprintf(stderr, "kernel_launch: memset failed\n");
  Params p{};
  for (int i = 0; i < 37; ++i) p.in[i] = (const float*)d_in[i];
  p.out = (float*)d_out; p.ws = (unsigned char*)d_ws;
#if MULTI_LAUNCH
  for (int ph = 0; ph < NPHASE; ++ph) hipLaunchKernelGGL(mk, dim3(grid_blocks), dim3(256), DYN_LDS, stream, p, ph, ph + 1);
#else
  int lo = 0, hi = NPHASE;
  void* args[] = {&p, &lo, &hi};
  hipError_t e = hipLaunchCooperativeKernel((void*)mk, dim3(grid_blocks), dim3(256), args, DYN_LDS, stream);
  if (e != hipSuccess) fprintf(stderr, "cooperative launch failed: %s (grid %d)\n", hipGetErrorString(e), grid_blocks);
#endif
}
```

```cpp
#include <hip/hip_runtime.h>
#include <hip/hip_cooperative_groups.h>
#include <cstdio>
namespace cg = cooperative_groups;

#ifndef MULTI_LAUNCH
#define MULTI_LAUNCH 0
#endif
#ifndef PHM
#define PHM 0xFFFFFFFFu
#endif
#define PHON(b) ((PHM >> (b)) & 1u)
#ifndef DUPM
#define DUPM 0u
#endif
#define NREP(b) (1 + ((DUPM >> (b)) & 1u))

typedef unsigned short u16;
using bf16x8 = __attribute__((ext_vector_type(8))) short;
using f32x4 = __attribute__((ext_vector_type(4))) float;
using u32x4 = __attribute__((ext_vector_type(4))) unsigned;
#define DI __device__ __forceinline__
#define MFMA16(a, b, c) __builtin_amdgcn_mfma_f32_16x16x32_bf16((a), (b), (c), 0, 0, 0)

constexpr int NTOK = 16384;
constexpr int DM = 1024;
constexpr int LDI = 2592;
constexpr int C_AQ = 0, C_AK = 256, C_AV = 384, C_LX = 512, C_LG = 768, C_GQ = 1024, C_GK = 1280, C_GV = 1536, C_GZ = 1792,
              C_DQ = 2048, C_DK = 2304, C_DV = 2432, C_GA = 2560, C_GB = 2568;
constexpr int NIN_PAD = 2688;

constexpr size_t WS_MOD = 0;
constexpr size_t WS_CTR = WS_MOD + 2 * 3 * 6144 * 4;
constexpr size_t WS_BAR = WS_CTR + 256;
constexpr size_t WS_LRUC = WS_BAR + 3456 * 4 + 256;
constexpr size_t WS_KC = WS_LRUC + (size_t)512 * 2 * 2 * 256 * 4;
constexpr size_t WS_GVEC = WS_KC + (size_t)16 * 512 * 64 * 2;
constexpr size_t WS_LRUW = WS_GVEC + (size_t)1024 * 2 * 256 * 4;
constexpr size_t WS_VT = WS_LRUW + (size_t)256 * 64 * 16;
constexpr size_t WS_WIN = WS_VT + (size_t)8 * 64 * 4608 * 2;
constexpr size_t WS_WM = WS_WIN + (size_t)NIN_PAD * 1024 * 2;
constexpr size_t WS_WB = WS_WM + (size_t)4096 * 1024 * 2;
constexpr size_t WS_WO = WS_WB + (size_t)4 * 1024 * 256 * 2;
constexpr size_t WS_W1 = WS_WO + (size_t)1024 * 1024 * 2;
constexpr size_t WS_W2 = WS_W1 + (size_t)4096 * 1024 * 2;
constexpr size_t WS_H = WS_W2 + (size_t)1024 * 4096 * 2;
constexpr size_t WS_BIG = WS_H + (size_t)NTOK * 1024 * 2;
constexpr size_t WS_INPROJ = WS_BIG;
constexpr size_t WS_BRANCH = WS_INPROJ + (size_t)NTOK * LDI * 2;
constexpr size_t WS_QHAT = WS_BRANCH + (size_t)NTOK * 1024 * 2;
constexpr size_t WS_KT = WS_QHAT + (size_t)1024 * 4096 * 2;
constexpr size_t WS_UW = WS_KT + (size_t)1024 * 4096 * 2;
constexpr size_t WS_QK = WS_UW + (size_t)1024 * 2 * 8192 * 2;
constexpr size_t WS_END = WS_QK + (size_t)1024 * 2 * 4096 * 2;
constexpr size_t WS_HIDDEN = WS_BIG;
constexpr size_t WS_MERGED = WS_BIG;
static_assert(WS_HIDDEN + (size_t)NTOK * 4096 * 2 <= WS_END, "hidden must fit");
static_assert(WS_END <= (size_t)256 * 1024 * 1024, "workspace budget");

constexpr size_t O_X = 0, O_AK = 16777216, O_AV = 18874368, O_DK = 20971520, O_DV = 23068672, O_LRU = 25165824, O_GDN = 25198592;

struct Params {
  const float* in[37];
  float* out;
  unsigned char* ws;
};

typedef const Params __attribute__((address_space(4)))* KP;
constexpr int SMEM_BYTES = 65536;
constexpr int DYN_LDS = SMEM_BYTES + 64;

DI int ltid() { int t = threadIdx.x; asm volatile("" : "+v"(t)); return t; }
typedef __bf16 bf16v2 __attribute__((ext_vector_type(2)));
DI u16 f2bf(float x) { __bf16 h = (__bf16)x; return __builtin_bit_cast(u16, h); }
DI float bf2f(u16 h) { return __uint_as_float(((unsigned)h) << 16); }
DI unsigned pack2(float a, float b) { bf16v2 v = {(__bf16)a, (__bf16)b}; return __builtin_bit_cast(unsigned, v); }
DI float bflo(unsigned u) { return __uint_as_float(u << 16); }
DI float bfhi(unsigned u) { return __uint_as_float(u & 0xffff0000u); }
DI float sigm(float x) { return 1.f / (1.f + __expf(-x)); }
DI float siluf_(float x) { return x / (1.f + __expf(-x)); }
DI float softplusf_(float x) { return x > 20.f ? x : log1pf(__expf(x)); }
DI float gelu_tanh(float x) { float u = 0.7978845608028654f * (x + 0.044715f * x * x * x); float t = 1.f - 2.f / (__expf(2.f * u) + 1.f); return 0.5f * x * (1.f + t); }
DI float wave_sum(float v) {
#pragma unroll
  for (int o = 32; o > 0; o >>= 1) v += __shfl_xor(v, o, 64);
  return v;
}
DI u32x4 mku4(unsigned a, unsigned b, unsigned c, unsigned d) { u32x4 v = {a, b, c, d}; return v; }
DI bf16x8 mk8(unsigned a, unsigned b, unsigned c, unsigned d) { u32x4 v = {a, b, c, d}; return __builtin_bit_cast(bf16x8, v); }
DI bf16x8 pack8(const f32x4& x, const f32x4& y) { return mk8(pack2(x[0], x[1]), pack2(x[2], x[3]), pack2(y[0], y[1]), pack2(y[2], y[3])); }
DI bf16x8 ld8(const u16* p) { return *(const bf16x8*)p; }
DI bf16x8 ldperm(const u16* p) { uint2 a = *(const uint2*)p; uint2 b = *(const uint2*)(p + 16); return mk8(a.x, a.y, b.x, b.y); }
DI int mod_group(int row) { return row < 8192 ? 0 : 1 + ((row - 8192) >> 12); }
DI const float* x_in_row(KP p, int l, int row) {
  if (l == 0) return row < 8192 ? p->in[0] + (size_t)row * DM : p->in[1] + (size_t)(row - 8192) * DM;
  return p->out + (size_t)row * DM;
}
DI unsigned swap16(unsigned u) { return (u >> 16) | (u << 16); }
DI u32x4 rev8(u32x4 v) { return mku4(swap16(v.w), swap16(v.z), swap16(v.y), swap16(v.x)); }

DI void mod_item(KP p, int item, unsigned char* smem) {
  float* sc = (float*)smem;
  float* sr = sc + 3072;
  const int tid = ltid();
  const int l = item / 96, cb = item % 96;
  for (int i = tid; i < 3072; i += 256) {
    int g = i >> 10, k = i & 1023;
    float c = g == 0 ? p->in[9][k] : p->in[2][(g - 1) * 1024 + k];
    sc[i] = siluf_(c);
  }
  __syncthreads();
  const int col = cb * 64 + (tid & 63), kg = tid >> 6;
  const float* W = p->in[10] + (size_t)l * 1024 * 6144;
  float a0 = 0.f, a1 = 0.f, a2 = 0.f;
  for (int k = kg * 256; k < kg * 256 + 256; ++k) {
    float w = W[(size_t)k * 6144 + col];
    a0 += sc[k] * w; a1 += sc[1024 + k] * w; a2 += sc[2048 + k] * w;
  }
  sr[(kg * 3 + 0) * 64 + (tid & 63)] = a0; sr[(kg * 3 + 1) * 64 + (tid & 63)] = a1; sr[(kg * 3 + 2) * 64 + (tid & 63)] = a2;
  __syncthreads();
  if (tid < 192) {
    int g = tid >> 6, cc = tid & 63;
    float s = p->in[11][l * 6144 + cb * 64 + cc];
    for (int q = 0; q < 4; ++q) s += sr[(q * 3 + g) * 64 + cc];
    ((float*)(p->ws + WS_MOD))[(l * 3 + g) * 6144 + cb * 64 + cc] = s;
  }
  __syncthreads();
}

DI void conv_tile(const float* src, int N, int k0, int n0, u16* dst, int K, bool perm, unsigned char* smem) {
  float* tile = (float*)smem;
  const int tid = ltid();
#pragma unroll
  for (int i = 0; i < 4; ++i) {
    int kr = (tid >> 4) + 16 * i, nc = (tid & 15) * 4;
    float4 v = make_float4(0.f, 0.f, 0.f, 0.f);
    if (n0 + nc < N) v = *(const float4*)(src + (size_t)(k0 + kr) * N + n0 + nc);
    tile[kr * 65 + nc] = v.x; tile[kr * 65 + nc + 1] = v.y; tile[kr * 65 + nc + 2] = v.z; tile[kr * 65 + nc + 3] = v.w;
  }
  __syncthreads();
#pragma unroll
  for (int i = 0; i < 2; ++i) {
    int n = (tid >> 3) + 32 * i, k8 = (tid & 7) * 8;
    int ng = n0 + n;
    if (ng < N) {
      int row = ng;
      if (perm) row = ng < 2048 ? ng : (ng < 2064 ? 2560 + (ng - 2048) : ng - 16);
      u32x4 o;
      o.x = pack2(tile[(k8 + 0) * 65 + n], tile[(k8 + 1) * 65 + n]);
      o.y = pack2(tile[(k8 + 2) * 65 + n], tile[(k8 + 3) * 65 + n]);
      o.z = pack2(tile[(k8 + 4) * 65 + n], tile[(k8 + 5) * 65 + n]);
      o.w = pack2(tile[(k8 + 6) * 65 + n], tile[(k8 + 7) * 65 + n]);
      *(u32x4*)(dst + (size_t)row * K + k0 + k8) = o;
    }
  }
  __syncthreads();
}

constexpr int CONV_ITEMS = 4241;
DI void convert_item(KP p, int l, int item, unsigned char* smem) {
  unsigned char* ws = p->ws;
  if (item < 656) { int kt = item / 41, nt = item % 41; conv_tile(p->in[14] + (size_t)l * 1024 * 2576, 2576, kt * 64, nt * 64, (u16*)(ws + WS_WIN), 1024, true, smem); return; }
  item -= 656;
  if (item < 1024) { int kt = item >> 6, nt = item & 63; conv_tile(p->in[32] + (size_t)l * 1024 * 4096, 4096, kt * 64, nt * 64, (u16*)(ws + WS_WM), 1024, false, smem); return; }
  item -= 1024;
  if (item < 256) { int m = item >> 6, r = item & 63, kt = r >> 4, nt = r & 15;
    conv_tile(p->in[31] + ((size_t)l * 4 + m) * 256 * 1024, 1024, kt * 64, nt * 64, (u16*)(ws + WS_WB) + (size_t)m * 1024 * 256, 256, false, smem); return; }
  item -= 256;
  if (item < 256) { int kt = item >> 4, nt = item & 15; conv_tile(p->in[34] + (size_t)l * 1024 * 1024, 1024, kt * 64, nt * 64, (u16*)(ws + WS_WO), 1024, false, smem); return; }
  item -= 256;
  if (item < 1024) { int kt = item >> 6, nt = item & 63; conv_tile(p->in[35] + (size_t)l * 1024 * 4096, 4096, kt * 64, nt * 64, (u16*)(ws + WS_W1), 1024, false, smem); return; }
  item -= 1024;
  if (item < 1024) { int kt = item >> 4, nt = item & 15; conv_tile(p->in[36] + (size_t)l * 4096 * 1024, 1024, kt * 64, nt * 64, (u16*)(ws + WS_W2), 4096, false, smem); return; }
  u32x4* z = (u32x4*)((u16*)(ws + WS_WIN) + (size_t)2576 * 1024);
  for (int i = ltid(); i < 112 * 1024 / 8; i += 256) z[i] = mku4(0, 0, 0, 0);
}

DI void lruw_item(KP p, int item) {
  const int gid = item * 256 + ltid();
  const int lane = gid & 63, fg = gid >> 6;
  const int s2 = fg & 1, j = (fg >> 1) & 3, n = (fg >> 3) & 3, g = (fg >> 5) & 1, ld_ = fg >> 6;
  const int lq = lane & 15, quad = lane >> 4;
  const float* W = (g == 0 ? p->in[20] : p->in[22]) + ((size_t)(ld_ * 4 + n) * 64) * 64 + (size_t)(s2 * 32 + quad * 8) * 64 + j * 16 + lq;
  u32x4 o = {pack2(W[0], W[64]), pack2(W[128], W[192]), pack2(W[256], W[320]), pack2(W[384], W[448])};
  ((u32x4*)(p->ws + WS_LRUW))[gid] = o;
}

template <int which>
DI void norm_item(KP p, int l, int item) {
  const int tid = ltid(), lane = tid & 63, wave = tid >> 6;
  const float* g = p->in[which == 0 ? 12 : 13] + l * 1024;
  f32x4 v[2][4]; float ss[2] = {0.f, 0.f};
#pragma unroll
  for (int h = 0; h < 2; ++h) {
    const int row = item * 8 + wave * 2 + h;
    const float* x = x_in_row(p, which == 0 ? l : 2, row);
#pragma unroll
    for (int i = 0; i < 4; ++i) v[h][i] = *(const f32x4*)(x + i * 256 + lane * 4);
  }
#pragma unroll
  for (int h = 0; h < 2; ++h) {
#pragma unroll
    for (int i = 0; i < 4; ++i) ss[h] += v[h][i].x * v[h][i].x + v[h][i].y * v[h][i].y + v[h][i].z * v[h][i].z + v[h][i].w * v[h][i].w;
    ss[h] = wave_sum(ss[h]);
  }
#pragma unroll
  for (int h = 0; h < 2; ++h) {
    const int row = item * 8 + wave * 2 + h;
    const float* mod = (const float*)(p->ws + WS_MOD) + (l * 3 + mod_group(row)) * 6144;
    const float* sh = mod + (which == 0 ? 0 : 3072);
    const float* sc = mod + (which == 0 ? 1024 : 4096);
    const float rstd = rsqrtf(ss[h] * (1.f / 1024.f) + 1e-6f);
    u16* H = (u16*)(p->ws + WS_H) + (size_t)row * 1024;
#pragma unroll
    for (int i = 0; i < 4; ++i) {
      int c = i * 256 + lane * 4;
      float4 gg = *(const float4*)(g + c), s1 = *(const float4*)(sc + c), s0 = *(const float4*)(sh + c);
      float y0 = v[h][i].x * rstd * gg.x * (1.f + s1.x) + s0.x, y1 = v[h][i].y * rstd * gg.y * (1.f + s1.y) + s0.y;
      float y2 = v[h][i].z * rstd * gg.z * (1.f + s1.z) + s0.z, y3 = v[h][i].w * rstd * gg.w * (1.f + s1.w) + s0.w;
      *(uint2*)(H + c) = make_uint2(pack2(y0, y1), pack2(y2, y3));
    }
  }
}

DI int lds_byte(int r, int c) {
  int st = (r >> 4) * 2 + (c >> 5), ob = (r & 15) * 64 + (c & 31) * 2;
  return st * 1024 + (ob ^ (((ob >> 9) & 1) << 5));
}
DI void stage_rc(int b, int& R, int& C) {
  int st = b >> 10, sb = b & 1023, swz = sb ^ (((sb >> 9) & 1) << 5);
  R = (st >> 1) * 16 + (swz >> 6);
  C = (st & 1) * 32 + ((swz & 63) >> 1);
}
template <int MT, int NT, bool pre = false>
DI void gemm_acc(f32x4 (&acc)[MT][NT], const u16* __restrict__ A, int lda, const u16* __restrict__ Bt, int ldb, int K, unsigned char* smem,
                 const u16* nxtA = nullptr, int nlda = 0, const u16* nxtB = nullptr, int nldb = 0) {
  constexpr int TA = MT * 32 * 128, TB = NT * 32 * 128, STAGE = TA + TB;
  static_assert(2 * STAGE <= 65536, "LDS");
  const int tid = ltid(), lane = tid & 63, wid = tid >> 6, wm = wid >> 1, wn = wid & 1;
  const int fr = lane & 15, fq = lane >> 4;
  const u16* ga[MT]; const u16* gb[NT];
#pragma unroll
  for (int i = 0; i < MT; ++i) { int R, C; stage_rc(wid * 1024 + i * 4096 + lane * 16, R, C); ga[i] = A + (size_t)R * lda + C; }
#pragma unroll
  for (int i = 0; i < NT; ++i) { int R, C; stage_rc(wid * 1024 + i * 4096 + lane * 16, R, C); gb[i] = Bt + (size_t)R * ldb + C; }
#define GLDS_STAGE(buf, k0)                                                                                                        \
  do {                                                                                                                             \
    _Pragma("unroll") for (int i = 0; i < MT; ++i)                                                                                 \
      __builtin_amdgcn_global_load_lds((const unsigned*)(ga[i] + (k0)), (unsigned*)(smem + (buf) * STAGE + wid * 1024 + i * 4096), 16, 0, 0); \
    _Pragma("unroll") for (int i = 0; i < NT; ++i)                                                                                 \
      __builtin_amdgcn_global_load_lds((const unsigned*)(gb[i] + (k0)), (unsigned*)(smem + (buf) * STAGE + TA + wid * 1024 + i * 4096), 16, 0, 0); \
  } while (0)
  if (!pre) {
    __syncthreads();
    GLDS_STAGE(0, 0);
  }
  asm volatile("s_waitcnt vmcnt(0)" ::: "memory");
  __syncthreads();
  const int nt = K >> 6;
  for (int t = 0; t < nt; ++t) {
    const int cur = t & 1;
    if (t + 1 < nt) GLDS_STAGE(cur ^ 1, (t + 1) * 64);
    const unsigned char* sA = smem + cur * STAGE;
    const unsigned char* sB = sA + TA;
    if constexpr (!pre) {
      bf16x8 bfr[2][NT], af[2][MT];
#pragma unroll
      for (int s = 0; s < 2; ++s) {
#pragma unroll
        for (int j = 0; j < NT; ++j) bfr[s][j] = *(const bf16x8*)(sB + lds_byte(wn * NT * 16 + j * 16 + fr, s * 32 + fq * 8));
#pragma unroll
        for (int i = 0; i < MT; ++i) af[s][i] = *(const bf16x8*)(sA + lds_byte(wm * MT * 16 + i * 16 + fr, s * 32 + fq * 8));
      }
#pragma unroll
      for (int s = 0; s < 2; ++s)
#pragma unroll
        for (int i = 0; i < MT; ++i)
#pragma unroll
          for (int j = 0; j < NT; ++j) acc[i][j] = MFMA16(af[s][i], bfr[s][j], acc[i][j]);
      __builtin_amdgcn_sched_group_barrier(0x100, MT + NT, 0);
#pragma unroll
      for (int q = 0; q < MT + NT; ++q) { __builtin_amdgcn_sched_group_barrier(0x008, 2, 0); __builtin_amdgcn_sched_group_barrier(0x100, 1, 0); }
      __builtin_amdgcn_sched_group_barrier(0x008, 2 * MT * NT - 2 * (MT + NT), 0);
    } else {
#pragma unroll
      for (int s = 0; s < 2; ++s) {
        bf16x8 bfr[NT], af[MT];
#pragma unroll
        for (int j = 0; j < NT; ++j) bfr[j] = *(const bf16x8*)(sB + lds_byte(wn * NT * 16 + j * 16 + fr, s * 32 + fq * 8));
#pragma unroll
        for (int i = 0; i < MT; ++i) af[i] = *(const bf16x8*)(sA + lds_byte(wm * MT * 16 + i * 16 + fr, s * 32 + fq * 8));
#pragma unroll
        for (int i = 0; i < MT; ++i)
#pragma unroll
          for (int j = 0; j < NT; ++j) acc[i][j] = MFMA16(af[i], bfr[j], acc[i][j]);
      }
    }
    asm volatile("s_waitcnt vmcnt(0)" ::: "memory");
    __syncthreads();
  }
  if (nxtA) {
#pragma unroll
    for (int i = 0; i < MT; ++i) { int R, C; stage_rc(wid * 1024 + i * 4096 + lane * 16, R, C);
      __builtin_amdgcn_global_load_lds((const unsigned*)(nxtA + (unsigned)(R * nlda + C)), (unsigned*)(smem + wid * 1024 + i * 4096), 16, 0, 0); }
#pragma unroll
    for (int i = 0; i < NT; ++i) { int R, C; stage_rc(wid * 1024 + i * 4096 + lane * 16, R, C);
      __builtin_amdgcn_global_load_lds((const unsigned*)(nxtB + (unsigned)(R * nldb + C)), (unsigned*)(smem + TA + wid * 1024 + i * 4096), 16, 0, 0); }
  }
#undef GLDS_STAGE
}

template <int MT, int NT>
DI void gemm_prefetch(const u16* A, int lda, const u16* Bt, int ldb, unsigned char* smem) {
  constexpr int TA = MT * 32 * 128;
  const int tid = ltid(), lane = tid & 63, wid = tid >> 6;
  __syncthreads();
#pragma unroll
  for (int i = 0; i < MT; ++i) { int R, C; stage_rc(wid * 1024 + i * 4096 + lane * 16, R, C);
    __builtin_amdgcn_global_load_lds((const unsigned*)(A + (unsigned)(R * lda + C)), (unsigned*)(smem + wid * 1024 + i * 4096), 16, 0, 0); }
#pragma unroll
  for (int i = 0; i < NT; ++i) { int R, C; stage_rc(wid * 1024 + i * 4096 + lane * 16, R, C);
    __builtin_amdgcn_global_load_lds((const unsigned*)(Bt + (unsigned)(R * ldb + C)), (unsigned*)(smem + TA + wid * 1024 + i * 4096), 16, 0, 0); }
}

template <int MT, int NT> DI void zero_acc(f32x4 (&acc)[MT][NT]) {
#pragma unroll
  for (int i = 0; i < MT; ++i)
#pragma unroll
    for (int j = 0; j < NT; ++j) acc[i][j] = f32x4{0.f, 0.f, 0.f, 0.f};
}

#define EPI_LOOP(MT, NT)                                                          \
  const int tid_ = ltid(), lane_ = tid_ & 63, wave_ = tid_ >> 6;                   \
  const int wm_ = wave_ >> 1, wn_ = wave_ & 1, lq_ = lane_ & 15, quad_ = lane_ >> 4; \
  _Pragma("unroll") for (int i = 0; i < MT; ++i)                                   \
  _Pragma("unroll") for (int j = 0; j < NT; ++j)                                   \
  _Pragma("unroll") for (int r = 0; r < 4; ++r)
#define EPI_ROW(m0, MT) ((m0) + wm_ * (MT) * 16 + i * 16 + quad_ * 4 + r)
#define EPI_COL(n0, NT) ((n0) + wn_ * (NT) * 16 + j * 16 + lq_)

constexpr int GMT = 4;
DI void inproj_item(KP p, int mt, int nt, unsigned char* smem) {
  const int m0 = mt * (GMT * 32), n0 = nt * 128;
  f32x4 acc[GMT][4]; zero_acc<GMT, 4>(acc);
  gemm_acc<GMT, 4>(acc, (const u16*)(p->ws + WS_H) + (size_t)m0 * 1024, 1024, (const u16*)(p->ws + WS_WIN) + (size_t)n0 * 1024, 1024, 1024, smem);
  u16* C = (u16*)(p->ws + WS_INPROJ);
  EPI_LOOP(GMT, 4) { int row = EPI_ROW(m0, GMT), col = EPI_COL(n0, 4); if (col < LDI) C[(size_t)row * LDI + col] = f2bf(acc[i][j][r]); }
}

DI void merge_item(KP p, int l, int mt, int nt, unsigned char* smem) {
  const int m0 = mt * 128, n0 = nt * 128;
  const u16* H = (const u16*)(p->ws + WS_H) + (size_t)m0 * 1024;
  const u16* BR = (const u16*)(p->ws + WS_BRANCH) + (size_t)m0 * 1024;
  const float* bm = p->in[33] + l * 4096;
  const u16* WM = (const u16*)(p->ws + WS_WM) + (size_t)n0 * 1024;
  const u16* WB = (const u16*)(p->ws + WS_WB) + (size_t)n0 * 256;
  unsigned am[4][4][2];
#pragma unroll
  for (int i = 0; i < 4; ++i)
#pragma unroll
    for (int j = 0; j < 4; ++j) { am[i][j][0] = 0u; am[i][j][1] = 0u; }
  gemm_prefetch<4, 4>(BR, 1024, WB, 256, smem);
#pragma unroll 1
  for (int m = 0; m < 4; ++m) {
    f32x4 acc[4][4]; zero_acc<4, 4>(acc);
    gemm_acc<4, 4, true>(acc, BR + m * 256, 1024, WB + (size_t)m * 1024 * 256, 256, 256, smem, H, 1024, WM + (size_t)m * 1024 * 1024, 1024);
    unsigned pp[4][4][2];
#pragma unroll
    for (int i = 0; i < 4; ++i)
#pragma unroll
      for (int j = 0; j < 4; ++j) { pp[i][j][0] = pack2(acc[i][j][0], acc[i][j][1]); pp[i][j][1] = pack2(acc[i][j][2], acc[i][j][3]); }
    zero_acc<4, 4>(acc);
    gemm_acc<4, 4, true>(acc, H, 1024, WM + (size_t)m * 1024 * 1024, 1024, 1024, smem,
                         m < 3 ? BR + (m + 1) * 256 : nullptr, 1024, WB + (size_t)(m + 1) * 1024 * 256, 256);
    {
      const int tid_ = ltid(), wn_ = (tid_ >> 6) & 1, lq_ = tid_ & 15;
      float bias4[4];
#pragma unroll
      for (int j = 0; j < 4; ++j) bias4[j] = bm[m * 1024 + n0 + wn_ * 64 + j * 16 + lq_];
#pragma unroll
      for (int i = 0; i < 4; ++i) {
#pragma unroll
        for (int j = 0; j < 4; ++j) {
          float v0 = bflo(am[i][j][0]) + sigm(acc[i][j][0] + bias4[j]) * bflo(pp[i][j][0]);
          float v1 = bfhi(am[i][j][0]) + sigm(acc[i][j][1] + bias4[j]) * bfhi(pp[i][j][0]);
          float v2 = bflo(am[i][j][1]) + sigm(acc[i][j][2] + bias4[j]) * bflo(pp[i][j][1]);
          float v3 = bfhi(am[i][j][1]) + sigm(acc[i][j][3] + bias4[j]) * bfhi(pp[i][j][1]);
          am[i][j][0] = pack2(v0, v1); am[i][j][1] = pack2(v2, v3);
          asm volatile("" : "+v"(am[i][j][0]), "+v"(am[i][j][1]));
          __builtin_amdgcn_sched_barrier(0);
        }
      }
    }
  }
  u16* C = (u16*)(p->ws + WS_MERGED);
  EPI_LOOP(4, 4) { int row = EPI_ROW(m0, 4), col = EPI_COL(n0, 4); const unsigned w = am[i][j][r >> 1]; C[(size_t)row * 1024 + col] = (u16)((r & 1) ? (w >> 16) : (w & 0xffffu)); }
}

DI void wout_item(KP p, int l, int mt, int nt, unsigned char* smem) {
  const int m0 = mt * (GMT * 32), n0 = nt * 128;
  f32x4 acc[GMT][4]; zero_acc<GMT, 4>(acc);
  gemm_acc<GMT, 4>(acc, (const u16*)(p->ws + WS_MERGED) + (size_t)m0 * 1024, 1024, (const u16*)(p->ws + WS_WO) + (size_t)n0 * 1024, 1024, 1024, smem);
  const float* g1 = (const float*)(p->ws + WS_MOD) + (l * 3 + mod_group(m0)) * 6144 + 2048;
  EPI_LOOP(GMT, 4) { int row = EPI_ROW(m0, GMT), col = EPI_COL(n0, 4); p->out[(size_t)row * DM + col] = x_in_row(p, l, row)[col] + g1[col] * acc[i][j][r]; }
}

DI void w1_item(KP p, int mt, int nt, unsigned char* smem) {
  const int m0 = mt * (GMT * 32), n0 = nt * 128;
  f32x4 acc[GMT][4]; zero_acc<GMT, 4>(acc);
  gemm_acc<GMT, 4>(acc, (const u16*)(p->ws + WS_H) + (size_t)m0 * 1024, 1024, (const u16*)(p->ws + WS_W1) + (size_t)n0 * 1024, 1024, 1024, smem);
  u16* C = (u16*)(p->ws + WS_HIDDEN);
  EPI_LOOP(GMT, 4) { int row = EPI_ROW(m0, GMT), col = EPI_COL(n0, 4); float v = fmaxf(acc[i][j][r], 0.f); C[(size_t)row * 4096 + col] = f2bf(v * v); }
}

DI void w2_item(KP p, int l, int mt, int nt, unsigned char* smem) {
  const int m0 = mt * (GMT * 32), n0 = nt * 128;
  f32x4 acc[GMT][4]; zero_acc<GMT, 4>(acc);
  gemm_acc<GMT, 4>(acc, (const u16*)(p->ws + WS_HIDDEN) + (size_t)m0 * 4096, 4096, (const u16*)(p->ws + WS_W2) + (size_t)n0 * 4096, 4096, 4096, smem);
  const float* g2 = (const float*)(p->ws + WS_MOD) + (l * 3 + mod_group(m0)) * 6144 + 5120;
  EPI_LOOP(GMT, 4) { int row = EPI_ROW(m0, GMT), col = EPI_COL(n0, 4); float* o = p->out + (size_t)row * DM + col; *o = *o + g2[col] * acc[i][j][r]; }
}

DI void prep_load(const u16* R, int lane, float (&hv)[12], float (&vv4)[4]) {
#pragma unroll
  for (int hh = 0; hh < 12; ++hh) {
    const int col = hh < 4 ? C_AQ + hh * 64 : (hh < 6 ? C_AK + (hh - 4) * 64 : (hh < 10 ? C_DQ + (hh - 6) * 64 : C_DK + (hh - 10) * 64));
    hv[hh] = bf2f(R[col + lane]);
  }
  vv4[0] = bf2f(R[C_AV + lane]); vv4[1] = bf2f(R[C_AV + 64 + lane]); vv4[2] = bf2f(R[C_DV + lane]); vv4[3] = bf2f(R[C_DV + 64 + lane]);
}
DI void prep_token(KP p, int l, int row, int lane, u16* R, const float (&hv)[12], const float (&vv4)[4]) {
  const bool lat = row >= 8192;
  float cs = 1.f, sn = 0.f;
  if (lat) {
    int t = (row - 8192) & 4095;
    int pos = (lane < 32) ? (t >> 6) : (t & 63);
    float inv = __expf(-(float)(lane & 15) * (9.210340371976184f / 16.f));
    float ang = (float)pos * inv;
    cs = __cosf(ang); sn = __sinf(ang);
  }
  const int b = row >> 8, t = row & 255;
#pragma unroll
  for (int hh = 0; hh < 12; ++hh) {
    int col; const float* g;
    if (hh < 4) { col = C_AQ + hh * 64; g = p->in[15] + l * 64; }
    else if (hh < 6) { col = C_AK + (hh - 4) * 64; g = p->in[16] + l * 64; }
    else if (hh < 10) { col = C_DQ + (hh - 6) * 64; g = p->in[29] + l * 64; }
    else { col = C_DK + (hh - 10) * 64; g = p->in[30] + l * 64; }
    float v = hv[hh];
    float ss = wave_sum(v * v);
    float y = v * rsqrtf(ss * (1.f / 64.f) + 1e-6f) * g[lane];
    if (lat) {
      float yp = __shfl_xor(y, 16, 64);
      y = ((lane & 31) < 16) ? (y * cs - yp * sn) : (y * cs + yp * sn);
    } else {
      if (hh == 4 || hh == 5) p->out[O_AK + ((size_t)(b * 2 + l) * 256 + t) * 128 + (hh - 4) * 64 + lane] = y;
      if (hh >= 10) p->out[O_DK + ((size_t)(b * 2 + l) * 256 + t) * 128 + (hh - 10) * 64 + lane] = y;
    }
    R[col + lane] = f2bf(y);
  }
  if (lat) {
    const int bl = (row - 8192) >> 12, tl = (row - 8192) & 4095;
    u16* VT = (u16*)(p->ws + WS_VT) + (size_t)lane * 4608 + 512 + tl;
#pragma unroll
    for (int q = 0; q < 4; ++q)
      VT[(size_t)(((q >> 1) * 2 + bl) * 2 + (q & 1)) * 64 * 4608] = f2bf(vv4[q]);
  }
  if (!lat) {
    size_t o = ((size_t)(b * 2 + l) * 256 + t) * 128;
    p->out[O_AV + o + lane] = vv4[0]; p->out[O_AV + o + 64 + lane] = vv4[1];
    p->out[O_DV + o + lane] = vv4[2]; p->out[O_DV + o + 64 + lane] = vv4[3];
  }
}
DI void prep_item(KP p, int l, int item) {
  const int tid = ltid(), lane = tid & 63, wave = tid >> 6;
  const int row0 = item * 8 + wave * 2;
  u16* R0 = (u16*)(p->ws + WS_INPROJ) + (size_t)row0 * LDI;
  u16* R1 = R0 + LDI;
  float hv0[12], vv0[4], hv1[12], vv1[4];
  prep_load(R0, lane, hv0, vv0); prep_load(R1, lane, hv1, vv1);
  prep_token(p, l, row0, lane, R0, hv0, vv0);
  prep_token(p, l, row0 + 1, lane, R1, hv1, vv1);
}

DI void kvc_item(KP p, int l, int item) {
  u16* KC = (u16*)(p->ws + WS_KC);
#pragma unroll
  for (int it = 0; it < 8; ++it) {
    int idx4 = item * 2048 + it * 256 + ltid();
    int e = idx4 * 4;
    int d = e & 63, key = (e >> 6) & 511, sel = e >> 15;
    int kv = sel & 1, kvh = (sel >> 1) & 1, b = (sel >> 2) & 1, mixer = sel >> 3;
    const float* srcb = mixer ? (kv ? p->in[6] : p->in[5]) : (kv ? p->in[4] : p->in[3]);
    const float* src = srcb + ((size_t)((b * 2 + l) * 512 + key) * 2 + kvh) * 64 + d;
    float4 v = *(const float4*)src;
    *(uint2*)(KC + e) = make_uint2(pack2(v.x, v.y), pack2(v.z, v.w));
    if (kv) {
      u16* VT = (u16*)(p->ws + WS_VT) + ((size_t)((mixer * 2 + b) * 2 + kvh) * 64 + d) * 4608 + key;
      VT[0] = f2bf(v.x); VT[4608] = f2bf(v.y); VT[2 * 4608] = f2bf(v.z); VT[3 * 4608] = f2bf(v.w);
    }
  }
}

DI void attn_item(KP p, int l, int it, unsigned char* smem) {
  u16* sK = (u16*)smem;
  u16* sVt = sK + 64 * 72;
  const int tid = ltid(), lane = tid & 63, wave = tid >> 6, lq = lane & 15, quad = lane >> 4;
  int kind, b, qh, qb;
  if (it < 512) { kind = it >> 8; int r = it & 255; b = r >> 7; qh = (r >> 5) & 3; qb = r & 31; }
  else { int r = it - 512; kind = 2 + (r >> 8); r &= 255; b = r >> 3; qh = (r >> 1) & 3; qb = r & 1; }
  const bool isD = (kind == 0 || kind == 3), lat = kind < 2;
  const int seqrow0 = lat ? 8192 + b * 4096 : b * 256;
  const int q0 = qb * 128, kvh = qh >> 1;
  const int qcol = (isD ? C_DQ : C_AQ) + qh * 64, kcol = (isD ? C_DK : C_AK) + kvh * 64, vcol = (isD ? C_DV : C_AV) + kvh * 64;
  const int ocol = (isD ? 768 : 0) + qh * 64;
  const int ncache = lat ? 8 : 0;
  int kt_lo = 0, kt_hi = lat ? 64 : 4;
  if (kind == 1) { kt_lo = max(0, 2 * qb - 2); kt_hi = min(64, 2 * qb + 4); }
  const int ntiles = ncache + kt_hi - kt_lo;
  const bool band = (kind == 1);
  const u16* INP = (const u16*)(p->ws + WS_INPROJ);
  const u16* KCk = (const u16*)(p->ws + WS_KC) + (size_t)((((isD ? 1 : 0) * 2 + b) * 2 + kvh) * 2) * 512 * 64;
  const u16* KCv = KCk + 512 * 64;
  constexpr float SC2 = 0.125f * 1.4426950408889634f;
  const float sinkv = isD ? -1e30f : p->in[17][l * 4 + qh] * 1.4426950408889634f;

  bf16x8 qf[2][2];
#pragma unroll
  for (int nt = 0; nt < 2; ++nt)
#pragma unroll
    for (int s = 0; s < 2; ++s) qf[nt][s] = ld8(INP + (size_t)(seqrow0 + q0 + wave * 32 + nt * 16 + lq) * LDI + qcol + s * 32 + quad * 8);
  float mrun[2], lsum[2];
  f32x4 oacc[4][2];
#pragma unroll
  for (int nt = 0; nt < 2; ++nt) { mrun[nt] = sinkv; lsum[nt] = (!isD && quad == 0) ? 1.f : 0.f; }
#pragma unroll
  for (int dt = 0; dt < 4; ++dt)
#pragma unroll
    for (int nt = 0; nt < 2; ++nt) oacc[dt][nt] = f32x4{0.f, 0.f, 0.f, 0.f};

  const int key = tid >> 2, seg = (tid & 3) * 16;
  struct KVReg { u32x4 k[2], v[2]; };
  KVReg R0, R1;
  const u16* VTp = (const u16*)(p->ws + WS_VT) + ((size_t)(((isD ? 1 : 0) * 2 + b) * 2 + kvh) * 64 + key) * 4608 + seg;
  auto tile_ptrs = [&](int t, const u16*& kp, const u16*& vp) {
    if (t < ncache) { kp = KCk + (size_t)(t * 64 + key) * 64 + seg; vp = VTp + t * 64; }
    else {
      const u16* rowp = INP + (size_t)(seqrow0 + (kt_lo + t - ncache) * 64 + key) * LDI; kp = rowp + kcol + seg;
      vp = lat ? VTp + 512 + (kt_lo + t - ncache) * 64 : rowp + vcol + seg;
    }
  };
  auto kvload = [&](int t, KVReg& R) {
    const u16 *kp, *vp; tile_ptrs(t, kp, vp);
    R.k[0] = *(const u32x4*)kp; R.k[1] = *(const u32x4*)(kp + 8); R.v[0] = *(const u32x4*)vp; R.v[1] = *(const u32x4*)(vp + 8);
  };
  kvload(0, R0);
  if (ntiles > 1) kvload(1, R1);
  auto step = [&](int t, KVReg& R) {
    __syncthreads();
    *(u32x4*)(sK + key * 72 + seg) = R.k[0]; *(u32x4*)(sK + key * 72 + seg + 8) = R.k[1];
    if (lat) {
      *(u32x4*)(sVt + key * 72 + seg) = R.v[0]; *(u32x4*)(sVt + key * 72 + seg + 8) = R.v[1];
    } else {
      unsigned vv[8] = {R.v[0].x, R.v[0].y, R.v[0].z, R.v[0].w, R.v[1].x, R.v[1].y, R.v[1].z, R.v[1].w};
#pragma unroll
      for (int e = 0; e < 8; ++e) { sVt[(seg + 2 * e) * 72 + key] = (u16)(vv[e] & 0xffffu); sVt[(seg + 2 * e + 1) * 72 + key] = (u16)(vv[e] >> 16); }
    }
    __syncthreads();
    if (t + 2 < ntiles) kvload(t + 2, R);
    f32x4 sacc[4][2];
#pragma unroll
    for (int mt = 0; mt < 4; ++mt) {
      sacc[mt][0] = f32x4{0.f, 0.f, 0.f, 0.f}; sacc[mt][1] = f32x4{0.f, 0.f, 0.f, 0.f};
#pragma unroll
      for (int s = 0; s < 2; ++s) {
        bf16x8 ka = ld8(sK + (mt * 16 + lq) * 72 + s * 32 + quad * 8);
        sacc[mt][0] = MFMA16(ka, qf[0][s], sacc[mt][0]);
        sacc[mt][1] = MFMA16(ka, qf[1][s], sacc[mt][1]);
      }
    }
    const bool masked_tile = band && t >= ncache;
    const int kbase = (kt_lo + t - ncache) * 64;
    bf16x8 pf[2][2];
#pragma unroll
    for (int nt = 0; nt < 2; ++nt) {
      const int qi = q0 + wave * 32 + nt * 16 + lq;
      float tmax = -1e30f;
#pragma unroll
      for (int mt = 0; mt < 4; ++mt)
#pragma unroll
        for (int r = 0; r < 4; ++r) {
          float sv_ = sacc[mt][nt][r] * SC2;
          if (masked_tile) { int kj = kbase + mt * 16 + quad * 4 + r; int dlt = qi - kj; if (dlt > 128 || dlt < -128) sv_ = -1e30f; }
          sacc[mt][nt][r] = sv_; tmax = fmaxf(tmax, sv_);
        }
      tmax = fmaxf(tmax, __shfl_xor(tmax, 16, 64)); tmax = fmaxf(tmax, __shfl_xor(tmax, 32, 64));
      const float mold = mrun[nt];
      const float mnew = fmaxf(mold, tmax);
      float ps = 0.f;
#pragma unroll
      for (int mt = 0; mt < 4; ++mt)
#pragma unroll
        for (int r = 0; r < 4; ++r) { float e = __builtin_amdgcn_exp2f(sacc[mt][nt][r] - mnew); sacc[mt][nt][r] = e; ps += e; }
      if (__any(mnew != mold)) {
        const float alpha = __builtin_amdgcn_exp2f(mold - mnew);
        lsum[nt] *= alpha;
#pragma unroll
        for (int dt = 0; dt < 4; ++dt)
#pragma unroll
          for (int r = 0; r < 4; ++r) oacc[dt][nt][r] *= alpha;
      }
      lsum[nt] += ps; mrun[nt] = mnew;
      pf[nt][0] = pack8(sacc[0][nt], sacc[1][nt]);
      pf[nt][1] = pack8(sacc[2][nt], sacc[3][nt]);
    }
#pragma unroll
    for (int dt = 0; dt < 4; ++dt)
#pragma unroll
      for (int s2 = 0; s2 < 2; ++s2) {
        bf16x8 va = ldperm(sVt + (dt * 16 + lq) * 72 + s2 * 32 + quad * 4);
        oacc[dt][0] = MFMA16(va, pf[0][s2], oacc[dt][0]);
        oacc[dt][1] = MFMA16(va, pf[1][s2], oacc[dt][1]);
      }
  };
  for (int t = 0; t < ntiles; t += 2) { step(t, R0); if (t + 1 < ntiles) step(t + 1, R1); }
  u16* BR = (u16*)(p->ws + WS_BRANCH);
#pragma unroll
  for (int nt = 0; nt < 2; ++nt) {
    float lt = lsum[nt]; lt += __shfl_xor(lt, 16, 64); lt += __shfl_xor(lt, 32, 64);
    const float inv = 1.f / lt;
    const size_t row = seqrow0 + q0 + wave * 32 + nt * 16 + lq;
#pragma unroll
    for (int dt = 0; dt < 4; ++dt)
      *(uint2*)(BR + row * 1024 + ocol + dt * 16 + quad * 4) = make_uint2(pack2(oacc[dt][nt][0] * inv, oacc[dt][nt][1] * inv), pack2(oacc[dt][nt][2] * inv, oacc[dt][nt][3] * inv));
  }
  __syncthreads();
}

DI int lru_xoff(int t, int c) { return t * 256 + (c ^ ((t & 7) << 3)); }
template <bool FINAL>
DI void lru_item(KP p, int l, int ci, unsigned char* smem) {
  u16* sxb = (u16*)smem;
  u16* sla = sxb + 32 * 256;
  u16* sbv = sla + 32 * 256;
  u16* shf = sbv + 32 * 256;
  const int tid = ltid(), ch = tid, lane = tid & 63, n = tid >> 6, lq = lane & 15, quad = lane >> 4;
  const int r0 = ci * 32;
  const bool lat = r0 >= 8192;
  int b, T, seqrow0;
  if (!lat) { b = r0 >> 8; T = 256; seqrow0 = b * 256; } else { b = (r0 - 8192) >> 12; T = 4096; seqrow0 = 8192 + b * 4096; }
  const int t0 = r0 - seqrow0;
  const u16* INP = (const u16*)(p->ws + WS_INPROJ);
  __syncthreads();
  {
    const float* cw = p->in[18] + l * 4 * 256;
    const float w0 = cw[ch], w1 = cw[256 + ch], w2 = cw[512 + ch], w3 = cw[768 + ch], cb = p->in[19][l * 256 + ch];
    auto ld = [&](int t) -> float { return (t >= 0 && t < T) ? bf2f(INP[(size_t)(seqrow0 + t) * LDI + C_LX + ch]) : 0.f; };
    float xin[35];
#pragma unroll
    for (int q = 0; q < 35; ++q) xin[q] = ld(t0 - 2 + q);
#pragma unroll
    for (int t = 0; t < 32; ++t) sxb[lru_xoff(t, ch)] = f2bf(xin[t] * w0 + xin[t + 1] * w1 + xin[t + 2] * w2 + xin[t + 3] * w3 + cb);
  }
  __syncthreads();
  const int nch = T / 32, c = t0 / 32;
  float* LC = (float*)(p->ws + WS_LRUC);
  bf16x8 af[2][2];
#pragma unroll
  for (int mt = 0; mt < 2; ++mt)
#pragma unroll
    for (int s2 = 0; s2 < 2; ++s2) af[mt][s2] = ld8(sxb + lru_xoff(mt * 16 + lq, n * 64 + s2 * 32 + quad * 8));
  for (int dir = 0; dir < 2; ++dir) {
    bf16x8 wf[2][4][2];
    {
      const u32x4* WF = (const u32x4*)(p->ws + WS_LRUW);
#pragma unroll
      for (int g = 0; g < 2; ++g)
#pragma unroll
        for (int j = 0; j < 4; ++j)
#pragma unroll
          for (int s2 = 0; s2 < 2; ++s2)
            wf[g][j][s2] = __builtin_bit_cast(bf16x8, WF[(size_t)((((((l * 2 + dir) * 2 + g) * 4 + n) * 4 + j) * 2 + s2)) * 64 + lane]);
    }
#pragma unroll
    for (int j = 0; j < 4; ++j) {
      f32x4 acc[2][2];
#pragma unroll
      for (int g = 0; g < 2; ++g) {
        f32x4 a0 = {0.f, 0.f, 0.f, 0.f}, a1 = {0.f, 0.f, 0.f, 0.f};
#pragma unroll
        for (int s2 = 0; s2 < 2; ++s2) { a0 = MFMA16(af[0][s2], wf[g][j][s2], a0); a1 = MFMA16(af[1][s2], wf[g][j][s2], a1); }
        acc[g][0] = a0; acc[g][1] = a1;
      }
      const int cc = n * 64 + j * 16 + lq;
      const float br = p->in[21][(l * 2 + dir) * 256 + cc], bi = p->in[23][(l * 2 + dir) * 256 + cc];
      const float sp = softplusf_(-p->in[24][(l * 2 + dir) * 256 + cc]);
#pragma unroll
      for (int mt = 0; mt < 2; ++mt)
#pragma unroll
        for (int r = 0; r < 4; ++r) {
          const int t = mt * 16 + quad * 4 + r;
          const float la = -8.f * sigm(acc[0][mt][r] + br) * sp;
          const float xt = bf2f(sxb[lru_xoff(t, cc)]);
          const float bb = sqrtf(-expm1f(2.f * la)) * sigm(acc[1][mt][r] + bi) * xt;
          sla[t * 256 + cc] = f2bf(la); sbv[t * 256 + cc] = f2bf(bb);
        }
    }
    __syncthreads();
    float h = 0.f, lasum = 0.f;
    if (FINAL) {
      h = lat ? p->in[7][((b * 2 + l) * 2 + dir) * 256 + ch] : 0.f;
      const int ncar = dir == 0 ? c : nch - 1 - c;
      const int cstart = dir == 0 ? ci - c : ci - c + nch - 1, cstep = dir == 0 ? 1 : -1;
      for (int q0 = 0; q0 < ncar; q0 += 16) {
        float ca[16], chh[16];
#pragma unroll
        for (int q = 0; q < 16; ++q) {
          const int qq = q0 + q < ncar ? q0 + q : ncar - 1;
          const float* C = LC + ((size_t)((cstart + cstep * qq) * 2 + dir) * 2) * 256;
          ca[q] = C[ch]; chh[q] = C[256 + ch];
        }
#pragma unroll
        for (int q = 0; q < 16; ++q) if (q0 + q < ncar) h = ca[q] * h + chh[q];
      }
    }
#pragma unroll 1
    for (int s8 = 0; s8 < 32; s8 += 16) {
      float gv[16];
      if (FINAL && dir == 1) {
#pragma unroll
        for (int q = 0; q < 16; ++q) gv[q] = bf2f(INP[(size_t)(r0 + 31 - s8 - q) * LDI + C_LG + ch]);
      }
#pragma unroll
      for (int q = 0; q < 16; ++q) {
        const int st = s8 + q;
        const int t = dir == 0 ? st : 31 - st;
        const float la = bf2f(sla[t * 256 + ch]);
        h = __expf(la) * h + bf2f(sbv[t * 256 + ch]);
        lasum += la;
        if (FINAL) {
          if (dir == 0) shf[t * 256 + ch] = f2bf(h);
          else ((u16*)(p->ws + WS_BRANCH))[(size_t)(r0 + t) * 1024 + 256 + ch] = f2bf((bf2f(shf[t * 256 + ch]) + h) * gelu_tanh(gv[q]));
        }
      }
    }
    if (!FINAL) { float* C = LC + ((size_t)(ci * 2 + dir) * 2) * 256; C[ch] = __expf(lasum); C[256 + ch] = h; }
    else if (!lat) {
      if (dir == 0 && c == nch - 1) p->out[O_LRU + ((size_t)(b * 2 + l) * 2 + 0) * 256 + ch] = h;
      if (dir == 1 && c == 0) p->out[O_LRU + ((size_t)(b * 2 + l) * 2 + 1) * 256 + ch] = h;
    }
    __syncthreads();
  }
}

template <int DIR, bool ISW>
DI void gdn_solve(const float* L, const u16* src, const float* sb_, const float* se_, u16* UW) {
  float sol[64];
#pragma unroll
  for (int i = 0; i < 64; ++i) {
    float s = bf2f(src[(DIR == 0 ? i : 63 - i) * 72]) * sb_[i];
    if (ISW) s *= se_[i];
    float s0 = 0.f, s1 = 0.f, s2 = 0.f, s3 = 0.f;
#pragma unroll
    for (int j4 = 0; j4 < (i + 3) / 4; ++j4) {
      float4 lv = *(const float4*)(L + i * 64 + j4 * 4);
      if (j4 * 4 + 0 < i) s0 += lv.x * sol[j4 * 4 + 0];
      if (j4 * 4 + 1 < i) s1 += lv.y * sol[j4 * 4 + 1];
      if (j4 * 4 + 2 < i) s2 += lv.z * sol[j4 * 4 + 2];
      if (j4 * 4 + 3 < i) s3 += lv.w * sol[j4 * 4 + 3];
      if ((j4 & 3) == 3) asm volatile("" ::: "memory");
    }
    s -= (s0 + s1) + (s2 + s3);
    sol[i] = s;
    UW[i * 128] = f2bf(s);
    asm volatile("" ::: "memory");
  }
}

DI void gdn1_item(KP p, int l, int item, unsigned char* smem) {
  const int cgi = item >> 2, hd = item & 3;
  u16* sq = (u16*)smem; u16* sk = sq + 64 * 72; u16* sv = sk + 64 * 72;
  float* sL = (float*)(smem + 27648);
  float* sgc = (float*)(smem + 60416);
  float* sbeta = sgc + 128;
  float* sge = sbeta + 128;
  const int tid = ltid(), lane = tid & 63, wave = tid >> 6, lq = lane & 15, quad = lane >> 4;
  const int r0 = cgi * 64;
  const bool lat = r0 >= 8192;
  int T, seqrow0;
  if (!lat) { T = 256; seqrow0 = (r0 >> 8) * 256; } else { T = 4096; seqrow0 = 8192 + ((r0 - 8192) >> 12) * 4096; }
  const int t0 = r0 - seqrow0;
  const u16* INP = (const u16*)(p->ws + WS_INPROJ);
  u16* QHAT = (u16*)(p->ws + WS_QHAT) + (size_t)item * 4096;
  {
    const int d = lane, tb = wave * 16;
#pragma unroll
    for (int mat = 0; mat < 3; ++mat) {
      const int col = C_GQ + mat * 256 + hd * 64 + d, wc = mat * 256 + hd * 64 + d;
      const float* cw = p->in[25] + (size_t)l * 4 * 768;
      const float w0 = cw[wc], w1 = cw[768 + wc], w2 = cw[1536 + wc], w3 = cw[2304 + wc];
      auto ld = [&](int t) -> float { return (t >= 0 && t < T) ? bf2f(INP[(size_t)(seqrow0 + t) * LDI + col]) : 0.f; };
      float xin[19];
#pragma unroll
      for (int q = 0; q < 19; ++q) xin[q] = ld(t0 + tb - 2 + q);
      u16* dst = mat == 0 ? sq : (mat == 1 ? sk : sv);
#pragma unroll
      for (int tt = 0; tt < 16; ++tt) {
        const int t = tb + tt;
        float v = siluf_(xin[tt] * w0 + xin[tt + 1] * w1 + xin[tt + 2] * w2 + xin[tt + 3] * w3);
        if (mat < 2) { float ss = wave_sum(v * v); v *= rsqrtf(ss + 1e-6f) * (mat == 0 ? 0.125f : 1.f); }
        u16 hb = f2bf(v);
        dst[t * 72 + d] = hb;
        if (mat == 0) QHAT[t * 64 + d] = hb;
      }
    }
  }
  if (tid < 128) {
    const int dir = tid >> 6, c = tid & 63;
    const int tok = dir == 0 ? c : 63 - c;
    const u16* R = INP + (size_t)(r0 + tok) * LDI;
    const float ga = bf2f(R[C_GA + dir * 4 + hd]), gb = bf2f(R[C_GB + dir * 4 + hd]);
    const float g = -__expf(p->in[26][(l * 2 + dir) * 4 + hd]) * softplusf_(ga + p->in[27][(l * 2 + dir) * 4 + hd]);
    float gc = g;
#pragma unroll
    for (int o = 1; o < 64; o <<= 1) { float tt = __shfl_up(gc, o, 64); if (lane >= o) gc += tt; }
    const float glast = __shfl(gc, 63, 64);
    sgc[dir * 64 + c] = gc; sbeta[dir * 64 + c] = sigm(gb); sge[dir * 64 + c] = __expf(gc);
    float* gv = (float*)(p->ws + WS_GVEC) + (size_t)(item * 2 + dir) * 256;
    gv[c] = __expf(gc); gv[64 + c] = __expf(glast - gc); if (c == 0) gv[128] = __expf(glast);
  }
  __syncthreads();
  {
    const int dk = tid >> 2, c0 = (tid & 3) * 16;
    unsigned w[8];
#pragma unroll
    for (int e = 0; e < 8; ++e) w[e] = (unsigned)sk[(c0 + 2 * e) * 72 + dk] | ((unsigned)sk[(c0 + 2 * e + 1) * 72 + dk] << 16);
    u16* KT = (u16*)(p->ws + WS_KT) + (size_t)item * 4096 + dk * 64 + c0;
    *(u32x4*)KT = mku4(w[0], w[1], w[2], w[3]); *(u32x4*)(KT + 8) = mku4(w[4], w[5], w[6], w[7]);
  }
  {
    const int i0 = wave * 16;
    f32x4 akk[4], aqk[4];
#pragma unroll
    for (int nt = 0; nt < 4; ++nt) { akk[nt] = f32x4{0.f, 0.f, 0.f, 0.f}; aqk[nt] = f32x4{0.f, 0.f, 0.f, 0.f}; }
#pragma unroll
    for (int s = 0; s < 2; ++s) {
      bf16x8 ak = ld8(sk + (i0 + lq) * 72 + s * 32 + quad * 8), aq = ld8(sq + (i0 + lq) * 72 + s * 32 + quad * 8);
#pragma unroll
      for (int nt = 0; nt < 4; ++nt) { bf16x8 bk = ld8(sk + (nt * 16 + lq) * 72 + s * 32 + quad * 8); akk[nt] = MFMA16(ak, bk, akk[nt]); aqk[nt] = MFMA16(aq, bk, aqk[nt]); }
    }
    u16* QKf = (u16*)(p->ws + WS_QK) + (size_t)(item * 2 + 0) * 4096;
    u16* QKb = (u16*)(p->ws + WS_QK) + (size_t)(item * 2 + 1) * 4096;
#pragma unroll
    for (int nt = 0; nt < 4; ++nt)
#pragma unroll
      for (int r = 0; r < 4; ++r) {
        const int i = i0 + quad * 4 + r, j = nt * 16 + lq, ib = 63 - i, jb = 63 - j;
        const float kkv = akk[nt][r], qkv = aqk[nt][r];
        if (j < i) sL[i * 64 + j] = sbeta[i] * kkv * __expf(sgc[i] - sgc[j]);
        if (j > i) sL[4096 + ib * 64 + jb] = sbeta[64 + ib] * kkv * __expf(sgc[64 + ib] - sgc[64 + jb]);
        QKf[i * 64 + j] = f2bf(j <= i ? qkv * __expf(sgc[i] - sgc[j]) : 0.f);
        QKb[ib * 64 + jb] = f2bf(j >= i ? qkv * __expf(sgc[64 + ib] - sgc[64 + jb]) : 0.f);
      }
  }
  __syncthreads();
  {
    const int col = tid & 127;
    u16* UW = (u16*)(p->ws + WS_UW) + (size_t)(item * 2 + (tid >> 7)) * 8192 + col;
    for (int rep = 0; rep < NREP(2); ++rep) {
    if (tid < 128) { if (col < 64) gdn_solve<0, false>(sL, sv + col, sbeta, sge, UW); else gdn_solve<0, true>(sL, sk + (col - 64), sbeta, sge, UW); }
    else { if (col < 64) gdn_solve<1, false>(sL + 4096, sv + col, sbeta + 64, sge + 64, UW); else gdn_solve<1, true>(sL + 4096, sk + (col - 64), sbeta + 64, sge + 64, UW); }
    }
  }
  __syncthreads();
}

DI void gdn2_item(KP p, int l, int item, unsigned char* smem) {
  u16* sW = (u16*)smem; u16* sKT = sW + 64 * 72; u16* sU = sKT + 64 * 72;
  float* sg = (float*)(smem + 27648);
  const int tid = ltid(), lane = tid & 63, wave = tid >> 6, lq = lane & 15, quad = lane >> 4;
  int b, hd, dir; bool lat;
  if (item < 16) { lat = true; b = item >> 3; hd = (item >> 1) & 3; dir = item & 1; }
  else { lat = false; int r = item - 16; b = r >> 3; hd = (r >> 1) & 3; dir = r & 1; }
  const int nch = lat ? 64 : 4, cg0 = lat ? 128 + b * 64 : b * 4;
  f32x4 st[4];
#pragma unroll
  for (int kt = 0; kt < 4; ++kt)
#pragma unroll
    for (int r = 0; r < 4; ++r)
      st[kt][r] = lat ? p->in[8][((size_t)(((b * 2 + l) * 2 + dir) * 4 + hd) * 64 + kt * 16 + quad * 4 + r) * 64 + wave * 16 + lq] : 0.f;
  const int lrow = tid >> 2, seg = (tid & 3) * 16;
  struct GReg { u32x4 U[2], W[2], KT[2]; float g; };
  GReg R0, R1;
  u16* UWb = (u16*)(p->ws + WS_UW);
  const u16* KTb = (const u16*)(p->ws + WS_KT);
  const float* GV = (const float*)(p->ws + WS_GVEC);
  auto gload = [&](int n, GReg& R) {
    const int cgi = dir == 0 ? cg0 + n : cg0 + nch - 1 - n;
    const size_t prob = (size_t)cgi * 4 + hd, pd = prob * 2 + dir;
    const u16* u = UWb + (pd * 64 + lrow) * 128 + seg;
    R.U[0] = *(const u32x4*)u; R.U[1] = *(const u32x4*)(u + 8); R.W[0] = *(const u32x4*)(u + 64); R.W[1] = *(const u32x4*)(u + 72);
    const u16* kt = KTb + (prob * 64 + lrow) * 64 + (dir ? 48 - seg : seg);
    u32x4 a = *(const u32x4*)kt, bb = *(const u32x4*)(kt + 8);
    if (dir) { R.KT[0] = rev8(bb); R.KT[1] = rev8(a); } else { R.KT[0] = a; R.KT[1] = bb; }
    R.g = GV[pd * 256 + (tid & 255)];
  };
  gload(0, R0); gload(1, R1);
  auto step = [&](int n, GReg& R) {
    const int cgi = dir == 0 ? cg0 + n : cg0 + nch - 1 - n;
    const size_t pd = ((size_t)cgi * 4 + hd) * 2 + dir;
    __syncthreads();
    *(u32x4*)(sW + lrow * 72 + seg) = R.W[0]; *(u32x4*)(sW + lrow * 72 + seg + 8) = R.W[1];
    *(u32x4*)(sKT + lrow * 72 + seg) = R.KT[0]; *(u32x4*)(sKT + lrow * 72 + seg + 8) = R.KT[1];
    *(u32x4*)(sU + lrow * 72 + seg) = R.U[0]; *(u32x4*)(sU + lrow * 72 + seg + 8) = R.U[1];
    sg[tid] = R.g;
    __syncthreads();
    if (n + 2 < nch) gload(n + 2, R);
    u32x4* FR = (u32x4*)(UWb + pd * 8192);
    const float elast = sg[128];
    bf16x8 sB[2] = {pack8(st[0], st[1]), pack8(st[2], st[3])};
    FR[(0 * 4 + wave) * 64 + lane] = __builtin_bit_cast(u32x4, sB[0]);
    FR[(1 * 4 + wave) * 64 + lane] = __builtin_bit_cast(u32x4, sB[1]);
    f32x4 vn[4];
#pragma unroll
    for (int mt = 0; mt < 4; ++mt) {
      f32x4 acc = {0.f, 0.f, 0.f, 0.f};
#pragma unroll
      for (int s2 = 0; s2 < 2; ++s2) acc = MFMA16(ldperm(sW + (mt * 16 + lq) * 72 + s2 * 32 + quad * 4), sB[s2], acc);
#pragma unroll
      for (int r = 0; r < 4; ++r) vn[mt][r] = bf2f(sU[(mt * 16 + quad * 4 + r) * 72 + wave * 16 + lq]) - acc[r];
    }
    bf16x8 vB[2] = {pack8(vn[0], vn[1]), pack8(vn[2], vn[3])};
    FR[512 + (0 * 4 + wave) * 64 + lane] = __builtin_bit_cast(u32x4, vB[0]);
    FR[512 + (1 * 4 + wave) * 64 + lane] = __builtin_bit_cast(u32x4, vB[1]);
#pragma unroll
    for (int mt = 0; mt < 4; ++mt)
#pragma unroll
      for (int r = 0; r < 4; ++r) vn[mt][r] *= sg[64 + mt * 16 + quad * 4 + r];
    bf16x8 vsB[2] = {pack8(vn[0], vn[1]), pack8(vn[2], vn[3])};
#pragma unroll
    for (int kt = 0; kt < 4; ++kt) {
      f32x4 acc = {0.f, 0.f, 0.f, 0.f};
#pragma unroll
      for (int s2 = 0; s2 < 2; ++s2) acc = MFMA16(ldperm(sKT + (kt * 16 + lq) * 72 + s2 * 32 + quad * 4), vsB[s2], acc);
#pragma unroll
      for (int r = 0; r < 4; ++r) st[kt][r] = elast * st[kt][r] + acc[r];
    }
  };
  for (int n = 0; n < nch; n += 2) { step(n, R0); step(n + 1, R1); }
  if (!lat) {
#pragma unroll
    for (int kt = 0; kt < 4; ++kt)
#pragma unroll
      for (int r = 0; r < 4; ++r)
        p->out[O_GDN + ((size_t)(((b * 2 + l) * 2 + dir) * 4 + hd) * 64 + kt * 16 + quad * 4 + r) * 64 + wave * 16 + lq] = st[kt][r];
  }
  __syncthreads();
}

DI void gdnfin_item(KP p, int l, int item, unsigned char* smem) {
  u16* sQ = (u16*)smem; u16* sQK = sQ + 64 * 72;
  float* so = (float*)(smem + 3 * 64 * 72 * 2);
  float* seg_ = so + 64 * 65;
  const int cgi = item >> 2, hd = item & 3;
  const int tid = ltid(), lane = tid & 63, wave = tid >> 6, lq = lane & 15, quad = lane >> 4;
  const int lrow = tid >> 2, seg = (tid & 3) * 16;
  __syncthreads();
  {
    const u16* q = (const u16*)(p->ws + WS_QHAT) + ((size_t)item * 64 + lrow) * 64 + seg;
    *(u32x4*)(sQ + lrow * 72 + seg) = *(const u32x4*)q; *(u32x4*)(sQ + lrow * 72 + seg + 8) = *(const u32x4*)(q + 8);
#pragma unroll
    for (int dir = 0; dir < 2; ++dir) {
      const u16* qk = (const u16*)(p->ws + WS_QK) + ((size_t)(item * 2 + dir) * 64 + lrow) * 64 + seg;
      *(u32x4*)(sQK + (dir * 64 + lrow) * 72 + seg) = *(const u32x4*)qk; *(u32x4*)(sQK + (dir * 64 + lrow) * 72 + seg + 8) = *(const u32x4*)(qk + 8);
    }
    if (tid < 128) seg_[tid] = ((const float*)(p->ws + WS_GVEC))[(size_t)(item * 2 + (tid >> 6)) * 256 + (tid & 63)];
  }
  __syncthreads();
#pragma unroll
  for (int dir = 0; dir < 2; ++dir) {
    const u32x4* FR = (const u32x4*)((const u16*)(p->ws + WS_UW) + (size_t)(item * 2 + dir) * 8192);
    bf16x8 sfr[2], vfr[2];
#pragma unroll
    for (int s2 = 0; s2 < 2; ++s2) {
      sfr[s2] = __builtin_bit_cast(bf16x8, FR[(s2 * 4 + wave) * 64 + lane]);
      vfr[s2] = __builtin_bit_cast(bf16x8, FR[512 + (s2 * 4 + wave) * 64 + lane]);
    }
#pragma unroll
    for (int mt = 0; mt < 4; ++mt) {
      f32x4 acc = {0.f, 0.f, 0.f, 0.f};
      const int qrow = dir ? 63 - (mt * 16 + lq) : mt * 16 + lq;
#pragma unroll
      for (int s2 = 0; s2 < 2; ++s2) acc = MFMA16(ldperm(sQ + qrow * 72 + s2 * 32 + quad * 4), sfr[s2], acc);
#pragma unroll
      for (int r = 0; r < 4; ++r) acc[r] *= seg_[dir * 64 + mt * 16 + quad * 4 + r];
#pragma unroll
      for (int s2 = 0; s2 < 2; ++s2) acc = MFMA16(ldperm(sQK + (dir * 64 + mt * 16 + lq) * 72 + s2 * 32 + quad * 4), vfr[s2], acc);
#pragma unroll
      for (int r = 0; r < 4; ++r) {
        const int c = mt * 16 + quad * 4 + r;
        const int tk = dir ? 63 - c : c;
        float* d = so + tk * 65 + wave * 16 + lq;
        if (dir == 0) *d = acc[r]; else *d += acc[r];
      }
    }
    __syncthreads();
  }
  const float gn = p->in[28][l * 64 + lane];
  float zv[16];
#pragma unroll
  for (int q = 0; q < 16; ++q)
    zv[q] = bf2f(((const u16*)(p->ws + WS_INPROJ))[((size_t)cgi * 64 + wave * 16 + q) * LDI + C_GZ + hd * 64 + lane]);
#pragma unroll
  for (int q = 0; q < 16; ++q) {
    const int c = wave * 16 + q;
    const size_t row = (size_t)cgi * 64 + c;
    float o = so[c * 65 + lane];
    float ss = wave_sum(o * o);
    float y = o * rsqrtf(ss * (1.f / 64.f) + 1e-6f) * gn * siluf_(zv[q]);
    ((u16*)(p->ws + WS_BRANCH))[row * 1024 + 512 + hd * 64 + lane] = f2bf(y);
  }
}

#define XB_TMO      128
#define XB_XCNT(j)  (256  + 64 * (j))
#define XB_XSUB(j)  (1280 + 64 * (j))
#define XB_XGEN(j)  (2304 + 64 * (j))
#define XB_TOP      3328
#define XB_TOPGEN   3392
#define XB_SPIN_CAP (1u << 20)
#define LAS __attribute__((address_space(3)))
DI unsigned xb_ld(unsigned* q) { return __hip_atomic_load(q, __ATOMIC_RELAXED, __HIP_MEMORY_SCOPE_AGENT); }
DI unsigned xb_add(unsigned* q, unsigned v) { return __hip_atomic_fetch_add(q, v, __ATOMIC_RELAXED, __HIP_MEMORY_SCOPE_AGENT); }
DI unsigned xb_xcc_id() { return (unsigned)__builtin_amdgcn_s_getreg((3 << 11) | 20) & 0xFu; }
#define XB_SPIN(cond, bar) do { unsigned _sp = 0; while (cond) { __builtin_amdgcn_s_sleep(1); \
    if ((++_sp & 255u) == 0u) { if (xb_ld(&(bar)[XB_TMO])) break; if (_sp > XB_SPIN_CAP) { atomicAdd(&(bar)[XB_TMO], 1u); break; } } } } while (0)
DI void xcd_barrier_complete(unsigned* bar, unsigned x, unsigned& nloc, unsigned& nx) {
  const unsigned G = gridDim.x;
  unsigned sum, cnt, mine, sp = 0u;
  for (;;) {
    sum = 0u; cnt = 0u; mine = 0u;
#pragma unroll
    for (unsigned j = 0; j < 16; ++j) { const unsigned c = xb_ld(&bar[XB_XCNT(j)]); sum += c; cnt += (c > 0u) ? 1u : 0u; mine = (j == x) ? c : mine; }
    if (sum == G) break;
    __builtin_amdgcn_s_sleep(1);
    if ((++sp & 255u) == 0u) { if (xb_ld(&bar[XB_TMO])) break; if (sp > XB_SPIN_CAP) { atomicAdd(&bar[XB_TMO], 1u); break; } }
  }
  nloc = mine > 0u ? mine : 1u; nx = cnt > 0u ? cnt : 1u;
}
DI void xcd_barrier(unsigned* bar, volatile LAS unsigned* st) {
  asm volatile("s_waitcnt vmcnt(0)" ::: "memory");
  __syncthreads();
  if (ltid() == 0) {
    const unsigned x = xb_xcc_id();
    __builtin_amdgcn_s_waitcnt(0);
    unsigned nloc = st[0], nx = st[1];
    if (nloc == 0u) { xcd_barrier_complete(bar, x, nloc, nx); st[0] = nloc; st[1] = nx; }
    const unsigned old = xb_add(&bar[XB_XSUB(x)], 1u);
    const unsigned gen = old / nloc;
    if (old + 1u == (gen + 1u) * nloc) {
      __builtin_amdgcn_fence(__ATOMIC_RELEASE, "agent");
      asm volatile("s_waitcnt vmcnt(0)" ::: "memory");
      const unsigned og = xb_add(&bar[XB_TOP], 1u);
      const unsigned tg = og / nx;
      if (og + 1u == (tg + 1u) * nx) xb_add(&bar[XB_TOPGEN], 1u);
      else XB_SPIN(xb_ld(&bar[XB_TOPGEN]) == tg, bar);
      __builtin_amdgcn_fence(__ATOMIC_ACQUIRE, "agent");
      xb_add(&bar[XB_XGEN(x)], 1u);
      asm volatile("s_waitcnt vmcnt(0)" ::: "memory");
    } else {
      XB_SPIN(xb_ld(&bar[XB_XGEN(x)]) == gen, bar);
      __builtin_amdgcn_fence(__ATOMIC_ACQUIRE, "agent");
      asm volatile("s_waitcnt vmcnt(0)" ::: "memory");
    }
  }
  __syncthreads();
}


#define FOR_TILES(MTI, NTI, SM, SN, CALL)                                                      \
  do {                                                                                         \
    if (G % 8 != 0) { for (int it_ = B; it_ < (MTI) * (NTI); it_ += G) { const int mt = it_ / (NTI), nt = it_ % (NTI); CALL; } } \
    else {                                                                                     \
      const int xcd_ = B & 7, j_ = B >> 3, J_ = G >> 3;                                        \
      const int nsm_ = ((MTI) + (SM) - 1) / (SM), nsn_ = ((NTI) + (SN) - 1) / (SN);            \
      for (int s_ = xcd_; s_ < nsm_ * nsn_; s_ += 8) {                                         \
        const int sm_ = s_ / nsn_, sn_ = s_ % nsn_;                                            \
        for (int t_ = j_; t_ < (SM) * (SN); t_ += J_) {                                        \
          const int mt = sm_ * (SM) + t_ / (SN), nt = sn_ * (SN) + t_ % (SN);                  \
          if (mt < (MTI) && nt < (NTI)) { CALL; }                                              \
        }                                                                                      \
      }                                                                                        \
    }                                                                                          \
  } while (0)

constexpr int NPHASE = 21;
__global__ void __launch_bounds__(256, 2) mk(Params p_unused, int ph_lo, int ph_hi) {
  extern __shared__ __attribute__((aligned(1024))) unsigned char smem[];
  int& s_item = *(int*)(smem + SMEM_BYTES);
  u32x4& xb_words = *(u32x4*)(smem + SMEM_BYTES + 16);
  const int G = gridDim.x, B = blockIdx.x;
  const bool fused = ph_hi - ph_lo > 1;
  if (fused) {
    if (ltid() == 0) { xb_words = u32x4{0u, 0u, 0u, 0u}; (void)xb_add(&((unsigned*)(((KP)__builtin_amdgcn_kernarg_segment_ptr())->ws + WS_BAR))[XB_XCNT(xb_xcc_id())], 1u); }
    __syncthreads();
  }
  for (int ph = ph_lo; ph < ph_hi; ++ph) {
    KP p = (KP)__builtin_amdgcn_kernarg_segment_ptr();
    asm volatile("" : "+s"(p));
    if (ph == 0) {
      for (int it = B; it < 192 + CONV_ITEMS + 64; it += G) { for (int rep = 0; rep < NREP(0); ++rep) { if (it < 192) mod_item(p, it, smem); else if (it < 192 + CONV_ITEMS) convert_item(p, 0, it - 192, smem); else lruw_item(p, it - 192 - CONV_ITEMS); } }
    } else {
      const int l = (ph - 1) / 10, sub = (ph - 1) % 10;
      switch (sub) {
        case 0:
          for (int it = B; it < 2048 + (l ? CONV_ITEMS : 0); it += G) { if (it < 2048) norm_item<0>(p, l, it); else convert_item(p, l, it - 2048, smem); }
          break;
        case 1: FOR_TILES(128, 21, 8, 7, inproj_item(p, mt, nt, smem)); break;
        case 2:
          for (int it = B; it < 1024 + 512 + 64 + 2048; it += G) {
            if (it < 1024) { for (int rep = 0; rep < NREP(4); ++rep) gdn1_item(p, l, it, smem); }
            else if (it < 1536) { for (int rep = 0; rep < NREP(5); ++rep) lru_item<false>(p, l, it - 1024, smem); }
            else if (it < 1600) { if (PHON(6)) kvc_item(p, l, it - 1536); }
            else if (PHON(6)) prep_item(p, l, it - 1600);
          }
          break;
        case 3: {
          int* ctr = (int*)(p->ws + WS_CTR) + l;
          for (;;) {
            __syncthreads();
            if (ltid() == 0) s_item = atomicAdd(ctr, 1);
            __syncthreads();
            const int it = s_item;
            if (it >= 16 + 256 + 256 + 256 + 512 + 512) break;
            if (it < 16) gdn2_item(p, l, it, smem);
            else if (it < 272) { for (int rep = 0; rep < NREP(8); ++rep) attn_item(p, l, it - 16, smem); }
            else if (it < 528) gdn2_item(p, l, it - 272 + 16, smem);
            else if (it < 784) { for (int rep = 0; rep < NREP(8); ++rep) attn_item(p, l, it - 528 + 256, smem); }
            else if (it < 1296) { for (int rep = 0; rep < NREP(9); ++rep) lru_item<true>(p, l, it - 784, smem); }
            else for (int rep = 0; rep < NREP(8); ++rep) attn_item(p, l, it - 1296 + 512, smem);
          }
        } break;
        case 4: for (int it = B; it < 1024; it += G) gdnfin_item(p, l, it, smem); break;
        case 5: for (int rep = 0; rep < NREP(11); ++rep) FOR_TILES(128, 8, 8, 8, merge_item(p, l, mt, nt, smem)); break;
        case 6: FOR_TILES(128, 8, 8, 8, wout_item(p, l, mt, nt, smem)); break;
        case 7: for (int it = B; it < 2048; it += G) norm_item<1>(p, l, it); break;
        case 8: FOR_TILES(128, 32, 8, 8, w1_item(p, mt, nt, smem)); break;
        case 9: FOR_TILES(128, 8, 8, 8, w2_item(p, l, mt, nt, smem)); break;
      }
    }
    if (ph + 1 < ph_hi) {
      if (ph == ph_lo) cg::this_grid().sync();
      else for (int rep = 0; rep < NREP(1); ++rep) xcd_barrier((unsigned*)(p->ws + WS_BAR), (volatile LAS unsigned*)&xb_words);
    }
  }
}

extern "C" void kernel_launch(void* const* d_in, const int* in_sizes, int n_in, void* d_out, int out_size, void* d_ws, size_t ws_size, hipStream_t stream) {
  static int grid_blocks = 0;
  if (!grid_blocks) {
    int dev = 0, cus = 0, per_cu = 0;
    (void)hipGetDevice(&dev);
    (void)hipDeviceGetAttribute(&cus, hipDeviceAttributeMultiprocessorCount, dev);
    if (hipFuncSetAttribute((const void*)mk, hipFuncAttributeMaxDynamicSharedMemorySize, DYN_LDS) != hipSuccess) fprintf(stderr, "kernel_launch: hipFuncSetAttribute failed\n");
    (void)hipOccupancyMaxActiveBlocksPerMultiprocessor(&per_cu, mk, 256, DYN_LDS);
    if (per_cu < 1) per_cu = 1;
    if (per_cu > 2) per_cu = 2;
    grid_blocks = cus * per_cu;
    if (ws_size < WS_END) fprintf(stderr, "kernel_launch: workspace too small: %zu < %zu\n", ws_size, (size_t)WS_END);
  }
  if (hipMemsetAsync((char*)d_ws + WS_CTR, 0, 256 + 3456 * 4 + 256, stream) != hipSuccess) fprintf(stderr, "kernel_launch: memset failed\n");
  Params p{};
  for (int i = 0; i < 37; ++i) p.in[i] = (const float*)d_in[i];
  p.out = (float*)d_out; p.ws = (unsigned char*)d_ws;
#if MULTI_LAUNCH
  for (int ph = 0; ph < NPHASE; ++ph) hipLaunchKernelGGL(mk, dim3(grid_blocks), dim3(256), DYN_LDS, stream, p, ph, ph + 1);
#else
  int lo = 0, hi = NPHASE;
  void* args[] = {&p, &lo, &hi};
  hipError_t e = hipLaunchCooperativeKernel((void*)mk, dim3(grid_blocks), dim3(256), args, DYN_LDS, stream);
  if (e != hipSuccess) fprintf(stderr, "cooperative launch failed: %s (grid %d)\n", hipGetErrorString(e), grid_blocks);
#endif
}
```

```cpp
#include <hip/hip_runtime.h>
#include <hip/hip_cooperative_groups.h>
#include <cstdio>
namespace cg = cooperative_groups;

#ifndef MULTI_LAUNCH
#define MULTI_LAUNCH 0
#endif
#ifndef PHM
#define PHM 0xFFFFFFFFu
#endif
#define PHON(b) ((PHM >> (b)) & 1u)
#ifndef DUPM
#define DUPM 0u
#endif
#define NREP(b) (1 + ((DUPM >> (b)) & 1u))

typedef unsigned short u16;
using bf16x8 = __attribute__((ext_vector_type(8))) short;
using f32x4 = __attribute__((ext_vector_type(4))) float;
using u32x4 = __attribute__((ext_vector_type(4))) unsigned;
#define DI __device__ __forceinline__
#define MFMA16(a, b, c) __builtin_amdgcn_mfma_f32_16x16x32_bf16((a), (b), (c), 0, 0, 0)

constexpr int NTOK = 16384;
constexpr int DM = 1024;
constexpr int LDI = 2592;
constexpr int C_AQ = 0, C_AK = 256, C_AV = 384, C_LX = 512, C_LG = 768, C_GQ = 1024, C_GK = 1280, C_GV = 1536, C_GZ = 1792,
              C_DQ = 2048, C_DK = 2304, C_DV = 2432, C_GA = 2560, C_GB = 2568;
constexpr int NIN_PAD = 2688;

constexpr size_t WS_MOD = 0;
constexpr size_t WS_CTR = WS_MOD + 2 * 3 * 6144 * 4;
constexpr size_t WS_BAR = WS_CTR + 256;
constexpr size_t WS_LRUC = WS_BAR + 3456 * 4 + 256;
constexpr size_t WS_KC = WS_LRUC + (size_t)512 * 2 * 2 * 256 * 4;
constexpr size_t WS_GVEC = WS_KC + (size_t)16 * 512 * 64 * 2;
constexpr size_t WS_LRUW = WS_GVEC + (size_t)1024 * 2 * 256 * 4;
constexpr size_t WS_VT = WS_LRUW + (size_t)256 * 64 * 16;
constexpr size_t WS_WIN = WS_VT + (size_t)8 * 64 * 4608 * 2;
constexpr size_t WS_WM = WS_WIN + (size_t)NIN_PAD * 1024 * 2;
constexpr size_t WS_WB = WS_WM + (size_t)4096 * 1024 * 2;
constexpr size_t WS_WO = WS_WB + (size_t)4 * 1024 * 256 * 2;
constexpr size_t WS_W1 = WS_WO + (size_t)1024 * 1024 * 2;
constexpr size_t WS_W2 = WS_W1 + (size_t)4096 * 1024 * 2;
constexpr size_t WS_H = WS_W2 + (size_t)1024 * 4096 * 2;
constexpr size_t WS_BIG = WS_H + (size_t)NTOK * 1024 * 2;
constexpr size_t WS_INPROJ = WS_BIG;
constexpr size_t WS_BRANCH = WS_INPROJ + (size_t)NTOK * LDI * 2;
constexpr size_t WS_QHAT = WS_BRANCH + (size_t)NTOK * 1024 * 2;
constexpr size_t WS_KT = WS_QHAT + (size_t)1024 * 4096 * 2;
constexpr size_t WS_UW = WS_KT + (size_t)1024 * 4096 * 2;
constexpr size_t WS_QK = WS_UW + (size_t)1024 * 2 * 8192 * 2;
constexpr size_t WS_END = WS_QK + (size_t)1024 * 2 * 4096 * 2;
constexpr size_t WS_HIDDEN = WS_BIG;
constexpr size_t WS_MERGED = WS_BIG;
static_assert(WS_HIDDEN + (size_t)NTOK * 4096 * 2 <= WS_END, "hidden must fit");
static_assert(WS_END <= (size_t)256 * 1024 * 1024, "workspace budget");

constexpr size_t O_X = 0, O_AK = 16777216, O_AV = 18874368, O_DK = 20971520, O_DV = 23068672, O_LRU = 25165824, O_GDN = 25198592;

struct Params {
  const float* in[37];
  float* out;
  unsigned char* ws;
};

typedef const Params __attribute__((address_space(4)))* KP;
constexpr int SMEM_BYTES = 65536;
constexpr int DYN_LDS = SMEM_BYTES + 64;

DI int ltid() { int t = threadIdx.x; asm volatile("" : "+v"(t)); return t; }
typedef __bf16 bf16v2 __attribute__((ext_vector_type(2)));
DI u16 f2bf(float x) { __bf16 h = (__bf16)x; return __builtin_bit_cast(u16, h); }
DI float bf2f(u16 h) { return __uint_as_float(((unsigned)h) << 16); }
DI unsigned pack2(float a, float b) { bf16v2 v = {(__bf16)a, (__bf16)b}; return __builtin_bit_cast(unsigned, v); }
DI float bflo(unsigned u) { return __uint_as_float(u << 16); }
DI float bfhi(unsigned u) { return __uint_as_float(u & 0xffff0000u); }
DI float sigm(float x) { return 1.f / (1.f + __expf(-x)); }
DI float siluf_(float x) { return x / (1.f + __expf(-x)); }
DI float softplusf_(float x) { return x > 20.f ? x : log1pf(__expf(x)); }
DI float gelu_tanh(float x) { float u = 0.7978845608028654f * (x + 0.044715f * x * x * x); float t = 1.f - 2.f / (__expf(2.f * u) + 1.f); return 0.5f * x * (1.f + t); }
DI float wave_sum(float v) {
#pragma unroll
  for (int o = 32; o > 0; o >>= 1) v += __shfl_xor(v, o, 64);
  return v;
}
DI u32x4 mku4(unsigned a, unsigned b, unsigned c, unsigned d) { u32x4 v = {a, b, c, d}; return v; }
DI bf16x8 mk8(unsigned a, unsigned b, unsigned c, unsigned d) { u32x4 v = {a, b, c, d}; return __builtin_bit_cast(bf16x8, v); }
DI bf16x8 pack8(const f32x4& x, const f32x4& y) { return mk8(pack2(x[0], x[1]), pack2(x[2], x[3]), pack2(y[0], y[1]), pack2(y[2], y[3])); }
DI bf16x8 ld8(const u16* p) { return *(const bf16x8*)p; }
DI bf16x8 ldperm(const u16* p) { uint2 a = *(const uint2*)p; uint2 b = *(const uint2*)(p + 16); return mk8(a.x, a.y, b.x, b.y); }
DI int mod_group(int row) { return row < 8192 ? 0 : 1 + ((row - 8192) >> 12); }
DI const float* x_in_row(KP p, int l, int row) {
  if (l == 0) return row < 8192 ? p->in[0] + (size_t)row * DM : p->in[1] + (size_t)(row - 8192) * DM;
  return p->out + (size_t)row * DM;
}
DI unsigned swap16(unsigned u) { return (u >> 16) | (u << 16); }
DI u32x4 rev8(u32x4 v) { return mku4(swap16(v.w), swap16(v.z), swap16(v.y), swap16(v.x)); }

DI void mod_item(KP p, int item, unsigned char* smem) {
  float* sc = (float*)smem;
  float* sr = sc + 3072;
  const int tid = ltid();
  const int l = item / 96, cb = item % 96;
  for (int i = tid; i < 3072; i += 256) {
    int g = i >> 10, k = i & 1023;
    float c = g == 0 ? p->in[9][k] : p->in[2][(g - 1) * 1024 + k];
    sc[i] = siluf_(c);
  }
  __syncthreads();
  const int col = cb * 64 + (tid & 63), kg = tid >> 6;
  const float* W = p->in[10] + (size_t)l * 1024 * 6144;
  float a0 = 0.f, a1 = 0.f, a2 = 0.f;
  for (int k = kg * 256; k < kg * 256 + 256; ++k) {
    float w = W[(size_t)k * 6144 + col];
    a0 += sc[k] * w; a1 += sc[1024 + k] * w; a2 += sc[2048 + k] * w;
  }
  sr[(kg * 3 + 0) * 64 + (tid & 63)] = a0; sr[(kg * 3 + 1) * 64 + (tid & 63)] = a1; sr[(kg * 3 + 2) * 64 + (tid & 63)] = a2;
  __syncthreads();
  if (tid < 192) {
    int g = tid >> 6, cc = tid & 63;
    float s = p->in[11][l * 6144 + cb * 64 + cc];
    for (int q = 0; q < 4; ++q) s += sr[(q * 3 + g) * 64 + cc];
    ((float*)(p->ws + WS_MOD))[(l * 3 + g) * 6144 + cb * 64 + cc] = s;
  }
  __syncthreads();
}

DI void conv_tile(const float* src, int N, int k0, int n0, u16* dst, int K, bool perm, unsigned char* smem) {
  float* tile = (float*)smem;
  const int tid = ltid();
#pragma unroll
  for (int i = 0; i < 4; ++i) {
    int kr = (tid >> 4) + 16 * i, nc = (tid & 15) * 4;
    float4 v = make_float4(0.f, 0.f, 0.f, 0.f);
    if (n0 + nc < N) v = *(const float4*)(src + (size_t)(k0 + kr) * N + n0 + nc);
    tile[kr * 65 + nc] = v.x; tile[kr * 65 + nc + 1] = v.y; tile[kr * 65 + nc + 2] = v.z; tile[kr * 65 + nc + 3] = v.w;
  }
  __syncthreads();
#pragma unroll
  for (int i = 0; i < 2; ++i) {
    int n = (tid >> 3) + 32 * i, k8 = (tid & 7) * 8;
    int ng = n0 + n;
    if (ng < N) {
      int row = ng;
      if (perm) row = ng < 2048 ? ng : (ng < 2064 ? 2560 + (ng - 2048) : ng - 16);
      u32x4 o;
      o.x = pack2(tile[(k8 + 0) * 65 + n], tile[(k8 + 1) * 65 + n]);
      o.y = pack2(tile[(k8 + 2) * 65 + n], tile[(k8 + 3) * 65 + n]);
      o.z = pack2(tile[(k8 + 4) * 65 + n], tile[(k8 + 5) * 65 + n]);
      o.w = pack2(tile[(k8 + 6) * 65 + n], tile[(k8 + 7) * 65 + n]);
      *(u32x4*)(dst + (size_t)row * K + k0 + k8) = o;
    }
  }
  __syncthreads();
}

constexpr int CONV_ITEMS = 4241;
DI void convert_item(KP p, int l, int item, unsigned char* smem) {
  unsigned char* ws = p->ws;
  if (item < 656) { int kt = item / 41, nt = item % 41; conv_tile(p->in[14] + (size_t)l * 1024 * 2576, 2576, kt * 64, nt * 64, (u16*)(ws + WS_WIN), 1024, true, smem); return; }
  item -= 656;
  if (item < 1024) { int kt = item >> 6, nt = item & 63; conv_tile(p->in[32] + (size_t)l * 1024 * 4096, 4096, kt * 64, nt * 64, (u16*)(ws + WS_WM), 1024, false, smem); return; }
  item -= 1024;
  if (item < 256) { int m = item >> 6, r = item & 63, kt = r >> 4, nt = r & 15;
    conv_tile(p->in[31] + ((size_t)l * 4 + m) * 256 * 1024, 1024, kt * 64, nt * 64, (u16*)(ws + WS_WB) + (size_t)m * 1024 * 256, 256, false, smem); return; }
  item -= 256;
  if (item < 256) { int kt = item >> 4, nt = item & 15; conv_tile(p->in[34] + (size_t)l * 1024 * 1024, 1024, kt * 64, nt * 64, (u16*)(ws + WS_WO), 1024, false, smem); return; }
  item -= 256;
  if (item < 1024) { int kt = item >> 6, nt = item & 63; conv_tile(p->in[35] + (size_t)l * 1024 * 4096, 4096, kt * 64, nt * 64, (u16*)(ws + WS_W1), 1024, false, smem); return; }
  item -= 1024;
  if (item < 1024) { int kt = item >> 4, nt = item & 15; conv_tile(p->in[36] + (size_t)l * 4096 * 1024, 1024, kt * 64, nt * 64, (u16*)(ws + WS_W2), 4096, false, smem); return; }
  u32x4* z = (u32x4*)((u16*)(ws + WS_WIN) + (size_t)2576 * 1024);
  for (int i = ltid(); i < 112 * 1024 / 8; i += 256) z[i] = mku4(0, 0, 0, 0);
}

DI void lruw_item(KP p, int item) {
  const int gid = item * 256 + ltid();
  const int lane = gid & 63, fg = gid >> 6;
  const int s2 = fg & 1, j = (fg >> 1) & 3, n = (fg >> 3) & 3, g = (fg >> 5) & 1, ld_ = fg >> 6;
  const int lq = lane & 15, quad = lane >> 4;
  const float* W = (g == 0 ? p->in[20] : p->in[22]) + ((size_t)(ld_ * 4 + n) * 64) * 64 + (size_t)(s2 * 32 + quad * 8) * 64 + j * 16 + lq;
  u32x4 o = {pack2(W[0], W[64]), pack2(W[128], W[192]), pack2(W[256], W[320]), pack2(W[384], W[448])};
  ((u32x4*)(p->ws + WS_LRUW))[gid] = o;
}

template <int which>
DI void norm_item(KP p, int l, int item) {
  const int tid = ltid(), lane = tid & 63, wave = tid >> 6;
  const float* g = p->in[which == 0 ? 12 : 13] + l * 1024;
  f32x4 v[2][4]; float ss[2] = {0.f, 0.f};
#pragma unroll
  for (int h = 0; h < 2; ++h) {
    const int row = item * 8 + wave * 2 + h;
    const float* x = x_in_row(p, which == 0 ? l : 2, row);
#pragma unroll
    for (int i = 0; i < 4; ++i) v[h][i] = *(const f32x4*)(x + i * 256 + lane * 4);
  }
#pragma unroll
  for (int h = 0; h < 2; ++h) {
#pragma unroll
    for (int i = 0; i < 4; ++i) ss[h] += v[h][i].x * v[h][i].x + v[h][i].y * v[h][i].y + v[h][i].z * v[h][i].z + v[h][i].w * v[h][i].w;
    ss[h] = wave_sum(ss[h]);
  }
#pragma unroll
  for (int h = 0; h < 2; ++h) {
    const int row = item * 8 + wave * 2 + h;
    const float* mod = (const float*)(p->ws + WS_MOD) + (l * 3 + mod_group(row)) * 6144;
    const float* sh = mod + (which == 0 ? 0 : 3072);
    const float* sc = mod + (which == 0 ? 1024 : 4096);
    const float rstd = rsqrtf(ss[h] * (1.f / 1024.f) + 1e-6f);
    u16* H = (u16*)(p->ws + WS_H) + (size_t)row * 1024;
#pragma unroll
    for (int i = 0; i < 4; ++i) {
      int c = i * 256 + lane * 4;
      float4 gg = *(const float4*)(g + c), s1 = *(const float4*)(sc + c), s0 = *(const float4*)(sh + c);
      float y0 = v[h][i].x * rstd * gg.x * (1.f + s1.x) + s0.x, y1 = v[h][i].y * rstd * gg.y * (1.f + s1.y) + s0.y;
      float y2 = v[h][i].z * rstd * gg.z * (1.f + s1.z) + s0.z, y3 = v[h][i].w * rstd * gg.w * (1.f + s1.w) + s0.w;
      *(uint2*)(H + c) = make_uint2(pack2(y0, y1), pack2(y2, y3));
    }
  }
}

DI int lds_byte(int r, int c) {
  int st = (r >> 4) * 2 + (c >> 5), ob = (r & 15) * 64 + (c & 31) * 2;
  return st * 1024 + (ob ^ (((ob >> 9) & 1) << 5));
}
DI void stage_rc(int b, int& R, int& C) {
  int st = b >> 10, sb = b & 1023, swz = sb ^ (((sb >> 9) & 1) << 5);
  R = (st >> 1) * 16 + (swz >> 6);
  C = (st & 1) * 32 + ((swz & 63) >> 1);
}
template <int MT, int NT, bool pre = false>
DI void gemm_acc(f32x4 (&acc)[MT][NT], const u16* __restrict__ A, int lda, const u16* __restrict__ Bt, int ldb, int K, unsigned char* smem,
                 const u16* nxtA = nullptr, int nlda = 0, const u16* nxtB = nullptr, int nldb = 0) {
  constexpr int TA = MT * 32 * 128, TB = NT * 32 * 128, STAGE = TA + TB;
  static_assert(2 * STAGE <= 65536, "LDS");
  const int tid = ltid(), lane = tid & 63, wid = tid >> 6, wm = wid >> 1, wn = wid & 1;
  const int fr = lane & 15, fq = lane >> 4;
  const u16* ga[MT]; const u16* gb[NT];
#pragma unroll
  for (int i = 0; i < MT; ++i) { int R, C; stage_rc(wid * 1024 + i * 4096 + lane * 16, R, C); ga[i] = A + (size_t)R * lda + C; }
#pragma unroll
  for (int i = 0; i < NT; ++i) { int R, C; stage_rc(wid * 1024 + i * 4096 + lane * 16, R, C); gb[i] = Bt + (size_t)R * ldb + C; }
#define GLDS_STAGE(buf, k0)                                                                                                        \
  do {                                                                                                                             \
    _Pragma("unroll") for (int i = 0; i < MT; ++i)                                                                                 \
      __builtin_amdgcn_global_load_lds((const unsigned*)(ga[i] + (k0)), (unsigned*)(smem + (buf) * STAGE + wid * 1024 + i * 4096), 16, 0, 0); \
    _Pragma("unroll") for (int i = 0; i < NT; ++i)                                                                                 \
      __builtin_amdgcn_global_load_lds((const unsigned*)(gb[i] + (k0)), (unsigned*)(smem + (buf) * STAGE + TA + wid * 1024 + i * 4096), 16, 0, 0); \
  } while (0)
  if (!pre) {
    __syncthreads();
    GLDS_STAGE(0, 0);
  }
  asm volatile("s_waitcnt vmcnt(0)" ::: "memory");
  __syncthreads();
  const int nt = K >> 6;
  for (int t = 0; t < nt; ++t) {
    const int cur = t & 1;
    if (t + 1 < nt) GLDS_STAGE(cur ^ 1, (t + 1) * 64);
    const unsigned char* sA = smem + cur * STAGE;
    const unsigned char* sB = sA + TA;
    if constexpr (!pre) {
      bf16x8 bfr[2][NT], af[2][MT];
#pragma unroll
      for (int s = 0; s < 2; ++s) {
#pragma unroll
        for (int j = 0; j < NT; ++j) bfr[s][j] = *(const bf16x8*)(sB + lds_byte(wn * NT * 16 + j * 16 + fr, s * 32 + fq * 8));
#pragma unroll
        for (int i = 0; i < MT; ++i) af[s][i] = *(const bf16x8*)(sA + lds_byte(wm * MT * 16 + i * 16 + fr, s * 32 + fq * 8));
      }
#pragma unroll
      for (int s = 0; s < 2; ++s)
#pragma unroll
        for (int i = 0; i < MT; ++i)
#pragma unroll
          for (int j = 0; j < NT; ++j) acc[i][j] = MFMA16(af[s][i], bfr[s][j], acc[i][j]);
      __builtin_amdgcn_sched_group_barrier(0x100, MT + NT, 0);
#pragma unroll
      for (int q = 0; q < MT + NT; ++q) { __builtin_amdgcn_sched_group_barrier(0x008, 2, 0); __builtin_amdgcn_sched_group_barrier(0x100, 1, 0); }
      __builtin_amdgcn_sched_group_barrier(0x008, 2 * MT * NT - 2 * (MT + NT), 0);
    } else {
#pragma unroll
      for (int s = 0; s < 2; ++s) {
        bf16x8 bfr[NT], af[MT];
#pragma unroll
        for (int j = 0; j < NT; ++j) bfr[j] = *(const bf16x8*)(sB + lds_byte(wn * NT * 16 + j * 16 + fr, s * 32 + fq * 8));
#pragma unroll
        for (int i = 0; i < MT; ++i) af[i] = *(const bf16x8*)(sA + lds_byte(wm * MT * 16 + i * 16 + fr, s * 32 + fq * 8));
#pragma unroll
        for (int i = 0; i < MT; ++i)
#pragma unroll
          for (int j = 0; j < NT; ++j) acc[i][j] = MFMA16(af[i], bfr[j], acc[i][j]);
      }
    }
    asm volatile("s_waitcnt vmcnt(0)" ::: "memory");
    __syncthreads();
  }
  if (nxtA) {
#pragma unroll
    for (int i = 0; i < MT; ++i) { int R, C; stage_rc(wid * 1024 + i * 4096 + lane * 16, R, C);
      __builtin_amdgcn_global_load_lds((const unsigned*)(nxtA + (unsigned)(R * nlda + C)), (unsigned*)(smem + wid * 1024 + i * 4096), 16, 0, 0); }
#pragma unroll
    for (int i = 0; i < NT; ++i) { int R, C; stage_rc(wid * 1024 + i * 4096 + lane * 16, R, C);
      __builtin_amdgcn_global_load_lds((const unsigned*)(nxtB + (unsigned)(R * nldb + C)), (unsigned*)(smem + TA + wid * 1024 + i * 4096), 16, 0, 0); }
  }
#undef GLDS_STAGE
}

template <int MT, int NT>
DI void gemm_prefetch(const u16* A, int lda, const u16* Bt, int ldb, unsigned char* smem) {
  constexpr int TA = MT * 32 * 128;
  const int tid = ltid(), lane = tid & 63, wid = tid >> 6;
  __syncthreads();
#pragma unroll
  for (int i = 0; i < MT; ++i) { int R, C; stage_rc(wid * 1024 + i * 4096 + lane * 16, R, C);
    __builtin_amdgcn_global_load_lds((const unsigned*)(A + (unsigned)(R * lda + C)), (unsigned*)(smem + wid * 1024 + i * 4096), 16, 0, 0); }
#pragma unroll
  for (int i = 0; i < NT; ++i) { int R, C; stage_rc(wid * 1024 + i * 4096 + lane * 16, R, C);
    __builtin_amdgcn_global_load_lds((const unsigned*)(Bt + (unsigned)(R * ldb + C)), (unsigned*)(smem + TA + wid * 1024 + i * 4096), 16, 0, 0); }
}

template <int MT, int NT> DI void zero_acc(f32x4 (&acc)[MT][NT]) {
#pragma unroll
  for (int i = 0; i < MT; ++i)
#pragma unroll
    for (int j = 0; j < NT; ++j) acc[i][j] = f32x4{0.f, 0.f, 0.f, 0.f};
}

#define EPI_LOOP(MT, NT)                                                          \
  const int tid_ = ltid(), lane_ = tid_ & 63, wave_ = tid_ >> 6;                   \
  const int wm_ = wave_ >> 1, wn_ = wave_ & 1, lq_ = lane_ & 15, quad_ = lane_ >> 4; \
  _Pragma("unroll") for (int i = 0; i < MT; ++i)                                   \
  _Pragma("unroll") for (int j = 0; j < NT; ++j)                                   \
  _Pragma("unroll") for (int r = 0; r < 4; ++r)
#define EPI_ROW(m0, MT) ((m0) + wm_ * (MT) * 16 + i * 16 + quad_ * 4 + r)
#define EPI_COL(n0, NT) ((n0) + wn_ * (NT) * 16 + j * 16 + lq_)

constexpr int GMT = 4;
DI void inproj_item(KP p, int mt, int nt, unsigned char* smem) {
  const int m0 = mt * (GMT * 32), n0 = nt * 128;
  f32x4 acc[GMT][4]; zero_acc<GMT, 4>(acc);
  gemm_acc<GMT, 4>(acc, (const u16*)(p->ws + WS_H) + (size_t)m0 * 1024, 1024, (const u16*)(p->ws + WS_WIN) + (size_t)n0 * 1024, 1024, 1024, smem);
  u16* C = (u16*)(p->ws + WS_INPROJ);
  EPI_LOOP(GMT, 4) { int row = EPI_ROW(m0, GMT), col = EPI_COL(n0, 4); if (col < LDI) C[(size_t)row * LDI + col] = f2bf(acc[i][j][r]); }
}

DI void merge_item(KP p, int l, int mt, int nt, unsigned char* smem) {
  const int m0 = mt * 128, n0 = nt * 128;
  const u16* H = (const u16*)(p->ws + WS_H) + (size_t)m0 * 1024;
  const u16* BR = (const u16*)(p->ws + WS_BRANCH) + (size_t)m0 * 1024;
  const float* bm = p->in[33] + l * 4096;
  const u16* WM = (const u16*)(p->ws + WS_WM) + (size_t)n0 * 1024;
  const u16* WB = (const u16*)(p->ws + WS_WB) + (size_t)n0 * 256;
  unsigned am[4][4][2];
#pragma unroll
  for (int i = 0; i < 4; ++i)
#pragma unroll
    for (int j = 0; j < 4; ++j) { am[i][j][0] = 0u; am[i][j][1] = 0u; }
  gemm_prefetch<4, 4>(BR, 1024, WB, 256, smem);
#pragma unroll 1
  for (int m = 0; m < 4; ++m) {
    f32x4 acc[4][4]; zero_acc<4, 4>(acc);
    gemm_acc<4, 4, true>(acc, BR + m * 256, 1024, WB + (size_t)m * 1024 * 256, 256, 256, smem, H, 1024, WM + (size_t)m * 1024 * 1024, 1024);
    unsigned pp[4][4][2];
#pragma unroll
    for (int i = 0; i < 4; ++i)
#pragma unroll
      for (int j = 0; j < 4; ++j) { pp[i][j][0] = pack2(acc[i][j][0], acc[i][j][1]); pp[i][j][1] = pack2(acc[i][j][2], acc[i][j][3]); }
    zero_acc<4, 4>(acc);
    gemm_acc<4, 4, true>(acc, H, 1024, WM + (size_t)m * 1024 * 1024, 1024, 1024, smem,
                         m < 3 ? BR + (m + 1) * 256 : nullptr, 1024, WB + (size_t)(m + 1) * 1024 * 256, 256);
    {
      const int tid_ = ltid(), wn_ = (tid_ >> 6) & 1, lq_ = tid_ & 15;
      float bias4[4];
#pragma unroll
      for (int j = 0; j < 4; ++j) bias4[j] = bm[m * 1024 + n0 + wn_ * 64 + j * 16 + lq_];
#pragma unroll
      for (int i = 0; i < 4; ++i) {
#pragma unroll
        for (int j = 0; j < 4; ++j) {
          float v0 = bflo(am[i][j][0]) + sigm(acc[i][j][0] + bias4[j]) * bflo(pp[i][j][0]);
          float v1 = bfhi(am[i][j][0]) + sigm(acc[i][j][1] + bias4[j]) * bfhi(pp[i][j][0]);
          float v2 = bflo(am[i][j][1]) + sigm(acc[i][j][2] + bias4[j]) * bflo(pp[i][j][1]);
          float v3 = bfhi(am[i][j][1]) + sigm(acc[i][j][3] + bias4[j]) * bfhi(pp[i][j][1]);
          am[i][j][0] = pack2(v0, v1); am[i][j][1] = pack2(v2, v3);
          asm volatile("" : "+v"(am[i][j][0]), "+v"(am[i][j][1]));
          __builtin_amdgcn_sched_barrier(0);
        }
      }
    }
  }
  u16* C = (u16*)(p->ws + WS_MERGED);
  EPI_LOOP(4, 4) { int row = EPI_ROW(m0, 4), col = EPI_COL(n0, 4); const unsigned w = am[i][j][r >> 1]; C[(size_t)row * 1024 + col] = (u16)((r & 1) ? (w >> 16) : (w & 0xffffu)); }
}

DI void wout_item(KP p, int l, int mt, int nt, unsigned char* smem) {
  const int m0 = mt * (GMT * 32), n0 = nt * 128;
  f32x4 acc[GMT][4]; zero_acc<GMT, 4>(acc);
  gemm_acc<GMT, 4>(acc, (const u16*)(p->ws + WS_MERGED) + (size_t)m0 * 1024, 1024, (const u16*)(p->ws + WS_WO) + (size_t)n0 * 1024, 1024, 1024, smem);
  const float* g1 = (const float*)(p->ws + WS_MOD) + (l * 3 + mod_group(m0)) * 6144 + 2048;
  EPI_LOOP(GMT, 4) { int row = EPI_ROW(m0, GMT), col = EPI_COL(n0, 4); p->out[(size_t)row * DM + col] = x_in_row(p, l, row)[col] + g1[col] * acc[i][j][r]; }
}

DI void w1_item(KP p, int mt, int nt, unsigned char* smem) {
  const int m0 = mt * (GMT * 32), n0 = nt * 128;
  f32x4 acc[GMT][4]; zero_acc<GMT, 4>(acc);
  gemm_acc<GMT, 4>(acc, (const u16*)(p->ws + WS_H) + (size_t)m0 * 1024, 1024, (const u16*)(p->ws + WS_W1) + (size_t)n0 * 1024, 1024, 1024, smem);
  u16* C = (u16*)(p->ws + WS_HIDDEN);
  EPI_LOOP(GMT, 4) { int row = EPI_ROW(m0, GMT), col = EPI_COL(n0, 4); float v = fmaxf(acc[i][j][r], 0.f); C[(size_t)row * 4096 + col] = f2bf(v * v); }
}

DI void w2_item(KP p, int l, int mt, int nt, unsigned char* smem) {
  const int m0 = mt * (GMT * 32), n0 = nt * 128;
  f32x4 acc[GMT][4]; zero_acc<GMT, 4>(acc);
  gemm_acc<GMT, 4>(acc, (const u16*)(p->ws + WS_HIDDEN) + (size_t)m0 * 4096, 4096, (const u16*)(p->ws + WS_W2) + (size_t)n0 * 4096, 4096, 4096, smem);
  const float* g2 = (const float*)(p->ws + WS_MOD) + (l * 3 + mod_group(m0)) * 6144 + 5120;
  EPI_LOOP(GMT, 4) { int row = EPI_ROW(m0, GMT), col = EPI_COL(n0, 4); float* o = p->out + (size_t)row * DM + col; *o = *o + g2[col] * acc[i][j][r]; }
}

DI void prep_load(const u16* R, int lane, float (&hv)[12], float (&vv4)[4]) {
#pragma unroll
  for (int hh = 0; hh < 12; ++hh) {
    const int col = hh < 4 ? C_AQ + hh * 64 : (hh < 6 ? C_AK + (hh - 4) * 64 : (hh < 10 ? C_DQ + (hh - 6) * 64 : C_DK + (hh - 10) * 64));
    hv[hh] = bf2f(R[col + lane]);
  }
  vv4[0] = bf2f(R[C_AV + lane]); vv4[1] = bf2f(R[C_AV + 64 + lane]); vv4[2] = bf2f(R[C_DV + lane]); vv4[3] = bf2f(R[C_DV + 64 + lane]);
}
DI void prep_token(KP p, int l, int row, int lane, u16* R, const float (&hv)[12], const float (&vv4)[4]) {
  const bool lat = row >= 8192;
  float cs = 1.f, sn = 0.f;
  if (lat) {
    int t = (row - 8192) & 4095;
    int pos = (lane < 32) ? (t >> 6) : (t & 63);
    float inv = __expf(-(float)(lane & 15) * (9.210340371976184f / 16.f));
    float ang = (float)pos * inv;
    cs = __cosf(ang); sn = __sinf(ang);
  }
  const int b = row >> 8, t = row & 255;
#pragma unroll
  for (int hh = 0; hh < 12; ++hh) {
    int col; const float* g;
    if (hh < 4) { col = C_AQ + hh * 64; g = p->in[15] + l * 64; }
    else if (hh < 6) { col = C_AK + (hh - 4) * 64; g = p->in[16] + l * 64; }
    else if (hh < 10) { col = C_DQ + (hh - 6) * 64; g = p->in[29] + l * 64; }
    else { col = C_DK + (hh - 10) * 64; g = p->in[30] + l * 64; }
    float v = hv[hh];
    float ss = wave_sum(v * v);
    float y = v * rsqrtf(ss * (1.f / 64.f) + 1e-6f) * g[lane];
    if (lat) {
      float yp = __shfl_xor(y, 16, 64);
      y = ((lane & 31) < 16) ? (y * cs - yp * sn) : (y * cs + yp * sn);
    } else {
      if (hh == 4 || hh == 5) p->out[O_AK + ((size_t)(b * 2 + l) * 256 + t) * 128 + (hh - 4) * 64 + lane] = y;
      if (hh >= 10) p->out[O_DK + ((size_t)(b * 2 + l) * 256 + t) * 128 + (hh - 10) * 64 + lane] = y;
    }
    R[col + lane] = f2bf(y);
  }
  if (lat) {
    const int bl = (row - 8192) >> 12, tl = (row - 8192) & 4095;
    u16* VT = (u16*)(p->ws + WS_VT) + (size_t)lane * 4608 + 512 + tl;
#pragma unroll
    for (int q = 0; q < 4; ++q)
      VT[(size_t)(((q >> 1) * 2 + bl) * 2 + (q & 1)) * 64 * 4608] = f2bf(vv4[q]);
  }
  if (!lat) {
    size_t o = ((size_t)(b * 2 + l) * 256 + t) * 128;
    p->out[O_AV + o + lane] = vv4[0]; p->out[O_AV + o + 64 + lane] = vv4[1];
    p->out[O_DV + o + lane] = vv4[2]; p->out[O_DV + o + 64 + lane] = vv4[3];
  }
}
DI void prep_item(KP p, int l, int item) {
  const int tid = ltid(), lane = tid & 63, wave = tid >> 6;
  const int row0 = item * 8 + wave * 2;
  u16* R0 = (u16*)(p->ws + WS_INPROJ) + (size_t)row0 * LDI;
  u16* R1 = R0 + LDI;
  float hv0[12], vv0[4], hv1[12], vv1[4];
  prep_load(R0, lane, hv0, vv0); prep_load(R1, lane, hv1, vv1);
  prep_token(p, l, row0, lane, R0, hv0, vv0);
  prep_token(p, l, row0 + 1, lane, R1, hv1, vv1);
}

DI void kvc_item(KP p, int l, int item) {
  u16* KC = (u16*)(p->ws + WS_KC);
#pragma unroll
  for (int it = 0; it < 8; ++it) {
    int idx4 = item * 2048 + it * 256 + ltid();
    int e = idx4 * 4;
    int d = e & 63, key = (e >> 6) & 511, sel = e >> 15;
    int kv = sel & 1, kvh = (sel >> 1) & 1, b = (sel >> 2) & 1, mixer = sel >> 3;
    const float* srcb = mixer ? (kv ? p->in[6] : p->in[5]) : (kv ? p->in[4] : p->in[3]);
    const float* src = srcb + ((size_t)((b * 2 + l) * 512 + key) * 2 + kvh) * 64 + d;
    float4 v = *(const float4*)src;
    *(uint2*)(KC + e) = make_uint2(pack2(v.x, v.y), pack2(v.z, v.w));
    if (kv) {
      u16* VT = (u16*)(p->ws + WS_VT) + ((size_t)((mixer * 2 + b) * 2 + kvh) * 64 + d) * 4608 + key;
      VT[0] = f2bf(v.x); VT[4608] = f2bf(v.y); VT[2 * 4608] = f2bf(v.z); VT[3 * 4608] = f2bf(v.w);
    }
  }
}

DI void attn_item(KP p, int l, int it, unsigned char* smem) {
  u16* sK = (u16*)smem;
  u16* sVt = sK + 64 * 72;
  const int tid = ltid(), lane = tid & 63, wave = tid >> 6, lq = lane & 15, quad = lane >> 4;
  int kind, b, qh, qb;
  if (it < 512) { kind = it >> 8; int r = it & 255; b = r >> 7; qh = (r >> 5) & 3; qb = r & 31; }
  else { int r = it - 512; kind = 2 + (r >> 8); r &= 255; b = r >> 3; qh = (r >> 1) & 3; qb = r & 1; }
  const bool isD = (kind == 0 || kind == 3), lat = kind < 2;
  const int seqrow0 = lat ? 8192 + b * 4096 : b * 256;
  const int q0 = qb * 128, kvh = qh >> 1;
  const int qcol = (isD ? C_DQ : C_AQ) + qh * 64, kcol = (isD ? C_DK : C_AK) + kvh * 64, vcol = (isD ? C_DV : C_AV) + kvh * 64;
  const int ocol = (isD ? 768 : 0) + qh * 64;
  const int ncache = lat ? 8 : 0;
  int kt_lo = 0, kt_hi = lat ? 64 : 4;
  if (kind == 1) { kt_lo = max(0, 2 * qb - 2); kt_hi = min(64, 2 * qb + 4); }
  const int ntiles = ncache + kt_hi - kt_lo;
  const bool band = (kind == 1);
  const u16* INP = (const u16*)(p->ws + WS_INPROJ);
  const u16* KCk = (const u16*)(p->ws + WS_KC) + (size_t)((((isD ? 1 : 0) * 2 + b) * 2 + kvh) * 2) * 512 * 64;
  const u16* KCv = KCk + 512 * 64;
  constexpr float SC2 = 0.125f * 1.4426950408889634f;
  const float sinkv = isD ? -1e30f : p->in[17][l * 4 + qh] * 1.4426950408889634f;

  bf16x8 qf[2][2];
#pragma unroll
  for (int nt = 0; nt < 2; ++nt)
#pragma unroll
    for (int s = 0; s < 2; ++s) qf[nt][s] = ld8(INP + (size_t)(seqrow0 + q0 + wave * 32 + nt * 16 + lq) * LDI + qcol + s * 32 + quad * 8);
  float mrun[2], lsum[2];
  f32x4 oacc[4][2];
#pragma unroll
  for (int nt = 0; nt < 2; ++nt) { mrun[nt] = sinkv; lsum[nt] = (!isD && quad == 0) ? 1.f : 0.f; }
#pragma unroll
  for (int dt = 0; dt < 4; ++dt)
#pragma unroll
    for (int nt = 0; nt < 2; ++nt) oacc[dt][nt] = f32x4{0.f, 0.f, 0.f, 0.f};

  const int key = tid >> 2, seg = (tid & 3) * 16;
  struct KVReg { u32x4 k[2], v[2]; };
  KVReg R0, R1;
  const u16* VTp = (const u16*)(p->ws + WS_VT) + ((size_t)(((isD ? 1 : 0) * 2 + b) * 2 + kvh) * 64 + key) * 4608 + seg;
  auto tile_ptrs = [&](int t, const u16*& kp, const u16*& vp) {
    if (t < ncache) { kp = KCk + (size_t)(t * 64 + key) * 64 + seg; vp = VTp + t * 64; }
    else {
      const u16* rowp = INP + (size_t)(seqrow0 + (kt_lo + t - ncache) * 64 + key) * LDI; kp = rowp + kcol + seg;
      vp = lat ? VTp + 512 + (kt_lo + t - ncache) * 64 : rowp + vcol + seg;
    }
  };
  auto kvload = [&](int t, KVReg& R) {
    const u16 *kp, *vp; tile_ptrs(t, kp, vp);
    R.k[0] = *(const u32x4*)kp; R.k[1] = *(const u32x4*)(kp + 8); R.v[0] = *(const u32x4*)vp; R.v[1] = *(const u32x4*)(vp + 8);
  };
  kvload(0, R0);
  if (ntiles > 1) kvload(1, R1);
  auto step = [&](int t, KVReg& R) {
    __syncthreads();
    *(u32x4*)(sK + key * 72 + seg) = R.k[0]; *(u32x4*)(sK + key * 72 + seg + 8) = R.k[1];
    if (lat) {
      *(u32x4*)(sVt + key * 72 + seg) = R.v[0]; *(u32x4*)(sVt + key * 72 + seg + 8) = R.v[1];
    } else {
      unsigned vv[8] = {R.v[0].x, R.v[0].y, R.v[0].z, R.v[0].w, R.v[1].x, R.v[1].y, R.v[1].z, R.v[1].w};
#pragma unroll
      for (int e = 0; e < 8; ++e) { sVt[(seg + 2 * e) * 72 + key] = (u16)(vv[e] & 0xffffu); sVt[(seg + 2 * e + 1) * 72 + key] = (u16)(vv[e] >> 16); }
    }
    __syncthreads();
    if (t + 2 < ntiles) kvload(t + 2, R);
    f32x4 sacc[4][2];
#pragma unroll
    for (int mt = 0; mt < 4; ++mt) {
      sacc[mt][0] = f32x4{0.f, 0.f, 0.f, 0.f}; sacc[mt][1] = f32x4{0.f, 0.f, 0.f, 0.f};
#pragma unroll
      for (int s = 0; s < 2; ++s) {
        bf16x8 ka = ld8(sK + (mt * 16 + lq) * 72 + s * 32 + quad * 8);
        sacc[mt][0] = MFMA16(ka, qf[0][s], sacc[mt][0]);
        sacc[mt][1] = MFMA16(ka, qf[1][s], sacc[mt][1]);
      }
    }
    const bool masked_tile = band && t >= ncache;
    const int kbase = (kt_lo + t - ncache) * 64;
    bf16x8 pf[2][2];
#pragma unroll
    for (int nt = 0; nt < 2; ++nt) {
      const int qi = q0 + wave * 32 + nt * 16 + lq;
      float tmax = -1e30f;
#pragma unroll
      for (int mt = 0; mt < 4; ++mt)
#pragma unroll
        for (int r = 0; r < 4; ++r) {
          float sv_ = sacc[mt][nt][r] * SC2;
          if (masked_tile) { int kj = kbase + mt * 16 + quad * 4 + r; int dlt = qi - kj; if (dlt > 128 || dlt < -128) sv_ = -1e30f; }
          sacc[mt][nt][r] = sv_; tmax = fmaxf(tmax, sv_);
        }
      tmax = fmaxf(tmax, __shfl_xor(tmax, 16, 64)); tmax = fmaxf(tmax, __shfl_xor(tmax, 32, 64));
      const float mold = mrun[nt];
      const float mnew = fmaxf(mold, tmax);
      float ps = 0.f;
#pragma unroll
      for (int mt = 0; mt < 4; ++mt)
#pragma unroll
        for (int r = 0; r < 4; ++r) { float e = __builtin_amdgcn_exp2f(sacc[mt][nt][r] - mnew); sacc[mt][nt][r] = e; ps += e; }
      if (__any(mnew != mold)) {
        const float alpha = __builtin_amdgcn_exp2f(mold - mnew);
        lsum[nt] *= alpha;
#pragma unroll
        for (int dt = 0; dt < 4; ++dt)
#pragma unroll
          for (int r = 0; r < 4; ++r) oacc[dt][nt][r] *= alpha;
      }
      lsum[nt] += ps; mrun[nt] = mnew;
      pf[nt][0] = pack8(sacc[0][nt], sacc[1][nt]);
      pf[nt][1] = pack8(sacc[2][nt], sacc[3][nt]);
    }
#pragma unroll
    for (int dt = 0; dt < 4; ++dt)
#pragma unroll
      for (int s2 = 0; s2 < 2; ++s2) {
        bf16x8 va = ldperm(sVt + (dt * 16 + lq) * 72 + s2 * 32 + quad * 4);
        oacc[dt][0] = MFMA16(va, pf[0][s2], oacc[dt][0]);
        oacc[dt][1] = MFMA16(va, pf[1][s2], oacc[dt][1]);
      }
  };
  for (int t = 0; t < ntiles; t += 2) { step(t, R0); if (t + 1 < ntiles) step(t + 1, R1); }
  u16* BR = (u16*)(p->ws + WS_BRANCH);
#pragma unroll
  for (int nt = 0; nt < 2; ++nt) {
    float lt = lsum[nt]; lt += __shfl_xor(lt, 16, 64); lt += __shfl_xor(lt, 32, 64);
    const float inv = 1.f / lt;
    const size_t row = seqrow0 + q0 + wave * 32 + nt * 16 + lq;
#pragma unroll
    for (int dt = 0; dt < 4; ++dt)
      *(uint2*)(BR + row * 1024 + ocol + dt * 16 + quad * 4) = make_uint2(pack2(oacc[dt][nt][0] * inv, oacc[dt][nt][1] * inv), pack2(oacc[dt][nt][2] * inv, oacc[dt][nt][3] * inv));
  }
  __syncthreads();
}

DI int lru_xoff(int t, int c) { return t * 256 + (c ^ ((t & 7) << 3)); }
template <bool FINAL>
DI void lru_item(KP p, int l, int ci, unsigned char* smem) {
  u16* sxb = (u16*)smem;
  u16* sla = sxb + 32 * 256;
  u16* sbv = sla + 32 * 256;
  u16* shf = sbv + 32 * 256;
  const int tid = ltid(), ch = tid, lane = tid & 63, n = tid >> 6, lq = lane & 15, quad = lane >> 4;
  const int r0 = ci * 32;
  const bool lat = r0 >= 8192;
  int b, T, seqrow0;
  if (!lat) { b = r0 >> 8; T = 256; seqrow0 = b * 256; } else { b = (r0 - 8192) >> 12; T = 4096; seqrow0 = 8192 + b * 4096; }
  const int t0 = r0 - seqrow0;
  const u16* INP = (const u16*)(p->ws + WS_INPROJ);
  __syncthreads();
  {
    const float* cw = p->in[18] + l * 4 * 256;
    const float w0 = cw[ch], w1 = cw[256 + ch], w2 = cw[512 + ch], w3 = cw[768 + ch], cb = p->in[19][l * 256 + ch];
    auto ld = [&](int t) -> float { return (t >= 0 && t < T) ? bf2f(INP[(size_t)(seqrow0 + t) * LDI + C_LX + ch]) : 0.f; };
    float xin[35];
#pragma unroll
    for (int q = 0; q < 35; ++q) xin[q] = ld(t0 - 2 + q);
#pragma unroll
    for (int t = 0; t < 32; ++t) sxb[lru_xoff(t, ch)] = f2bf(xin[t] * w0 + xin[t + 1] * w1 + xin[t + 2] * w2 + xin[t + 3] * w3 + cb);
  }
  __syncthreads();
  const int nch = T / 32, c = t0 / 32;
  float* LC = (float*)(p->ws + WS_LRUC);
  bf16x8 af[2][2];
#pragma unroll
  for (int mt = 0; mt < 2; ++mt)
#pragma unroll
    for (int s2 = 0; s2 < 2; ++s2) af[mt][s2] = ld8(sxb + lru_xoff(mt * 16 + lq, n * 64 + s2 * 32 + quad * 8));
  for (int dir = 0; dir < 2; ++dir) {
    bf16x8 wf[2][4][2];
    {
      const u32x4* WF = (const u32x4*)(p->ws + WS_LRUW);
#pragma unroll
      for (int g = 0; g < 2; ++g)
#pragma unroll
        for (int j = 0; j < 4; ++j)
#pragma unroll
          for (int s2 = 0; s2 < 2; ++s2)
            wf[g][j][s2] = __builtin_bit_cast(bf16x8, WF[(size_t)((((((l * 2 + dir) * 2 + g) * 4 + n) * 4 + j) * 2 + s2)) * 64 + lane]);
    }
#pragma unroll
    for (int j = 0; j < 4; ++j) {
      f32x4 acc[2][2];
#pragma unroll
      for (int g = 0; g < 2; ++g) {
        f32x4 a0 = {0.f, 0.f, 0.f, 0.f}, a1 = {0.f, 0.f, 0.f, 0.f};
#pragma unroll
        for (int s2 = 0; s2 < 2; ++s2) { a0 = MFMA16(af[0][s2], wf[g][j][s2], a0); a1 = MFMA16(af[1][s2], wf[g][j][s2], a1); }
        acc[g][0] = a0; acc[g][1] = a1;
      }
      const int cc = n * 64 + j * 16 + lq;
      const float br = p->in[21][(l * 2 + dir) * 256 + cc], bi = p->in[23][(l * 2 + dir) * 256 + cc];
      const float sp = softplusf_(-p->in[24][(l * 2 + dir) * 256 + cc]);
#pragma unroll
      for (int mt = 0; mt < 2; ++mt)
#pragma unroll
        for (int r = 0; r < 4; ++r) {
          const int t = mt * 16 + quad * 4 + r;
          const float la = -8.f * sigm(acc[0][mt][r] + br) * sp;
          const float xt = bf2f(sxb[lru_xoff(t, cc)]);
          const float bb = sqrtf(-expm1f(2.f * la)) * sigm(acc[1][mt][r] + bi) * xt;
          sla[t * 256 + cc] = f2bf(la); sbv[t * 256 + cc] = f2bf(bb);
        }
    }
    __syncthreads();
    float h = 0.f, lasum = 0.f;
    if (FINAL) {
      h = lat ? p->in[7][((b * 2 + l) * 2 + dir) * 256 + ch] : 0.f;
      const int ncar = dir == 0 ? c : nch - 1 - c;
      const int cstart = dir == 0 ? ci - c : ci - c + nch - 1, cstep = dir == 0 ? 1 : -1;
      for (int q0 = 0; q0 < ncar; q0 += 16) {
        float ca[16], chh[16];
#pragma unroll
        for (int q = 0; q < 16; ++q) {
          const int qq = q0 + q < ncar ? q0 + q : ncar - 1;
          const float* C = LC + ((size_t)((cstart + cstep * qq) * 2 + dir) * 2) * 256;
          ca[q] = C[ch]; chh[q] = C[256 + ch];
        }
#pragma unroll
        for (int q = 0; q < 16; ++q) if (q0 + q < ncar) h = ca[q] * h + chh[q];
      }
    }
#pragma unroll 1
    for (int s8 = 0; s8 < 32; s8 += 16) {
      float gv[16];
      if (FINAL && dir == 1) {
#pragma unroll
        for (int q = 0; q < 16; ++q) gv[q] = bf2f(INP[(size_t)(r0 + 31 - s8 - q) * LDI + C_LG + ch]);
      }
#pragma unroll
      for (int q = 0; q < 16; ++q) {
        const int st = s8 + q;
        const int t = dir == 0 ? st : 31 - st;
        const float la = bf2f(sla[t * 256 + ch]);
        h = __expf(la) * h + bf2f(sbv[t * 256 + ch]);
        lasum += la;
        if (FINAL) {
          if (dir == 0) shf[t * 256 + ch] = f2bf(h);
          else ((u16*)(p->ws + WS_BRANCH))[(size_t)(r0 + t) * 1024 + 256 + ch] = f2bf((bf2f(shf[t * 256 + ch]) + h) * gelu_tanh(gv[q]));
        }
      }
    }
    if (!FINAL) { float* C = LC + ((size_t)(ci * 2 + dir) * 2) * 256; C[ch] = __expf(lasum); C[256 + ch] = h; }
    else if (!lat) {
      if (dir == 0 && c == nch - 1) p->out[O_LRU + ((size_t)(b * 2 + l) * 2 + 0) * 256 + ch] = h;
      if (dir == 1 && c == 0) p->out[O_LRU + ((size_t)(b * 2 + l) * 2 + 1) * 256 + ch] = h;
    }
    __syncthreads();
  }
}

template <int DIR, bool ISW>
DI void gdn_solve(const float* L, const u16* src, const float* sb_, const float* se_, u16* UW) {
  float sol[64];
#pragma unroll
  for (int i = 0; i < 64; ++i) {
    float s = bf2f(src[(DIR == 0 ? i : 63 - i) * 72]) * sb_[i];
    if (ISW) s *= se_[i];
    float s0 = 0.f, s1 = 0.f, s2 = 0.f, s3 = 0.f;
#pragma unroll
    for (int j4 = 0; j4 < (i + 3) / 4; ++j4) {
      float4 lv = *(const float4*)(L + i * 64 + j4 * 4);
      if (j4 * 4 + 0 < i) s0 += lv.x * sol[j4 * 4 + 0];
      if (j4 * 4 + 1 < i) s1 += lv.y * sol[j4 * 4 + 1];
      if (j4 * 4 + 2 < i) s2 += lv.z * sol[j4 * 4 + 2];
      if (j4 * 4 + 3 < i) s3 += lv.w * sol[j4 * 4 + 3];
      if ((j4 & 3) == 3) asm volatile("" ::: "memory");
    }
    s -= (s0 + s1) + (s2 + s3);
    sol[i] = s;
    UW[i * 128] = f2bf(s);
    asm volatile("" ::: "memory");
  }
}

DI void gdn1_item(KP p, int l, int item, unsigned char* smem) {
  const int cgi = item >> 2, hd = item & 3;
  u16* sq = (u16*)smem; u16* sk = sq + 64 * 72; u16* sv = sk + 64 * 72;
  float* sL = (float*)(smem + 27648);
  float* sgc = (float*)(smem + 60416);
  float* sbeta = sgc + 128;
  float* sge = sbeta + 128;
  const int tid = ltid(), lane = tid & 63, wave = tid >> 6, lq = lane & 15, quad = lane >> 4;
  const int r0 = cgi * 64;
  const bool lat = r0 >= 8192;
  int T, seqrow0;
  if (!lat) { T = 256; seqrow0 = (r0 >> 8) * 256; } else { T = 4096; seqrow0 = 8192 + ((r0 - 8192) >> 12) * 4096; }
  const int t0 = r0 - seqrow0;
  const u16* INP = (const u16*)(p->ws + WS_INPROJ);
  u16* QHAT = (u16*)(p->ws + WS_QHAT) + (size_t)item * 4096;
  {
    const int d = lane, tb = wave * 16;
#pragma unroll
    for (int mat = 0; mat < 3; ++mat) {
      const int col = C_GQ + mat * 256 + hd * 64 + d, wc = mat * 256 + hd * 64 + d;
      const float* cw = p->in[25] + (size_t)l * 4 * 768;
      const float w0 = cw[wc], w1 = cw[768 + wc], w2 = cw[1536 + wc], w3 = cw[2304 + wc];
      auto ld = [&](int t) -> float { return (t >= 0 && t < T) ? bf2f(INP[(size_t)(seqrow0 + t) * LDI + col]) : 0.f; };
      float xin[19];
#pragma unroll
      for (int q = 0; q < 19; ++q) xin[q] = ld(t0 + tb - 2 + q);
      u16* dst = mat == 0 ? sq : (mat == 1 ? sk : sv);
#pragma unroll
      for (int tt = 0; tt < 16; ++tt) {
        const int t = tb + tt;
        float v = siluf_(xin[tt] * w0 + xin[tt + 1] * w1 + xin[tt + 2] * w2 + xin[tt + 3] * w3);
        if (mat < 2) { float ss = wave_sum(v * v); v *= rsqrtf(ss + 1e-6f) * (mat == 0 ? 0.125f : 1.f); }
        u16 hb = f2bf(v);
        dst[t * 72 + d] = hb;
        if (mat == 0) QHAT[t * 64 + d] = hb;
      }
    }
  }
  if (tid < 128) {
    const int dir = tid >> 6, c = tid & 63;
    const int tok = dir == 0 ? c : 63 - c;
    const u16* R = INP + (size_t)(r0 + tok) * LDI;
    const float ga = bf2f(R[C_GA + dir * 4 + hd]), gb = bf2f(R[C_GB + dir * 4 + hd]);
    const float g = -__expf(p->in[26][(l * 2 + dir) * 4 + hd]) * softplusf_(ga + p->in[27][(l * 2 + dir) * 4 + hd]);
    float gc = g;
#pragma unroll
    for (int o = 1; o < 64; o <<= 1) { float tt = __shfl_up(gc, o, 64); if (lane >= o) gc += tt; }
    const float glast = __shfl(gc, 63, 64);
    sgc[dir * 64 + c] = gc; sbeta[dir * 64 + c] = sigm(gb); sge[dir * 64 + c] = __expf(gc);
    float* gv = (float*)(p->ws + WS_GVEC) + (size_t)(item * 2 + dir) * 256;
    gv[c] = __expf(gc); gv[64 + c] = __expf(glast - gc); if (c == 0) gv[128] = __expf(glast);
  }
  __syncthreads();
  {
    const int dk = tid >> 2, c0 = (tid & 3) * 16;
    unsigned w[8];
#pragma unroll
    for (int e = 0; e < 8; ++e) w[e] = (unsigned)sk[(c0 + 2 * e) * 72 + dk] | ((unsigned)sk[(c0 + 2 * e + 1) * 72 + dk] << 16);
    u16* KT = (u16*)(p->ws + WS_KT) + (size_t)item * 4096 + dk * 64 + c0;
    *(u32x4*)KT = mku4(w[0], w[1], w[2], w[3]); *(u32x4*)(KT + 8) = mku4(w[4], w[5], w[6], w[7]);
  }
  {
    const int i0 = wave * 16;
    f32x4 akk[4], aqk[4];
#pragma unroll
    for (int nt = 0; nt < 4; ++nt) { akk[nt] = f32x4{0.f, 0.f, 0.f, 0.f}; aqk[nt] = f32x4{0.f, 0.f, 0.f, 0.f}; }
#pragma unroll
    for (int s = 0; s < 2; ++s) {
      bf16x8 ak = ld8(sk + (i0 + lq) * 72 + s * 32 + quad * 8), aq = ld8(sq + (i0 + lq) * 72 + s * 32 + quad * 8);
#pragma unroll
      for (int nt = 0; nt < 4; ++nt) { bf16x8 bk = ld8(sk + (nt * 16 + lq) * 72 + s * 32 + quad * 8); akk[nt] = MFMA16(ak, bk, akk[nt]); aqk[nt] = MFMA16(aq, bk, aqk[nt]); }
    }
    u16* QKf = (u16*)(p->ws + WS_QK) + (size_t)(item * 2 + 0) * 4096;
    u16* QKb = (u16*)(p->ws + WS_QK) + (size_t)(item * 2 + 1) * 4096;
#pragma unroll
    for (int nt = 0; nt < 4; ++nt)
#pragma unroll
      for (int r = 0; r < 4; ++r) {
        const int i = i0 + quad * 4 + r, j = nt * 16 + lq, ib = 63 - i, jb = 63 - j;
        const float kkv = akk[nt][r], qkv = aqk[nt][r];
        if (j < i) sL[i * 64 + j] = sbeta[i] * kkv * __expf(sgc[i] - sgc[j]);
        if (j > i) sL[4096 + ib * 64 + jb] = sbeta[64 + ib] * kkv * __expf(sgc[64 + ib] - sgc[64 + jb]);
        QKf[i * 64 + j] = f2bf(j <= i ? qkv * __expf(sgc[i] - sgc[j]) : 0.f);
        QKb[ib * 64 + jb] = f2bf(j >= i ? qkv * __expf(sgc[64 + ib] - sgc[64 + jb]) : 0.f);
      }
  }
  __syncthreads();
  {
    const int col = tid & 127;
    u16* UW = (u16*)(p->ws + WS_UW) + (size_t)(item * 2 + (tid >> 7)) * 8192 + col;
    for (int rep = 0; rep < NREP(2); ++rep) {
    if (tid < 128) { if (col < 64) gdn_solve<0, false>(sL, sv + col, sbeta, sge, UW); else gdn_solve<0, true>(sL, sk + (col - 64), sbeta, sge, UW); }
    else { if (col < 64) gdn_solve<1, false>(sL + 4096, sv + col, sbeta + 64, sge + 64, UW); else gdn_solve<1, true>(sL + 4096, sk + (col - 64), sbeta + 64, sge + 64, UW); }
    }
  }
  __syncthreads();
}

DI void gdn2_item(KP p, int l, int item, unsigned char* smem) {
  u16* sW = (u16*)smem; u16* sKT = sW + 64 * 72; u16* sU = sKT + 64 * 72;
  float* sg = (float*)(smem + 27648);
  const int tid = ltid(), lane = tid & 63, wave = tid >> 6, lq = lane & 15, quad = lane >> 4;
  int b, hd, dir; bool lat;
  if (item < 16) { lat = true; b = item >> 3; hd = (item >> 1) & 3; dir = item & 1; }
  else { lat = false; int r = item - 16; b = r >> 3; hd = (r >> 1) & 3; dir = r & 1; }
  const int nch = lat ? 64 : 4, cg0 = lat ? 128 + b * 64 : b * 4;
  f32x4 st[4];
#pragma unroll
  for (int kt = 0; kt < 4; ++kt)
#pragma unroll
    for (int r = 0; r < 4; ++r)
      st[kt][r] = lat ? p->in[8][((size_t)(((b * 2 + l) * 2 + dir) * 4 + hd) * 64 + kt * 16 + quad * 4 + r) * 64 + wave * 16 + lq] : 0.f;
  const int lrow = tid >> 2, seg = (tid & 3) * 16;
  struct GReg { u32x4 U[2], W[2], KT[2]; float g; };
  GReg R0, R1;
  u16* UWb = (u16*)(p->ws + WS_UW);
  const u16* KTb = (const u16*)(p->ws + WS_KT);
  const float* GV = (const float*)(p->ws + WS_GVEC);
  auto gload = [&](int n, GReg& R) {
    const int cgi = dir == 0 ? cg0 + n : cg0 + nch - 1 - n;
    const size_t prob = (size_t)cgi * 4 + hd, pd = prob * 2 + dir;
    const u16* u = UWb + (pd * 64 + lrow) * 128 + seg;
    R.U[0] = *(const u32x4*)u; R.U[1] = *(const u32x4*)(u + 8); R.W[0] = *(const u32x4*)(u + 64); R.W[1] = *(const u32x4*)(u + 72);
    const u16* kt = KTb + (prob * 64 + lrow) * 64 + (dir ? 48 - seg : seg);
    u32x4 a = *(const u32x4*)kt, bb = *(const u32x4*)(kt + 8);
    if (dir) { R.KT[0] = rev8(bb); R.KT[1] = rev8(a); } else { R.KT[0] = a; R.KT[1] = bb; }
    R.g = GV[pd * 256 + (tid & 255)];
  };
  gload(0, R0); gload(1, R1);
  auto step = [&](int n, GReg& R) {
    const int cgi = dir == 0 ? cg0 + n : cg0 + nch - 1 - n;
    const size_t pd = ((size_t)cgi * 4 + hd) * 2 + dir;
    __syncthreads();
    *(u32x4*)(sW + lrow * 72 + seg) = R.W[0]; *(u32x4*)(sW + lrow * 72 + seg + 8) = R.W[1];
    *(u32x4*)(sKT + lrow * 72 + seg) = R.KT[0]; *(u32x4*)(sKT + lrow * 72 + seg + 8) = R.KT[1];
    *(u32x4*)(sU + lrow * 72 + seg) = R.U[0]; *(u32x4*)(sU + lrow * 72 + seg + 8) = R.U[1];
    sg[tid] = R.g;
    __syncthreads();
    if (n + 2 < nch) gload(n + 2, R);
    u32x4* FR = (u32x4*)(UWb + pd * 8192);
    const float elast = sg[128];
    bf16x8 sB[2] = {pack8(st[0], st[1]), pack8(st[2], st[3])};
    FR[(0 * 4 + wave) * 64 + lane] = __builtin_bit_cast(u32x4, sB[0]);
    FR[(1 * 4 + wave) * 64 + lane] = __builtin_bit_cast(u32x4, sB[1]);
    f32x4 vn[4];
#pragma unroll
    for (int mt = 0; mt < 4; ++mt) {
      f32x4 acc = {0.f, 0.f, 0.f, 0.f};
#pragma unroll
      for (int s2 = 0; s2 < 2; ++s2) acc = MFMA16(ldperm(sW + (mt * 16 + lq) * 72 + s2 * 32 + quad * 4), sB[s2], acc);
#pragma unroll
      for (int r = 0; r < 4; ++r) vn[mt][r] = bf2f(sU[(mt * 16 + quad * 4 + r) * 72 + wave * 16 + lq]) - acc[r];
    }
    bf16x8 vB[2] = {pack8(vn[0], vn[1]), pack8(vn[2], vn[3])};
    FR[512 + (0 * 4 + wave) * 64 + lane] = __builtin_bit_cast(u32x4, vB[0]);
    FR[512 + (1 * 4 + wave) * 64 + lane] = __builtin_bit_cast(u32x4, vB[1]);
#pragma unroll
    for (int mt = 0; mt < 4; ++mt)
#pragma unroll
      for (int r = 0; r < 4; ++r) vn[mt][r] *= sg[64 + mt * 16 + quad * 4 + r];
    bf16x8 vsB[2] = {pack8(vn[0], vn[1]), pack8(vn[2], vn[3])};
#pragma unroll
    for (int kt = 0; kt < 4; ++kt) {
      f32x4 acc = {0.f, 0.f, 0.f, 0.f};
#pragma unroll
      for (int s2 = 0; s2 < 2; ++s2) acc = MFMA16(ldperm(sKT + (kt * 16 + lq) * 72 + s2 * 32 + quad * 4), vsB[s2], acc);
#pragma unroll
      for (int r = 0; r < 4; ++r) st[kt][r] = elast * st[kt][r] + acc[r];
    }
  };
  for (int n = 0; n < nch; n += 2) { step(n, R0); step(n + 1, R1); }
  if (!lat) {
#pragma unroll
    for (int kt = 0; kt < 4; ++kt)
#pragma unroll
      for (int r = 0; r < 4; ++r)
        p->out[O_GDN + ((size_t)(((b * 2 + l) * 2 + dir) * 4 + hd) * 64 + kt * 16 + quad * 4 + r) * 64 + wave * 16 + lq] = st[kt][r];
  }
  __syncthreads();
}

DI void gdnfin_item(KP p, int l, int item, unsigned char* smem) {
  u16* sQ = (u16*)smem; u16* sQK = sQ + 64 * 72;
  float* so = (float*)(smem + 3 * 64 * 72 * 2);
  float* seg_ = so + 64 * 65;
  const int cgi = item >> 2, hd = item & 3;
  const int tid = ltid(), lane = tid & 63, wave = tid >> 6, lq = lane & 15, quad = lane >> 4;
  const int lrow = tid >> 2, seg = (tid & 3) * 16;
  __syncthreads();
  {
    const u16* q = (const u16*)(p->ws + WS_QHAT) + ((size_t)item * 64 + lrow) * 64 + seg;
    *(u32x4*)(sQ + lrow * 72 + seg) = *(const u32x4*)q; *(u32x4*)(sQ + lrow * 72 + seg + 8) = *(const u32x4*)(q + 8);
#pragma unroll
    for (int dir = 0; dir < 2; ++dir) {
      const u16* qk = (const u16*)(p->ws + WS_QK) + ((size_t)(item * 2 + dir) * 64 + lrow) * 64 + seg;
      *(u32x4*)(sQK + (dir * 64 + lrow) * 72 + seg) = *(const u32x4*)qk; *(u32x4*)(sQK + (dir * 64 + lrow) * 72 + seg + 8) = *(const u32x4*)(qk + 8);
    }
    if (tid < 128) seg_[tid] = ((const float*)(p->ws + WS_GVEC))[(size_t)(item * 2 + (tid >> 6)) * 256 + (tid & 63)];
  }
  __syncthreads();
#pragma unroll
  for (int dir = 0; dir < 2; ++dir) {
    const u32x4* FR = (const u32x4*)((const u16*)(p->ws + WS_UW) + (size_t)(item * 2 + dir) * 8192);
    bf16x8 sfr[2], vfr[2];
#pragma unroll
    for (int s2 = 0; s2 < 2; ++s2) {
      sfr[s2] = __builtin_bit_cast(bf16x8, FR[(s2 * 4 + wave) * 64 + lane]);
      vfr[s2] = __builtin_bit_cast(bf16x8, FR[512 + (s2 * 4 + wave) * 64 + lane]);
    }
#pragma unroll
    for (int mt = 0; mt < 4; ++mt) {
      f32x4 acc = {0.f, 0.f, 0.f, 0.f};
      const int qrow = dir ? 63 - (mt * 16 + lq) : mt * 16 + lq;
#pragma unroll
      for (int s2 = 0; s2 < 2; ++s2) acc = MFMA16(ldperm(sQ + qrow * 72 + s2 * 32 + quad * 4), sfr[s2], acc);
#pragma unroll
      for (int r = 0; r < 4; ++r) acc[r] *= seg_[dir * 64 + mt * 16 + quad * 4 + r];
#pragma unroll
      for (int s2 = 0; s2 < 2; ++s2) acc = MFMA16(ldperm(sQK + (dir * 64 + mt * 16 + lq) * 72 + s2 * 32 + quad * 4), vfr[s2], acc);
#pragma unroll
      for (int r = 0; r < 4; ++r) {
        const int c = mt * 16 + quad * 4 + r;
        const int tk = dir ? 63 - c : c;
        float* d = so + tk * 65 + wave * 16 + lq;
        if (dir == 0) *d = acc[r]; else *d += acc[r];
      }
    }
    __syncthreads();
  }
  const float gn = p->in[28][l * 64 + lane];
  float zv[16];
#pragma unroll
  for (int q = 0; q < 16; ++q)
    zv[q] = bf2f(((const u16*)(p->ws + WS_INPROJ))[((size_t)cgi * 64 + wave * 16 + q) * LDI + C_GZ + hd * 64 + lane]);
#pragma unroll
  for (int q = 0; q < 16; ++q) {
    const int c = wave * 16 + q;
    const size_t row = (size_t)cgi * 64 + c;
    float o = so[c * 65 + lane];
    float ss = wave_sum(o * o);
    float y = o * rsqrtf(ss * (1.f / 64.f) + 1e-6f) * gn * siluf_(zv[q]);
    ((u16*)(p->ws + WS_BRANCH))[row * 1024 + 512 + hd * 64 + lane] = f2bf(y);
  }
}

#define XB_TMO      128
#define XB_XCNT(j)  (256  + 64 * (j))
#define XB_XSUB(j)  (1280 + 64 * (j))
#define XB_XGEN(j)  (2304 + 64 * (j))
#define XB_TOP      3328
#define XB_TOPGEN   3392
#define XB_SPIN_CAP (1u << 20)
#define LAS __attribute__((address_space(3)))
DI unsigned xb_ld(unsigned* q) { return __hip_atomic_load(q, __ATOMIC_RELAXED, __HIP_MEMORY_SCOPE_AGENT); }
DI unsigned xb_add(unsigned* q, unsigned v) { return __hip_atomic_fetch_add(q, v, __ATOMIC_RELAXED, __HIP_MEMORY_SCOPE_AGENT); }
DI unsigned xb_xcc_id() { return (unsigned)__builtin_amdgcn_s_getreg((3 << 11) | 20) & 0xFu; }
#define XB_SPIN(cond, bar) do { unsigned _sp = 0; while (cond) { __builtin_amdgcn_s_sleep(1); \
    if ((++_sp & 255u) == 0u) { if (xb_ld(&(bar)[XB_TMO])) break; if (_sp > XB_SPIN_CAP) { atomicAdd(&(bar)[XB_TMO], 1u); break; } } } } while (0)
DI void xcd_barrier_complete(unsigned* bar, unsigned x, unsigned& nloc, unsigned& nx) {
  const unsigned G = gridDim.x;
  unsigned sum, cnt, mine, sp = 0u;
  for (;;) {
    sum = 0u; cnt = 0u; mine = 0u;
#pragma unroll
    for (unsigned j = 0; j < 16; ++j) { const unsigned c = xb_ld(&bar[XB_XCNT(j)]); sum += c; cnt += (c > 0u) ? 1u : 0u; mine = (j == x) ? c : mine; }
    if (sum == G) break;
    __builtin_amdgcn_s_sleep(1);
    if ((++sp & 255u) == 0u) { if (xb_ld(&bar[XB_TMO])) break; if (sp > XB_SPIN_CAP) { atomicAdd(&bar[XB_TMO], 1u); break; } }
  }
  nloc = mine > 0u ? mine : 1u; nx = cnt > 0u ? cnt : 1u;
}
DI void xcd_barrier(unsigned* bar, volatile LAS unsigned* st) {
  asm volatile("s_waitcnt vmcnt(0)" ::: "memory");
  __syncthreads();
  if (ltid() == 0) {
    const unsigned x = xb_xcc_id();
    __builtin_amdgcn_s_waitcnt(0);
    unsigned nloc = st[0], nx = st[1];
    if (nloc == 0u) { xcd_barrier_complete(bar, x, nloc, nx); st[0] = nloc; st[1] = nx; }
    const unsigned old = xb_add(&bar[XB_XSUB(x)], 1u);
    const unsigned gen = old / nloc;
    if (old + 1u == (gen + 1u) * nloc) {
      __builtin_amdgcn_fence(__ATOMIC_RELEASE, "agent");
      asm volatile("s_waitcnt vmcnt(0)" ::: "memory");
      const unsigned og = xb_add(&bar[XB_TOP], 1u);
      const unsigned tg = og / nx;
      if (og + 1u == (tg + 1u) * nx) xb_add(&bar[XB_TOPGEN], 1u);
      else XB_SPIN(xb_ld(&bar[XB_TOPGEN]) == tg, bar);
      __builtin_amdgcn_fence(__ATOMIC_ACQUIRE, "agent");
      xb_add(&bar[XB_XGEN(x)], 1u);
      asm volatile("s_waitcnt vmcnt(0)" ::: "memory");
    } else {
      XB_SPIN(xb_ld(&bar[XB_XGEN(x)]) == gen, bar);
      __builtin_amdgcn_fence(__ATOMIC_ACQUIRE, "agent");
      asm volatile("s_waitcnt vmcnt(0)" ::: "memory");
    }
  }
  __syncthreads();
}


#define FOR_TILES(MTI, NTI, SM, SN, CALL)                                                      \
  do {                                                                                         \
    if (G % 8 != 0) { for (int it_ = B; it_ < (MTI) * (NTI); it_ += G) { const int mt = it_ / (NTI), nt = it_ % (NTI); CALL; } } \
    else {                                                                                     \
      const int xcd_ = B & 7, j_ = B >> 3, J_ = G >> 3;                                        \
      const int nsm_ = ((MTI) + (SM) - 1) / (SM), nsn_ = ((NTI) + (SN) - 1) / (SN);            \
      const int st_ = (SM) * (SN), mysup_ = (nsm_ * nsn_ - xcd_ + 7) / 8;                      \
        \
                                  \
      for (int u_ = j_; u_ < mysup_ * st_; u_ += J_) {                                         \
        const int s_ = xcd_ + 8 * (u_ / st_), t_ = u_ % st_;                                   \
        const int sm_ = s_ / nsn_, sn_ = s_ % nsn_;                                            \
        const int mt = sm_ * (SM) + t_ / (SN), nt = sn_ * (SN) + t_ % (SN);                    \
        if (mt < (MTI) && nt < (NTI)) { CALL; }                                                \
      }                                                                                        \
    }                                                                                          \
  } while (0)

constexpr int NPHASE = 21;
__global__ void __launch_bounds__(256, 2) mk(Params p_unused, int ph_lo, int ph_hi) {
  extern __shared__ __attribute__((aligned(1024))) unsigned char smem[];
  int& s_item = *(int*)(smem + SMEM_BYTES);
  u32x4& xb_words = *(u32x4*)(smem + SMEM_BYTES + 16);
  const int G = gridDim.x, B = blockIdx.x;
  const bool fused = ph_hi - ph_lo > 1;
  if (fused) {
    if (ltid() == 0) { xb_words = u32x4{0u, 0u, 0u, 0u}; (void)xb_add(&((unsigned*)(((KP)__builtin_amdgcn_kernarg_segment_ptr())->ws + WS_BAR))[XB_XCNT(xb_xcc_id())], 1u); }
    __syncthreads();
  }
  for (int ph = ph_lo; ph < ph_hi; ++ph) {
    KP p = (KP)__builtin_amdgcn_kernarg_segment_ptr();
    asm volatile("" : "+s"(p));
    if (ph == 0) {
      for (int it = B; it < 192 + CONV_ITEMS + 64; it += G) { for (int rep = 0; rep < NREP(0); ++rep) { if (it < 192) mod_item(p, it, smem); else if (it < 192 + CONV_ITEMS) convert_item(p, 0, it - 192, smem); else lruw_item(p, it - 192 - CONV_ITEMS); } }
    } else {
      const int l = (ph - 1) / 10, sub = (ph - 1) % 10;
      switch (sub) {
        case 0:
          for (int it = B; it < 2048 + (l ? CONV_ITEMS : 0); it += G) { if (it < 2048) norm_item<0>(p, l, it); else convert_item(p, l, it - 2048, smem); }
          break;
        case 1: FOR_TILES(128, 21, 8, 7, inproj_item(p, mt, nt, smem)); break;
        case 2:
          for (int it = B; it < 1024 + 512 + 64 + 2048; it += G) {
            if (it < 1024) { for (int rep = 0; rep < NREP(4); ++rep) gdn1_item(p, l, it, smem); }
            else if (it < 1536) { for (int rep = 0; rep < NREP(5); ++rep) lru_item<false>(p, l, it - 1024, smem); }
            else if (it < 1600) { if (PHON(6)) kvc_item(p, l, it - 1536); }
            else if (PHON(6)) prep_item(p, l, it - 1600);
          }
          break;
        case 3: {
          int* ctr = (int*)(p->ws + WS_CTR) + l;
          for (;;) {
            __syncthreads();
            if (ltid() == 0) s_item = atomicAdd(ctr, 1);
            __syncthreads();
            const int it = s_item;
            if (it >= 16 + 256 + 256 + 256 + 512 + 512) break;
            if (it < 16) gdn2_item(p, l, it, smem);
            else if (it < 272) { for (int rep = 0; rep < NREP(8); ++rep) attn_item(p, l, it - 16, smem); }
            else if (it < 528) gdn2_item(p, l, it - 272 + 16, smem);
            else if (it < 784) { for (int rep = 0; rep < NREP(8); ++rep) attn_item(p, l, it - 528 + 256, smem); }
            else if (it < 1296) { for (int rep = 0; rep < NREP(9); ++rep) lru_item<true>(p, l, it - 784, smem); }
            else for (int rep = 0; rep < NREP(8); ++rep) attn_item(p, l, it - 1296 + 512, smem);
          }
        } break;
        case 4: for (int it = B; it < 1024; it += G) gdnfin_item(p, l, it, smem); break;
        case 5: for (int rep = 0; rep < NREP(11); ++rep) FOR_TILES(128, 8, 8, 8, merge_item(p, l, mt, nt, smem)); break;
        case 6: FOR_TILES(128, 8, 8, 8, wout_item(p, l, mt, nt, smem)); break;
        case 7: for (int it = B; it < 2048; it += G) norm_item<1>(p, l, it); break;
        case 8: FOR_TILES(128, 32, 8, 8, w1_item(p, mt, nt, smem)); break;
        case 9: FOR_TILES(128, 8, 8, 8, w2_item(p, l, mt, nt, smem)); break;
      }
    }
    if (ph + 1 < ph_hi) {
      if (ph == ph_lo) cg::this_grid().sync();
      else for (int rep = 0; rep < NREP(1); ++rep) xcd_barrier((unsigned*)(p->ws + WS_BAR), (volatile LAS unsigned*)&xb_words);
    }
  }
}

extern "C" void kernel_launch(void* const* d_in, const int* in_sizes, int n_in, void* d_out, int out_size, void* d_ws, size_t ws_size, hipStream_t stream) {
  static int grid_blocks = 0;
  if (!grid_blocks) {
    int dev = 0, cus = 0, per_cu = 0;
    (void)hipGetDevice(&dev);
    (void)hipDeviceGetAttribute(&cus, hipDeviceAttributeMultiprocessorCount, dev);
    if (hipFuncSetAttribute((const void*)mk, hipFuncAttributeMaxDynamicSharedMemorySize, DYN_LDS) != hipSuccess) fprintf(stderr, "kernel_launch: hipFuncSetAttribute failed\n");
    (void)hipOccupancyMaxActiveBlocksPerMultiprocessor(&per_cu, mk, 256, DYN_LDS);
    if (per_cu < 1) per_cu = 1;
    if (per_cu > 2) per_cu = 2;
    grid_blocks = cus * per_cu;
    if (ws_size < WS_END) fprintf(stderr, "kernel_launch: workspace too small: %zu < %zu\n", ws_size, (size_t)WS_END);
  }
  if (hipMemsetAsync((char*)d_ws + WS_CTR, 0, 256 + 3456 * 4 + 256, stream) != hipSuccess) fprintf(stderr, "kernel_launch: memset failed\n");
  Params p{};
  for (int i = 0; i < 37; ++i) p.in[i] = (const float*)d_in[i];
  p.out = (float*)d_out; p.ws = (unsigned char*)d_ws;
#if MULTI_LAUNCH
  for (int ph = 0; ph < NPHASE; ++ph) hipLaunchKernelGGL(mk, dim3(grid_blocks), dim3(256), DYN_LDS, stream, p, ph, ph + 1);
#else
  int lo = 0, hi = NPHASE;
  void* args[] = {&p, &lo, &hi};
  hipError_t e = hipLaunchCooperativeKernel((void*)mk, dim3(grid_blocks), dim3(256), args, DYN_LDS, stream);
  if (e != hipSuccess) fprintf(stderr, "cooperative launch failed: %s (grid %d)\n", hipGetErrorString(e), grid_blocks);
#endif
}
```

```cpp
#include <hip/hip_runtime.h>
#include <hip/hip_cooperative_groups.h>
#include <cstdio>
namespace cg = cooperative_groups;

#ifndef MULTI_LAUNCH
#define MULTI_LAUNCH 0
#endif
#ifndef PHM
#define PHM 0xFFFFFFFFu
#endif
#define PHON(b) ((PHM >> (b)) & 1u)
#ifndef DUPM
#define DUPM 0u
#endif
#define NREP(b) (1 + ((DUPM >> (b)) & 1u))

typedef unsigned short u16;
using bf16x8 = __attribute__((ext_vector_type(8))) short;
using f32x4 = __attribute__((ext_vector_type(4))) float;
using u32x4 = __attribute__((ext_vector_type(4))) unsigned;
#define DI __device__ __forceinline__
#define MFMA16(a, b, c) __builtin_amdgcn_mfma_f32_16x16x32_bf16((a), (b), (c), 0, 0, 0)

constexpr int NTOK = 16384;
constexpr int DM = 1024;
constexpr int LDI = 2592;
constexpr int C_AQ = 0, C_AK = 256, C_AV = 384, C_LX = 512, C_LG = 768, C_GQ = 1024, C_GK = 1280, C_GV = 1536, C_GZ = 1792,
              C_DQ = 2048, C_DK = 2304, C_DV = 2432, C_GA = 2560, C_GB = 2568;
constexpr int NIN_PAD = 2688;

constexpr size_t WS_MOD = 0;
constexpr size_t WS_CTR = WS_MOD + 2 * 3 * 6144 * 4;
constexpr size_t WS_BAR = WS_CTR + 256;
constexpr size_t WS_LRUC = WS_BAR + 3456 * 4 + 256;
constexpr size_t WS_KC = WS_LRUC + (size_t)512 * 2 * 2 * 256 * 4;
constexpr size_t WS_GVEC = WS_KC + (size_t)16 * 512 * 64 * 2;
constexpr size_t WS_LRUW = WS_GVEC + (size_t)1024 * 2 * 256 * 4;
constexpr size_t WS_VT = WS_LRUW + (size_t)256 * 64 * 16;
constexpr size_t WS_WIN = WS_VT + (size_t)8 * 64 * 4608 * 2;
constexpr size_t WS_WM = WS_WIN + (size_t)NIN_PAD * 1024 * 2;
constexpr size_t WS_WB = WS_WM + (size_t)4096 * 1024 * 2;
constexpr size_t WS_WO = WS_WB + (size_t)4 * 1024 * 256 * 2;
constexpr size_t WS_W1 = WS_WO + (size_t)1024 * 1024 * 2;
constexpr size_t WS_W2 = WS_W1 + (size_t)4096 * 1024 * 2;
constexpr size_t WS_H = WS_W2 + (size_t)1024 * 4096 * 2;
constexpr size_t WS_BIG = WS_H + (size_t)NTOK * 1024 * 2;
constexpr size_t WS_INPROJ = WS_BIG;
constexpr size_t WS_BRANCH = WS_INPROJ + (size_t)NTOK * LDI * 2;
constexpr size_t WS_QHAT = WS_BRANCH + (size_t)NTOK * 1024 * 2;
constexpr size_t WS_KT = WS_QHAT + (size_t)1024 * 4096 * 2;
constexpr size_t WS_UW = WS_KT + (size_t)1024 * 4096 * 2;
constexpr size_t WS_QK = WS_UW + (size_t)1024 * 2 * 8192 * 2;
constexpr size_t WS_END = WS_QK + (size_t)1024 * 2 * 4096 * 2;
constexpr size_t WS_HIDDEN = WS_BIG;
constexpr size_t WS_MERGED = WS_BIG;
static_assert(WS_HIDDEN + (size_t)NTOK * 4096 * 2 <= WS_END, "hidden must fit");
static_assert(WS_END <= (size_t)256 * 1024 * 1024, "workspace budget");

constexpr size_t O_X = 0, O_AK = 16777216, O_AV = 18874368, O_DK = 20971520, O_DV = 23068672, O_LRU = 25165824, O_GDN = 25198592;

struct Params {
  const float* in[37];
  float* out;
  unsigned char* ws;
};

typedef const Params __attribute__((address_space(4)))* KP;
constexpr int SMEM_BYTES = 65536;
constexpr int DYN_LDS = SMEM_BYTES + 64;

DI int ltid() { int t = threadIdx.x; asm volatile("" : "+v"(t)); return t; }
typedef __bf16 bf16v2 __attribute__((ext_vector_type(2)));
DI u16 f2bf(float x) { __bf16 h = (__bf16)x; return __builtin_bit_cast(u16, h); }
DI float bf2f(u16 h) { return __uint_as_float(((unsigned)h) << 16); }
DI unsigned pack2(float a, float b) { bf16v2 v = {(__bf16)a, (__bf16)b}; return __builtin_bit_cast(unsigned, v); }
DI float bflo(unsigned u) { return __uint_as_float(u << 16); }
DI float bfhi(unsigned u) { return __uint_as_float(u & 0xffff0000u); }
DI float sigm(float x) { return 1.f / (1.f + __expf(-x)); }
DI float siluf_(float x) { return x / (1.f + __expf(-x)); }
DI float softplusf_(float x) { return x > 20.f ? x : log1pf(__expf(x)); }
DI float gelu_tanh(float x) { float u = 0.7978845608028654f * (x + 0.044715f * x * x * x); float t = 1.f - 2.f / (__expf(2.f * u) + 1.f); return 0.5f * x * (1.f + t); }
DI float wave_sum(float v) {
#pragma unroll
  for (int o = 32; o > 0; o >>= 1) v += __shfl_xor(v, o, 64);
  return v;
}
DI u32x4 mku4(unsigned a, unsigned b, unsigned c, unsigned d) { u32x4 v = {a, b, c, d}; return v; }
DI bf16x8 mk8(unsigned a, unsigned b, unsigned c, unsigned d) { u32x4 v = {a, b, c, d}; return __builtin_bit_cast(bf16x8, v); }
DI bf16x8 pack8(const f32x4& x, const f32x4& y) { return mk8(pack2(x[0], x[1]), pack2(x[2], x[3]), pack2(y[0], y[1]), pack2(y[2], y[3])); }
DI bf16x8 ld8(const u16* p) { return *(const bf16x8*)p; }
DI bf16x8 ldperm(const u16* p) { uint2 a = *(const uint2*)p; uint2 b = *(const uint2*)(p + 16); return mk8(a.x, a.y, b.x, b.y); }
DI int mod_group(int row) { return row < 8192 ? 0 : 1 + ((row - 8192) >> 12); }
DI const float* x_in_row(KP p, int l, int row) {
  if (l == 0) return row < 8192 ? p->in[0] + (size_t)row * DM : p->in[1] + (size_t)(row - 8192) * DM;
  return p->out + (size_t)row * DM;
}
DI unsigned swap16(unsigned u) { return (u >> 16) | (u << 16); }
DI u32x4 rev8(u32x4 v) { return mku4(swap16(v.w), swap16(v.z), swap16(v.y), swap16(v.x)); }

DI void mod_item(KP p, int item, unsigned char* smem) {
  float* sc = (float*)smem;
  float* sr = sc + 3072;
  const int tid = ltid();
  const int l = item / 96, cb = item % 96;
  for (int i = tid; i < 3072; i += 256) {
    int g = i >> 10, k = i & 1023;
    float c = g == 0 ? p->in[9][k] : p->in[2][(g - 1) * 1024 + k];
    sc[i] = siluf_(c);
  }
  __syncthreads();
  const int col = cb * 64 + (tid & 63), kg = tid >> 6;
  const float* W = p->in[10] + (size_t)l * 1024 * 6144;
  float a0 = 0.f, a1 = 0.f, a2 = 0.f;
  for (int k = kg * 256; k < kg * 256 + 256; ++k) {
    float w = W[(size_t)k * 6144 + col];
    a0 += sc[k] * w; a1 += sc[1024 + k] * w; a2 += sc[2048 + k] * w;
  }
  sr[(kg * 3 + 0) * 64 + (tid & 63)] = a0; sr[(kg * 3 + 1) * 64 + (tid & 63)] = a1; sr[(kg * 3 + 2) * 64 + (tid & 63)] = a2;
  __syncthreads();
  if (tid < 192) {
    int g = tid >> 6, cc = tid & 63;
    float s = p->in[11][l * 6144 + cb * 64 + cc];
    for (int q = 0; q < 4; ++q) s += sr[(q * 3 + g) * 64 + cc];
    ((float*)(p->ws + WS_MOD))[(l * 3 + g) * 6144 + cb * 64 + cc] = s;
  }
  __syncthreads();
}

DI void conv_tile(const float* src, int N, int k0, int n0, u16* dst, int K, bool perm, unsigned char* smem) {
  float* tile = (float*)smem;
  const int tid = ltid();
#pragma unroll
  for (int i = 0; i < 4; ++i) {
    int kr = (tid >> 4) + 16 * i, nc = (tid & 15) * 4;
    float4 v = make_float4(0.f, 0.f, 0.f, 0.f);
    if (n0 + nc < N) v = *(const float4*)(src + (size_t)(k0 + kr) * N + n0 + nc);
    tile[kr * 65 + nc] = v.x; tile[kr * 65 + nc + 1] = v.y; tile[kr * 65 + nc + 2] = v.z; tile[kr * 65 + nc + 3] = v.w;
  }
  __syncthreads();
#pragma unroll
  for (int i = 0; i < 2; ++i) {
    int n = (tid >> 3) + 32 * i, k8 = (tid & 7) * 8;
    int ng = n0 + n;
    if (ng < N) {
      int row = ng;
      if (perm) row = ng < 2048 ? ng : (ng < 2064 ? 2560 + (ng - 2048) : ng - 16);
      u32x4 o;
      o.x = pack2(tile[(k8 + 0) * 65 + n], tile[(k8 + 1) * 65 + n]);
      o.y = pack2(tile[(k8 + 2) * 65 + n], tile[(k8 + 3) * 65 + n]);
      o.z = pack2(tile[(k8 + 4) * 65 + n], tile[(k8 + 5) * 65 + n]);
      o.w = pack2(tile[(k8 + 6) * 65 + n], tile[(k8 + 7) * 65 + n]);
      *(u32x4*)(dst + (size_t)row * K + k0 + k8) = o;
    }
  }
  __syncthreads();
}

constexpr int CONV_ITEMS = 4241;
DI void convert_item(KP p, int l, int item, unsigned char* smem) {
  unsigned char* ws = p->ws;
  if (item < 656) { int kt = item / 41, nt = item % 41; conv_tile(p->in[14] + (size_t)l * 1024 * 2576, 2576, kt * 64, nt * 64, (u16*)(ws + WS_WIN), 1024, true, smem); return; }
  item -= 656;
  if (item < 1024) { int kt = item >> 6, nt = item & 63; conv_tile(p->in[32] + (size_t)l * 1024 * 4096, 4096, kt * 64, nt * 64, (u16*)(ws + WS_WM), 1024, false, smem); return; }
  item -= 1024;
  if (item < 256) { int m = item >> 6, r = item & 63, kt = r >> 4, nt = r & 15;
    conv_tile(p->in[31] + ((size_t)l * 4 + m) * 256 * 1024, 1024, kt * 64, nt * 64, (u16*)(ws + WS_WB) + (size_t)m * 1024 * 256, 256, false, smem); return; }
  item -= 256;
  if (item < 256) { int kt = item >> 4, nt = item & 15; conv_tile(p->in[34] + (size_t)l * 1024 * 1024, 1024, kt * 64, nt * 64, (u16*)(ws + WS_WO), 1024, false, smem); return; }
  item -= 256;
  if (item < 1024) { int kt = item >> 6, nt = item & 63; conv_tile(p->in[35] + (size_t)l * 1024 * 4096, 4096, kt * 64, nt * 64, (u16*)(ws + WS_W1), 1024, false, smem); return; }
  item -= 1024;
  if (item < 1024) { int kt = item >> 4, nt = item & 15; conv_tile(p->in[36] + (size_t)l * 4096 * 1024, 1024, kt * 64, nt * 64, (u16*)(ws + WS_W2), 4096, false, smem); return; }
  u32x4* z = (u32x4*)((u16*)(ws + WS_WIN) + (size_t)2576 * 1024);
  for (int i = ltid(); i < 112 * 1024 / 8; i += 256) z[i] = mku4(0, 0, 0, 0);
}

DI void lruw_item(KP p, int item) {
  const int gid = item * 256 + ltid();
  const int lane = gid & 63, fg = gid >> 6;
  const int s2 = fg & 1, j = (fg >> 1) & 3, n = (fg >> 3) & 3, g = (fg >> 5) & 1, ld_ = fg >> 6;
  const int lq = lane & 15, quad = lane >> 4;
  const float* W = (g == 0 ? p->in[20] : p->in[22]) + ((size_t)(ld_ * 4 + n) * 64) * 64 + (size_t)(s2 * 32 + quad * 8) * 64 + j * 16 + lq;
  u32x4 o = {pack2(W[0], W[64]), pack2(W[128], W[192]), pack2(W[256], W[320]), pack2(W[384], W[448])};
  ((u32x4*)(p->ws + WS_LRUW))[gid] = o;
}

template <int which>
DI void norm_item(KP p, int l, int item) {
  const int tid = ltid(), lane = tid & 63, wave = tid >> 6;
  const float* g = p->in[which == 0 ? 12 : 13] + l * 1024;
  f32x4 v[2][4]; float ss[2] = {0.f, 0.f};
#pragma unroll
  for (int h = 0; h < 2; ++h) {
    const int row = item * 8 + wave * 2 + h;
    const float* x = x_in_row(p, which == 0 ? l : 2, row);
#pragma unroll
    for (int i = 0; i < 4; ++i) v[h][i] = *(const f32x4*)(x + i * 256 + lane * 4);
  }
#pragma unroll
  for (int h = 0; h < 2; ++h) {
#pragma unroll
    for (int i = 0; i < 4; ++i) ss[h] += v[h][i].x * v[h][i].x + v[h][i].y * v[h][i].y + v[h][i].z * v[h][i].z + v[h][i].w * v[h][i].w;
    ss[h] = wave_sum(ss[h]);
  }
#pragma unroll
  for (int h = 0; h < 2; ++h) {
    const int row = item * 8 + wave * 2 + h;
    const float* mod = (const float*)(p->ws + WS_MOD) + (l * 3 + mod_group(row)) * 6144;
    const float* sh = mod + (which == 0 ? 0 : 3072);
    const float* sc = mod + (which == 0 ? 1024 : 4096);
    const float rstd = rsqrtf(ss[h] * (1.f / 1024.f) + 1e-6f);
    u16* H = (u16*)(p->ws + WS_H) + (size_t)row * 1024;
#pragma unroll
    for (int i = 0; i < 4; ++i) {
      int c = i * 256 + lane * 4;
      float4 gg = *(const float4*)(g + c), s1 = *(const float4*)(sc + c), s0 = *(const float4*)(sh + c);
      float y0 = v[h][i].x * rstd * gg.x * (1.f + s1.x) + s0.x, y1 = v[h][i].y * rstd * gg.y * (1.f + s1.y) + s0.y;
      float y2 = v[h][i].z * rstd * gg.z * (1.f + s1.z) + s0.z, y3 = v[h][i].w * rstd * gg.w * (1.f + s1.w) + s0.w;
      *(uint2*)(H + c) = make_uint2(pack2(y0, y1), pack2(y2, y3));
    }
  }
}

DI int lds_byte(int r, int c) {
  int st = (r >> 4) * 2 + (c >> 5), ob = (r & 15) * 64 + (c & 31) * 2;
  return st * 1024 + (ob ^ (((ob >> 9) & 1) << 5));
}
DI void stage_rc(int b, int& R, int& C) {
  int st = b >> 10, sb = b & 1023, swz = sb ^ (((sb >> 9) & 1) << 5);
  R = (st >> 1) * 16 + (swz >> 6);
  C = (st & 1) * 32 + ((swz & 63) >> 1);
}
template <int MT, int NT, bool pre = false>
DI void gemm_acc(f32x4 (&acc)[MT][NT], const u16* __restrict__ A, int lda, const u16* __restrict__ Bt, int ldb, int K, unsigned char* smem,
                 const u16* nxtA = nullptr, int nlda = 0, const u16* nxtB = nullptr, int nldb = 0) {
  constexpr int TA = MT * 32 * 128, TB = NT * 32 * 128, STAGE = TA + TB;
  static_assert(2 * STAGE <= 65536, "LDS");
  const int tid = ltid(), lane = tid & 63, wid = tid >> 6, wm = wid >> 1, wn = wid & 1;
  const int fr = lane & 15, fq = lane >> 4;
  const u16* ga[MT]; const u16* gb[NT];
#pragma unroll
  for (int i = 0; i < MT; ++i) { int R, C; stage_rc(wid * 1024 + i * 4096 + lane * 16, R, C); ga[i] = A + (size_t)R * lda + C; }
#pragma unroll
  for (int i = 0; i < NT; ++i) { int R, C; stage_rc(wid * 1024 + i * 4096 + lane * 16, R, C); gb[i] = Bt + (size_t)R * ldb + C; }
#define GLDS_STAGE(buf, k0)                                                                                                        \
  do {                                                                                                                             \
    _Pragma("unroll") for (int i = 0; i < MT; ++i)                                                                                 \
      __builtin_amdgcn_global_load_lds((const unsigned*)(ga[i] + (k0)), (unsigned*)(smem + (buf) * STAGE + wid * 1024 + i * 4096), 16, 0, 0); \
    _Pragma("unroll") for (int i = 0; i < NT; ++i)                                                                                 \
      __builtin_amdgcn_global_load_lds((const unsigned*)(gb[i] + (k0)), (unsigned*)(smem + (buf) * STAGE + TA + wid * 1024 + i * 4096), 16, 0, 0); \
  } while (0)
  if (!pre) {
    __syncthreads();
    GLDS_STAGE(0, 0);
  }
  asm volatile("s_waitcnt vmcnt(0)" ::: "memory");
  __syncthreads();
  const int nt = K >> 6;
  for (int t = 0; t < nt; ++t) {
    const int cur = t & 1;
    if (t + 1 < nt) GLDS_STAGE(cur ^ 1, (t + 1) * 64);
    const unsigned char* sA = smem + cur * STAGE;
    const unsigned char* sB = sA + TA;
    if constexpr (!pre) {
      bf16x8 bfr[2][NT], af[2][MT];
#pragma unroll
      for (int s = 0; s < 2; ++s) {
#pragma unroll
        for (int j = 0; j < NT; ++j) bfr[s][j] = *(const bf16x8*)(sB + lds_byte(wn * NT * 16 + j * 16 + fr, s * 32 + fq * 8));
#pragma unroll
        for (int i = 0; i < MT; ++i) af[s][i] = *(const bf16x8*)(sA + lds_byte(wm * MT * 16 + i * 16 + fr, s * 32 + fq * 8));
      }
#pragma unroll
      for (int s = 0; s < 2; ++s)
#pragma unroll
        for (int i = 0; i < MT; ++i)
#pragma unroll
          for (int j = 0; j < NT; ++j) acc[i][j] = MFMA16(bfr[s][j], af[s][i], acc[i][j]);
      __builtin_amdgcn_sched_group_barrier(0x100, MT + NT, 0);
#pragma unroll
      for (int q = 0; q < MT + NT; ++q) { __builtin_amdgcn_sched_group_barrier(0x008, 2, 0); __builtin_amdgcn_sched_group_barrier(0x100, 1, 0); }
      __builtin_amdgcn_sched_group_barrier(0x008, 2 * MT * NT - 2 * (MT + NT), 0);
    } else {
#pragma unroll
      for (int s = 0; s < 2; ++s) {
        bf16x8 bfr[NT], af[MT];
#pragma unroll
        for (int j = 0; j < NT; ++j) bfr[j] = *(const bf16x8*)(sB + lds_byte(wn * NT * 16 + j * 16 + fr, s * 32 + fq * 8));
#pragma unroll
        for (int i = 0; i < MT; ++i) af[i] = *(const bf16x8*)(sA + lds_byte(wm * MT * 16 + i * 16 + fr, s * 32 + fq * 8));
#pragma unroll
        for (int i = 0; i < MT; ++i)
#pragma unroll
          for (int j = 0; j < NT; ++j) acc[i][j] = MFMA16(bfr[j], af[i], acc[i][j]);
      }
    }
    asm volatile("s_waitcnt vmcnt(0)" ::: "memory");
    __syncthreads();
  }
  if (nxtA) {
#pragma unroll
    for (int i = 0; i < MT; ++i) { int R, C; stage_rc(wid * 1024 + i * 4096 + lane * 16, R, C);
      __builtin_amdgcn_global_load_lds((const unsigned*)(nxtA + (unsigned)(R * nlda + C)), (unsigned*)(smem + wid * 1024 + i * 4096), 16, 0, 0); }
#pragma unroll
    for (int i = 0; i < NT; ++i) { int R, C; stage_rc(wid * 1024 + i * 4096 + lane * 16, R, C);
      __builtin_amdgcn_global_load_lds((const unsigned*)(nxtB + (unsigned)(R * nldb + C)), (unsigned*)(smem + TA + wid * 1024 + i * 4096), 16, 0, 0); }
  }
#undef GLDS_STAGE
}

template <int MT, int NT>
DI void gemm_prefetch(const u16* A, int lda, const u16* Bt, int ldb, unsigned char* smem) {
  constexpr int TA = MT * 32 * 128;
  const int tid = ltid(), lane = tid & 63, wid = tid >> 6;
  __syncthreads();
#pragma unroll
  for (int i = 0; i < MT; ++i) { int R, C; stage_rc(wid * 1024 + i * 4096 + lane * 16, R, C);
    __builtin_amdgcn_global_load_lds((const unsigned*)(A + (unsigned)(R * lda + C)), (unsigned*)(smem + wid * 1024 + i * 4096), 16, 0, 0); }
#pragma unroll
  for (int i = 0; i < NT; ++i) { int R, C; stage_rc(wid * 1024 + i * 4096 + lane * 16, R, C);
    __builtin_amdgcn_global_load_lds((const unsigned*)(Bt + (unsigned)(R * ldb + C)), (unsigned*)(smem + TA + wid * 1024 + i * 4096), 16, 0, 0); }
}

template <int MT, int NT> DI void zero_acc(f32x4 (&acc)[MT][NT]) {
#pragma unroll
  for (int i = 0; i < MT; ++i)
#pragma unroll
    for (int j = 0; j < NT; ++j) acc[i][j] = f32x4{0.f, 0.f, 0.f, 0.f};
}

#define EPI_LOOP(MT, NT)                                                          \
  const int tid_ = ltid(), lane_ = tid_ & 63, wave_ = tid_ >> 6;                   \
  const int wm_ = wave_ >> 1, wn_ = wave_ & 1, lq_ = lane_ & 15, quad_ = lane_ >> 4; \
  _Pragma("unroll") for (int i = 0; i < MT; ++i)                                   \
  _Pragma("unroll") for (int j = 0; j < NT; ++j)
#define EPI_ROW(m0, MT) ((m0) + wm_ * (MT) * 16 + i * 16 + lq_)
#define EPI_COL(n0, NT) ((n0) + wn_ * (NT) * 16 + j * 16 + quad_ * 4)

constexpr int GMT = 4;
DI void inproj_item(KP p, int mt, int nt, unsigned char* smem) {
  const int m0 = mt * (GMT * 32), n0 = nt * 128;
  f32x4 acc[GMT][4]; zero_acc<GMT, 4>(acc);
  gemm_acc<GMT, 4>(acc, (const u16*)(p->ws + WS_H) + (size_t)m0 * 1024, 1024, (const u16*)(p->ws + WS_WIN) + (size_t)n0 * 1024, 1024, 1024, smem);
  u16* C = (u16*)(p->ws + WS_INPROJ);
  EPI_LOOP(GMT, 4) { int row = EPI_ROW(m0, GMT), col = EPI_COL(n0, 4); if (col < LDI) *(uint2*)(C + (size_t)row * LDI + col) = make_uint2(pack2(acc[i][j][0], acc[i][j][1]), pack2(acc[i][j][2], acc[i][j][3])); }
}

DI void merge_item(KP p, int l, int mt, int nt, unsigned char* smem) {
  const int m0 = mt * 128, n0 = nt * 128;
  const u16* H = (const u16*)(p->ws + WS_H) + (size_t)m0 * 1024;
  const u16* BR = (const u16*)(p->ws + WS_BRANCH) + (size_t)m0 * 1024;
  const float* bm = p->in[33] + l * 4096;
  const u16* WM = (const u16*)(p->ws + WS_WM) + (size_t)n0 * 1024;
  const u16* WB = (const u16*)(p->ws + WS_WB) + (size_t)n0 * 256;
  unsigned am[4][4][2];
#pragma unroll
  for (int i = 0; i < 4; ++i)
#pragma unroll
    for (int j = 0; j < 4; ++j) { am[i][j][0] = 0u; am[i][j][1] = 0u; }
  gemm_prefetch<4, 4>(BR, 1024, WB, 256, smem);
#pragma unroll 1
  for (int m = 0; m < 4; ++m) {
    f32x4 acc[4][4]; zero_acc<4, 4>(acc);
    gemm_acc<4, 4, true>(acc, BR + m * 256, 1024, WB + (size_t)m * 1024 * 256, 256, 256, smem, H, 1024, WM + (size_t)m * 1024 * 1024, 1024);
    unsigned pp[4][4][2];
#pragma unroll
    for (int i = 0; i < 4; ++i)
#pragma unroll
      for (int j = 0; j < 4; ++j) { pp[i][j][0] = pack2(acc[i][j][0], acc[i][j][1]); pp[i][j][1] = pack2(acc[i][j][2], acc[i][j][3]); }
    zero_acc<4, 4>(acc);
    gemm_acc<4, 4, true>(acc, H, 1024, WM + (size_t)m * 1024 * 1024, 1024, 1024, smem,
                         m < 3 ? BR + (m + 1) * 256 : nullptr, 1024, WB + (size_t)(m + 1) * 1024 * 256, 256);
    {
      const int tid_ = ltid(), wn_ = (tid_ >> 6) & 1, quad_ = (tid_ & 63) >> 4;
      float4 bias4[4];
#pragma unroll
      for (int j = 0; j < 4; ++j) bias4[j] = *(const float4*)(bm + m * 1024 + n0 + wn_ * 64 + j * 16 + quad_ * 4);
#pragma unroll
      for (int i = 0; i < 4; ++i) {
#pragma unroll
        for (int j = 0; j < 4; ++j) {
          float v0 = bflo(am[i][j][0]) + sigm(acc[i][j][0] + bias4[j].x) * bflo(pp[i][j][0]);
          float v1 = bfhi(am[i][j][0]) + sigm(acc[i][j][1] + bias4[j].y) * bfhi(pp[i][j][0]);
          float v2 = bflo(am[i][j][1]) + sigm(acc[i][j][2] + bias4[j].z) * bflo(pp[i][j][1]);
          float v3 = bfhi(am[i][j][1]) + sigm(acc[i][j][3] + bias4[j].w) * bfhi(pp[i][j][1]);
          am[i][j][0] = pack2(v0, v1); am[i][j][1] = pack2(v2, v3);
          asm volatile("" : "+v"(am[i][j][0]), "+v"(am[i][j][1]));
          __builtin_amdgcn_sched_barrier(0);
        }
      }
    }
  }
  u16* C = (u16*)(p->ws + WS_MERGED);
  EPI_LOOP(4, 4) { int row = EPI_ROW(m0, 4), col = EPI_COL(n0, 4); *(uint2*)(C + (size_t)row * 1024 + col) = make_uint2(am[i][j][0], am[i][j][1]); }
}

DI void wout_item(KP p, int l, int mt, int nt, unsigned char* smem) {
  const int m0 = mt * (GMT * 32), n0 = nt * 128;
  f32x4 acc[GMT][4]; zero_acc<GMT, 4>(acc);
  gemm_acc<GMT, 4>(acc, (const u16*)(p->ws + WS_MERGED) + (size_t)m0 * 1024, 1024, (const u16*)(p->ws + WS_WO) + (size_t)n0 * 1024, 1024, 1024, smem);
  const float* g1 = (const float*)(p->ws + WS_MOD) + (l * 3 + mod_group(m0)) * 6144 + 2048;
  EPI_LOOP(GMT, 4) { int row = EPI_ROW(m0, GMT), col = EPI_COL(n0, 4); const float4 xv = *(const float4*)(x_in_row(p, l, row) + col), gv = *(const float4*)(g1 + col);
    *(float4*)(p->out + (size_t)row * DM + col) = make_float4(xv.x + gv.x * acc[i][j][0], xv.y + gv.y * acc[i][j][1], xv.z + gv.z * acc[i][j][2], xv.w + gv.w * acc[i][j][3]); }
}

DI void w1_item(KP p, int mt, int nt, unsigned char* smem) {
  const int m0 = mt * (GMT * 32), n0 = nt * 128;
  f32x4 acc[GMT][4]; zero_acc<GMT, 4>(acc);
  gemm_acc<GMT, 4>(acc, (const u16*)(p->ws + WS_H) + (size_t)m0 * 1024, 1024, (const u16*)(p->ws + WS_W1) + (size_t)n0 * 1024, 1024, 1024, smem);
  u16* C = (u16*)(p->ws + WS_HIDDEN);
  EPI_LOOP(GMT, 4) { int row = EPI_ROW(m0, GMT), col = EPI_COL(n0, 4); const float v0 = fmaxf(acc[i][j][0], 0.f), v1 = fmaxf(acc[i][j][1], 0.f), v2 = fmaxf(acc[i][j][2], 0.f), v3 = fmaxf(acc[i][j][3], 0.f);
    *(uint2*)(C + (size_t)row * 4096 + col) = make_uint2(pack2(v0 * v0, v1 * v1), pack2(v2 * v2, v3 * v3)); }
}

DI void w2_item(KP p, int l, int mt, int nt, unsigned char* smem) {
  const int m0 = mt * (GMT * 32), n0 = nt * 128;
  f32x4 acc[GMT][4]; zero_acc<GMT, 4>(acc);
  gemm_acc<GMT, 4>(acc, (const u16*)(p->ws + WS_HIDDEN) + (size_t)m0 * 4096, 4096, (const u16*)(p->ws + WS_W2) + (size_t)n0 * 4096, 4096, 4096, smem);
  const float* g2 = (const float*)(p->ws + WS_MOD) + (l * 3 + mod_group(m0)) * 6144 + 5120;
  EPI_LOOP(GMT, 4) { int row = EPI_ROW(m0, GMT), col = EPI_COL(n0, 4); float4* o = (float4*)(p->out + (size_t)row * DM + col); const float4 xv = *o, gv = *(const float4*)(g2 + col);
    *o = make_float4(xv.x + gv.x * acc[i][j][0], xv.y + gv.y * acc[i][j][1], xv.z + gv.z * acc[i][j][2], xv.w + gv.w * acc[i][j][3]); }
}

DI void prep_load(const u16* R, int lane, float (&hv)[12], float (&vv4)[4]) {
#pragma unroll
  for (int hh = 0; hh < 12; ++hh) {
    const int col = hh < 4 ? C_AQ + hh * 64 : (hh < 6 ? C_AK + (hh - 4) * 64 : (hh < 10 ? C_DQ + (hh - 6) * 64 : C_DK + (hh - 10) * 64));
    hv[hh] = bf2f(R[col + lane]);
  }
  vv4[0] = bf2f(R[C_AV + lane]); vv4[1] = bf2f(R[C_AV + 64 + lane]); vv4[2] = bf2f(R[C_DV + lane]); vv4[3] = bf2f(R[C_DV + 64 + lane]);
}
DI void prep_token(KP p, int l, int row, int lane, u16* R, const float (&hv)[12], const float (&vv4)[4]) {
  const bool lat = row >= 8192;
  float cs = 1.f, sn = 0.f;
  if (lat) {
    int t = (row - 8192) & 4095;
    int pos = (lane < 32) ? (t >> 6) : (t & 63);
    float inv = __expf(-(float)(lane & 15) * (9.210340371976184f / 16.f));
    float ang = (float)pos * inv;
    cs = __cosf(ang); sn = __sinf(ang);
  }
  const int b = row >> 8, t = row & 255;
#pragma unroll
  for (int hh = 0; hh < 12; ++hh) {
    int col; const float* g;
    if (hh < 4) { col = C_AQ + hh * 64; g = p->in[15] + l * 64; }
    else if (hh < 6) { col = C_AK + (hh - 4) * 64; g = p->in[16] + l * 64; }
    else if (hh < 10) { col = C_DQ + (hh - 6) * 64; g = p->in[29] + l * 64; }
    else { col = C_DK + (hh - 10) * 64; g = p->in[30] + l * 64; }
    float v = hv[hh];
    float ss = wave_sum(v * v);
    float y = v * rsqrtf(ss * (1.f / 64.f) + 1e-6f) * g[lane];
    if (lat) {
      float yp = __shfl_xor(y, 16, 64);
      y = ((lane & 31) < 16) ? (y * cs - yp * sn) : (y * cs + yp * sn);
    } else {
      if (hh == 4 || hh == 5) p->out[O_AK + ((size_t)(b * 2 + l) * 256 + t) * 128 + (hh - 4) * 64 + lane] = y;
      if (hh >= 10) p->out[O_DK + ((size_t)(b * 2 + l) * 256 + t) * 128 + (hh - 10) * 64 + lane] = y;
    }
    R[col + lane] = f2bf(y);
  }
  if (lat) {
    const int bl = (row - 8192) >> 12, tl = (row - 8192) & 4095;
    u16* VT = (u16*)(p->ws + WS_VT) + (size_t)lane * 4608 + 512 + tl;
#pragma unroll
    for (int q = 0; q < 4; ++q)
      VT[(size_t)(((q >> 1) * 2 + bl) * 2 + (q & 1)) * 64 * 4608] = f2bf(vv4[q]);
  }
  if (!lat) {
    size_t o = ((size_t)(b * 2 + l) * 256 + t) * 128;
    p->out[O_AV + o + lane] = vv4[0]; p->out[O_AV + o + 64 + lane] = vv4[1];
    p->out[O_DV + o + lane] = vv4[2]; p->out[O_DV + o + 64 + lane] = vv4[3];
  }
}
DI void prep_item(KP p, int l, int item) {
  const int tid = ltid(), lane = tid & 63, wave = tid >> 6;
  const int row0 = item * 8 + wave * 2;
  u16* R0 = (u16*)(p->ws + WS_INPROJ) + (size_t)row0 * LDI;
  u16* R1 = R0 + LDI;
  float hv0[12], vv0[4], hv1[12], vv1[4];
  prep_load(R0, lane, hv0, vv0); prep_load(R1, lane, hv1, vv1);
  prep_token(p, l, row0, lane, R0, hv0, vv0);
  prep_token(p, l, row0 + 1, lane, R1, hv1, vv1);
}

DI void kvc_item(KP p, int l, int item) {
  u16* KC = (u16*)(p->ws + WS_KC);
#pragma unroll
  for (int it = 0; it < 8; ++it) {
    int idx4 = item * 2048 + it * 256 + ltid();
    int e = idx4 * 4;
    int d = e & 63, key = (e >> 6) & 511, sel = e >> 15;
    int kv = sel & 1, kvh = (sel >> 1) & 1, b = (sel >> 2) & 1, mixer = sel >> 3;
    const float* srcb = mixer ? (kv ? p->in[6] : p->in[5]) : (kv ? p->in[4] : p->in[3]);
    const float* src = srcb + ((size_t)((b * 2 + l) * 512 + key) * 2 + kvh) * 64 + d;
    float4 v = *(const float4*)src;
    *(uint2*)(KC + e) = make_uint2(pack2(v.x, v.y), pack2(v.z, v.w));
    if (kv) {
      u16* VT = (u16*)(p->ws + WS_VT) + ((size_t)((mixer * 2 + b) * 2 + kvh) * 64 + d) * 4608 + key;
      VT[0] = f2bf(v.x); VT[4608] = f2bf(v.y); VT[2 * 4608] = f2bf(v.z); VT[3 * 4608] = f2bf(v.w);
    }
  }
}

DI void attn_item(KP p, int l, int it, unsigned char* smem) {
  u16* sK = (u16*)smem;
  u16* sVt = sK + 64 * 72;
  const int tid = ltid(), lane = tid & 63, wave = tid >> 6, lq = lane & 15, quad = lane >> 4;
  int kind, b, qh, qb;
  if (it < 512) { kind = it >> 8; int r = it & 255; b = r >> 7; qh = (r >> 5) & 3; qb = r & 31; }
  else { int r = it - 512; kind = 2 + (r >> 8); r &= 255; b = r >> 3; qh = (r >> 1) & 3; qb = r & 1; }
  const bool isD = (kind == 0 || kind == 3), lat = kind < 2;
  const int seqrow0 = lat ? 8192 + b * 4096 : b * 256;
  const int q0 = qb * 128, kvh = qh >> 1;
  const int qcol = (isD ? C_DQ : C_AQ) + qh * 64, kcol = (isD ? C_DK : C_AK) + kvh * 64, vcol = (isD ? C_DV : C_AV) + kvh * 64;
  const int ocol = (isD ? 768 : 0) + qh * 64;
  const int ncache = lat ? 8 : 0;
  int kt_lo = 0, kt_hi = lat ? 64 : 4;
  if (kind == 1) { kt_lo = max(0, 2 * qb - 2); kt_hi = min(64, 2 * qb + 4); }
  const int ntiles = ncache + kt_hi - kt_lo;
  const bool band = (kind == 1);
  const u16* INP = (const u16*)(p->ws + WS_INPROJ);
  const u16* KCk = (const u16*)(p->ws + WS_KC) + (size_t)((((isD ? 1 : 0) * 2 + b) * 2 + kvh) * 2) * 512 * 64;
  const u16* KCv = KCk + 512 * 64;
  constexpr float SC2 = 0.125f * 1.4426950408889634f;
  const float sinkv = isD ? -1e30f : p->in[17][l * 4 + qh] * 1.4426950408889634f;

  bf16x8 qf[2][2];
#pragma unroll
  for (int nt = 0; nt < 2; ++nt)
#pragma unroll
    for (int s = 0; s < 2; ++s) qf[nt][s] = ld8(INP + (size_t)(seqrow0 + q0 + wave * 32 + nt * 16 + lq) * LDI + qcol + s * 32 + quad * 8);
  float mrun[2], lsum[2];
  f32x4 oacc[4][2];
#pragma unroll
  for (int nt = 0; nt < 2; ++nt) { mrun[nt] = sinkv; lsum[nt] = (!isD && quad == 0) ? 1.f : 0.f; }
#pragma unroll
  for (int dt = 0; dt < 4; ++dt)
#pragma unroll
    for (int nt = 0; nt < 2; ++nt) oacc[dt][nt] = f32x4{0.f, 0.f, 0.f, 0.f};

  const int key = tid >> 2, seg = (tid & 3) * 16;
  struct KVReg { u32x4 k[2], v[2]; };
  KVReg R0, R1;
  const u16* VTp = (const u16*)(p->ws + WS_VT) + ((size_t)(((isD ? 1 : 0) * 2 + b) * 2 + kvh) * 64 + key) * 4608 + seg;
  auto tile_ptrs = [&](int t, const u16*& kp, const u16*& vp) {
    if (t < ncache) { kp = KCk + (size_t)(t * 64 + key) * 64 + seg; vp = VTp + t * 64; }
    else {
      const u16* rowp = INP + (size_t)(seqrow0 + (kt_lo + t - ncache) * 64 + key) * LDI; kp = rowp + kcol + seg;
      vp = lat ? VTp + 512 + (kt_lo + t - ncache) * 64 : rowp + vcol + seg;
    }
  };
  auto kvload = [&](int t, KVReg& R) {
    const u16 *kp, *vp; tile_ptrs(t, kp, vp);
    R.k[0] = *(const u32x4*)kp; R.k[1] = *(const u32x4*)(kp + 8); R.v[0] = *(const u32x4*)vp; R.v[1] = *(const u32x4*)(vp + 8);
  };
  kvload(0, R0);
  if (ntiles > 1) kvload(1, R1);
  auto step = [&](int t, KVReg& R) {
    __syncthreads();
    *(u32x4*)(sK + key * 72 + seg) = R.k[0]; *(u32x4*)(sK + key * 72 + seg + 8) = R.k[1];
    if (lat) {
      *(u32x4*)(sVt + key * 72 + seg) = R.v[0]; *(u32x4*)(sVt + key * 72 + seg + 8) = R.v[1];
    } else {
      unsigned vv[8] = {R.v[0].x, R.v[0].y, R.v[0].z, R.v[0].w, R.v[1].x, R.v[1].y, R.v[1].z, R.v[1].w};
#pragma unroll
      for (int e = 0; e < 8; ++e) { sVt[(seg + 2 * e) * 72 + key] = (u16)(vv[e] & 0xffffu); sVt[(seg + 2 * e + 1) * 72 + key] = (u16)(vv[e] >> 16); }
    }
    __syncthreads();
    if (t + 2 < ntiles) kvload(t + 2, R);
    f32x4 sacc[4][2];
#pragma unroll
    for (int mt = 0; mt < 4; ++mt) {
      sacc[mt][0] = f32x4{0.f, 0.f, 0.f, 0.f}; sacc[mt][1] = f32x4{0.f, 0.f, 0.f, 0.f};
#pragma unroll
      for (int s = 0; s < 2; ++s) {
        bf16x8 ka = ld8(sK + (mt * 16 + lq) * 72 + s * 32 + quad * 8);
        sacc[mt][0] = MFMA16(ka, qf[0][s], sacc[mt][0]);
        sacc[mt][1] = MFMA16(ka, qf[1][s], sacc[mt][1]);
      }
    }
    const bool masked_tile = band && t >= ncache;
    const int kbase = (kt_lo + t - ncache) * 64;
    bf16x8 pf[2][2];
#pragma unroll
    for (int nt = 0; nt < 2; ++nt) {
      const int qi = q0 + wave * 32 + nt * 16 + lq;
      float tmax = -1e30f;
#pragma unroll
      for (int mt = 0; mt < 4; ++mt)
#pragma unroll
        for (int r = 0; r < 4; ++r) {
          float sv_ = sacc[mt][nt][r] * SC2;
          if (masked_tile) { int kj = kbase + mt * 16 + quad * 4 + r; int dlt = qi - kj; if (dlt > 128 || dlt < -128) sv_ = -1e30f; }
          sacc[mt][nt][r] = sv_; tmax = fmaxf(tmax, sv_);
        }
      tmax = fmaxf(tmax, __shfl_xor(tmax, 16, 64)); tmax = fmaxf(tmax, __shfl_xor(tmax, 32, 64));
      const float mold = mrun[nt];
      const float mnew = fmaxf(mold, tmax);
      float ps = 0.f;
#pragma unroll
      for (int mt = 0; mt < 4; ++mt)
#pragma unroll
        for (int r = 0; r < 4; ++r) { float e = __builtin_amdgcn_exp2f(sacc[mt][nt][r] - mnew); sacc[mt][nt][r] = e; ps += e; }
      if (__any(mnew != mold)) {
        const float alpha = __builtin_amdgcn_exp2f(mold - mnew);
        lsum[nt] *= alpha;
#pragma unroll
        for (int dt = 0; dt < 4; ++dt)
#pragma unroll
          for (int r = 0; r < 4; ++r) oacc[dt][nt][r] *= alpha;
      }
      lsum[nt] += ps; mrun[nt] = mnew;
      pf[nt][0] = pack8(sacc[0][nt], sacc[1][nt]);
      pf[nt][1] = pack8(sacc[2][nt], sacc[3][nt]);
    }
#pragma unroll
    for (int dt = 0; dt < 4; ++dt)
#pragma unroll
      for (int s2 = 0; s2 < 2; ++s2) {
        bf16x8 va = ldperm(sVt + (dt * 16 + lq) * 72 + s2 * 32 + quad * 4);
        oacc[dt][0] = MFMA16(va, pf[0][s2], oacc[dt][0]);
        oacc[dt][1] = MFMA16(va, pf[1][s2], oacc[dt][1]);
      }
  };
  for (int t = 0; t < ntiles; t += 2) { step(t, R0); if (t + 1 < ntiles) step(t + 1, R1); }
  u16* BR = (u16*)(p->ws + WS_BRANCH);
#pragma unroll
  for (int nt = 0; nt < 2; ++nt) {
    float lt = lsum[nt]; lt += __shfl_xor(lt, 16, 64); lt += __shfl_xor(lt, 32, 64);
    const float inv = 1.f / lt;
    const size_t row = seqrow0 + q0 + wave * 32 + nt * 16 + lq;
#pragma unroll
    for (int dt = 0; dt < 4; ++dt)
      *(uint2*)(BR + row * 1024 + ocol + dt * 16 + quad * 4) = make_uint2(pack2(oacc[dt][nt][0] * inv, oacc[dt][nt][1] * inv), pack2(oacc[dt][nt][2] * inv, oacc[dt][nt][3] * inv));
  }
  __syncthreads();
}

DI int lru_xoff(int t, int c) { return t * 256 + (c ^ ((t & 7) << 3)); }
template <bool FINAL>
DI void lru_item(KP p, int l, int ci, unsigned char* smem) {
  u16* sxb = (u16*)smem;
  u16* sla = sxb + 32 * 256;
  u16* sbv = sla + 32 * 256;
  u16* shf = sbv + 32 * 256;
  const int tid = ltid(), ch = tid, lane = tid & 63, n = tid >> 6, lq = lane & 15, quad = lane >> 4;
  const int r0 = ci * 32;
  const bool lat = r0 >= 8192;
  int b, T, seqrow0;
  if (!lat) { b = r0 >> 8; T = 256; seqrow0 = b * 256; } else { b = (r0 - 8192) >> 12; T = 4096; seqrow0 = 8192 + b * 4096; }
  const int t0 = r0 - seqrow0;
  const u16* INP = (const u16*)(p->ws + WS_INPROJ);
  __syncthreads();
  {
    const float* cw = p->in[18] + l * 4 * 256;
    const float w0 = cw[ch], w1 = cw[256 + ch], w2 = cw[512 + ch], w3 = cw[768 + ch], cb = p->in[19][l * 256 + ch];
    auto ld = [&](int t) -> float { return (t >= 0 && t < T) ? bf2f(INP[(size_t)(seqrow0 + t) * LDI + C_LX + ch]) : 0.f; };
    float xin[35];
#pragma unroll
    for (int q = 0; q < 35; ++q) xin[q] = ld(t0 - 2 + q);
#pragma unroll
    for (int t = 0; t < 32; ++t) sxb[lru_xoff(t, ch)] = f2bf(xin[t] * w0 + xin[t + 1] * w1 + xin[t + 2] * w2 + xin[t + 3] * w3 + cb);
  }
  __syncthreads();
  const int nch = T / 32, c = t0 / 32;
  float* LC = (float*)(p->ws + WS_LRUC);
  bf16x8 af[2][2];
#pragma unroll
  for (int mt = 0; mt < 2; ++mt)
#pragma unroll
    for (int s2 = 0; s2 < 2; ++s2) af[mt][s2] = ld8(sxb + lru_xoff(mt * 16 + lq, n * 64 + s2 * 32 + quad * 8));
  for (int dir = 0; dir < 2; ++dir) {
    bf16x8 wf[2][4][2];
    {
      const u32x4* WF = (const u32x4*)(p->ws + WS_LRUW);
#pragma unroll
      for (int g = 0; g < 2; ++g)
#pragma unroll
        for (int j = 0; j < 4; ++j)
#pragma unroll
          for (int s2 = 0; s2 < 2; ++s2)
            wf[g][j][s2] = __builtin_bit_cast(bf16x8, WF[(size_t)((((((l * 2 + dir) * 2 + g) * 4 + n) * 4 + j) * 2 + s2)) * 64 + lane]);
    }
#pragma unroll
    for (int j = 0; j < 4; ++j) {
      f32x4 acc[2][2];
#pragma unroll
      for (int g = 0; g < 2; ++g) {
        f32x4 a0 = {0.f, 0.f, 0.f, 0.f}, a1 = {0.f, 0.f, 0.f, 0.f};
#pragma unroll
        for (int s2 = 0; s2 < 2; ++s2) { a0 = MFMA16(af[0][s2], wf[g][j][s2], a0); a1 = MFMA16(af[1][s2], wf[g][j][s2], a1); }
        acc[g][0] = a0; acc[g][1] = a1;
      }
      const int cc = n * 64 + j * 16 + lq;
      const float br = p->in[21][(l * 2 + dir) * 256 + cc], bi = p->in[23][(l * 2 + dir) * 256 + cc];
      const float sp = softplusf_(-p->in[24][(l * 2 + dir) * 256 + cc]);
#pragma unroll
      for (int mt = 0; mt < 2; ++mt)
#pragma unroll
        for (int r = 0; r < 4; ++r) {
          const int t = mt * 16 + quad * 4 + r;
          const float la = -8.f * sigm(acc[0][mt][r] + br) * sp;
          const float xt = bf2f(sxb[lru_xoff(t, cc)]);
          const float bb = sqrtf(-expm1f(2.f * la)) * sigm(acc[1][mt][r] + bi) * xt;
          sla[t * 256 + cc] = f2bf(la); sbv[t * 256 + cc] = f2bf(bb);
        }
    }
    __syncthreads();
    float h = 0.f, lasum = 0.f;
    if (FINAL) {
      h = lat ? p->in[7][((b * 2 + l) * 2 + dir) * 256 + ch] : 0.f;
      const int ncar = dir == 0 ? c : nch - 1 - c;
      const int cstart = dir == 0 ? ci - c : ci - c + nch - 1, cstep = dir == 0 ? 1 : -1;
      for (int q0 = 0; q0 < ncar; q0 += 16) {
        float ca[16], chh[16];
#pragma unroll
        for (int q = 0; q < 16; ++q) {
          const int qq = q0 + q < ncar ? q0 + q : ncar - 1;
          const float* C = LC + ((size_t)((cstart + cstep * qq) * 2 + dir) * 2) * 256;
          ca[q] = C[ch]; chh[q] = C[256 + ch];
        }
#pragma unroll
        for (int q = 0; q < 16; ++q) if (q0 + q < ncar) h = ca[q] * h + chh[q];
      }
    }
#pragma unroll 1
    for (int s8 = 0; s8 < 32; s8 += 16) {
      float gv[16];
      if (FINAL && dir == 1) {
#pragma unroll
        for (int q = 0; q < 16; ++q) gv[q] = bf2f(INP[(size_t)(r0 + 31 - s8 - q) * LDI + C_LG + ch]);
      }
#pragma unroll
      for (int q = 0; q < 16; ++q) {
        const int st = s8 + q;
        const int t = dir == 0 ? st : 31 - st;
        const float la = bf2f(sla[t * 256 + ch]);
        h = __expf(la) * h + bf2f(sbv[t * 256 + ch]);
        lasum += la;
        if (FINAL) {
          if (dir == 0) shf[t * 256 + ch] = f2bf(h);
          else ((u16*)(p->ws + WS_BRANCH))[(size_t)(r0 + t) * 1024 + 256 + ch] = f2bf((bf2f(shf[t * 256 + ch]) + h) * gelu_tanh(gv[q]));
        }
      }
    }
    if (!FINAL) { float* C = LC + ((size_t)(ci * 2 + dir) * 2) * 256; C[ch] = __expf(lasum); C[256 + ch] = h; }
    else if (!lat) {
      if (dir == 0 && c == nch - 1) p->out[O_LRU + ((size_t)(b * 2 + l) * 2 + 0) * 256 + ch] = h;
      if (dir == 1 && c == 0) p->out[O_LRU + ((size_t)(b * 2 + l) * 2 + 1) * 256 + ch] = h;
    }
    __syncthreads();
  }
}

template <int DIR, bool ISW>
DI void gdn_solve(const float* L, const u16* src, const float* sb_, const float* se_, u16* UW) {
  float sol[64];
#pragma unroll
  for (int i = 0; i < 64; ++i) {
    float s = bf2f(src[(DIR == 0 ? i : 63 - i) * 72]) * sb_[i];
    if (ISW) s *= se_[i];
    float s0 = 0.f, s1 = 0.f, s2 = 0.f, s3 = 0.f;
#pragma unroll
    for (int j4 = 0; j4 < (i + 3) / 4; ++j4) {
      float4 lv = *(const float4*)(L + i * 64 + j4 * 4);
      if (j4 * 4 + 0 < i) s0 += lv.x * sol[j4 * 4 + 0];
      if (j4 * 4 + 1 < i) s1 += lv.y * sol[j4 * 4 + 1];
      if (j4 * 4 + 2 < i) s2 += lv.z * sol[j4 * 4 + 2];
      if (j4 * 4 + 3 < i) s3 += lv.w * sol[j4 * 4 + 3];
      if ((j4 & 3) == 3) asm volatile("" ::: "memory");
    }
    s -= (s0 + s1) + (s2 + s3);
    sol[i] = s;
    UW[i * 128] = f2bf(s);
    asm volatile("" ::: "memory");
  }
}

DI void gdn1_item(KP p, int l, int item, unsigned char* smem) {
  const int cgi = item >> 2, hd = item & 3;
  u16* sq = (u16*)smem; u16* sk = sq + 64 * 72; u16* sv = sk + 64 * 72;
  float* sL = (float*)(smem + 27648);
  float* sgc = (float*)(smem + 60416);
  float* sbeta = sgc + 128;
  float* sge = sbeta + 128;
  const int tid = ltid(), lane = tid & 63, wave = tid >> 6, lq = lane & 15, quad = lane >> 4;
  const int r0 = cgi * 64;
  const bool lat = r0 >= 8192;
  int T, seqrow0;
  if (!lat) { T = 256; seqrow0 = (r0 >> 8) * 256; } else { T = 4096; seqrow0 = 8192 + ((r0 - 8192) >> 12) * 4096; }
  const int t0 = r0 - seqrow0;
  const u16* INP = (const u16*)(p->ws + WS_INPROJ);
  u16* QHAT = (u16*)(p->ws + WS_QHAT) + (size_t)item * 4096;
  {
    const int d = lane, tb = wave * 16;
#pragma unroll
    for (int mat = 0; mat < 3; ++mat) {
      const int col = C_GQ + mat * 256 + hd * 64 + d, wc = mat * 256 + hd * 64 + d;
      const float* cw = p->in[25] + (size_t)l * 4 * 768;
      const float w0 = cw[wc], w1 = cw[768 + wc], w2 = cw[1536 + wc], w3 = cw[2304 + wc];
      auto ld = [&](int t) -> float { return (t >= 0 && t < T) ? bf2f(INP[(size_t)(seqrow0 + t) * LDI + col]) : 0.f; };
      float xin[19];
#pragma unroll
      for (int q = 0; q < 19; ++q) xin[q] = ld(t0 + tb - 2 + q);
      u16* dst = mat == 0 ? sq : (mat == 1 ? sk : sv);
#pragma unroll
      for (int tt = 0; tt < 16; ++tt) {
        const int t = tb + tt;
        float v = siluf_(xin[tt] * w0 + xin[tt + 1] * w1 + xin[tt + 2] * w2 + xin[tt + 3] * w3);
        if (mat < 2) { float ss = wave_sum(v * v); v *= rsqrtf(ss + 1e-6f) * (mat == 0 ? 0.125f : 1.f); }
        u16 hb = f2bf(v);
        dst[t * 72 + d] = hb;
        if (mat == 0) QHAT[t * 64 + d] = hb;
      }
    }
  }
  if (tid < 128) {
    const int dir = tid >> 6, c = tid & 63;
    const int tok = dir == 0 ? c : 63 - c;
    const u16* R = INP + (size_t)(r0 + tok) * LDI;
    const float ga = bf2f(R[C_GA + dir * 4 + hd]), gb = bf2f(R[C_GB + dir * 4 + hd]);
    const float g = -__expf(p->in[26][(l * 2 + dir) * 4 + hd]) * softplusf_(ga + p->in[27][(l * 2 + dir) * 4 + hd]);
    float gc = g;
#pragma unroll
    for (int o = 1; o < 64; o <<= 1) { float tt = __shfl_up(gc, o, 64); if (lane >= o) gc += tt; }
    const float glast = __shfl(gc, 63, 64);
    sgc[dir * 64 + c] = gc; sbeta[dir * 64 + c] = sigm(gb); sge[dir * 64 + c] = __expf(gc);
    float* gv = (float*)(p->ws + WS_GVEC) + (size_t)(item * 2 + dir) * 256;
    gv[c] = __expf(gc); gv[64 + c] = __expf(glast - gc); if (c == 0) gv[128] = __expf(glast);
  }
  __syncthreads();
  {
    const int dk = tid >> 2, c0 = (tid & 3) * 16;
    unsigned w[8];
#pragma unroll
    for (int e = 0; e < 8; ++e) w[e] = (unsigned)sk[(c0 + 2 * e) * 72 + dk] | ((unsigned)sk[(c0 + 2 * e + 1) * 72 + dk] << 16);
    u16* KT = (u16*)(p->ws + WS_KT) + (size_t)item * 4096 + dk * 64 + c0;
    *(u32x4*)KT = mku4(w[0], w[1], w[2], w[3]); *(u32x4*)(KT + 8) = mku4(w[4], w[5], w[6], w[7]);
  }
  {
    const int i0 = wave * 16;
    f32x4 akk[4], aqk[4];
#pragma unroll
    for (int nt = 0; nt < 4; ++nt) { akk[nt] = f32x4{0.f, 0.f, 0.f, 0.f}; aqk[nt] = f32x4{0.f, 0.f, 0.f, 0.f}; }
#pragma unroll
    for (int s = 0; s < 2; ++s) {
      bf16x8 ak = ld8(sk + (i0 + lq) * 72 + s * 32 + quad * 8), aq = ld8(sq + (i0 + lq) * 72 + s * 32 + quad * 8);
#pragma unroll
      for (int nt = 0; nt < 4; ++nt) { bf16x8 bk = ld8(sk + (nt * 16 + lq) * 72 + s * 32 + quad * 8); akk[nt] = MFMA16(ak, bk, akk[nt]); aqk[nt] = MFMA16(aq, bk, aqk[nt]); }
    }
    u16* QKf = (u16*)(p->ws + WS_QK) + (size_t)(item * 2 + 0) * 4096;
    u16* QKb = (u16*)(p->ws + WS_QK) + (size_t)(item * 2 + 1) * 4096;
#pragma unroll
    for (int nt = 0; nt < 4; ++nt)
#pragma unroll
      for (int r = 0; r < 4; ++r) {
        const int i = i0 + quad * 4 + r, j = nt * 16 + lq, ib = 63 - i, jb = 63 - j;
        const float kkv = akk[nt][r], qkv = aqk[nt][r];
        if (j < i) sL[i * 64 + j] = sbeta[i] * kkv * __expf(sgc[i] - sgc[j]);
        if (j > i) sL[4096 + ib * 64 + jb] = sbeta[64 + ib] * kkv * __expf(sgc[64 + ib] - sgc[64 + jb]);
        QKf[i * 64 + j] = f2bf(j <= i ? qkv * __expf(sgc[i] - sgc[j]) : 0.f);
        QKb[ib * 64 + jb] = f2bf(j >= i ? qkv * __expf(sgc[64 + ib] - sgc[64 + jb]) : 0.f);
      }
  }
  __syncthreads();
  {
    const int col = tid & 127;
    u16* UW = (u16*)(p->ws + WS_UW) + (size_t)(item * 2 + (tid >> 7)) * 8192 + col;
    for (int rep = 0; rep < NREP(2); ++rep) {
    if (tid < 128) { if (col < 64) gdn_solve<0, false>(sL, sv + col, sbeta, sge, UW); else gdn_solve<0, true>(sL, sk + (col - 64), sbeta, sge, UW); }
    else { if (col < 64) gdn_solve<1, false>(sL + 4096, sv + col, sbeta + 64, sge + 64, UW); else gdn_solve<1, true>(sL + 4096, sk + (col - 64), sbeta + 64, sge + 64, UW); }
    }
  }
  __syncthreads();
}

DI void gdn2_item(KP p, int l, int item, unsigned char* smem) {
  u16* sW = (u16*)smem; u16* sKT = sW + 64 * 72; u16* sU = sKT + 64 * 72;
  float* sg = (float*)(smem + 27648);
  const int tid = ltid(), lane = tid & 63, wave = tid >> 6, lq = lane & 15, quad = lane >> 4;
  int b, hd, dir; bool lat;
  if (item < 16) { lat = true; b = item >> 3; hd = (item >> 1) & 3; dir = item & 1; }
  else { lat = false; int r = item - 16; b = r >> 3; hd = (r >> 1) & 3; dir = r & 1; }
  const int nch = lat ? 64 : 4, cg0 = lat ? 128 + b * 64 : b * 4;
  f32x4 st[4];
#pragma unroll
  for (int kt = 0; kt < 4; ++kt)
#pragma unroll
    for (int r = 0; r < 4; ++r)
      st[kt][r] = lat ? p->in[8][((size_t)(((b * 2 + l) * 2 + dir) * 4 + hd) * 64 + kt * 16 + quad * 4 + r) * 64 + wave * 16 + lq] : 0.f;
  const int lrow = tid >> 2, seg = (tid & 3) * 16;
  struct GReg { u32x4 U[2], W[2], KT[2]; float g; };
  GReg R0, R1;
  u16* UWb = (u16*)(p->ws + WS_UW);
  const u16* KTb = (const u16*)(p->ws + WS_KT);
  const float* GV = (const float*)(p->ws + WS_GVEC);
  auto gload = [&](int n, GReg& R) {
    const int cgi = dir == 0 ? cg0 + n : cg0 + nch - 1 - n;
    const size_t prob = (size_t)cgi * 4 + hd, pd = prob * 2 + dir;
    const u16* u = UWb + (pd * 64 + lrow) * 128 + seg;
    R.U[0] = *(const u32x4*)u; R.U[1] = *(const u32x4*)(u + 8); R.W[0] = *(const u32x4*)(u + 64); R.W[1] = *(const u32x4*)(u + 72);
    const u16* kt = KTb + (prob * 64 + lrow) * 64 + (dir ? 48 - seg : seg);
    u32x4 a = *(const u32x4*)kt, bb = *(const u32x4*)(kt + 8);
    if (dir) { R.KT[0] = rev8(bb); R.KT[1] = rev8(a); } else { R.KT[0] = a; R.KT[1] = bb; }
    R.g = GV[pd * 256 + (tid & 255)];
  };
  gload(0, R0); gload(1, R1);
  auto step = [&](int n, GReg& R) {
    const int cgi = dir == 0 ? cg0 + n : cg0 + nch - 1 - n;
    const size_t pd = ((size_t)cgi * 4 + hd) * 2 + dir;
    __syncthreads();
    *(u32x4*)(sW + lrow * 72 + seg) = R.W[0]; *(u32x4*)(sW + lrow * 72 + seg + 8) = R.W[1];
    *(u32x4*)(sKT + lrow * 72 + seg) = R.KT[0]; *(u32x4*)(sKT + lrow * 72 + seg + 8) = R.KT[1];
    *(u32x4*)(sU + lrow * 72 + seg) = R.U[0]; *(u32x4*)(sU + lrow * 72 + seg + 8) = R.U[1];
    sg[tid] = R.g;
    __syncthreads();
    if (n + 2 < nch) gload(n + 2, R);
    u32x4* FR = (u32x4*)(UWb + pd * 8192);
    const float elast = sg[128];
    bf16x8 sB[2] = {pack8(st[0], st[1]), pack8(st[2], st[3])};
    FR[(0 * 4 + wave) * 64 + lane] = __builtin_bit_cast(u32x4, sB[0]);
    FR[(1 * 4 + wave) * 64 + lane] = __builtin_bit_cast(u32x4, sB[1]);
    f32x4 vn[4];
#pragma unroll
    for (int mt = 0; mt < 4; ++mt) {
      f32x4 acc = {0.f, 0.f, 0.f, 0.f};
#pragma unroll
      for (int s2 = 0; s2 < 2; ++s2) acc = MFMA16(ldperm(sW + (mt * 16 + lq) * 72 + s2 * 32 + quad * 4), sB[s2], acc);
#pragma unroll
      for (int r = 0; r < 4; ++r) vn[mt][r] = bf2f(sU[(mt * 16 + quad * 4 + r) * 72 + wave * 16 + lq]) - acc[r];
    }
    bf16x8 vB[2] = {pack8(vn[0], vn[1]), pack8(vn[2], vn[3])};
    FR[512 + (0 * 4 + wave) * 64 + lane] = __builtin_bit_cast(u32x4, vB[0]);
    FR[512 + (1 * 4 + wave) * 64 + lane] = __builtin_bit_cast(u32x4, vB[1]);
#pragma unroll
    for (int mt = 0; mt < 4; ++mt)
#pragma unroll
      for (int r = 0; r < 4; ++r) vn[mt][r] *= sg[64 + mt * 16 + quad * 4 + r];
    bf16x8 vsB[2] = {pack8(vn[0], vn[1]), pack8(vn[2], vn[3])};
#pragma unroll
    for (int kt = 0; kt < 4; ++kt) {
      f32x4 acc = {0.f, 0.f, 0.f, 0.f};
#pragma unroll
      for (int s2 = 0; s2 < 2; ++s2) acc = MFMA16(ldperm(sKT + (kt * 16 + lq) * 72 + s2 * 32 + quad * 4), vsB[s2], acc);
#pragma unroll
      for (int r = 0; r < 4; ++r) st[kt][r] = elast * st[kt][r] + acc[r];
    }
  };
  for (int n = 0; n < nch; n += 2) { step(n, R0); step(n + 1, R1); }
  if (!lat) {
#pragma unroll
    for (int kt = 0; kt < 4; ++kt)
#pragma unroll
      for (int r = 0; r < 4; ++r)
        p->out[O_GDN + ((size_t)(((b * 2 + l) * 2 + dir) * 4 + hd) * 64 + kt * 16 + quad * 4 + r) * 64 + wave * 16 + lq] = st[kt][r];
  }
  __syncthreads();
}

DI void gdnfin_item(KP p, int l, int item, unsigned char* smem) {
  u16* sQ = (u16*)smem; u16* sQK = sQ + 64 * 72;
  float* so = (float*)(smem + 3 * 64 * 72 * 2);
  float* seg_ = so + 64 * 65;
  const int cgi = item >> 2, hd = item & 3;
  const int tid = ltid(), lane = tid & 63, wave = tid >> 6, lq = lane & 15, quad = lane >> 4;
  const int lrow = tid >> 2, seg = (tid & 3) * 16;
  __syncthreads();
  {
    const u16* q = (const u16*)(p->ws + WS_QHAT) + ((size_t)item * 64 + lrow) * 64 + seg;
    *(u32x4*)(sQ + lrow * 72 + seg) = *(const u32x4*)q; *(u32x4*)(sQ + lrow * 72 + seg + 8) = *(const u32x4*)(q + 8);
#pragma unroll
    for (int dir = 0; dir < 2; ++dir) {
      const u16* qk = (const u16*)(p->ws + WS_QK) + ((size_t)(item * 2 + dir) * 64 + lrow) * 64 + seg;
      *(u32x4*)(sQK + (dir * 64 + lrow) * 72 + seg) = *(const u32x4*)qk; *(u32x4*)(sQK + (dir * 64 + lrow) * 72 + seg + 8) = *(const u32x4*)(qk + 8);
    }
    if (tid < 128) seg_[tid] = ((const float*)(p->ws + WS_GVEC))[(size_t)(item * 2 + (tid >> 6)) * 256 + (tid & 63)];
  }
  __syncthreads();
#pragma unroll
  for (int dir = 0; dir < 2; ++dir) {
    const u32x4* FR = (const u32x4*)((const u16*)(p->ws + WS_UW) + (size_t)(item * 2 + dir) * 8192);
    bf16x8 sfr[2], vfr[2];
#pragma unroll
    for (int s2 = 0; s2 < 2; ++s2) {
      sfr[s2] = __builtin_bit_cast(bf16x8, FR[(s2 * 4 + wave) * 64 + lane]);
      vfr[s2] = __builtin_bit_cast(bf16x8, FR[512 + (s2 * 4 + wave) * 64 + lane]);
    }
#pragma unroll
    for (int mt = 0; mt < 4; ++mt) {
      f32x4 acc = {0.f, 0.f, 0.f, 0.f};
      const int qrow = dir ? 63 - (mt * 16 + lq) : mt * 16 + lq;
#pragma unroll
      for (int s2 = 0; s2 < 2; ++s2) acc = MFMA16(ldperm(sQ + qrow * 72 + s2 * 32 + quad * 4), sfr[s2], acc);
#pragma unroll
      for (int r = 0; r < 4; ++r) acc[r] *= seg_[dir * 64 + mt * 16 + quad * 4 + r];
#pragma unroll
      for (int s2 = 0; s2 < 2; ++s2) acc = MFMA16(ldperm(sQK + (dir * 64 + mt * 16 + lq) * 72 + s2 * 32 + quad * 4), vfr[s2], acc);
#pragma unroll
      for (int r = 0; r < 4; ++r) {
        const int c = mt * 16 + quad * 4 + r;
        const int tk = dir ? 63 - c : c;
        float* d = so + tk * 65 + wave * 16 + lq;
        if (dir == 0) *d = acc[r]; else *d += acc[r];
      }
    }
    __syncthreads();
  }
  const float gn = p->in[28][l * 64 + lane];
  float zv[16];
#pragma unroll
  for (int q = 0; q < 16; ++q)
    zv[q] = bf2f(((const u16*)(p->ws + WS_INPROJ))[((size_t)cgi * 64 + wave * 16 + q) * LDI + C_GZ + hd * 64 + lane]);
#pragma unroll
  for (int q = 0; q < 16; ++q) {
    const int c = wave * 16 + q;
    const size_t row = (size_t)cgi * 64 + c;
    float o = so[c * 65 + lane];
    float ss = wave_sum(o * o);
    float y = o * rsqrtf(ss * (1.f / 64.f) + 1e-6f) * gn * siluf_(zv[q]);
    ((u16*)(p->ws + WS_BRANCH))[row * 1024 + 512 + hd * 64 + lane] = f2bf(y);
  }
}

#define XB_TMO      128
#define XB_XCNT(j)  (256  + 64 * (j))
#define XB_XSUB(j)  (1280 + 64 * (j))
#define XB_XGEN(j)  (2304 + 64 * (j))
#define XB_TOP      3328
#define XB_TOPGEN   3392
#define XB_SPIN_CAP (1u << 20)
#define LAS __attribute__((address_space(3)))
DI unsigned xb_ld(unsigned* q) { return __hip_atomic_load(q, __ATOMIC_RELAXED, __HIP_MEMORY_SCOPE_AGENT); }
DI unsigned xb_add(unsigned* q, unsigned v) { return __hip_atomic_fetch_add(q, v, __ATOMIC_RELAXED, __HIP_MEMORY_SCOPE_AGENT); }
DI unsigned xb_xcc_id() { return (unsigned)__builtin_amdgcn_s_getreg((3 << 11) | 20) & 0xFu; }
#define XB_SPIN(cond, bar) do { unsigned _sp = 0; while (cond) { __builtin_amdgcn_s_sleep(1); \
    if ((++_sp & 255u) == 0u) { if (xb_ld(&(bar)[XB_TMO])) break; if (_sp > XB_SPIN_CAP) { atomicAdd(&(bar)[XB_TMO], 1u); break; } } } } while (0)
DI void xcd_barrier_complete(unsigned* bar, unsigned x, unsigned& nloc, unsigned& nx) {
  const unsigned G = gridDim.x;
  unsigned sum, cnt, mine, sp = 0u;
  for (;;) {
    sum = 0u; cnt = 0u; mine = 0u;
#pragma unroll
    for (unsigned j = 0; j < 16; ++j) { const unsigned c = xb_ld(&bar[XB_XCNT(j)]); sum += c; cnt += (c > 0u) ? 1u : 0u; mine = (j == x) ? c : mine; }
    if (sum == G) break;
    __builtin_amdgcn_s_sleep(1);
    if ((++sp & 255u) == 0u) { if (xb_ld(&bar[XB_TMO])) break; if (sp > XB_SPIN_CAP) { atomicAdd(&bar[XB_TMO], 1u); break; } }
  }
  nloc = mine > 0u ? mine : 1u; nx = cnt > 0u ? cnt : 1u;
}
DI void xcd_barrier(unsigned* bar, volatile LAS unsigned* st) {
  asm volatile("s_waitcnt vmcnt(0)" ::: "memory");
  __syncthreads();
  if (ltid() == 0) {
    const unsigned x = xb_xcc_id();
    __builtin_amdgcn_s_waitcnt(0);
    unsigned nloc = st[0], nx = st[1];
    if (nloc == 0u) { xcd_barrier_complete(bar, x, nloc, nx); st[0] = nloc; st[1] = nx; }
    const unsigned old = xb_add(&bar[XB_XSUB(x)], 1u);
    const unsigned gen = old / nloc;
    if (old + 1u == (gen + 1u) * nloc) {
      __builtin_amdgcn_fence(__ATOMIC_RELEASE, "agent");
      asm volatile("s_waitcnt vmcnt(0)" ::: "memory");
      const unsigned og = xb_add(&bar[XB_TOP], 1u);
      const unsigned tg = og / nx;
      if (og + 1u == (tg + 1u) * nx) xb_add(&bar[XB_TOPGEN], 1u);
      else XB_SPIN(xb_ld(&bar[XB_TOPGEN]) == tg, bar);
      __builtin_amdgcn_fence(__ATOMIC_ACQUIRE, "agent");
      xb_add(&bar[XB_XGEN(x)], 1u);
      asm volatile("s_waitcnt vmcnt(0)" ::: "memory");
    } else {
      XB_SPIN(xb_ld(&bar[XB_XGEN(x)]) == gen, bar);
      __builtin_amdgcn_fence(__ATOMIC_ACQUIRE, "agent");
      asm volatile("s_waitcnt vmcnt(0)" ::: "memory");
    }
  }
  __syncthreads();
}


#define FOR_TILES(MTI, NTI, SM, SN, CALL)                                                      \
  do {                                                                                         \
    if (G % 8 != 0) { for (int it_ = B; it_ < (MTI) * (NTI); it_ += G) { const int mt = it_ / (NTI), nt = it_ % (NTI); CALL; } } \
    else {                                                                                     \
      const int xcd_ = B & 7, j_ = B >> 3, J_ = G >> 3;                                        \
      const int nsm_ = ((MTI) + (SM) - 1) / (SM), nsn_ = ((NTI) + (SN) - 1) / (SN);            \
      const int st_ = (SM) * (SN), mysup_ = (nsm_ * nsn_ - xcd_ + 7) / 8;                      \
        \
                                  \
      for (int u_ = j_; u_ < mysup_ * st_; u_ += J_) {                                         \
        const int s_ = xcd_ + 8 * (u_ / st_), t_ = u_ % st_;                                   \
        const int sm_ = s_ / nsn_, sn_ = s_ % nsn_;                                            \
        const int mt = sm_ * (SM) + t_ / (SN), nt = sn_ * (SN) + t_ % (SN);                    \
        if (mt < (MTI) && nt < (NTI)) { CALL; }                                                \
      }                                                                                        \
    }                                                                                          \
  } while (0)

constexpr int NPHASE = 21;
__global__ void __launch_bounds__(256, 2) mk(Params p_unused, int ph_lo, int ph_hi) {
  extern __shared__ __attribute__((aligned(1024))) unsigned char smem[];
  int& s_item = *(int*)(smem + SMEM_BYTES);
  u32x4& xb_words = *(u32x4*)(smem + SMEM_BYTES + 16);
  const int G = gridDim.x, B = blockIdx.x;
  const bool fused = ph_hi - ph_lo > 1;
  if (fused) {
    if (ltid() == 0) { xb_words = u32x4{0u, 0u, 0u, 0u}; (void)xb_add(&((unsigned*)(((KP)__builtin_amdgcn_kernarg_segment_ptr())->ws + WS_BAR))[XB_XCNT(xb_xcc_id())], 1u); }
    __syncthreads();
  }
  for (int ph = ph_lo; ph < ph_hi; ++ph) {
    KP p = (KP)__builtin_amdgcn_kernarg_segment_ptr();
    asm volatile("" : "+s"(p));
    if (ph == 0) {
      for (int it = B; it < 192 + CONV_ITEMS + 64; it += G) { for (int rep = 0; rep < NREP(0); ++rep) { if (it < 192) mod_item(p, it, smem); else if (it < 192 + CONV_ITEMS) convert_item(p, 0, it - 192, smem); else lruw_item(p, it - 192 - CONV_ITEMS); } }
    } else {
      const int l = (ph - 1) / 10, sub = (ph - 1) % 10;
      switch (sub) {
        case 0:
          for (int it = B; it < 2048 + (l ? CONV_ITEMS : 0); it += G) { if (it < 2048) norm_item<0>(p, l, it); else convert_item(p, l, it - 2048, smem); }
          break;
        case 1: FOR_TILES(128, 21, 8, 7, inproj_item(p, mt, nt, smem)); break;
        case 2:
          for (int it = B; it < 1024 + 512 + 64 + 2048; it += G) {
            if (it < 1024) { for (int rep = 0; rep < NREP(4); ++rep) gdn1_item(p, l, it, smem); }
            else if (it < 1536) { for (int rep = 0; rep < NREP(5); ++rep) lru_item<false>(p, l, it - 1024, smem); }
            else if (it < 1600) { if (PHON(6)) kvc_item(p, l, it - 1536); }
            else if (PHON(6)) prep_item(p, l, it - 1600);
          }
          break;
        case 3: {
          int* ctr = (int*)(p->ws + WS_CTR) + l;
          for (;;) {
            __syncthreads();
            if (ltid() == 0) s_item = atomicAdd(ctr, 1);
            __syncthreads();
            const int it = s_item;
            if (it >= 16 + 256 + 256 + 256 + 512 + 512) break;
            if (it < 16) gdn2_item(p, l, it, smem);
            else if (it < 272) { for (int rep = 0; rep < NREP(8); ++rep) attn_item(p, l, it - 16, smem); }
            else if (it < 528) gdn2_item(p, l, it - 272 + 16, smem);
            else if (it < 784) { for (int rep = 0; rep < NREP(8); ++rep) attn_item(p, l, it - 528 + 256, smem); }
            else if (it < 1296) { for (int rep = 0; rep < NREP(9); ++rep) lru_item<true>(p, l, it - 784, smem); }
            else for (int rep = 0; rep < NREP(8); ++rep) attn_item(p, l, it - 1296 + 512, smem);
          }
        } break;
        case 4: for (int it = B; it < 1024; it += G) gdnfin_item(p, l, it, smem); break;
        case 5: for (int rep = 0; rep < NREP(11); ++rep) FOR_TILES(128, 8, 8, 8, merge_item(p, l, mt, nt, smem)); break;
        case 6: FOR_TILES(128, 8, 8, 8, wout_item(p, l, mt, nt, smem)); break;
        case 7: for (int it = B; it < 2048; it += G) norm_item<1>(p, l, it); break;
        case 8: FOR_TILES(128, 32, 8, 8, w1_item(p, mt, nt, smem)); break;
        case 9: FOR_TILES(128, 8, 8, 8, w2_item(p, l, mt, nt, smem)); break;
      }
    }
    if (ph + 1 < ph_hi) {
      if (ph == ph_lo) cg::this_grid().sync();
      else for (int rep = 0; rep < NREP(1); ++rep) xcd_barrier((unsigned*)(p->ws + WS_BAR), (volatile LAS unsigned*)&xb_words);
    }
  }
}

extern "C" void kernel_launch(void* const* d_in, const int* in_sizes, int n_in, void* d_out, int out_size, void* d_ws, size_t ws_size, hipStream_t stream) {
  static int grid_blocks = 0;
  if (!grid_blocks) {
    int dev = 0, cus = 0, per_cu = 0;
    (void)hipGetDevice(&dev);
    (void)hipDeviceGetAttribute(&cus, hipDeviceAttributeMultiprocessorCount, dev);
    if (hipFuncSetAttribute((const void*)mk, hipFuncAttributeMaxDynamicSharedMemorySize, DYN_LDS) != hipSuccess) fprintf(stderr, "kernel_launch: hipFuncSetAttribute failed\n");
    (void)hipOccupancyMaxActiveBlocksPerMultiprocessor(&per_cu, mk, 256, DYN_LDS);
    if (per_cu < 1) per_cu = 1;
    if (per_cu > 2) per_cu = 2;
    grid_blocks = cus * per_cu;
    if (ws_size < WS_END) fprintf(stderr, "kernel_launch: workspace too small: %zu < %zu\n", ws_size, (size_t)WS_END);
  }
  if (hipMemsetAsync((char*)d_ws + WS_CTR, 0, 256 + 3456 * 4 + 256, stream) != hipSuccess) fprintf(stderr, "kernel_launch: memset failed\n");
  Params p{};
  for (int i = 0; i < 37; ++i) p.in[i] = (const float*)d_in[i];
  p.out = (float*)d_out; p.ws = (unsigned char*)d_ws;
#if MULTI_LAUNCH
  for (int ph = 0; ph < NPHASE; ++ph) hipLaunchKernelGGL(mk, dim3(grid_blocks), dim3(256), DYN_LDS, stream, p, ph, ph + 1);
#else
  int lo = 0, hi = NPHASE;
  void* args[] = {&p, &lo, &hi};
  hipError_t e = hipLaunchCooperativeKernel((void*)mk, dim3(grid_blocks), dim3(256), args, DYN_LDS, stream);
  if (e != hipSuccess) fprintf(stderr, "cooperative launch failed: %s (grid %d)\n", hipGetErrorString(e), grid_blocks);
#endif
}
```

```cpp
#include <hip/hip_runtime.h>
#include <hip/hip_cooperative_groups.h>
#include <cstdio>
namespace cg = cooperative_groups;

#ifndef MULTI_LAUNCH
#define MULTI_LAUNCH 0
#endif
#ifndef PHM
#define PHM 0xFFFFFFFFu
#endif
#define PHON(b) ((PHM >> (b)) & 1u)
#ifndef DUPM
#define DUPM 0u
#endif
#define NREP(b) (1 + ((DUPM >> (b)) & 1u))

typedef unsigned short u16;
using bf16x8 = __attribute__((ext_vector_type(8))) short;
using f32x4 = __attribute__((ext_vector_type(4))) float;
using u32x4 = __attribute__((ext_vector_type(4))) unsigned;
#define DI __device__ __forceinline__
#define MFMA16(a, b, c) __builtin_amdgcn_mfma_f32_16x16x32_bf16((a), (b), (c), 0, 0, 0)

constexpr int NTOK = 16384;
constexpr int DM = 1024;
constexpr int LDI = 2592;
constexpr int C_AQ = 0, C_AK = 256, C_AV = 384, C_LX = 512, C_LG = 768, C_GQ = 1024, C_GK = 1280, C_GV = 1536, C_GZ = 1792,
              C_DQ = 2048, C_DK = 2304, C_DV = 2432, C_GA = 2560, C_GB = 2568;
constexpr int NIN_PAD = 2688;

constexpr size_t WS_MOD = 0;
constexpr size_t WS_CTR = WS_MOD + 2 * 3 * 6144 * 4;
constexpr size_t WS_BAR = WS_CTR + 256;
constexpr size_t WS_LRUC = WS_BAR + 3456 * 4 + 256;
constexpr size_t WS_KC = WS_LRUC + (size_t)512 * 2 * 2 * 256 * 4;
constexpr size_t WS_GVEC = WS_KC + (size_t)16 * 512 * 64 * 2;
constexpr size_t WS_LRUW = WS_GVEC + (size_t)1024 * 2 * 256 * 4;
constexpr size_t WS_VT = WS_LRUW + (size_t)256 * 64 * 16;
constexpr size_t WS_WIN = WS_VT + (size_t)8 * 64 * 4608 * 2;
constexpr size_t WS_WM = WS_WIN + (size_t)NIN_PAD * 1024 * 2;
constexpr size_t WS_WB = WS_WM + (size_t)4096 * 1024 * 2;
constexpr size_t WS_WO = WS_WB + (size_t)4 * 1024 * 256 * 2;
constexpr size_t WS_W1 = WS_WO + (size_t)1024 * 1024 * 2;
constexpr size_t WS_W2 = WS_W1 + (size_t)4096 * 1024 * 2;
constexpr size_t WS_H = WS_W2 + (size_t)1024 * 4096 * 2;
constexpr size_t WS_BIG = WS_H + (size_t)NTOK * 1024 * 2;
constexpr size_t WS_INPROJ = WS_BIG;
constexpr size_t WS_BRANCH = WS_INPROJ + (size_t)NTOK * LDI * 2;
constexpr size_t WS_QHAT = WS_BRANCH + (size_t)NTOK * 1024 * 2;
constexpr size_t WS_KT = WS_QHAT + (size_t)1024 * 4096 * 2;
constexpr size_t WS_UW = WS_KT + (size_t)1024 * 4096 * 2;
constexpr size_t WS_QK = WS_UW + (size_t)1024 * 2 * 8192 * 2;
constexpr size_t WS_END = WS_QK + (size_t)1024 * 2 * 4096 * 2;
constexpr size_t WS_HIDDEN = WS_BIG;
constexpr size_t WS_MERGED = WS_BIG;
static_assert(WS_HIDDEN + (size_t)NTOK * 4096 * 2 <= WS_END, "hidden must fit");
static_assert(WS_END <= (size_t)256 * 1024 * 1024, "workspace budget");

constexpr size_t O_X = 0, O_AK = 16777216, O_AV = 18874368, O_DK = 20971520, O_DV = 23068672, O_LRU = 25165824, O_GDN = 25198592;

struct Params {
  const float* in[37];
  float* out;
  unsigned char* ws;
};

typedef const Params __attribute__((address_space(4)))* KP;
constexpr int SMEM_BYTES = 65536;
constexpr int DYN_LDS = SMEM_BYTES + 64;

DI int ltid() { int t = threadIdx.x; asm volatile("" : "+v"(t)); return t; }
typedef __bf16 bf16v2 __attribute__((ext_vector_type(2)));
DI u16 f2bf(float x) { __bf16 h = (__bf16)x; return __builtin_bit_cast(u16, h); }
DI float bf2f(u16 h) { return __uint_as_float(((unsigned)h) << 16); }
DI unsigned pack2(float a, float b) { bf16v2 v = {(__bf16)a, (__bf16)b}; return __builtin_bit_cast(unsigned, v); }
DI float bflo(unsigned u) { return __uint_as_float(u << 16); }
DI float bfhi(unsigned u) { return __uint_as_float(u & 0xffff0000u); }
DI float sigm(float x) { return __builtin_amdgcn_rcpf(1.f + __expf(-x)); }
DI float siluf_(float x) { return x * __builtin_amdgcn_rcpf(1.f + __expf(-x)); }
DI float softplusf_(float x) { return x > 20.f ? x : __logf(1.f + __expf(x)); }
DI float gelu_tanh(float x) { float u = 0.7978845608028654f * (x + 0.044715f * x * x * x); float t = 1.f - 2.f * __builtin_amdgcn_rcpf(__expf(2.f * u) + 1.f); return 0.5f * x * (1.f + t); }
template <int CTRL> DI float dppf(float v) { return __int_as_float(__builtin_amdgcn_update_dpp(0, __float_as_int(v), CTRL, 0xF, 0xF, true)); }
DI float rlane(float v, int l) { return __int_as_float(__builtin_amdgcn_readlane(__float_as_int(v), l)); }
DI float wave_sum(float v) {
  v += dppf<0xB1>(v);
  v += dppf<0x4E>(v);
  v += dppf<0x141>(v);
  v += dppf<0x140>(v);
  return (rlane(v, 0) + rlane(v, 16)) + (rlane(v, 32) + rlane(v, 48));
}
DI u32x4 mku4(unsigned a, unsigned b, unsigned c, unsigned d) { u32x4 v = {a, b, c, d}; return v; }
DI bf16x8 mk8(unsigned a, unsigned b, unsigned c, unsigned d) { u32x4 v = {a, b, c, d}; return __builtin_bit_cast(bf16x8, v); }
DI bf16x8 pack8(const f32x4& x, const f32x4& y) { return mk8(pack2(x[0], x[1]), pack2(x[2], x[3]), pack2(y[0], y[1]), pack2(y[2], y[3])); }
DI bf16x8 ld8(const u16* p) { return *(const bf16x8*)p; }
DI bf16x8 ldperm(const u16* p) { uint2 a = *(const uint2*)p; uint2 b = *(const uint2*)(p + 16); return mk8(a.x, a.y, b.x, b.y); }
DI int mod_group(int row) { return row < 8192 ? 0 : 1 + ((row - 8192) >> 12); }
DI const float* x_in_row(KP p, int l, int row) {
  if (l == 0) return row < 8192 ? p->in[0] + (size_t)row * DM : p->in[1] + (size_t)(row - 8192) * DM;
  return p->out + (size_t)row * DM;
}
DI unsigned swap16(unsigned u) { return (u >> 16) | (u << 16); }
DI u32x4 rev8(u32x4 v) { return mku4(swap16(v.w), swap16(v.z), swap16(v.y), swap16(v.x)); }

DI void mod_item(KP p, int item, unsigned char* smem) {
  float* sc = (float*)smem;
  float* sr = sc + 3072;
  const int tid = ltid();
  const int l = item / 96, cb = item % 96;
  for (int i = tid; i < 3072; i += 256) {
    int g = i >> 10, k = i & 1023;
    float c = g == 0 ? p->in[9][k] : p->in[2][(g - 1) * 1024 + k];
    sc[i] = siluf_(c);
  }
  __syncthreads();
  const int col = cb * 64 + (tid & 63), kg = tid >> 6;
  const float* W = p->in[10] + (size_t)l * 1024 * 6144;
  float a0 = 0.f, a1 = 0.f, a2 = 0.f;
  for (int k = kg * 256; k < kg * 256 + 256; ++k) {
    float w = W[(size_t)k * 6144 + col];
    a0 += sc[k] * w; a1 += sc[1024 + k] * w; a2 += sc[2048 + k] * w;
  }
  sr[(kg * 3 + 0) * 64 + (tid & 63)] = a0; sr[(kg * 3 + 1) * 64 + (tid & 63)] = a1; sr[(kg * 3 + 2) * 64 + (tid & 63)] = a2;
  __syncthreads();
  if (tid < 192) {
    int g = tid >> 6, cc = tid & 63;
    float s = p->in[11][l * 6144 + cb * 64 + cc];
    for (int q = 0; q < 4; ++q) s += sr[(q * 3 + g) * 64 + cc];
    ((float*)(p->ws + WS_MOD))[(l * 3 + g) * 6144 + cb * 64 + cc] = s;
  }
  __syncthreads();
}

DI void conv_tile(const float* src, int N, int k0, int n0, u16* dst, int K, bool perm, unsigned char* smem) {
  float* tile = (float*)smem;
  const int tid = ltid();
#pragma unroll
  for (int i = 0; i < 4; ++i) {
    int kr = (tid >> 4) + 16 * i, nc = (tid & 15) * 4;
    float4 v = make_float4(0.f, 0.f, 0.f, 0.f);
    if (n0 + nc < N) v = *(const float4*)(src + (size_t)(k0 + kr) * N + n0 + nc);
    tile[kr * 65 + nc] = v.x; tile[kr * 65 + nc + 1] = v.y; tile[kr * 65 + nc + 2] = v.z; tile[kr * 65 + nc + 3] = v.w;
  }
  __syncthreads();
#pragma unroll
  for (int i = 0; i < 2; ++i) {
    int n = (tid >> 3) + 32 * i, k8 = (tid & 7) * 8;
    int ng = n0 + n;
    if (ng < N) {
      int row = ng;
      if (perm) row = ng < 2048 ? ng : (ng < 2064 ? 2560 + (ng - 2048) : ng - 16);
      u32x4 o;
      o.x = pack2(tile[(k8 + 0) * 65 + n], tile[(k8 + 1) * 65 + n]);
      o.y = pack2(tile[(k8 + 2) * 65 + n], tile[(k8 + 3) * 65 + n]);
      o.z = pack2(tile[(k8 + 4) * 65 + n], tile[(k8 + 5) * 65 + n]);
      o.w = pack2(tile[(k8 + 6) * 65 + n], tile[(k8 + 7) * 65 + n]);
      *(u32x4*)(dst + (size_t)row * K + k0 + k8) = o;
    }
  }
  __syncthreads();
}

constexpr int CONV_ITEMS = 4241;
DI void convert_item(KP p, int l, int item, unsigned char* smem) {
  unsigned char* ws = p->ws;
  if (item < 656) { int kt = item / 41, nt = item % 41; conv_tile(p->in[14] + (size_t)l * 1024 * 2576, 2576, kt * 64, nt * 64, (u16*)(ws + WS_WIN), 1024, true, smem); return; }
  item -= 656;
  if (item < 1024) { int kt = item >> 6, nt = item & 63; conv_tile(p->in[32] + (size_t)l * 1024 * 4096, 4096, kt * 64, nt * 64, (u16*)(ws + WS_WM), 1024, false, smem); return; }
  item -= 1024;
  if (item < 256) { int m = item >> 6, r = item & 63, kt = r >> 4, nt = r & 15;
    conv_tile(p->in[31] + ((size_t)l * 4 + m) * 256 * 1024, 1024, kt * 64, nt * 64, (u16*)(ws + WS_WB) + (size_t)m * 1024 * 256, 256, false, smem); return; }
  item -= 256;
  if (item < 256) { int kt = item >> 4, nt = item & 15; conv_tile(p->in[34] + (size_t)l * 1024 * 1024, 1024, kt * 64, nt * 64, (u16*)(ws + WS_WO), 1024, false, smem); return; }
  item -= 256;
  if (item < 1024) { int kt = item >> 6, nt = item & 63; conv_tile(p->in[35] + (size_t)l * 1024 * 4096, 4096, kt * 64, nt * 64, (u16*)(ws + WS_W1), 1024, false, smem); return; }
  item -= 1024;
  if (item < 1024) { int kt = item >> 4, nt = item & 15; conv_tile(p->in[36] + (size_t)l * 4096 * 1024, 1024, kt * 64, nt * 64, (u16*)(ws + WS_W2), 4096, false, smem); return; }
  u32x4* z = (u32x4*)((u16*)(ws + WS_WIN) + (size_t)2576 * 1024);
  for (int i = ltid(); i < 112 * 1024 / 8; i += 256) z[i] = mku4(0, 0, 0, 0);
}

DI void lruw_item(KP p, int item) {
  const int gid = item * 256 + ltid();
  const int lane = gid & 63, fg = gid >> 6;
  const int s2 = fg & 1, j = (fg >> 1) & 3, n = (fg >> 3) & 3, g = (fg >> 5) & 1, ld_ = fg >> 6;
  const int lq = lane & 15, quad = lane >> 4;
  const float* W = (g == 0 ? p->in[20] : p->in[22]) + ((size_t)(ld_ * 4 + n) * 64) * 64 + (size_t)(s2 * 32 + quad * 8) * 64 + j * 16 + lq;
  u32x4 o = {pack2(W[0], W[64]), pack2(W[128], W[192]), pack2(W[256], W[320]), pack2(W[384], W[448])};
  ((u32x4*)(p->ws + WS_LRUW))[gid] = o;
}

template <int which>
DI void norm_item(KP p, int l, int item) {
  const int tid = ltid(), lane = tid & 63, wave = tid >> 6;
  const float* g = p->in[which == 0 ? 12 : 13] + l * 1024;
  f32x4 v[2][4]; float ss[2] = {0.f, 0.f};
#pragma unroll
  for (int h = 0; h < 2; ++h) {
    const int row = item * 8 + wave * 2 + h;
    const float* x = x_in_row(p, which == 0 ? l : 2, row);
#pragma unroll
    for (int i = 0; i < 4; ++i) v[h][i] = *(const f32x4*)(x + i * 256 + lane * 4);
  }
#pragma unroll
  for (int h = 0; h < 2; ++h) {
#pragma unroll
    for (int i = 0; i < 4; ++i) ss[h] += v[h][i].x * v[h][i].x + v[h][i].y * v[h][i].y + v[h][i].z * v[h][i].z + v[h][i].w * v[h][i].w;
    ss[h] = wave_sum(ss[h]);
  }
#pragma unroll
  for (int h = 0; h < 2; ++h) {
    const int row = item * 8 + wave * 2 + h;
    const float* mod = (const float*)(p->ws + WS_MOD) + (l * 3 + mod_group(row)) * 6144;
    const float* sh = mod + (which == 0 ? 0 : 3072);
    const float* sc = mod + (which == 0 ? 1024 : 4096);
    const float rstd = rsqrtf(ss[h] * (1.f / 1024.f) + 1e-6f);
    u16* H = (u16*)(p->ws + WS_H) + (size_t)row * 1024;
#pragma unroll
    for (int i = 0; i < 4; ++i) {
      int c = i * 256 + lane * 4;
      float4 gg = *(const float4*)(g + c), s1 = *(const float4*)(sc + c), s0 = *(const float4*)(sh + c);
      float y0 = v[h][i].x * rstd * gg.x * (1.f + s1.x) + s0.x, y1 = v[h][i].y * rstd * gg.y * (1.f + s1.y) + s0.y;
      float y2 = v[h][i].z * rstd * gg.z * (1.f + s1.z) + s0.z, y3 = v[h][i].w * rstd * gg.w * (1.f + s1.w) + s0.w;
      *(uint2*)(H + c) = make_uint2(pack2(y0, y1), pack2(y2, y3));
    }
  }
}

DI int lds_byte(int r, int c) {
  int st = (r >> 4) * 2 + (c >> 5), ob = (r & 15) * 64 + (c & 31) * 2;
  return st * 1024 + (ob ^ (((ob >> 9) & 1) << 5));
}
DI void stage_rc(int b, int& R, int& C) {
  int st = b >> 10, sb = b & 1023, swz = sb ^ (((sb >> 9) & 1) << 5);
  R = (st >> 1) * 16 + (swz >> 6);
  C = (st & 1) * 32 + ((swz & 63) >> 1);
}
template <int MT, int NT, bool pre = false>
DI void gemm_acc(f32x4 (&acc)[MT][NT], const u16* __restrict__ A, int lda, const u16* __restrict__ Bt, int ldb, int K, unsigned char* smem,
                 const u16* nxtA = nullptr, int nlda = 0, const u16* nxtB = nullptr, int nldb = 0) {
  constexpr int TA = MT * 32 * 128, TB = NT * 32 * 128, STAGE = TA + TB;
  static_assert(2 * STAGE <= 65536, "LDS");
  const int tid = ltid(), lane = tid & 63, wid = tid >> 6, wm = wid >> 1, wn = wid & 1;
  const int fr = lane & 15, fq = lane >> 4;
  const u16* ga[MT]; const u16* gb[NT];
#pragma unroll
  for (int i = 0; i < MT; ++i) { int R, C; stage_rc(wid * 1024 + i * 4096 + lane * 16, R, C); ga[i] = A + (size_t)R * lda + C; }
#pragma unroll
  for (int i = 0; i < NT; ++i) { int R, C; stage_rc(wid * 1024 + i * 4096 + lane * 16, R, C); gb[i] = Bt + (size_t)R * ldb + C; }
#define GLDS_STAGE(buf, k0)                                                                                                        \
  do {                                                                                                                             \
    _Pragma("unroll") for (int i = 0; i < MT; ++i)                                                                                 \
      __builtin_amdgcn_global_load_lds((const unsigned*)(ga[i] + (k0)), (unsigned*)(smem + (buf) * STAGE + wid * 1024 + i * 4096), 16, 0, 0); \
    _Pragma("unroll") for (int i = 0; i < NT; ++i)                                                                                 \
      __builtin_amdgcn_global_load_lds((const unsigned*)(gb[i] + (k0)), (unsigned*)(smem + (buf) * STAGE + TA + wid * 1024 + i * 4096), 16, 0, 0); \
  } while (0)
  if (!pre) {
    __syncthreads();
    GLDS_STAGE(0, 0);
  }
  asm volatile("s_waitcnt vmcnt(0)" ::: "memory");
  __syncthreads();
  const int nt = K >> 6;
  for (int t = 0; t < nt; ++t) {
    const int cur = t & 1;
    if (t + 1 < nt) GLDS_STAGE(cur ^ 1, (t + 1) * 64);
    const unsigned char* sA = smem + cur * STAGE;
    const unsigned char* sB = sA + TA;
    if constexpr (!pre) {
      bf16x8 bfr[2][NT], af[2][MT];
#pragma unroll
      for (int s = 0; s < 2; ++s) {
#pragma unroll
        for (int j = 0; j < NT; ++j) bfr[s][j] = *(const bf16x8*)(sB + lds_byte(wn * NT * 16 + j * 16 + fr, s * 32 + fq * 8));
#pragma unroll
        for (int i = 0; i < MT; ++i) af[s][i] = *(const bf16x8*)(sA + lds_byte(wm * MT * 16 + i * 16 + fr, s * 32 + fq * 8));
      }
#pragma unroll
      for (int s = 0; s < 2; ++s)
#pragma unroll
        for (int i = 0; i < MT; ++i)
#pragma unroll
          for (int j = 0; j < NT; ++j) acc[i][j] = MFMA16(bfr[s][j], af[s][i], acc[i][j]);
      __builtin_amdgcn_sched_group_barrier(0x100, MT + NT, 0);
#pragma unroll
      for (int q = 0; q < MT + NT; ++q) { __builtin_amdgcn_sched_group_barrier(0x008, 2, 0); __builtin_amdgcn_sched_group_barrier(0x100, 1, 0); }
      __builtin_amdgcn_sched_group_barrier(0x008, 2 * MT * NT - 2 * (MT + NT), 0);
    } else {
#pragma unroll
      for (int s = 0; s < 2; ++s) {
        bf16x8 bfr[NT], af[MT];
#pragma unroll
        for (int j = 0; j < NT; ++j) bfr[j] = *(const bf16x8*)(sB + lds_byte(wn * NT * 16 + j * 16 + fr, s * 32 + fq * 8));
#pragma unroll
        for (int i = 0; i < MT; ++i) af[i] = *(const bf16x8*)(sA + lds_byte(wm * MT * 16 + i * 16 + fr, s * 32 + fq * 8));
#pragma unroll
        for (int i = 0; i < MT; ++i)
#pragma unroll
          for (int j = 0; j < NT; ++j) acc[i][j] = MFMA16(bfr[j], af[i], acc[i][j]);
      }
    }
    asm volatile("s_waitcnt vmcnt(0)" ::: "memory");
    __syncthreads();
  }
  if (nxtA) {
#pragma unroll
    for (int i = 0; i < MT; ++i) { int R, C; stage_rc(wid * 1024 + i * 4096 + lane * 16, R, C);
      __builtin_amdgcn_global_load_lds((const unsigned*)(nxtA + (unsigned)(R * nlda + C)), (unsigned*)(smem + wid * 1024 + i * 4096), 16, 0, 0); }
#pragma unroll
    for (int i = 0; i < NT; ++i) { int R, C; stage_rc(wid * 1024 + i * 4096 + lane * 16, R, C);
      __builtin_amdgcn_global_load_lds((const unsigned*)(nxtB + (unsigned)(R * nldb + C)), (unsigned*)(smem + TA + wid * 1024 + i * 4096), 16, 0, 0); }
  }
#undef GLDS_STAGE
}

template <int MT, int NT>
DI void gemm_prefetch(const u16* A, int lda, const u16* Bt, int ldb, unsigned char* smem) {
  constexpr int TA = MT * 32 * 128;
  const int tid = ltid(), lane = tid & 63, wid = tid >> 6;
  __syncthreads();
#pragma unroll
  for (int i = 0; i < MT; ++i) { int R, C; stage_rc(wid * 1024 + i * 4096 + lane * 16, R, C);
    __builtin_amdgcn_global_load_lds((const unsigned*)(A + (unsigned)(R * lda + C)), (unsigned*)(smem + wid * 1024 + i * 4096), 16, 0, 0); }
#pragma unroll
  for (int i = 0; i < NT; ++i) { int R, C; stage_rc(wid * 1024 + i * 4096 + lane * 16, R, C);
    __builtin_amdgcn_global_load_lds((const unsigned*)(Bt + (unsigned)(R * ldb + C)), (unsigned*)(smem + TA + wid * 1024 + i * 4096), 16, 0, 0); }
}

template <int MT, int NT> DI void zero_acc(f32x4 (&acc)[MT][NT]) {
#pragma unroll
  for (int i = 0; i < MT; ++i)
#pragma unroll
    for (int j = 0; j < NT; ++j) acc[i][j] = f32x4{0.f, 0.f, 0.f, 0.f};
}

#define EPI_LOOP(MT, NT)                                                          \
  const int tid_ = ltid(), lane_ = tid_ & 63, wave_ = tid_ >> 6;                   \
  const int wm_ = wave_ >> 1, wn_ = wave_ & 1, lq_ = lane_ & 15, quad_ = lane_ >> 4; \
  _Pragma("unroll") for (int i = 0; i < MT; ++i)                                   \
  _Pragma("unroll") for (int j = 0; j < NT; ++j)
#define EPI_ROW(m0, MT) ((m0) + wm_ * (MT) * 16 + i * 16 + lq_)
#define EPI_COL(n0, NT) ((n0) + wn_ * (NT) * 16 + j * 16 + quad_ * 4)

constexpr int GMT = 4;
DI void inproj_item(KP p, int mt, int nt, unsigned char* smem) {
  const int m0 = mt * (GMT * 32), n0 = nt * 128;
  f32x4 acc[GMT][4]; zero_acc<GMT, 4>(acc);
  gemm_acc<GMT, 4>(acc, (const u16*)(p->ws + WS_H) + (size_t)m0 * 1024, 1024, (const u16*)(p->ws + WS_WIN) + (size_t)n0 * 1024, 1024, 1024, smem);
  u16* C = (u16*)(p->ws + WS_INPROJ);
  EPI_LOOP(GMT, 4) { int row = EPI_ROW(m0, GMT), col = EPI_COL(n0, 4); if (col < LDI) *(uint2*)(C + (size_t)row * LDI + col) = make_uint2(pack2(acc[i][j][0], acc[i][j][1]), pack2(acc[i][j][2], acc[i][j][3])); }
}

DI void merge_item(KP p, int l, int mt, int nt, unsigned char* smem) {
  const int m0 = mt * 128, n0 = nt * 128;
  const u16* H = (const u16*)(p->ws + WS_H) + (size_t)m0 * 1024;
  const u16* BR = (const u16*)(p->ws + WS_BRANCH) + (size_t)m0 * 1024;
  const float* bm = p->in[33] + l * 4096;
  const u16* WM = (const u16*)(p->ws + WS_WM) + (size_t)n0 * 1024;
  const u16* WB = (const u16*)(p->ws + WS_WB) + (size_t)n0 * 256;
  unsigned am[4][4][2];
#pragma unroll
  for (int i = 0; i < 4; ++i)
#pragma unroll
    for (int j = 0; j < 4; ++j) { am[i][j][0] = 0u; am[i][j][1] = 0u; }
  gemm_prefetch<4, 4>(BR, 1024, WB, 256, smem);
#pragma unroll 1
  for (int m = 0; m < 4; ++m) {
    f32x4 acc[4][4]; zero_acc<4, 4>(acc);
    gemm_acc<4, 4, true>(acc, BR + m * 256, 1024, WB + (size_t)m * 1024 * 256, 256, 256, smem, H, 1024, WM + (size_t)m * 1024 * 1024, 1024);
    unsigned pp[4][4][2];
#pragma unroll
    for (int i = 0; i < 4; ++i)
#pragma unroll
      for (int j = 0; j < 4; ++j) { pp[i][j][0] = pack2(acc[i][j][0], acc[i][j][1]); pp[i][j][1] = pack2(acc[i][j][2], acc[i][j][3]); }
    zero_acc<4, 4>(acc);
    gemm_acc<4, 4, true>(acc, H, 1024, WM + (size_t)m * 1024 * 1024, 1024, 1024, smem,
                         m < 3 ? BR + (m + 1) * 256 : nullptr, 1024, WB + (size_t)(m + 1) * 1024 * 256, 256);
    {
      const int tid_ = ltid(), wn_ = (tid_ >> 6) & 1, quad_ = (tid_ & 63) >> 4;
      float4 bias4[4];
#pragma unroll
      for (int j = 0; j < 4; ++j) bias4[j] = *(const float4*)(bm + m * 1024 + n0 + wn_ * 64 + j * 16 + quad_ * 4);
#pragma unroll
      for (int i = 0; i < 4; ++i) {
#pragma unroll
        for (int j = 0; j < 4; ++j) {
          float v0 = bflo(am[i][j][0]) + sigm(acc[i][j][0] + bias4[j].x) * bflo(pp[i][j][0]);
          float v1 = bfhi(am[i][j][0]) + sigm(acc[i][j][1] + bias4[j].y) * bfhi(pp[i][j][0]);
          float v2 = bflo(am[i][j][1]) + sigm(acc[i][j][2] + bias4[j].z) * bflo(pp[i][j][1]);
          float v3 = bfhi(am[i][j][1]) + sigm(acc[i][j][3] + bias4[j].w) * bfhi(pp[i][j][1]);
          am[i][j][0] = pack2(v0, v1); am[i][j][1] = pack2(v2, v3);
          asm volatile("" : "+v"(am[i][j][0]), "+v"(am[i][j][1]));
          __builtin_amdgcn_sched_barrier(0);
        }
      }
    }
  }
  u16* C = (u16*)(p->ws + WS_MERGED);
  EPI_LOOP(4, 4) { int row = EPI_ROW(m0, 4), col = EPI_COL(n0, 4); *(uint2*)(C + (size_t)row * 1024 + col) = make_uint2(am[i][j][0], am[i][j][1]); }
}

DI void wout_item(KP p, int l, int mt, int nt, unsigned char* smem) {
  const int m0 = mt * (GMT * 32), n0 = nt * 128;
  f32x4 acc[GMT][4]; zero_acc<GMT, 4>(acc);
  gemm_acc<GMT, 4>(acc, (const u16*)(p->ws + WS_MERGED) + (size_t)m0 * 1024, 1024, (const u16*)(p->ws + WS_WO) + (size_t)n0 * 1024, 1024, 1024, smem);
  const float* g1 = (const float*)(p->ws + WS_MOD) + (l * 3 + mod_group(m0)) * 6144 + 2048;
  EPI_LOOP(GMT, 4) { int row = EPI_ROW(m0, GMT), col = EPI_COL(n0, 4); const float4 xv = *(const float4*)(x_in_row(p, l, row) + col), gv = *(const float4*)(g1 + col);
    *(float4*)(p->out + (size_t)row * DM + col) = make_float4(xv.x + gv.x * acc[i][j][0], xv.y + gv.y * acc[i][j][1], xv.z + gv.z * acc[i][j][2], xv.w + gv.w * acc[i][j][3]); }
}

DI void w1_item(KP p, int mt, int nt, unsigned char* smem) {
  const int m0 = mt * (GMT * 32), n0 = nt * 128;
  f32x4 acc[GMT][4]; zero_acc<GMT, 4>(acc);
  gemm_acc<GMT, 4>(acc, (const u16*)(p->ws + WS_H) + (size_t)m0 * 1024, 1024, (const u16*)(p->ws + WS_W1) + (size_t)n0 * 1024, 1024, 1024, smem);
  u16* C = (u16*)(p->ws + WS_HIDDEN);
  EPI_LOOP(GMT, 4) { int row = EPI_ROW(m0, GMT), col = EPI_COL(n0, 4); const float v0 = fmaxf(acc[i][j][0], 0.f), v1 = fmaxf(acc[i][j][1], 0.f), v2 = fmaxf(acc[i][j][2], 0.f), v3 = fmaxf(acc[i][j][3], 0.f);
    *(uint2*)(C + (size_t)row * 4096 + col) = make_uint2(pack2(v0 * v0, v1 * v1), pack2(v2 * v2, v3 * v3)); }
}

DI void w2_item(KP p, int l, int mt, int nt, unsigned char* smem) {
  const int m0 = mt * (GMT * 32), n0 = nt * 128;
  f32x4 acc[GMT][4]; zero_acc<GMT, 4>(acc);
  gemm_acc<GMT, 4>(acc, (const u16*)(p->ws + WS_HIDDEN) + (size_t)m0 * 4096, 4096, (const u16*)(p->ws + WS_W2) + (size_t)n0 * 4096, 4096, 4096, smem);
  const float* g2 = (const float*)(p->ws + WS_MOD) + (l * 3 + mod_group(m0)) * 6144 + 5120;
  EPI_LOOP(GMT, 4) { int row = EPI_ROW(m0, GMT), col = EPI_COL(n0, 4); float4* o = (float4*)(p->out + (size_t)row * DM + col); const float4 xv = *o, gv = *(const float4*)(g2 + col);
    *o = make_float4(xv.x + gv.x * acc[i][j][0], xv.y + gv.y * acc[i][j][1], xv.z + gv.z * acc[i][j][2], xv.w + gv.w * acc[i][j][3]); }
}

DI void prep_load(const u16* R, int lane, float (&hv)[12], float (&vv4)[4]) {
#pragma unroll
  for (int hh = 0; hh < 12; ++hh) {
    const int col = hh < 4 ? C_AQ + hh * 64 : (hh < 6 ? C_AK + (hh - 4) * 64 : (hh < 10 ? C_DQ + (hh - 6) * 64 : C_DK + (hh - 10) * 64));
    hv[hh] = bf2f(R[col + lane]);
  }
  vv4[0] = bf2f(R[C_AV + lane]); vv4[1] = bf2f(R[C_AV + 64 + lane]); vv4[2] = bf2f(R[C_DV + lane]); vv4[3] = bf2f(R[C_DV + 64 + lane]);
}
DI void prep_token(KP p, int l, int row, int lane, u16* R, const float (&hv)[12], const float (&vv4)[4]) {
  const bool lat = row >= 8192;
  float cs = 1.f, sn = 0.f;
  if (lat) {
    int t = (row - 8192) & 4095;
    int pos = (lane < 32) ? (t >> 6) : (t & 63);
    float inv = __expf(-(float)(lane & 15) * (9.210340371976184f / 16.f));
    float ang = (float)pos * inv;
    cs = __cosf(ang); sn = __sinf(ang);
  }
  const int b = row >> 8, t = row & 255;
#pragma unroll
  for (int hh = 0; hh < 12; ++hh) {
    int col; const float* g;
    if (hh < 4) { col = C_AQ + hh * 64; g = p->in[15] + l * 64; }
    else if (hh < 6) { col = C_AK + (hh - 4) * 64; g = p->in[16] + l * 64; }
    else if (hh < 10) { col = C_DQ + (hh - 6) * 64; g = p->in[29] + l * 64; }
    else { col = C_DK + (hh - 10) * 64; g = p->in[30] + l * 64; }
    float v = hv[hh];
    float ss = wave_sum(v * v);
    float y = v * rsqrtf(ss * (1.f / 64.f) + 1e-6f) * g[lane];
    if (lat) {
      float yp = __shfl_xor(y, 16, 64);
      y = ((lane & 31) < 16) ? (y * cs - yp * sn) : (y * cs + yp * sn);
    } else {
      if (hh == 4 || hh == 5) p->out[O_AK + ((size_t)(b * 2 + l) * 256 + t) * 128 + (hh - 4) * 64 + lane] = y;
      if (hh >= 10) p->out[O_DK + ((size_t)(b * 2 + l) * 256 + t) * 128 + (hh - 10) * 64 + lane] = y;
    }
    R[col + lane] = f2bf(y);
  }
  if (lat) {
    const int bl = (row - 8192) >> 12, tl = (row - 8192) & 4095;
    u16* VT = (u16*)(p->ws + WS_VT) + (size_t)lane * 4608 + 512 + tl;
#pragma unroll
    for (int q = 0; q < 4; ++q)
      VT[(size_t)(((q >> 1) * 2 + bl) * 2 + (q & 1)) * 64 * 4608] = f2bf(vv4[q]);
  }
  if (!lat) {
    size_t o = ((size_t)(b * 2 + l) * 256 + t) * 128;
    p->out[O_AV + o + lane] = vv4[0]; p->out[O_AV + o + 64 + lane] = vv4[1];
    p->out[O_DV + o + lane] = vv4[2]; p->out[O_DV + o + 64 + lane] = vv4[3];
  }
}
DI void prep_item(KP p, int l, int item) {
  const int tid = ltid(), lane = tid & 63, wave = tid >> 6;
  const int row0 = item * 8 + wave * 2;
  u16* R0 = (u16*)(p->ws + WS_INPROJ) + (size_t)row0 * LDI;
  u16* R1 = R0 + LDI;
  float hv0[12], vv0[4], hv1[12], vv1[4];
  prep_load(R0, lane, hv0, vv0); prep_load(R1, lane, hv1, vv1);
  prep_token(p, l, row0, lane, R0, hv0, vv0);
  prep_token(p, l, row0 + 1, lane, R1, hv1, vv1);
}

DI void kvc_item(KP p, int l, int item) {
  u16* KC = (u16*)(p->ws + WS_KC);
#pragma unroll
  for (int it = 0; it < 8; ++it) {
    int idx4 = item * 2048 + it * 256 + ltid();
    int e = idx4 * 4;
    int d = e & 63, key = (e >> 6) & 511, sel = e >> 15;
    int kv = sel & 1, kvh = (sel >> 1) & 1, b = (sel >> 2) & 1, mixer = sel >> 3;
    const float* srcb = mixer ? (kv ? p->in[6] : p->in[5]) : (kv ? p->in[4] : p->in[3]);
    const float* src = srcb + ((size_t)((b * 2 + l) * 512 + key) * 2 + kvh) * 64 + d;
    float4 v = *(const float4*)src;
    *(uint2*)(KC + e) = make_uint2(pack2(v.x, v.y), pack2(v.z, v.w));
    if (kv) {
      u16* VT = (u16*)(p->ws + WS_VT) + ((size_t)((mixer * 2 + b) * 2 + kvh) * 64 + d) * 4608 + key;
      VT[0] = f2bf(v.x); VT[4608] = f2bf(v.y); VT[2 * 4608] = f2bf(v.z); VT[3 * 4608] = f2bf(v.w);
    }
  }
}

DI void attn_item(KP p, int l, int it, unsigned char* smem) {
  u16* sK = (u16*)smem;
  u16* sVt = sK + 64 * 72;
  const int tid = ltid(), lane = tid & 63, wave = tid >> 6, lq = lane & 15, quad = lane >> 4;
  int kind, b, qh, qb;
  if (it < 512) { kind = it >> 8; int r = it & 255; b = r >> 7; qh = (r >> 5) & 3; qb = r & 31; }
  else { int r = it - 512; kind = 2 + (r >> 8); r &= 255; b = r >> 3; qh = (r >> 1) & 3; qb = r & 1; }
  const bool isD = (kind == 0 || kind == 3), lat = kind < 2;
  const int seqrow0 = lat ? 8192 + b * 4096 : b * 256;
  const int q0 = qb * 128, kvh = qh >> 1;
  const int qcol = (isD ? C_DQ : C_AQ) + qh * 64, kcol = (isD ? C_DK : C_AK) + kvh * 64, vcol = (isD ? C_DV : C_AV) + kvh * 64;
  const int ocol = (isD ? 768 : 0) + qh * 64;
  const int ncache = lat ? 8 : 0;
  int kt_lo = 0, kt_hi = lat ? 64 : 4;
  if (kind == 1) { kt_lo = max(0, 2 * qb - 2); kt_hi = min(64, 2 * qb + 4); }
  const int ntiles = ncache + kt_hi - kt_lo;
  const bool band = (kind == 1);
  const u16* INP = (const u16*)(p->ws + WS_INPROJ);
  const u16* KCk = (const u16*)(p->ws + WS_KC) + (size_t)((((isD ? 1 : 0) * 2 + b) * 2 + kvh) * 2) * 512 * 64;
  const u16* KCv = KCk + 512 * 64;
  constexpr float SC2 = 0.125f * 1.4426950408889634f;
  const float sinkv = isD ? -1e30f : p->in[17][l * 4 + qh] * 1.4426950408889634f;

  bf16x8 qf[2][2];
#pragma unroll
  for (int nt = 0; nt < 2; ++nt)
#pragma unroll
    for (int s = 0; s < 2; ++s) qf[nt][s] = ld8(INP + (size_t)(seqrow0 + q0 + wave * 32 + nt * 16 + lq) * LDI + qcol + s * 32 + quad * 8);
  float mrun[2], lsum[2];
  f32x4 oacc[4][2];
#pragma unroll
  for (int nt = 0; nt < 2; ++nt) { mrun[nt] = sinkv; lsum[nt] = (!isD && quad == 0) ? 1.f : 0.f; }
#pragma unroll
  for (int dt = 0; dt < 4; ++dt)
#pragma unroll
    for (int nt = 0; nt < 2; ++nt) oacc[dt][nt] = f32x4{0.f, 0.f, 0.f, 0.f};

  const int key = tid >> 2, seg = (tid & 3) * 16;
  struct KVReg { u32x4 k[2], v[2]; };
  KVReg R0, R1;
  const u16* VTp = (const u16*)(p->ws + WS_VT) + ((size_t)(((isD ? 1 : 0) * 2 + b) * 2 + kvh) * 64 + key) * 4608 + seg;
  auto tile_ptrs = [&](int t, const u16*& kp, const u16*& vp) {
    if (t < ncache) { kp = KCk + (size_t)(t * 64 + key) * 64 + seg; vp = VTp + t * 64; }
    else {
      const u16* rowp = INP + (size_t)(seqrow0 + (kt_lo + t - ncache) * 64 + key) * LDI; kp = rowp + kcol + seg;
      vp = lat ? VTp + 512 + (kt_lo + t - ncache) * 64 : rowp + vcol + seg;
    }
  };
  auto kvload = [&](int t, KVReg& R) {
    const u16 *kp, *vp; tile_ptrs(t, kp, vp);
    R.k[0] = *(const u32x4*)kp; R.k[1] = *(const u32x4*)(kp + 8); R.v[0] = *(const u32x4*)vp; R.v[1] = *(const u32x4*)(vp + 8);
  };
  kvload(0, R0);
  if (ntiles > 1) kvload(1, R1);
  auto step = [&](int t, KVReg& R) {
    __syncthreads();
    *(u32x4*)(sK + key * 72 + seg) = R.k[0]; *(u32x4*)(sK + key * 72 + seg + 8) = R.k[1];
    if (lat) {
      *(u32x4*)(sVt + key * 72 + seg) = R.v[0]; *(u32x4*)(sVt + key * 72 + seg + 8) = R.v[1];
    } else {
      unsigned vv[8] = {R.v[0].x, R.v[0].y, R.v[0].z, R.v[0].w, R.v[1].x, R.v[1].y, R.v[1].z, R.v[1].w};
#pragma unroll
      for (int e = 0; e < 8; ++e) { sVt[(seg + 2 * e) * 72 + key] = (u16)(vv[e] & 0xffffu); sVt[(seg + 2 * e + 1) * 72 + key] = (u16)(vv[e] >> 16); }
    }
    __syncthreads();
    if (t + 2 < ntiles) kvload(t + 2, R);
    f32x4 sacc[4][2];
#pragma unroll
    for (int mt = 0; mt < 4; ++mt) {
      sacc[mt][0] = f32x4{0.f, 0.f, 0.f, 0.f}; sacc[mt][1] = f32x4{0.f, 0.f, 0.f, 0.f};
#pragma unroll
      for (int s = 0; s < 2; ++s) {
        bf16x8 ka = ld8(sK + (mt * 16 + lq) * 72 + s * 32 + quad * 8);
        sacc[mt][0] = MFMA16(ka, qf[0][s], sacc[mt][0]);
        sacc[mt][1] = MFMA16(ka, qf[1][s], sacc[mt][1]);
      }
    }
    const bool masked_tile = band && t >= ncache;
    const int kbase = (kt_lo + t - ncache) * 64;
    bf16x8 pf[2][2];
#pragma unroll
    for (int nt = 0; nt < 2; ++nt) {
      const int qi = q0 + wave * 32 + nt * 16 + lq;
      float tmax = -1e30f;
#pragma unroll
      for (int mt = 0; mt < 4; ++mt)
#pragma unroll
        for (int r = 0; r < 4; ++r) {
          float sv_ = sacc[mt][nt][r] * SC2;
          if (masked_tile) { int kj = kbase + mt * 16 + quad * 4 + r; int dlt = qi - kj; if (dlt > 128 || dlt < -128) sv_ = -1e30f; }
          sacc[mt][nt][r] = sv_; tmax = fmaxf(tmax, sv_);
        }
      tmax = fmaxf(tmax, __shfl_xor(tmax, 16, 64)); tmax = fmaxf(tmax, __shfl_xor(tmax, 32, 64));
      const float mold = mrun[nt];
      const float mnew = fmaxf(mold, tmax);
      float ps = 0.f;
#pragma unroll
      for (int mt = 0; mt < 4; ++mt)
#pragma unroll
        for (int r = 0; r < 4; ++r) { float e = __builtin_amdgcn_exp2f(sacc[mt][nt][r] - mnew); sacc[mt][nt][r] = e; ps += e; }
      if (__any(mnew != mold)) {
        const float alpha = __builtin_amdgcn_exp2f(mold - mnew);
        lsum[nt] *= alpha;
#pragma unroll
        for (int dt = 0; dt < 4; ++dt)
#pragma unroll
          for (int r = 0; r < 4; ++r) oacc[dt][nt][r] *= alpha;
      }
      lsum[nt] += ps; mrun[nt] = mnew;
      pf[nt][0] = pack8(sacc[0][nt], sacc[1][nt]);
      pf[nt][1] = pack8(sacc[2][nt], sacc[3][nt]);
    }
#pragma unroll
    for (int dt = 0; dt < 4; ++dt)
#pragma unroll
      for (int s2 = 0; s2 < 2; ++s2) {
        bf16x8 va = ldperm(sVt + (dt * 16 + lq) * 72 + s2 * 32 + quad * 4);
        oacc[dt][0] = MFMA16(va, pf[0][s2], oacc[dt][0]);
        oacc[dt][1] = MFMA16(va, pf[1][s2], oacc[dt][1]);
      }
  };
  for (int t = 0; t < ntiles; t += 2) { step(t, R0); if (t + 1 < ntiles) step(t + 1, R1); }
  u16* BR = (u16*)(p->ws + WS_BRANCH);
#pragma unroll
  for (int nt = 0; nt < 2; ++nt) {
    float lt = lsum[nt]; lt += __shfl_xor(lt, 16, 64); lt += __shfl_xor(lt, 32, 64);
    const float inv = __builtin_amdgcn_rcpf(lt);
    const size_t row = seqrow0 + q0 + wave * 32 + nt * 16 + lq;
#pragma unroll
    for (int dt = 0; dt < 4; ++dt)
      *(uint2*)(BR + row * 1024 + ocol + dt * 16 + quad * 4) = make_uint2(pack2(oacc[dt][nt][0] * inv, oacc[dt][nt][1] * inv), pack2(oacc[dt][nt][2] * inv, oacc[dt][nt][3] * inv));
  }
  __syncthreads();
}

DI int lru_xoff(int t, int c) { return t * 256 + (c ^ ((t & 7) << 3)); }
template <bool FINAL>
DI void lru_item(KP p, int l, int ci, unsigned char* smem) {
  u16* sxb = (u16*)smem;
  u16* sla = sxb + 32 * 256;
  u16* sbv = sla + 32 * 256;
  u16* shf = sbv + 32 * 256;
  const int tid = ltid(), ch = tid, lane = tid & 63, n = tid >> 6, lq = lane & 15, quad = lane >> 4;
  const int r0 = ci * 32;
  const bool lat = r0 >= 8192;
  int b, T, seqrow0;
  if (!lat) { b = r0 >> 8; T = 256; seqrow0 = b * 256; } else { b = (r0 - 8192) >> 12; T = 4096; seqrow0 = 8192 + b * 4096; }
  const int t0 = r0 - seqrow0;
  const u16* INP = (const u16*)(p->ws + WS_INPROJ);
  __syncthreads();
  {
    const float* cw = p->in[18] + l * 4 * 256;
    const float w0 = cw[ch], w1 = cw[256 + ch], w2 = cw[512 + ch], w3 = cw[768 + ch], cb = p->in[19][l * 256 + ch];
    auto ld = [&](int t) -> float { return (t >= 0 && t < T) ? bf2f(INP[(size_t)(seqrow0 + t) * LDI + C_LX + ch]) : 0.f; };
    float xin[35];
#pragma unroll
    for (int q = 0; q < 35; ++q) xin[q] = ld(t0 - 2 + q);
#pragma unroll
    for (int t = 0; t < 32; ++t) sxb[lru_xoff(t, ch)] = f2bf(xin[t] * w0 + xin[t + 1] * w1 + xin[t + 2] * w2 + xin[t + 3] * w3 + cb);
  }
  __syncthreads();
  const int nch = T / 32, c = t0 / 32;
  float* LC = (float*)(p->ws + WS_LRUC);
  bf16x8 af[2][2];
#pragma unroll
  for (int mt = 0; mt < 2; ++mt)
#pragma unroll
    for (int s2 = 0; s2 < 2; ++s2) af[mt][s2] = ld8(sxb + lru_xoff(mt * 16 + lq, n * 64 + s2 * 32 + quad * 8));
  for (int dir = 0; dir < 2; ++dir) {
    bf16x8 wf[2][4][2];
    {
      const u32x4* WF = (const u32x4*)(p->ws + WS_LRUW);
#pragma unroll
      for (int g = 0; g < 2; ++g)
#pragma unroll
        for (int j = 0; j < 4; ++j)
#pragma unroll
          for (int s2 = 0; s2 < 2; ++s2)
            wf[g][j][s2] = __builtin_bit_cast(bf16x8, WF[(size_t)((((((l * 2 + dir) * 2 + g) * 4 + n) * 4 + j) * 2 + s2)) * 64 + lane]);
    }
#pragma unroll
    for (int j = 0; j < 4; ++j) {
      f32x4 acc[2][2];
#pragma unroll
      for (int g = 0; g < 2; ++g) {
        f32x4 a0 = {0.f, 0.f, 0.f, 0.f}, a1 = {0.f, 0.f, 0.f, 0.f};
#pragma unroll
        for (int s2 = 0; s2 < 2; ++s2) { a0 = MFMA16(af[0][s2], wf[g][j][s2], a0); a1 = MFMA16(af[1][s2], wf[g][j][s2], a1); }
        acc[g][0] = a0; acc[g][1] = a1;
      }
      const int cc = n * 64 + j * 16 + lq;
      const float br = p->in[21][(l * 2 + dir) * 256 + cc], bi = p->in[23][(l * 2 + dir) * 256 + cc];
      const float sp = softplusf_(-p->in[24][(l * 2 + dir) * 256 + cc]);
#pragma unroll
      for (int mt = 0; mt < 2; ++mt)
#pragma unroll
        for (int r = 0; r < 4; ++r) {
          const int t = mt * 16 + quad * 4 + r;
          const float la = -8.f * sigm(acc[0][mt][r] + br) * sp;
          const float xt = bf2f(sxb[lru_xoff(t, cc)]);
          const float bb = __builtin_amdgcn_sqrtf(1.f - __expf(2.f * la)) * sigm(acc[1][mt][r] + bi) * xt;
          sla[t * 256 + cc] = f2bf(la); sbv[t * 256 + cc] = f2bf(bb);
        }
    }
    __syncthreads();
    float h = 0.f, lasum = 0.f;
    if (FINAL) {
      h = lat ? p->in[7][((b * 2 + l) * 2 + dir) * 256 + ch] : 0.f;
      const int ncar = dir == 0 ? c : nch - 1 - c;
      const int cstart = dir == 0 ? ci - c : ci - c + nch - 1, cstep = dir == 0 ? 1 : -1;
      for (int q0 = 0; q0 < ncar; q0 += 16) {
        float ca[16], chh[16];
#pragma unroll
        for (int q = 0; q < 16; ++q) {
          const int qq = q0 + q < ncar ? q0 + q : ncar - 1;
          const float* C = LC + ((size_t)((cstart + cstep * qq) * 2 + dir) * 2) * 256;
          ca[q] = C[ch]; chh[q] = C[256 + ch];
        }
#pragma unroll
        for (int q = 0; q < 16; ++q) if (q0 + q < ncar) h = ca[q] * h + chh[q];
      }
    }
#pragma unroll 1
    for (int s8 = 0; s8 < 32; s8 += 16) {
      float gv[16];
      if (FINAL && dir == 1) {
#pragma unroll
        for (int q = 0; q < 16; ++q) gv[q] = bf2f(INP[(size_t)(r0 + 31 - s8 - q) * LDI + C_LG + ch]);
      }
#pragma unroll
      for (int q = 0; q < 16; ++q) {
        const int st = s8 + q;
        const int t = dir == 0 ? st : 31 - st;
        const float la = bf2f(sla[t * 256 + ch]);
        h = __expf(la) * h + bf2f(sbv[t * 256 + ch]);
        lasum += la;
        if (FINAL) {
          if (dir == 0) shf[t * 256 + ch] = f2bf(h);
          else ((u16*)(p->ws + WS_BRANCH))[(size_t)(r0 + t) * 1024 + 256 + ch] = f2bf((bf2f(shf[t * 256 + ch]) + h) * gelu_tanh(gv[q]));
        }
      }
    }
    if (!FINAL) { float* C = LC + ((size_t)(ci * 2 + dir) * 2) * 256; C[ch] = __expf(lasum); C[256 + ch] = h; }
    else if (!lat) {
      if (dir == 0 && c == nch - 1) p->out[O_LRU + ((size_t)(b * 2 + l) * 2 + 0) * 256 + ch] = h;
      if (dir == 1 && c == 0) p->out[O_LRU + ((size_t)(b * 2 + l) * 2 + 1) * 256 + ch] = h;
    }
    __syncthreads();
  }
}

template <int DIR, bool ISW>
DI void gdn_solve(const float* L, const u16* src, const float* sb_, const float* se_, u16* UW) {
  float sol[64];
#pragma unroll
  for (int i = 0; i < 64; ++i) {
    float s = bf2f(src[(DIR == 0 ? i : 63 - i) * 72]) * sb_[i];
    if (ISW) s *= se_[i];
    float s0 = 0.f, s1 = 0.f, s2 = 0.f, s3 = 0.f;
#pragma unroll
    for (int j4 = 0; j4 < (i + 3) / 4; ++j4) {
      float4 lv = *(const float4*)(L + i * 64 + j4 * 4);
      if (j4 * 4 + 0 < i) s0 += lv.x * sol[j4 * 4 + 0];
      if (j4 * 4 + 1 < i) s1 += lv.y * sol[j4 * 4 + 1];
      if (j4 * 4 + 2 < i) s2 += lv.z * sol[j4 * 4 + 2];
      if (j4 * 4 + 3 < i) s3 += lv.w * sol[j4 * 4 + 3];
      if ((j4 & 3) == 3) asm volatile("" ::: "memory");
    }
    s -= (s0 + s1) + (s2 + s3);
    sol[i] = s;
    UW[i * 128] = f2bf(s);
    asm volatile("" ::: "memory");
  }
}

DI void gdn1_item(KP p, int l, int item, unsigned char* smem) {
  const int cgi = item >> 2, hd = item & 3;
  u16* sq = (u16*)smem; u16* sk = sq + 64 * 72; u16* sv = sk + 64 * 72;
  float* sL = (float*)(smem + 27648);
  float* sgc = (float*)(smem + 60416);
  float* sbeta = sgc + 128;
  float* sge = sbeta + 128;
  const int tid = ltid(), lane = tid & 63, wave = tid >> 6, lq = lane & 15, quad = lane >> 4;
  const int r0 = cgi * 64;
  const bool lat = r0 >= 8192;
  int T, seqrow0;
  if (!lat) { T = 256; seqrow0 = (r0 >> 8) * 256; } else { T = 4096; seqrow0 = 8192 + ((r0 - 8192) >> 12) * 4096; }
  const int t0 = r0 - seqrow0;
  const u16* INP = (const u16*)(p->ws + WS_INPROJ);
  u16* QHAT = (u16*)(p->ws + WS_QHAT) + (size_t)item * 4096;
  {
    const int d = lane, tb = wave * 16;
#pragma unroll
    for (int mat = 0; mat < 3; ++mat) {
      const int col = C_GQ + mat * 256 + hd * 64 + d, wc = mat * 256 + hd * 64 + d;
      const float* cw = p->in[25] + (size_t)l * 4 * 768;
      const float w0 = cw[wc], w1 = cw[768 + wc], w2 = cw[1536 + wc], w3 = cw[2304 + wc];
      auto ld = [&](int t) -> float { return (t >= 0 && t < T) ? bf2f(INP[(size_t)(seqrow0 + t) * LDI + col]) : 0.f; };
      float xin[19];
#pragma unroll
      for (int q = 0; q < 19; ++q) xin[q] = ld(t0 + tb - 2 + q);
      u16* dst = mat == 0 ? sq : (mat == 1 ? sk : sv);
#pragma unroll
      for (int tt = 0; tt < 16; ++tt) {
        const int t = tb + tt;
        float v = siluf_(xin[tt] * w0 + xin[tt + 1] * w1 + xin[tt + 2] * w2 + xin[tt + 3] * w3);
        if (mat < 2) { float ss = wave_sum(v * v); v *= rsqrtf(ss + 1e-6f) * (mat == 0 ? 0.125f : 1.f); }
        u16 hb = f2bf(v);
        dst[t * 72 + d] = hb;
        if (mat == 0) QHAT[t * 64 + d] = hb;
      }
    }
  }
  if (tid < 128) {
    const int dir = tid >> 6, c = tid & 63;
    const int tok = dir == 0 ? c : 63 - c;
    const u16* R = INP + (size_t)(r0 + tok) * LDI;
    const float ga = bf2f(R[C_GA + dir * 4 + hd]), gb = bf2f(R[C_GB + dir * 4 + hd]);
    const float g = -__expf(p->in[26][(l * 2 + dir) * 4 + hd]) * softplusf_(ga + p->in[27][(l * 2 + dir) * 4 + hd]);
    float gc = g;
#pragma unroll
    for (int o = 1; o < 64; o <<= 1) { float tt = __shfl_up(gc, o, 64); if (lane >= o) gc += tt; }
    const float glast = __shfl(gc, 63, 64);
    sgc[dir * 64 + c] = gc; sbeta[dir * 64 + c] = sigm(gb); sge[dir * 64 + c] = __expf(gc);
    float* gv = (float*)(p->ws + WS_GVEC) + (size_t)(item * 2 + dir) * 256;
    gv[c] = __expf(gc); gv[64 + c] = __expf(glast - gc); if (c == 0) gv[128] = __expf(glast);
  }
  __syncthreads();
  {
    const int dk = tid >> 2, c0 = (tid & 3) * 16;
    unsigned w[8];
#pragma unroll
    for (int e = 0; e < 8; ++e) w[e] = (unsigned)sk[(c0 + 2 * e) * 72 + dk] | ((unsigned)sk[(c0 + 2 * e + 1) * 72 + dk] << 16);
    u16* KT = (u16*)(p->ws + WS_KT) + (size_t)item * 4096 + dk * 64 + c0;
    *(u32x4*)KT = mku4(w[0], w[1], w[2], w[3]); *(u32x4*)(KT + 8) = mku4(w[4], w[5], w[6], w[7]);
  }
  {
    const int i0 = wave * 16;
    f32x4 akk[4], aqk[4];
#pragma unroll
    for (int nt = 0; nt < 4; ++nt) { akk[nt] = f32x4{0.f, 0.f, 0.f, 0.f}; aqk[nt] = f32x4{0.f, 0.f, 0.f, 0.f}; }
#pragma unroll
    for (int s = 0; s < 2; ++s) {
      bf16x8 ak = ld8(sk + (i0 + lq) * 72 + s * 32 + quad * 8), aq = ld8(sq + (i0 + lq) * 72 + s * 32 + quad * 8);
#pragma unroll
      for (int nt = 0; nt < 4; ++nt) { bf16x8 bk = ld8(sk + (nt * 16 + lq) * 72 + s * 32 + quad * 8); akk[nt] = MFMA16(bk, ak, akk[nt]); aqk[nt] = MFMA16(bk, aq, aqk[nt]); }
    }
    u16* QKf = (u16*)(p->ws + WS_QK) + (size_t)(item * 2 + 0) * 4096;
    u16* QKb = (u16*)(p->ws + WS_QK) + (size_t)(item * 2 + 1) * 4096;
    const int i = i0 + lq, ib = 63 - i;
    const float gci = sgc[i], gcbi = sgc[64 + ib], bti = sbeta[i], btbi = sbeta[64 + ib];
#pragma unroll
    for (int nt = 0; nt < 4; ++nt) {
      const int j0 = nt * 16 + quad * 4;
      const float4 gcj = *(const float4*)(sgc + j0), gcbj = *(const float4*)(sgc + 64 + 60 - j0);
      const float gj[4] = {gcj.x, gcj.y, gcj.z, gcj.w};
      const float gbj[4] = {gcbj.w, gcbj.z, gcbj.y, gcbj.x};
      float qf[4], qb[4];
#pragma unroll
      for (int r = 0; r < 4; ++r) {
        const int j = j0 + r, jb = 63 - j;
        const float kkv = akk[nt][r], qkv = aqk[nt][r];
        const float ef = (j <= i) ? __expf(gci - gj[r]) : 0.f;
        const float eb = (j >= i) ? __expf(gcbi - gbj[r]) : 0.f;
        if (j < i) sL[i * 64 + j] = bti * kkv * ef;
        if (j > i) sL[4096 + ib * 64 + jb] = btbi * kkv * eb;
        qf[r] = qkv * ef; qb[r] = qkv * eb;
      }
      *(uint2*)(QKf + i * 64 + j0) = make_uint2(pack2(qf[0], qf[1]), pack2(qf[2], qf[3]));
      *(uint2*)(QKb + ib * 64 + 60 - j0) = make_uint2(pack2(qb[3], qb[2]), pack2(qb[1], qb[0]));
    }
  }
  __syncthreads();
  {
    const int col = tid & 127;
    u16* UW = (u16*)(p->ws + WS_UW) + (size_t)(item * 2 + (tid >> 7)) * 8192 + col;
    for (int rep = 0; rep < NREP(2); ++rep) {
    if (tid < 128) { if (col < 64) gdn_solve<0, false>(sL, sv + col, sbeta, sge, UW); else gdn_solve<0, true>(sL, sk + (col - 64), sbeta, sge, UW); }
    else { if (col < 64) gdn_solve<1, false>(sL + 4096, sv + col, sbeta + 64, sge + 64, UW); else gdn_solve<1, true>(sL + 4096, sk + (col - 64), sbeta + 64, sge + 64, UW); }
    }
  }
  __syncthreads();
}

DI void gdn2_item(KP p, int l, int item, unsigned char* smem) {
  u16* sW = (u16*)smem; u16* sKT = sW + 64 * 72; u16* sU = sKT + 64 * 72;
  float* sg = (float*)(smem + 27648);
  const int tid = ltid(), lane = tid & 63, wave = tid >> 6, lq = lane & 15, quad = lane >> 4;
  int b, hd, dir; bool lat;
  if (item < 16) { lat = true; b = item >> 3; hd = (item >> 1) & 3; dir = item & 1; }
  else { lat = false; int r = item - 16; b = r >> 3; hd = (r >> 1) & 3; dir = r & 1; }
  const int nch = lat ? 64 : 4, cg0 = lat ? 128 + b * 64 : b * 4;
  f32x4 st[4];
#pragma unroll
  for (int kt = 0; kt < 4; ++kt)
#pragma unroll
    for (int r = 0; r < 4; ++r)
      st[kt][r] = lat ? p->in[8][((size_t)(((b * 2 + l) * 2 + dir) * 4 + hd) * 64 + kt * 16 + quad * 4 + r) * 64 + wave * 16 + lq] : 0.f;
  const int lrow = tid >> 2, seg = (tid & 3) * 16;
  struct GReg { u32x4 U[2], W[2], KT[2]; float g; };
  GReg R0, R1;
  u16* UWb = (u16*)(p->ws + WS_UW);
  const u16* KTb = (const u16*)(p->ws + WS_KT);
  const float* GV = (const float*)(p->ws + WS_GVEC);
  auto gload = [&](int n, GReg& R) {
    const int cgi = dir == 0 ? cg0 + n : cg0 + nch - 1 - n;
    const size_t prob = (size_t)cgi * 4 + hd, pd = prob * 2 + dir;
    const u16* u = UWb + (pd * 64 + lrow) * 128 + seg;
    R.U[0] = *(const u32x4*)u; R.U[1] = *(const u32x4*)(u + 8); R.W[0] = *(const u32x4*)(u + 64); R.W[1] = *(const u32x4*)(u + 72);
    const u16* kt = KTb + (prob * 64 + lrow) * 64 + (dir ? 48 - seg : seg);
    u32x4 a = *(const u32x4*)kt, bb = *(const u32x4*)(kt + 8);
    if (dir) { R.KT[0] = rev8(bb); R.KT[1] = rev8(a); } else { R.KT[0] = a; R.KT[1] = bb; }
    R.g = GV[pd * 256 + (tid & 255)];
  };
  gload(0, R0); gload(1, R1);
  auto step = [&](int n, GReg& R) {
    const int cgi = dir == 0 ? cg0 + n : cg0 + nch - 1 - n;
    const size_t pd = ((size_t)cgi * 4 + hd) * 2 + dir;
    __syncthreads();
    *(u32x4*)(sW + lrow * 72 + seg) = R.W[0]; *(u32x4*)(sW + lrow * 72 + seg + 8) = R.W[1];
    *(u32x4*)(sKT + lrow * 72 + seg) = R.KT[0]; *(u32x4*)(sKT + lrow * 72 + seg + 8) = R.KT[1];
    *(u32x4*)(sU + lrow * 72 + seg) = R.U[0]; *(u32x4*)(sU + lrow * 72 + seg + 8) = R.U[1];
    sg[tid] = R.g;
    __syncthreads();
    if (n + 2 < nch) gload(n + 2, R);
    u32x4* FR = (u32x4*)(UWb + pd * 8192);
    const float elast = sg[128];
    bf16x8 sB[2] = {pack8(st[0], st[1]), pack8(st[2], st[3])};
    FR[(0 * 4 + wave) * 64 + lane] = __builtin_bit_cast(u32x4, sB[0]);
    FR[(1 * 4 + wave) * 64 + lane] = __builtin_bit_cast(u32x4, sB[1]);
    f32x4 vn[4];
#pragma unroll
    for (int mt = 0; mt < 4; ++mt) {
      f32x4 acc = {0.f, 0.f, 0.f, 0.f};
#pragma unroll
      for (int s2 = 0; s2 < 2; ++s2) acc = MFMA16(ldperm(sW + (mt * 16 + lq) * 72 + s2 * 32 + quad * 4), sB[s2], acc);
#pragma unroll
      for (int r = 0; r < 4; ++r) vn[mt][r] = bf2f(sU[(mt * 16 + quad * 4 + r) * 72 + wave * 16 + lq]) - acc[r];
    }
    bf16x8 vB[2] = {pack8(vn[0], vn[1]), pack8(vn[2], vn[3])};
    FR[512 + (0 * 4 + wave) * 64 + lane] = __builtin_bit_cast(u32x4, vB[0]);
    FR[512 + (1 * 4 + wave) * 64 + lane] = __builtin_bit_cast(u32x4, vB[1]);
#pragma unroll
    for (int mt = 0; mt < 4; ++mt)
#pragma unroll
      for (int r = 0; r < 4; ++r) vn[mt][r] *= sg[64 + mt * 16 + quad * 4 + r];
    bf16x8 vsB[2] = {pack8(vn[0], vn[1]), pack8(vn[2], vn[3])};
#pragma unroll
    for (int kt = 0; kt < 4; ++kt) {
      f32x4 acc = {0.f, 0.f, 0.f, 0.f};
#pragma unroll
      for (int s2 = 0; s2 < 2; ++s2) acc = MFMA16(ldperm(sKT + (kt * 16 + lq) * 72 + s2 * 32 + quad * 4), vsB[s2], acc);
#pragma unroll
      for (int r = 0; r < 4; ++r) st[kt][r] = elast * st[kt][r] + acc[r];
    }
  };
  for (int n = 0; n < nch; n += 2) { step(n, R0); step(n + 1, R1); }
  if (!lat) {
#pragma unroll
    for (int kt = 0; kt < 4; ++kt)
#pragma unroll
      for (int r = 0; r < 4; ++r)
        p->out[O_GDN + ((size_t)(((b * 2 + l) * 2 + dir) * 4 + hd) * 64 + kt * 16 + quad * 4 + r) * 64 + wave * 16 + lq] = st[kt][r];
  }
  __syncthreads();
}

DI void gdnfin_item(KP p, int l, int item, unsigned char* smem) {
  u16* sQ = (u16*)smem; u16* sQK = sQ + 64 * 72;
  float* so = (float*)(smem + 3 * 64 * 72 * 2);
  float* seg_ = so + 64 * 65;
  const int cgi = item >> 2, hd = item & 3;
  const int tid = ltid(), lane = tid & 63, wave = tid >> 6, lq = lane & 15, quad = lane >> 4;
  const int lrow = tid >> 2, seg = (tid & 3) * 16;
  __syncthreads();
  {
    const u16* q = (const u16*)(p->ws + WS_QHAT) + ((size_t)item * 64 + lrow) * 64 + seg;
    *(u32x4*)(sQ + lrow * 72 + seg) = *(const u32x4*)q; *(u32x4*)(sQ + lrow * 72 + seg + 8) = *(const u32x4*)(q + 8);
#pragma unroll
    for (int dir = 0; dir < 2; ++dir) {
      const u16* qk = (const u16*)(p->ws + WS_QK) + ((size_t)(item * 2 + dir) * 64 + lrow) * 64 + seg;
      *(u32x4*)(sQK + (dir * 64 + lrow) * 72 + seg) = *(const u32x4*)qk; *(u32x4*)(sQK + (dir * 64 + lrow) * 72 + seg + 8) = *(const u32x4*)(qk + 8);
    }
    if (tid < 128) seg_[tid] = ((const float*)(p->ws + WS_GVEC))[(size_t)(item * 2 + (tid >> 6)) * 256 + (tid & 63)];
  }
  __syncthreads();
#pragma unroll
  for (int dir = 0; dir < 2; ++dir) {
    const u32x4* FR = (const u32x4*)((const u16*)(p->ws + WS_UW) + (size_t)(item * 2 + dir) * 8192);
    bf16x8 sfr[2], vfr[2];
#pragma unroll
    for (int s2 = 0; s2 < 2; ++s2) {
      sfr[s2] = __builtin_bit_cast(bf16x8, FR[(s2 * 4 + wave) * 64 + lane]);
      vfr[s2] = __builtin_bit_cast(bf16x8, FR[512 + (s2 * 4 + wave) * 64 + lane]);
    }
#pragma unroll
    for (int mt = 0; mt < 4; ++mt) {
      f32x4 acc = {0.f, 0.f, 0.f, 0.f};
      const int qrow = dir ? 63 - (mt * 16 + lq) : mt * 16 + lq;
#pragma unroll
      for (int s2 = 0; s2 < 2; ++s2) acc = MFMA16(ldperm(sQ + qrow * 72 + s2 * 32 + quad * 4), sfr[s2], acc);
#pragma unroll
      for (int r = 0; r < 4; ++r) acc[r] *= seg_[dir * 64 + mt * 16 + quad * 4 + r];
#pragma unroll
      for (int s2 = 0; s2 < 2; ++s2) acc = MFMA16(ldperm(sQK + (dir * 64 + mt * 16 + lq) * 72 + s2 * 32 + quad * 4), vfr[s2], acc);
#pragma unroll
      for (int r = 0; r < 4; ++r) {
        const int c = mt * 16 + quad * 4 + r;
        const int tk = dir ? 63 - c : c;
        float* d = so + tk * 65 + wave * 16 + lq;
        if (dir == 0) *d = acc[r]; else *d += acc[r];
      }
    }
    __syncthreads();
  }
  const float gn = p->in[28][l * 64 + lane];
  float zv[16];
#pragma unroll
  for (int q = 0; q < 16; ++q)
    zv[q] = bf2f(((const u16*)(p->ws + WS_INPROJ))[((size_t)cgi * 64 + wave * 16 + q) * LDI + C_GZ + hd * 64 + lane]);
#pragma unroll
  for (int q = 0; q < 16; ++q) {
    const int c = wave * 16 + q;
    const size_t row = (size_t)cgi * 64 + c;
    float o = so[c * 65 + lane];
    float ss = wave_sum(o * o);
    float y = o * rsqrtf(ss * (1.f / 64.f) + 1e-6f) * gn * siluf_(zv[q]);
    ((u16*)(p->ws + WS_BRANCH))[row * 1024 + 512 + hd * 64 + lane] = f2bf(y);
  }
}

#define XB_TMO      128
#define XB_XCNT(j)  (256  + 64 * (j))
#define XB_XSUB(j)  (1280 + 64 * (j))
#define XB_XGEN(j)  (2304 + 64 * (j))
#define XB_TOP      3328
#define XB_TOPGEN   3392
#define XB_SPIN_CAP (1u << 20)
#define LAS __attribute__((address_space(3)))
DI unsigned xb_ld(unsigned* q) { return __hip_atomic_load(q, __ATOMIC_RELAXED, __HIP_MEMORY_SCOPE_AGENT); }
DI unsigned xb_add(unsigned* q, unsigned v) { return __hip_atomic_fetch_add(q, v, __ATOMIC_RELAXED, __HIP_MEMORY_SCOPE_AGENT); }
DI unsigned xb_xcc_id() { return (unsigned)__builtin_amdgcn_s_getreg((3 << 11) | 20) & 0xFu; }
#define XB_SPIN(cond, bar) do { unsigned _sp = 0; while (cond) { __builtin_amdgcn_s_sleep(1); \
    if ((++_sp & 255u) == 0u) { if (xb_ld(&(bar)[XB_TMO])) break; if (_sp > XB_SPIN_CAP) { atomicAdd(&(bar)[XB_TMO], 1u); break; } } } } while (0)
DI void xcd_barrier_complete(unsigned* bar, unsigned x, unsigned& nloc, unsigned& nx) {
  const unsigned G = gridDim.x;
  unsigned sum, cnt, mine, sp = 0u;
  for (;;) {
    sum = 0u; cnt = 0u; mine = 0u;
#pragma unroll
    for (unsigned j = 0; j < 16; ++j) { const unsigned c = xb_ld(&bar[XB_XCNT(j)]); sum += c; cnt += (c > 0u) ? 1u : 0u; mine = (j == x) ? c : mine; }
    if (sum == G) break;
    __builtin_amdgcn_s_sleep(1);
    if ((++sp & 255u) == 0u) { if (xb_ld(&bar[XB_TMO])) break; if (sp > XB_SPIN_CAP) { atomicAdd(&bar[XB_TMO], 1u); break; } }
  }
  nloc = mine > 0u ? mine : 1u; nx = cnt > 0u ? cnt : 1u;
}
DI void xcd_barrier(unsigned* bar, volatile LAS unsigned* st) {
  asm volatile("s_waitcnt vmcnt(0)" ::: "memory");
  __syncthreads();
  if (ltid() == 0) {
    const unsigned x = xb_xcc_id();
    __builtin_amdgcn_s_waitcnt(0);
    unsigned nloc = st[0], nx = st[1];
    if (nloc == 0u) { xcd_barrier_complete(bar, x, nloc, nx); st[0] = nloc; st[1] = nx; }
    const unsigned old = xb_add(&bar[XB_XSUB(x)], 1u);
    const unsigned gen = old / nloc;
    if (old + 1u == (gen + 1u) * nloc) {
      __builtin_amdgcn_fence(__ATOMIC_RELEASE, "agent");
      asm volatile("s_waitcnt vmcnt(0)" ::: "memory");
      const unsigned og = xb_add(&bar[XB_TOP], 1u);
      const unsigned tg = og / nx;
      if (og + 1u == (tg + 1u) * nx) xb_add(&bar[XB_TOPGEN], 1u);
      else XB_SPIN(xb_ld(&bar[XB_TOPGEN]) == tg, bar);
      __builtin_amdgcn_fence(__ATOMIC_ACQUIRE, "agent");
      xb_add(&bar[XB_XGEN(x)], 1u);
      asm volatile("s_waitcnt vmcnt(0)" ::: "memory");
    } else {
      XB_SPIN(xb_ld(&bar[XB_XGEN(x)]) == gen, bar);
      __builtin_amdgcn_fence(__ATOMIC_ACQUIRE, "agent");
      asm volatile("s_waitcnt vmcnt(0)" ::: "memory");
    }
  }
  __syncthreads();
}


#define FOR_TILES(MTI, NTI, SM, SN, CALL)                                                      \
  do {                                                                                         \
    if (G % 8 != 0) { for (int it_ = B; it_ < (MTI) * (NTI); it_ += G) { const int mt = it_ / (NTI), nt = it_ % (NTI); CALL; } } \
    else {                                                                                     \
      const int xcd_ = B & 7, j_ = B >> 3, J_ = G >> 3;                                        \
      const int nsm_ = ((MTI) + (SM) - 1) / (SM), nsn_ = ((NTI) + (SN) - 1) / (SN);            \
      const int st_ = (SM) * (SN), mysup_ = (nsm_ * nsn_ - xcd_ + 7) / 8;                      \
        \
                                  \
      for (int u_ = j_; u_ < mysup_ * st_; u_ += J_) {                                         \
        const int s_ = xcd_ + 8 * (u_ / st_), t_ = u_ % st_;                                   \
        const int sm_ = s_ / nsn_, sn_ = s_ % nsn_;                                            \
        const int mt = sm_ * (SM) + t_ / (SN), nt = sn_ * (SN) + t_ % (SN);                    \
        if (mt < (MTI) && nt < (NTI)) { CALL; }                                                \
      }                                                                                        \
    }                                                                                          \
  } while (0)

constexpr int NPHASE = 21;
__global__ void __launch_bounds__(256, 2) mk(Params p_unused, int ph_lo, int ph_hi) {
  extern __shared__ __attribute__((aligned(1024))) unsigned char smem[];
  int& s_item = *(int*)(smem + SMEM_BYTES);
  u32x4& xb_words = *(u32x4*)(smem + SMEM_BYTES + 16);
  const int G = gridDim.x, B = blockIdx.x;
  const bool fused = ph_hi - ph_lo > 1;
  if (fused) {
    if (ltid() == 0) { xb_words = u32x4{0u, 0u, 0u, 0u}; (void)xb_add(&((unsigned*)(((KP)__builtin_amdgcn_kernarg_segment_ptr())->ws + WS_BAR))[XB_XCNT(xb_xcc_id())], 1u); }
    __syncthreads();
  }
  for (int ph = ph_lo; ph < ph_hi; ++ph) {
    KP p = (KP)__builtin_amdgcn_kernarg_segment_ptr();
    asm volatile("" : "+s"(p));
    if (ph == 0) {
      for (int it = B; it < 192 + CONV_ITEMS + 64; it += G) { for (int rep = 0; rep < NREP(0); ++rep) { if (it < 192) mod_item(p, it, smem); else if (it < 192 + CONV_ITEMS) convert_item(p, 0, it - 192, smem); else lruw_item(p, it - 192 - CONV_ITEMS); } }
    } else {
      const int l = (ph - 1) / 10, sub = (ph - 1) % 10;
      switch (sub) {
        case 0:
          for (int it = B; it < 2048 + (l ? CONV_ITEMS : 0); it += G) { if (it < 2048) norm_item<0>(p, l, it); else convert_item(p, l, it - 2048, smem); }
          break;
        case 1: FOR_TILES(128, 21, 8, 7, inproj_item(p, mt, nt, smem)); break;
        case 2:
          for (int it = B; it < 1024 + 512 + 64 + 2048; it += G) {
            if (it < 1024) { for (int rep = 0; rep < NREP(4); ++rep) gdn1_item(p, l, it, smem); }
            else if (it < 1536) { for (int rep = 0; rep < NREP(5); ++rep) lru_item<false>(p, l, it - 1024, smem); }
            else if (it < 1600) { if (PHON(6)) kvc_item(p, l, it - 1536); }
            else if (PHON(6)) prep_item(p, l, it - 1600);
          }
          break;
        case 3: {
          int* ctr = (int*)(p->ws + WS_CTR) + l;
          for (;;) {
            __syncthreads();
            if (ltid() == 0) s_item = atomicAdd(ctr, 1);
            __syncthreads();
            const int it = s_item;
            if (it >= 16 + 256 + 256 + 256 + 512 + 512) break;
            if (it < 16) gdn2_item(p, l, it, smem);
            else if (it < 272) { for (int rep = 0; rep < NREP(8); ++rep) attn_item(p, l, it - 16, smem); }
            else if (it < 528) gdn2_item(p, l, it - 272 + 16, smem);
            else if (it < 784) { for (int rep = 0; rep < NREP(8); ++rep) attn_item(p, l, it - 528 + 256, smem); }
            else if (it < 1296) { for (int rep = 0; rep < NREP(9); ++rep) lru_item<true>(p, l, it - 784, smem); }
            else for (int rep = 0; rep < NREP(8); ++rep) attn_item(p, l, it - 1296 + 512, smem);
          }
        } break;
        case 4: for (int it = B; it < 1024; it += G) gdnfin_item(p, l, it, smem); break;
        case 5: for (int rep = 0; rep < NREP(11); ++rep) FOR_TILES(128, 8, 8, 8, merge_item(p, l, mt, nt, smem)); break;
        case 6: FOR_TILES(128, 8, 8, 8, wout_item(p, l, mt, nt, smem)); break;
        case 7: for (int it = B; it < 2048; it += G) norm_item<1>(p, l, it); break;
        case 8: FOR_TILES(128, 32, 8, 8, w1_item(p, mt, nt, smem)); break;
        case 9: FOR_TILES(128, 8, 8, 8, w2_item(p, l, mt, nt, smem)); break;
      }
    }
    if (ph + 1 < ph_hi) {
      if (ph == ph_lo) cg::this_grid().sync();
      else for (int rep = 0; rep < NREP(1); ++rep) xcd_barrier((unsigned*)(p->ws + WS_BAR), (volatile LAS unsigned*)&xb_words);
    }
  }
}

extern "C" void kernel_launch(void* const* d_in, const int* in_sizes, int n_in, void* d_out, int out_size, void* d_ws, size_t ws_size, hipStream_t stream) {
  static int grid_blocks = 0;
  if (!grid_blocks) {
    int dev = 0, cus = 0, per_cu = 0;
    (void)hipGetDevice(&dev);
    (void)hipDeviceGetAttribute(&cus, hipDeviceAttributeMultiprocessorCount, dev);
    if (hipFuncSetAttribute((const void*)mk, hipFuncAttributeMaxDynamicSharedMemorySize, DYN_LDS) != hipSuccess) fprintf(stderr, "kernel_launch: hipFuncSetAttribute failed\n");
    (void)hipOccupancyMaxActiveBlocksPerMultiprocessor(&per_cu, mk, 256, DYN_LDS);
    if (per_cu < 1) per_cu = 1;
    if (per_cu > 2) per_cu = 2;
    grid_blocks = cus * per_cu;
    if (ws_size < WS_END) fprintf(stderr, "kernel_launch: workspace too small: %zu < %zu\n", ws_size, (size_t)WS_END);
  }
  if (hipMemsetAsync((char*)d_ws + WS_CTR, 0, 256 + 3456 * 4 + 256, stream) != hipSuccess) fprintf(stderr, "kernel_launch: memset failed\n");
  Params p{};
  for (int i = 0; i < 37; ++i) p.in[i] = (const float*)d_in[i];
  p.out = (float*)d_out; p.ws = (unsigned char*)d_ws;
#if MULTI_LAUNCH
  for (int ph = 0; ph < NPHASE; ++ph) hipLaunchKernelGGL(mk, dim3(grid_blocks), dim3(256), DYN_LDS, stream, p, ph, ph + 1);
#else
  int lo = 0, hi = NPHASE;
  void* args[] = {&p, &lo, &hi};
  hipError_t e = hipLaunchCooperativeKernel((void*)mk, dim3(grid_blocks), dim3(256), args, DYN_LDS, stream);
  if (e != hipSuccess) fprintf(stderr, "cooperative launch failed: %s (grid %d)\n", hipGetErrorString(e), grid_blocks);
#endif
}
```

```cpp
#include <hip/hip_runtime.h>
#include <hip/hip_cooperative_groups.h>
#include <cstdio>
namespace cg = cooperative_groups;

#ifndef MULTI_LAUNCH
#define MULTI_LAUNCH 0
#endif
#ifndef PHM
#define PHM 0xFFFFFFFFu
#endif
#define PHON(b) ((PHM >> (b)) & 1u)
#ifndef DUPM
#define DUPM 0u
#endif
#define NREP(b) (1 + ((DUPM >> (b)) & 1u))

typedef unsigned short u16;
using bf16x8 = __attribute__((ext_vector_type(8))) short;
using f32x4 = __attribute__((ext_vector_type(4))) float;
using u32x4 = __attribute__((ext_vector_type(4))) unsigned;
#define DI __device__ __forceinline__
#define MFMA16(a, b, c) __builtin_amdgcn_mfma_f32_16x16x32_bf16((a), (b), (c), 0, 0, 0)

constexpr int NTOK = 16384;
constexpr int DM = 1024;
constexpr int LDI = 2592;
constexpr int C_AQ = 0, C_AK = 256, C_AV = 384, C_LX = 512, C_LG = 768, C_GQ = 1024, C_GK = 1280, C_GV = 1536, C_GZ = 1792,
              C_DQ = 2048, C_DK = 2304, C_DV = 2432, C_GA = 2560, C_GB = 2568;
constexpr int NIN_PAD = 2688;

constexpr size_t WS_MOD = 0;
constexpr size_t WS_CTR = WS_MOD + 2 * 3 * 6144 * 4;
constexpr size_t WS_BAR = WS_CTR + 256;
constexpr size_t WS_LRUC = WS_BAR + 3456 * 4 + 256;
constexpr size_t WS_KC = WS_LRUC + (size_t)512 * 2 * 2 * 256 * 4;
constexpr size_t WS_GVEC = WS_KC + (size_t)16 * 512 * 64 * 2;
constexpr size_t WS_LRUW = WS_GVEC + (size_t)1024 * 2 * 256 * 4;
constexpr size_t WS_VT = WS_LRUW + (size_t)256 * 64 * 16;
constexpr size_t WS_WIN = WS_VT + (size_t)8 * 64 * 4608 * 2;
constexpr size_t WS_WM = WS_WIN + (size_t)NIN_PAD * 1024 * 2;
constexpr size_t WS_WB = WS_WM + (size_t)4096 * 1024 * 2;
constexpr size_t WS_WO = WS_WB + (size_t)4 * 1024 * 256 * 2;
constexpr size_t WS_W1 = WS_WO + (size_t)1024 * 1024 * 2;
constexpr size_t WS_W2 = WS_W1 + (size_t)4096 * 1024 * 2;
constexpr size_t WS_H = WS_W2 + (size_t)1024 * 4096 * 2;
constexpr size_t WS_BIG = WS_H + (size_t)NTOK * 1024 * 2;
constexpr size_t WS_INPROJ = WS_BIG;
constexpr size_t WS_BRANCH = WS_INPROJ + (size_t)NTOK * LDI * 2;
constexpr size_t WS_QHAT = WS_BRANCH + (size_t)NTOK * 1024 * 2;
constexpr size_t WS_KT = WS_QHAT + (size_t)1024 * 4096 * 2;
constexpr size_t WS_UW = WS_KT + (size_t)1024 * 4096 * 2;
constexpr size_t WS_QK = WS_UW + (size_t)1024 * 2 * 8192 * 2;
constexpr size_t WS_END = WS_QK + (size_t)1024 * 2 * 4096 * 2;
constexpr size_t WS_HIDDEN = WS_BIG;
constexpr size_t WS_MERGED = WS_BIG;
static_assert(WS_HIDDEN + (size_t)NTOK * 4096 * 2 <= WS_END, "hidden must fit");
static_assert(WS_END <= (size_t)256 * 1024 * 1024, "workspace budget");

constexpr size_t O_X = 0, O_AK = 16777216, O_AV = 18874368, O_DK = 20971520, O_DV = 23068672, O_LRU = 25165824, O_GDN = 25198592;

struct Params {
  const float* in[37];
  float* out;
  unsigned char* ws;
};

typedef const Params __attribute__((address_space(4)))* KP;
constexpr int SMEM_BYTES = 65536;
constexpr int DYN_LDS = SMEM_BYTES + 64;

DI int ltid() { int t = threadIdx.x; asm volatile("" : "+v"(t)); return t; }
typedef __bf16 bf16v2 __attribute__((ext_vector_type(2)));
DI u16 f2bf(float x) { __bf16 h = (__bf16)x; return __builtin_bit_cast(u16, h); }
DI float bf2f(u16 h) { return __uint_as_float(((unsigned)h) << 16); }
DI unsigned pack2(float a, float b) { bf16v2 v = {(__bf16)a, (__bf16)b}; return __builtin_bit_cast(unsigned, v); }
DI float bflo(unsigned u) { return __uint_as_float(u << 16); }
DI float bfhi(unsigned u) { return __uint_as_float(u & 0xffff0000u); }
DI float sigm(float x) { return __builtin_amdgcn_rcpf(1.f + __expf(-x)); }
DI float siluf_(float x) { return x * __builtin_amdgcn_rcpf(1.f + __expf(-x)); }
DI float softplusf_(float x) { return x > 20.f ? x : __logf(1.f + __expf(x)); }
DI float gelu_tanh(float x) { float u = 0.7978845608028654f * (x + 0.044715f * x * x * x); float t = 1.f - 2.f * __builtin_amdgcn_rcpf(__expf(2.f * u) + 1.f); return 0.5f * x * (1.f + t); }
template <int CTRL> DI float dppf(float v) { return __int_as_float(__builtin_amdgcn_update_dpp(0, __float_as_int(v), CTRL, 0xF, 0xF, true)); }
DI float rlane(float v, int l) { return __int_as_float(__builtin_amdgcn_readlane(__float_as_int(v), l)); }
DI float wave_sum(float v) {
  v += dppf<0xB1>(v);
  v += dppf<0x4E>(v);
  v += dppf<0x141>(v);
  v += dppf<0x140>(v);
  return (rlane(v, 0) + rlane(v, 16)) + (rlane(v, 32) + rlane(v, 48));
}
DI float xrow16_max(float x) { auto r = __builtin_amdgcn_permlane16_swap(__float_as_uint(x), __float_as_uint(x), false, false); return fmaxf(__uint_as_float(r[0]), __uint_as_float(r[1])); }
DI float xrow32_max(float x) { auto r = __builtin_amdgcn_permlane32_swap(__float_as_uint(x), __float_as_uint(x), false, false); return fmaxf(__uint_as_float(r[0]), __uint_as_float(r[1])); }
DI float xrow16_sum(float x) { auto r = __builtin_amdgcn_permlane16_swap(__float_as_uint(x), __float_as_uint(x), false, false); return __uint_as_float(r[0]) + __uint_as_float(r[1]); }
DI float xrow32_sum(float x) { auto r = __builtin_amdgcn_permlane32_swap(__float_as_uint(x), __float_as_uint(x), false, false); return __uint_as_float(r[0]) + __uint_as_float(r[1]); }
DI float xor16_partner(float x, int lane) { auto r = __builtin_amdgcn_permlane16_swap(__float_as_uint(x), __float_as_uint(x), false, false); return __uint_as_float((lane & 16) ? r[0] : r[1]); }
DI u32x4 mku4(unsigned a, unsigned b, unsigned c, unsigned d) { u32x4 v = {a, b, c, d}; return v; }
DI bf16x8 mk8(unsigned a, unsigned b, unsigned c, unsigned d) { u32x4 v = {a, b, c, d}; return __builtin_bit_cast(bf16x8, v); }
DI bf16x8 pack8(const f32x4& x, const f32x4& y) { return mk8(pack2(x[0], x[1]), pack2(x[2], x[3]), pack2(y[0], y[1]), pack2(y[2], y[3])); }
DI bf16x8 ld8(const u16* p) { return *(const bf16x8*)p; }
DI bf16x8 ldperm(const u16* p) { uint2 a = *(const uint2*)p; uint2 b = *(const uint2*)(p + 16); return mk8(a.x, a.y, b.x, b.y); }
DI int mod_group(int row) { return row < 8192 ? 0 : 1 + ((row - 8192) >> 12); }
DI const float* x_in_row(KP p, int l, int row) {
  if (l == 0) return row < 8192 ? p->in[0] + (size_t)row * DM : p->in[1] + (size_t)(row - 8192) * DM;
  return p->out + (size_t)row * DM;
}
DI unsigned swap16(unsigned u) { return (u >> 16) | (u << 16); }
DI u32x4 rev8(u32x4 v) { return mku4(swap16(v.w), swap16(v.z), swap16(v.y), swap16(v.x)); }

DI void mod_item(KP p, int item, unsigned char* smem) {
  float* sc = (float*)smem;
  float* sr = sc + 3072;
  const int tid = ltid();
  const int l = item / 96, cb = item % 96;
  for (int i = tid; i < 3072; i += 256) {
    int g = i >> 10, k = i & 1023;
    float c = g == 0 ? p->in[9][k] : p->in[2][(g - 1) * 1024 + k];
    sc[i] = siluf_(c);
  }
  __syncthreads();
  const int col = cb * 64 + (tid & 63), kg = tid >> 6;
  const float* W = p->in[10] + (size_t)l * 1024 * 6144;
  float a0 = 0.f, a1 = 0.f, a2 = 0.f;
  for (int k = kg * 256; k < kg * 256 + 256; ++k) {
    float w = W[(size_t)k * 6144 + col];
    a0 += sc[k] * w; a1 += sc[1024 + k] * w; a2 += sc[2048 + k] * w;
  }
  sr[(kg * 3 + 0) * 64 + (tid & 63)] = a0; sr[(kg * 3 + 1) * 64 + (tid & 63)] = a1; sr[(kg * 3 + 2) * 64 + (tid & 63)] = a2;
  __syncthreads();
  if (tid < 192) {
    int g = tid >> 6, cc = tid & 63;
    float s = p->in[11][l * 6144 + cb * 64 + cc];
    for (int q = 0; q < 4; ++q) s += sr[(q * 3 + g) * 64 + cc];
    ((float*)(p->ws + WS_MOD))[(l * 3 + g) * 6144 + cb * 64 + cc] = s;
  }
  __syncthreads();
}

DI void conv_tile(const float* src, int N, int k0, int n0, u16* dst, int K, bool perm, unsigned char* smem) {
  float* tile = (float*)smem;
  const int tid = ltid();
#pragma unroll
  for (int i = 0; i < 4; ++i) {
    int kr = (tid >> 4) + 16 * i, nc = (tid & 15) * 4;
    float4 v = make_float4(0.f, 0.f, 0.f, 0.f);
    if (n0 + nc < N) v = *(const float4*)(src + (size_t)(k0 + kr) * N + n0 + nc);
    tile[kr * 65 + nc] = v.x; tile[kr * 65 + nc + 1] = v.y; tile[kr * 65 + nc + 2] = v.z; tile[kr * 65 + nc + 3] = v.w;
  }
  __syncthreads();
#pragma unroll
  for (int i = 0; i < 2; ++i) {
    int n = (tid >> 3) + 32 * i, k8 = (tid & 7) * 8;
    int ng = n0 + n;
    if (ng < N) {
      int row = ng;
      if (perm) row = ng < 2048 ? ng : (ng < 2064 ? 2560 + (ng - 2048) : ng - 16);
      u32x4 o;
      o.x = pack2(tile[(k8 + 0) * 65 + n], tile[(k8 + 1) * 65 + n]);
      o.y = pack2(tile[(k8 + 2) * 65 + n], tile[(k8 + 3) * 65 + n]);
      o.z = pack2(tile[(k8 + 4) * 65 + n], tile[(k8 + 5) * 65 + n]);
      o.w = pack2(tile[(k8 + 6) * 65 + n], tile[(k8 + 7) * 65 + n]);
      *(u32x4*)(dst + (size_t)row * K + k0 + k8) = o;
    }
  }
  __syncthreads();
}

constexpr int CONV_ITEMS = 4241;
DI void convert_item(KP p, int l, int item, unsigned char* smem) {
  unsigned char* ws = p->ws;
  if (item < 656) { int kt = item / 41, nt = item % 41; conv_tile(p->in[14] + (size_t)l * 1024 * 2576, 2576, kt * 64, nt * 64, (u16*)(ws + WS_WIN), 1024, true, smem); return; }
  item -= 656;
  if (item < 1024) { int kt = item >> 6, nt = item & 63; conv_tile(p->in[32] + (size_t)l * 1024 * 4096, 4096, kt * 64, nt * 64, (u16*)(ws + WS_WM), 1024, false, smem); return; }
  item -= 1024;
  if (item < 256) { int m = item >> 6, r = item & 63, kt = r >> 4, nt = r & 15;
    conv_tile(p->in[31] + ((size_t)l * 4 + m) * 256 * 1024, 1024, kt * 64, nt * 64, (u16*)(ws + WS_WB) + (size_t)m * 1024 * 256, 256, false, smem); return; }
  item -= 256;
  if (item < 256) { int kt = item >> 4, nt = item & 15; conv_tile(p->in[34] + (size_t)l * 1024 * 1024, 1024, kt * 64, nt * 64, (u16*)(ws + WS_WO), 1024, false, smem); return; }
  item -= 256;
  if (item < 1024) { int kt = item >> 6, nt = item & 63; conv_tile(p->in[35] + (size_t)l * 1024 * 4096, 4096, kt * 64, nt * 64, (u16*)(ws + WS_W1), 1024, false, smem); return; }
  item -= 1024;
  if (item < 1024) { int kt = item >> 4, nt = item & 15; conv_tile(p->in[36] + (size_t)l * 4096 * 1024, 1024, kt * 64, nt * 64, (u16*)(ws + WS_W2), 4096, false, smem); return; }
  u32x4* z = (u32x4*)((u16*)(ws + WS_WIN) + (size_t)2576 * 1024);
  for (int i = ltid(); i < 112 * 1024 / 8; i += 256) z[i] = mku4(0, 0, 0, 0);
}

DI void lruw_item(KP p, int item) {
  const int gid = item * 256 + ltid();
  const int lane = gid & 63, fg = gid >> 6;
  const int s2 = fg & 1, j = (fg >> 1) & 3, n = (fg >> 3) & 3, g = (fg >> 5) & 1, ld_ = fg >> 6;
  const int lq = lane & 15, quad = lane >> 4;
  const float* W = (g == 0 ? p->in[20] : p->in[22]) + ((size_t)(ld_ * 4 + n) * 64) * 64 + (size_t)(s2 * 32 + quad * 8) * 64 + j * 16 + lq;
  u32x4 o = {pack2(W[0], W[64]), pack2(W[128], W[192]), pack2(W[256], W[320]), pack2(W[384], W[448])};
  ((u32x4*)(p->ws + WS_LRUW))[gid] = o;
}

template <int which>
DI void norm_item(KP p, int l, int item) {
  const int tid = ltid(), lane = tid & 63, wave = tid >> 6;
  const float* g = p->in[which == 0 ? 12 : 13] + l * 1024;
  f32x4 v[2][4]; float ss[2] = {0.f, 0.f};
#pragma unroll
  for (int h = 0; h < 2; ++h) {
    const int row = item * 8 + wave * 2 + h;
    const float* x = x_in_row(p, which == 0 ? l : 2, row);
#pragma unroll
    for (int i = 0; i < 4; ++i) v[h][i] = *(const f32x4*)(x + i * 256 + lane * 4);
  }
#pragma unroll
  for (int h = 0; h < 2; ++h) {
#pragma unroll
    for (int i = 0; i < 4; ++i) ss[h] += v[h][i].x * v[h][i].x + v[h][i].y * v[h][i].y + v[h][i].z * v[h][i].z + v[h][i].w * v[h][i].w;
    ss[h] = wave_sum(ss[h]);
  }
#pragma unroll
  for (int h = 0; h < 2; ++h) {
    const int row = item * 8 + wave * 2 + h;
    const float* mod = (const float*)(p->ws + WS_MOD) + (l * 3 + mod_group(row)) * 6144;
    const float* sh = mod + (which == 0 ? 0 : 3072);
    const float* sc = mod + (which == 0 ? 1024 : 4096);
    const float rstd = rsqrtf(ss[h] * (1.f / 1024.f) + 1e-6f);
    u16* H = (u16*)(p->ws + WS_H) + (size_t)row * 1024;
#pragma unroll
    for (int i = 0; i < 4; ++i) {
      int c = i * 256 + lane * 4;
      float4 gg = *(const float4*)(g + c), s1 = *(const float4*)(sc + c), s0 = *(const float4*)(sh + c);
      float y0 = v[h][i].x * rstd * gg.x * (1.f + s1.x) + s0.x, y1 = v[h][i].y * rstd * gg.y * (1.f + s1.y) + s0.y;
      float y2 = v[h][i].z * rstd * gg.z * (1.f + s1.z) + s0.z, y3 = v[h][i].w * rstd * gg.w * (1.f + s1.w) + s0.w;
      *(uint2*)(H + c) = make_uint2(pack2(y0, y1), pack2(y2, y3));
    }
  }
}

DI int lds_byte(int r, int c) {
  int st = (r >> 4) * 2 + (c >> 5), ob = (r & 15) * 64 + (c & 31) * 2;
  return st * 1024 + (ob ^ (((ob >> 9) & 1) << 5));
}
DI void stage_rc(int b, int& R, int& C) {
  int st = b >> 10, sb = b & 1023, swz = sb ^ (((sb >> 9) & 1) << 5);
  R = (st >> 1) * 16 + (swz >> 6);
  C = (st & 1) * 32 + ((swz & 63) >> 1);
}
template <int MT, int NT, bool pre = false>
DI void gemm_acc(f32x4 (&acc)[MT][NT], const u16* __restrict__ A, int lda, const u16* __restrict__ Bt, int ldb, int K, unsigned char* smem,
                 const u16* nxtA = nullptr, int nlda = 0, const u16* nxtB = nullptr, int nldb = 0) {
  constexpr int TA = MT * 32 * 128, TB = NT * 32 * 128, STAGE = TA + TB;
  static_assert(2 * STAGE <= 65536, "LDS");
  const int tid = ltid(), lane = tid & 63, wid = tid >> 6, wm = wid >> 1, wn = wid & 1;
  const int fr = lane & 15, fq = lane >> 4;
  const u16* ga[MT]; const u16* gb[NT];
#pragma unroll
  for (int i = 0; i < MT; ++i) { int R, C; stage_rc(wid * 1024 + i * 4096 + lane * 16, R, C); ga[i] = A + (size_t)R * lda + C; }
#pragma unroll
  for (int i = 0; i < NT; ++i) { int R, C; stage_rc(wid * 1024 + i * 4096 + lane * 16, R, C); gb[i] = Bt + (size_t)R * ldb + C; }
#define GLDS_STAGE(buf, k0)                                                                                                        \
  do {                                                                                                                             \
    _Pragma("unroll") for (int i = 0; i < MT; ++i)                                                                                 \
      __builtin_amdgcn_global_load_lds((const unsigned*)(ga[i] + (k0)), (unsigned*)(smem + (buf) * STAGE + wid * 1024 + i * 4096), 16, 0, 0); \
    _Pragma("unroll") for (int i = 0; i < NT; ++i)                                                                                 \
      __builtin_amdgcn_global_load_lds((const unsigned*)(gb[i] + (k0)), (unsigned*)(smem + (buf) * STAGE + TA + wid * 1024 + i * 4096), 16, 0, 0); \
  } while (0)
  if (!pre) {
    __syncthreads();
    GLDS_STAGE(0, 0);
  }
  asm volatile("s_waitcnt vmcnt(0)" ::: "memory");
  __syncthreads();
  const int nt = K >> 6;
  for (int t = 0; t < nt; ++t) {
    const int cur = t & 1;
    if (t + 1 < nt) GLDS_STAGE(cur ^ 1, (t + 1) * 64);
    const unsigned char* sA = smem + cur * STAGE;
    const unsigned char* sB = sA + TA;
    if constexpr (!pre) {
      bf16x8 bfr[2][NT], af[2][MT];
#pragma unroll
      for (int s = 0; s < 2; ++s) {
#pragma unroll
        for (int j = 0; j < NT; ++j) bfr[s][j] = *(const bf16x8*)(sB + lds_byte(wn * NT * 16 + j * 16 + fr, s * 32 + fq * 8));
#pragma unroll
        for (int i = 0; i < MT; ++i) af[s][i] = *(const bf16x8*)(sA + lds_byte(wm * MT * 16 + i * 16 + fr, s * 32 + fq * 8));
      }
#pragma unroll
      for (int s = 0; s < 2; ++s)
#pragma unroll
        for (int i = 0; i < MT; ++i)
#pragma unroll
          for (int j = 0; j < NT; ++j) acc[i][j] = MFMA16(bfr[s][j], af[s][i], acc[i][j]);
      __builtin_amdgcn_sched_group_barrier(0x100, MT + NT, 0);
#pragma unroll
      for (int q = 0; q < MT + NT; ++q) { __builtin_amdgcn_sched_group_barrier(0x008, 2, 0); __builtin_amdgcn_sched_group_barrier(0x100, 1, 0); }
      __builtin_amdgcn_sched_group_barrier(0x008, 2 * MT * NT - 2 * (MT + NT), 0);
    } else {
#pragma unroll
      for (int s = 0; s < 2; ++s) {
        bf16x8 bfr[NT], af[MT];
#pragma unroll
        for (int j = 0; j < NT; ++j) bfr[j] = *(const bf16x8*)(sB + lds_byte(wn * NT * 16 + j * 16 + fr, s * 32 + fq * 8));
#pragma unroll
        for (int i = 0; i < MT; ++i) af[i] = *(const bf16x8*)(sA + lds_byte(wm * MT * 16 + i * 16 + fr, s * 32 + fq * 8));
#pragma unroll
        for (int i = 0; i < MT; ++i)
#pragma unroll
          for (int j = 0; j < NT; ++j) acc[i][j] = MFMA16(bfr[j], af[i], acc[i][j]);
      }
    }
    asm volatile("s_waitcnt vmcnt(0)" ::: "memory");
    __syncthreads();
  }
  if (nxtA) {
#pragma unroll
    for (int i = 0; i < MT; ++i) { int R, C; stage_rc(wid * 1024 + i * 4096 + lane * 16, R, C);
      __builtin_amdgcn_global_load_lds((const unsigned*)(nxtA + (unsigned)(R * nlda + C)), (unsigned*)(smem + wid * 1024 + i * 4096), 16, 0, 0); }
#pragma unroll
    for (int i = 0; i < NT; ++i) { int R, C; stage_rc(wid * 1024 + i * 4096 + lane * 16, R, C);
      __builtin_amdgcn_global_load_lds((const unsigned*)(nxtB + (unsigned)(R * nldb + C)), (unsigned*)(smem + TA + wid * 1024 + i * 4096), 16, 0, 0); }
  }
#undef GLDS_STAGE
}

template <int MT, int NT>
DI void gemm_prefetch(const u16* A, int lda, const u16* Bt, int ldb, unsigned char* smem) {
  constexpr int TA = MT * 32 * 128;
  const int tid = ltid(), lane = tid & 63, wid = tid >> 6;
  __syncthreads();
#pragma unroll
  for (int i = 0; i < MT; ++i) { int R, C; stage_rc(wid * 1024 + i * 4096 + lane * 16, R, C);
    __builtin_amdgcn_global_load_lds((const unsigned*)(A + (unsigned)(R * lda + C)), (unsigned*)(smem + wid * 1024 + i * 4096), 16, 0, 0); }
#pragma unroll
  for (int i = 0; i < NT; ++i) { int R, C; stage_rc(wid * 1024 + i * 4096 + lane * 16, R, C);
    __builtin_amdgcn_global_load_lds((const unsigned*)(Bt + (unsigned)(R * ldb + C)), (unsigned*)(smem + TA + wid * 1024 + i * 4096), 16, 0, 0); }
}

template <int MT, int NT> DI void zero_acc(f32x4 (&acc)[MT][NT]) {
#pragma unroll
  for (int i = 0; i < MT; ++i)
#pragma unroll
    for (int j = 0; j < NT; ++j) acc[i][j] = f32x4{0.f, 0.f, 0.f, 0.f};
}

#define EPI_LOOP(MT, NT)                                                          \
  const int tid_ = ltid(), lane_ = tid_ & 63, wave_ = tid_ >> 6;                   \
  const int wm_ = wave_ >> 1, wn_ = wave_ & 1, lq_ = lane_ & 15, quad_ = lane_ >> 4; \
  _Pragma("unroll") for (int i = 0; i < MT; ++i)                                   \
  _Pragma("unroll") for (int j = 0; j < NT; ++j)
#define EPI_ROW(m0, MT) ((m0) + wm_ * (MT) * 16 + i * 16 + lq_)
#define EPI_COL(n0, NT) ((n0) + wn_ * (NT) * 16 + j * 16 + quad_ * 4)

constexpr int GMT = 4;
DI void inproj_item(KP p, int mt, int nt, unsigned char* smem) {
  const int m0 = mt * (GMT * 32), n0 = nt * 128;
  f32x4 acc[GMT][4]; zero_acc<GMT, 4>(acc);
  gemm_acc<GMT, 4>(acc, (const u16*)(p->ws + WS_H) + (size_t)m0 * 1024, 1024, (const u16*)(p->ws + WS_WIN) + (size_t)n0 * 1024, 1024, 1024, smem);
  u16* C = (u16*)(p->ws + WS_INPROJ);
  EPI_LOOP(GMT, 4) { int row = EPI_ROW(m0, GMT), col = EPI_COL(n0, 4); if (col < LDI) *(uint2*)(C + (size_t)row * LDI + col) = make_uint2(pack2(acc[i][j][0], acc[i][j][1]), pack2(acc[i][j][2], acc[i][j][3])); }
}

DI void merge_item(KP p, int l, int mt, int nt, unsigned char* smem) {
  const int m0 = mt * 128, n0 = nt * 128;
  const u16* H = (const u16*)(p->ws + WS_H) + (size_t)m0 * 1024;
  const u16* BR = (const u16*)(p->ws + WS_BRANCH) + (size_t)m0 * 1024;
  const float* bm = p->in[33] + l * 4096;
  const u16* WM = (const u16*)(p->ws + WS_WM) + (size_t)n0 * 1024;
  const u16* WB = (const u16*)(p->ws + WS_WB) + (size_t)n0 * 256;
  unsigned am[4][4][2];
#pragma unroll
  for (int i = 0; i < 4; ++i)
#pragma unroll
    for (int j = 0; j < 4; ++j) { am[i][j][0] = 0u; am[i][j][1] = 0u; }
  gemm_prefetch<4, 4>(BR, 1024, WB, 256, smem);
#pragma unroll 1
  for (int m = 0; m < 4; ++m) {
    f32x4 acc[4][4]; zero_acc<4, 4>(acc);
    gemm_acc<4, 4, true>(acc, BR + m * 256, 1024, WB + (size_t)m * 1024 * 256, 256, 256, smem, H, 1024, WM + (size_t)m * 1024 * 1024, 1024);
    unsigned pp[4][4][2];
#pragma unroll
    for (int i = 0; i < 4; ++i)
#pragma unroll
      for (int j = 0; j < 4; ++j) { pp[i][j][0] = pack2(acc[i][j][0], acc[i][j][1]); pp[i][j][1] = pack2(acc[i][j][2], acc[i][j][3]); }
    zero_acc<4, 4>(acc);
    gemm_acc<4, 4, true>(acc, H, 1024, WM + (size_t)m * 1024 * 1024, 1024, 1024, smem,
                         m < 3 ? BR + (m + 1) * 256 : nullptr, 1024, WB + (size_t)(m + 1) * 1024 * 256, 256);
    {
      const int tid_ = ltid(), wn_ = (tid_ >> 6) & 1, quad_ = (tid_ & 63) >> 4;
      float4 bias4[4];
#pragma unroll
      for (int j = 0; j < 4; ++j) bias4[j] = *(const float4*)(bm + m * 1024 + n0 + wn_ * 64 + j * 16 + quad_ * 4);
#pragma unroll
      for (int i = 0; i < 4; ++i) {
#pragma unroll
        for (int j = 0; j < 4; ++j) {
          float v0 = bflo(am[i][j][0]) + sigm(acc[i][j][0] + bias4[j].x) * bflo(pp[i][j][0]);
          float v1 = bfhi(am[i][j][0]) + sigm(acc[i][j][1] + bias4[j].y) * bfhi(pp[i][j][0]);
          float v2 = bflo(am[i][j][1]) + sigm(acc[i][j][2] + bias4[j].z) * bflo(pp[i][j][1]);
          float v3 = bfhi(am[i][j][1]) + sigm(acc[i][j][3] + bias4[j].w) * bfhi(pp[i][j][1]);
          am[i][j][0] = pack2(v0, v1); am[i][j][1] = pack2(v2, v3);
          asm volatile("" : "+v"(am[i][j][0]), "+v"(am[i][j][1]));
          __builtin_amdgcn_sched_barrier(0);
        }
      }
    }
  }
  u16* C = (u16*)(p->ws + WS_MERGED);
  EPI_LOOP(4, 4) { int row = EPI_ROW(m0, 4), col = EPI_COL(n0, 4); *(uint2*)(C + (size_t)row * 1024 + col) = make_uint2(am[i][j][0], am[i][j][1]); }
}

DI void wout_item(KP p, int l, int mt, int nt, unsigned char* smem) {
  const int m0 = mt * (GMT * 32), n0 = nt * 128;
  f32x4 acc[GMT][4]; zero_acc<GMT, 4>(acc);
  gemm_acc<GMT, 4>(acc, (const u16*)(p->ws + WS_MERGED) + (size_t)m0 * 1024, 1024, (const u16*)(p->ws + WS_WO) + (size_t)n0 * 1024, 1024, 1024, smem);
  const float* g1 = (const float*)(p->ws + WS_MOD) + (l * 3 + mod_group(m0)) * 6144 + 2048;
  EPI_LOOP(GMT, 4) { int row = EPI_ROW(m0, GMT), col = EPI_COL(n0, 4); const float4 xv = *(const float4*)(x_in_row(p, l, row) + col), gv = *(const float4*)(g1 + col);
    *(float4*)(p->out + (size_t)row * DM + col) = make_float4(xv.x + gv.x * acc[i][j][0], xv.y + gv.y * acc[i][j][1], xv.z + gv.z * acc[i][j][2], xv.w + gv.w * acc[i][j][3]); }
}

DI void w1_item(KP p, int mt, int nt, unsigned char* smem) {
  const int m0 = mt * (GMT * 32), n0 = nt * 128;
  f32x4 acc[GMT][4]; zero_acc<GMT, 4>(acc);
  gemm_acc<GMT, 4>(acc, (const u16*)(p->ws + WS_H) + (size_t)m0 * 1024, 1024, (const u16*)(p->ws + WS_W1) + (size_t)n0 * 1024, 1024, 1024, smem);
  u16* C = (u16*)(p->ws + WS_HIDDEN);
  EPI_LOOP(GMT, 4) { int row = EPI_ROW(m0, GMT), col = EPI_COL(n0, 4); const float v0 = fmaxf(acc[i][j][0], 0.f), v1 = fmaxf(acc[i][j][1], 0.f), v2 = fmaxf(acc[i][j][2], 0.f), v3 = fmaxf(acc[i][j][3], 0.f);
    *(uint2*)(C + (size_t)row * 4096 + col) = make_uint2(pack2(v0 * v0, v1 * v1), pack2(v2 * v2, v3 * v3)); }
}

DI void w2_item(KP p, int l, int mt, int nt, unsigned char* smem) {
  const int m0 = mt * (GMT * 32), n0 = nt * 128;
  f32x4 acc[GMT][4]; zero_acc<GMT, 4>(acc);
  gemm_acc<GMT, 4>(acc, (const u16*)(p->ws + WS_HIDDEN) + (size_t)m0 * 4096, 4096, (const u16*)(p->ws + WS_W2) + (size_t)n0 * 4096, 4096, 4096, smem);
  const float* g2 = (const float*)(p->ws + WS_MOD) + (l * 3 + mod_group(m0)) * 6144 + 5120;
  EPI_LOOP(GMT, 4) { int row = EPI_ROW(m0, GMT), col = EPI_COL(n0, 4); float4* o = (float4*)(p->out + (size_t)row * DM + col); const float4 xv = *o, gv = *(const float4*)(g2 + col);
    *o = make_float4(xv.x + gv.x * acc[i][j][0], xv.y + gv.y * acc[i][j][1], xv.z + gv.z * acc[i][j][2], xv.w + gv.w * acc[i][j][3]); }
}

DI void prep_load(const u16* R, int lane, float (&hv)[12], float (&vv4)[4]) {
#pragma unroll
  for (int hh = 0; hh < 12; ++hh) {
    const int col = hh < 4 ? C_AQ + hh * 64 : (hh < 6 ? C_AK + (hh - 4) * 64 : (hh < 10 ? C_DQ + (hh - 6) * 64 : C_DK + (hh - 10) * 64));
    hv[hh] = bf2f(R[col + lane]);
  }
  vv4[0] = bf2f(R[C_AV + lane]); vv4[1] = bf2f(R[C_AV + 64 + lane]); vv4[2] = bf2f(R[C_DV + lane]); vv4[3] = bf2f(R[C_DV + 64 + lane]);
}
DI void prep_token(KP p, int l, int row, int lane, u16* R, const float (&hv)[12], const float (&vv4)[4]) {
  const bool lat = row >= 8192;
  float cs = 1.f, sn = 0.f;
  if (lat) {
    int t = (row - 8192) & 4095;
    int pos = (lane < 32) ? (t >> 6) : (t & 63);
    float inv = __expf(-(float)(lane & 15) * (9.210340371976184f / 16.f));
    float ang = (float)pos * inv;
    cs = __cosf(ang); sn = __sinf(ang);
  }
  const int b = row >> 8, t = row & 255;
#pragma unroll
  for (int hh = 0; hh < 12; ++hh) {
    int col; const float* g;
    if (hh < 4) { col = C_AQ + hh * 64; g = p->in[15] + l * 64; }
    else if (hh < 6) { col = C_AK + (hh - 4) * 64; g = p->in[16] + l * 64; }
    else if (hh < 10) { col = C_DQ + (hh - 6) * 64; g = p->in[29] + l * 64; }
    else { col = C_DK + (hh - 10) * 64; g = p->in[30] + l * 64; }
    float v = hv[hh];
    float ss = wave_sum(v * v);
    float y = v * rsqrtf(ss * (1.f / 64.f) + 1e-6f) * g[lane];
    if (lat) {
      float yp = xor16_partner(y, lane);
      y = ((lane & 31) < 16) ? (y * cs - yp * sn) : (y * cs + yp * sn);
    } else {
      if (hh == 4 || hh == 5) p->out[O_AK + ((size_t)(b * 2 + l) * 256 + t) * 128 + (hh - 4) * 64 + lane] = y;
      if (hh >= 10) p->out[O_DK + ((size_t)(b * 2 + l) * 256 + t) * 128 + (hh - 10) * 64 + lane] = y;
    }
    R[col + lane] = f2bf(y);
  }
  if (lat) {
    const int bl = (row - 8192) >> 12, tl = (row - 8192) & 4095;
    u16* VT = (u16*)(p->ws + WS_VT) + (size_t)lane * 4608 + 512 + tl;
#pragma unroll
    for (int q = 0; q < 4; ++q)
      VT[(size_t)(((q >> 1) * 2 + bl) * 2 + (q & 1)) * 64 * 4608] = f2bf(vv4[q]);
  }
  if (!lat) {
    size_t o = ((size_t)(b * 2 + l) * 256 + t) * 128;
    p->out[O_AV + o + lane] = vv4[0]; p->out[O_AV + o + 64 + lane] = vv4[1];
    p->out[O_DV + o + lane] = vv4[2]; p->out[O_DV + o + 64 + lane] = vv4[3];
  }
}
DI void prep_item(KP p, int l, int item) {
  const int tid = ltid(), lane = tid & 63, wave = tid >> 6;
  const int row0 = item * 8 + wave * 2;
  u16* R0 = (u16*)(p->ws + WS_INPROJ) + (size_t)row0 * LDI;
  u16* R1 = R0 + LDI;
  float hv0[12], vv0[4], hv1[12], vv1[4];
  prep_load(R0, lane, hv0, vv0); prep_load(R1, lane, hv1, vv1);
  prep_token(p, l, row0, lane, R0, hv0, vv0);
  prep_token(p, l, row0 + 1, lane, R1, hv1, vv1);
}

DI void kvc_item(KP p, int l, int item) {
  u16* KC = (u16*)(p->ws + WS_KC);
#pragma unroll
  for (int it = 0; it < 8; ++it) {
    int idx4 = item * 2048 + it * 256 + ltid();
    int e = idx4 * 4;
    int d = e & 63, key = (e >> 6) & 511, sel = e >> 15;
    int kv = sel & 1, kvh = (sel >> 1) & 1, b = (sel >> 2) & 1, mixer = sel >> 3;
    const float* srcb = mixer ? (kv ? p->in[6] : p->in[5]) : (kv ? p->in[4] : p->in[3]);
    const float* src = srcb + ((size_t)((b * 2 + l) * 512 + key) * 2 + kvh) * 64 + d;
    float4 v = *(const float4*)src;
    *(uint2*)(KC + e) = make_uint2(pack2(v.x, v.y), pack2(v.z, v.w));
    if (kv) {
      u16* VT = (u16*)(p->ws + WS_VT) + ((size_t)((mixer * 2 + b) * 2 + kvh) * 64 + d) * 4608 + key;
      VT[0] = f2bf(v.x); VT[4608] = f2bf(v.y); VT[2 * 4608] = f2bf(v.z); VT[3 * 4608] = f2bf(v.w);
    }
  }
}

DI void attn_item(KP p, int l, int it, unsigned char* smem) {
  u16* sK = (u16*)smem;
  u16* sVt = sK + 64 * 72;
  const int tid = ltid(), lane = tid & 63, wave = tid >> 6, lq = lane & 15, quad = lane >> 4;
  int kind, b, qh, qb;
  if (it < 512) { kind = it >> 8; int r = it & 255; b = r >> 7; qh = (r >> 5) & 3; qb = r & 31; }
  else { int r = it - 512; kind = 2 + (r >> 8); r &= 255; b = r >> 3; qh = (r >> 1) & 3; qb = r & 1; }
  const bool isD = (kind == 0 || kind == 3), lat = kind < 2;
  const int seqrow0 = lat ? 8192 + b * 4096 : b * 256;
  const int q0 = qb * 128, kvh = qh >> 1;
  const int qcol = (isD ? C_DQ : C_AQ) + qh * 64, kcol = (isD ? C_DK : C_AK) + kvh * 64, vcol = (isD ? C_DV : C_AV) + kvh * 64;
  const int ocol = (isD ? 768 : 0) + qh * 64;
  const int ncache = lat ? 8 : 0;
  int kt_lo = 0, kt_hi = lat ? 64 : 4;
  if (kind == 1) { kt_lo = max(0, 2 * qb - 2); kt_hi = min(64, 2 * qb + 4); }
  const int ntiles = ncache + kt_hi - kt_lo;
  const bool band = (kind == 1);
  const u16* INP = (const u16*)(p->ws + WS_INPROJ);
  const u16* KCk = (const u16*)(p->ws + WS_KC) + (size_t)((((isD ? 1 : 0) * 2 + b) * 2 + kvh) * 2) * 512 * 64;
  const u16* KCv = KCk + 512 * 64;
  constexpr float SC2 = 0.125f * 1.4426950408889634f;
  const float sinkv = isD ? -1e30f : p->in[17][l * 4 + qh] * 1.4426950408889634f;

  bf16x8 qf[2][2];
#pragma unroll
  for (int nt = 0; nt < 2; ++nt)
#pragma unroll
    for (int s = 0; s < 2; ++s) qf[nt][s] = ld8(INP + (size_t)(seqrow0 + q0 + wave * 32 + nt * 16 + lq) * LDI + qcol + s * 32 + quad * 8);
  float mrun[2], lsum[2];
  f32x4 oacc[4][2];
#pragma unroll
  for (int nt = 0; nt < 2; ++nt) { mrun[nt] = sinkv; lsum[nt] = (!isD && quad == 0) ? 1.f : 0.f; }
#pragma unroll
  for (int dt = 0; dt < 4; ++dt)
#pragma unroll
    for (int nt = 0; nt < 2; ++nt) oacc[dt][nt] = f32x4{0.f, 0.f, 0.f, 0.f};

  const int key = tid >> 2, seg = (tid & 3) * 16;
  struct KVReg { u32x4 k[2], v[2]; };
  KVReg R0, R1;
  const u16* VTp = (const u16*)(p->ws + WS_VT) + ((size_t)(((isD ? 1 : 0) * 2 + b) * 2 + kvh) * 64 + key) * 4608 + seg;
  auto tile_ptrs = [&](int t, const u16*& kp, const u16*& vp) {
    if (t < ncache) { kp = KCk + (size_t)(t * 64 + key) * 64 + seg; vp = VTp + t * 64; }
    else {
      const u16* rowp = INP + (size_t)(seqrow0 + (kt_lo + t - ncache) * 64 + key) * LDI; kp = rowp + kcol + seg;
      vp = lat ? VTp + 512 + (kt_lo + t - ncache) * 64 : rowp + vcol + seg;
    }
  };
  auto kvload = [&](int t, KVReg& R) {
    const u16 *kp, *vp; tile_ptrs(t, kp, vp);
    R.k[0] = *(const u32x4*)kp; R.k[1] = *(const u32x4*)(kp + 8); R.v[0] = *(const u32x4*)vp; R.v[1] = *(const u32x4*)(vp + 8);
  };
  kvload(0, R0);
  if (ntiles > 1) kvload(1, R1);
  auto step = [&](int t, KVReg& R) {
    __syncthreads();
    *(u32x4*)(sK + key * 72 + seg) = R.k[0]; *(u32x4*)(sK + key * 72 + seg + 8) = R.k[1];
    if (lat) {
      *(u32x4*)(sVt + key * 72 + seg) = R.v[0]; *(u32x4*)(sVt + key * 72 + seg + 8) = R.v[1];
    } else {
      unsigned vv[8] = {R.v[0].x, R.v[0].y, R.v[0].z, R.v[0].w, R.v[1].x, R.v[1].y, R.v[1].z, R.v[1].w};
#pragma unroll
      for (int e = 0; e < 8; ++e) { sVt[(seg + 2 * e) * 72 + key] = (u16)(vv[e] & 0xffffu); sVt[(seg + 2 * e + 1) * 72 + key] = (u16)(vv[e] >> 16); }
    }
    __syncthreads();
    if (t + 2 < ntiles) kvload(t + 2, R);
    f32x4 sacc[4][2];
#pragma unroll
    for (int mt = 0; mt < 4; ++mt) {
      sacc[mt][0] = f32x4{0.f, 0.f, 0.f, 0.f}; sacc[mt][1] = f32x4{0.f, 0.f, 0.f, 0.f};
#pragma unroll
      for (int s = 0; s < 2; ++s) {
        bf16x8 ka = ld8(sK + (mt * 16 + lq) * 72 + s * 32 + quad * 8);
        sacc[mt][0] = MFMA16(ka, qf[0][s], sacc[mt][0]);
        sacc[mt][1] = MFMA16(ka, qf[1][s], sacc[mt][1]);
      }
    }
    const bool masked_tile = band && t >= ncache;
    const int kbase = (kt_lo + t - ncache) * 64;
    bf16x8 pf[2][2];
#pragma unroll
    for (int nt = 0; nt < 2; ++nt) {
      const int qi = q0 + wave * 32 + nt * 16 + lq;
      float tmax = -1e30f;
#pragma unroll
      for (int mt = 0; mt < 4; ++mt)
#pragma unroll
        for (int r = 0; r < 4; ++r) {
          float sv_ = sacc[mt][nt][r] * SC2;
          if (masked_tile) { int kj = kbase + mt * 16 + quad * 4 + r; int dlt = qi - kj; if (dlt > 128 || dlt < -128) sv_ = -1e30f; }
          sacc[mt][nt][r] = sv_; tmax = fmaxf(tmax, sv_);
        }
      tmax = xrow32_max(xrow16_max(tmax));
      const float mold = mrun[nt];
      const float mnew = fmaxf(mold, tmax);
      float ps = 0.f;
#pragma unroll
      for (int mt = 0; mt < 4; ++mt)
#pragma unroll
        for (int r = 0; r < 4; ++r) { float e = __builtin_amdgcn_exp2f(sacc[mt][nt][r] - mnew); sacc[mt][nt][r] = e; ps += e; }
      if (__any(mnew != mold)) {
        const float alpha = __builtin_amdgcn_exp2f(mold - mnew);
        lsum[nt] *= alpha;
#pragma unroll
        for (int dt = 0; dt < 4; ++dt)
#pragma unroll
          for (int r = 0; r < 4; ++r) oacc[dt][nt][r] *= alpha;
      }
      lsum[nt] += ps; mrun[nt] = mnew;
      pf[nt][0] = pack8(sacc[0][nt], sacc[1][nt]);
      pf[nt][1] = pack8(sacc[2][nt], sacc[3][nt]);
    }
#pragma unroll
    for (int dt = 0; dt < 4; ++dt)
#pragma unroll
      for (int s2 = 0; s2 < 2; ++s2) {
        bf16x8 va = ldperm(sVt + (dt * 16 + lq) * 72 + s2 * 32 + quad * 4);
        oacc[dt][0] = MFMA16(va, pf[0][s2], oacc[dt][0]);
        oacc[dt][1] = MFMA16(va, pf[1][s2], oacc[dt][1]);
      }
  };
  for (int t = 0; t < ntiles; t += 2) { step(t, R0); if (t + 1 < ntiles) step(t + 1, R1); }
  u16* BR = (u16*)(p->ws + WS_BRANCH);
#pragma unroll
  for (int nt = 0; nt < 2; ++nt) {
    float lt = xrow32_sum(xrow16_sum(lsum[nt]));
    const float inv = __builtin_amdgcn_rcpf(lt);
    const size_t row = seqrow0 + q0 + wave * 32 + nt * 16 + lq;
#pragma unroll
    for (int dt = 0; dt < 4; ++dt)
      *(uint2*)(BR + row * 1024 + ocol + dt * 16 + quad * 4) = make_uint2(pack2(oacc[dt][nt][0] * inv, oacc[dt][nt][1] * inv), pack2(oacc[dt][nt][2] * inv, oacc[dt][nt][3] * inv));
  }
  __syncthreads();
}

DI int lru_xoff(int t, int c) { return t * 256 + (c ^ ((t & 7) << 3)); }
template <bool FINAL>
DI void lru_item(KP p, int l, int ci, unsigned char* smem) {
  u16* sxb = (u16*)smem;
  u16* sla = sxb + 32 * 256;
  u16* sbv = sla + 32 * 256;
  u16* shf = sbv + 32 * 256;
  const int tid = ltid(), ch = tid, lane = tid & 63, n = tid >> 6, lq = lane & 15, quad = lane >> 4;
  const int r0 = ci * 32;
  const bool lat = r0 >= 8192;
  int b, T, seqrow0;
  if (!lat) { b = r0 >> 8; T = 256; seqrow0 = b * 256; } else { b = (r0 - 8192) >> 12; T = 4096; seqrow0 = 8192 + b * 4096; }
  const int t0 = r0 - seqrow0;
  const u16* INP = (const u16*)(p->ws + WS_INPROJ);
  __syncthreads();
  {
    const float* cw = p->in[18] + l * 4 * 256;
    const float w0 = cw[ch], w1 = cw[256 + ch], w2 = cw[512 + ch], w3 = cw[768 + ch], cb = p->in[19][l * 256 + ch];
    auto ld = [&](int t) -> float { return (t >= 0 && t < T) ? bf2f(INP[(size_t)(seqrow0 + t) * LDI + C_LX + ch]) : 0.f; };
    float xin[35];
#pragma unroll
    for (int q = 0; q < 35; ++q) xin[q] = ld(t0 - 2 + q);
#pragma unroll
    for (int t = 0; t < 32; ++t) sxb[lru_xoff(t, ch)] = f2bf(xin[t] * w0 + xin[t + 1] * w1 + xin[t + 2] * w2 + xin[t + 3] * w3 + cb);
  }
  __syncthreads();
  const int nch = T / 32, c = t0 / 32;
  float* LC = (float*)(p->ws + WS_LRUC);
  bf16x8 af[2][2];
#pragma unroll
  for (int mt = 0; mt < 2; ++mt)
#pragma unroll
    for (int s2 = 0; s2 < 2; ++s2) af[mt][s2] = ld8(sxb + lru_xoff(mt * 16 + lq, n * 64 + s2 * 32 + quad * 8));
  for (int dir = 0; dir < 2; ++dir) {
    bf16x8 wf[2][4][2];
    {
      const u32x4* WF = (const u32x4*)(p->ws + WS_LRUW);
#pragma unroll
      for (int g = 0; g < 2; ++g)
#pragma unroll
        for (int j = 0; j < 4; ++j)
#pragma unroll
          for (int s2 = 0; s2 < 2; ++s2)
            wf[g][j][s2] = __builtin_bit_cast(bf16x8, WF[(size_t)((((((l * 2 + dir) * 2 + g) * 4 + n) * 4 + j) * 2 + s2)) * 64 + lane]);
    }
#pragma unroll
    for (int j = 0; j < 4; ++j) {
      f32x4 acc[2][2];
#pragma unroll
      for (int g = 0; g < 2; ++g) {
        f32x4 a0 = {0.f, 0.f, 0.f, 0.f}, a1 = {0.f, 0.f, 0.f, 0.f};
#pragma unroll
        for (int s2 = 0; s2 < 2; ++s2) { a0 = MFMA16(af[0][s2], wf[g][j][s2], a0); a1 = MFMA16(af[1][s2], wf[g][j][s2], a1); }
        acc[g][0] = a0; acc[g][1] = a1;
      }
      const int cc = n * 64 + j * 16 + lq;
      const float br = p->in[21][(l * 2 + dir) * 256 + cc], bi = p->in[23][(l * 2 + dir) * 256 + cc];
      const float sp = softplusf_(-p->in[24][(l * 2 + dir) * 256 + cc]);
#pragma unroll
      for (int mt = 0; mt < 2; ++mt)
#pragma unroll
        for (int r = 0; r < 4; ++r) {
          const int t = mt * 16 + quad * 4 + r;
          const float la = -8.f * sigm(acc[0][mt][r] + br) * sp;
          const float xt = bf2f(sxb[lru_xoff(t, cc)]);
          const float bb = __builtin_amdgcn_sqrtf(1.f - __expf(2.f * la)) * sigm(acc[1][mt][r] + bi) * xt;
          sla[t * 256 + cc] = f2bf(la); sbv[t * 256 + cc] = f2bf(bb);
        }
    }
    __syncthreads();
    float h = 0.f, lasum = 0.f;
    if (FINAL) {
      h = lat ? p->in[7][((b * 2 + l) * 2 + dir) * 256 + ch] : 0.f;
      const int ncar = dir == 0 ? c : nch - 1 - c;
      const int cstart = dir == 0 ? ci - c : ci - c + nch - 1, cstep = dir == 0 ? 1 : -1;
      for (int q0 = 0; q0 < ncar; q0 += 16) {
        float ca[16], chh[16];
#pragma unroll
        for (int q = 0; q < 16; ++q) {
          const int qq = q0 + q < ncar ? q0 + q : ncar - 1;
          const float* C = LC + ((size_t)((cstart + cstep * qq) * 2 + dir) * 2) * 256;
          ca[q] = C[ch]; chh[q] = C[256 + ch];
        }
#pragma unroll
        for (int q = 0; q < 16; ++q) if (q0 + q < ncar) h = ca[q] * h + chh[q];
      }
    }
#pragma unroll 1
    for (int s8 = 0; s8 < 32; s8 += 16) {
      float gv[16];
      if (FINAL && dir == 1) {
#pragma unroll
        for (int q = 0; q < 16; ++q) gv[q] = bf2f(INP[(size_t)(r0 + 31 - s8 - q) * LDI + C_LG + ch]);
      }
#pragma unroll
      for (int q = 0; q < 16; ++q) {
        const int st = s8 + q;
        const int t = dir == 0 ? st : 31 - st;
        const float la = bf2f(sla[t * 256 + ch]);
        h = __expf(la) * h + bf2f(sbv[t * 256 + ch]);
        lasum += la;
        if (FINAL) {
          if (dir == 0) shf[t * 256 + ch] = f2bf(h);
          else ((u16*)(p->ws + WS_BRANCH))[(size_t)(r0 + t) * 1024 + 256 + ch] = f2bf((bf2f(shf[t * 256 + ch]) + h) * gelu_tanh(gv[q]));
        }
      }
    }
    if (!FINAL) { float* C = LC + ((size_t)(ci * 2 + dir) * 2) * 256; C[ch] = __expf(lasum); C[256 + ch] = h; }
    else if (!lat) {
      if (dir == 0 && c == nch - 1) p->out[O_LRU + ((size_t)(b * 2 + l) * 2 + 0) * 256 + ch] = h;
      if (dir == 1 && c == 0) p->out[O_LRU + ((size_t)(b * 2 + l) * 2 + 1) * 256 + ch] = h;
    }
    __syncthreads();
  }
}

template <int DIR, bool ISW>
DI void gdn_solve(const float* L, const u16* src, const float* sb_, const float* se_, u16* UW) {
  float sol[64];
#pragma unroll
  for (int i = 0; i < 64; ++i) {
    float s = bf2f(src[(DIR == 0 ? i : 63 - i) * 72]) * sb_[i];
    if (ISW) s *= se_[i];
    float s0 = 0.f, s1 = 0.f, s2 = 0.f, s3 = 0.f;
#pragma unroll
    for (int j4 = 0; j4 < (i + 3) / 4; ++j4) {
      float4 lv = *(const float4*)(L + i * 64 + j4 * 4);
      if (j4 * 4 + 0 < i) s0 += lv.x * sol[j4 * 4 + 0];
      if (j4 * 4 + 1 < i) s1 += lv.y * sol[j4 * 4 + 1];
      if (j4 * 4 + 2 < i) s2 += lv.z * sol[j4 * 4 + 2];
      if (j4 * 4 + 3 < i) s3 += lv.w * sol[j4 * 4 + 3];
      if ((j4 & 3) == 3) asm volatile("" ::: "memory");
    }
    s -= (s0 + s1) + (s2 + s3);
    sol[i] = s;
    UW[i * 128] = f2bf(s);
    asm volatile("" ::: "memory");
  }
}

DI void gdn1_item(KP p, int l, int item, unsigned char* smem) {
  const int cgi = item >> 2, hd = item & 3;
  u16* sq = (u16*)smem; u16* sk = sq + 64 * 72; u16* sv = sk + 64 * 72;
  float* sL = (float*)(smem + 27648);
  float* sgc = (float*)(smem + 60416);
  float* sbeta = sgc + 128;
  float* sge = sbeta + 128;
  const int tid = ltid(), lane = tid & 63, wave = tid >> 6, lq = lane & 15, quad = lane >> 4;
  const int r0 = cgi * 64;
  const bool lat = r0 >= 8192;
  int T, seqrow0;
  if (!lat) { T = 256; seqrow0 = (r0 >> 8) * 256; } else { T = 4096; seqrow0 = 8192 + ((r0 - 8192) >> 12) * 4096; }
  const int t0 = r0 - seqrow0;
  const u16* INP = (const u16*)(p->ws + WS_INPROJ);
  u16* QHAT = (u16*)(p->ws + WS_QHAT) + (size_t)item * 4096;
  {
    const int d = lane, tb = wave * 16;
#pragma unroll
    for (int mat = 0; mat < 3; ++mat) {
      const int col = C_GQ + mat * 256 + hd * 64 + d, wc = mat * 256 + hd * 64 + d;
      const float* cw = p->in[25] + (size_t)l * 4 * 768;
      const float w0 = cw[wc], w1 = cw[768 + wc], w2 = cw[1536 + wc], w3 = cw[2304 + wc];
      auto ld = [&](int t) -> float { return (t >= 0 && t < T) ? bf2f(INP[(size_t)(seqrow0 + t) * LDI + col]) : 0.f; };
      float xin[19];
#pragma unroll
      for (int q = 0; q < 19; ++q) xin[q] = ld(t0 + tb - 2 + q);
      u16* dst = mat == 0 ? sq : (mat == 1 ? sk : sv);
#pragma unroll
      for (int tt = 0; tt < 16; ++tt) {
        const int t = tb + tt;
        float v = siluf_(xin[tt] * w0 + xin[tt + 1] * w1 + xin[tt + 2] * w2 + xin[tt + 3] * w3);
        if (mat < 2) { float ss = wave_sum(v * v); v *= rsqrtf(ss + 1e-6f) * (mat == 0 ? 0.125f : 1.f); }
        u16 hb = f2bf(v);
        dst[t * 72 + d] = hb;
        if (mat == 0) QHAT[t * 64 + d] = hb;
      }
    }
  }
  if (tid < 128) {
    const int dir = tid >> 6, c = tid & 63;
    const int tok = dir == 0 ? c : 63 - c;
    const u16* R = INP + (size_t)(r0 + tok) * LDI;
    const float ga = bf2f(R[C_GA + dir * 4 + hd]), gb = bf2f(R[C_GB + dir * 4 + hd]);
    const float g = -__expf(p->in[26][(l * 2 + dir) * 4 + hd]) * softplusf_(ga + p->in[27][(l * 2 + dir) * 4 + hd]);
    float gc = g;
#pragma unroll
    for (int o = 1; o < 64; o <<= 1) { float tt = __shfl_up(gc, o, 64); if (lane >= o) gc += tt; }
    const float glast = __shfl(gc, 63, 64);
    sgc[dir * 64 + c] = gc; sbeta[dir * 64 + c] = sigm(gb); sge[dir * 64 + c] = __expf(gc);
    float* gv = (float*)(p->ws + WS_GVEC) + (size_t)(item * 2 + dir) * 256;
    gv[c] = __expf(gc); gv[64 + c] = __expf(glast - gc); if (c == 0) gv[128] = __expf(glast);
  }
  __syncthreads();
  {
    const int dk = tid >> 2, c0 = (tid & 3) * 16;
    unsigned w[8];
#pragma unroll
    for (int e = 0; e < 8; ++e) w[e] = (unsigned)sk[(c0 + 2 * e) * 72 + dk] | ((unsigned)sk[(c0 + 2 * e + 1) * 72 + dk] << 16);
    u16* KT = (u16*)(p->ws + WS_KT) + (size_t)item * 4096 + dk * 64 + c0;
    *(u32x4*)KT = mku4(w[0], w[1], w[2], w[3]); *(u32x4*)(KT + 8) = mku4(w[4], w[5], w[6], w[7]);
  }
  {
    const int i0 = wave * 16;
    f32x4 akk[4], aqk[4];
#pragma unroll
    for (int nt = 0; nt < 4; ++nt) { akk[nt] = f32x4{0.f, 0.f, 0.f, 0.f}; aqk[nt] = f32x4{0.f, 0.f, 0.f, 0.f}; }
#pragma unroll
    for (int s = 0; s < 2; ++s) {
      bf16x8 ak = ld8(sk + (i0 + lq) * 72 + s * 32 + quad * 8), aq = ld8(sq + (i0 + lq) * 72 + s * 32 + quad * 8);
#pragma unroll
      for (int nt = 0; nt < 4; ++nt) { bf16x8 bk = ld8(sk + (nt * 16 + lq) * 72 + s * 32 + quad * 8); akk[nt] = MFMA16(bk, ak, akk[nt]); aqk[nt] = MFMA16(bk, aq, aqk[nt]); }
    }
    u16* QKf = (u16*)(p->ws + WS_QK) + (size_t)(item * 2 + 0) * 4096;
    u16* QKb = (u16*)(p->ws + WS_QK) + (size_t)(item * 2 + 1) * 4096;
    const int i = i0 + lq, ib = 63 - i;
    const float gci = sgc[i], gcbi = sgc[64 + ib], bti = sbeta[i], btbi = sbeta[64 + ib];
#pragma unroll
    for (int nt = 0; nt < 4; ++nt) {
      const int j0 = nt * 16 + quad * 4;
      const float4 gcj = *(const float4*)(sgc + j0), gcbj = *(const float4*)(sgc + 64 + 60 - j0);
      const float gj[4] = {gcj.x, gcj.y, gcj.z, gcj.w};
      const float gbj[4] = {gcbj.w, gcbj.z, gcbj.y, gcbj.x};
      float qf[4], qb[4];
#pragma unroll
      for (int r = 0; r < 4; ++r) {
        const int j = j0 + r, jb = 63 - j;
        const float kkv = akk[nt][r], qkv = aqk[nt][r];
        const float ef = (j <= i) ? __expf(gci - gj[r]) : 0.f;
        const float eb = (j >= i) ? __expf(gcbi - gbj[r]) : 0.f;
        if (j < i) sL[i * 64 + j] = bti * kkv * ef;
        if (j > i) sL[4096 + ib * 64 + jb] = btbi * kkv * eb;
        qf[r] = qkv * ef; qb[r] = qkv * eb;
      }
      *(uint2*)(QKf + i * 64 + j0) = make_uint2(pack2(qf[0], qf[1]), pack2(qf[2], qf[3]));
      *(uint2*)(QKb + ib * 64 + 60 - j0) = make_uint2(pack2(qb[3], qb[2]), pack2(qb[1], qb[0]));
    }
  }
  __syncthreads();
  {
    const int col = tid & 127;
    u16* UW = (u16*)(p->ws + WS_UW) + (size_t)(item * 2 + (tid >> 7)) * 8192 + col;
    for (int rep = 0; rep < NREP(2); ++rep) {
    if (tid < 128) { if (col < 64) gdn_solve<0, false>(sL, sv + col, sbeta, sge, UW); else gdn_solve<0, true>(sL, sk + (col - 64), sbeta, sge, UW); }
    else { if (col < 64) gdn_solve<1, false>(sL + 4096, sv + col, sbeta + 64, sge + 64, UW); else gdn_solve<1, true>(sL + 4096, sk + (col - 64), sbeta + 64, sge + 64, UW); }
    }
  }
  __syncthreads();
}

DI void gdn2_item(KP p, int l, int item, unsigned char* smem) {
  u16* sW = (u16*)smem; u16* sKT = sW + 64 * 72; u16* sU = sKT + 64 * 72;
  float* sg = (float*)(smem + 27648);
  const int tid = ltid(), lane = tid & 63, wave = tid >> 6, lq = lane & 15, quad = lane >> 4;
  int b, hd, dir; bool lat;
  if (item < 16) { lat = true; b = item >> 3; hd = (item >> 1) & 3; dir = item & 1; }
  else { lat = false; int r = item - 16; b = r >> 3; hd = (r >> 1) & 3; dir = r & 1; }
  const int nch = lat ? 64 : 4, cg0 = lat ? 128 + b * 64 : b * 4;
  f32x4 st[4];
#pragma unroll
  for (int kt = 0; kt < 4; ++kt)
#pragma unroll
    for (int r = 0; r < 4; ++r)
      st[kt][r] = lat ? p->in[8][((size_t)(((b * 2 + l) * 2 + dir) * 4 + hd) * 64 + kt * 16 + quad * 4 + r) * 64 + wave * 16 + lq] : 0.f;
  const int lrow = tid >> 2, seg = (tid & 3) * 16;
  struct GReg { u32x4 U[2], W[2], KT[2]; float g; };
  GReg R0, R1;
  u16* UWb = (u16*)(p->ws + WS_UW);
  const u16* KTb = (const u16*)(p->ws + WS_KT);
  const float* GV = (const float*)(p->ws + WS_GVEC);
  auto gload = [&](int n, GReg& R) {
    const int cgi = dir == 0 ? cg0 + n : cg0 + nch - 1 - n;
    const size_t prob = (size_t)cgi * 4 + hd, pd = prob * 2 + dir;
    const u16* u = UWb + (pd * 64 + lrow) * 128 + seg;
    R.U[0] = *(const u32x4*)u; R.U[1] = *(const u32x4*)(u + 8); R.W[0] = *(const u32x4*)(u + 64); R.W[1] = *(const u32x4*)(u + 72);
    const u16* kt = KTb + (prob * 64 + lrow) * 64 + (dir ? 48 - seg : seg);
    u32x4 a = *(const u32x4*)kt, bb = *(const u32x4*)(kt + 8);
    if (dir) { R.KT[0] = rev8(bb); R.KT[1] = rev8(a); } else { R.KT[0] = a; R.KT[1] = bb; }
    R.g = GV[pd * 256 + (tid & 255)];
  };
  gload(0, R0); gload(1, R1);
  auto step = [&](int n, GReg& R) {
    const int cgi = dir == 0 ? cg0 + n : cg0 + nch - 1 - n;
    const size_t pd = ((size_t)cgi * 4 + hd) * 2 + dir;
    __syncthreads();
    *(u32x4*)(sW + lrow * 72 + seg) = R.W[0]; *(u32x4*)(sW + lrow * 72 + seg + 8) = R.W[1];
    *(u32x4*)(sKT + lrow * 72 + seg) = R.KT[0]; *(u32x4*)(sKT + lrow * 72 + seg + 8) = R.KT[1];
    *(u32x4*)(sU + lrow * 72 + seg) = R.U[0]; *(u32x4*)(sU + lrow * 72 + seg + 8) = R.U[1];
    sg[tid] = R.g;
    __syncthreads();
    if (n + 2 < nch) gload(n + 2, R);
    u32x4* FR = (u32x4*)(UWb + pd * 8192);
    const float elast = sg[128];
    bf16x8 sB[2] = {pack8(st[0], st[1]), pack8(st[2], st[3])};
    FR[(0 * 4 + wave) * 64 + lane] = __builtin_bit_cast(u32x4, sB[0]);
    FR[(1 * 4 + wave) * 64 + lane] = __builtin_bit_cast(u32x4, sB[1]);
    f32x4 vn[4];
#pragma unroll
    for (int mt = 0; mt < 4; ++mt) {
      f32x4 acc = {0.f, 0.f, 0.f, 0.f};
#pragma unroll
      for (int s2 = 0; s2 < 2; ++s2) acc = MFMA16(ldperm(sW + (mt * 16 + lq) * 72 + s2 * 32 + quad * 4), sB[s2], acc);
#pragma unroll
      for (int r = 0; r < 4; ++r) vn[mt][r] = bf2f(sU[(mt * 16 + quad * 4 + r) * 72 + wave * 16 + lq]) - acc[r];
    }
    bf16x8 vB[2] = {pack8(vn[0], vn[1]), pack8(vn[2], vn[3])};
    FR[512 + (0 * 4 + wave) * 64 + lane] = __builtin_bit_cast(u32x4, vB[0]);
    FR[512 + (1 * 4 + wave) * 64 + lane] = __builtin_bit_cast(u32x4, vB[1]);
#pragma unroll
    for (int mt = 0; mt < 4; ++mt)
#pragma unroll
      for (int r = 0; r < 4; ++r) vn[mt][r] *= sg[64 + mt * 16 + quad * 4 + r];
    bf16x8 vsB[2] = {pack8(vn[0], vn[1]), pack8(vn[2], vn[3])};
#pragma unroll
    for (int kt = 0; kt < 4; ++kt) {
      f32x4 acc = {0.f, 0.f, 0.f, 0.f};
#pragma unroll
      for (int s2 = 0; s2 < 2; ++s2) acc = MFMA16(ldperm(sKT + (kt * 16 + lq) * 72 + s2 * 32 + quad * 4), vsB[s2], acc);
#pragma unroll
      for (int r = 0; r < 4; ++r) st[kt][r] = elast * st[kt][r] + acc[r];
    }
  };
  for (int n = 0; n < nch; n += 2) { step(n, R0); step(n + 1, R1); }
  if (!lat) {
#pragma unroll
    for (int kt = 0; kt < 4; ++kt)
#pragma unroll
      for (int r = 0; r < 4; ++r)
        p->out[O_GDN + ((size_t)(((b * 2 + l) * 2 + dir) * 4 + hd) * 64 + kt * 16 + quad * 4 + r) * 64 + wave * 16 + lq] = st[kt][r];
  }
  __syncthreads();
}

DI void gdnfin_item(KP p, int l, int item, unsigned char* smem) {
  u16* sQ = (u16*)smem; u16* sQK = sQ + 64 * 72;
  float* so = (float*)(smem + 3 * 64 * 72 * 2);
  float* seg_ = so + 64 * 65;
  const int cgi = item >> 2, hd = item & 3;
  const int tid = ltid(), lane = tid & 63, wave = tid >> 6, lq = lane & 15, quad = lane >> 4;
  const int lrow = tid >> 2, seg = (tid & 3) * 16;
  __syncthreads();
  {
    const u16* q = (const u16*)(p->ws + WS_QHAT) + ((size_t)item * 64 + lrow) * 64 + seg;
    *(u32x4*)(sQ + lrow * 72 + seg) = *(const u32x4*)q; *(u32x4*)(sQ + lrow * 72 + seg + 8) = *(const u32x4*)(q + 8);
#pragma unroll
    for (int dir = 0; dir < 2; ++dir) {
      const u16* qk = (const u16*)(p->ws + WS_QK) + ((size_t)(item * 2 + dir) * 64 + lrow) * 64 + seg;
      *(u32x4*)(sQK + (dir * 64 + lrow) * 72 + seg) = *(const u32x4*)qk; *(u32x4*)(sQK + (dir * 64 + lrow) * 72 + seg + 8) = *(const u32x4*)(qk + 8);
    }
    if (tid < 128) seg_[tid] = ((const float*)(p->ws + WS_GVEC))[(size_t)(item * 2 + (tid >> 6)) * 256 + (tid & 63)];
  }
  __syncthreads();
#pragma unroll
  for (int dir = 0; dir < 2; ++dir) {
    const u32x4* FR = (const u32x4*)((const u16*)(p->ws + WS_UW) + (size_t)(item * 2 + dir) * 8192);
    bf16x8 sfr[2], vfr[2];
#pragma unroll
    for (int s2 = 0; s2 < 2; ++s2) {
      sfr[s2] = __builtin_bit_cast(bf16x8, FR[(s2 * 4 + wave) * 64 + lane]);
      vfr[s2] = __builtin_bit_cast(bf16x8, FR[512 + (s2 * 4 + wave) * 64 + lane]);
    }
#pragma unroll
    for (int mt = 0; mt < 4; ++mt) {
      f32x4 acc = {0.f, 0.f, 0.f, 0.f};
      const int qrow = dir ? 63 - (mt * 16 + lq) : mt * 16 + lq;
#pragma unroll
      for (int s2 = 0; s2 < 2; ++s2) acc = MFMA16(ldperm(sQ + qrow * 72 + s2 * 32 + quad * 4), sfr[s2], acc);
#pragma unroll
      for (int r = 0; r < 4; ++r) acc[r] *= seg_[dir * 64 + mt * 16 + quad * 4 + r];
#pragma unroll
      for (int s2 = 0; s2 < 2; ++s2) acc = MFMA16(ldperm(sQK + (dir * 64 + mt * 16 + lq) * 72 + s2 * 32 + quad * 4), vfr[s2], acc);
#pragma unroll
      for (int r = 0; r < 4; ++r) {
        const int c = mt * 16 + quad * 4 + r;
        const int tk = dir ? 63 - c : c;
        float* d = so + tk * 65 + wave * 16 + lq;
        if (dir == 0) *d = acc[r]; else *d += acc[r];
      }
    }
    __syncthreads();
  }
  const float gn = p->in[28][l * 64 + lane];
  float zv[16];
#pragma unroll
  for (int q = 0; q < 16; ++q)
    zv[q] = bf2f(((const u16*)(p->ws + WS_INPROJ))[((size_t)cgi * 64 + wave * 16 + q) * LDI + C_GZ + hd * 64 + lane]);
#pragma unroll
  for (int q = 0; q < 16; ++q) {
    const int c = wave * 16 + q;
    const size_t row = (size_t)cgi * 64 + c;
    float o = so[c * 65 + lane];
    float ss = wave_sum(o * o);
    float y = o * rsqrtf(ss * (1.f / 64.f) + 1e-6f) * gn * siluf_(zv[q]);
    ((u16*)(p->ws + WS_BRANCH))[row * 1024 + 512 + hd * 64 + lane] = f2bf(y);
  }
}

#define XB_TMO      128
#define XB_XCNT(j)  (256  + 64 * (j))
#define XB_XSUB(j)  (1280 + 64 * (j))
#define XB_XGEN(j)  (2304 + 64 * (j))
#define XB_TOP      3328
#define XB_TOPGEN   3392
#define XB_SPIN_CAP (1u << 20)
#define LAS __attribute__((address_space(3)))
DI unsigned xb_ld(unsigned* q) { return __hip_atomic_load(q, __ATOMIC_RELAXED, __HIP_MEMORY_SCOPE_AGENT); }
DI unsigned xb_add(unsigned* q, unsigned v) { return __hip_atomic_fetch_add(q, v, __ATOMIC_RELAXED, __HIP_MEMORY_SCOPE_AGENT); }
DI unsigned xb_xcc_id() { return (unsigned)__builtin_amdgcn_s_getreg((3 << 11) | 20) & 0xFu; }
#define XB_SPIN(cond, bar) do { unsigned _sp = 0; while (cond) { __builtin_amdgcn_s_sleep(1); \
    if ((++_sp & 255u) == 0u) { if (xb_ld(&(bar)[XB_TMO])) break; if (_sp > XB_SPIN_CAP) { atomicAdd(&(bar)[XB_TMO], 1u); break; } } } } while (0)
DI void xcd_barrier_complete(unsigned* bar, unsigned x, unsigned& nloc, unsigned& nx) {
  const unsigned G = gridDim.x;
  unsigned sum, cnt, mine, sp = 0u;
  for (;;) {
    sum = 0u; cnt = 0u; mine = 0u;
#pragma unroll
    for (unsigned j = 0; j < 16; ++j) { const unsigned c = xb_ld(&bar[XB_XCNT(j)]); sum += c; cnt += (c > 0u) ? 1u : 0u; mine = (j == x) ? c : mine; }
    if (sum == G) break;
    __builtin_amdgcn_s_sleep(1);
    if ((++sp & 255u) == 0u) { if (xb_ld(&bar[XB_TMO])) break; if (sp > XB_SPIN_CAP) { atomicAdd(&bar[XB_TMO], 1u); break; } }
  }
  nloc = mine > 0u ? mine : 1u; nx = cnt > 0u ? cnt : 1u;
}
DI void xcd_barrier(unsigned* bar, volatile LAS unsigned* st) {
  asm volatile("s_waitcnt vmcnt(0)" ::: "memory");
  __syncthreads();
  if (ltid() == 0) {
    const unsigned x = xb_xcc_id();
    __builtin_amdgcn_s_waitcnt(0);
    unsigned nloc = st[0], nx = st[1];
    if (nloc == 0u) { xcd_barrier_complete(bar, x, nloc, nx); st[0] = nloc; st[1] = nx; }
    const unsigned old = xb_add(&bar[XB_XSUB(x)], 1u);
    const unsigned gen = old / nloc;
    if (old + 1u == (gen + 1u) * nloc) {
      __builtin_amdgcn_fence(__ATOMIC_RELEASE, "agent");
      asm volatile("s_waitcnt vmcnt(0)" ::: "memory");
      const unsigned og = xb_add(&bar[XB_TOP], 1u);
      const unsigned tg = og / nx;
      if (og + 1u == (tg + 1u) * nx) xb_add(&bar[XB_TOPGEN], 1u);
      else XB_SPIN(xb_ld(&bar[XB_TOPGEN]) == tg, bar);
      __builtin_amdgcn_fence(__ATOMIC_ACQUIRE, "agent");
      xb_add(&bar[XB_XGEN(x)], 1u);
      asm volatile("s_waitcnt vmcnt(0)" ::: "memory");
    } else {
      XB_SPIN(xb_ld(&bar[XB_XGEN(x)]) == gen, bar);
      __builtin_amdgcn_fence(__ATOMIC_ACQUIRE, "agent");
      asm volatile("s_waitcnt vmcnt(0)" ::: "memory");
    }
  }
  __syncthreads();
}


#define FOR_TILES(MTI, NTI, SM, SN, CALL)                                                      \
  do {                                                                                         \
    if (G % 8 != 0) { for (int it_ = B; it_ < (MTI) * (NTI); it_ += G) { const int mt = it_ / (NTI), nt = it_ % (NTI); CALL; } } \
    else {                                                                                     \
      const int xcd_ = B & 7, j_ = B >> 3, J_ = G >> 3;                                        \
      const int nsm_ = ((MTI) + (SM) - 1) / (SM), nsn_ = ((NTI) + (SN) - 1) / (SN);            \
      const int st_ = (SM) * (SN), mysup_ = (nsm_ * nsn_ - xcd_ + 7) / 8;                      \
        \
                                  \
      for (int u_ = j_; u_ < mysup_ * st_; u_ += J_) {                                         \
        const int s_ = xcd_ + 8 * (u_ / st_), t_ = u_ % st_;                                   \
        const int sm_ = s_ / nsn_, sn_ = s_ % nsn_;                                            \
        const int mt = sm_ * (SM) + t_ / (SN), nt = sn_ * (SN) + t_ % (SN);                    \
        if (mt < (MTI) && nt < (NTI)) { CALL; }                                                \
      }                                                                                        \
    }                                                                                          \
  } while (0)

constexpr int NPHASE = 21;
__global__ void __launch_bounds__(256, 2) mk(Params p_unused, int ph_lo, int ph_hi) {
  extern __shared__ __attribute__((aligned(1024))) unsigned char smem[];
  int& s_item = *(int*)(smem + SMEM_BYTES);
  u32x4& xb_words = *(u32x4*)(smem + SMEM_BYTES + 16);
  const int G = gridDim.x, B = blockIdx.x;
  const bool fused = ph_hi - ph_lo > 1;
  if (fused) {
    if (ltid() == 0) { xb_words = u32x4{0u, 0u, 0u, 0u}; (void)xb_add(&((unsigned*)(((KP)__builtin_amdgcn_kernarg_segment_ptr())->ws + WS_BAR))[XB_XCNT(xb_xcc_id())], 1u); }
    __syncthreads();
  }
  for (int ph = ph_lo; ph < ph_hi; ++ph) {
    KP p = (KP)__builtin_amdgcn_kernarg_segment_ptr();
    asm volatile("" : "+s"(p));
    if (ph == 0) {
      for (int it = B; it < 192 + 64; it += G) { if (it < 192) mod_item(p, it, smem); else lruw_item(p, it - 192); }
    } else {
      const int l = (ph - 1) / 10, sub = (ph - 1) % 10;
      switch (sub) {
        case 0:
          for (int it = B; it < 2048 + CONV_ITEMS; it += G) { if (it < 2048) norm_item<0>(p, l, it); else convert_item(p, l, it - 2048, smem); }
          break;
        case 1: FOR_TILES(128, 21, 8, 7, inproj_item(p, mt, nt, smem)); break;
        case 2:
          for (int it = B; it < 1024 + 512 + 64 + 2048; it += G) {
            if (it < 1024) { for (int rep = 0; rep < NREP(4); ++rep) gdn1_item(p, l, it, smem); }
            else if (it < 1536) { for (int rep = 0; rep < NREP(5); ++rep) lru_item<false>(p, l, it - 1024, smem); }
            else if (it < 1600) { if (PHON(6)) kvc_item(p, l, it - 1536); }
            else if (PHON(6)) prep_item(p, l, it - 1600);
          }
          break;
        case 3: {
          int* ctr = (int*)(p->ws + WS_CTR) + l;
          for (;;) {
            __syncthreads();
            if (ltid() == 0) s_item = atomicAdd(ctr, 1);
            __syncthreads();
            const int it = s_item;
            if (it >= 16 + 256 + 256 + 256 + 512 + 512) break;
            if (it < 16) gdn2_item(p, l, it, smem);
            else if (it < 272) { for (int rep = 0; rep < NREP(8); ++rep) attn_item(p, l, it - 16, smem); }
            else if (it < 528) gdn2_item(p, l, it - 272 + 16, smem);
            else if (it < 784) { for (int rep = 0; rep < NREP(8); ++rep) attn_item(p, l, it - 528 + 256, smem); }
            else if (it < 1296) { for (int rep = 0; rep < NREP(9); ++rep) lru_item<true>(p, l, it - 784, smem); }
            else for (int rep = 0; rep < NREP(8); ++rep) attn_item(p, l, it - 1296 + 512, smem);
          }
        } break;
        case 4: for (int it = B; it < 1024; it += G) gdnfin_item(p, l, it, smem); break;
        case 5: for (int rep = 0; rep < NREP(11); ++rep) FOR_TILES(128, 8, 8, 8, merge_item(p, l, mt, nt, smem)); break;
        case 6: FOR_TILES(128, 8, 8, 8, wout_item(p, l, mt, nt, smem)); break;
        case 7: for (int it = B; it < 2048; it += G) norm_item<1>(p, l, it); break;
        case 8: FOR_TILES(128, 32, 8, 8, w1_item(p, mt, nt, smem)); break;
        case 9: FOR_TILES(128, 8, 8, 8, w2_item(p, l, mt, nt, smem)); break;
      }
    }
    if (ph + 1 < ph_hi) {
      if (ph == ph_lo) cg::this_grid().sync();
      else for (int rep = 0; rep < NREP(1); ++rep) xcd_barrier((unsigned*)(p->ws + WS_BAR), (volatile LAS unsigned*)&xb_words);
    }
  }
}

extern "C" void kernel_launch(void* const* d_in, const int* in_sizes, int n_in, void* d_out, int out_size, void* d_ws, size_t ws_size, hipStream_t stream) {
  static int grid_blocks = 0;
  if (!grid_blocks) {
    int dev = 0, cus = 0, per_cu = 0;
    (void)hipGetDevice(&dev);
    (void)hipDeviceGetAttribute(&cus, hipDeviceAttributeMultiprocessorCount, dev);
    if (hipFuncSetAttribute((const void*)mk, hipFuncAttributeMaxDynamicSharedMemorySize, DYN_LDS) != hipSuccess) fprintf(stderr, "kernel_launch: hipFuncSetAttribute failed\n");
    (void)hipOccupancyMaxActiveBlocksPerMultiprocessor(&per_cu, mk, 256, DYN_LDS);
    if (per_cu < 1) per_cu = 1;
    if (per_cu > 2) per_cu = 2;
    grid_blocks = cus * per_cu;
    if (ws_size < WS_END) fprintf(stderr, "kernel_launch: workspace too small: %zu < %zu\n", ws_size, (size_t)WS_END);
  }
  if (hipMemsetAsync((char*)d_ws + WS_CTR, 0, 256 + 3456 * 4 + 256, stream) != hipSuccess) fprintf(stderr, "kernel_launch: memset failed\n");
  Params p{};
  for (int i = 0; i < 37; ++i) p.in[i] = (const float*)d_in[i];
  p.out = (float*)d_out; p.ws = (unsigned char*)d_ws;
#if MULTI_LAUNCH
  for (int ph = 0; ph < NPHASE; ++ph) hipLaunchKernelGGL(mk, dim3(grid_blocks), dim3(256), DYN_LDS, stream, p, ph, ph + 1);
#else
  int lo = 0, hi = NPHASE;
  void* args[] = {&p, &lo, &hi};
  hipError_t e = hipLaunchCooperativeKernel((void*)mk, dim3(grid_blocks), dim3(256), args, DYN_LDS, stream);
  if (e != hipSuccess) fprintf(stderr, "cooperative launch failed: %s (grid %d)\n", hipGetErrorString(e), grid_blocks);
#endif
}
```

```cpp
#include <hip/hip_runtime.h>
#include <hip/hip_cooperative_groups.h>
#include <cstdio>
namespace cg = cooperative_groups;

#ifndef MULTI_LAUNCH
#define MULTI_LAUNCH 0
#endif
#ifndef PHM
#define PHM 0xFFFFFFFFu
#endif
#define PHON(b) ((PHM >> (b)) & 1u)
#ifndef DUPM
#define DUPM 0u
#endif
#define NREP(b) (1 + ((DUPM >> (b)) & 1u))

typedef unsigned short u16;
using bf16x8 = __attribute__((ext_vector_type(8))) short;
using f32x4 = __attribute__((ext_vector_type(4))) float;
using u32x4 = __attribute__((ext_vector_type(4))) unsigned;
#define DI __device__ __forceinline__
#define MFMA16(a, b, c) __builtin_amdgcn_mfma_f32_16x16x32_bf16((a), (b), (c), 0, 0, 0)

constexpr int NTOK = 16384;
constexpr int DM = 1024;
constexpr int LDI = 2592;
constexpr int C_AQ = 0, C_AK = 256, C_AV = 384, C_LX = 512, C_LG = 768, C_GQ = 1024, C_GK = 1280, C_GV = 1536, C_GZ = 1792,
              C_DQ = 2048, C_DK = 2304, C_DV = 2432, C_GA = 2560, C_GB = 2568;
constexpr int NIN_PAD = 2688;

constexpr size_t WS_MOD = 0;
constexpr size_t WS_CTR = WS_MOD + 2 * 3 * 6144 * 4;
constexpr size_t WS_BAR = WS_CTR + 256;
constexpr size_t WS_LRUC = WS_BAR + 3456 * 4 + 256;
constexpr size_t WS_KC = WS_LRUC + (size_t)512 * 2 * 2 * 256 * 4;
constexpr size_t WS_GVEC = WS_KC + (size_t)16 * 512 * 64 * 2;
constexpr size_t WS_LRUW = WS_GVEC + (size_t)1024 * 2 * 256 * 4;
constexpr size_t WS_VT = WS_LRUW + (size_t)256 * 64 * 16;
constexpr size_t WS_WIN = WS_VT + (size_t)8 * 64 * 4608 * 2;
constexpr size_t WS_WM = WS_WIN + (size_t)NIN_PAD * 1024 * 2;
constexpr size_t WS_WB = WS_WM + (size_t)4096 * 1024 * 2;
constexpr size_t WS_WO = WS_WB + (size_t)4 * 1024 * 256 * 2;
constexpr size_t WS_W1 = WS_WO + (size_t)1024 * 1024 * 2;
constexpr size_t WS_W2 = WS_W1 + (size_t)4096 * 1024 * 2;
constexpr size_t WS_H = WS_W2 + (size_t)1024 * 4096 * 2;
constexpr size_t WS_BIG = WS_H + (size_t)NTOK * 1024 * 2;
constexpr size_t WS_INPROJ = WS_BIG;
constexpr size_t WS_BRANCH = WS_INPROJ + (size_t)NTOK * LDI * 2;
constexpr size_t WS_QHAT = WS_BRANCH + (size_t)NTOK * 1024 * 2;
constexpr size_t WS_KT = WS_QHAT + (size_t)1024 * 4096 * 2;
constexpr size_t WS_UW = WS_KT + (size_t)1024 * 4096 * 2;
constexpr size_t WS_QK = WS_UW + (size_t)1024 * 2 * 8192 * 2;
constexpr size_t WS_END = WS_QK + (size_t)1024 * 2 * 4096 * 2;
constexpr size_t WS_HIDDEN = WS_BIG;
constexpr size_t WS_MERGED = WS_BIG;
static_assert(WS_HIDDEN + (size_t)NTOK * 4096 * 2 <= WS_END, "hidden must fit");
static_assert(WS_END <= (size_t)256 * 1024 * 1024, "workspace budget");

constexpr size_t O_X = 0, O_AK = 16777216, O_AV = 18874368, O_DK = 20971520, O_DV = 23068672, O_LRU = 25165824, O_GDN = 25198592;

struct Params {
  const float* in[37];
  float* out;
  unsigned char* ws;
};

typedef const Params __attribute__((address_space(4)))* KP;
constexpr int SMEM_BYTES = 65536;
constexpr int DYN_LDS = SMEM_BYTES + 64;

DI int ltid() { int t = threadIdx.x; asm volatile("" : "+v"(t)); return t; }
typedef __bf16 bf16v2 __attribute__((ext_vector_type(2)));
DI u16 f2bf(float x) { __bf16 h = (__bf16)x; return __builtin_bit_cast(u16, h); }
DI float bf2f(u16 h) { return __uint_as_float(((unsigned)h) << 16); }
DI unsigned pack2(float a, float b) { bf16v2 v = {(__bf16)a, (__bf16)b}; return __builtin_bit_cast(unsigned, v); }
DI float bflo(unsigned u) { return __uint_as_float(u << 16); }
DI float bfhi(unsigned u) { return __uint_as_float(u & 0xffff0000u); }
DI float sigm(float x) { return __builtin_amdgcn_rcpf(1.f + __expf(-x)); }
DI float siluf_(float x) { return x * __builtin_amdgcn_rcpf(1.f + __expf(-x)); }
DI float softplusf_(float x) { return x > 20.f ? x : __logf(1.f + __expf(x)); }
DI float gelu_tanh(float x) { float u = 0.7978845608028654f * (x + 0.044715f * x * x * x); float t = 1.f - 2.f * __builtin_amdgcn_rcpf(__expf(2.f * u) + 1.f); return 0.5f * x * (1.f + t); }
template <int CTRL> DI float dppf(float v) { return __int_as_float(__builtin_amdgcn_update_dpp(0, __float_as_int(v), CTRL, 0xF, 0xF, true)); }
DI float rlane(float v, int l) { return __int_as_float(__builtin_amdgcn_readlane(__float_as_int(v), l)); }
DI float wave_sum(float v) {
  v += dppf<0xB1>(v);
  v += dppf<0x4E>(v);
  v += dppf<0x141>(v);
  v += dppf<0x140>(v);
  return (rlane(v, 0) + rlane(v, 16)) + (rlane(v, 32) + rlane(v, 48));
}
DI float xrow16_max(float x) { auto r = __builtin_amdgcn_permlane16_swap(__float_as_uint(x), __float_as_uint(x), false, false); return fmaxf(__uint_as_float(r[0]), __uint_as_float(r[1])); }
DI float xrow32_max(float x) { auto r = __builtin_amdgcn_permlane32_swap(__float_as_uint(x), __float_as_uint(x), false, false); return fmaxf(__uint_as_float(r[0]), __uint_as_float(r[1])); }
DI float xrow16_sum(float x) { auto r = __builtin_amdgcn_permlane16_swap(__float_as_uint(x), __float_as_uint(x), false, false); return __uint_as_float(r[0]) + __uint_as_float(r[1]); }
DI float xrow32_sum(float x) { auto r = __builtin_amdgcn_permlane32_swap(__float_as_uint(x), __float_as_uint(x), false, false); return __uint_as_float(r[0]) + __uint_as_float(r[1]); }
DI float xor16_partner(float x, int lane) { auto r = __builtin_amdgcn_permlane16_swap(__float_as_uint(x), __float_as_uint(x), false, false); return __uint_as_float((lane & 16) ? r[0] : r[1]); }
DI u32x4 mku4(unsigned a, unsigned b, unsigned c, unsigned d) { u32x4 v = {a, b, c, d}; return v; }
DI bf16x8 mk8(unsigned a, unsigned b, unsigned c, unsigned d) { u32x4 v = {a, b, c, d}; return __builtin_bit_cast(bf16x8, v); }
DI bf16x8 pack8(const f32x4& x, const f32x4& y) { return mk8(pack2(x[0], x[1]), pack2(x[2], x[3]), pack2(y[0], y[1]), pack2(y[2], y[3])); }
DI bf16x8 ld8(const u16* p) { return *(const bf16x8*)p; }
DI bf16x8 ldperm(const u16* p) { uint2 a = *(const uint2*)p; uint2 b = *(const uint2*)(p + 16); return mk8(a.x, a.y, b.x, b.y); }
DI int mod_group(int row) { return row < 8192 ? 0 : 1 + ((row - 8192) >> 12); }
DI const float* x_in_row(KP p, int l, int row) {
  if (l == 0) return row < 8192 ? p->in[0] + (size_t)row * DM : p->in[1] + (size_t)(row - 8192) * DM;
  return p->out + (size_t)row * DM;
}
DI unsigned swap16(unsigned u) { return (u >> 16) | (u << 16); }
DI u32x4 rev8(u32x4 v) { return mku4(swap16(v.w), swap16(v.z), swap16(v.y), swap16(v.x)); }

DI void mod_item(KP p, int item, unsigned char* smem) {
  float* sc = (float*)smem;
  float* sr = sc + 3072;
  const int tid = ltid();
  const int l = item / 96, cb = item % 96;
  for (int i = tid; i < 3072; i += 256) {
    int g = i >> 10, k = i & 1023;
    float c = g == 0 ? p->in[9][k] : p->in[2][(g - 1) * 1024 + k];
    sc[i] = siluf_(c);
  }
  __syncthreads();
  const int col = cb * 64 + (tid & 63), kg = tid >> 6;
  const float* W = p->in[10] + (size_t)l * 1024 * 6144;
  float a0 = 0.f, a1 = 0.f, a2 = 0.f;
  for (int k = kg * 256; k < kg * 256 + 256; ++k) {
    float w = W[(size_t)k * 6144 + col];
    a0 += sc[k] * w; a1 += sc[1024 + k] * w; a2 += sc[2048 + k] * w;
  }
  sr[(kg * 3 + 0) * 64 + (tid & 63)] = a0; sr[(kg * 3 + 1) * 64 + (tid & 63)] = a1; sr[(kg * 3 + 2) * 64 + (tid & 63)] = a2;
  __syncthreads();
  if (tid < 192) {
    int g = tid >> 6, cc = tid & 63;
    float s = p->in[11][l * 6144 + cb * 64 + cc];
    for (int q = 0; q < 4; ++q) s += sr[(q * 3 + g) * 64 + cc];
    ((float*)(p->ws + WS_MOD))[(l * 3 + g) * 6144 + cb * 64 + cc] = s;
  }
  __syncthreads();
}

DI void conv_tile(const float* src, int N, int k0, int n0, u16* dst, int K, bool perm, unsigned char* smem) {
  float* tile = (float*)smem;
  const int tid = ltid();
#pragma unroll
  for (int i = 0; i < 4; ++i) {
    int kr = (tid >> 4) + 16 * i, nc = (tid & 15) * 4;
    float4 v = make_float4(0.f, 0.f, 0.f, 0.f);
    if (n0 + nc < N) v = *(const float4*)(src + (size_t)(k0 + kr) * N + n0 + nc);
    tile[kr * 65 + nc] = v.x; tile[kr * 65 + nc + 1] = v.y; tile[kr * 65 + nc + 2] = v.z; tile[kr * 65 + nc + 3] = v.w;
  }
  __syncthreads();
#pragma unroll
  for (int i = 0; i < 2; ++i) {
    int n = (tid >> 3) + 32 * i, k8 = (tid & 7) * 8;
    int ng = n0 + n;
    if (ng < N) {
      int row = ng;
      if (perm) row = ng < 2048 ? ng : (ng < 2064 ? 2560 + (ng - 2048) : ng - 16);
      u32x4 o;
      o.x = pack2(tile[(k8 + 0) * 65 + n], tile[(k8 + 1) * 65 + n]);
      o.y = pack2(tile[(k8 + 2) * 65 + n], tile[(k8 + 3) * 65 + n]);
      o.z = pack2(tile[(k8 + 4) * 65 + n], tile[(k8 + 5) * 65 + n]);
      o.w = pack2(tile[(k8 + 6) * 65 + n], tile[(k8 + 7) * 65 + n]);
      *(u32x4*)(dst + (size_t)row * K + k0 + k8) = o;
    }
  }
  __syncthreads();
}

constexpr int CONV_ITEMS = 4241;
DI void convert_item(KP p, int l, int item, unsigned char* smem) {
  unsigned char* ws = p->ws;
  if (item < 656) { int kt = item / 41, nt = item % 41; conv_tile(p->in[14] + (size_t)l * 1024 * 2576, 2576, kt * 64, nt * 64, (u16*)(ws + WS_WIN), 1024, true, smem); return; }
  item -= 656;
  if (item < 1024) { int kt = item >> 6, nt = item & 63; conv_tile(p->in[32] + (size_t)l * 1024 * 4096, 4096, kt * 64, nt * 64, (u16*)(ws + WS_WM), 1024, false, smem); return; }
  item -= 1024;
  if (item < 256) { int m = item >> 6, r = item & 63, kt = r >> 4, nt = r & 15;
    conv_tile(p->in[31] + ((size_t)l * 4 + m) * 256 * 1024, 1024, kt * 64, nt * 64, (u16*)(ws + WS_WB) + (size_t)m * 1024 * 256, 256, false, smem); return; }
  item -= 256;
  if (item < 256) { int kt = item >> 4, nt = item & 15; conv_tile(p->in[34] + (size_t)l * 1024 * 1024, 1024, kt * 64, nt * 64, (u16*)(ws + WS_WO), 1024, false, smem); return; }
  item -= 256;
  if (item < 1024) { int kt = item >> 6, nt = item & 63; conv_tile(p->in[35] + (size_t)l * 1024 * 4096, 4096, kt * 64, nt * 64, (u16*)(ws + WS_W1), 1024, false, smem); return; }
  item -= 1024;
  if (item < 1024) { int kt = item >> 4, nt = item & 15; conv_tile(p->in[36] + (size_t)l * 4096 * 1024, 1024, kt * 64, nt * 64, (u16*)(ws + WS_W2), 4096, false, smem); return; }
  u32x4* z = (u32x4*)((u16*)(ws + WS_WIN) + (size_t)2576 * 1024);
  for (int i = ltid(); i < 112 * 1024 / 8; i += 256) z[i] = mku4(0, 0, 0, 0);
}

DI void lruw_item(KP p, int item) {
  const int gid = item * 256 + ltid();
  const int lane = gid & 63, fg = gid >> 6;
  const int s2 = fg & 1, j = (fg >> 1) & 3, n = (fg >> 3) & 3, g = (fg >> 5) & 1, ld_ = fg >> 6;
  const int lq = lane & 15, quad = lane >> 4;
  const float* W = (g == 0 ? p->in[20] : p->in[22]) + ((size_t)(ld_ * 4 + n) * 64) * 64 + (size_t)(s2 * 32 + quad * 8) * 64 + j * 16 + lq;
  u32x4 o = {pack2(W[0], W[64]), pack2(W[128], W[192]), pack2(W[256], W[320]), pack2(W[384], W[448])};
  ((u32x4*)(p->ws + WS_LRUW))[gid] = o;
}

template <int which>
DI void norm_item(KP p, int l, int item) {
  const int tid = ltid(), lane = tid & 63, wave = tid >> 6;
  const float* g = p->in[which == 0 ? 12 : 13] + l * 1024;
  f32x4 v[2][4]; float ss[2] = {0.f, 0.f};
#pragma unroll
  for (int h = 0; h < 2; ++h) {
    const int row = item * 8 + wave * 2 + h;
    const float* x = x_in_row(p, which == 0 ? l : 2, row);
#pragma unroll
    for (int i = 0; i < 4; ++i) v[h][i] = *(const f32x4*)(x + i * 256 + lane * 4);
  }
#pragma unroll
  for (int h = 0; h < 2; ++h) {
#pragma unroll
    for (int i = 0; i < 4; ++i) ss[h] += v[h][i].x * v[h][i].x + v[h][i].y * v[h][i].y + v[h][i].z * v[h][i].z + v[h][i].w * v[h][i].w;
    ss[h] = wave_sum(ss[h]);
  }
#pragma unroll
  for (int h = 0; h < 2; ++h) {
    const int row = item * 8 + wave * 2 + h;
    const float* mod = (const float*)(p->ws + WS_MOD) + (l * 3 + mod_group(row)) * 6144;
    const float* sh = mod + (which == 0 ? 0 : 3072);
    const float* sc = mod + (which == 0 ? 1024 : 4096);
    const float rstd = rsqrtf(ss[h] * (1.f / 1024.f) + 1e-6f);
    u16* H = (u16*)(p->ws + WS_H) + (size_t)row * 1024;
#pragma unroll
    for (int i = 0; i < 4; ++i) {
      int c = i * 256 + lane * 4;
      float4 gg = *(const float4*)(g + c), s1 = *(const float4*)(sc + c), s0 = *(const float4*)(sh + c);
      float y0 = v[h][i].x * rstd * gg.x * (1.f + s1.x) + s0.x, y1 = v[h][i].y * rstd * gg.y * (1.f + s1.y) + s0.y;
      float y2 = v[h][i].z * rstd * gg.z * (1.f + s1.z) + s0.z, y3 = v[h][i].w * rstd * gg.w * (1.f + s1.w) + s0.w;
      *(uint2*)(H + c) = make_uint2(pack2(y0, y1), pack2(y2, y3));
    }
  }
}

DI int lds_byte(int r, int c) {
  int st = (r >> 4) * 2 + (c >> 5), ob = (r & 15) * 64 + (c & 31) * 2;
  return st * 1024 + (ob ^ (((ob >> 9) & 1) << 5));
}
DI void stage_rc(int b, int& R, int& C) {
  int st = b >> 10, sb = b & 1023, swz = sb ^ (((sb >> 9) & 1) << 5);
  R = (st >> 1) * 16 + (swz >> 6);
  C = (st & 1) * 32 + ((swz & 63) >> 1);
}
template <int MT, int NT, bool pre = false>
DI void gemm_acc(f32x4 (&acc)[MT][NT], const u16* __restrict__ A, int lda, const u16* __restrict__ Bt, int ldb, int K, unsigned char* smem,
                 const u16* nxtA = nullptr, int nlda = 0, const u16* nxtB = nullptr, int nldb = 0) {
  constexpr int TA = MT * 32 * 128, TB = NT * 32 * 128, STAGE = TA + TB;
  static_assert(2 * STAGE <= 65536, "LDS");
  const int tid = ltid(), lane = tid & 63, wid = tid >> 6, wm = wid >> 1, wn = wid & 1;
  const int fr = lane & 15, fq = lane >> 4;
  const u16* ga[MT]; const u16* gb[NT];
#pragma unroll
  for (int i = 0; i < MT; ++i) { int R, C; stage_rc(wid * 1024 + i * 4096 + lane * 16, R, C); ga[i] = A + (size_t)R * lda + C; }
#pragma unroll
  for (int i = 0; i < NT; ++i) { int R, C; stage_rc(wid * 1024 + i * 4096 + lane * 16, R, C); gb[i] = Bt + (size_t)R * ldb + C; }
#define GLDS_STAGE(buf, k0)                                                                                                        \
  do {                                                                                                                             \
    _Pragma("unroll") for (int i = 0; i < MT; ++i)                                                                                 \
      __builtin_amdgcn_global_load_lds((const unsigned*)(ga[i] + (k0)), (unsigned*)(smem + (buf) * STAGE + wid * 1024 + i * 4096), 16, 0, 0); \
    _Pragma("unroll") for (int i = 0; i < NT; ++i)                                                                                 \
      __builtin_amdgcn_global_load_lds((const unsigned*)(gb[i] + (k0)), (unsigned*)(smem + (buf) * STAGE + TA + wid * 1024 + i * 4096), 16, 0, 0); \
  } while (0)
  if (!pre) {
    __syncthreads();
    GLDS_STAGE(0, 0);
  }
  asm volatile("s_waitcnt vmcnt(0)" ::: "memory");
  __syncthreads();
  const int nt = K >> 6;
  for (int t = 0; t < nt; ++t) {
    const int cur = t & 1;
    if (t + 1 < nt) GLDS_STAGE(cur ^ 1, (t + 1) * 64);
    const unsigned char* sA = smem + cur * STAGE;
    const unsigned char* sB = sA + TA;
    if constexpr (!pre) {
      bf16x8 bfr[2][NT], af[2][MT];
#pragma unroll
      for (int s = 0; s < 2; ++s) {
#pragma unroll
        for (int j = 0; j < NT; ++j) bfr[s][j] = *(const bf16x8*)(sB + lds_byte(wn * NT * 16 + j * 16 + fr, s * 32 + fq * 8));
#pragma unroll
        for (int i = 0; i < MT; ++i) af[s][i] = *(const bf16x8*)(sA + lds_byte(wm * MT * 16 + i * 16 + fr, s * 32 + fq * 8));
      }
#pragma unroll
      for (int s = 0; s < 2; ++s)
#pragma unroll
        for (int i = 0; i < MT; ++i)
#pragma unroll
          for (int j = 0; j < NT; ++j) acc[i][j] = MFMA16(bfr[s][j], af[s][i], acc[i][j]);
      __builtin_amdgcn_sched_group_barrier(0x100, MT + NT, 0);
#pragma unroll
      for (int q = 0; q < MT + NT; ++q) { __builtin_amdgcn_sched_group_barrier(0x008, 2, 0); __builtin_amdgcn_sched_group_barrier(0x100, 1, 0); }
      __builtin_amdgcn_sched_group_barrier(0x008, 2 * MT * NT - 2 * (MT + NT), 0);
    } else {
#pragma unroll
      for (int s = 0; s < 2; ++s) {
        bf16x8 bfr[NT], af[MT];
#pragma unroll
        for (int j = 0; j < NT; ++j) bfr[j] = *(const bf16x8*)(sB + lds_byte(wn * NT * 16 + j * 16 + fr, s * 32 + fq * 8));
#pragma unroll
        for (int i = 0; i < MT; ++i) af[i] = *(const bf16x8*)(sA + lds_byte(wm * MT * 16 + i * 16 + fr, s * 32 + fq * 8));
#pragma unroll
        for (int i = 0; i < MT; ++i)
#pragma unroll
          for (int j = 0; j < NT; ++j) acc[i][j] = MFMA16(bfr[j], af[i], acc[i][j]);
      }
    }
    asm volatile("s_waitcnt vmcnt(0)" ::: "memory");
    __syncthreads();
  }
  if (nxtA) {
#pragma unroll
    for (int i = 0; i < MT; ++i) { int R, C; stage_rc(wid * 1024 + i * 4096 + lane * 16, R, C);
      __builtin_amdgcn_global_load_lds((const unsigned*)(nxtA + (unsigned)(R * nlda + C)), (unsigned*)(smem + wid * 1024 + i * 4096), 16, 0, 0); }
#pragma unroll
    for (int i = 0; i < NT; ++i) { int R, C; stage_rc(wid * 1024 + i * 4096 + lane * 16, R, C);
      __builtin_amdgcn_global_load_lds((const unsigned*)(nxtB + (unsigned)(R * nldb + C)), (unsigned*)(smem + TA + wid * 1024 + i * 4096), 16, 0, 0); }
  }
#undef GLDS_STAGE
}

template <int MT, int NT>
DI void gemm_prefetch(const u16* A, int lda, const u16* Bt, int ldb, unsigned char* smem) {
  constexpr int TA = MT * 32 * 128;
  const int tid = ltid(), lane = tid & 63, wid = tid >> 6;
  __syncthreads();
#pragma unroll
  for (int i = 0; i < MT; ++i) { int R, C; stage_rc(wid * 1024 + i * 4096 + lane * 16, R, C);
    __builtin_amdgcn_global_load_lds((const unsigned*)(A + (unsigned)(R * lda + C)), (unsigned*)(smem + wid * 1024 + i * 4096), 16, 0, 0); }
#pragma unroll
  for (int i = 0; i < NT; ++i) { int R, C; stage_rc(wid * 1024 + i * 4096 + lane * 16, R, C);
    __builtin_amdgcn_global_load_lds((const unsigned*)(Bt + (unsigned)(R * ldb + C)), (unsigned*)(smem + TA + wid * 1024 + i * 4096), 16, 0, 0); }
}

template <int MT, int NT> DI void zero_acc(f32x4 (&acc)[MT][NT]) {
#pragma unroll
  for (int i = 0; i < MT; ++i)
#pragma unroll
    for (int j = 0; j < NT; ++j) acc[i][j] = f32x4{0.f, 0.f, 0.f, 0.f};
}

#define EPI_LOOP(MT, NT)                                                          \
  const int tid_ = ltid(), lane_ = tid_ & 63, wave_ = tid_ >> 6;                   \
  const int wm_ = wave_ >> 1, wn_ = wave_ & 1, lq_ = lane_ & 15, quad_ = lane_ >> 4; \
  _Pragma("unroll") for (int i = 0; i < MT; ++i)                                   \
  _Pragma("unroll") for (int j = 0; j < NT; ++j)
#define EPI_ROW(m0, MT) ((m0) + wm_ * (MT) * 16 + i * 16 + lq_)
#define EPI_COL(n0, NT) ((n0) + wn_ * (NT) * 16 + j * 16 + quad_ * 4)

constexpr int GMT = 4;
DI void inproj_item(KP p, int mt, int nt, unsigned char* smem) {
  const int m0 = mt * (GMT * 32), n0 = nt * 128;
  f32x4 acc[GMT][4]; zero_acc<GMT, 4>(acc);
  gemm_acc<GMT, 4>(acc, (const u16*)(p->ws + WS_H) + (size_t)m0 * 1024, 1024, (const u16*)(p->ws + WS_WIN) + (size_t)n0 * 1024, 1024, 1024, smem);
  u16* C = (u16*)(p->ws + WS_INPROJ);
  EPI_LOOP(GMT, 4) { int row = EPI_ROW(m0, GMT), col = EPI_COL(n0, 4); if (col < LDI) *(uint2*)(C + (size_t)row * LDI + col) = make_uint2(pack2(acc[i][j][0], acc[i][j][1]), pack2(acc[i][j][2], acc[i][j][3])); }
}

DI void merge_item(KP p, int l, int mt, int nt, unsigned char* smem) {
  const int m0 = mt * 128, n0 = nt * 128;
  const u16* H = (const u16*)(p->ws + WS_H) + (size_t)m0 * 1024;
  const u16* BR = (const u16*)(p->ws + WS_BRANCH) + (size_t)m0 * 1024;
  const float* bm = p->in[33] + l * 4096;
  const u16* WM = (const u16*)(p->ws + WS_WM) + (size_t)n0 * 1024;
  const u16* WB = (const u16*)(p->ws + WS_WB) + (size_t)n0 * 256;
  unsigned am[4][4][2];
#pragma unroll
  for (int i = 0; i < 4; ++i)
#pragma unroll
    for (int j = 0; j < 4; ++j) { am[i][j][0] = 0u; am[i][j][1] = 0u; }
  gemm_prefetch<4, 4>(BR, 1024, WB, 256, smem);
#pragma unroll 1
  for (int m = 0; m < 4; ++m) {
    f32x4 acc[4][4]; zero_acc<4, 4>(acc);
    gemm_acc<4, 4, true>(acc, BR + m * 256, 1024, WB + (size_t)m * 1024 * 256, 256, 256, smem, H, 1024, WM + (size_t)m * 1024 * 1024, 1024);
    unsigned pp[4][4][2];
#pragma unroll
    for (int i = 0; i < 4; ++i)
#pragma unroll
      for (int j = 0; j < 4; ++j) { pp[i][j][0] = pack2(acc[i][j][0], acc[i][j][1]); pp[i][j][1] = pack2(acc[i][j][2], acc[i][j][3]); }
    zero_acc<4, 4>(acc);
    gemm_acc<4, 4, true>(acc, H, 1024, WM + (size_t)m * 1024 * 1024, 1024, 1024, smem,
                         m < 3 ? BR + (m + 1) * 256 : nullptr, 1024, WB + (size_t)(m + 1) * 1024 * 256, 256);
    {
      const int tid_ = ltid(), wn_ = (tid_ >> 6) & 1, quad_ = (tid_ & 63) >> 4;
      float4 bias4[4];
#pragma unroll
      for (int j = 0; j < 4; ++j) bias4[j] = *(const float4*)(bm + m * 1024 + n0 + wn_ * 64 + j * 16 + quad_ * 4);
#pragma unroll
      for (int i = 0; i < 4; ++i) {
#pragma unroll
        for (int j = 0; j < 4; ++j) {
          float v0 = bflo(am[i][j][0]) + sigm(acc[i][j][0] + bias4[j].x) * bflo(pp[i][j][0]);
          float v1 = bfhi(am[i][j][0]) + sigm(acc[i][j][1] + bias4[j].y) * bfhi(pp[i][j][0]);
          float v2 = bflo(am[i][j][1]) + sigm(acc[i][j][2] + bias4[j].z) * bflo(pp[i][j][1]);
          float v3 = bfhi(am[i][j][1]) + sigm(acc[i][j][3] + bias4[j].w) * bfhi(pp[i][j][1]);
          am[i][j][0] = pack2(v0, v1); am[i][j][1] = pack2(v2, v3);
          asm volatile("" : "+v"(am[i][j][0]), "+v"(am[i][j][1]));
          __builtin_amdgcn_sched_barrier(0);
        }
      }
    }
  }
  u16* C = (u16*)(p->ws + WS_MERGED);
  EPI_LOOP(4, 4) { int row = EPI_ROW(m0, 4), col = EPI_COL(n0, 4); *(uint2*)(C + (size_t)row * 1024 + col) = make_uint2(am[i][j][0], am[i][j][1]); }
}

DI void wout_item(KP p, int l, int mt, int nt, unsigned char* smem) {
  const int m0 = mt * (GMT * 32), n0 = nt * 128;
  f32x4 acc[GMT][4]; zero_acc<GMT, 4>(acc);
  gemm_acc<GMT, 4>(acc, (const u16*)(p->ws + WS_MERGED) + (size_t)m0 * 1024, 1024, (const u16*)(p->ws + WS_WO) + (size_t)n0 * 1024, 1024, 1024, smem);
  const float* g1 = (const float*)(p->ws + WS_MOD) + (l * 3 + mod_group(m0)) * 6144 + 2048;
  EPI_LOOP(GMT, 4) { int row = EPI_ROW(m0, GMT), col = EPI_COL(n0, 4); const float4 xv = *(const float4*)(x_in_row(p, l, row) + col), gv = *(const float4*)(g1 + col);
    *(float4*)(p->out + (size_t)row * DM + col) = make_float4(xv.x + gv.x * acc[i][j][0], xv.y + gv.y * acc[i][j][1], xv.z + gv.z * acc[i][j][2], xv.w + gv.w * acc[i][j][3]); }
}

DI void w1_item(KP p, int mt, int nt, unsigned char* smem) {
  const int m0 = mt * (GMT * 32), n0 = nt * 128;
  f32x4 acc[GMT][4]; zero_acc<GMT, 4>(acc);
  gemm_acc<GMT, 4>(acc, (const u16*)(p->ws + WS_H) + (size_t)m0 * 1024, 1024, (const u16*)(p->ws + WS_W1) + (size_t)n0 * 1024, 1024, 1024, smem);
  u16* C = (u16*)(p->ws + WS_HIDDEN);
  EPI_LOOP(GMT, 4) { int row = EPI_ROW(m0, GMT), col = EPI_COL(n0, 4); const float v0 = fmaxf(acc[i][j][0], 0.f), v1 = fmaxf(acc[i][j][1], 0.f), v2 = fmaxf(acc[i][j][2], 0.f), v3 = fmaxf(acc[i][j][3], 0.f);
    *(uint2*)(C + (size_t)row * 4096 + col) = make_uint2(pack2(v0 * v0, v1 * v1), pack2(v2 * v2, v3 * v3)); }
}

DI void w2_item(KP p, int l, int mt, int nt, unsigned char* smem) {
  const int m0 = mt * (GMT * 32), n0 = nt * 128;
  f32x4 acc[GMT][4]; zero_acc<GMT, 4>(acc);
  gemm_acc<GMT, 4>(acc, (const u16*)(p->ws + WS_HIDDEN) + (size_t)m0 * 4096, 4096, (const u16*)(p->ws + WS_W2) + (size_t)n0 * 4096, 4096, 4096, smem);
  const float* g2 = (const float*)(p->ws + WS_MOD) + (l * 3 + mod_group(m0)) * 6144 + 5120;
  EPI_LOOP(GMT, 4) { int row = EPI_ROW(m0, GMT), col = EPI_COL(n0, 4); float4* o = (float4*)(p->out + (size_t)row * DM + col); const float4 xv = *o, gv = *(const float4*)(g2 + col);
    *o = make_float4(xv.x + gv.x * acc[i][j][0], xv.y + gv.y * acc[i][j][1], xv.z + gv.z * acc[i][j][2], xv.w + gv.w * acc[i][j][3]); }
}

DI void prep_load(const u16* R, int lane, float (&hv)[12], float (&vv4)[4]) {
#pragma unroll
  for (int hh = 0; hh < 12; ++hh) {
    const int col = hh < 4 ? C_AQ + hh * 64 : (hh < 6 ? C_AK + (hh - 4) * 64 : (hh < 10 ? C_DQ + (hh - 6) * 64 : C_DK + (hh - 10) * 64));
    hv[hh] = bf2f(R[col + lane]);
  }
  vv4[0] = bf2f(R[C_AV + lane]); vv4[1] = bf2f(R[C_AV + 64 + lane]); vv4[2] = bf2f(R[C_DV + lane]); vv4[3] = bf2f(R[C_DV + 64 + lane]);
}
DI void prep_token(KP p, int l, int row, int lane, u16* R, const float (&hv)[12], const float (&vv4)[4]) {
  const bool lat = row >= 8192;
  float cs = 1.f, sn = 0.f;
  if (lat) {
    int t = (row - 8192) & 4095;
    int pos = (lane < 32) ? (t >> 6) : (t & 63);
    float inv = __expf(-(float)(lane & 15) * (9.210340371976184f / 16.f));
    float ang = (float)pos * inv;
    cs = __cosf(ang); sn = __sinf(ang);
  }
  const int b = row >> 8, t = row & 255;
#pragma unroll
  for (int hh = 0; hh < 12; ++hh) {
    int col; const float* g;
    if (hh < 4) { col = C_AQ + hh * 64; g = p->in[15] + l * 64; }
    else if (hh < 6) { col = C_AK + (hh - 4) * 64; g = p->in[16] + l * 64; }
    else if (hh < 10) { col = C_DQ + (hh - 6) * 64; g = p->in[29] + l * 64; }
    else { col = C_DK + (hh - 10) * 64; g = p->in[30] + l * 64; }
    float v = hv[hh];
    float ss = wave_sum(v * v);
    float y = v * rsqrtf(ss * (1.f / 64.f) + 1e-6f) * g[lane];
    if (lat) {
      float yp = xor16_partner(y, lane);
      y = ((lane & 31) < 16) ? (y * cs - yp * sn) : (y * cs + yp * sn);
    } else {
      if (hh == 4 || hh == 5) p->out[O_AK + ((size_t)(b * 2 + l) * 256 + t) * 128 + (hh - 4) * 64 + lane] = y;
      if (hh >= 10) p->out[O_DK + ((size_t)(b * 2 + l) * 256 + t) * 128 + (hh - 10) * 64 + lane] = y;
    }
    R[col + lane] = f2bf(y);
  }
  if (lat) {
    const int bl = (row - 8192) >> 12, tl = (row - 8192) & 4095;
    u16* VT = (u16*)(p->ws + WS_VT) + (size_t)lane * 4608 + 512 + tl;
#pragma unroll
    for (int q = 0; q < 4; ++q)
      VT[(size_t)(((q >> 1) * 2 + bl) * 2 + (q & 1)) * 64 * 4608] = f2bf(vv4[q]);
  }
  if (!lat) {
    size_t o = ((size_t)(b * 2 + l) * 256 + t) * 128;
    p->out[O_AV + o + lane] = vv4[0]; p->out[O_AV + o + 64 + lane] = vv4[1];
    p->out[O_DV + o + lane] = vv4[2]; p->out[O_DV + o + 64 + lane] = vv4[3];
  }
}
DI void prep_item(KP p, int l, int item) {
  const int tid = ltid(), lane = tid & 63, wave = tid >> 6;
  const int row0 = item * 8 + wave * 2;
  u16* R0 = (u16*)(p->ws + WS_INPROJ) + (size_t)row0 * LDI;
  u16* R1 = R0 + LDI;
  float hv0[12], vv0[4], hv1[12], vv1[4];
  prep_load(R0, lane, hv0, vv0); prep_load(R1, lane, hv1, vv1);
  prep_token(p, l, row0, lane, R0, hv0, vv0);
  prep_token(p, l, row0 + 1, lane, R1, hv1, vv1);
}

DI void kvc_item(KP p, int l, int item) {
  u16* KC = (u16*)(p->ws + WS_KC);
#pragma unroll
  for (int it = 0; it < 8; ++it) {
    int idx4 = item * 2048 + it * 256 + ltid();
    int e = idx4 * 4;
    int d = e & 63, key = (e >> 6) & 511, sel = e >> 15;
    int kv = sel & 1, kvh = (sel >> 1) & 1, b = (sel >> 2) & 1, mixer = sel >> 3;
    const float* srcb = mixer ? (kv ? p->in[6] : p->in[5]) : (kv ? p->in[4] : p->in[3]);
    const float* src = srcb + ((size_t)((b * 2 + l) * 512 + key) * 2 + kvh) * 64 + d;
    float4 v = *(const float4*)src;
    *(uint2*)(KC + e) = make_uint2(pack2(v.x, v.y), pack2(v.z, v.w));
    if (kv) {
      u16* VT = (u16*)(p->ws + WS_VT) + ((size_t)((mixer * 2 + b) * 2 + kvh) * 64 + d) * 4608 + key;
      VT[0] = f2bf(v.x); VT[4608] = f2bf(v.y); VT[2 * 4608] = f2bf(v.z); VT[3 * 4608] = f2bf(v.w);
    }
  }
}

DI void attn_item(KP p, int l, int it, unsigned char* smem) {
  u16* sK = (u16*)smem;
  u16* sVt = sK + 64 * 72;
  const int tid = ltid(), lane = tid & 63, wave = tid >> 6, lq = lane & 15, quad = lane >> 4;
  int kind, b, qh, qb;
  if (it < 512) { kind = it >> 8; int r = it & 255; b = r >> 7; qh = (r >> 5) & 3; qb = r & 31; }
  else { int r = it - 512; kind = 2 + (r >> 8); r &= 255; b = r >> 3; qh = (r >> 1) & 3; qb = r & 1; }
  const bool isD = (kind == 0 || kind == 3), lat = kind < 2;
  const int seqrow0 = lat ? 8192 + b * 4096 : b * 256;
  const int q0 = qb * 128, kvh = qh >> 1;
  const int qcol = (isD ? C_DQ : C_AQ) + qh * 64, kcol = (isD ? C_DK : C_AK) + kvh * 64, vcol = (isD ? C_DV : C_AV) + kvh * 64;
  const int ocol = (isD ? 768 : 0) + qh * 64;
  const int ncache = lat ? 8 : 0;
  int kt_lo = 0, kt_hi = lat ? 64 : 4;
  if (kind == 1) { kt_lo = max(0, 2 * qb - 2); kt_hi = min(64, 2 * qb + 4); }
  const int ntiles = ncache + kt_hi - kt_lo;
  const bool band = (kind == 1);
  const u16* INP = (const u16*)(p->ws + WS_INPROJ);
  const u16* KCk = (const u16*)(p->ws + WS_KC) + (size_t)((((isD ? 1 : 0) * 2 + b) * 2 + kvh) * 2) * 512 * 64;
  const u16* KCv = KCk + 512 * 64;
  constexpr float SC2 = 0.125f * 1.4426950408889634f;
  const float sinkv = isD ? -1e30f : p->in[17][l * 4 + qh] * 1.4426950408889634f;

  bf16x8 qf[2][2];
#pragma unroll
  for (int nt = 0; nt < 2; ++nt)
#pragma unroll
    for (int s = 0; s < 2; ++s) qf[nt][s] = ld8(INP + (size_t)(seqrow0 + q0 + wave * 32 + nt * 16 + lq) * LDI + qcol + s * 32 + quad * 8);
  float mrun[2], lsum[2];
  f32x4 oacc[4][2];
#pragma unroll
  for (int nt = 0; nt < 2; ++nt) { mrun[nt] = sinkv; lsum[nt] = (!isD && quad == 0) ? 1.f : 0.f; }
#pragma unroll
  for (int dt = 0; dt < 4; ++dt)
#pragma unroll
    for (int nt = 0; nt < 2; ++nt) oacc[dt][nt] = f32x4{0.f, 0.f, 0.f, 0.f};

  const int key = tid >> 2, seg = (tid & 3) * 16;
  struct KVReg { u32x4 k[2], v[2]; };
  KVReg R0, R1;
  const u16* VTp = (const u16*)(p->ws + WS_VT) + ((size_t)(((isD ? 1 : 0) * 2 + b) * 2 + kvh) * 64 + key) * 4608 + seg;
  auto tile_ptrs = [&](int t, const u16*& kp, const u16*& vp) {
    if (t < ncache) { kp = KCk + (size_t)(t * 64 + key) * 64 + seg; vp = VTp + t * 64; }
    else {
      const u16* rowp = INP + (size_t)(seqrow0 + (kt_lo + t - ncache) * 64 + key) * LDI; kp = rowp + kcol + seg;
      vp = lat ? VTp + 512 + (kt_lo + t - ncache) * 64 : rowp + vcol + seg;
    }
  };
  auto kvload = [&](int t, KVReg& R) {
    const u16 *kp, *vp; tile_ptrs(t, kp, vp);
    R.k[0] = *(const u32x4*)kp; R.k[1] = *(const u32x4*)(kp + 8); R.v[0] = *(const u32x4*)vp; R.v[1] = *(const u32x4*)(vp + 8);
  };
  kvload(0, R0);
  if (ntiles > 1) kvload(1, R1);
  auto step = [&](int t, KVReg& R) {
    __syncthreads();
    *(u32x4*)(sK + key * 72 + seg) = R.k[0]; *(u32x4*)(sK + key * 72 + seg + 8) = R.k[1];
    if (lat) {
      *(u32x4*)(sVt + key * 72 + seg) = R.v[0]; *(u32x4*)(sVt + key * 72 + seg + 8) = R.v[1];
    } else {
      unsigned vv[8] = {R.v[0].x, R.v[0].y, R.v[0].z, R.v[0].w, R.v[1].x, R.v[1].y, R.v[1].z, R.v[1].w};
#pragma unroll
      for (int e = 0; e < 8; ++e) { sVt[(seg + 2 * e) * 72 + key] = (u16)(vv[e] & 0xffffu); sVt[(seg + 2 * e + 1) * 72 + key] = (u16)(vv[e] >> 16); }
    }
    __syncthreads();
    if (t + 2 < ntiles) kvload(t + 2, R);
    f32x4 sacc[4][2];
#pragma unroll
    for (int mt = 0; mt < 4; ++mt) {
      sacc[mt][0] = f32x4{0.f, 0.f, 0.f, 0.f}; sacc[mt][1] = f32x4{0.f, 0.f, 0.f, 0.f};
#pragma unroll
      for (int s = 0; s < 2; ++s) {
        bf16x8 ka = ld8(sK + (mt * 16 + lq) * 72 + s * 32 + quad * 8);
        sacc[mt][0] = MFMA16(ka, qf[0][s], sacc[mt][0]);
        sacc[mt][1] = MFMA16(ka, qf[1][s], sacc[mt][1]);
      }
    }
    const bool masked_tile = band && t >= ncache;
    const int kbase = (kt_lo + t - ncache) * 64;
    bf16x8 pf[2][2];
#pragma unroll
    for (int nt = 0; nt < 2; ++nt) {
      const int qi = q0 + wave * 32 + nt * 16 + lq;
      float tmax = -1e30f;
#pragma unroll
      for (int mt = 0; mt < 4; ++mt)
#pragma unroll
        for (int r = 0; r < 4; ++r) {
          float sv_ = sacc[mt][nt][r] * SC2;
          if (masked_tile) { int kj = kbase + mt * 16 + quad * 4 + r; int dlt = qi - kj; if (dlt > 128 || dlt < -128) sv_ = -1e30f; }
          sacc[mt][nt][r] = sv_; tmax = fmaxf(tmax, sv_);
        }
      tmax = xrow32_max(xrow16_max(tmax));
      const float mold = mrun[nt];
      const float mnew = fmaxf(mold, tmax);
      float ps = 0.f;
#pragma unroll
      for (int mt = 0; mt < 4; ++mt)
#pragma unroll
        for (int r = 0; r < 4; ++r) { float e = __builtin_amdgcn_exp2f(sacc[mt][nt][r] - mnew); sacc[mt][nt][r] = e; ps += e; }
      if (__any(mnew != mold)) {
        const float alpha = __builtin_amdgcn_exp2f(mold - mnew);
        lsum[nt] *= alpha;
#pragma unroll
        for (int dt = 0; dt < 4; ++dt)
#pragma unroll
          for (int r = 0; r < 4; ++r) oacc[dt][nt][r] *= alpha;
      }
      lsum[nt] += ps; mrun[nt] = mnew;
      pf[nt][0] = pack8(sacc[0][nt], sacc[1][nt]);
      pf[nt][1] = pack8(sacc[2][nt], sacc[3][nt]);
    }
#pragma unroll
    for (int dt = 0; dt < 4; ++dt)
#pragma unroll
      for (int s2 = 0; s2 < 2; ++s2) {
        bf16x8 va = ldperm(sVt + (dt * 16 + lq) * 72 + s2 * 32 + quad * 4);
        oacc[dt][0] = MFMA16(va, pf[0][s2], oacc[dt][0]);
        oacc[dt][1] = MFMA16(va, pf[1][s2], oacc[dt][1]);
      }
  };
  for (int t = 0; t < ntiles; t += 2) { step(t, R0); if (t + 1 < ntiles) step(t + 1, R1); }
  u16* BR = (u16*)(p->ws + WS_BRANCH);
#pragma unroll
  for (int nt = 0; nt < 2; ++nt) {
    float lt = xrow32_sum(xrow16_sum(lsum[nt]));
    const float inv = __builtin_amdgcn_rcpf(lt);
    const size_t row = seqrow0 + q0 + wave * 32 + nt * 16 + lq;
#pragma unroll
    for (int dt = 0; dt < 4; ++dt)
      *(uint2*)(BR + row * 1024 + ocol + dt * 16 + quad * 4) = make_uint2(pack2(oacc[dt][nt][0] * inv, oacc[dt][nt][1] * inv), pack2(oacc[dt][nt][2] * inv, oacc[dt][nt][3] * inv));
  }
  __syncthreads();
}

DI int lru_xoff(int t, int c) { return t * 256 + (c ^ ((t & 7) << 3)); }
template <bool FINAL>
DI void lru_item(KP p, int l, int ci, unsigned char* smem) {
  u16* sxb = (u16*)smem;
  u16* sla = sxb + 32 * 256;
  u16* sbv = sla + 32 * 256;
  u16* shf = sbv + 32 * 256;
  const int tid = ltid(), ch = tid, lane = tid & 63, n = tid >> 6, lq = lane & 15, quad = lane >> 4;
  const int r0 = ci * 32;
  const bool lat = r0 >= 8192;
  int b, T, seqrow0;
  if (!lat) { b = r0 >> 8; T = 256; seqrow0 = b * 256; } else { b = (r0 - 8192) >> 12; T = 4096; seqrow0 = 8192 + b * 4096; }
  const int t0 = r0 - seqrow0;
  const u16* INP = (const u16*)(p->ws + WS_INPROJ);
  __syncthreads();
  {
    const float* cw = p->in[18] + l * 4 * 256;
    const float w0 = cw[ch], w1 = cw[256 + ch], w2 = cw[512 + ch], w3 = cw[768 + ch], cb = p->in[19][l * 256 + ch];
    auto ld = [&](int t) -> float { return (t >= 0 && t < T) ? bf2f(INP[(size_t)(seqrow0 + t) * LDI + C_LX + ch]) : 0.f; };
    float xin[35];
#pragma unroll
    for (int q = 0; q < 35; ++q) xin[q] = ld(t0 - 2 + q);
#pragma unroll
    for (int t = 0; t < 32; ++t) sxb[lru_xoff(t, ch)] = f2bf(xin[t] * w0 + xin[t + 1] * w1 + xin[t + 2] * w2 + xin[t + 3] * w3 + cb);
  }
  __syncthreads();
  const int nch = T / 32, c = t0 / 32;
  float* LC = (float*)(p->ws + WS_LRUC);
  bf16x8 af[2][2];
#pragma unroll
  for (int mt = 0; mt < 2; ++mt)
#pragma unroll
    for (int s2 = 0; s2 < 2; ++s2) af[mt][s2] = ld8(sxb + lru_xoff(mt * 16 + lq, n * 64 + s2 * 32 + quad * 8));
  for (int dir = 0; dir < 2; ++dir) {
    bf16x8 wf[2][4][2];
    {
      const u32x4* WF = (const u32x4*)(p->ws + WS_LRUW);
#pragma unroll
      for (int g = 0; g < 2; ++g)
#pragma unroll
        for (int j = 0; j < 4; ++j)
#pragma unroll
          for (int s2 = 0; s2 < 2; ++s2)
            wf[g][j][s2] = __builtin_bit_cast(bf16x8, WF[(size_t)((((((l * 2 + dir) * 2 + g) * 4 + n) * 4 + j) * 2 + s2)) * 64 + lane]);
    }
#pragma unroll
    for (int j = 0; j < 4; ++j) {
      f32x4 acc[2][2];
#pragma unroll
      for (int g = 0; g < 2; ++g) {
        f32x4 a0 = {0.f, 0.f, 0.f, 0.f}, a1 = {0.f, 0.f, 0.f, 0.f};
#pragma unroll
        for (int s2 = 0; s2 < 2; ++s2) { a0 = MFMA16(af[0][s2], wf[g][j][s2], a0); a1 = MFMA16(af[1][s2], wf[g][j][s2], a1); }
        acc[g][0] = a0; acc[g][1] = a1;
      }
      const int cc = n * 64 + j * 16 + lq;
      const float br = p->in[21][(l * 2 + dir) * 256 + cc], bi = p->in[23][(l * 2 + dir) * 256 + cc];
      const float sp = softplusf_(-p->in[24][(l * 2 + dir) * 256 + cc]);
#pragma unroll
      for (int mt = 0; mt < 2; ++mt)
#pragma unroll
        for (int r = 0; r < 4; ++r) {
          const int t = mt * 16 + quad * 4 + r;
          const float la = -8.f * sigm(acc[0][mt][r] + br) * sp;
          const float xt = bf2f(sxb[lru_xoff(t, cc)]);
          const float bb = __builtin_amdgcn_sqrtf(1.f - __expf(2.f * la)) * sigm(acc[1][mt][r] + bi) * xt;
          sla[t * 256 + cc] = f2bf(la); sbv[t * 256 + cc] = f2bf(bb);
        }
    }
    __syncthreads();
    float h = 0.f, lasum = 0.f;
    if (FINAL) {
      h = lat ? p->in[7][((b * 2 + l) * 2 + dir) * 256 + ch] : 0.f;
      const int ncar = dir == 0 ? c : nch - 1 - c;
      const int cstart = dir == 0 ? ci - c : ci - c + nch - 1, cstep = dir == 0 ? 1 : -1;
      for (int q0 = 0; q0 < ncar; q0 += 16) {
        float ca[16], chh[16];
#pragma unroll
        for (int q = 0; q < 16; ++q) {
          const int qq = q0 + q < ncar ? q0 + q : ncar - 1;
          const float* C = LC + ((size_t)((cstart + cstep * qq) * 2 + dir) * 2) * 256;
          ca[q] = C[ch]; chh[q] = C[256 + ch];
        }
#pragma unroll
        for (int q = 0; q < 16; ++q) if (q0 + q < ncar) h = ca[q] * h + chh[q];
      }
    }
#pragma unroll 1
    for (int s8 = 0; s8 < 32; s8 += 16) {
      float gv[16];
      if (FINAL && dir == 1) {
#pragma unroll
        for (int q = 0; q < 16; ++q) gv[q] = bf2f(INP[(size_t)(r0 + 31 - s8 - q) * LDI + C_LG + ch]);
      }
#pragma unroll
      for (int q = 0; q < 16; ++q) {
        const int st = s8 + q;
        const int t = dir == 0 ? st : 31 - st;
        const float la = bf2f(sla[t * 256 + ch]);
        h = __expf(la) * h + bf2f(sbv[t * 256 + ch]);
        lasum += la;
        if (FINAL) {
          if (dir == 0) shf[t * 256 + ch] = f2bf(h);
          else ((u16*)(p->ws + WS_BRANCH))[(size_t)(r0 + t) * 1024 + 256 + ch] = f2bf((bf2f(shf[t * 256 + ch]) + h) * gelu_tanh(gv[q]));
        }
      }
    }
    if (!FINAL) { float* C = LC + ((size_t)(ci * 2 + dir) * 2) * 256; C[ch] = __expf(lasum); C[256 + ch] = h; }
    else if (!lat) {
      if (dir == 0 && c == nch - 1) p->out[O_LRU + ((size_t)(b * 2 + l) * 2 + 0) * 256 + ch] = h;
      if (dir == 1 && c == 0) p->out[O_LRU + ((size_t)(b * 2 + l) * 2 + 1) * 256 + ch] = h;
    }
    __syncthreads();
  }
}

template <int DIR, bool ISW>
DI void gdn_solve(const float* L, const u16* src, const float* sb_, const float* se_, u16* UW) {
  float sol[64];
#pragma unroll
  for (int i = 0; i < 64; ++i) {
    float s = bf2f(src[(DIR == 0 ? i : 63 - i) * 72]) * sb_[i];
    if (ISW) s *= se_[i];
    float s0 = 0.f, s1 = 0.f, s2 = 0.f, s3 = 0.f;
#pragma unroll
    for (int j4 = 0; j4 < (i + 3) / 4; ++j4) {
      float4 lv = *(const float4*)(L + i * 64 + j4 * 4);
      if (j4 * 4 + 0 < i) s0 += lv.x * sol[j4 * 4 + 0];
      if (j4 * 4 + 1 < i) s1 += lv.y * sol[j4 * 4 + 1];
      if (j4 * 4 + 2 < i) s2 += lv.z * sol[j4 * 4 + 2];
      if (j4 * 4 + 3 < i) s3 += lv.w * sol[j4 * 4 + 3];
      if ((j4 & 3) == 3) asm volatile("" ::: "memory");
    }
    s -= (s0 + s1) + (s2 + s3);
    sol[i] = s;
    UW[i * 128] = f2bf(s);
    asm volatile("" ::: "memory");
  }
}

DI void gdn1_item(KP p, int l, int item, unsigned char* smem) {
  const int cgi = item >> 2, hd = item & 3;
  u16* sq = (u16*)smem; u16* sk = sq + 64 * 72; u16* sv = sk + 64 * 72;
  float* sL = (float*)(smem + 27648);
  float* sgc = (float*)(smem + 60416);
  float* sbeta = sgc + 128;
  float* sge = sbeta + 128;
  const int tid = ltid(), lane = tid & 63, wave = tid >> 6, lq = lane & 15, quad = lane >> 4;
  const int r0 = cgi * 64;
  const bool lat = r0 >= 8192;
  int T, seqrow0;
  if (!lat) { T = 256; seqrow0 = (r0 >> 8) * 256; } else { T = 4096; seqrow0 = 8192 + ((r0 - 8192) >> 12) * 4096; }
  const int t0 = r0 - seqrow0;
  const u16* INP = (const u16*)(p->ws + WS_INPROJ);
  u16* QHAT = (u16*)(p->ws + WS_QHAT) + (size_t)item * 4096;
  {
    const int d = lane, tb = wave * 16;
#pragma unroll
    for (int mat = 0; mat < 3; ++mat) {
      const int col = C_GQ + mat * 256 + hd * 64 + d, wc = mat * 256 + hd * 64 + d;
      const float* cw = p->in[25] + (size_t)l * 4 * 768;
      const float w0 = cw[wc], w1 = cw[768 + wc], w2 = cw[1536 + wc], w3 = cw[2304 + wc];
      auto ld = [&](int t) -> float { return (t >= 0 && t < T) ? bf2f(INP[(size_t)(seqrow0 + t) * LDI + col]) : 0.f; };
      float xin[19];
#pragma unroll
      for (int q = 0; q < 19; ++q) xin[q] = ld(t0 + tb - 2 + q);
      u16* dst = mat == 0 ? sq : (mat == 1 ? sk : sv);
#pragma unroll
      for (int tt = 0; tt < 16; ++tt) {
        const int t = tb + tt;
        float v = siluf_(xin[tt] * w0 + xin[tt + 1] * w1 + xin[tt + 2] * w2 + xin[tt + 3] * w3);
        if (mat < 2) { float ss = wave_sum(v * v); v *= rsqrtf(ss + 1e-6f) * (mat == 0 ? 0.125f : 1.f); }
        u16 hb = f2bf(v);
        dst[t * 72 + d] = hb;
        if (mat == 0) QHAT[t * 64 + d] = hb;
      }
    }
  }
  if (tid < 128) {
    const int dir = tid >> 6, c = tid & 63;
    const int tok = dir == 0 ? c : 63 - c;
    const u16* R = INP + (size_t)(r0 + tok) * LDI;
    const float ga = bf2f(R[C_GA + dir * 4 + hd]), gb = bf2f(R[C_GB + dir * 4 + hd]);
    const float g = -__expf(p->in[26][(l * 2 + dir) * 4 + hd]) * softplusf_(ga + p->in[27][(l * 2 + dir) * 4 + hd]);
    float gc = g;
#pragma unroll
    for (int o = 1; o < 64; o <<= 1) { float tt = __shfl_up(gc, o, 64); if (lane >= o) gc += tt; }
    const float glast = __shfl(gc, 63, 64);
    sgc[dir * 64 + c] = gc; sbeta[dir * 64 + c] = sigm(gb); sge[dir * 64 + c] = __expf(gc);
    float* gv = (float*)(p->ws + WS_GVEC) + (size_t)(item * 2 + dir) * 256;
    gv[c] = __expf(gc); gv[64 + c] = __expf(glast - gc); if (c == 0) gv[128] = __expf(glast);
  }
  __syncthreads();
  {
    const int dk = tid >> 2, c0 = (tid & 3) * 16;
    unsigned w[8];
#pragma unroll
    for (int e = 0; e < 8; ++e) w[e] = (unsigned)sk[(c0 + 2 * e) * 72 + dk] | ((unsigned)sk[(c0 + 2 * e + 1) * 72 + dk] << 16);
    u16* KT = (u16*)(p->ws + WS_KT) + (size_t)item * 4096 + dk * 64 + c0;
    *(u32x4*)KT = mku4(w[0], w[1], w[2], w[3]); *(u32x4*)(KT + 8) = mku4(w[4], w[5], w[6], w[7]);
  }
  {
    const int i0 = wave * 16;
    f32x4 akk[4], aqk[4];
#pragma unroll
    for (int nt = 0; nt < 4; ++nt) { akk[nt] = f32x4{0.f, 0.f, 0.f, 0.f}; aqk[nt] = f32x4{0.f, 0.f, 0.f, 0.f}; }
#pragma unroll
    for (int s = 0; s < 2; ++s) {
      bf16x8 ak = ld8(sk + (i0 + lq) * 72 + s * 32 + quad * 8), aq = ld8(sq + (i0 + lq) * 72 + s * 32 + quad * 8);
#pragma unroll
      for (int nt = 0; nt < 4; ++nt) { bf16x8 bk = ld8(sk + (nt * 16 + lq) * 72 + s * 32 + quad * 8); akk[nt] = MFMA16(bk, ak, akk[nt]); aqk[nt] = MFMA16(bk, aq, aqk[nt]); }
    }
    u16* QKf = (u16*)(p->ws + WS_QK) + (size_t)(item * 2 + 0) * 4096;
    u16* QKb = (u16*)(p->ws + WS_QK) + (size_t)(item * 2 + 1) * 4096;
    const int i = i0 + lq, ib = 63 - i;
    const float gci = sgc[i], gcbi = sgc[64 + ib], bti = sbeta[i], btbi = sbeta[64 + ib];
#pragma unroll
    for (int nt = 0; nt < 4; ++nt) {
      const int j0 = nt * 16 + quad * 4;
      const float4 gcj = *(const float4*)(sgc + j0), gcbj = *(const float4*)(sgc + 64 + 60 - j0);
      const float gj[4] = {gcj.x, gcj.y, gcj.z, gcj.w};
      const float gbj[4] = {gcbj.w, gcbj.z, gcbj.y, gcbj.x};
      float qf[4], qb[4];
#pragma unroll
      for (int r = 0; r < 4; ++r) {
        const int j = j0 + r, jb = 63 - j;
        const float kkv = akk[nt][r], qkv = aqk[nt][r];
        const float ef = (j <= i) ? __expf(gci - gj[r]) : 0.f;
        const float eb = (j >= i) ? __expf(gcbi - gbj[r]) : 0.f;
        if (j < i) sL[i * 64 + j] = bti * kkv * ef;
        if (j > i) sL[4096 + ib * 64 + jb] = btbi * kkv * eb;
        qf[r] = qkv * ef; qb[r] = qkv * eb;
      }
      *(uint2*)(QKf + i * 64 + j0) = make_uint2(pack2(qf[0], qf[1]), pack2(qf[2], qf[3]));
      *(uint2*)(QKb + ib * 64 + 60 - j0) = make_uint2(pack2(qb[3], qb[2]), pack2(qb[1], qb[0]));
    }
  }
  __syncthreads();
  {
    const int col = tid & 127;
    u16* UW = (u16*)(p->ws + WS_UW) + (size_t)(item * 2 + (tid >> 7)) * 8192 + col;
    for (int rep = 0; rep < NREP(2); ++rep) {
    if (tid < 128) { if (col < 64) gdn_solve<0, false>(sL, sv + col, sbeta, sge, UW); else gdn_solve<0, true>(sL, sk + (col - 64), sbeta, sge, UW); }
    else { if (col < 64) gdn_solve<1, false>(sL + 4096, sv + col, sbeta + 64, sge + 64, UW); else gdn_solve<1, true>(sL + 4096, sk + (col - 64), sbeta + 64, sge + 64, UW); }
    }
  }
  __syncthreads();
}

DI void gdn2_item(KP p, int l, int item, unsigned char* smem) {
  u16* sW = (u16*)smem; u16* sKT = sW + 64 * 72; u16* sU = sKT + 64 * 72;
  float* sg = (float*)(smem + 27648);
  const int tid = ltid(), lane = tid & 63, wave = tid >> 6, lq = lane & 15, quad = lane >> 4;
  int b, hd, dir; bool lat;
  if (item < 16) { lat = true; b = item >> 3; hd = (item >> 1) & 3; dir = item & 1; }
  else { lat = false; int r = item - 16; b = r >> 3; hd = (r >> 1) & 3; dir = r & 1; }
  const int nch = lat ? 64 : 4, cg0 = lat ? 128 + b * 64 : b * 4;
  f32x4 st[4];
#pragma unroll
  for (int kt = 0; kt < 4; ++kt)
#pragma unroll
    for (int r = 0; r < 4; ++r)
      st[kt][r] = lat ? p->in[8][((size_t)(((b * 2 + l) * 2 + dir) * 4 + hd) * 64 + kt * 16 + quad * 4 + r) * 64 + wave * 16 + lq] : 0.f;
  const int lrow = tid >> 2, seg = (tid & 3) * 16;
  struct GReg { u32x4 U[2], W[2], KT[2]; float g; };
  GReg R0, R1;
  u16* UWb = (u16*)(p->ws + WS_UW);
  const u16* KTb = (const u16*)(p->ws + WS_KT);
  const float* GV = (const float*)(p->ws + WS_GVEC);
  auto gload = [&](int n, GReg& R) {
    const int cgi = dir == 0 ? cg0 + n : cg0 + nch - 1 - n;
    const size_t prob = (size_t)cgi * 4 + hd, pd = prob * 2 + dir;
    const u16* u = UWb + (pd * 64 + lrow) * 128 + seg;
    R.U[0] = *(const u32x4*)u; R.U[1] = *(const u32x4*)(u + 8); R.W[0] = *(const u32x4*)(u + 64); R.W[1] = *(const u32x4*)(u + 72);
    const u16* kt = KTb + (prob * 64 + lrow) * 64 + (dir ? 48 - seg : seg);
    u32x4 a = *(const u32x4*)kt, bb = *(const u32x4*)(kt + 8);
    if (dir) { R.KT[0] = rev8(bb); R.KT[1] = rev8(a); } else { R.KT[0] = a; R.KT[1] = bb; }
    R.g = GV[pd * 256 + (tid & 255)];
  };
  gload(0, R0); gload(1, R1);
  auto step = [&](int n, GReg& R) {
    const int cgi = dir == 0 ? cg0 + n : cg0 + nch - 1 - n;
    const size_t pd = ((size_t)cgi * 4 + hd) * 2 + dir;
    __syncthreads();
    *(u32x4*)(sW + lrow * 72 + seg) = R.W[0]; *(u32x4*)(sW + lrow * 72 + seg + 8) = R.W[1];
    *(u32x4*)(sKT + lrow * 72 + seg) = R.KT[0]; *(u32x4*)(sKT + lrow * 72 + seg + 8) = R.KT[1];
    *(u32x4*)(sU + lrow * 72 + seg) = R.U[0]; *(u32x4*)(sU + lrow * 72 + seg + 8) = R.U[1];
    sg[tid] = R.g;
    __syncthreads();
    if (n + 2 < nch) gload(n + 2, R);
    u32x4* FR = (u32x4*)(UWb + pd * 8192);
    const float elast = sg[128];
    bf16x8 sB[2] = {pack8(st[0], st[1]), pack8(st[2], st[3])};
    FR[(0 * 4 + wave) * 64 + lane] = __builtin_bit_cast(u32x4, sB[0]);
    FR[(1 * 4 + wave) * 64 + lane] = __builtin_bit_cast(u32x4, sB[1]);
    f32x4 vn[4];
#pragma unroll
    for (int mt = 0; mt < 4; ++mt) {
      f32x4 acc = {0.f, 0.f, 0.f, 0.f};
#pragma unroll
      for (int s2 = 0; s2 < 2; ++s2) acc = MFMA16(ldperm(sW + (mt * 16 + lq) * 72 + s2 * 32 + quad * 4), sB[s2], acc);
#pragma unroll
      for (int r = 0; r < 4; ++r) vn[mt][r] = bf2f(sU[(mt * 16 + quad * 4 + r) * 72 + wave * 16 + lq]) - acc[r];
    }
    bf16x8 vB[2] = {pack8(vn[0], vn[1]), pack8(vn[2], vn[3])};
    FR[512 + (0 * 4 + wave) * 64 + lane] = __builtin_bit_cast(u32x4, vB[0]);
    FR[512 + (1 * 4 + wave) * 64 + lane] = __builtin_bit_cast(u32x4, vB[1]);
#pragma unroll
    for (int mt = 0; mt < 4; ++mt)
#pragma unroll
      for (int r = 0; r < 4; ++r) vn[mt][r] *= sg[64 + mt * 16 + quad * 4 + r];
    bf16x8 vsB[2] = {pack8(vn[0], vn[1]), pack8(vn[2], vn[3])};
#pragma unroll
    for (int kt = 0; kt < 4; ++kt) {
      f32x4 acc = {0.f, 0.f, 0.f, 0.f};
#pragma unroll
      for (int s2 = 0; s2 < 2; ++s2) acc = MFMA16(ldperm(sKT + (kt * 16 + lq) * 72 + s2 * 32 + quad * 4), vsB[s2], acc);
#pragma unroll
      for (int r = 0; r < 4; ++r) st[kt][r] = elast * st[kt][r] + acc[r];
    }
  };
  for (int n = 0; n < nch; n += 2) { step(n, R0); step(n + 1, R1); }
  if (!lat) {
#pragma unroll
    for (int kt = 0; kt < 4; ++kt)
#pragma unroll
      for (int r = 0; r < 4; ++r)
        p->out[O_GDN + ((size_t)(((b * 2 + l) * 2 + dir) * 4 + hd) * 64 + kt * 16 + quad * 4 + r) * 64 + wave * 16 + lq] = st[kt][r];
  }
  __syncthreads();
}

DI void gdnfin_item(KP p, int l, int item, unsigned char* smem) {
  u16* sQ = (u16*)smem; u16* sQK = sQ + 64 * 72;
  float* so = (float*)(smem + 3 * 64 * 72 * 2);
  float* seg_ = so + 64 * 65;
  const int cgi = item >> 2, hd = item & 3;
  const int tid = ltid(), lane = tid & 63, wave = tid >> 6, lq = lane & 15, quad = lane >> 4;
  const int lrow = tid >> 2, seg = (tid & 3) * 16;
  __syncthreads();
  {
    const u16* q = (const u16*)(p->ws + WS_QHAT) + ((size_t)item * 64 + lrow) * 64 + seg;
    *(u32x4*)(sQ + lrow * 72 + seg) = *(const u32x4*)q; *(u32x4*)(sQ + lrow * 72 + seg + 8) = *(const u32x4*)(q + 8);
#pragma unroll
    for (int dir = 0; dir < 2; ++dir) {
      const u16* qk = (const u16*)(p->ws + WS_QK) + ((size_t)(item * 2 + dir) * 64 + lrow) * 64 + seg;
      *(u32x4*)(sQK + (dir * 64 + lrow) * 72 + seg) = *(const u32x4*)qk; *(u32x4*)(sQK + (dir * 64 + lrow) * 72 + seg + 8) = *(const u32x4*)(qk + 8);
    }
    if (tid < 128) seg_[tid] = ((const float*)(p->ws + WS_GVEC))[(size_t)(item * 2 + (tid >> 6)) * 256 + (tid & 63)];
  }
  __syncthreads();
#pragma unroll
  for (int dir = 0; dir < 2; ++dir) {
    const u32x4* FR = (const u32x4*)((const u16*)(p->ws + WS_UW) + (size_t)(item * 2 + dir) * 8192);
    bf16x8 sfr[2], vfr[2];
#pragma unroll
    for (int s2 = 0; s2 < 2; ++s2) {
      sfr[s2] = __builtin_bit_cast(bf16x8, FR[(s2 * 4 + wave) * 64 + lane]);
      vfr[s2] = __builtin_bit_cast(bf16x8, FR[512 + (s2 * 4 + wave) * 64 + lane]);
    }
#pragma unroll
    for (int mt = 0; mt < 4; ++mt) {
      f32x4 acc = {0.f, 0.f, 0.f, 0.f};
      const int qrow = dir ? 63 - (mt * 16 + lq) : mt * 16 + lq;
#pragma unroll
      for (int s2 = 0; s2 < 2; ++s2) acc = MFMA16(ldperm(sQ + qrow * 72 + s2 * 32 + quad * 4), sfr[s2], acc);
#pragma unroll
      for (int r = 0; r < 4; ++r) acc[r] *= seg_[dir * 64 + mt * 16 + quad * 4 + r];
#pragma unroll
      for (int s2 = 0; s2 < 2; ++s2) acc = MFMA16(ldperm(sQK + (dir * 64 + mt * 16 + lq) * 72 + s2 * 32 + quad * 4), vfr[s2], acc);
#pragma unroll
      for (int r = 0; r < 4; ++r) {
        const int c = mt * 16 + quad * 4 + r;
        const int tk = dir ? 63 - c : c;
        float* d = so + tk * 65 + wave * 16 + lq;
        if (dir == 0) *d = acc[r]; else *d += acc[r];
      }
    }
    __syncthreads();
  }
  const float gn = p->in[28][l * 64 + lane];
  float zv[16];
#pragma unroll
  for (int q = 0; q < 16; ++q)
    zv[q] = bf2f(((const u16*)(p->ws + WS_INPROJ))[((size_t)cgi * 64 + wave * 16 + q) * LDI + C_GZ + hd * 64 + lane]);
#pragma unroll
  for (int q = 0; q < 16; ++q) {
    const int c = wave * 16 + q;
    const size_t row = (size_t)cgi * 64 + c;
    float o = so[c * 65 + lane];
    float ss = wave_sum(o * o);
    float y = o * rsqrtf(ss * (1.f / 64.f) + 1e-6f) * gn * siluf_(zv[q]);
    ((u16*)(p->ws + WS_BRANCH))[row * 1024 + 512 + hd * 64 + lane] = f2bf(y);
  }
}

#define XB_TMO      128
#define XB_XCNT(j)  (256  + 64 * (j))
#define XB_XSUB(j)  (1280 + 64 * (j))
#define XB_XGEN(j)  (2304 + 64 * (j))
#define XB_TOP      3328
#define XB_TOPGEN   3392
#define XB_SPIN_CAP (1u << 20)
#define LAS __attribute__((address_space(3)))
DI unsigned xb_ld(unsigned* q) { return __hip_atomic_load(q, __ATOMIC_RELAXED, __HIP_MEMORY_SCOPE_AGENT); }
DI unsigned xb_add(unsigned* q, unsigned v) { return __hip_atomic_fetch_add(q, v, __ATOMIC_RELAXED, __HIP_MEMORY_SCOPE_AGENT); }
DI unsigned xb_xcc_id() { return (unsigned)__builtin_amdgcn_s_getreg((3 << 11) | 20) & 0xFu; }
#define XB_SPIN(cond, bar) do { unsigned _sp = 0; while (cond) { __builtin_amdgcn_s_sleep(1); \
    if ((++_sp & 255u) == 0u) { if (xb_ld(&(bar)[XB_TMO])) break; if (_sp > XB_SPIN_CAP) { atomicAdd(&(bar)[XB_TMO], 1u); break; } } } } while (0)
DI void xcd_barrier_complete(unsigned* bar, unsigned x, unsigned& nloc, unsigned& nx) {
  const unsigned G = gridDim.x;
  unsigned sum, cnt, mine, sp = 0u;
  for (;;) {
    sum = 0u; cnt = 0u; mine = 0u;
#pragma unroll
    for (unsigned j = 0; j < 16; ++j) { const unsigned c = xb_ld(&bar[XB_XCNT(j)]); sum += c; cnt += (c > 0u) ? 1u : 0u; mine = (j == x) ? c : mine; }
    if (sum == G) break;
    __builtin_amdgcn_s_sleep(1);
    if ((++sp & 255u) == 0u) { if (xb_ld(&bar[XB_TMO])) break; if (sp > XB_SPIN_CAP) { atomicAdd(&bar[XB_TMO], 1u); break; } }
  }
  nloc = mine > 0u ? mine : 1u; nx = cnt > 0u ? cnt : 1u;
}
DI void xcd_barrier(unsigned* bar, volatile LAS unsigned* st) {
  asm volatile("s_waitcnt vmcnt(0)" ::: "memory");
  __syncthreads();
  if (ltid() == 0) {
    const unsigned x = xb_xcc_id();
    __builtin_amdgcn_s_waitcnt(0);
    unsigned nloc = st[0], nx = st[1];
    if (nloc == 0u) { xcd_barrier_complete(bar, x, nloc, nx); st[0] = nloc; st[1] = nx; }
    const unsigned old = xb_add(&bar[XB_XSUB(x)], 1u);
    const unsigned gen = old / nloc;
    if (old + 1u == (gen + 1u) * nloc) {
      __builtin_amdgcn_fence(__ATOMIC_RELEASE, "agent");
      asm volatile("s_waitcnt vmcnt(0)" ::: "memory");
      const unsigned og = xb_add(&bar[XB_TOP], 1u);
      const unsigned tg = og / nx;
      if (og + 1u == (tg + 1u) * nx) xb_add(&bar[XB_TOPGEN], 1u);
      else XB_SPIN(xb_ld(&bar[XB_TOPGEN]) == tg, bar);
      __builtin_amdgcn_fence(__ATOMIC_ACQUIRE, "agent");
      xb_add(&bar[XB_XGEN(x)], 1u);
      asm volatile("s_waitcnt vmcnt(0)" ::: "memory");
    } else {
      XB_SPIN(xb_ld(&bar[XB_XGEN(x)]) == gen, bar);
      __builtin_amdgcn_fence(__ATOMIC_ACQUIRE, "agent");
      asm volatile("s_waitcnt vmcnt(0)" ::: "memory");
    }
  }
  __syncthreads();
}


#define FOR_TILES(MTI, NTI, SM, SN, CALL)                                                      \
  do {                                                                                         \
    if (G % 8 != 0) { for (int it_ = B; it_ < (MTI) * (NTI); it_ += G) { const int mt = it_ / (NTI), nt = it_ % (NTI); CALL; } } \
    else {                                                                                     \
      const int xcd_ = B & 7, j_ = B >> 3, J_ = G >> 3;                                        \
      const int nsm_ = ((MTI) + (SM) - 1) / (SM), nsn_ = ((NTI) + (SN) - 1) / (SN);            \
      const int st_ = (SM) * (SN), mysup_ = (nsm_ * nsn_ - xcd_ + 7) / 8;                      \
        \
                                  \
      for (int u_ = j_; u_ < mysup_ * st_; u_ += J_) {                                         \
        const int s_ = xcd_ + 8 * (u_ / st_), t_ = u_ % st_;                                   \
        const int sm_ = s_ / nsn_, sn_ = s_ % nsn_;                                            \
        const int mt = sm_ * (SM) + t_ / (SN), nt = sn_ * (SN) + t_ % (SN);                    \
        if (mt < (MTI) && nt < (NTI)) { CALL; }                                                \
      }                                                                                        \
    }                                                                                          \
  } while (0)

constexpr int NPHASE = 21;
__global__ void __launch_bounds__(256, 2) mk(Params p_unused, int ph_lo, int ph_hi) {
  extern __shared__ __attribute__((aligned(1024))) unsigned char smem[];
  int& s_item = *(int*)(smem + SMEM_BYTES);
  u32x4& xb_words = *(u32x4*)(smem + SMEM_BYTES + 16);
  const int G = gridDim.x, B = blockIdx.x;
  const bool fused = ph_hi - ph_lo > 1;
  if (fused) {
    if (ltid() == 0) { xb_words = u32x4{0u, 0u, 0u, 0u}; (void)xb_add(&((unsigned*)(((KP)__builtin_amdgcn_kernarg_segment_ptr())->ws + WS_BAR))[XB_XCNT(xb_xcc_id())], 1u); }
    __syncthreads();
  }
  for (int ph = ph_lo; ph < ph_hi; ++ph) {
    KP p = (KP)__builtin_amdgcn_kernarg_segment_ptr();
    asm volatile("" : "+s"(p));
    if (ph == 0) {
      for (int it = B; it < 192 + 64; it += G) { if (it < 192) mod_item(p, it, smem); else lruw_item(p, it - 192); }
    } else {
      const int l = (ph - 1) / 10, sub = (ph - 1) % 10;
      switch (sub) {
        case 0:
          for (int it = B; it < 2048 + CONV_ITEMS; it += G) { if (it < 2048) norm_item<0>(p, l, it); else convert_item(p, l, it - 2048, smem); }
          break;
        case 1: FOR_TILES(128, 21, 8, 7, inproj_item(p, mt, nt, smem)); break;
        case 2:
          for (int it = B; it < 1024 + 512 + 64 + 2048; it += G) {
            if (it < 1024) { for (int rep = 0; rep < NREP(4); ++rep) gdn1_item(p, l, it, smem); }
            else if (it < 1536) { for (int rep = 0; rep < NREP(5); ++rep) lru_item<false>(p, l, it - 1024, smem); }
            else if (it < 1600) { if (PHON(6)) kvc_item(p, l, it - 1536); }
            else if (PHON(6)) prep_item(p, l, it - 1600);
          }
          break;
        case 3: {
          int* ctr = (int*)(p->ws + WS_CTR) + l;
          for (;;) {
            __syncthreads();
            if (ltid() == 0) s_item = atomicAdd(ctr, 1);
            __syncthreads();
            const int it = s_item;
            if (it >= 16 + 256 + 256 + 256 + 512 + 512) break;
            if (it < 16) gdn2_item(p, l, it, smem);
            else if (it < 272) { for (int rep = 0; rep < NREP(8); ++rep) attn_item(p, l, it - 16, smem); }
            else if (it < 528) gdn2_item(p, l, it - 272 + 16, smem);
            else if (it < 784) { for (int rep = 0; rep < NREP(8); ++rep) attn_item(p, l, it - 528 + 256, smem); }
            else if (it < 1296) { for (int rep = 0; rep < NREP(9); ++rep) lru_item<true>(p, l, it - 784, smem); }
            else for (int rep = 0; rep < NREP(8); ++rep) attn_item(p, l, it - 1296 + 512, smem);
          }
        } break;
        case 4: for (int it = B; it < 1024; it += G) gdnfin_item(p, l, it, smem); break;
        case 5: for (int rep = 0; rep < NREP(11); ++rep) FOR_TILES(128, 8, 8, 8, merge_item(p, l, mt, nt, smem)); break;
        case 6: FOR_TILES(128, 8, 8, 8, wout_item(p, l, mt, nt, smem)); break;
        case 7: for (int it = B; it < 2048; it += G) norm_item<1>(p, l, it); break;
        case 8: FOR_TILES(128, 32, 8, 8, w1_item(p, mt, nt, smem)); break;
        case 9: FOR_TILES(128, 8, 8, 8, w2_item(p, l, mt, nt, smem)); break;
      }
    }
    if (ph + 1 < ph_hi) {
      if (ph_hi > NPHASE) cg::this_grid().sync();
      else for (int rep = 0; rep < NREP(1); ++rep) xcd_barrier((unsigned*)(p->ws + WS_BAR), (volatile LAS unsigned*)&xb_words);
    }
  }
}

extern "C" void kernel_launch(void* const* d_in, const int* in_sizes, int n_in, void* d_out, int out_size, void* d_ws, size_t ws_size, hipStream_t stream) {
  static int grid_blocks = 0;
  if (!grid_blocks) {
    int dev = 0, cus = 0, per_cu = 0;
    (void)hipGetDevice(&dev);
    (void)hipDeviceGetAttribute(&cus, hipDeviceAttributeMultiprocessorCount, dev);
    if (hipFuncSetAttribute((const void*)mk, hipFuncAttributeMaxDynamicSharedMemorySize, DYN_LDS) != hipSuccess) fprintf(stderr, "kernel_launch: hipFuncSetAttribute failed\n");
    (void)hipOccupancyMaxActiveBlocksPerMultiprocessor(&per_cu, mk, 256, DYN_LDS);
    if (per_cu < 1) per_cu = 1;
    if (per_cu > 2) per_cu = 2;
    grid_blocks = cus * per_cu;
    if (ws_size < WS_END) fprintf(stderr, "kernel_launch: workspace too small: %zu < %zu\n", ws_size, (size_t)WS_END);
  }
  if (hipMemsetAsync((char*)d_ws + WS_CTR, 0, 256 + 3456 * 4 + 256, stream) != hipSuccess) fprintf(stderr, "kernel_launch: memset failed\n");
  Params p{};
  for (int i = 0; i < 37; ++i) p.in[i] = (const float*)d_in[i];
  p.out = (float*)d_out; p.ws = (unsigned char*)d_ws;
#if MULTI_LAUNCH
  for (int ph = 0; ph < NPHASE; ++ph) hipLaunchKernelGGL(mk, dim3(grid_blocks), dim3(256), DYN_LDS, stream, p, ph, ph + 1);
#else
  int lo = 0, hi = NPHASE;
  void* args[] = {&p, &lo, &hi};
  hipError_t e = hipLaunchCooperativeKernel((void*)mk, dim3(grid_blocks), dim3(256), args, DYN_LDS, stream);
  if (e != hipSuccess) fprintf(stderr, "cooperative launch failed: %s (grid %d)\n", hipGetErrorString(e), grid_blocks);
#endif
}
```

```cpp
#include <hip/hip_runtime.h>
#include <hip/hip_cooperative_groups.h>
#include <cstdio>
namespace cg = cooperative_groups;

#ifndef MULTI_LAUNCH
#define MULTI_LAUNCH 0
#endif
#ifndef PHM
#define PHM 0xFFFFFFFFu
#endif
#define PHON(b) ((PHM >> (b)) & 1u)
#ifndef DUPM
#define DUPM 0u
#endif
#define NREP(b) (1 + ((DUPM >> (b)) & 1u))

typedef unsigned short u16;
using bf16x8 = __attribute__((ext_vector_type(8))) short;
using f32x4 = __attribute__((ext_vector_type(4))) float;
using u32x4 = __attribute__((ext_vector_type(4))) unsigned;
#define DI __device__ __forceinline__
#define MFMA16(a, b, c) __builtin_amdgcn_mfma_f32_16x16x32_bf16((a), (b), (c), 0, 0, 0)

constexpr int NTOK = 16384;
constexpr int DM = 1024;
constexpr int LDI = 2592;
constexpr int C_AQ = 0, C_AK = 256, C_AV = 384, C_LX = 512, C_LG = 768, C_GQ = 1024, C_GK = 1280, C_GV = 1536, C_GZ = 1792,
              C_DQ = 2048, C_DK = 2304, C_DV = 2432, C_GA = 2560, C_GB = 2568;
constexpr int NIN_PAD = 2688;

constexpr size_t WS_MOD = 0;
constexpr size_t WS_CTR = WS_MOD + 2 * 3 * 6144 * 4;
constexpr size_t WS_BAR = WS_CTR + 256;
constexpr size_t WS_LRUC = WS_BAR + 3456 * 4 + 256;
constexpr size_t WS_KC = WS_LRUC + (size_t)512 * 2 * 2 * 256 * 4;
constexpr size_t WS_GVEC = WS_KC + (size_t)16 * 512 * 64 * 2;
constexpr size_t WS_LRUW = WS_GVEC + (size_t)1024 * 2 * 256 * 4;
constexpr size_t WS_VT = WS_LRUW + (size_t)256 * 64 * 16;
constexpr size_t WS_WIN = WS_VT + (size_t)8 * 64 * 4608 * 2;
constexpr size_t WS_WM = WS_WIN + (size_t)NIN_PAD * 1024 * 2;
constexpr size_t WS_WB = WS_WM + (size_t)4096 * 1024 * 2;
constexpr size_t WS_WO = WS_WB + (size_t)4 * 1024 * 256 * 2;
constexpr size_t WS_W1 = WS_WO + (size_t)1024 * 1024 * 2;
constexpr size_t WS_W2 = WS_W1 + (size_t)4096 * 1024 * 2;
constexpr size_t WS_H = WS_W2 + (size_t)1024 * 4096 * 2;
constexpr size_t WS_BIG = WS_H + (size_t)NTOK * 1024 * 2;
constexpr size_t WS_INPROJ = WS_BIG;
constexpr size_t WS_BRANCH = WS_INPROJ + (size_t)NTOK * LDI * 2;
constexpr size_t WS_QHAT = WS_BRANCH + (size_t)NTOK * 1024 * 2;
constexpr size_t WS_KT = WS_QHAT + (size_t)1024 * 4096 * 2;
constexpr size_t WS_UW = WS_KT + (size_t)1024 * 4096 * 2;
constexpr size_t WS_QK = WS_UW + (size_t)1024 * 2 * 8192 * 2;
constexpr size_t WS_END = WS_QK + (size_t)1024 * 2 * 4096 * 2;
constexpr size_t WS_HIDDEN = WS_BIG;
constexpr size_t WS_MERGED = WS_BIG;
static_assert(WS_HIDDEN + (size_t)NTOK * 4096 * 2 <= WS_END, "hidden must fit");
static_assert(WS_END <= (size_t)256 * 1024 * 1024, "workspace budget");

constexpr size_t O_X = 0, O_AK = 16777216, O_AV = 18874368, O_DK = 20971520, O_DV = 23068672, O_LRU = 25165824, O_GDN = 25198592;

struct Params {
  const float* in[37];
  float* out;
  unsigned char* ws;
};

typedef const Params __attribute__((address_space(4)))* KP;
constexpr int SMEM_BYTES = 65536;
constexpr int DYN_LDS = SMEM_BYTES + 64;

DI int ltid() { int t = threadIdx.x; asm volatile("" : "+v"(t)); return t; }
typedef __bf16 bf16v2 __attribute__((ext_vector_type(2)));
DI u16 f2bf(float x) { __bf16 h = (__bf16)x; return __builtin_bit_cast(u16, h); }
DI float bf2f(u16 h) { return __uint_as_float(((unsigned)h) << 16); }
DI unsigned pack2(float a, float b) { bf16v2 v = {(__bf16)a, (__bf16)b}; return __builtin_bit_cast(unsigned, v); }
DI float bflo(unsigned u) { return __uint_as_float(u << 16); }
DI float bfhi(unsigned u) { return __uint_as_float(u & 0xffff0000u); }
DI float sigm(float x) { return __builtin_amdgcn_rcpf(1.f + __expf(-x)); }
DI float siluf_(float x) { return x * __builtin_amdgcn_rcpf(1.f + __expf(-x)); }
DI float softplusf_(float x) { return x > 20.f ? x : __logf(1.f + __expf(x)); }
DI float gelu_tanh(float x) { float u = 0.7978845608028654f * (x + 0.044715f * x * x * x); float t = 1.f - 2.f * __builtin_amdgcn_rcpf(__expf(2.f * u) + 1.f); return 0.5f * x * (1.f + t); }
template <int CTRL> DI float dppf(float v) { return __int_as_float(__builtin_amdgcn_update_dpp(0, __float_as_int(v), CTRL, 0xF, 0xF, true)); }
DI float rlane(float v, int l) { return __int_as_float(__builtin_amdgcn_readlane(__float_as_int(v), l)); }
DI float wave_sum(float v) {
  v += dppf<0xB1>(v);
  v += dppf<0x4E>(v);
  v += dppf<0x141>(v);
  v += dppf<0x140>(v);
  return (rlane(v, 0) + rlane(v, 16)) + (rlane(v, 32) + rlane(v, 48));
}
DI float xrow16_max(float x) { auto r = __builtin_amdgcn_permlane16_swap(__float_as_uint(x), __float_as_uint(x), false, false); return fmaxf(__uint_as_float(r[0]), __uint_as_float(r[1])); }
DI float xrow32_max(float x) { auto r = __builtin_amdgcn_permlane32_swap(__float_as_uint(x), __float_as_uint(x), false, false); return fmaxf(__uint_as_float(r[0]), __uint_as_float(r[1])); }
DI float xrow16_sum(float x) { auto r = __builtin_amdgcn_permlane16_swap(__float_as_uint(x), __float_as_uint(x), false, false); return __uint_as_float(r[0]) + __uint_as_float(r[1]); }
DI float xrow32_sum(float x) { auto r = __builtin_amdgcn_permlane32_swap(__float_as_uint(x), __float_as_uint(x), false, false); return __uint_as_float(r[0]) + __uint_as_float(r[1]); }
DI float xor16_partner(float x, int lane) { auto r = __builtin_amdgcn_permlane16_swap(__float_as_uint(x), __float_as_uint(x), false, false); return __uint_as_float((lane & 16) ? r[0] : r[1]); }
DI u32x4 mku4(unsigned a, unsigned b, unsigned c, unsigned d) { u32x4 v = {a, b, c, d}; return v; }
DI bf16x8 mk8(unsigned a, unsigned b, unsigned c, unsigned d) { u32x4 v = {a, b, c, d}; return __builtin_bit_cast(bf16x8, v); }
DI bf16x8 pack8(const f32x4& x, const f32x4& y) { return mk8(pack2(x[0], x[1]), pack2(x[2], x[3]), pack2(y[0], y[1]), pack2(y[2], y[3])); }
DI bf16x8 ld8(const u16* p) { return *(const bf16x8*)p; }
DI bf16x8 ldperm(const u16* p) { uint2 a = *(const uint2*)p; uint2 b = *(const uint2*)(p + 16); return mk8(a.x, a.y, b.x, b.y); }
DI int mod_group(int row) { return row < 8192 ? 0 : 1 + ((row - 8192) >> 12); }
DI const float* x_in_row(KP p, int l, int row) {
  if (l == 0) return row < 8192 ? p->in[0] + (size_t)row * DM : p->in[1] + (size_t)(row - 8192) * DM;
  return p->out + (size_t)row * DM;
}
DI unsigned swap16(unsigned u) { return (u >> 16) | (u << 16); }
DI u32x4 rev8(u32x4 v) { return mku4(swap16(v.w), swap16(v.z), swap16(v.y), swap16(v.x)); }

DI void mod_item(KP p, int item, unsigned char* smem) {
  float* sc = (float*)smem;
  float* sr = sc + 3072;
  const int tid = ltid();
  const int l = item / 96, cb = item % 96;
  for (int i = tid; i < 3072; i += 256) {
    int g = i >> 10, k = i & 1023;
    float c = g == 0 ? p->in[9][k] : p->in[2][(g - 1) * 1024 + k];
    sc[i] = siluf_(c);
  }
  __syncthreads();
  const int col = cb * 64 + (tid & 63), kg = tid >> 6;
  const float* W = p->in[10] + (size_t)l * 1024 * 6144;
  float a0 = 0.f, a1 = 0.f, a2 = 0.f;
  for (int k0 = kg * 256; k0 < kg * 256 + 256; k0 += 32) {
    float w[32];
#pragma unroll
    for (int q = 0; q < 32; ++q) w[q] = W[(size_t)(k0 + q) * 6144 + col];
#pragma unroll
    for (int q = 0; q < 32; ++q) { a0 += sc[k0 + q] * w[q]; a1 += sc[1024 + k0 + q] * w[q]; a2 += sc[2048 + k0 + q] * w[q]; }
  }
  sr[(kg * 3 + 0) * 64 + (tid & 63)] = a0; sr[(kg * 3 + 1) * 64 + (tid & 63)] = a1; sr[(kg * 3 + 2) * 64 + (tid & 63)] = a2;
  __syncthreads();
  if (tid < 192) {
    int g = tid >> 6, cc = tid & 63;
    float s = p->in[11][l * 6144 + cb * 64 + cc];
    for (int q = 0; q < 4; ++q) s += sr[(q * 3 + g) * 64 + cc];
    ((float*)(p->ws + WS_MOD))[(l * 3 + g) * 6144 + cb * 64 + cc] = s;
  }
  __syncthreads();
}

DI void conv_tile(const float* src, int N, int k0, int n0, u16* dst, int K, bool perm, unsigned char* smem) {
  float* tile = (float*)smem;
  const int tid = ltid();
#pragma unroll
  for (int i = 0; i < 4; ++i) {
    int kr = (tid >> 4) + 16 * i, nc = (tid & 15) * 4;
    float4 v = make_float4(0.f, 0.f, 0.f, 0.f);
    if (n0 + nc < N) v = *(const float4*)(src + (size_t)(k0 + kr) * N + n0 + nc);
    tile[kr * 65 + nc] = v.x; tile[kr * 65 + nc + 1] = v.y; tile[kr * 65 + nc + 2] = v.z; tile[kr * 65 + nc + 3] = v.w;
  }
  __syncthreads();
#pragma unroll
  for (int i = 0; i < 2; ++i) {
    int n = (tid >> 3) + 32 * i, k8 = (tid & 7) * 8;
    int ng = n0 + n;
    if (ng < N) {
      int row = ng;
      if (perm) row = ng < 2048 ? ng : (ng < 2064 ? 2560 + (ng - 2048) : ng - 16);
      u32x4 o;
      o.x = pack2(tile[(k8 + 0) * 65 + n], tile[(k8 + 1) * 65 + n]);
      o.y = pack2(tile[(k8 + 2) * 65 + n], tile[(k8 + 3) * 65 + n]);
      o.z = pack2(tile[(k8 + 4) * 65 + n], tile[(k8 + 5) * 65 + n]);
      o.w = pack2(tile[(k8 + 6) * 65 + n], tile[(k8 + 7) * 65 + n]);
      *(u32x4*)(dst + (size_t)row * K + k0 + k8) = o;
    }
  }
  __syncthreads();
}

constexpr int CONV_ITEMS = 4241;
DI void convert_item(KP p, int l, int item, unsigned char* smem) {
  unsigned char* ws = p->ws;
  if (item < 656) { int kt = item / 41, nt = item % 41; conv_tile(p->in[14] + (size_t)l * 1024 * 2576, 2576, kt * 64, nt * 64, (u16*)(ws + WS_WIN), 1024, true, smem); return; }
  item -= 656;
  if (item < 1024) { int kt = item >> 6, nt = item & 63; conv_tile(p->in[32] + (size_t)l * 1024 * 4096, 4096, kt * 64, nt * 64, (u16*)(ws + WS_WM), 1024, false, smem); return; }
  item -= 1024;
  if (item < 256) { int m = item >> 6, r = item & 63, kt = r >> 4, nt = r & 15;
    conv_tile(p->in[31] + ((size_t)l * 4 + m) * 256 * 1024, 1024, kt * 64, nt * 64, (u16*)(ws + WS_WB) + (size_t)m * 1024 * 256, 256, false, smem); return; }
  item -= 256;
  if (item < 256) { int kt = item >> 4, nt = item & 15; conv_tile(p->in[34] + (size_t)l * 1024 * 1024, 1024, kt * 64, nt * 64, (u16*)(ws + WS_WO), 1024, false, smem); return; }
  item -= 256;
  if (item < 1024) { int kt = item >> 6, nt = item & 63; conv_tile(p->in[35] + (size_t)l * 1024 * 4096, 4096, kt * 64, nt * 64, (u16*)(ws + WS_W1), 1024, false, smem); return; }
  item -= 1024;
  if (item < 1024) { int kt = item >> 4, nt = item & 15; conv_tile(p->in[36] + (size_t)l * 4096 * 1024, 1024, kt * 64, nt * 64, (u16*)(ws + WS_W2), 4096, false, smem); return; }
  u32x4* z = (u32x4*)((u16*)(ws + WS_WIN) + (size_t)2576 * 1024);
  for (int i = ltid(); i < 112 * 1024 / 8; i += 256) z[i] = mku4(0, 0, 0, 0);
}

DI void lruw_item(KP p, int item) {
  const int gid = item * 256 + ltid();
  const int lane = gid & 63, fg = gid >> 6;
  const int s2 = fg & 1, j = (fg >> 1) & 3, n = (fg >> 3) & 3, g = (fg >> 5) & 1, ld_ = fg >> 6;
  const int lq = lane & 15, quad = lane >> 4;
  const float* W = (g == 0 ? p->in[20] : p->in[22]) + ((size_t)(ld_ * 4 + n) * 64) * 64 + (size_t)(s2 * 32 + quad * 8) * 64 + j * 16 + lq;
  u32x4 o = {pack2(W[0], W[64]), pack2(W[128], W[192]), pack2(W[256], W[320]), pack2(W[384], W[448])};
  ((u32x4*)(p->ws + WS_LRUW))[gid] = o;
}

template <int which>
DI void norm_item(KP p, int l, int item) {
  const int tid = ltid(), lane = tid & 63, wave = tid >> 6;
  const float* g = p->in[which == 0 ? 12 : 13] + l * 1024;
  f32x4 v[2][4]; float ss[2] = {0.f, 0.f};
#pragma unroll
  for (int h = 0; h < 2; ++h) {
    const int row = item * 8 + wave * 2 + h;
    const float* x = x_in_row(p, which == 0 ? l : 2, row);
#pragma unroll
    for (int i = 0; i < 4; ++i) v[h][i] = *(const f32x4*)(x + i * 256 + lane * 4);
  }
#pragma unroll
  for (int h = 0; h < 2; ++h) {
#pragma unroll
    for (int i = 0; i < 4; ++i) ss[h] += v[h][i].x * v[h][i].x + v[h][i].y * v[h][i].y + v[h][i].z * v[h][i].z + v[h][i].w * v[h][i].w;
    ss[h] = wave_sum(ss[h]);
  }
#pragma unroll
  for (int h = 0; h < 2; ++h) {
    const int row = item * 8 + wave * 2 + h;
    const float* mod = (const float*)(p->ws + WS_MOD) + (l * 3 + mod_group(row)) * 6144;
    const float* sh = mod + (which == 0 ? 0 : 3072);
    const float* sc = mod + (which == 0 ? 1024 : 4096);
    const float rstd = rsqrtf(ss[h] * (1.f / 1024.f) + 1e-6f);
    u16* H = (u16*)(p->ws + WS_H) + (size_t)row * 1024;
#pragma unroll
    for (int i = 0; i < 4; ++i) {
      int c = i * 256 + lane * 4;
      float4 gg = *(const float4*)(g + c), s1 = *(const float4*)(sc + c), s0 = *(const float4*)(sh + c);
      float y0 = v[h][i].x * rstd * gg.x * (1.f + s1.x) + s0.x, y1 = v[h][i].y * rstd * gg.y * (1.f + s1.y) + s0.y;
      float y2 = v[h][i].z * rstd * gg.z * (1.f + s1.z) + s0.z, y3 = v[h][i].w * rstd * gg.w * (1.f + s1.w) + s0.w;
      *(uint2*)(H + c) = make_uint2(pack2(y0, y1), pack2(y2, y3));
    }
  }
}

DI int lds_byte(int r, int c) {
  int st = (r >> 4) * 2 + (c >> 5), ob = (r & 15) * 64 + (c & 31) * 2;
  return st * 1024 + (ob ^ (((ob >> 9) & 1) << 5));
}
DI void stage_rc(int b, int& R, int& C) {
  int st = b >> 10, sb = b & 1023, swz = sb ^ (((sb >> 9) & 1) << 5);
  R = (st >> 1) * 16 + (swz >> 6);
  C = (st & 1) * 32 + ((swz & 63) >> 1);
}
template <int MT, int NT, bool pre = false>
DI void gemm_acc(f32x4 (&acc)[MT][NT], const u16* __restrict__ A, int lda, const u16* __restrict__ Bt, int ldb, int K, unsigned char* smem,
                 const u16* nxtA = nullptr, int nlda = 0, const u16* nxtB = nullptr, int nldb = 0) {
  constexpr int TA = MT * 32 * 128, TB = NT * 32 * 128, STAGE = TA + TB;
  static_assert(2 * STAGE <= 65536, "LDS");
  const int tid = ltid(), lane = tid & 63, wid = tid >> 6, wm = wid >> 1, wn = wid & 1;
  const int fr = lane & 15, fq = lane >> 4;
  const u16* ga[MT]; const u16* gb[NT];
#pragma unroll
  for (int i = 0; i < MT; ++i) { int R, C; stage_rc(wid * 1024 + i * 4096 + lane * 16, R, C); ga[i] = A + (size_t)R * lda + C; }
#pragma unroll
  for (int i = 0; i < NT; ++i) { int R, C; stage_rc(wid * 1024 + i * 4096 + lane * 16, R, C); gb[i] = Bt + (size_t)R * ldb + C; }
#define GLDS_STAGE(buf, k0)                                                                                                        \
  do {                                                                                                                             \
    _Pragma("unroll") for (int i = 0; i < MT; ++i)                                                                                 \
      __builtin_amdgcn_global_load_lds((const unsigned*)(ga[i] + (k0)), (unsigned*)(smem + (buf) * STAGE + wid * 1024 + i * 4096), 16, 0, 0); \
    _Pragma("unroll") for (int i = 0; i < NT; ++i)                                                                                 \
      __builtin_amdgcn_global_load_lds((const unsigned*)(gb[i] + (k0)), (unsigned*)(smem + (buf) * STAGE + TA + wid * 1024 + i * 4096), 16, 0, 0); \
  } while (0)
  if (!pre) {
    __syncthreads();
    GLDS_STAGE(0, 0);
  }
  asm volatile("s_waitcnt vmcnt(0)" ::: "memory");
  __syncthreads();
  const int nt = K >> 6;
  for (int t = 0; t < nt; ++t) {
    const int cur = t & 1;
    if (t + 1 < nt) GLDS_STAGE(cur ^ 1, (t + 1) * 64);
    const unsigned char* sA = smem + cur * STAGE;
    const unsigned char* sB = sA + TA;
    if constexpr (!pre) {
      bf16x8 bfr[2][NT], af[2][MT];
#pragma unroll
      for (int s = 0; s < 2; ++s) {
#pragma unroll
        for (int j = 0; j < NT; ++j) bfr[s][j] = *(const bf16x8*)(sB + lds_byte(wn * NT * 16 + j * 16 + fr, s * 32 + fq * 8));
#pragma unroll
        for (int i = 0; i < MT; ++i) af[s][i] = *(const bf16x8*)(sA + lds_byte(wm * MT * 16 + i * 16 + fr, s * 32 + fq * 8));
      }
#pragma unroll
      for (int s = 0; s < 2; ++s)
#pragma unroll
        for (int i = 0; i < MT; ++i)
#pragma unroll
          for (int j = 0; j < NT; ++j) acc[i][j] = MFMA16(bfr[s][j], af[s][i], acc[i][j]);
      __builtin_amdgcn_sched_group_barrier(0x100, MT + NT, 0);
#pragma unroll
      for (int q = 0; q < MT + NT; ++q) { __builtin_amdgcn_sched_group_barrier(0x008, 2, 0); __builtin_amdgcn_sched_group_barrier(0x100, 1, 0); }
      __builtin_amdgcn_sched_group_barrier(0x008, 2 * MT * NT - 2 * (MT + NT), 0);
    } else {
#pragma unroll
      for (int s = 0; s < 2; ++s) {
        bf16x8 bfr[NT], af[MT];
#pragma unroll
        for (int j = 0; j < NT; ++j) bfr[j] = *(const bf16x8*)(sB + lds_byte(wn * NT * 16 + j * 16 + fr, s * 32 + fq * 8));
#pragma unroll
        for (int i = 0; i < MT; ++i) af[i] = *(const bf16x8*)(sA + lds_byte(wm * MT * 16 + i * 16 + fr, s * 32 + fq * 8));
#pragma unroll
        for (int i = 0; i < MT; ++i)
#pragma unroll
          for (int j = 0; j < NT; ++j) acc[i][j] = MFMA16(bfr[j], af[i], acc[i][j]);
      }
    }
    asm volatile("s_waitcnt vmcnt(0)" ::: "memory");
    __syncthreads();
  }
  if (nxtA) {
#pragma unroll
    for (int i = 0; i < MT; ++i) { int R, C; stage_rc(wid * 1024 + i * 4096 + lane * 16, R, C);
      __builtin_amdgcn_global_load_lds((const unsigned*)(nxtA + (unsigned)(R * nlda + C)), (unsigned*)(smem + wid * 1024 + i * 4096), 16, 0, 0); }
#pragma unroll
    for (int i = 0; i < NT; ++i) { int R, C; stage_rc(wid * 1024 + i * 4096 + lane * 16, R, C);
      __builtin_amdgcn_global_load_lds((const unsigned*)(nxtB + (unsigned)(R * nldb + C)), (unsigned*)(smem + TA + wid * 1024 + i * 4096), 16, 0, 0); }
  }
#undef GLDS_STAGE
}

template <int MT, int NT>
DI void gemm_prefetch(const u16* A, int lda, const u16* Bt, int ldb, unsigned char* smem) {
  constexpr int TA = MT * 32 * 128;
  const int tid = ltid(), lane = tid & 63, wid = tid >> 6;
  __syncthreads();
#pragma unroll
  for (int i = 0; i < MT; ++i) { int R, C; stage_rc(wid * 1024 + i * 4096 + lane * 16, R, C);
    __builtin_amdgcn_global_load_lds((const unsigned*)(A + (unsigned)(R * lda + C)), (unsigned*)(smem + wid * 1024 + i * 4096), 16, 0, 0); }
#pragma unroll
  for (int i = 0; i < NT; ++i) { int R, C; stage_rc(wid * 1024 + i * 4096 + lane * 16, R, C);
    __builtin_amdgcn_global_load_lds((const unsigned*)(Bt + (unsigned)(R * ldb + C)), (unsigned*)(smem + TA + wid * 1024 + i * 4096), 16, 0, 0); }
}

template <int MT, int NT> DI void zero_acc(f32x4 (&acc)[MT][NT]) {
#pragma unroll
  for (int i = 0; i < MT; ++i)
#pragma unroll
    for (int j = 0; j < NT; ++j) acc[i][j] = f32x4{0.f, 0.f, 0.f, 0.f};
}

#define EPI_LOOP(MT, NT)                                                          \
  const int tid_ = ltid(), lane_ = tid_ & 63, wave_ = tid_ >> 6;                   \
  const int wm_ = wave_ >> 1, wn_ = wave_ & 1, lq_ = lane_ & 15, quad_ = lane_ >> 4; \
  _Pragma("unroll") for (int i = 0; i < MT; ++i)                                   \
  _Pragma("unroll") for (int j = 0; j < NT; ++j)
#define EPI_ROW(m0, MT) ((m0) + wm_ * (MT) * 16 + i * 16 + lq_)
#define EPI_COL(n0, NT) ((n0) + wn_ * (NT) * 16 + j * 16 + quad_ * 4)

constexpr int GMT = 4;
DI void inproj_item(KP p, int mt, int nt, unsigned char* smem) {
  const int m0 = mt * (GMT * 32), n0 = nt * 128;
  f32x4 acc[GMT][4]; zero_acc<GMT, 4>(acc);
  gemm_acc<GMT, 4>(acc, (const u16*)(p->ws + WS_H) + (size_t)m0 * 1024, 1024, (const u16*)(p->ws + WS_WIN) + (size_t)n0 * 1024, 1024, 1024, smem);
  u16* C = (u16*)(p->ws + WS_INPROJ);
  EPI_LOOP(GMT, 4) { int row = EPI_ROW(m0, GMT), col = EPI_COL(n0, 4); if (col < LDI) *(uint2*)(C + (size_t)row * LDI + col) = make_uint2(pack2(acc[i][j][0], acc[i][j][1]), pack2(acc[i][j][2], acc[i][j][3])); }
}

DI void merge_item(KP p, int l, int mt, int nt, unsigned char* smem) {
  const int m0 = mt * 128, n0 = nt * 128;
  const u16* H = (const u16*)(p->ws + WS_H) + (size_t)m0 * 1024;
  const u16* BR = (const u16*)(p->ws + WS_BRANCH) + (size_t)m0 * 1024;
  const float* bm = p->in[33] + l * 4096;
  const u16* WM = (const u16*)(p->ws + WS_WM) + (size_t)n0 * 1024;
  const u16* WB = (const u16*)(p->ws + WS_WB) + (size_t)n0 * 256;
  unsigned am[4][4][2];
#pragma unroll
  for (int i = 0; i < 4; ++i)
#pragma unroll
    for (int j = 0; j < 4; ++j) { am[i][j][0] = 0u; am[i][j][1] = 0u; }
  gemm_prefetch<4, 4>(BR, 1024, WB, 256, smem);
#pragma unroll 1
  for (int m = 0; m < 4; ++m) {
    f32x4 acc[4][4]; zero_acc<4, 4>(acc);
    gemm_acc<4, 4, true>(acc, BR + m * 256, 1024, WB + (size_t)m * 1024 * 256, 256, 256, smem, H, 1024, WM + (size_t)m * 1024 * 1024, 1024);
    unsigned pp[4][4][2];
#pragma unroll
    for (int i = 0; i < 4; ++i)
#pragma unroll
      for (int j = 0; j < 4; ++j) { pp[i][j][0] = pack2(acc[i][j][0], acc[i][j][1]); pp[i][j][1] = pack2(acc[i][j][2], acc[i][j][3]); }
    zero_acc<4, 4>(acc);
    gemm_acc<4, 4, true>(acc, H, 1024, WM + (size_t)m * 1024 * 1024, 1024, 1024, smem,
                         m < 3 ? BR + (m + 1) * 256 : nullptr, 1024, WB + (size_t)(m + 1) * 1024 * 256, 256);
    {
      const int tid_ = ltid(), wn_ = (tid_ >> 6) & 1, quad_ = (tid_ & 63) >> 4;
      float4 bias4[4];
#pragma unroll
      for (int j = 0; j < 4; ++j) bias4[j] = *(const float4*)(bm + m * 1024 + n0 + wn_ * 64 + j * 16 + quad_ * 4);
#pragma unroll
      for (int i = 0; i < 4; ++i) {
#pragma unroll
        for (int j = 0; j < 4; ++j) {
          float v0 = bflo(am[i][j][0]) + sigm(acc[i][j][0] + bias4[j].x) * bflo(pp[i][j][0]);
          float v1 = bfhi(am[i][j][0]) + sigm(acc[i][j][1] + bias4[j].y) * bfhi(pp[i][j][0]);
          float v2 = bflo(am[i][j][1]) + sigm(acc[i][j][2] + bias4[j].z) * bflo(pp[i][j][1]);
          float v3 = bfhi(am[i][j][1]) + sigm(acc[i][j][3] + bias4[j].w) * bfhi(pp[i][j][1]);
          am[i][j][0] = pack2(v0, v1); am[i][j][1] = pack2(v2, v3);
          asm volatile("" : "+v"(am[i][j][0]), "+v"(am[i][j][1]));
          __builtin_amdgcn_sched_barrier(0);
        }
      }
    }
  }
  u16* C = (u16*)(p->ws + WS_MERGED);
  EPI_LOOP(4, 4) { int row = EPI_ROW(m0, 4), col = EPI_COL(n0, 4); *(uint2*)(C + (size_t)row * 1024 + col) = make_uint2(am[i][j][0], am[i][j][1]); }
}

DI void wout_item(KP p, int l, int mt, int nt, unsigned char* smem) {
  const int m0 = mt * (GMT * 32), n0 = nt * 128;
  f32x4 acc[GMT][4]; zero_acc<GMT, 4>(acc);
  gemm_acc<GMT, 4>(acc, (const u16*)(p->ws + WS_MERGED) + (size_t)m0 * 1024, 1024, (const u16*)(p->ws + WS_WO) + (size_t)n0 * 1024, 1024, 1024, smem);
  const float* g1 = (const float*)(p->ws + WS_MOD) + (l * 3 + mod_group(m0)) * 6144 + 2048;
  EPI_LOOP(GMT, 4) { int row = EPI_ROW(m0, GMT), col = EPI_COL(n0, 4); const float4 xv = *(const float4*)(x_in_row(p, l, row) + col), gv = *(const float4*)(g1 + col);
    *(float4*)(p->out + (size_t)row * DM + col) = make_float4(xv.x + gv.x * acc[i][j][0], xv.y + gv.y * acc[i][j][1], xv.z + gv.z * acc[i][j][2], xv.w + gv.w * acc[i][j][3]); }
}

DI void w1_item(KP p, int mt, int nt, unsigned char* smem) {
  const int m0 = mt * (GMT * 32), n0 = nt * 128;
  f32x4 acc[GMT][4]; zero_acc<GMT, 4>(acc);
  gemm_acc<GMT, 4>(acc, (const u16*)(p->ws + WS_H) + (size_t)m0 * 1024, 1024, (const u16*)(p->ws + WS_W1) + (size_t)n0 * 1024, 1024, 1024, smem);
  u16* C = (u16*)(p->ws + WS_HIDDEN);
  EPI_LOOP(GMT, 4) { int row = EPI_ROW(m0, GMT), col = EPI_COL(n0, 4); const float v0 = fmaxf(acc[i][j][0], 0.f), v1 = fmaxf(acc[i][j][1], 0.f), v2 = fmaxf(acc[i][j][2], 0.f), v3 = fmaxf(acc[i][j][3], 0.f);
    *(uint2*)(C + (size_t)row * 4096 + col) = make_uint2(pack2(v0 * v0, v1 * v1), pack2(v2 * v2, v3 * v3)); }
}

DI void w2_item(KP p, int l, int mt, int nt, unsigned char* smem) {
  const int m0 = mt * (GMT * 32), n0 = nt * 128;
  f32x4 acc[GMT][4]; zero_acc<GMT, 4>(acc);
  gemm_acc<GMT, 4>(acc, (const u16*)(p->ws + WS_HIDDEN) + (size_t)m0 * 4096, 4096, (const u16*)(p->ws + WS_W2) + (size_t)n0 * 4096, 4096, 4096, smem);
  const float* g2 = (const float*)(p->ws + WS_MOD) + (l * 3 + mod_group(m0)) * 6144 + 5120;
  EPI_LOOP(GMT, 4) { int row = EPI_ROW(m0, GMT), col = EPI_COL(n0, 4); float4* o = (float4*)(p->out + (size_t)row * DM + col); const float4 xv = *o, gv = *(const float4*)(g2 + col);
    *o = make_float4(xv.x + gv.x * acc[i][j][0], xv.y + gv.y * acc[i][j][1], xv.z + gv.z * acc[i][j][2], xv.w + gv.w * acc[i][j][3]); }
}

DI void prep_load(const u16* R, int lane, float (&hv)[12], float (&vv4)[4]) {
#pragma unroll
  for (int hh = 0; hh < 12; ++hh) {
    const int col = hh < 4 ? C_AQ + hh * 64 : (hh < 6 ? C_AK + (hh - 4) * 64 : (hh < 10 ? C_DQ + (hh - 6) * 64 : C_DK + (hh - 10) * 64));
    hv[hh] = bf2f(R[col + lane]);
  }
  vv4[0] = bf2f(R[C_AV + lane]); vv4[1] = bf2f(R[C_AV + 64 + lane]); vv4[2] = bf2f(R[C_DV + lane]); vv4[3] = bf2f(R[C_DV + 64 + lane]);
}
DI void prep_token(KP p, int l, int row, int lane, u16* R, const float (&hv)[12], const float (&vv4)[4]) {
  const bool lat = row >= 8192;
  float cs = 1.f, sn = 0.f;
  if (lat) {
    int t = (row - 8192) & 4095;
    int pos = (lane < 32) ? (t >> 6) : (t & 63);
    float inv = __expf(-(float)(lane & 15) * (9.210340371976184f / 16.f));
    float ang = (float)pos * inv;
    cs = __cosf(ang); sn = __sinf(ang);
  }
  const int b = row >> 8, t = row & 255;
#pragma unroll
  for (int hh = 0; hh < 12; ++hh) {
    int col; const float* g;
    if (hh < 4) { col = C_AQ + hh * 64; g = p->in[15] + l * 64; }
    else if (hh < 6) { col = C_AK + (hh - 4) * 64; g = p->in[16] + l * 64; }
    else if (hh < 10) { col = C_DQ + (hh - 6) * 64; g = p->in[29] + l * 64; }
    else { col = C_DK + (hh - 10) * 64; g = p->in[30] + l * 64; }
    float v = hv[hh];
    float ss = wave_sum(v * v);
    float y = v * rsqrtf(ss * (1.f / 64.f) + 1e-6f) * g[lane];
    if (lat) {
      float yp = xor16_partner(y, lane);
      y = ((lane & 31) < 16) ? (y * cs - yp * sn) : (y * cs + yp * sn);
    } else {
      if (hh == 4 || hh == 5) p->out[O_AK + ((size_t)(b * 2 + l) * 256 + t) * 128 + (hh - 4) * 64 + lane] = y;
      if (hh >= 10) p->out[O_DK + ((size_t)(b * 2 + l) * 256 + t) * 128 + (hh - 10) * 64 + lane] = y;
    }
    R[col + lane] = f2bf(y);
  }
  if (lat) {
    const int bl = (row - 8192) >> 12, tl = (row - 8192) & 4095;
    u16* VT = (u16*)(p->ws + WS_VT) + (size_t)lane * 4608 + 512 + tl;
#pragma unroll
    for (int q = 0; q < 4; ++q)
      VT[(size_t)(((q >> 1) * 2 + bl) * 2 + (q & 1)) * 64 * 4608] = f2bf(vv4[q]);
  }
  if (!lat) {
    size_t o = ((size_t)(b * 2 + l) * 256 + t) * 128;
    p->out[O_AV + o + lane] = vv4[0]; p->out[O_AV + o + 64 + lane] = vv4[1];
    p->out[O_DV + o + lane] = vv4[2]; p->out[O_DV + o + 64 + lane] = vv4[3];
  }
}
DI void prep_item(KP p, int l, int item) {
  const int tid = ltid(), lane = tid & 63, wave = tid >> 6;
  const int row0 = item * 8 + wave * 2;
  u16* R0 = (u16*)(p->ws + WS_INPROJ) + (size_t)row0 * LDI;
  u16* R1 = R0 + LDI;
  float hv0[12], vv0[4], hv1[12], vv1[4];
  prep_load(R0, lane, hv0, vv0); prep_load(R1, lane, hv1, vv1);
  prep_token(p, l, row0, lane, R0, hv0, vv0);
  prep_token(p, l, row0 + 1, lane, R1, hv1, vv1);
}

DI void kvc_item(KP p, int l, int item) {
  u16* KC = (u16*)(p->ws + WS_KC);
#pragma unroll
  for (int it = 0; it < 8; ++it) {
    int idx4 = item * 2048 + it * 256 + ltid();
    int e = idx4 * 4;
    int d = e & 63, key = (e >> 6) & 511, sel = e >> 15;
    int kv = sel & 1, kvh = (sel >> 1) & 1, b = (sel >> 2) & 1, mixer = sel >> 3;
    const float* srcb = mixer ? (kv ? p->in[6] : p->in[5]) : (kv ? p->in[4] : p->in[3]);
    const float* src = srcb + ((size_t)((b * 2 + l) * 512 + key) * 2 + kvh) * 64 + d;
    float4 v = *(const float4*)src;
    *(uint2*)(KC + e) = make_uint2(pack2(v.x, v.y), pack2(v.z, v.w));
    if (kv) {
      u16* VT = (u16*)(p->ws + WS_VT) + ((size_t)((mixer * 2 + b) * 2 + kvh) * 64 + d) * 4608 + key;
      VT[0] = f2bf(v.x); VT[4608] = f2bf(v.y); VT[2 * 4608] = f2bf(v.z); VT[3 * 4608] = f2bf(v.w);
    }
  }
}

DI void attn_item(KP p, int l, int it, unsigned char* smem) {
  u16* sK = (u16*)smem;
  u16* sVt = sK + 64 * 72;
  const int tid = ltid(), lane = tid & 63, wave = tid >> 6, lq = lane & 15, quad = lane >> 4;
  int kind, b, qh, qb;
  if (it < 512) { kind = it >> 8; int r = it & 255; b = r >> 7; qh = (r >> 5) & 3; qb = r & 31; }
  else { int r = it - 512; kind = 2 + (r >> 8); r &= 255; b = r >> 3; qh = (r >> 1) & 3; qb = r & 1; }
  const bool isD = (kind == 0 || kind == 3), lat = kind < 2;
  const int seqrow0 = lat ? 8192 + b * 4096 : b * 256;
  const int q0 = qb * 128, kvh = qh >> 1;
  const int qcol = (isD ? C_DQ : C_AQ) + qh * 64, kcol = (isD ? C_DK : C_AK) + kvh * 64, vcol = (isD ? C_DV : C_AV) + kvh * 64;
  const int ocol = (isD ? 768 : 0) + qh * 64;
  const int ncache = lat ? 8 : 0;
  int kt_lo = 0, kt_hi = lat ? 64 : 4;
  if (kind == 1) { kt_lo = max(0, 2 * qb - 2); kt_hi = min(64, 2 * qb + 4); }
  const int ntiles = ncache + kt_hi - kt_lo;
  const bool band = (kind == 1);
  const u16* INP = (const u16*)(p->ws + WS_INPROJ);
  const u16* KCk = (const u16*)(p->ws + WS_KC) + (size_t)((((isD ? 1 : 0) * 2 + b) * 2 + kvh) * 2) * 512 * 64;
  const u16* KCv = KCk + 512 * 64;
  constexpr float SC2 = 0.125f * 1.4426950408889634f;
  const float sinkv = isD ? -1e30f : p->in[17][l * 4 + qh] * 1.4426950408889634f;

  bf16x8 qf[2][2];
#pragma unroll
  for (int nt = 0; nt < 2; ++nt)
#pragma unroll
    for (int s = 0; s < 2; ++s) qf[nt][s] = ld8(INP + (size_t)(seqrow0 + q0 + wave * 32 + nt * 16 + lq) * LDI + qcol + s * 32 + quad * 8);
  float mrun[2], lsum[2];
  f32x4 oacc[4][2];
#pragma unroll
  for (int nt = 0; nt < 2; ++nt) { mrun[nt] = sinkv; lsum[nt] = (!isD && quad == 0) ? 1.f : 0.f; }
#pragma unroll
  for (int dt = 0; dt < 4; ++dt)
#pragma unroll
    for (int nt = 0; nt < 2; ++nt) oacc[dt][nt] = f32x4{0.f, 0.f, 0.f, 0.f};

  const int key = tid >> 2, seg = (tid & 3) * 16;
  struct KVReg { u32x4 k[2], v[2]; };
  KVReg R0, R1;
  const u16* VTp = (const u16*)(p->ws + WS_VT) + ((size_t)(((isD ? 1 : 0) * 2 + b) * 2 + kvh) * 64 + key) * 4608 + seg;
  auto tile_ptrs = [&](int t, const u16*& kp, const u16*& vp) {
    if (t < ncache) { kp = KCk + (size_t)(t * 64 + key) * 64 + seg; vp = VTp + t * 64; }
    else {
      const u16* rowp = INP + (size_t)(seqrow0 + (kt_lo + t - ncache) * 64 + key) * LDI; kp = rowp + kcol + seg;
      vp = lat ? VTp + 512 + (kt_lo + t - ncache) * 64 : rowp + vcol + seg;
    }
  };
  auto kvload = [&](int t, KVReg& R) {
    const u16 *kp, *vp; tile_ptrs(t, kp, vp);
    R.k[0] = *(const u32x4*)kp; R.k[1] = *(const u32x4*)(kp + 8); R.v[0] = *(const u32x4*)vp; R.v[1] = *(const u32x4*)(vp + 8);
  };
  kvload(0, R0);
  if (ntiles > 1) kvload(1, R1);
  auto step = [&](int t, KVReg& R) {
    __syncthreads();
    *(u32x4*)(sK + key * 72 + seg) = R.k[0]; *(u32x4*)(sK + key * 72 + seg + 8) = R.k[1];
    if (lat) {
      *(u32x4*)(sVt + key * 72 + seg) = R.v[0]; *(u32x4*)(sVt + key * 72 + seg + 8) = R.v[1];
    } else {
      unsigned vv[8] = {R.v[0].x, R.v[0].y, R.v[0].z, R.v[0].w, R.v[1].x, R.v[1].y, R.v[1].z, R.v[1].w};
#pragma unroll
      for (int e = 0; e < 8; ++e) { sVt[(seg + 2 * e) * 72 + key] = (u16)(vv[e] & 0xffffu); sVt[(seg + 2 * e + 1) * 72 + key] = (u16)(vv[e] >> 16); }
    }
    __syncthreads();
    if (t + 2 < ntiles) kvload(t + 2, R);
    f32x4 sacc[4][2];
#pragma unroll
    for (int mt = 0; mt < 4; ++mt) {
      sacc[mt][0] = f32x4{0.f, 0.f, 0.f, 0.f}; sacc[mt][1] = f32x4{0.f, 0.f, 0.f, 0.f};
#pragma unroll
      for (int s = 0; s < 2; ++s) {
        bf16x8 ka = ld8(sK + (mt * 16 + lq) * 72 + s * 32 + quad * 8);
        sacc[mt][0] = MFMA16(ka, qf[0][s], sacc[mt][0]);
        sacc[mt][1] = MFMA16(ka, qf[1][s], sacc[mt][1]);
      }
    }
    const bool masked_tile = band && t >= ncache;
    const int kbase = (kt_lo + t - ncache) * 64;
    bf16x8 pf[2][2];
#pragma unroll
    for (int nt = 0; nt < 2; ++nt) {
      const int qi = q0 + wave * 32 + nt * 16 + lq;
      float tmax = -1e30f;
#pragma unroll
      for (int mt = 0; mt < 4; ++mt)
#pragma unroll
        for (int r = 0; r < 4; ++r) {
          float sv_ = sacc[mt][nt][r] * SC2;
          if (masked_tile) { int kj = kbase + mt * 16 + quad * 4 + r; int dlt = qi - kj; if (dlt > 128 || dlt < -128) sv_ = -1e30f; }
          sacc[mt][nt][r] = sv_; tmax = fmaxf(tmax, sv_);
        }
      tmax = xrow32_max(xrow16_max(tmax));
      const float mold = mrun[nt];
      const float mnew = fmaxf(mold, tmax);
      float ps = 0.f;
#pragma unroll
      for (int mt = 0; mt < 4; ++mt)
#pragma unroll
        for (int r = 0; r < 4; ++r) { float e = __builtin_amdgcn_exp2f(sacc[mt][nt][r] - mnew); sacc[mt][nt][r] = e; ps += e; }
      if (__any(mnew != mold)) {
        const float alpha = __builtin_amdgcn_exp2f(mold - mnew);
        lsum[nt] *= alpha;
#pragma unroll
        for (int dt = 0; dt < 4; ++dt)
#pragma unroll
          for (int r = 0; r < 4; ++r) oacc[dt][nt][r] *= alpha;
      }
      lsum[nt] += ps; mrun[nt] = mnew;
      pf[nt][0] = pack8(sacc[0][nt], sacc[1][nt]);
      pf[nt][1] = pack8(sacc[2][nt], sacc[3][nt]);
    }
#pragma unroll
    for (int dt = 0; dt < 4; ++dt)
#pragma unroll
      for (int s2 = 0; s2 < 2; ++s2) {
        bf16x8 va = ldperm(sVt + (dt * 16 + lq) * 72 + s2 * 32 + quad * 4);
        oacc[dt][0] = MFMA16(va, pf[0][s2], oacc[dt][0]);
        oacc[dt][1] = MFMA16(va, pf[1][s2], oacc[dt][1]);
      }
  };
  for (int t = 0; t < ntiles; t += 2) { step(t, R0); if (t + 1 < ntiles) step(t + 1, R1); }
  u16* BR = (u16*)(p->ws + WS_BRANCH);
#pragma unroll
  for (int nt = 0; nt < 2; ++nt) {
    float lt = xrow32_sum(xrow16_sum(lsum[nt]));
    const float inv = __builtin_amdgcn_rcpf(lt);
    const size_t row = seqrow0 + q0 + wave * 32 + nt * 16 + lq;
#pragma unroll
    for (int dt = 0; dt < 4; ++dt)
      *(uint2*)(BR + row * 1024 + ocol + dt * 16 + quad * 4) = make_uint2(pack2(oacc[dt][nt][0] * inv, oacc[dt][nt][1] * inv), pack2(oacc[dt][nt][2] * inv, oacc[dt][nt][3] * inv));
  }
  __syncthreads();
}

DI int lru_xoff(int t, int c) { return t * 256 + (c ^ ((t & 7) << 3)); }
template <bool FINAL>
DI void lru_item(KP p, int l, int ci, unsigned char* smem) {
  u16* sxb = (u16*)smem;
  u16* sla = sxb + 32 * 256;
  u16* sbv = sla + 32 * 256;
  u16* shf = sbv + 32 * 256;
  const int tid = ltid(), ch = tid, lane = tid & 63, n = tid >> 6, lq = lane & 15, quad = lane >> 4;
  const int r0 = ci * 32;
  const bool lat = r0 >= 8192;
  int b, T, seqrow0;
  if (!lat) { b = r0 >> 8; T = 256; seqrow0 = b * 256; } else { b = (r0 - 8192) >> 12; T = 4096; seqrow0 = 8192 + b * 4096; }
  const int t0 = r0 - seqrow0;
  const u16* INP = (const u16*)(p->ws + WS_INPROJ);
  __syncthreads();
  {
    const float* cw = p->in[18] + l * 4 * 256;
    const float w0 = cw[ch], w1 = cw[256 + ch], w2 = cw[512 + ch], w3 = cw[768 + ch], cb = p->in[19][l * 256 + ch];
    auto ld = [&](int t) -> float { return (t >= 0 && t < T) ? bf2f(INP[(size_t)(seqrow0 + t) * LDI + C_LX + ch]) : 0.f; };
    float xin[35];
#pragma unroll
    for (int q = 0; q < 35; ++q) xin[q] = ld(t0 - 2 + q);
#pragma unroll
    for (int t = 0; t < 32; ++t) sxb[lru_xoff(t, ch)] = f2bf(xin[t] * w0 + xin[t + 1] * w1 + xin[t + 2] * w2 + xin[t + 3] * w3 + cb);
  }
  __syncthreads();
  const int nch = T / 32, c = t0 / 32;
  float* LC = (float*)(p->ws + WS_LRUC);
  bf16x8 af[2][2];
#pragma unroll
  for (int mt = 0; mt < 2; ++mt)
#pragma unroll
    for (int s2 = 0; s2 < 2; ++s2) af[mt][s2] = ld8(sxb + lru_xoff(mt * 16 + lq, n * 64 + s2 * 32 + quad * 8));
  for (int dir = 0; dir < 2; ++dir) {
    bf16x8 wf[2][4][2];
    {
      const u32x4* WF = (const u32x4*)(p->ws + WS_LRUW);
#pragma unroll
      for (int g = 0; g < 2; ++g)
#pragma unroll
        for (int j = 0; j < 4; ++j)
#pragma unroll
          for (int s2 = 0; s2 < 2; ++s2)
            wf[g][j][s2] = __builtin_bit_cast(bf16x8, WF[(size_t)((((((l * 2 + dir) * 2 + g) * 4 + n) * 4 + j) * 2 + s2)) * 64 + lane]);
    }
#pragma unroll
    for (int j = 0; j < 4; ++j) {
      f32x4 acc[2][2];
#pragma unroll
      for (int g = 0; g < 2; ++g) {
        f32x4 a0 = {0.f, 0.f, 0.f, 0.f}, a1 = {0.f, 0.f, 0.f, 0.f};
#pragma unroll
        for (int s2 = 0; s2 < 2; ++s2) { a0 = MFMA16(af[0][s2], wf[g][j][s2], a0); a1 = MFMA16(af[1][s2], wf[g][j][s2], a1); }
        acc[g][0] = a0; acc[g][1] = a1;
      }
      const int cc = n * 64 + j * 16 + lq;
      const float br = p->in[21][(l * 2 + dir) * 256 + cc], bi = p->in[23][(l * 2 + dir) * 256 + cc];
      const float sp = softplusf_(-p->in[24][(l * 2 + dir) * 256 + cc]);
#pragma unroll
      for (int mt = 0; mt < 2; ++mt)
#pragma unroll
        for (int r = 0; r < 4; ++r) {
          const int t = mt * 16 + quad * 4 + r;
          const float la = -8.f * sigm(acc[0][mt][r] + br) * sp;
          const float xt = bf2f(sxb[lru_xoff(t, cc)]);
          const float bb = __builtin_amdgcn_sqrtf(1.f - __expf(2.f * la)) * sigm(acc[1][mt][r] + bi) * xt;
          sla[t * 256 + cc] = f2bf(la); sbv[t * 256 + cc] = f2bf(bb);
        }
    }
    __syncthreads();
    float h = 0.f, lasum = 0.f;
    if (FINAL) {
      h = lat ? p->in[7][((b * 2 + l) * 2 + dir) * 256 + ch] : 0.f;
      const int ncar = dir == 0 ? c : nch - 1 - c;
      const int cstart = dir == 0 ? ci - c : ci - c + nch - 1, cstep = dir == 0 ? 1 : -1;
      for (int q0 = 0; q0 < ncar; q0 += 16) {
        float ca[16], chh[16];
#pragma unroll
        for (int q = 0; q < 16; ++q) {
          const int qq = q0 + q < ncar ? q0 + q : ncar - 1;
          const float* C = LC + ((size_t)((cstart + cstep * qq) * 2 + dir) * 2) * 256;
          ca[q] = C[ch]; chh[q] = C[256 + ch];
        }
#pragma unroll
        for (int q = 0; q < 16; ++q) if (q0 + q < ncar) h = ca[q] * h + chh[q];
      }
    }
#pragma unroll 1
    for (int s8 = 0; s8 < 32; s8 += 16) {
      float gv[16];
      if (FINAL && dir == 1) {
#pragma unroll
        for (int q = 0; q < 16; ++q) gv[q] = bf2f(INP[(size_t)(r0 + 31 - s8 - q) * LDI + C_LG + ch]);
      }
#pragma unroll
      for (int q = 0; q < 16; ++q) {
        const int st = s8 + q;
        const int t = dir == 0 ? st : 31 - st;
        const float la = bf2f(sla[t * 256 + ch]);
        h = __expf(la) * h + bf2f(sbv[t * 256 + ch]);
        lasum += la;
        if (FINAL) {
          if (dir == 0) shf[t * 256 + ch] = f2bf(h);
          else ((u16*)(p->ws + WS_BRANCH))[(size_t)(r0 + t) * 1024 + 256 + ch] = f2bf((bf2f(shf[t * 256 + ch]) + h) * gelu_tanh(gv[q]));
        }
      }
    }
    if (!FINAL) { float* C = LC + ((size_t)(ci * 2 + dir) * 2) * 256; C[ch] = __expf(lasum); C[256 + ch] = h; }
    else if (!lat) {
      if (dir == 0 && c == nch - 1) p->out[O_LRU + ((size_t)(b * 2 + l) * 2 + 0) * 256 + ch] = h;
      if (dir == 1 && c == 0) p->out[O_LRU + ((size_t)(b * 2 + l) * 2 + 1) * 256 + ch] = h;
    }
    __syncthreads();
  }
}

template <int DIR, bool ISW>
DI void gdn_solve(const float* L, const u16* src, const float* sb_, const float* se_, u16* UW) {
  float sol[64];
#pragma unroll
  for (int i = 0; i < 64; ++i) {
    float s = bf2f(src[(DIR == 0 ? i : 63 - i) * 72]) * sb_[i];
    if (ISW) s *= se_[i];
    float s0 = 0.f, s1 = 0.f, s2 = 0.f, s3 = 0.f;
#pragma unroll
    for (int j4 = 0; j4 < (i + 3) / 4; ++j4) {
      float4 lv = *(const float4*)(L + i * 64 + j4 * 4);
      if (j4 * 4 + 0 < i) s0 += lv.x * sol[j4 * 4 + 0];
      if (j4 * 4 + 1 < i) s1 += lv.y * sol[j4 * 4 + 1];
      if (j4 * 4 + 2 < i) s2 += lv.z * sol[j4 * 4 + 2];
      if (j4 * 4 + 3 < i) s3 += lv.w * sol[j4 * 4 + 3];
      if ((j4 & 3) == 3) asm volatile("" ::: "memory");
    }
    s -= (s0 + s1) + (s2 + s3);
    sol[i] = s;
    UW[i * 128] = f2bf(s);
    asm volatile("" ::: "memory");
  }
}

DI void gdn1_item(KP p, int l, int item, unsigned char* smem) {
  const int cgi = item >> 2, hd = item & 3;
  u16* sq = (u16*)smem; u16* sk = sq + 64 * 72; u16* sv = sk + 64 * 72;
  float* sL = (float*)(smem + 27648);
  float* sgc = (float*)(smem + 60416);
  float* sbeta = sgc + 128;
  float* sge = sbeta + 128;
  const int tid = ltid(), lane = tid & 63, wave = tid >> 6, lq = lane & 15, quad = lane >> 4;
  const int r0 = cgi * 64;
  const bool lat = r0 >= 8192;
  int T, seqrow0;
  if (!lat) { T = 256; seqrow0 = (r0 >> 8) * 256; } else { T = 4096; seqrow0 = 8192 + ((r0 - 8192) >> 12) * 4096; }
  const int t0 = r0 - seqrow0;
  const u16* INP = (const u16*)(p->ws + WS_INPROJ);
  u16* QHAT = (u16*)(p->ws + WS_QHAT) + (size_t)item * 4096;
  {
    const int d = lane, tb = wave * 16;
#pragma unroll
    for (int mat = 0; mat < 3; ++mat) {
      const int col = C_GQ + mat * 256 + hd * 64 + d, wc = mat * 256 + hd * 64 + d;
      const float* cw = p->in[25] + (size_t)l * 4 * 768;
      const float w0 = cw[wc], w1 = cw[768 + wc], w2 = cw[1536 + wc], w3 = cw[2304 + wc];
      auto ld = [&](int t) -> float { return (t >= 0 && t < T) ? bf2f(INP[(size_t)(seqrow0 + t) * LDI + col]) : 0.f; };
      float xin[19];
#pragma unroll
      for (int q = 0; q < 19; ++q) xin[q] = ld(t0 + tb - 2 + q);
      u16* dst = mat == 0 ? sq : (mat == 1 ? sk : sv);
#pragma unroll
      for (int tt = 0; tt < 16; ++tt) {
        const int t = tb + tt;
        float v = siluf_(xin[tt] * w0 + xin[tt + 1] * w1 + xin[tt + 2] * w2 + xin[tt + 3] * w3);
        if (mat < 2) { float ss = wave_sum(v * v); v *= rsqrtf(ss + 1e-6f) * (mat == 0 ? 0.125f : 1.f); }
        u16 hb = f2bf(v);
        dst[t * 72 + d] = hb;
        if (mat == 0) QHAT[t * 64 + d] = hb;
      }
    }
  }
  if (tid < 128) {
    const int dir = tid >> 6, c = tid & 63;
    const int tok = dir == 0 ? c : 63 - c;
    const u16* R = INP + (size_t)(r0 + tok) * LDI;
    const float ga = bf2f(R[C_GA + dir * 4 + hd]), gb = bf2f(R[C_GB + dir * 4 + hd]);
    const float g = -__expf(p->in[26][(l * 2 + dir) * 4 + hd]) * softplusf_(ga + p->in[27][(l * 2 + dir) * 4 + hd]);
    float gc = g;
#pragma unroll
    for (int o = 1; o < 64; o <<= 1) { float tt = __shfl_up(gc, o, 64); if (lane >= o) gc += tt; }
    const float glast = __shfl(gc, 63, 64);
    sgc[dir * 64 + c] = gc; sbeta[dir * 64 + c] = sigm(gb); sge[dir * 64 + c] = __expf(gc);
    float* gv = (float*)(p->ws + WS_GVEC) + (size_t)(item * 2 + dir) * 256;
    gv[c] = __expf(gc); gv[64 + c] = __expf(glast - gc); if (c == 0) gv[128] = __expf(glast);
  }
  __syncthreads();
  {
    const int dk = tid >> 2, c0 = (tid & 3) * 16;
    unsigned w[8];
#pragma unroll
    for (int e = 0; e < 8; ++e) w[e] = (unsigned)sk[(c0 + 2 * e) * 72 + dk] | ((unsigned)sk[(c0 + 2 * e + 1) * 72 + dk] << 16);
    u16* KT = (u16*)(p->ws + WS_KT) + (size_t)item * 4096 + dk * 64 + c0;
    *(u32x4*)KT = mku4(w[0], w[1], w[2], w[3]); *(u32x4*)(KT + 8) = mku4(w[4], w[5], w[6], w[7]);
  }
  {
    const int i0 = wave * 16;
    f32x4 akk[4], aqk[4];
#pragma unroll
    for (int nt = 0; nt < 4; ++nt) { akk[nt] = f32x4{0.f, 0.f, 0.f, 0.f}; aqk[nt] = f32x4{0.f, 0.f, 0.f, 0.f}; }
#pragma unroll
    for (int s = 0; s < 2; ++s) {
      bf16x8 ak = ld8(sk + (i0 + lq) * 72 + s * 32 + quad * 8), aq = ld8(sq + (i0 + lq) * 72 + s * 32 + quad * 8);
#pragma unroll
      for (int nt = 0; nt < 4; ++nt) { bf16x8 bk = ld8(sk + (nt * 16 + lq) * 72 + s * 32 + quad * 8); akk[nt] = MFMA16(bk, ak, akk[nt]); aqk[nt] = MFMA16(bk, aq, aqk[nt]); }
    }
    u16* QKf = (u16*)(p->ws + WS_QK) + (size_t)(item * 2 + 0) * 4096;
    u16* QKb = (u16*)(p->ws + WS_QK) + (size_t)(item * 2 + 1) * 4096;
    const int i = i0 + lq, ib = 63 - i;
    const float gci = sgc[i], gcbi = sgc[64 + ib], bti = sbeta[i], btbi = sbeta[64 + ib];
#pragma unroll
    for (int nt = 0; nt < 4; ++nt) {
      const int j0 = nt * 16 + quad * 4;
      const float4 gcj = *(const float4*)(sgc + j0), gcbj = *(const float4*)(sgc + 64 + 60 - j0);
      const float gj[4] = {gcj.x, gcj.y, gcj.z, gcj.w};
      const float gbj[4] = {gcbj.w, gcbj.z, gcbj.y, gcbj.x};
      float qf[4], qb[4];
#pragma unroll
      for (int r = 0; r < 4; ++r) {
        const int j = j0 + r, jb = 63 - j;
        const float kkv = akk[nt][r], qkv = aqk[nt][r];
        const float ef = (j <= i) ? __expf(gci - gj[r]) : 0.f;
        const float eb = (j >= i) ? __expf(gcbi - gbj[r]) : 0.f;
        if (j < i) sL[i * 64 + j] = bti * kkv * ef;
        if (j > i) sL[4096 + ib * 64 + jb] = btbi * kkv * eb;
        qf[r] = qkv * ef; qb[r] = qkv * eb;
      }
      *(uint2*)(QKf + i * 64 + j0) = make_uint2(pack2(qf[0], qf[1]), pack2(qf[2], qf[3]));
      *(uint2*)(QKb + ib * 64 + 60 - j0) = make_uint2(pack2(qb[3], qb[2]), pack2(qb[1], qb[0]));
    }
  }
  __syncthreads();
  {
    const int col = tid & 127;
    u16* UW = (u16*)(p->ws + WS_UW) + (size_t)(item * 2 + (tid >> 7)) * 8192 + col;
    for (int rep = 0; rep < NREP(2); ++rep) {
    if (tid < 128) { if (col < 64) gdn_solve<0, false>(sL, sv + col, sbeta, sge, UW); else gdn_solve<0, true>(sL, sk + (col - 64), sbeta, sge, UW); }
    else { if (col < 64) gdn_solve<1, false>(sL + 4096, sv + col, sbeta + 64, sge + 64, UW); else gdn_solve<1, true>(sL + 4096, sk + (col - 64), sbeta + 64, sge + 64, UW); }
    }
  }
  __syncthreads();
}

DI void gdn2_item(KP p, int l, int item, unsigned char* smem) {
  u16* sW = (u16*)smem; u16* sKT = sW + 64 * 72; u16* sU = sKT + 64 * 72;
  float* sg = (float*)(smem + 27648);
  const int tid = ltid(), lane = tid & 63, wave = tid >> 6, lq = lane & 15, quad = lane >> 4;
  int b, hd, dir; bool lat;
  if (item < 16) { lat = true; b = item >> 3; hd = (item >> 1) & 3; dir = item & 1; }
  else { lat = false; int r = item - 16; b = r >> 3; hd = (r >> 1) & 3; dir = r & 1; }
  const int nch = lat ? 64 : 4, cg0 = lat ? 128 + b * 64 : b * 4;
  f32x4 st[4];
#pragma unroll
  for (int kt = 0; kt < 4; ++kt)
#pragma unroll
    for (int r = 0; r < 4; ++r)
      st[kt][r] = lat ? p->in[8][((size_t)(((b * 2 + l) * 2 + dir) * 4 + hd) * 64 + kt * 16 + quad * 4 + r) * 64 + wave * 16 + lq] : 0.f;
  const int lrow = tid >> 2, seg = (tid & 3) * 16;
  struct GReg { u32x4 U[2], W[2], KT[2]; float g; };
  GReg R0, R1;
  u16* UWb = (u16*)(p->ws + WS_UW);
  const u16* KTb = (const u16*)(p->ws + WS_KT);
  const float* GV = (const float*)(p->ws + WS_GVEC);
  auto gload = [&](int n, GReg& R) {
    const int cgi = dir == 0 ? cg0 + n : cg0 + nch - 1 - n;
    const size_t prob = (size_t)cgi * 4 + hd, pd = prob * 2 + dir;
    const u16* u = UWb + (pd * 64 + lrow) * 128 + seg;
    R.U[0] = *(const u32x4*)u; R.U[1] = *(const u32x4*)(u + 8); R.W[0] = *(const u32x4*)(u + 64); R.W[1] = *(const u32x4*)(u + 72);
    const u16* kt = KTb + (prob * 64 + lrow) * 64 + (dir ? 48 - seg : seg);
    u32x4 a = *(const u32x4*)kt, bb = *(const u32x4*)(kt + 8);
    if (dir) { R.KT[0] = rev8(bb); R.KT[1] = rev8(a); } else { R.KT[0] = a; R.KT[1] = bb; }
    R.g = GV[pd * 256 + (tid & 255)];
  };
  gload(0, R0); gload(1, R1);
  auto step = [&](int n, GReg& R) {
    const int cgi = dir == 0 ? cg0 + n : cg0 + nch - 1 - n;
    const size_t pd = ((size_t)cgi * 4 + hd) * 2 + dir;
    __syncthreads();
    *(u32x4*)(sW + lrow * 72 + seg) = R.W[0]; *(u32x4*)(sW + lrow * 72 + seg + 8) = R.W[1];
    *(u32x4*)(sKT + lrow * 72 + seg) = R.KT[0]; *(u32x4*)(sKT + lrow * 72 + seg + 8) = R.KT[1];
    *(u32x4*)(sU + lrow * 72 + seg) = R.U[0]; *(u32x4*)(sU + lrow * 72 + seg + 8) = R.U[1];
    sg[tid] = R.g;
    __syncthreads();
    if (n + 2 < nch) gload(n + 2, R);
    u32x4* FR = (u32x4*)(UWb + pd * 8192);
    const float elast = sg[128];
    bf16x8 sB[2] = {pack8(st[0], st[1]), pack8(st[2], st[3])};
    FR[(0 * 4 + wave) * 64 + lane] = __builtin_bit_cast(u32x4, sB[0]);
    FR[(1 * 4 + wave) * 64 + lane] = __builtin_bit_cast(u32x4, sB[1]);
    f32x4 vn[4];
#pragma unroll
    for (int mt = 0; mt < 4; ++mt) {
      f32x4 acc = {0.f, 0.f, 0.f, 0.f};
#pragma unroll
      for (int s2 = 0; s2 < 2; ++s2) acc = MFMA16(ldperm(sW + (mt * 16 + lq) * 72 + s2 * 32 + quad * 4), sB[s2], acc);
#pragma unroll
      for (int r = 0; r < 4; ++r) vn[mt][r] = bf2f(sU[(mt * 16 + quad * 4 + r) * 72 + wave * 16 + lq]) - acc[r];
    }
    bf16x8 vB[2] = {pack8(vn[0], vn[1]), pack8(vn[2], vn[3])};
    FR[512 + (0 * 4 + wave) * 64 + lane] = __builtin_bit_cast(u32x4, vB[0]);
    FR[512 + (1 * 4 + wave) * 64 + lane] = __builtin_bit_cast(u32x4, vB[1]);
#pragma unroll
    for (int mt = 0; mt < 4; ++mt)
#pragma unroll
      for (int r = 0; r < 4; ++r) vn[mt][r] *= sg[64 + mt * 16 + quad * 4 + r];
    bf16x8 vsB[2] = {pack8(vn[0], vn[1]), pack8(vn[2], vn[3])};
#pragma unroll
    for (int kt = 0; kt < 4; ++kt) {
      f32x4 acc = {0.f, 0.f, 0.f, 0.f};
#pragma unroll
      for (int s2 = 0; s2 < 2; ++s2) acc = MFMA16(ldperm(sKT + (kt * 16 + lq) * 72 + s2 * 32 + quad * 4), vsB[s2], acc);
#pragma unroll
      for (int r = 0; r < 4; ++r) st[kt][r] = elast * st[kt][r] + acc[r];
    }
  };
  for (int n = 0; n < nch; n += 2) { step(n, R0); step(n + 1, R1); }
  if (!lat) {
#pragma unroll
    for (int kt = 0; kt < 4; ++kt)
#pragma unroll
      for (int r = 0; r < 4; ++r)
        p->out[O_GDN + ((size_t)(((b * 2 + l) * 2 + dir) * 4 + hd) * 64 + kt * 16 + quad * 4 + r) * 64 + wave * 16 + lq] = st[kt][r];
  }
  __syncthreads();
}

DI void gdnfin_item(KP p, int l, int item, unsigned char* smem) {
  u16* sQ = (u16*)smem; u16* sQK = sQ + 64 * 72;
  float* so = (float*)(smem + 3 * 64 * 72 * 2);
  float* seg_ = so + 64 * 65;
  const int cgi = item >> 2, hd = item & 3;
  const int tid = ltid(), lane = tid & 63, wave = tid >> 6, lq = lane & 15, quad = lane >> 4;
  const int lrow = tid >> 2, seg = (tid & 3) * 16;
  __syncthreads();
  {
    const u16* q = (const u16*)(p->ws + WS_QHAT) + ((size_t)item * 64 + lrow) * 64 + seg;
    *(u32x4*)(sQ + lrow * 72 + seg) = *(const u32x4*)q; *(u32x4*)(sQ + lrow * 72 + seg + 8) = *(const u32x4*)(q + 8);
#pragma unroll
    for (int dir = 0; dir < 2; ++dir) {
      const u16* qk = (const u16*)(p->ws + WS_QK) + ((size_t)(item * 2 + dir) * 64 + lrow) * 64 + seg;
      *(u32x4*)(sQK + (dir * 64 + lrow) * 72 + seg) = *(const u32x4*)qk; *(u32x4*)(sQK + (dir * 64 + lrow) * 72 + seg + 8) = *(const u32x4*)(qk + 8);
    }
    if (tid < 128) seg_[tid] = ((const float*)(p->ws + WS_GVEC))[(size_t)(item * 2 + (tid >> 6)) * 256 + (tid & 63)];
  }
  __syncthreads();
#pragma unroll
  for (int dir = 0; dir < 2; ++dir) {
    const u32x4* FR = (const u32x4*)((const u16*)(p->ws + WS_UW) + (size_t)(item * 2 + dir) * 8192);
    bf16x8 sfr[2], vfr[2];
#pragma unroll
    for (int s2 = 0; s2 < 2; ++s2) {
      sfr[s2] = __builtin_bit_cast(bf16x8, FR[(s2 * 4 + wave) * 64 + lane]);
      vfr[s2] = __builtin_bit_cast(bf16x8, FR[512 + (s2 * 4 + wave) * 64 + lane]);
    }
#pragma unroll
    for (int mt = 0; mt < 4; ++mt) {
      f32x4 acc = {0.f, 0.f, 0.f, 0.f};
      const int qrow = dir ? 63 - (mt * 16 + lq) : mt * 16 + lq;
#pragma unroll
      for (int s2 = 0; s2 < 2; ++s2) acc = MFMA16(ldperm(sQ + qrow * 72 + s2 * 32 + quad * 4), sfr[s2], acc);
#pragma unroll
      for (int r = 0; r < 4; ++r) acc[r] *= seg_[dir * 64 + mt * 16 + quad * 4 + r];
#pragma unroll
      for (int s2 = 0; s2 < 2; ++s2) acc = MFMA16(ldperm(sQK + (dir * 64 + mt * 16 + lq) * 72 + s2 * 32 + quad * 4), vfr[s2], acc);
#pragma unroll
      for (int r = 0; r < 4; ++r) {
        const int c = mt * 16 + quad * 4 + r;
        const int tk = dir ? 63 - c : c;
        float* d = so + tk * 65 + wave * 16 + lq;
        if (dir == 0) *d = acc[r]; else *d += acc[r];
      }
    }
    __syncthreads();
  }
  const float gn = p->in[28][l * 64 + lane];
  float zv[16];
#pragma unroll
  for (int q = 0; q < 16; ++q)
    zv[q] = bf2f(((const u16*)(p->ws + WS_INPROJ))[((size_t)cgi * 64 + wave * 16 + q) * LDI + C_GZ + hd * 64 + lane]);
#pragma unroll
  for (int q = 0; q < 16; ++q) {
    const int c = wave * 16 + q;
    const size_t row = (size_t)cgi * 64 + c;
    float o = so[c * 65 + lane];
    float ss = wave_sum(o * o);
    float y = o * rsqrtf(ss * (1.f / 64.f) + 1e-6f) * gn * siluf_(zv[q]);
    ((u16*)(p->ws + WS_BRANCH))[row * 1024 + 512 + hd * 64 + lane] = f2bf(y);
  }
}

#define XB_TMO      128
#define XB_XCNT(j)  (256  + 64 * (j))
#define XB_XSUB(j)  (1280 + 64 * (j))
#define XB_XGEN(j)  (2304 + 64 * (j))
#define XB_TOP      3328
#define XB_TOPGEN   3392
#define XB_SPIN_CAP (1u << 20)
#define LAS __attribute__((address_space(3)))
DI unsigned xb_ld(unsigned* q) { return __hip_atomic_load(q, __ATOMIC_RELAXED, __HIP_MEMORY_SCOPE_AGENT); }
DI unsigned xb_add(unsigned* q, unsigned v) { return __hip_atomic_fetch_add(q, v, __ATOMIC_RELAXED, __HIP_MEMORY_SCOPE_AGENT); }
DI unsigned xb_xcc_id() { return (unsigned)__builtin_amdgcn_s_getreg((3 << 11) | 20) & 0xFu; }
#define XB_SPIN(cond, bar) do { unsigned _sp = 0; while (cond) { __builtin_amdgcn_s_sleep(1); \
    if ((++_sp & 255u) == 0u) { if (xb_ld(&(bar)[XB_TMO])) break; if (_sp > XB_SPIN_CAP) { atomicAdd(&(bar)[XB_TMO], 1u); break; } } } } while (0)
DI void xcd_barrier_complete(unsigned* bar, unsigned x, unsigned& nloc, unsigned& nx) {
  const unsigned G = gridDim.x;
  unsigned sum, cnt, mine, sp = 0u;
  for (;;) {
    sum = 0u; cnt = 0u; mine = 0u;
#pragma unroll
    for (unsigned j = 0; j < 16; ++j) { const unsigned c = xb_ld(&bar[XB_XCNT(j)]); sum += c; cnt += (c > 0u) ? 1u : 0u; mine = (j == x) ? c : mine; }
    if (sum == G) break;
    __builtin_amdgcn_s_sleep(1);
    if ((++sp & 255u) == 0u) { if (xb_ld(&bar[XB_TMO])) break; if (sp > XB_SPIN_CAP) { atomicAdd(&bar[XB_TMO], 1u); break; } }
  }
  nloc = mine > 0u ? mine : 1u; nx = cnt > 0u ? cnt : 1u;
}
DI void xcd_barrier(unsigned* bar, volatile LAS unsigned* st) {
  asm volatile("s_waitcnt vmcnt(0)" ::: "memory");
  __syncthreads();
  if (ltid() == 0) {
    const unsigned x = xb_xcc_id();
    __builtin_amdgcn_s_waitcnt(0);
    unsigned nloc = st[0], nx = st[1];
    if (nloc == 0u) { xcd_barrier_complete(bar, x, nloc, nx); st[0] = nloc; st[1] = nx; }
    const unsigned old = xb_add(&bar[XB_XSUB(x)], 1u);
    const unsigned gen = old / nloc;
    if (old + 1u == (gen + 1u) * nloc) {
      __builtin_amdgcn_fence(__ATOMIC_RELEASE, "agent");
      asm volatile("s_waitcnt vmcnt(0)" ::: "memory");
      const unsigned og = xb_add(&bar[XB_TOP], 1u);
      const unsigned tg = og / nx;
      if (og + 1u == (tg + 1u) * nx) xb_add(&bar[XB_TOPGEN], 1u);
      else XB_SPIN(xb_ld(&bar[XB_TOPGEN]) == tg, bar);
      __builtin_amdgcn_fence(__ATOMIC_ACQUIRE, "agent");
      xb_add(&bar[XB_XGEN(x)], 1u);
      asm volatile("s_waitcnt vmcnt(0)" ::: "memory");
    } else {
      XB_SPIN(xb_ld(&bar[XB_XGEN(x)]) == gen, bar);
      __builtin_amdgcn_fence(__ATOMIC_ACQUIRE, "agent");
      asm volatile("s_waitcnt vmcnt(0)" ::: "memory");
    }
  }
  __syncthreads();
}


#define FOR_TILES(MTI, NTI, SM, SN, CALL)                                                      \
  do {                                                                                         \
    if (G % 8 != 0) { for (int it_ = B; it_ < (MTI) * (NTI); it_ += G) { const int mt = it_ / (NTI), nt = it_ % (NTI); CALL; } } \
    else {                                                                                     \
      const int xcd_ = B & 7, j_ = B >> 3, J_ = G >> 3;                                        \
      const int nsm_ = ((MTI) + (SM) - 1) / (SM), nsn_ = ((NTI) + (SN) - 1) / (SN);            \
      const int st_ = (SM) * (SN), mysup_ = (nsm_ * nsn_ - xcd_ + 7) / 8;                      \
        \
                                  \
      for (int u_ = j_; u_ < mysup_ * st_; u_ += J_) {                                         \
        const int s_ = xcd_ + 8 * (u_ / st_), t_ = u_ % st_;                                   \
        const int sm_ = s_ / nsn_, sn_ = s_ % nsn_;                                            \
        const int mt = sm_ * (SM) + t_ / (SN), nt = sn_ * (SN) + t_ % (SN);                    \
        if (mt < (MTI) && nt < (NTI)) { CALL; }                                                \
      }                                                                                        \
    }                                                                                          \
  } while (0)

constexpr int NPHASE = 21;
__global__ void __launch_bounds__(256, 2) mk(Params p_unused, int ph_lo, int ph_hi) {
  extern __shared__ __attribute__((aligned(1024))) unsigned char smem[];
  int& s_item = *(int*)(smem + SMEM_BYTES);
  u32x4& xb_words = *(u32x4*)(smem + SMEM_BYTES + 16);
  const int G = gridDim.x, B = blockIdx.x;
  const bool fused = ph_hi - ph_lo > 1;
  if (fused) {
    if (ltid() == 0) { xb_words = u32x4{0u, 0u, 0u, 0u}; (void)xb_add(&((unsigned*)(((KP)__builtin_amdgcn_kernarg_segment_ptr())->ws + WS_BAR))[XB_XCNT(xb_xcc_id())], 1u); }
    __syncthreads();
  }
  for (int ph = ph_lo; ph < ph_hi; ++ph) {
    KP p = (KP)__builtin_amdgcn_kernarg_segment_ptr();
    asm volatile("" : "+s"(p));
    if (ph == 0) {
      for (int it = B; it < 192 + 64; it += G) { if (it < 192) mod_item(p, it, smem); else lruw_item(p, it - 192); }
    } else {
      const int l = (ph - 1) / 10, sub = (ph - 1) % 10;
      switch (sub) {
        case 0:
          for (int it = B; it < 2048 + CONV_ITEMS; it += G) { if (it < 2048) norm_item<0>(p, l, it); else convert_item(p, l, it - 2048, smem); }
          break;
        case 1: FOR_TILES(128, 21, 8, 7, inproj_item(p, mt, nt, smem)); break;
        case 2:
          for (int it = B; it < 1024 + 512 + 64 + 2048; it += G) {
            if (it < 1024) { for (int rep = 0; rep < NREP(4); ++rep) gdn1_item(p, l, it, smem); }
            else if (it < 1536) { for (int rep = 0; rep < NREP(5); ++rep) lru_item<false>(p, l, it - 1024, smem); }
            else if (it < 1600) { if (PHON(6)) kvc_item(p, l, it - 1536); }
            else if (PHON(6)) prep_item(p, l, it - 1600);
          }
          break;
        case 3: {
          int* ctr = (int*)(p->ws + WS_CTR) + l;
          for (;;) {
            __syncthreads();
            if (ltid() == 0) s_item = atomicAdd(ctr, 1);
            __syncthreads();
            const int it = s_item;
            if (it >= 16 + 256 + 256 + 256 + 512 + 512) break;
            if (it < 16) gdn2_item(p, l, it, smem);
            else if (it < 272) { for (int rep = 0; rep < NREP(8); ++rep) attn_item(p, l, it - 16, smem); }
            else if (it < 528) gdn2_item(p, l, it - 272 + 16, smem);
            else if (it < 784) { for (int rep = 0; rep < NREP(8); ++rep) attn_item(p, l, it - 528 + 256, smem); }
            else if (it < 1296) { for (int rep = 0; rep < NREP(9); ++rep) lru_item<true>(p, l, it - 784, smem); }
            else for (int rep = 0; rep < NREP(8); ++rep) attn_item(p, l, it - 1296 + 512, smem);
          }
        } break;
        case 4: for (int it = B; it < 1024; it += G) gdnfin_item(p, l, it, smem); break;
        case 5: for (int rep = 0; rep < NREP(11); ++rep) FOR_TILES(128, 8, 8, 8, merge_item(p, l, mt, nt, smem)); break;
        case 6: FOR_TILES(128, 8, 8, 8, wout_item(p, l, mt, nt, smem)); break;
        case 7: for (int it = B; it < 2048; it += G) norm_item<1>(p, l, it); break;
        case 8: FOR_TILES(128, 32, 8, 8, w1_item(p, mt, nt, smem)); break;
        case 9: FOR_TILES(128, 8, 8, 8, w2_item(p, l, mt, nt, smem)); break;
      }
    }
    if (ph + 1 < ph_hi) {
      if (ph_hi > NPHASE) cg::this_grid().sync();
      else for (int rep = 0; rep < NREP(1); ++rep) xcd_barrier((unsigned*)(p->ws + WS_BAR), (volatile LAS unsigned*)&xb_words);
    }
  }
}

extern "C" void kernel_launch(void* const* d_in, const int* in_sizes, int n_in, void* d_out, int out_size, void* d_ws, size_t ws_size, hipStream_t stream) {
  static int grid_blocks = 0;
  if (!grid_blocks) {
    int dev = 0, cus = 0, per_cu = 0;
    (void)hipGetDevice(&dev);
    (void)hipDeviceGetAttribute(&cus, hipDeviceAttributeMultiprocessorCount, dev);
    if (hipFuncSetAttribute((const void*)mk, hipFuncAttributeMaxDynamicSharedMemorySize, DYN_LDS) != hipSuccess) fprintf(stderr, "kernel_launch: hipFuncSetAttribute failed\n");
    (void)hipOccupancyMaxActiveBlocksPerMultiprocessor(&per_cu, mk, 256, DYN_LDS);
    if (per_cu < 1) per_cu = 1;
    if (per_cu > 2) per_cu = 2;
    grid_blocks = cus * per_cu;
    if (ws_size < WS_END) fprintf(stderr, "kernel_launch: workspace too small: %zu < %zu\n", ws_size, (size_t)WS_END);
  }
  if (hipMemsetAsync((char*)d_ws + WS_CTR, 0, 256 + 3456 * 4 + 256, stream) != hipSuccess) fprintf(stderr, "kernel_launch: memset failed\n");
  Params p{};
  for (int i = 0; i < 37; ++i) p.in[i] = (const float*)d_in[i];
  p.out = (float*)d_out; p.ws = (unsigned char*)d_ws;
#if MULTI_LAUNCH
  for (int ph = 0; ph < NPHASE; ++ph) hipLaunchKernelGGL(mk, dim3(grid_blocks), dim3(256), DYN_LDS, stream, p, ph, ph + 1);
#else
  int lo = 0, hi = NPHASE;
  void* args[] = {&p, &lo, &hi};
  hipError_t e = hipLaunchCooperativeKernel((void*)mk, dim3(grid_blocks), dim3(256), args, DYN_LDS, stream);
  if (e != hipSuccess) fprintf(stderr, "cooperative launch failed: %s (grid %d)\n", hipGetErrorString(e), grid_blocks);
#endif
}
```

```cpp
#include <hip/hip_runtime.h>
#include <hip/hip_cooperative_groups.h>
#include <cstdio>
namespace cg = cooperative_groups;

#ifndef MULTI_LAUNCH
#define MULTI_LAUNCH 0
#endif
#ifndef PHM
#define PHM 0xFFFFFFFFu
#endif
#define PHON(b) ((PHM >> (b)) & 1u)
#ifndef DUPM
#define DUPM 0u
#endif
#define NREP(b) (1 + ((DUPM >> (b)) & 1u))

typedef unsigned short u16;
using bf16x8 = __attribute__((ext_vector_type(8))) short;
using f32x4 = __attribute__((ext_vector_type(4))) float;
using u32x4 = __attribute__((ext_vector_type(4))) unsigned;
#define DI __device__ __forceinline__
#define MFMA16(a, b, c) __builtin_amdgcn_mfma_f32_16x16x32_bf16((a), (b), (c), 0, 0, 0)

constexpr int NTOK = 16384;
constexpr int DM = 1024;
constexpr int LDI = 2592;
constexpr int C_AQ = 0, C_AK = 256, C_AV = 384, C_LX = 512, C_LG = 768, C_GQ = 1024, C_GK = 1280, C_GV = 1536, C_GZ = 1792,
              C_DQ = 2048, C_DK = 2304, C_DV = 2432, C_GA = 2560, C_GB = 2568;
constexpr int NIN_PAD = 2688;

constexpr size_t WS_MOD = 0;
constexpr size_t WS_CTR = WS_MOD + 2 * 3 * 6144 * 4;
constexpr size_t WS_BAR = WS_CTR + 256;
constexpr size_t WS_LRUC = WS_BAR + 3456 * 4 + 256;
constexpr size_t WS_KC = WS_LRUC + (size_t)512 * 2 * 2 * 256 * 4;
constexpr size_t WS_GVEC = WS_KC + (size_t)16 * 512 * 64 * 2;
constexpr size_t WS_LRUW = WS_GVEC + (size_t)1024 * 2 * 256 * 4;
constexpr size_t WS_VT = WS_LRUW + (size_t)256 * 64 * 16;
constexpr size_t WS_WIN = WS_VT + (size_t)8 * 64 * 4608 * 2;
constexpr size_t WS_WM = WS_WIN + (size_t)NIN_PAD * 1024 * 2;
constexpr size_t WS_WB = WS_WM + (size_t)4096 * 1024 * 2;
constexpr size_t WS_WO = WS_WB + (size_t)4 * 1024 * 256 * 2;
constexpr size_t WS_W1 = WS_WO + (size_t)1024 * 1024 * 2;
constexpr size_t WS_W2 = WS_W1 + (size_t)4096 * 1024 * 2;
constexpr size_t WS_H = WS_W2 + (size_t)1024 * 4096 * 2;
constexpr size_t WS_BIG = WS_H + (size_t)NTOK * 1024 * 2;
constexpr size_t WS_INPROJ = WS_BIG;
constexpr size_t WS_BRANCH = WS_INPROJ + (size_t)NTOK * LDI * 2;
constexpr size_t WS_QHAT = WS_BRANCH + (size_t)NTOK * 1024 * 2;
constexpr size_t WS_KT = WS_QHAT + (size_t)1024 * 4096 * 2;
constexpr size_t WS_UW = WS_KT + (size_t)1024 * 4096 * 2;
constexpr size_t WS_QK = WS_UW + (size_t)1024 * 2 * 8192 * 2;
constexpr size_t WS_END = WS_QK + (size_t)1024 * 2 * 4096 * 2;
constexpr size_t WS_HIDDEN = WS_BIG;
constexpr size_t WS_MERGED = WS_BIG;
static_assert(WS_HIDDEN + (size_t)NTOK * 4096 * 2 <= WS_END, "hidden must fit");
static_assert(WS_END <= (size_t)256 * 1024 * 1024, "workspace budget");

constexpr size_t O_X = 0, O_AK = 16777216, O_AV = 18874368, O_DK = 20971520, O_DV = 23068672, O_LRU = 25165824, O_GDN = 25198592;

struct Params {
  const float* in[37];
  float* out;
  unsigned char* ws;
};

typedef const Params __attribute__((address_space(4)))* KP;
constexpr int SMEM_BYTES = 65536;
constexpr int DYN_LDS = SMEM_BYTES + 64;

DI int ltid() { int t = threadIdx.x; asm volatile("" : "+v"(t)); return t; }
typedef __bf16 bf16v2 __attribute__((ext_vector_type(2)));
DI u16 f2bf(float x) { __bf16 h = (__bf16)x; return __builtin_bit_cast(u16, h); }
DI float bf2f(u16 h) { return __uint_as_float(((unsigned)h) << 16); }
DI unsigned pack2(float a, float b) { bf16v2 v = {(__bf16)a, (__bf16)b}; return __builtin_bit_cast(unsigned, v); }
DI float bflo(unsigned u) { return __uint_as_float(u << 16); }
DI float bfhi(unsigned u) { return __uint_as_float(u & 0xffff0000u); }
DI float sigm(float x) { return __builtin_amdgcn_rcpf(1.f + __expf(-x)); }
DI float siluf_(float x) { return x * __builtin_amdgcn_rcpf(1.f + __expf(-x)); }
DI float softplusf_(float x) { return x > 20.f ? x : __logf(1.f + __expf(x)); }
DI float gelu_tanh(float x) { float u = 0.7978845608028654f * (x + 0.044715f * x * x * x); float t = 1.f - 2.f * __builtin_amdgcn_rcpf(__expf(2.f * u) + 1.f); return 0.5f * x * (1.f + t); }
template <int CTRL> DI float dppf(float v) { return __int_as_float(__builtin_amdgcn_update_dpp(0, __float_as_int(v), CTRL, 0xF, 0xF, true)); }
DI float rlane(float v, int l) { return __int_as_float(__builtin_amdgcn_readlane(__float_as_int(v), l)); }
DI float wave_sum(float v) {
  v += dppf<0xB1>(v);
  v += dppf<0x4E>(v);
  v += dppf<0x141>(v);
  v += dppf<0x140>(v);
  return (rlane(v, 0) + rlane(v, 16)) + (rlane(v, 32) + rlane(v, 48));
}
DI float xrow16_max(float x) { auto r = __builtin_amdgcn_permlane16_swap(__float_as_uint(x), __float_as_uint(x), false, false); return fmaxf(__uint_as_float(r[0]), __uint_as_float(r[1])); }
DI float xrow32_max(float x) { auto r = __builtin_amdgcn_permlane32_swap(__float_as_uint(x), __float_as_uint(x), false, false); return fmaxf(__uint_as_float(r[0]), __uint_as_float(r[1])); }
DI float xrow16_sum(float x) { auto r = __builtin_amdgcn_permlane16_swap(__float_as_uint(x), __float_as_uint(x), false, false); return __uint_as_float(r[0]) + __uint_as_float(r[1]); }
DI float xrow32_sum(float x) { auto r = __builtin_amdgcn_permlane32_swap(__float_as_uint(x), __float_as_uint(x), false, false); return __uint_as_float(r[0]) + __uint_as_float(r[1]); }
DI float xor16_partner(float x, int lane) { auto r = __builtin_amdgcn_permlane16_swap(__float_as_uint(x), __float_as_uint(x), false, false); return __uint_as_float((lane & 16) ? r[0] : r[1]); }
DI u32x4 mku4(unsigned a, unsigned b, unsigned c, unsigned d) { u32x4 v = {a, b, c, d}; return v; }
DI bf16x8 mk8(unsigned a, unsigned b, unsigned c, unsigned d) { u32x4 v = {a, b, c, d}; return __builtin_bit_cast(bf16x8, v); }
DI bf16x8 pack8(const f32x4& x, const f32x4& y) { return mk8(pack2(x[0], x[1]), pack2(x[2], x[3]), pack2(y[0], y[1]), pack2(y[2], y[3])); }
DI bf16x8 ld8(const u16* p) { return *(const bf16x8*)p; }
DI bf16x8 ldperm(const u16* p) { uint2 a = *(const uint2*)p; uint2 b = *(const uint2*)(p + 16); return mk8(a.x, a.y, b.x, b.y); }
DI int mod_group(int row) { return row < 8192 ? 0 : 1 + ((row - 8192) >> 12); }
DI const float* x_in_row(KP p, int l, int row) {
  if (l == 0) return row < 8192 ? p->in[0] + (size_t)row * DM : p->in[1] + (size_t)(row - 8192) * DM;
  return p->out + (size_t)row * DM;
}
DI unsigned swap16(unsigned u) { return (u >> 16) | (u << 16); }
DI u32x4 rev8(u32x4 v) { return mku4(swap16(v.w), swap16(v.z), swap16(v.y), swap16(v.x)); }

DI void mod_item(KP p, int item, unsigned char* smem) {
  float* sc = (float*)smem;
  float* sr = sc + 3072;
  const int tid = ltid();
  const int l = item / 96, cb = item % 96;
  for (int i = tid; i < 3072; i += 256) {
    int g = i >> 10, k = i & 1023;
    float c = g == 0 ? p->in[9][k] : p->in[2][(g - 1) * 1024 + k];
    sc[i] = siluf_(c);
  }
  __syncthreads();
  const int col = cb * 64 + (tid & 63), kg = tid >> 6;
  const float* W = p->in[10] + (size_t)l * 1024 * 6144;
  float a0 = 0.f, a1 = 0.f, a2 = 0.f;
  for (int k0 = kg * 256; k0 < kg * 256 + 256; k0 += 32) {
    float w[32];
#pragma unroll
    for (int q = 0; q < 32; ++q) w[q] = W[(size_t)(k0 + q) * 6144 + col];
#pragma unroll
    for (int q = 0; q < 32; ++q) { a0 += sc[k0 + q] * w[q]; a1 += sc[1024 + k0 + q] * w[q]; a2 += sc[2048 + k0 + q] * w[q]; }
  }
  sr[(kg * 3 + 0) * 64 + (tid & 63)] = a0; sr[(kg * 3 + 1) * 64 + (tid & 63)] = a1; sr[(kg * 3 + 2) * 64 + (tid & 63)] = a2;
  __syncthreads();
  if (tid < 192) {
    int g = tid >> 6, cc = tid & 63;
    float s = p->in[11][l * 6144 + cb * 64 + cc];
    for (int q = 0; q < 4; ++q) s += sr[(q * 3 + g) * 64 + cc];
    ((float*)(p->ws + WS_MOD))[(l * 3 + g) * 6144 + cb * 64 + cc] = s;
  }
  __syncthreads();
}

DI void conv_tile(const float* src, int N, int k0, int n0, u16* dst, int K, bool perm, unsigned char* smem) {
  float* tile = (float*)smem;
  const int tid = ltid();
#pragma unroll
  for (int i = 0; i < 4; ++i) {
    int kr = (tid >> 4) + 16 * i, nc = (tid & 15) * 4;
    float4 v = make_float4(0.f, 0.f, 0.f, 0.f);
    if (n0 + nc < N) v = *(const float4*)(src + (size_t)(k0 + kr) * N + n0 + nc);
    tile[kr * 65 + nc] = v.x; tile[kr * 65 + nc + 1] = v.y; tile[kr * 65 + nc + 2] = v.z; tile[kr * 65 + nc + 3] = v.w;
  }
  __syncthreads();
#pragma unroll
  for (int i = 0; i < 2; ++i) {
    int n = (tid >> 3) + 32 * i, k8 = (tid & 7) * 8;
    int ng = n0 + n;
    if (ng < N) {
      int row = ng;
      if (perm) row = ng < 2048 ? ng : (ng < 2064 ? 2560 + (ng - 2048) : ng - 16);
      u32x4 o;
      o.x = pack2(tile[(k8 + 0) * 65 + n], tile[(k8 + 1) * 65 + n]);
      o.y = pack2(tile[(k8 + 2) * 65 + n], tile[(k8 + 3) * 65 + n]);
      o.z = pack2(tile[(k8 + 4) * 65 + n], tile[(k8 + 5) * 65 + n]);
      o.w = pack2(tile[(k8 + 6) * 65 + n], tile[(k8 + 7) * 65 + n]);
      *(u32x4*)(dst + (size_t)row * K + k0 + k8) = o;
    }
  }
  __syncthreads();
}

constexpr int CONV_ITEMS = 4241;
DI void convert_item(KP p, int l, int item, unsigned char* smem) {
  unsigned char* ws = p->ws;
  if (item < 656) { int kt = item / 41, nt = item % 41; conv_tile(p->in[14] + (size_t)l * 1024 * 2576, 2576, kt * 64, nt * 64, (u16*)(ws + WS_WIN), 1024, true, smem); return; }
  item -= 656;
  if (item < 1024) { int kt = item >> 6, nt = item & 63; conv_tile(p->in[32] + (size_t)l * 1024 * 4096, 4096, kt * 64, nt * 64, (u16*)(ws + WS_WM), 1024, false, smem); return; }
  item -= 1024;
  if (item < 256) { int m = item >> 6, r = item & 63, kt = r >> 4, nt = r & 15;
    conv_tile(p->in[31] + ((size_t)l * 4 + m) * 256 * 1024, 1024, kt * 64, nt * 64, (u16*)(ws + WS_WB) + (size_t)m * 1024 * 256, 256, false, smem); return; }
  item -= 256;
  if (item < 256) { int kt = item >> 4, nt = item & 15; conv_tile(p->in[34] + (size_t)l * 1024 * 1024, 1024, kt * 64, nt * 64, (u16*)(ws + WS_WO), 1024, false, smem); return; }
  item -= 256;
  if (item < 1024) { int kt = item >> 6, nt = item & 63; conv_tile(p->in[35] + (size_t)l * 1024 * 4096, 4096, kt * 64, nt * 64, (u16*)(ws + WS_W1), 1024, false, smem); return; }
  item -= 1024;
  if (item < 1024) { int kt = item >> 4, nt = item & 15; conv_tile(p->in[36] + (size_t)l * 4096 * 1024, 1024, kt * 64, nt * 64, (u16*)(ws + WS_W2), 4096, false, smem); return; }
  u32x4* z = (u32x4*)((u16*)(ws + WS_WIN) + (size_t)2576 * 1024);
  for (int i = ltid(); i < 112 * 1024 / 8; i += 256) z[i] = mku4(0, 0, 0, 0);
}

DI void lruw_item(KP p, int item) {
  const int gid = item * 256 + ltid();
  const int lane = gid & 63, fg = gid >> 6;
  const int s2 = fg & 1, j = (fg >> 1) & 3, n = (fg >> 3) & 3, g = (fg >> 5) & 1, ld_ = fg >> 6;
  const int lq = lane & 15, quad = lane >> 4;
  const float* W = (g == 0 ? p->in[20] : p->in[22]) + ((size_t)(ld_ * 4 + n) * 64) * 64 + (size_t)(s2 * 32 + quad * 8) * 64 + j * 16 + lq;
  u32x4 o = {pack2(W[0], W[64]), pack2(W[128], W[192]), pack2(W[256], W[320]), pack2(W[384], W[448])};
  ((u32x4*)(p->ws + WS_LRUW))[gid] = o;
}

template <int which>
DI void norm_item(KP p, int l, int item) {
  const int tid = ltid(), lane = tid & 63, wave = tid >> 6;
  const float* g = p->in[which == 0 ? 12 : 13] + l * 1024;
  f32x4 v[2][4]; float ss[2] = {0.f, 0.f};
#pragma unroll
  for (int h = 0; h < 2; ++h) {
    const int row = item * 8 + wave * 2 + h;
    const float* x = x_in_row(p, which == 0 ? l : 2, row);
#pragma unroll
    for (int i = 0; i < 4; ++i) v[h][i] = *(const f32x4*)(x + i * 256 + lane * 4);
  }
#pragma unroll
  for (int h = 0; h < 2; ++h) {
#pragma unroll
    for (int i = 0; i < 4; ++i) ss[h] += v[h][i].x * v[h][i].x + v[h][i].y * v[h][i].y + v[h][i].z * v[h][i].z + v[h][i].w * v[h][i].w;
    ss[h] = wave_sum(ss[h]);
  }
#pragma unroll
  for (int h = 0; h < 2; ++h) {
    const int row = item * 8 + wave * 2 + h;
    const float* mod = (const float*)(p->ws + WS_MOD) + (l * 3 + mod_group(row)) * 6144;
    const float* sh = mod + (which == 0 ? 0 : 3072);
    const float* sc = mod + (which == 0 ? 1024 : 4096);
    const float rstd = rsqrtf(ss[h] * (1.f / 1024.f) + 1e-6f);
    u16* H = (u16*)(p->ws + WS_H) + (size_t)row * 1024;
#pragma unroll
    for (int i = 0; i < 4; ++i) {
      int c = i * 256 + lane * 4;
      float4 gg = *(const float4*)(g + c), s1 = *(const float4*)(sc + c), s0 = *(const float4*)(sh + c);
      float y0 = v[h][i].x * rstd * gg.x * (1.f + s1.x) + s0.x, y1 = v[h][i].y * rstd * gg.y * (1.f + s1.y) + s0.y;
      float y2 = v[h][i].z * rstd * gg.z * (1.f + s1.z) + s0.z, y3 = v[h][i].w * rstd * gg.w * (1.f + s1.w) + s0.w;
      *(uint2*)(H + c) = make_uint2(pack2(y0, y1), pack2(y2, y3));
    }
  }
}

DI int lds_byte(int r, int c) {
  int st = (r >> 4) * 2 + (c >> 5), ob = (r & 15) * 64 + (c & 31) * 2;
  return st * 1024 + (ob ^ (((ob >> 9) & 1) << 5));
}
DI void stage_rc(int b, int& R, int& C) {
  int st = b >> 10, sb = b & 1023, swz = sb ^ (((sb >> 9) & 1) << 5);
  R = (st >> 1) * 16 + (swz >> 6);
  C = (st & 1) * 32 + ((swz & 63) >> 1);
}
template <int MT, int NT, bool pre = false>
DI void gemm_acc(f32x4 (&acc)[MT][NT], const u16* __restrict__ A, int lda, const u16* __restrict__ Bt, int ldb, int K, unsigned char* smem,
                 const u16* nxtA = nullptr, int nlda = 0, const u16* nxtB = nullptr, int nldb = 0) {
  constexpr int TA = MT * 32 * 128, TB = NT * 32 * 128, STAGE = TA + TB;
  static_assert(2 * STAGE <= 65536, "LDS");
  const int tid = ltid(), lane = tid & 63, wid = tid >> 6, wm = wid >> 1, wn = wid & 1;
  const int fr = lane & 15, fq = lane >> 4;
  const u16* ga[MT]; const u16* gb[NT];
#pragma unroll
  for (int i = 0; i < MT; ++i) { int R, C; stage_rc(wid * 1024 + i * 4096 + lane * 16, R, C); ga[i] = A + (size_t)R * lda + C; }
#pragma unroll
  for (int i = 0; i < NT; ++i) { int R, C; stage_rc(wid * 1024 + i * 4096 + lane * 16, R, C); gb[i] = Bt + (size_t)R * ldb + C; }
#define GLDS_STAGE(buf, k0)                                                                                                        \
  do {                                                                                                                             \
    _Pragma("unroll") for (int i = 0; i < MT; ++i)                                                                                 \
      __builtin_amdgcn_global_load_lds((const unsigned*)(ga[i] + (k0)), (unsigned*)(smem + (buf) * STAGE + wid * 1024 + i * 4096), 16, 0, 0); \
    _Pragma("unroll") for (int i = 0; i < NT; ++i)                                                                                 \
      __builtin_amdgcn_global_load_lds((const unsigned*)(gb[i] + (k0)), (unsigned*)(smem + (buf) * STAGE + TA + wid * 1024 + i * 4096), 16, 0, 0); \
  } while (0)
  if (!pre) {
    __syncthreads();
    GLDS_STAGE(0, 0);
  }
  asm volatile("s_waitcnt vmcnt(0)" ::: "memory");
  __syncthreads();
  const int nt = K >> 6;
  for (int t = 0; t < nt; ++t) {
    const int cur = t & 1;
    if (t + 1 < nt) GLDS_STAGE(cur ^ 1, (t + 1) * 64);
    const unsigned char* sA = smem + cur * STAGE;
    const unsigned char* sB = sA + TA;
    if constexpr (!pre) {
      bf16x8 bfr[2][NT], af[2][MT];
#pragma unroll
      for (int s = 0; s < 2; ++s) {
#pragma unroll
        for (int j = 0; j < NT; ++j) bfr[s][j] = *(const bf16x8*)(sB + lds_byte(wn * NT * 16 + j * 16 + fr, s * 32 + fq * 8));
#pragma unroll
        for (int i = 0; i < MT; ++i) af[s][i] = *(const bf16x8*)(sA + lds_byte(wm * MT * 16 + i * 16 + fr, s * 32 + fq * 8));
      }
#pragma unroll
      for (int s = 0; s < 2; ++s)
#pragma unroll
        for (int i = 0; i < MT; ++i)
#pragma unroll
          for (int j = 0; j < NT; ++j) acc[i][j] = MFMA16(bfr[s][j], af[s][i], acc[i][j]);
      __builtin_amdgcn_sched_group_barrier(0x100, MT + NT, 0);
#pragma unroll
      for (int q = 0; q < MT + NT; ++q) { __builtin_amdgcn_sched_group_barrier(0x008, 2, 0); __builtin_amdgcn_sched_group_barrier(0x100, 1, 0); }
      __builtin_amdgcn_sched_group_barrier(0x008, 2 * MT * NT - 2 * (MT + NT), 0);
    } else {
#pragma unroll
      for (int s = 0; s < 2; ++s) {
        bf16x8 bfr[NT], af[MT];
#pragma unroll
        for (int j = 0; j < NT; ++j) bfr[j] = *(const bf16x8*)(sB + lds_byte(wn * NT * 16 + j * 16 + fr, s * 32 + fq * 8));
#pragma unroll
        for (int i = 0; i < MT; ++i) af[i] = *(const bf16x8*)(sA + lds_byte(wm * MT * 16 + i * 16 + fr, s * 32 + fq * 8));
#pragma unroll
        for (int i = 0; i < MT; ++i)
#pragma unroll
          for (int j = 0; j < NT; ++j) acc[i][j] = MFMA16(bfr[j], af[i], acc[i][j]);
      }
    }
    asm volatile("s_waitcnt vmcnt(0)" ::: "memory");
    __syncthreads();
  }
  if (nxtA) {
#pragma unroll
    for (int i = 0; i < MT; ++i) { int R, C; stage_rc(wid * 1024 + i * 4096 + lane * 16, R, C);
      __builtin_amdgcn_global_load_lds((const unsigned*)(nxtA + (unsigned)(R * nlda + C)), (unsigned*)(smem + wid * 1024 + i * 4096), 16, 0, 0); }
#pragma unroll
    for (int i = 0; i < NT; ++i) { int R, C; stage_rc(wid * 1024 + i * 4096 + lane * 16, R, C);
      __builtin_amdgcn_global_load_lds((const unsigned*)(nxtB + (unsigned)(R * nldb + C)), (unsigned*)(smem + TA + wid * 1024 + i * 4096), 16, 0, 0); }
  }
#undef GLDS_STAGE
}

template <int MT, int NT>
DI void gemm_prefetch(const u16* A, int lda, const u16* Bt, int ldb, unsigned char* smem) {
  constexpr int TA = MT * 32 * 128;
  const int tid = ltid(), lane = tid & 63, wid = tid >> 6;
  __syncthreads();
#pragma unroll
  for (int i = 0; i < MT; ++i) { int R, C; stage_rc(wid * 1024 + i * 4096 + lane * 16, R, C);
    __builtin_amdgcn_global_load_lds((const unsigned*)(A + (unsigned)(R * lda + C)), (unsigned*)(smem + wid * 1024 + i * 4096), 16, 0, 0); }
#pragma unroll
  for (int i = 0; i < NT; ++i) { int R, C; stage_rc(wid * 1024 + i * 4096 + lane * 16, R, C);
    __builtin_amdgcn_global_load_lds((const unsigned*)(Bt + (unsigned)(R * ldb + C)), (unsigned*)(smem + TA + wid * 1024 + i * 4096), 16, 0, 0); }
}

template <int MT, int NT> DI void zero_acc(f32x4 (&acc)[MT][NT]) {
#pragma unroll
  for (int i = 0; i < MT; ++i)
#pragma unroll
    for (int j = 0; j < NT; ++j) acc[i][j] = f32x4{0.f, 0.f, 0.f, 0.f};
}

#define EPI_LOOP(MT, NT)                                                          \
  const int tid_ = ltid(), lane_ = tid_ & 63, wave_ = tid_ >> 6;                   \
  const int wm_ = wave_ >> 1, wn_ = wave_ & 1, lq_ = lane_ & 15, quad_ = lane_ >> 4; \
  _Pragma("unroll") for (int i = 0; i < MT; ++i)                                   \
  _Pragma("unroll") for (int j = 0; j < NT; ++j)
#define EPI_ROW(m0, MT) ((m0) + wm_ * (MT) * 16 + i * 16 + lq_)
#define EPI_COL(n0, NT) ((n0) + wn_ * (NT) * 16 + j * 16 + quad_ * 4)

constexpr int GMT = 4;
DI void inproj_item(KP p, int mt, int nt, unsigned char* smem) {
  const int m0 = mt * (GMT * 32), n0 = nt * 128;
  f32x4 acc[GMT][4]; zero_acc<GMT, 4>(acc);
  gemm_acc<GMT, 4>(acc, (const u16*)(p->ws + WS_H) + (size_t)m0 * 1024, 1024, (const u16*)(p->ws + WS_WIN) + (size_t)n0 * 1024, 1024, 1024, smem);
  u16* C = (u16*)(p->ws + WS_INPROJ);
  EPI_LOOP(GMT, 4) { int row = EPI_ROW(m0, GMT), col = EPI_COL(n0, 4); if (col < LDI) *(uint2*)(C + (size_t)row * LDI + col) = make_uint2(pack2(acc[i][j][0], acc[i][j][1]), pack2(acc[i][j][2], acc[i][j][3])); }
}

DI void merge_item(KP p, int l, int mt, int nt, unsigned char* smem) {
  const int m0 = mt * 128, n0 = nt * 128;
  const u16* H = (const u16*)(p->ws + WS_H) + (size_t)m0 * 1024;
  const u16* BR = (const u16*)(p->ws + WS_BRANCH) + (size_t)m0 * 1024;
  const float* bm = p->in[33] + l * 4096;
  const u16* WM = (const u16*)(p->ws + WS_WM) + (size_t)n0 * 1024;
  const u16* WB = (const u16*)(p->ws + WS_WB) + (size_t)n0 * 256;
  unsigned am[4][4][2];
#pragma unroll
  for (int i = 0; i < 4; ++i)
#pragma unroll
    for (int j = 0; j < 4; ++j) { am[i][j][0] = 0u; am[i][j][1] = 0u; }
  gemm_prefetch<4, 4>(BR, 1024, WB, 256, smem);
#pragma unroll 1
  for (int m = 0; m < 4; ++m) {
    f32x4 acc[4][4]; zero_acc<4, 4>(acc);
    gemm_acc<4, 4, true>(acc, BR + m * 256, 1024, WB + (size_t)m * 1024 * 256, 256, 256, smem, H, 1024, WM + (size_t)m * 1024 * 1024, 1024);
    unsigned pp[4][4][2];
#pragma unroll
    for (int i = 0; i < 4; ++i)
#pragma unroll
      for (int j = 0; j < 4; ++j) { pp[i][j][0] = pack2(acc[i][j][0], acc[i][j][1]); pp[i][j][1] = pack2(acc[i][j][2], acc[i][j][3]); }
    zero_acc<4, 4>(acc);
    gemm_acc<4, 4, true>(acc, H, 1024, WM + (size_t)m * 1024 * 1024, 1024, 1024, smem,
                         m < 3 ? BR + (m + 1) * 256 : nullptr, 1024, WB + (size_t)(m + 1) * 1024 * 256, 256);
    {
      const int tid_ = ltid(), wn_ = (tid_ >> 6) & 1, quad_ = (tid_ & 63) >> 4;
      float4 bias4[4];
#pragma unroll
      for (int j = 0; j < 4; ++j) bias4[j] = *(const float4*)(bm + m * 1024 + n0 + wn_ * 64 + j * 16 + quad_ * 4);
#pragma unroll
      for (int i = 0; i < 4; ++i) {
#pragma unroll
        for (int j = 0; j < 4; ++j) {
          float v0 = bflo(am[i][j][0]) + sigm(acc[i][j][0] + bias4[j].x) * bflo(pp[i][j][0]);
          float v1 = bfhi(am[i][j][0]) + sigm(acc[i][j][1] + bias4[j].y) * bfhi(pp[i][j][0]);
          float v2 = bflo(am[i][j][1]) + sigm(acc[i][j][2] + bias4[j].z) * bflo(pp[i][j][1]);
          float v3 = bfhi(am[i][j][1]) + sigm(acc[i][j][3] + bias4[j].w) * bfhi(pp[i][j][1]);
          am[i][j][0] = pack2(v0, v1); am[i][j][1] = pack2(v2, v3);
          asm volatile("" : "+v"(am[i][j][0]), "+v"(am[i][j][1]));
          __builtin_amdgcn_sched_barrier(0);
        }
      }
    }
  }
  u16* C = (u16*)(p->ws + WS_MERGED);
  EPI_LOOP(4, 4) { int row = EPI_ROW(m0, 4), col = EPI_COL(n0, 4); *(uint2*)(C + (size_t)row * 1024 + col) = make_uint2(am[i][j][0], am[i][j][1]); }
}

DI void wout_item(KP p, int l, int mt, int nt, unsigned char* smem) {
  const int m0 = mt * (GMT * 32), n0 = nt * 128;
  f32x4 acc[GMT][4]; zero_acc<GMT, 4>(acc);
  gemm_acc<GMT, 4>(acc, (const u16*)(p->ws + WS_MERGED) + (size_t)m0 * 1024, 1024, (const u16*)(p->ws + WS_WO) + (size_t)n0 * 1024, 1024, 1024, smem);
  const float* g1 = (const float*)(p->ws + WS_MOD) + (l * 3 + mod_group(m0)) * 6144 + 2048;
  EPI_LOOP(GMT, 4) { int row = EPI_ROW(m0, GMT), col = EPI_COL(n0, 4); const float4 xv = *(const float4*)(x_in_row(p, l, row) + col), gv = *(const float4*)(g1 + col);
    *(float4*)(p->out + (size_t)row * DM + col) = make_float4(xv.x + gv.x * acc[i][j][0], xv.y + gv.y * acc[i][j][1], xv.z + gv.z * acc[i][j][2], xv.w + gv.w * acc[i][j][3]); }
}

DI void w1_item(KP p, int mt, int nt, unsigned char* smem) {
  const int m0 = mt * (GMT * 32), n0 = nt * 128;
  f32x4 acc[GMT][4]; zero_acc<GMT, 4>(acc);
  gemm_acc<GMT, 4>(acc, (const u16*)(p->ws + WS_H) + (size_t)m0 * 1024, 1024, (const u16*)(p->ws + WS_W1) + (size_t)n0 * 1024, 1024, 1024, smem);
  u16* C = (u16*)(p->ws + WS_HIDDEN);
  EPI_LOOP(GMT, 4) { int row = EPI_ROW(m0, GMT), col = EPI_COL(n0, 4); const float v0 = fmaxf(acc[i][j][0], 0.f), v1 = fmaxf(acc[i][j][1], 0.f), v2 = fmaxf(acc[i][j][2], 0.f), v3 = fmaxf(acc[i][j][3], 0.f);
    *(uint2*)(C + (size_t)row * 4096 + col) = make_uint2(pack2(v0 * v0, v1 * v1), pack2(v2 * v2, v3 * v3)); }
}

DI void w2_item(KP p, int l, int mt, int nt, unsigned char* smem) {
  const int m0 = mt * (GMT * 32), n0 = nt * 128;
  f32x4 acc[GMT][4]; zero_acc<GMT, 4>(acc);
  gemm_acc<GMT, 4>(acc, (const u16*)(p->ws + WS_HIDDEN) + (size_t)m0 * 4096, 4096, (const u16*)(p->ws + WS_W2) + (size_t)n0 * 4096, 4096, 4096, smem);
  const float* g2 = (const float*)(p->ws + WS_MOD) + (l * 3 + mod_group(m0)) * 6144 + 5120;
  EPI_LOOP(GMT, 4) { int row = EPI_ROW(m0, GMT), col = EPI_COL(n0, 4); float4* o = (float4*)(p->out + (size_t)row * DM + col); const float4 xv = *o, gv = *(const float4*)(g2 + col);
    *o = make_float4(xv.x + gv.x * acc[i][j][0], xv.y + gv.y * acc[i][j][1], xv.z + gv.z * acc[i][j][2], xv.w + gv.w * acc[i][j][3]); }
}

DI void prep_load(const u16* R, int lane, float (&hv)[12], float (&vv4)[4]) {
#pragma unroll
  for (int hh = 0; hh < 12; ++hh) {
    const int col = hh < 4 ? C_AQ + hh * 64 : (hh < 6 ? C_AK + (hh - 4) * 64 : (hh < 10 ? C_DQ + (hh - 6) * 64 : C_DK + (hh - 10) * 64));
    hv[hh] = bf2f(R[col + lane]);
  }
  vv4[0] = bf2f(R[C_AV + lane]); vv4[1] = bf2f(R[C_AV + 64 + lane]); vv4[2] = bf2f(R[C_DV + lane]); vv4[3] = bf2f(R[C_DV + 64 + lane]);
}
DI void prep_token(KP p, int l, int row, int lane, u16* R, const float (&hv)[12], const float (&vv4)[4]) {
  const bool lat = row >= 8192;
  float cs = 1.f, sn = 0.f;
  if (lat) {
    int t = (row - 8192) & 4095;
    int pos = (lane < 32) ? (t >> 6) : (t & 63);
    float inv = __expf(-(float)(lane & 15) * (9.210340371976184f / 16.f));
    float ang = (float)pos * inv;
    cs = __cosf(ang); sn = __sinf(ang);
  }
  const int b = row >> 8, t = row & 255;
#pragma unroll
  for (int hh = 0; hh < 12; ++hh) {
    int col; const float* g;
    if (hh < 4) { col = C_AQ + hh * 64; g = p->in[15] + l * 64; }
    else if (hh < 6) { col = C_AK + (hh - 4) * 64; g = p->in[16] + l * 64; }
    else if (hh < 10) { col = C_DQ + (hh - 6) * 64; g = p->in[29] + l * 64; }
    else { col = C_DK + (hh - 10) * 64; g = p->in[30] + l * 64; }
    float v = hv[hh];
    float ss = wave_sum(v * v);
    float y = v * rsqrtf(ss * (1.f / 64.f) + 1e-6f) * g[lane];
    if (hh < 4 || (hh >= 6 && hh < 10)) y *= 0.125f * 1.4426950408889634f;
    if (lat) {
      float yp = xor16_partner(y, lane);
      y = ((lane & 31) < 16) ? (y * cs - yp * sn) : (y * cs + yp * sn);
    } else {
      if (hh == 4 || hh == 5) p->out[O_AK + ((size_t)(b * 2 + l) * 256 + t) * 128 + (hh - 4) * 64 + lane] = y;
      if (hh >= 10) p->out[O_DK + ((size_t)(b * 2 + l) * 256 + t) * 128 + (hh - 10) * 64 + lane] = y;
    }
    R[col + lane] = f2bf(y);
  }
  if (lat) {
    const int bl = (row - 8192) >> 12, tl = (row - 8192) & 4095;
    u16* VT = (u16*)(p->ws + WS_VT) + (size_t)lane * 4608 + 512 + tl;
#pragma unroll
    for (int q = 0; q < 4; ++q)
      VT[(size_t)(((q >> 1) * 2 + bl) * 2 + (q & 1)) * 64 * 4608] = f2bf(vv4[q]);
  }
  if (!lat) {
    size_t o = ((size_t)(b * 2 + l) * 256 + t) * 128;
    p->out[O_AV + o + lane] = vv4[0]; p->out[O_AV + o + 64 + lane] = vv4[1];
    p->out[O_DV + o + lane] = vv4[2]; p->out[O_DV + o + 64 + lane] = vv4[3];
  }
}
DI void prep_item(KP p, int l, int item) {
  const int tid = ltid(), lane = tid & 63, wave = tid >> 6;
  const int row0 = item * 8 + wave * 2;
  u16* R0 = (u16*)(p->ws + WS_INPROJ) + (size_t)row0 * LDI;
  u16* R1 = R0 + LDI;
  float hv0[12], vv0[4], hv1[12], vv1[4];
  prep_load(R0, lane, hv0, vv0); prep_load(R1, lane, hv1, vv1);
  prep_token(p, l, row0, lane, R0, hv0, vv0);
  prep_token(p, l, row0 + 1, lane, R1, hv1, vv1);
}

DI void kvc_item(KP p, int l, int item) {
  u16* KC = (u16*)(p->ws + WS_KC);
#pragma unroll
  for (int it = 0; it < 8; ++it) {
    int idx4 = item * 2048 + it * 256 + ltid();
    int e = idx4 * 4;
    int d = e & 63, key = (e >> 6) & 511, sel = e >> 15;
    int kv = sel & 1, kvh = (sel >> 1) & 1, b = (sel >> 2) & 1, mixer = sel >> 3;
    const float* srcb = mixer ? (kv ? p->in[6] : p->in[5]) : (kv ? p->in[4] : p->in[3]);
    const float* src = srcb + ((size_t)((b * 2 + l) * 512 + key) * 2 + kvh) * 64 + d;
    float4 v = *(const float4*)src;
    *(uint2*)(KC + e) = make_uint2(pack2(v.x, v.y), pack2(v.z, v.w));
    if (kv) {
      u16* VT = (u16*)(p->ws + WS_VT) + ((size_t)((mixer * 2 + b) * 2 + kvh) * 64 + d) * 4608 + key;
      VT[0] = f2bf(v.x); VT[4608] = f2bf(v.y); VT[2 * 4608] = f2bf(v.z); VT[3 * 4608] = f2bf(v.w);
    }
  }
}

DI void attn_item(KP p, int l, int it, unsigned char* smem) {
  u16* sK = (u16*)smem;
  u16* sVt = sK + 64 * 72;
  const int tid = ltid(), lane = tid & 63, wave = tid >> 6, lq = lane & 15, quad = lane >> 4;
  int kind, b, qh, qb;
  if (it < 512) { kind = it >> 8; int r = it & 255; b = r >> 7; qh = (r >> 5) & 3; qb = r & 31; }
  else { int r = it - 512; kind = 2 + (r >> 8); r &= 255; b = r >> 3; qh = (r >> 1) & 3; qb = r & 1; }
  const bool isD = (kind == 0 || kind == 3), lat = kind < 2;
  const int seqrow0 = lat ? 8192 + b * 4096 : b * 256;
  const int q0 = qb * 128, kvh = qh >> 1;
  const int qcol = (isD ? C_DQ : C_AQ) + qh * 64, kcol = (isD ? C_DK : C_AK) + kvh * 64, vcol = (isD ? C_DV : C_AV) + kvh * 64;
  const int ocol = (isD ? 768 : 0) + qh * 64;
  const int ncache = lat ? 8 : 0;
  int kt_lo = 0, kt_hi = lat ? 64 : 4;
  if (kind == 1) { kt_lo = max(0, 2 * qb - 2); kt_hi = min(64, 2 * qb + 4); }
  const int ntiles = ncache + kt_hi - kt_lo;
  const bool band = (kind == 1);
  const u16* INP = (const u16*)(p->ws + WS_INPROJ);
  const u16* KCk = (const u16*)(p->ws + WS_KC) + (size_t)((((isD ? 1 : 0) * 2 + b) * 2 + kvh) * 2) * 512 * 64;
  const u16* KCv = KCk + 512 * 64;
  const float sinkv = isD ? -1e30f : p->in[17][l * 4 + qh] * 1.4426950408889634f;

  bf16x8 qf[2][2];
#pragma unroll
  for (int nt = 0; nt < 2; ++nt)
#pragma unroll
    for (int s = 0; s < 2; ++s) qf[nt][s] = ld8(INP + (size_t)(seqrow0 + q0 + wave * 32 + nt * 16 + lq) * LDI + qcol + s * 32 + quad * 8);
  float mrun[2], lsum[2];
  f32x4 oacc[4][2];
#pragma unroll
  for (int nt = 0; nt < 2; ++nt) { mrun[nt] = sinkv; lsum[nt] = (!isD && quad == 0) ? 1.f : 0.f; }
#pragma unroll
  for (int dt = 0; dt < 4; ++dt)
#pragma unroll
    for (int nt = 0; nt < 2; ++nt) oacc[dt][nt] = f32x4{0.f, 0.f, 0.f, 0.f};

  const int key = tid >> 2, seg = (tid & 3) * 16;
  struct KVReg { u32x4 k[2], v[2]; };
  KVReg R0, R1;
  const u16* VTp = (const u16*)(p->ws + WS_VT) + ((size_t)(((isD ? 1 : 0) * 2 + b) * 2 + kvh) * 64 + key) * 4608 + seg;
  auto tile_ptrs = [&](int t, const u16*& kp, const u16*& vp) {
    if (t < ncache) { kp = KCk + (size_t)(t * 64 + key) * 64 + seg; vp = VTp + t * 64; }
    else {
      const u16* rowp = INP + (size_t)(seqrow0 + (kt_lo + t - ncache) * 64 + key) * LDI; kp = rowp + kcol + seg;
      vp = lat ? VTp + 512 + (kt_lo + t - ncache) * 64 : rowp + vcol + seg;
    }
  };
  auto kvload = [&](int t, KVReg& R) {
    const u16 *kp, *vp; tile_ptrs(t, kp, vp);
    R.k[0] = *(const u32x4*)kp; R.k[1] = *(const u32x4*)(kp + 8); R.v[0] = *(const u32x4*)vp; R.v[1] = *(const u32x4*)(vp + 8);
  };
  kvload(0, R0);
  if (ntiles > 1) kvload(1, R1);
  auto step = [&](int t, KVReg& R) {
    __syncthreads();
    *(u32x4*)(sK + key * 72 + seg) = R.k[0]; *(u32x4*)(sK + key * 72 + seg + 8) = R.k[1];
    if (lat) {
      *(u32x4*)(sVt + key * 72 + seg) = R.v[0]; *(u32x4*)(sVt + key * 72 + seg + 8) = R.v[1];
    } else {
      unsigned vv[8] = {R.v[0].x, R.v[0].y, R.v[0].z, R.v[0].w, R.v[1].x, R.v[1].y, R.v[1].z, R.v[1].w};
#pragma unroll
      for (int e = 0; e < 8; ++e) { sVt[(seg + 2 * e) * 72 + key] = (u16)(vv[e] & 0xffffu); sVt[(seg + 2 * e + 1) * 72 + key] = (u16)(vv[e] >> 16); }
    }
    __syncthreads();
    if (t + 2 < ntiles) kvload(t + 2, R);
    f32x4 sacc[4][2];
#pragma unroll
    for (int mt = 0; mt < 4; ++mt) {
      sacc[mt][0] = f32x4{0.f, 0.f, 0.f, 0.f}; sacc[mt][1] = f32x4{0.f, 0.f, 0.f, 0.f};
#pragma unroll
      for (int s = 0; s < 2; ++s) {
        bf16x8 ka = ld8(sK + (mt * 16 + lq) * 72 + s * 32 + quad * 8);
        sacc[mt][0] = MFMA16(ka, qf[0][s], sacc[mt][0]);
        sacc[mt][1] = MFMA16(ka, qf[1][s], sacc[mt][1]);
      }
    }
    const bool masked_tile = band && t >= ncache;
    const int kbase = (kt_lo + t - ncache) * 64;
    bf16x8 pf[2][2];
#pragma unroll
    for (int nt = 0; nt < 2; ++nt) {
      const int qi = q0 + wave * 32 + nt * 16 + lq;
      float tmax = -1e30f;
#pragma unroll
      for (int mt = 0; mt < 4; ++mt)
#pragma unroll
        for (int r = 0; r < 4; ++r) {
          float sv_ = sacc[mt][nt][r];
          if (masked_tile) { int kj = kbase + mt * 16 + quad * 4 + r; int dlt = qi - kj; if (dlt > 128 || dlt < -128) sv_ = -1e30f; }
          sacc[mt][nt][r] = sv_; tmax = fmaxf(tmax, sv_);
        }
      tmax = xrow32_max(xrow16_max(tmax));
      const float mold = mrun[nt];
      const float mnew = fmaxf(mold, tmax);
      float ps = 0.f;
#pragma unroll
      for (int mt = 0; mt < 4; ++mt)
#pragma unroll
        for (int r = 0; r < 4; ++r) { float e = __builtin_amdgcn_exp2f(sacc[mt][nt][r] - mnew); sacc[mt][nt][r] = e; ps += e; }
      if (__any(mnew != mold)) {
        const float alpha = __builtin_amdgcn_exp2f(mold - mnew);
        lsum[nt] *= alpha;
#pragma unroll
        for (int dt = 0; dt < 4; ++dt)
#pragma unroll
          for (int r = 0; r < 4; ++r) oacc[dt][nt][r] *= alpha;
      }
      lsum[nt] += ps; mrun[nt] = mnew;
      pf[nt][0] = pack8(sacc[0][nt], sacc[1][nt]);
      pf[nt][1] = pack8(sacc[2][nt], sacc[3][nt]);
    }
#pragma unroll
    for (int dt = 0; dt < 4; ++dt)
#pragma unroll
      for (int s2 = 0; s2 < 2; ++s2) {
        bf16x8 va = ldperm(sVt + (dt * 16 + lq) * 72 + s2 * 32 + quad * 4);
        oacc[dt][0] = MFMA16(va, pf[0][s2], oacc[dt][0]);
        oacc[dt][1] = MFMA16(va, pf[1][s2], oacc[dt][1]);
      }
  };
  for (int t = 0; t < ntiles; t += 2) { step(t, R0); if (t + 1 < ntiles) step(t + 1, R1); }
  u16* BR = (u16*)(p->ws + WS_BRANCH);
#pragma unroll
  for (int nt = 0; nt < 2; ++nt) {
    float lt = xrow32_sum(xrow16_sum(lsum[nt]));
    const float inv = __builtin_amdgcn_rcpf(lt);
    const size_t row = seqrow0 + q0 + wave * 32 + nt * 16 + lq;
#pragma unroll
    for (int dt = 0; dt < 4; ++dt)
      *(uint2*)(BR + row * 1024 + ocol + dt * 16 + quad * 4) = make_uint2(pack2(oacc[dt][nt][0] * inv, oacc[dt][nt][1] * inv), pack2(oacc[dt][nt][2] * inv, oacc[dt][nt][3] * inv));
  }
  __syncthreads();
}

DI int lru_xoff(int t, int c) { return t * 256 + (c ^ ((t & 7) << 3)); }
template <bool FINAL>
DI void lru_item(KP p, int l, int ci, unsigned char* smem) {
  u16* sxb = (u16*)smem;
  u16* sla = sxb + 32 * 256;
  u16* sbv = sla + 32 * 256;
  u16* shf = sbv + 32 * 256;
  const int tid = ltid(), ch = tid, lane = tid & 63, n = tid >> 6, lq = lane & 15, quad = lane >> 4;
  const int r0 = ci * 32;
  const bool lat = r0 >= 8192;
  int b, T, seqrow0;
  if (!lat) { b = r0 >> 8; T = 256; seqrow0 = b * 256; } else { b = (r0 - 8192) >> 12; T = 4096; seqrow0 = 8192 + b * 4096; }
  const int t0 = r0 - seqrow0;
  const u16* INP = (const u16*)(p->ws + WS_INPROJ);
  __syncthreads();
  {
    const float* cw = p->in[18] + l * 4 * 256;
    const float w0 = cw[ch], w1 = cw[256 + ch], w2 = cw[512 + ch], w3 = cw[768 + ch], cb = p->in[19][l * 256 + ch];
    auto ld = [&](int t) -> float { return (t >= 0 && t < T) ? bf2f(INP[(size_t)(seqrow0 + t) * LDI + C_LX + ch]) : 0.f; };
    float xin[35];
#pragma unroll
    for (int q = 0; q < 35; ++q) xin[q] = ld(t0 - 2 + q);
#pragma unroll
    for (int t = 0; t < 32; ++t) sxb[lru_xoff(t, ch)] = f2bf(xin[t] * w0 + xin[t + 1] * w1 + xin[t + 2] * w2 + xin[t + 3] * w3 + cb);
  }
  __syncthreads();
  const int nch = T / 32, c = t0 / 32;
  float* LC = (float*)(p->ws + WS_LRUC);
  bf16x8 af[2][2];
#pragma unroll
  for (int mt = 0; mt < 2; ++mt)
#pragma unroll
    for (int s2 = 0; s2 < 2; ++s2) af[mt][s2] = ld8(sxb + lru_xoff(mt * 16 + lq, n * 64 + s2 * 32 + quad * 8));
  for (int dir = 0; dir < 2; ++dir) {
    bf16x8 wf[2][4][2];
    {
      const u32x4* WF = (const u32x4*)(p->ws + WS_LRUW);
#pragma unroll
      for (int g = 0; g < 2; ++g)
#pragma unroll
        for (int j = 0; j < 4; ++j)
#pragma unroll
          for (int s2 = 0; s2 < 2; ++s2)
            wf[g][j][s2] = __builtin_bit_cast(bf16x8, WF[(size_t)((((((l * 2 + dir) * 2 + g) * 4 + n) * 4 + j) * 2 + s2)) * 64 + lane]);
    }
#pragma unroll
    for (int j = 0; j < 4; ++j) {
      f32x4 acc[2][2];
#pragma unroll
      for (int g = 0; g < 2; ++g) {
        f32x4 a0 = {0.f, 0.f, 0.f, 0.f}, a1 = {0.f, 0.f, 0.f, 0.f};
#pragma unroll
        for (int s2 = 0; s2 < 2; ++s2) { a0 = MFMA16(af[0][s2], wf[g][j][s2], a0); a1 = MFMA16(af[1][s2], wf[g][j][s2], a1); }
        acc[g][0] = a0; acc[g][1] = a1;
      }
      const int cc = n * 64 + j * 16 + lq;
      const float br = p->in[21][(l * 2 + dir) * 256 + cc], bi = p->in[23][(l * 2 + dir) * 256 + cc];
      const float sp = softplusf_(-p->in[24][(l * 2 + dir) * 256 + cc]);
#pragma unroll
      for (int mt = 0; mt < 2; ++mt)
#pragma unroll
        for (int r = 0; r < 4; ++r) {
          const int t = mt * 16 + quad * 4 + r;
          const float la = -8.f * sigm(acc[0][mt][r] + br) * sp;
          const float xt = bf2f(sxb[lru_xoff(t, cc)]);
          const float bb = __builtin_amdgcn_sqrtf(1.f - __expf(2.f * la)) * sigm(acc[1][mt][r] + bi) * xt;
          sla[t * 256 + cc] = f2bf(la); sbv[t * 256 + cc] = f2bf(bb);
        }
    }
    __syncthreads();
    float h = 0.f, lasum = 0.f;
    if (FINAL) {
      h = lat ? p->in[7][((b * 2 + l) * 2 + dir) * 256 + ch] : 0.f;
      const int ncar = dir == 0 ? c : nch - 1 - c;
      const int cstart = dir == 0 ? ci - c : ci - c + nch - 1, cstep = dir == 0 ? 1 : -1;
      for (int q0 = 0; q0 < ncar; q0 += 16) {
        float ca[16], chh[16];
#pragma unroll
        for (int q = 0; q < 16; ++q) {
          const int qq = q0 + q < ncar ? q0 + q : ncar - 1;
          const float* C = LC + ((size_t)((cstart + cstep * qq) * 2 + dir) * 2) * 256;
          ca[q] = C[ch]; chh[q] = C[256 + ch];
        }
#pragma unroll
        for (int q = 0; q < 16; ++q) if (q0 + q < ncar) h = ca[q] * h + chh[q];
      }
    }
#pragma unroll 1
    for (int s8 = 0; s8 < 32; s8 += 16) {
      float gv[16];
      if (FINAL && dir == 1) {
#pragma unroll
        for (int q = 0; q < 16; ++q) gv[q] = bf2f(INP[(size_t)(r0 + 31 - s8 - q) * LDI + C_LG + ch]);
      }
#pragma unroll
      for (int q = 0; q < 16; ++q) {
        const int st = s8 + q;
        const int t = dir == 0 ? st : 31 - st;
        const float la = bf2f(sla[t * 256 + ch]);
        h = __expf(la) * h + bf2f(sbv[t * 256 + ch]);
        lasum += la;
        if (FINAL) {
          if (dir == 0) shf[t * 256 + ch] = f2bf(h);
          else ((u16*)(p->ws + WS_BRANCH))[(size_t)(r0 + t) * 1024 + 256 + ch] = f2bf((bf2f(shf[t * 256 + ch]) + h) * gelu_tanh(gv[q]));
        }
      }
    }
    if (!FINAL) { float* C = LC + ((size_t)(ci * 2 + dir) * 2) * 256; C[ch] = __expf(lasum); C[256 + ch] = h; }
    else if (!lat) {
      if (dir == 0 && c == nch - 1) p->out[O_LRU + ((size_t)(b * 2 + l) * 2 + 0) * 256 + ch] = h;
      if (dir == 1 && c == 0) p->out[O_LRU + ((size_t)(b * 2 + l) * 2 + 1) * 256 + ch] = h;
    }
    __syncthreads();
  }
}

template <int DIR, bool ISW>
DI void gdn_solve(const float* L, const u16* src, const float* sb_, const float* se_, u16* UW) {
  float sol[64];
#pragma unroll
  for (int i = 0; i < 64; ++i) {
    float s = bf2f(src[(DIR == 0 ? i : 63 - i) * 72]) * sb_[i];
    if (ISW) s *= se_[i];
    float s0 = 0.f, s1 = 0.f, s2 = 0.f, s3 = 0.f;
#pragma unroll
    for (int j4 = 0; j4 < (i + 3) / 4; ++j4) {
      float4 lv = *(const float4*)(L + i * 64 + j4 * 4);
      if (j4 * 4 + 0 < i) s0 += lv.x * sol[j4 * 4 + 0];
      if (j4 * 4 + 1 < i) s1 += lv.y * sol[j4 * 4 + 1];
      if (j4 * 4 + 2 < i) s2 += lv.z * sol[j4 * 4 + 2];
      if (j4 * 4 + 3 < i) s3 += lv.w * sol[j4 * 4 + 3];
      if ((j4 & 3) == 3) asm volatile("" ::: "memory");
    }
    s -= (s0 + s1) + (s2 + s3);
    sol[i] = s;
    UW[i * 128] = f2bf(s);
    asm volatile("" ::: "memory");
  }
}

DI void gdn1_item(KP p, int l, int item, unsigned char* smem) {
  const int cgi = item >> 2, hd = item & 3;
  u16* sq = (u16*)smem; u16* sk = sq + 64 * 72; u16* sv = sk + 64 * 72;
  float* sL = (float*)(smem + 27648);
  float* sgc = (float*)(smem + 60416);
  float* sbeta = sgc + 128;
  float* sge = sbeta + 128;
  const int tid = ltid(), lane = tid & 63, wave = tid >> 6, lq = lane & 15, quad = lane >> 4;
  const int r0 = cgi * 64;
  const bool lat = r0 >= 8192;
  int T, seqrow0;
  if (!lat) { T = 256; seqrow0 = (r0 >> 8) * 256; } else { T = 4096; seqrow0 = 8192 + ((r0 - 8192) >> 12) * 4096; }
  const int t0 = r0 - seqrow0;
  const u16* INP = (const u16*)(p->ws + WS_INPROJ);
  u16* QHAT = (u16*)(p->ws + WS_QHAT) + (size_t)item * 4096;
  {
    const int d = lane, tb = wave * 16;
#pragma unroll
    for (int mat = 0; mat < 3; ++mat) {
      const int col = C_GQ + mat * 256 + hd * 64 + d, wc = mat * 256 + hd * 64 + d;
      const float* cw = p->in[25] + (size_t)l * 4 * 768;
      const float w0 = cw[wc], w1 = cw[768 + wc], w2 = cw[1536 + wc], w3 = cw[2304 + wc];
      auto ld = [&](int t) -> float { return (t >= 0 && t < T) ? bf2f(INP[(size_t)(seqrow0 + t) * LDI + col]) : 0.f; };
      float xin[19];
#pragma unroll
      for (int q = 0; q < 19; ++q) xin[q] = ld(t0 + tb - 2 + q);
      u16* dst = mat == 0 ? sq : (mat == 1 ? sk : sv);
#pragma unroll
      for (int tt = 0; tt < 16; ++tt) {
        const int t = tb + tt;
        float v = siluf_(xin[tt] * w0 + xin[tt + 1] * w1 + xin[tt + 2] * w2 + xin[tt + 3] * w3);
        if (mat < 2) { float ss = wave_sum(v * v); v *= rsqrtf(ss + 1e-6f) * (mat == 0 ? 0.125f : 1.f); }
        u16 hb = f2bf(v);
        dst[t * 72 + d] = hb;
        if (mat == 0) QHAT[t * 64 + d] = hb;
      }
    }
  }
  if (tid < 128) {
    const int dir = tid >> 6, c = tid & 63;
    const int tok = dir == 0 ? c : 63 - c;
    const u16* R = INP + (size_t)(r0 + tok) * LDI;
    const float ga = bf2f(R[C_GA + dir * 4 + hd]), gb = bf2f(R[C_GB + dir * 4 + hd]);
    const float g = -__expf(p->in[26][(l * 2 + dir) * 4 + hd]) * softplusf_(ga + p->in[27][(l * 2 + dir) * 4 + hd]);
    float gc = g;
#pragma unroll
    for (int o = 1; o < 64; o <<= 1) { float tt = __shfl_up(gc, o, 64); if (lane >= o) gc += tt; }
    const float glast = __shfl(gc, 63, 64);
    sgc[dir * 64 + c] = gc; sbeta[dir * 64 + c] = sigm(gb); sge[dir * 64 + c] = __expf(gc);
    float* gv = (float*)(p->ws + WS_GVEC) + (size_t)(item * 2 + dir) * 256;
    gv[c] = __expf(gc); gv[64 + c] = __expf(glast - gc); if (c == 0) gv[128] = __expf(glast);
  }
  __syncthreads();
  {
    const int dk = tid >> 2, c0 = (tid & 3) * 16;
    unsigned w[8];
#pragma unroll
    for (int e = 0; e < 8; ++e) w[e] = (unsigned)sk[(c0 + 2 * e) * 72 + dk] | ((unsigned)sk[(c0 + 2 * e + 1) * 72 + dk] << 16);
    u16* KT = (u16*)(p->ws + WS_KT) + (size_t)item * 4096 + dk * 64 + c0;
    *(u32x4*)KT = mku4(w[0], w[1], w[2], w[3]); *(u32x4*)(KT + 8) = mku4(w[4], w[5], w[6], w[7]);
  }
  {
    const int i0 = wave * 16;
    f32x4 akk[4], aqk[4];
#pragma unroll
    for (int nt = 0; nt < 4; ++nt) { akk[nt] = f32x4{0.f, 0.f, 0.f, 0.f}; aqk[nt] = f32x4{0.f, 0.f, 0.f, 0.f}; }
#pragma unroll
    for (int s = 0; s < 2; ++s) {
      bf16x8 ak = ld8(sk + (i0 + lq) * 72 + s * 32 + quad * 8), aq = ld8(sq + (i0 + lq) * 72 + s * 32 + quad * 8);
#pragma unroll
      for (int nt = 0; nt < 4; ++nt) { bf16x8 bk = ld8(sk + (nt * 16 + lq) * 72 + s * 32 + quad * 8); akk[nt] = MFMA16(bk, ak, akk[nt]); aqk[nt] = MFMA16(bk, aq, aqk[nt]); }
    }
    u16* QKf = (u16*)(p->ws + WS_QK) + (size_t)(item * 2 + 0) * 4096;
    u16* QKb = (u16*)(p->ws + WS_QK) + (size_t)(item * 2 + 1) * 4096;
    const int i = i0 + lq, ib = 63 - i;
    const float gci = sgc[i], gcbi = sgc[64 + ib], bti = sbeta[i], btbi = sbeta[64 + ib];
#pragma unroll
    for (int nt = 0; nt < 4; ++nt) {
      const int j0 = nt * 16 + quad * 4;
      const float4 gcj = *(const float4*)(sgc + j0), gcbj = *(const float4*)(sgc + 64 + 60 - j0);
      const float gj[4] = {gcj.x, gcj.y, gcj.z, gcj.w};
      const float gbj[4] = {gcbj.w, gcbj.z, gcbj.y, gcbj.x};
      float qf[4], qb[4];
#pragma unroll
      for (int r = 0; r < 4; ++r) {
        const int j = j0 + r, jb = 63 - j;
        const float kkv = akk[nt][r], qkv = aqk[nt][r];
        const float ef = (j <= i) ? __expf(gci - gj[r]) : 0.f;
        const float eb = (j >= i) ? __expf(gcbi - gbj[r]) : 0.f;
        if (j < i) sL[i * 64 + j] = bti * kkv * ef;
        if (j > i) sL[4096 + ib * 64 + jb] = btbi * kkv * eb;
        qf[r] = qkv * ef; qb[r] = qkv * eb;
      }
      *(uint2*)(QKf + i * 64 + j0) = make_uint2(pack2(qf[0], qf[1]), pack2(qf[2], qf[3]));
      *(uint2*)(QKb + ib * 64 + 60 - j0) = make_uint2(pack2(qb[3], qb[2]), pack2(qb[1], qb[0]));
    }
  }
  __syncthreads();
  {
    const int col = tid & 127;
    u16* UW = (u16*)(p->ws + WS_UW) + (size_t)(item * 2 + (tid >> 7)) * 8192 + col;
    for (int rep = 0; rep < NREP(2); ++rep) {
    if (tid < 128) { if (col < 64) gdn_solve<0, false>(sL, sv + col, sbeta, sge, UW); else gdn_solve<0, true>(sL, sk + (col - 64), sbeta, sge, UW); }
    else { if (col < 64) gdn_solve<1, false>(sL + 4096, sv + col, sbeta + 64, sge + 64, UW); else gdn_solve<1, true>(sL + 4096, sk + (col - 64), sbeta + 64, sge + 64, UW); }
    }
  }
  __syncthreads();
}

DI void gdn2_item(KP p, int l, int item, unsigned char* smem) {
  u16* sW = (u16*)smem; u16* sKT = sW + 64 * 72; u16* sU = sKT + 64 * 72;
  float* sg = (float*)(smem + 27648);
  const int tid = ltid(), lane = tid & 63, wave = tid >> 6, lq = lane & 15, quad = lane >> 4;
  int b, hd, dir; bool lat;
  if (item < 16) { lat = true; b = item >> 3; hd = (item >> 1) & 3; dir = item & 1; }
  else { lat = false; int r = item - 16; b = r >> 3; hd = (r >> 1) & 3; dir = r & 1; }
  const int nch = lat ? 64 : 4, cg0 = lat ? 128 + b * 64 : b * 4;
  f32x4 st[4];
#pragma unroll
  for (int kt = 0; kt < 4; ++kt)
#pragma unroll
    for (int r = 0; r < 4; ++r)
      st[kt][r] = lat ? p->in[8][((size_t)(((b * 2 + l) * 2 + dir) * 4 + hd) * 64 + kt * 16 + quad * 4 + r) * 64 + wave * 16 + lq] : 0.f;
  const int lrow = tid >> 2, seg = (tid & 3) * 16;
  struct GReg { u32x4 U[2], W[2], KT[2]; float g; };
  GReg R0, R1;
  u16* UWb = (u16*)(p->ws + WS_UW);
  const u16* KTb = (const u16*)(p->ws + WS_KT);
  const float* GV = (const float*)(p->ws + WS_GVEC);
  auto gload = [&](int n, GReg& R) {
    const int cgi = dir == 0 ? cg0 + n : cg0 + nch - 1 - n;
    const size_t prob = (size_t)cgi * 4 + hd, pd = prob * 2 + dir;
    const u16* u = UWb + (pd * 64 + lrow) * 128 + seg;
    R.U[0] = *(const u32x4*)u; R.U[1] = *(const u32x4*)(u + 8); R.W[0] = *(const u32x4*)(u + 64); R.W[1] = *(const u32x4*)(u + 72);
    const u16* kt = KTb + (prob * 64 + lrow) * 64 + (dir ? 48 - seg : seg);
    u32x4 a = *(const u32x4*)kt, bb = *(const u32x4*)(kt + 8);
    if (dir) { R.KT[0] = rev8(bb); R.KT[1] = rev8(a); } else { R.KT[0] = a; R.KT[1] = bb; }
    R.g = GV[pd * 256 + (tid & 255)];
  };
  gload(0, R0); gload(1, R1);
  auto step = [&](int n, GReg& R) {
    const int cgi = dir == 0 ? cg0 + n : cg0 + nch - 1 - n;
    const size_t pd = ((size_t)cgi * 4 + hd) * 2 + dir;
    __syncthreads();
    *(u32x4*)(sW + lrow * 72 + seg) = R.W[0]; *(u32x4*)(sW + lrow * 72 + seg + 8) = R.W[1];
    *(u32x4*)(sKT + lrow * 72 + seg) = R.KT[0]; *(u32x4*)(sKT + lrow * 72 + seg + 8) = R.KT[1];
    *(u32x4*)(sU + lrow * 72 + seg) = R.U[0]; *(u32x4*)(sU + lrow * 72 + seg + 8) = R.U[1];
    sg[tid] = R.g;
    __syncthreads();
    if (n + 2 < nch) gload(n + 2, R);
    u32x4* FR = (u32x4*)(UWb + pd * 8192);
    const float elast = sg[128];
    bf16x8 sB[2] = {pack8(st[0], st[1]), pack8(st[2], st[3])};
    FR[(0 * 4 + wave) * 64 + lane] = __builtin_bit_cast(u32x4, sB[0]);
    FR[(1 * 4 + wave) * 64 + lane] = __builtin_bit_cast(u32x4, sB[1]);
    f32x4 vn[4];
#pragma unroll
    for (int mt = 0; mt < 4; ++mt) {
      f32x4 acc = {0.f, 0.f, 0.f, 0.f};
#pragma unroll
      for (int s2 = 0; s2 < 2; ++s2) acc = MFMA16(ldperm(sW + (mt * 16 + lq) * 72 + s2 * 32 + quad * 4), sB[s2], acc);
#pragma unroll
      for (int r = 0; r < 4; ++r) vn[mt][r] = bf2f(sU[(mt * 16 + quad * 4 + r) * 72 + wave * 16 + lq]) - acc[r];
    }
    bf16x8 vB[2] = {pack8(vn[0], vn[1]), pack8(vn[2], vn[3])};
    FR[512 + (0 * 4 + wave) * 64 + lane] = __builtin_bit_cast(u32x4, vB[0]);
    FR[512 + (1 * 4 + wave) * 64 + lane] = __builtin_bit_cast(u32x4, vB[1]);
#pragma unroll
    for (int mt = 0; mt < 4; ++mt)
#pragma unroll
      for (int r = 0; r < 4; ++r) vn[mt][r] *= sg[64 + mt * 16 + quad * 4 + r];
    bf16x8 vsB[2] = {pack8(vn[0], vn[1]), pack8(vn[2], vn[3])};
#pragma unroll
    for (int kt = 0; kt < 4; ++kt) {
      f32x4 acc = {0.f, 0.f, 0.f, 0.f};
#pragma unroll
      for (int s2 = 0; s2 < 2; ++s2) acc = MFMA16(ldperm(sKT + (kt * 16 + lq) * 72 + s2 * 32 + quad * 4), vsB[s2], acc);
#pragma unroll
      for (int r = 0; r < 4; ++r) st[kt][r] = elast * st[kt][r] + acc[r];
    }
  };
  for (int n = 0; n < nch; n += 2) { step(n, R0); step(n + 1, R1); }
  if (!lat) {
#pragma unroll
    for (int kt = 0; kt < 4; ++kt)
#pragma unroll
      for (int r = 0; r < 4; ++r)
        p->out[O_GDN + ((size_t)(((b * 2 + l) * 2 + dir) * 4 + hd) * 64 + kt * 16 + quad * 4 + r) * 64 + wave * 16 + lq] = st[kt][r];
  }
  __syncthreads();
}

DI void gdnfin_item(KP p, int l, int item, unsigned char* smem) {
  u16* sQ = (u16*)smem; u16* sQK = sQ + 64 * 72;
  float* so = (float*)(smem + 3 * 64 * 72 * 2);
  float* seg_ = so + 64 * 65;
  const int cgi = item >> 2, hd = item & 3;
  const int tid = ltid(), lane = tid & 63, wave = tid >> 6, lq = lane & 15, quad = lane >> 4;
  const int lrow = tid >> 2, seg = (tid & 3) * 16;
  __syncthreads();
  {
    const u16* q = (const u16*)(p->ws + WS_QHAT) + ((size_t)item * 64 + lrow) * 64 + seg;
    *(u32x4*)(sQ + lrow * 72 + seg) = *(const u32x4*)q; *(u32x4*)(sQ + lrow * 72 + seg + 8) = *(const u32x4*)(q + 8);
#pragma unroll
    for (int dir = 0; dir < 2; ++dir) {
      const u16* qk = (const u16*)(p->ws + WS_QK) + ((size_t)(item * 2 + dir) * 64 + lrow) * 64 + seg;
      *(u32x4*)(sQK + (dir * 64 + lrow) * 72 + seg) = *(const u32x4*)qk; *(u32x4*)(sQK + (dir * 64 + lrow) * 72 + seg + 8) = *(const u32x4*)(qk + 8);
    }
    if (tid < 128) seg_[tid] = ((const float*)(p->ws + WS_GVEC))[(size_t)(item * 2 + (tid >> 6)) * 256 + (tid & 63)];
  }
  __syncthreads();
#pragma unroll
  for (int dir = 0; dir < 2; ++dir) {
    const u32x4* FR = (const u32x4*)((const u16*)(p->ws + WS_UW) + (size_t)(item * 2 + dir) * 8192);
    bf16x8 sfr[2], vfr[2];
#pragma unroll
    for (int s2 = 0; s2 < 2; ++s2) {
      sfr[s2] = __builtin_bit_cast(bf16x8, FR[(s2 * 4 + wave) * 64 + lane]);
      vfr[s2] = __builtin_bit_cast(bf16x8, FR[512 + (s2 * 4 + wave) * 64 + lane]);
    }
#pragma unroll
    for (int mt = 0; mt < 4; ++mt) {
      f32x4 acc = {0.f, 0.f, 0.f, 0.f};
      const int qrow = dir ? 63 - (mt * 16 + lq) : mt * 16 + lq;
#pragma unroll
      for (int s2 = 0; s2 < 2; ++s2) acc = MFMA16(ldperm(sQ + qrow * 72 + s2 * 32 + quad * 4), sfr[s2], acc);
#pragma unroll
      for (int r = 0; r < 4; ++r) acc[r] *= seg_[dir * 64 + mt * 16 + quad * 4 + r];
#pragma unroll
      for (int s2 = 0; s2 < 2; ++s2) acc = MFMA16(ldperm(sQK + (dir * 64 + mt * 16 + lq) * 72 + s2 * 32 + quad * 4), vfr[s2], acc);
#pragma unroll
      for (int r = 0; r < 4; ++r) {
        const int c = mt * 16 + quad * 4 + r;
        const int tk = dir ? 63 - c : c;
        float* d = so + tk * 65 + wave * 16 + lq;
        if (dir == 0) *d = acc[r]; else *d += acc[r];
      }
    }
    __syncthreads();
  }
  const float gn = p->in[28][l * 64 + lane];
  float zv[16];
#pragma unroll
  for (int q = 0; q < 16; ++q)
    zv[q] = bf2f(((const u16*)(p->ws + WS_INPROJ))[((size_t)cgi * 64 + wave * 16 + q) * LDI + C_GZ + hd * 64 + lane]);
#pragma unroll
  for (int q = 0; q < 16; ++q) {
    const int c = wave * 16 + q;
    const size_t row = (size_t)cgi * 64 + c;
    float o = so[c * 65 + lane];
    float ss = wave_sum(o * o);
    float y = o * rsqrtf(ss * (1.f / 64.f) + 1e-6f) * gn * siluf_(zv[q]);
    ((u16*)(p->ws + WS_BRANCH))[row * 1024 + 512 + hd * 64 + lane] = f2bf(y);
  }
}

#define XB_TMO      128
#define XB_XCNT(j)  (256  + 64 * (j))
#define XB_XSUB(j)  (1280 + 64 * (j))
#define XB_XGEN(j)  (2304 + 64 * (j))
#define XB_TOP      3328
#define XB_TOPGEN   3392
#define XB_SPIN_CAP (1u << 20)
#define LAS __attribute__((address_space(3)))
DI unsigned xb_ld(unsigned* q) { return __hip_atomic_load(q, __ATOMIC_RELAXED, __HIP_MEMORY_SCOPE_AGENT); }
DI unsigned xb_add(unsigned* q, unsigned v) { return __hip_atomic_fetch_add(q, v, __ATOMIC_RELAXED, __HIP_MEMORY_SCOPE_AGENT); }
DI unsigned xb_xcc_id() { return (unsigned)__builtin_amdgcn_s_getreg((3 << 11) | 20) & 0xFu; }
#define XB_SPIN(cond, bar) do { unsigned _sp = 0; while (cond) { __builtin_amdgcn_s_sleep(1); \
    if ((++_sp & 255u) == 0u) { if (xb_ld(&(bar)[XB_TMO])) break; if (_sp > XB_SPIN_CAP) { atomicAdd(&(bar)[XB_TMO], 1u); break; } } } } while (0)
DI void xcd_barrier_complete(unsigned* bar, unsigned x, unsigned& nloc, unsigned& nx) {
  const unsigned G = gridDim.x;
  unsigned sum, cnt, mine, sp = 0u;
  for (;;) {
    sum = 0u; cnt = 0u; mine = 0u;
#pragma unroll
    for (unsigned j = 0; j < 16; ++j) { const unsigned c = xb_ld(&bar[XB_XCNT(j)]); sum += c; cnt += (c > 0u) ? 1u : 0u; mine = (j == x) ? c : mine; }
    if (sum == G) break;
    __builtin_amdgcn_s_sleep(1);
    if ((++sp & 255u) == 0u) { if (xb_ld(&bar[XB_TMO])) break; if (sp > XB_SPIN_CAP) { atomicAdd(&bar[XB_TMO], 1u); break; } }
  }
  nloc = mine > 0u ? mine : 1u; nx = cnt > 0u ? cnt : 1u;
}
DI void xcd_barrier(unsigned* bar, volatile LAS unsigned* st) {
  asm volatile("s_waitcnt vmcnt(0)" ::: "memory");
  __syncthreads();
  if (ltid() == 0) {
    const unsigned x = xb_xcc_id();
    __builtin_amdgcn_s_waitcnt(0);
    unsigned nloc = st[0], nx = st[1];
    if (nloc == 0u) { xcd_barrier_complete(bar, x, nloc, nx); st[0] = nloc; st[1] = nx; }
    const unsigned old = xb_add(&bar[XB_XSUB(x)], 1u);
    const unsigned gen = old / nloc;
    if (old + 1u == (gen + 1u) * nloc) {
      __builtin_amdgcn_fence(__ATOMIC_RELEASE, "agent");
      asm volatile("s_waitcnt vmcnt(0)" ::: "memory");
      const unsigned og = xb_add(&bar[XB_TOP], 1u);
      const unsigned tg = og / nx;
      if (og + 1u == (tg + 1u) * nx) xb_add(&bar[XB_TOPGEN], 1u);
      else XB_SPIN(xb_ld(&bar[XB_TOPGEN]) == tg, bar);
      __builtin_amdgcn_fence(__ATOMIC_ACQUIRE, "agent");
      xb_add(&bar[XB_XGEN(x)], 1u);
      asm volatile("s_waitcnt vmcnt(0)" ::: "memory");
    } else {
      XB_SPIN(xb_ld(&bar[XB_XGEN(x)]) == gen, bar);
      __builtin_amdgcn_fence(__ATOMIC_ACQUIRE, "agent");
      asm volatile("s_waitcnt vmcnt(0)" ::: "memory");
    }
  }
  __syncthreads();
}


#define FOR_TILES(MTI, NTI, SM, SN, CALL)                                                      \
  do {                                                                                         \
    if (G % 8 != 0) { for (int it_ = B; it_ < (MTI) * (NTI); it_ += G) { const int mt = it_ / (NTI), nt = it_ % (NTI); CALL; } } \
    else {                                                                                     \
      const int xcd_ = B & 7, j_ = B >> 3, J_ = G >> 3;                                        \
      const int nsm_ = ((MTI) + (SM) - 1) / (SM), nsn_ = ((NTI) + (SN) - 1) / (SN);            \
      const int st_ = (SM) * (SN), mysup_ = (nsm_ * nsn_ - xcd_ + 7) / 8;                      \
        \
                                  \
      for (int u_ = j_; u_ < mysup_ * st_; u_ += J_) {                                         \
        const int s_ = xcd_ + 8 * (u_ / st_), t_ = u_ % st_;                                   \
        const int sm_ = s_ / nsn_, sn_ = s_ % nsn_;                                            \
        const int mt = sm_ * (SM) + t_ / (SN), nt = sn_ * (SN) + t_ % (SN);                    \
        if (mt < (MTI) && nt < (NTI)) { CALL; }                                                \
      }                                                                                        \
    }                                                                                          \
  } while (0)

constexpr int NPHASE = 21;
__global__ void __launch_bounds__(256, 2) mk(Params p_unused, int ph_lo, int ph_hi) {
  extern __shared__ __attribute__((aligned(1024))) unsigned char smem[];
  int& s_item = *(int*)(smem + SMEM_BYTES);
  u32x4& xb_words = *(u32x4*)(smem + SMEM_BYTES + 16);
  const int G = gridDim.x, B = blockIdx.x;
  const bool fused = ph_hi - ph_lo > 1;
  if (fused) {
    if (ltid() == 0) { xb_words = u32x4{0u, 0u, 0u, 0u}; (void)xb_add(&((unsigned*)(((KP)__builtin_amdgcn_kernarg_segment_ptr())->ws + WS_BAR))[XB_XCNT(xb_xcc_id())], 1u); }
    __syncthreads();
  }
  for (int ph = ph_lo; ph < ph_hi; ++ph) {
    KP p = (KP)__builtin_amdgcn_kernarg_segment_ptr();
    asm volatile("" : "+s"(p));
    if (ph == 0) {
      for (int it = B; it < 192 + 64; it += G) { if (it < 192) mod_item(p, it, smem); else lruw_item(p, it - 192); }
    } else {
      const int l = (ph - 1) / 10, sub = (ph - 1) % 10;
      switch (sub) {
        case 0:
          for (int it = B; it < 2048 + CONV_ITEMS; it += G) { if (it < 2048) norm_item<0>(p, l, it); else convert_item(p, l, it - 2048, smem); }
          break;
        case 1: FOR_TILES(128, 21, 8, 7, inproj_item(p, mt, nt, smem)); break;
        case 2:
          for (int it = B; it < 1024 + 512 + 64 + 2048; it += G) {
            if (it < 1024) { for (int rep = 0; rep < NREP(4); ++rep) gdn1_item(p, l, it, smem); }
            else if (it < 1536) { for (int rep = 0; rep < NREP(5); ++rep) lru_item<false>(p, l, it - 1024, smem); }
            else if (it < 1600) { if (PHON(6)) kvc_item(p, l, it - 1536); }
            else if (PHON(6)) prep_item(p, l, it - 1600);
          }
          break;
        case 3: {
          int* ctr = (int*)(p->ws + WS_CTR) + l;
          for (;;) {
            __syncthreads();
            if (ltid() == 0) s_item = atomicAdd(ctr, 1);
            __syncthreads();
            const int it = s_item;
            if (it >= 16 + 256 + 256 + 256 + 512 + 512) break;
            if (it < 16) gdn2_item(p, l, it, smem);
            else if (it < 272) { for (int rep = 0; rep < NREP(8); ++rep) attn_item(p, l, it - 16, smem); }
            else if (it < 528) gdn2_item(p, l, it - 272 + 16, smem);
            else if (it < 784) { for (int rep = 0; rep < NREP(8); ++rep) attn_item(p, l, it - 528 + 256, smem); }
            else if (it < 1296) { for (int rep = 0; rep < NREP(9); ++rep) lru_item<true>(p, l, it - 784, smem); }
            else for (int rep = 0; rep < NREP(8); ++rep) attn_item(p, l, it - 1296 + 512, smem);
          }
        } break;
        case 4: for (int it = B; it < 1024; it += G) gdnfin_item(p, l, it, smem); break;
        case 5: for (int rep = 0; rep < NREP(11); ++rep) FOR_TILES(128, 8, 8, 8, merge_item(p, l, mt, nt, smem)); break;
        case 6: FOR_TILES(128, 8, 8, 8, wout_item(p, l, mt, nt, smem)); break;
        case 7: for (int it = B; it < 2048; it += G) norm_item<1>(p, l, it); break;
        case 8: FOR_TILES(128, 32, 8, 8, w1_item(p, mt, nt, smem)); break;
        case 9: FOR_TILES(128, 8, 8, 8, w2_item(p, l, mt, nt, smem)); break;
      }
    }
    if (ph + 1 < ph_hi) {
      if (ph_hi > NPHASE) cg::this_grid().sync();
      else for (int rep = 0; rep < NREP(1); ++rep) xcd_barrier((unsigned*)(p->ws + WS_BAR), (volatile LAS unsigned*)&xb_words);
    }
  }
}

extern "C" void kernel_launch(void* const* d_in, const int* in_sizes, int n_in, void* d_out, int out_size, void* d_ws, size_t ws_size, hipStream_t stream) {
  static int grid_blocks = 0;
  if (!grid_blocks) {
    int dev = 0, cus = 0, per_cu = 0;
    (void)hipGetDevice(&dev);
    (void)hipDeviceGetAttribute(&cus, hipDeviceAttributeMultiprocessorCount, dev);
    if (hipFuncSetAttribute((const void*)mk, hipFuncAttributeMaxDynamicSharedMemorySize, DYN_LDS) != hipSuccess) fprintf(stderr, "kernel_launch: hipFuncSetAttribute failed\n");
    (void)hipOccupancyMaxActiveBlocksPerMultiprocessor(&per_cu, mk, 256, DYN_LDS);
    if (per_cu < 1) per_cu = 1;
    if (per_cu > 2) per_cu = 2;
    grid_blocks = cus * per_cu;
    if (ws_size < WS_END) fprintf(stderr, "kernel_launch: workspace too small: %zu < %zu\n", ws_size, (size_t)WS_END);
  }
  if (hipMemsetAsync((char*)d_ws + WS_CTR, 0, 256 + 3456 * 4 + 256, stream) != hipSuccess) fprintf(stderr, "kernel_launch: memset failed\n");
  Params p{};
  for (int i = 0; i < 37; ++i) p.in[i] = (const float*)d_in[i];
  p.out = (float*)d_out; p.ws = (unsigned char*)d_ws;
#if MULTI_LAUNCH
  for (int ph = 0; ph < NPHASE; ++ph) hipLaunchKernelGGL(mk, dim3(grid_blocks), dim3(256), DYN_LDS, stream, p, ph, ph + 1);
#else
  int lo = 0, hi = NPHASE;
  void* args[] = {&p, &lo, &hi};
  hipError_t e = hipLaunchCooperativeKernel((void*)mk, dim3(grid_blocks), dim3(256), args, DYN_LDS, stream);
  if (e != hipSuccess) fprintf(stderr, "cooperative launch failed: %s (grid %d)\n", hipGetErrorString(e), grid_blocks);
#endif
}
```

```cpp
#include <hip/hip_runtime.h>
#include <hip/hip_cooperative_groups.h>
#include <cstdio>
namespace cg = cooperative_groups;

#ifndef MULTI_LAUNCH
#define MULTI_LAUNCH 0
#endif
#ifndef PHM
#define PHM 0xFFFFFFFFu
#endif
#define PHON(b) ((PHM >> (b)) & 1u)
#ifndef DUPM
#define DUPM 0u
#endif
#define NREP(b) (1 + ((DUPM >> (b)) & 1u))

typedef unsigned short u16;
using bf16x8 = __attribute__((ext_vector_type(8))) short;
using f32x4 = __attribute__((ext_vector_type(4))) float;
using u32x4 = __attribute__((ext_vector_type(4))) unsigned;
#define DI __device__ __forceinline__
#define MFMA16(a, b, c) __builtin_amdgcn_mfma_f32_16x16x32_bf16((a), (b), (c), 0, 0, 0)

constexpr int NTOK = 16384;
constexpr int DM = 1024;
constexpr int LDI = 2592;
constexpr int C_AQ = 0, C_AK = 256, C_AV = 384, C_LX = 512, C_LG = 768, C_GQ = 1024, C_GK = 1280, C_GV = 1536, C_GZ = 1792,
              C_DQ = 2048, C_DK = 2304, C_DV = 2432, C_GA = 2560, C_GB = 2568;
constexpr int NIN_PAD = 2688;

constexpr size_t WS_MOD = 0;
constexpr size_t WS_CTR = WS_MOD + 2 * 3 * 6144 * 4;
constexpr size_t WS_BAR = WS_CTR + 256;
constexpr size_t WS_LRUC = WS_BAR + 3456 * 4 + 256;
constexpr size_t WS_KC = WS_LRUC + (size_t)512 * 2 * 2 * 256 * 4;
constexpr size_t WS_GVEC = WS_KC + (size_t)16 * 512 * 64 * 2;
constexpr size_t WS_LRUW = WS_GVEC + (size_t)1024 * 2 * 256 * 4;
constexpr size_t WS_VT = WS_LRUW + (size_t)256 * 64 * 16;
constexpr size_t WS_WIN = WS_VT + (size_t)8 * 64 * 4608 * 2;
constexpr size_t WS_WM = WS_WIN + (size_t)NIN_PAD * 1024 * 2;
constexpr size_t WS_WB = WS_WM + (size_t)4096 * 1024 * 2;
constexpr size_t WS_WO = WS_WB + (size_t)4 * 1024 * 256 * 2;
constexpr size_t WS_W1 = WS_WO + (size_t)1024 * 1024 * 2;
constexpr size_t WS_W2 = WS_W1 + (size_t)4096 * 1024 * 2;
constexpr size_t WS_H = WS_W2 + (size_t)1024 * 4096 * 2;
constexpr size_t WS_BIG = WS_H + (size_t)NTOK * 1024 * 2;
constexpr size_t WS_INPROJ = WS_BIG;
constexpr size_t WS_BRANCH = WS_INPROJ + (size_t)NTOK * LDI * 2;
constexpr size_t WS_QHAT = WS_BRANCH + (size_t)NTOK * 1024 * 2;
constexpr size_t WS_KT = WS_QHAT + (size_t)1024 * 4096 * 2;
constexpr size_t WS_UW = WS_KT + (size_t)1024 * 4096 * 2;
constexpr size_t WS_QK = WS_UW + (size_t)1024 * 2 * 8192 * 2;
constexpr size_t WS_END = WS_QK + (size_t)1024 * 2 * 4096 * 2;
constexpr size_t WS_HIDDEN = WS_BIG;
constexpr size_t WS_MERGED = WS_BIG;
static_assert(WS_HIDDEN + (size_t)NTOK * 4096 * 2 <= WS_END, "hidden must fit");
static_assert(WS_END <= (size_t)256 * 1024 * 1024, "workspace budget");

constexpr size_t O_X = 0, O_AK = 16777216, O_AV = 18874368, O_DK = 20971520, O_DV = 23068672, O_LRU = 25165824, O_GDN = 25198592;

struct Params {
  const float* in[37];
  float* out;
  unsigned char* ws;
};

typedef const Params __attribute__((address_space(4)))* KP;
constexpr int SMEM_BYTES = 65536;
constexpr int DYN_LDS = SMEM_BYTES + 64;

DI int ltid() { int t = threadIdx.x; asm volatile("" : "+v"(t)); return t; }
typedef __bf16 bf16v2 __attribute__((ext_vector_type(2)));
DI u16 f2bf(float x) { __bf16 h = (__bf16)x; return __builtin_bit_cast(u16, h); }
DI float bf2f(u16 h) { return __uint_as_float(((unsigned)h) << 16); }
DI unsigned pack2(float a, float b) { bf16v2 v = {(__bf16)a, (__bf16)b}; return __builtin_bit_cast(unsigned, v); }
DI float bflo(unsigned u) { return __uint_as_float(u << 16); }
DI float bfhi(unsigned u) { return __uint_as_float(u & 0xffff0000u); }
DI float sigm(float x) { return __builtin_amdgcn_rcpf(1.f + __expf(-x)); }
DI float siluf_(float x) { return x * __builtin_amdgcn_rcpf(1.f + __expf(-x)); }
DI float softplusf_(float x) { return x > 20.f ? x : __logf(1.f + __expf(x)); }
DI float gelu_tanh(float x) { float u = 0.7978845608028654f * (x + 0.044715f * x * x * x); float t = 1.f - 2.f * __builtin_amdgcn_rcpf(__expf(2.f * u) + 1.f); return 0.5f * x * (1.f + t); }
template <int CTRL> DI float dppf(float v) { return __int_as_float(__builtin_amdgcn_update_dpp(0, __float_as_int(v), CTRL, 0xF, 0xF, true)); }
DI float rlane(float v, int l) { return __int_as_float(__builtin_amdgcn_readlane(__float_as_int(v), l)); }
DI float wave_sum(float v) {
  v += dppf<0xB1>(v);
  v += dppf<0x4E>(v);
  v += dppf<0x141>(v);
  v += dppf<0x140>(v);
  return (rlane(v, 0) + rlane(v, 16)) + (rlane(v, 32) + rlane(v, 48));
}
DI float xrow16_max(float x) { auto r = __builtin_amdgcn_permlane16_swap(__float_as_uint(x), __float_as_uint(x), false, false); return fmaxf(__uint_as_float(r[0]), __uint_as_float(r[1])); }
DI float xrow32_max(float x) { auto r = __builtin_amdgcn_permlane32_swap(__float_as_uint(x), __float_as_uint(x), false, false); return fmaxf(__uint_as_float(r[0]), __uint_as_float(r[1])); }
DI float xrow16_sum(float x) { auto r = __builtin_amdgcn_permlane16_swap(__float_as_uint(x), __float_as_uint(x), false, false); return __uint_as_float(r[0]) + __uint_as_float(r[1]); }
DI float xrow32_sum(float x) { auto r = __builtin_amdgcn_permlane32_swap(__float_as_uint(x), __float_as_uint(x), false, false); return __uint_as_float(r[0]) + __uint_as_float(r[1]); }
DI float xor16_partner(float x, int lane) { auto r = __builtin_amdgcn_permlane16_swap(__float_as_uint(x), __float_as_uint(x), false, false); return __uint_as_float((lane & 16) ? r[0] : r[1]); }
DI u32x4 mku4(unsigned a, unsigned b, unsigned c, unsigned d) { u32x4 v = {a, b, c, d}; return v; }
DI bf16x8 mk8(unsigned a, unsigned b, unsigned c, unsigned d) { u32x4 v = {a, b, c, d}; return __builtin_bit_cast(bf16x8, v); }
DI bf16x8 pack8(const f32x4& x, const f32x4& y) { return mk8(pack2(x[0], x[1]), pack2(x[2], x[3]), pack2(y[0], y[1]), pack2(y[2], y[3])); }
DI bf16x8 ld8(const u16* p) { return *(const bf16x8*)p; }
DI bf16x8 ldperm(const u16* p) { uint2 a = *(const uint2*)p; uint2 b = *(const uint2*)(p + 16); return mk8(a.x, a.y, b.x, b.y); }
DI int mod_group(int row) { return row < 8192 ? 0 : 1 + ((row - 8192) >> 12); }
DI const float* x_in_row(KP p, int l, int row) {
  if (l == 0) return row < 8192 ? p->in[0] + (size_t)row * DM : p->in[1] + (size_t)(row - 8192) * DM;
  return p->out + (size_t)row * DM;
}
DI unsigned swap16(unsigned u) { return (u >> 16) | (u << 16); }
DI u32x4 rev8(u32x4 v) { return mku4(swap16(v.w), swap16(v.z), swap16(v.y), swap16(v.x)); }

DI void mod_item(KP p, int item, unsigned char* smem) {
  float* sc = (float*)smem;
  float* sr = sc + 3072;
  const int tid = ltid();
  const int l = item / 96, cb = item % 96;
  for (int i = tid; i < 3072; i += 256) {
    int g = i >> 10, k = i & 1023;
    float c = g == 0 ? p->in[9][k] : p->in[2][(g - 1) * 1024 + k];
    sc[i] = siluf_(c);
  }
  __syncthreads();
  const int col = cb * 64 + (tid & 63), kg = tid >> 6;
  const float* W = p->in[10] + (size_t)l * 1024 * 6144;
  float a0 = 0.f, a1 = 0.f, a2 = 0.f;
  for (int k0 = kg * 256; k0 < kg * 256 + 256; k0 += 32) {
    float w[32];
#pragma unroll
    for (int q = 0; q < 32; ++q) w[q] = W[(size_t)(k0 + q) * 6144 + col];
#pragma unroll
    for (int q = 0; q < 32; ++q) { a0 += sc[k0 + q] * w[q]; a1 += sc[1024 + k0 + q] * w[q]; a2 += sc[2048 + k0 + q] * w[q]; }
  }
  sr[(kg * 3 + 0) * 64 + (tid & 63)] = a0; sr[(kg * 3 + 1) * 64 + (tid & 63)] = a1; sr[(kg * 3 + 2) * 64 + (tid & 63)] = a2;
  __syncthreads();
  if (tid < 192) {
    int g = tid >> 6, cc = tid & 63;
    float s = p->in[11][l * 6144 + cb * 64 + cc];
    for (int q = 0; q < 4; ++q) s += sr[(q * 3 + g) * 64 + cc];
    ((float*)(p->ws + WS_MOD))[(l * 3 + g) * 6144 + cb * 64 + cc] = s;
  }
  __syncthreads();
}

DI void conv_tile(const float* src, int N, int k0, int n0, u16* dst, int K, bool perm, unsigned char* smem) {
  float* tile = (float*)smem;
  const int tid = ltid();
#pragma unroll
  for (int i = 0; i < 4; ++i) {
    int kr = (tid >> 4) + 16 * i, nc = (tid & 15) * 4;
    float4 v = make_float4(0.f, 0.f, 0.f, 0.f);
    if (n0 + nc < N) v = *(const float4*)(src + (size_t)(k0 + kr) * N + n0 + nc);
    tile[kr * 65 + nc] = v.x; tile[kr * 65 + nc + 1] = v.y; tile[kr * 65 + nc + 2] = v.z; tile[kr * 65 + nc + 3] = v.w;
  }
  __syncthreads();
#pragma unroll
  for (int i = 0; i < 2; ++i) {
    int n = (tid >> 3) + 32 * i, k8 = (tid & 7) * 8;
    int ng = n0 + n;
    if (ng < N) {
      int row = ng;
      if (perm) row = ng < 2048 ? ng : (ng < 2064 ? 2560 + (ng - 2048) : ng - 16);
      u32x4 o;
      o.x = pack2(tile[(k8 + 0) * 65 + n], tile[(k8 + 1) * 65 + n]);
      o.y = pack2(tile[(k8 + 2) * 65 + n], tile[(k8 + 3) * 65 + n]);
      o.z = pack2(tile[(k8 + 4) * 65 + n], tile[(k8 + 5) * 65 + n]);
      o.w = pack2(tile[(k8 + 6) * 65 + n], tile[(k8 + 7) * 65 + n]);
      *(u32x4*)(dst + (size_t)row * K + k0 + k8) = o;
    }
  }
  __syncthreads();
}

constexpr int CONV_ITEMS = 4241;
DI void convert_item(KP p, int l, int item, unsigned char* smem) {
  unsigned char* ws = p->ws;
  if (item < 656) { int kt = item / 41, nt = item % 41; conv_tile(p->in[14] + (size_t)l * 1024 * 2576, 2576, kt * 64, nt * 64, (u16*)(ws + WS_WIN), 1024, true, smem); return; }
  item -= 656;
  if (item < 1024) { int kt = item >> 6, nt = item & 63; conv_tile(p->in[32] + (size_t)l * 1024 * 4096, 4096, kt * 64, nt * 64, (u16*)(ws + WS_WM), 1024, false, smem); return; }
  item -= 1024;
  if (item < 256) { int m = item >> 6, r = item & 63, kt = r >> 4, nt = r & 15;
    conv_tile(p->in[31] + ((size_t)l * 4 + m) * 256 * 1024, 1024, kt * 64, nt * 64, (u16*)(ws + WS_WB) + (size_t)m * 1024 * 256, 256, false, smem); return; }
  item -= 256;
  if (item < 256) { int kt = item >> 4, nt = item & 15; conv_tile(p->in[34] + (size_t)l * 1024 * 1024, 1024, kt * 64, nt * 64, (u16*)(ws + WS_WO), 1024, false, smem); return; }
  item -= 256;
  if (item < 1024) { int kt = item >> 6, nt = item & 63; conv_tile(p->in[35] + (size_t)l * 1024 * 4096, 4096, kt * 64, nt * 64, (u16*)(ws + WS_W1), 1024, false, smem); return; }
  item -= 1024;
  if (item < 1024) { int kt = item >> 4, nt = item & 15; conv_tile(p->in[36] + (size_t)l * 4096 * 1024, 1024, kt * 64, nt * 64, (u16*)(ws + WS_W2), 4096, false, smem); return; }
  u32x4* z = (u32x4*)((u16*)(ws + WS_WIN) + (size_t)2576 * 1024);
  for (int i = ltid(); i < 112 * 1024 / 8; i += 256) z[i] = mku4(0, 0, 0, 0);
}

DI void lruw_item(KP p, int item) {
  const int gid = item * 256 + ltid();
  const int lane = gid & 63, fg = gid >> 6;
  const int s2 = fg & 1, j = (fg >> 1) & 3, n = (fg >> 3) & 3, g = (fg >> 5) & 1, ld_ = fg >> 6;
  const int lq = lane & 15, quad = lane >> 4;
  const float* W = (g == 0 ? p->in[20] : p->in[22]) + ((size_t)(ld_ * 4 + n) * 64) * 64 + (size_t)(s2 * 32 + quad * 8) * 64 + j * 16 + lq;
  u32x4 o = {pack2(W[0], W[64]), pack2(W[128], W[192]), pack2(W[256], W[320]), pack2(W[384], W[448])};
  ((u32x4*)(p->ws + WS_LRUW))[gid] = o;
}

template <int which>
DI void norm_item(KP p, int l, int item) {
  const int tid = ltid(), lane = tid & 63, wave = tid >> 6;
  const float* g = p->in[which == 0 ? 12 : 13] + l * 1024;
  f32x4 v[2][4]; float ss[2] = {0.f, 0.f};
#pragma unroll
  for (int h = 0; h < 2; ++h) {
    const int row = item * 8 + wave * 2 + h;
    const float* x = x_in_row(p, which == 0 ? l : 2, row);
#pragma unroll
    for (int i = 0; i < 4; ++i) v[h][i] = *(const f32x4*)(x + i * 256 + lane * 4);
  }
#pragma unroll
  for (int h = 0; h < 2; ++h) {
#pragma unroll
    for (int i = 0; i < 4; ++i) ss[h] += v[h][i].x * v[h][i].x + v[h][i].y * v[h][i].y + v[h][i].z * v[h][i].z + v[h][i].w * v[h][i].w;
    ss[h] = wave_sum(ss[h]);
  }
#pragma unroll
  for (int h = 0; h < 2; ++h) {
    const int row = item * 8 + wave * 2 + h;
    const float* mod = (const float*)(p->ws + WS_MOD) + (l * 3 + mod_group(row)) * 6144;
    const float* sh = mod + (which == 0 ? 0 : 3072);
    const float* sc = mod + (which == 0 ? 1024 : 4096);
    const float rstd = rsqrtf(ss[h] * (1.f / 1024.f) + 1e-6f);
    u16* H = (u16*)(p->ws + WS_H) + (size_t)row * 1024;
#pragma unroll
    for (int i = 0; i < 4; ++i) {
      int c = i * 256 + lane * 4;
      float4 gg = *(const float4*)(g + c), s1 = *(const float4*)(sc + c), s0 = *(const float4*)(sh + c);
      float y0 = v[h][i].x * rstd * gg.x * (1.f + s1.x) + s0.x, y1 = v[h][i].y * rstd * gg.y * (1.f + s1.y) + s0.y;
      float y2 = v[h][i].z * rstd * gg.z * (1.f + s1.z) + s0.z, y3 = v[h][i].w * rstd * gg.w * (1.f + s1.w) + s0.w;
      *(uint2*)(H + c) = make_uint2(pack2(y0, y1), pack2(y2, y3));
    }
  }
}

DI int lds_byte(int r, int c) {
  int st = (r >> 4) * 2 + (c >> 5), ob = (r & 15) * 64 + (c & 31) * 2;
  return st * 1024 + (ob ^ (((ob >> 9) & 1) << 5));
}
DI void stage_rc(int b, int& R, int& C) {
  int st = b >> 10, sb = b & 1023, swz = sb ^ (((sb >> 9) & 1) << 5);
  R = (st >> 1) * 16 + (swz >> 6);
  C = (st & 1) * 32 + ((swz & 63) >> 1);
}
template <int MT, int NT, bool pre = false>
DI void gemm_acc(f32x4 (&acc)[MT][NT], const u16* __restrict__ A, int lda, const u16* __restrict__ Bt, int ldb, int K, unsigned char* smem,
                 const u16* nxtA = nullptr, int nlda = 0, const u16* nxtB = nullptr, int nldb = 0) {
  constexpr int TA = MT * 32 * 128, TB = NT * 32 * 128, STAGE = TA + TB;
  static_assert(2 * STAGE <= 65536, "LDS");
  const int tid = ltid(), lane = tid & 63, wid = tid >> 6, wm = wid >> 1, wn = wid & 1;
  const int fr = lane & 15, fq = lane >> 4;
  const u16* ga[MT]; const u16* gb[NT];
#pragma unroll
  for (int i = 0; i < MT; ++i) { int R, C; stage_rc(wid * 1024 + i * 4096 + lane * 16, R, C); ga[i] = A + (size_t)R * lda + C; }
#pragma unroll
  for (int i = 0; i < NT; ++i) { int R, C; stage_rc(wid * 1024 + i * 4096 + lane * 16, R, C); gb[i] = Bt + (size_t)R * ldb + C; }
#define GLDS_STAGE(buf, k0)                                                                                                        \
  do {                                                                                                                             \
    _Pragma("unroll") for (int i = 0; i < MT; ++i)                                                                                 \
      __builtin_amdgcn_global_load_lds((const unsigned*)(ga[i] + (k0)), (unsigned*)(smem + (buf) * STAGE + wid * 1024 + i * 4096), 16, 0, 0); \
    _Pragma("unroll") for (int i = 0; i < NT; ++i)                                                                                 \
      __builtin_amdgcn_global_load_lds((const unsigned*)(gb[i] + (k0)), (unsigned*)(smem + (buf) * STAGE + TA + wid * 1024 + i * 4096), 16, 0, 0); \
  } while (0)
  if (!pre) {
    __syncthreads();
    GLDS_STAGE(0, 0);
  }
  asm volatile("s_waitcnt vmcnt(0)" ::: "memory");
  __syncthreads();
  const int nt = K >> 6;
  for (int t = 0; t < nt; ++t) {
    const int cur = t & 1;
    if (t + 1 < nt) GLDS_STAGE(cur ^ 1, (t + 1) * 64);
    const unsigned char* sA = smem + cur * STAGE;
    const unsigned char* sB = sA + TA;
    if constexpr (!pre) {
      bf16x8 bfr[2][NT], af[2][MT];
#pragma unroll
      for (int s = 0; s < 2; ++s) {
#pragma unroll
        for (int j = 0; j < NT; ++j) bfr[s][j] = *(const bf16x8*)(sB + lds_byte(wn * NT * 16 + j * 16 + fr, s * 32 + fq * 8));
#pragma unroll
        for (int i = 0; i < MT; ++i) af[s][i] = *(const bf16x8*)(sA + lds_byte(wm * MT * 16 + i * 16 + fr, s * 32 + fq * 8));
      }
#pragma unroll
      for (int s = 0; s < 2; ++s)
#pragma unroll
        for (int i = 0; i < MT; ++i)
#pragma unroll
          for (int j = 0; j < NT; ++j) acc[i][j] = MFMA16(bfr[s][j], af[s][i], acc[i][j]);
      __builtin_amdgcn_sched_group_barrier(0x100, MT + NT, 0);
#pragma unroll
      for (int q = 0; q < MT + NT; ++q) { __builtin_amdgcn_sched_group_barrier(0x008, 2, 0); __builtin_amdgcn_sched_group_barrier(0x100, 1, 0); }
      __builtin_amdgcn_sched_group_barrier(0x008, 2 * MT * NT - 2 * (MT + NT), 0);
    } else {
#pragma unroll
      for (int s = 0; s < 2; ++s) {
        bf16x8 bfr[NT], af[MT];
#pragma unroll
        for (int j = 0; j < NT; ++j) bfr[j] = *(const bf16x8*)(sB + lds_byte(wn * NT * 16 + j * 16 + fr, s * 32 + fq * 8));
#pragma unroll
        for (int i = 0; i < MT; ++i) af[i] = *(const bf16x8*)(sA + lds_byte(wm * MT * 16 + i * 16 + fr, s * 32 + fq * 8));
#pragma unroll
        for (int i = 0; i < MT; ++i)
#pragma unroll
          for (int j = 0; j < NT; ++j) acc[i][j] = MFMA16(bfr[j], af[i], acc[i][j]);
      }
    }
    asm volatile("s_waitcnt vmcnt(0)" ::: "memory");
    __syncthreads();
  }
  if (nxtA) {
#pragma unroll
    for (int i = 0; i < MT; ++i) { int R, C; stage_rc(wid * 1024 + i * 4096 + lane * 16, R, C);
      __builtin_amdgcn_global_load_lds((const unsigned*)(nxtA + (unsigned)(R * nlda + C)), (unsigned*)(smem + wid * 1024 + i * 4096), 16, 0, 0); }
#pragma unroll
    for (int i = 0; i < NT; ++i) { int R, C; stage_rc(wid * 1024 + i * 4096 + lane * 16, R, C);
      __builtin_amdgcn_global_load_lds((const unsigned*)(nxtB + (unsigned)(R * nldb + C)), (unsigned*)(smem + TA + wid * 1024 + i * 4096), 16, 0, 0); }
  }
#undef GLDS_STAGE
}

template <int MT, int NT>
DI void gemm_prefetch(const u16* A, int lda, const u16* Bt, int ldb, unsigned char* smem) {
  constexpr int TA = MT * 32 * 128;
  const int tid = ltid(), lane = tid & 63, wid = tid >> 6;
  __syncthreads();
#pragma unroll
  for (int i = 0; i < MT; ++i) { int R, C; stage_rc(wid * 1024 + i * 4096 + lane * 16, R, C);
    __builtin_amdgcn_global_load_lds((const unsigned*)(A + (unsigned)(R * lda + C)), (unsigned*)(smem + wid * 1024 + i * 4096), 16, 0, 0); }
#pragma unroll
  for (int i = 0; i < NT; ++i) { int R, C; stage_rc(wid * 1024 + i * 4096 + lane * 16, R, C);
    __builtin_amdgcn_global_load_lds((const unsigned*)(Bt + (unsigned)(R * ldb + C)), (unsigned*)(smem + TA + wid * 1024 + i * 4096), 16, 0, 0); }
}

template <int MT, int NT> DI void zero_acc(f32x4 (&acc)[MT][NT]) {
#pragma unroll
  for (int i = 0; i < MT; ++i)
#pragma unroll
    for (int j = 0; j < NT; ++j) acc[i][j] = f32x4{0.f, 0.f, 0.f, 0.f};
}

#define EPI_LOOP(MT, NT)                                                          \
  const int tid_ = ltid(), lane_ = tid_ & 63, wave_ = tid_ >> 6;                   \
  const int wm_ = wave_ >> 1, wn_ = wave_ & 1, lq_ = lane_ & 15, quad_ = lane_ >> 4; \
  _Pragma("unroll") for (int i = 0; i < MT; ++i)                                   \
  _Pragma("unroll") for (int j = 0; j < NT; ++j)
#define EPI_ROW(m0, MT) ((m0) + wm_ * (MT) * 16 + i * 16 + lq_)
#define EPI_COL(n0, NT) ((n0) + wn_ * (NT) * 16 + j * 16 + quad_ * 4)

constexpr int GMT = 4;
DI void inproj_item(KP p, int mt, int nt, unsigned char* smem) {
  const int m0 = mt * (GMT * 32), n0 = nt * 128;
  f32x4 acc[GMT][4]; zero_acc<GMT, 4>(acc);
  gemm_acc<GMT, 4>(acc, (const u16*)(p->ws + WS_H) + (size_t)m0 * 1024, 1024, (const u16*)(p->ws + WS_WIN) + (size_t)n0 * 1024, 1024, 1024, smem);
  u16* C = (u16*)(p->ws + WS_INPROJ);
  EPI_LOOP(GMT, 4) { int row = EPI_ROW(m0, GMT), col = EPI_COL(n0, 4); if (col < LDI) *(uint2*)(C + (size_t)row * LDI + col) = make_uint2(pack2(acc[i][j][0], acc[i][j][1]), pack2(acc[i][j][2], acc[i][j][3])); }
}

DI void merge_item(KP p, int l, int mt, int nt, unsigned char* smem) {
  const int m0 = mt * 128, n0 = nt * 128;
  const u16* H = (const u16*)(p->ws + WS_H) + (size_t)m0 * 1024;
  const u16* BR = (const u16*)(p->ws + WS_BRANCH) + (size_t)m0 * 1024;
  const float* bm = p->in[33] + l * 4096;
  const u16* WM = (const u16*)(p->ws + WS_WM) + (size_t)n0 * 1024;
  const u16* WB = (const u16*)(p->ws + WS_WB) + (size_t)n0 * 256;
  unsigned am[4][4][2];
#pragma unroll
  for (int i = 0; i < 4; ++i)
#pragma unroll
    for (int j = 0; j < 4; ++j) { am[i][j][0] = 0u; am[i][j][1] = 0u; }
  gemm_prefetch<4, 4>(BR, 1024, WB, 256, smem);
#pragma unroll 1
  for (int m = 0; m < 4; ++m) {
    f32x4 acc[4][4]; zero_acc<4, 4>(acc);
    gemm_acc<4, 4, true>(acc, BR + m * 256, 1024, WB + (size_t)m * 1024 * 256, 256, 256, smem, H, 1024, WM + (size_t)m * 1024 * 1024, 1024);
    unsigned pp[4][4][2];
#pragma unroll
    for (int i = 0; i < 4; ++i)
#pragma unroll
      for (int j = 0; j < 4; ++j) { pp[i][j][0] = pack2(acc[i][j][0], acc[i][j][1]); pp[i][j][1] = pack2(acc[i][j][2], acc[i][j][3]); }
    zero_acc<4, 4>(acc);
    gemm_acc<4, 4, true>(acc, H, 1024, WM + (size_t)m * 1024 * 1024, 1024, 1024, smem,
                         m < 3 ? BR + (m + 1) * 256 : nullptr, 1024, WB + (size_t)(m + 1) * 1024 * 256, 256);
    {
      const int tid_ = ltid(), wn_ = (tid_ >> 6) & 1, quad_ = (tid_ & 63) >> 4;
      float4 bias4[4];
#pragma unroll
      for (int j = 0; j < 4; ++j) bias4[j] = *(const float4*)(bm + m * 1024 + n0 + wn_ * 64 + j * 16 + quad_ * 4);
#pragma unroll
      for (int i = 0; i < 4; ++i) {
#pragma unroll
        for (int j = 0; j < 4; ++j) {
          float v0 = bflo(am[i][j][0]) + sigm(acc[i][j][0] + bias4[j].x) * bflo(pp[i][j][0]);
          float v1 = bfhi(am[i][j][0]) + sigm(acc[i][j][1] + bias4[j].y) * bfhi(pp[i][j][0]);
          float v2 = bflo(am[i][j][1]) + sigm(acc[i][j][2] + bias4[j].z) * bflo(pp[i][j][1]);
          float v3 = bfhi(am[i][j][1]) + sigm(acc[i][j][3] + bias4[j].w) * bfhi(pp[i][j][1]);
          am[i][j][0] = pack2(v0, v1); am[i][j][1] = pack2(v2, v3);
          asm volatile("" : "+v"(am[i][j][0]), "+v"(am[i][j][1]));
          __builtin_amdgcn_sched_barrier(0);
        }
      }
    }
  }
  u16* C = (u16*)(p->ws + WS_MERGED);
  EPI_LOOP(4, 4) { int row = EPI_ROW(m0, 4), col = EPI_COL(n0, 4); *(uint2*)(C + (size_t)row * 1024 + col) = make_uint2(am[i][j][0], am[i][j][1]); }
}

DI void wout_item(KP p, int l, int mt, int nt, unsigned char* smem) {
  const int m0 = mt * (GMT * 32), n0 = nt * 128;
  f32x4 acc[GMT][4]; zero_acc<GMT, 4>(acc);
  gemm_acc<GMT, 4>(acc, (const u16*)(p->ws + WS_MERGED) + (size_t)m0 * 1024, 1024, (const u16*)(p->ws + WS_WO) + (size_t)n0 * 1024, 1024, 1024, smem);
  const float* g1 = (const float*)(p->ws + WS_MOD) + (l * 3 + mod_group(m0)) * 6144 + 2048;
  EPI_LOOP(GMT, 4) { int row = EPI_ROW(m0, GMT), col = EPI_COL(n0, 4); const float4 xv = *(const float4*)(x_in_row(p, l, row) + col), gv = *(const float4*)(g1 + col);
    *(float4*)(p->out + (size_t)row * DM + col) = make_float4(xv.x + gv.x * acc[i][j][0], xv.y + gv.y * acc[i][j][1], xv.z + gv.z * acc[i][j][2], xv.w + gv.w * acc[i][j][3]); }
}

DI void w1_item(KP p, int mt, int nt, unsigned char* smem) {
  const int m0 = mt * (GMT * 32), n0 = nt * 128;
  f32x4 acc[GMT][4]; zero_acc<GMT, 4>(acc);
  gemm_acc<GMT, 4>(acc, (const u16*)(p->ws + WS_H) + (size_t)m0 * 1024, 1024, (const u16*)(p->ws + WS_W1) + (size_t)n0 * 1024, 1024, 1024, smem);
  u16* C = (u16*)(p->ws + WS_HIDDEN);
  EPI_LOOP(GMT, 4) { int row = EPI_ROW(m0, GMT), col = EPI_COL(n0, 4); const float v0 = fmaxf(acc[i][j][0], 0.f), v1 = fmaxf(acc[i][j][1], 0.f), v2 = fmaxf(acc[i][j][2], 0.f), v3 = fmaxf(acc[i][j][3], 0.f);
    *(uint2*)(C + (size_t)row * 4096 + col) = make_uint2(pack2(v0 * v0, v1 * v1), pack2(v2 * v2, v3 * v3)); }
}

DI void w2_item(KP p, int l, int mt, int nt, unsigned char* smem) {
  const int m0 = mt * (GMT * 32), n0 = nt * 128;
  f32x4 acc[GMT][4]; zero_acc<GMT, 4>(acc);
  gemm_acc<GMT, 4>(acc, (const u16*)(p->ws + WS_HIDDEN) + (size_t)m0 * 4096, 4096, (const u16*)(p->ws + WS_W2) + (size_t)n0 * 4096, 4096, 4096, smem);
  const float* g2 = (const float*)(p->ws + WS_MOD) + (l * 3 + mod_group(m0)) * 6144 + 5120;
  EPI_LOOP(GMT, 4) { int row = EPI_ROW(m0, GMT), col = EPI_COL(n0, 4); float4* o = (float4*)(p->out + (size_t)row * DM + col); const float4 xv = *o, gv = *(const float4*)(g2 + col);
    *o = make_float4(xv.x + gv.x * acc[i][j][0], xv.y + gv.y * acc[i][j][1], xv.z + gv.z * acc[i][j][2], xv.w + gv.w * acc[i][j][3]); }
}

DI void prep_load(const u16* R, int lane, float (&hv)[12], float (&vv4)[4]) {
#pragma unroll
  for (int hh = 0; hh < 12; ++hh) {
    const int col = hh < 4 ? C_AQ + hh * 64 : (hh < 6 ? C_AK + (hh - 4) * 64 : (hh < 10 ? C_DQ + (hh - 6) * 64 : C_DK + (hh - 10) * 64));
    hv[hh] = bf2f(R[col + lane]);
  }
  vv4[0] = bf2f(R[C_AV + lane]); vv4[1] = bf2f(R[C_AV + 64 + lane]); vv4[2] = bf2f(R[C_DV + lane]); vv4[3] = bf2f(R[C_DV + 64 + lane]);
}
DI void prep_token(KP p, int l, int row, int lane, u16* R, const float (&hv)[12], const float (&vv4)[4]) {
  const bool lat = row >= 8192;
  float cs = 1.f, sn = 0.f;
  if (lat) {
    int t = (row - 8192) & 4095;
    int pos = (lane < 32) ? (t >> 6) : (t & 63);
    float inv = __expf(-(float)(lane & 15) * (9.210340371976184f / 16.f));
    float ang = (float)pos * inv;
    cs = __cosf(ang); sn = __sinf(ang);
  }
  const int b = row >> 8, t = row & 255;
#pragma unroll
  for (int hh = 0; hh < 12; ++hh) {
    int col; const float* g;
    if (hh < 4) { col = C_AQ + hh * 64; g = p->in[15] + l * 64; }
    else if (hh < 6) { col = C_AK + (hh - 4) * 64; g = p->in[16] + l * 64; }
    else if (hh < 10) { col = C_DQ + (hh - 6) * 64; g = p->in[29] + l * 64; }
    else { col = C_DK + (hh - 10) * 64; g = p->in[30] + l * 64; }
    float v = hv[hh];
    float ss = wave_sum(v * v);
    float y = v * rsqrtf(ss * (1.f / 64.f) + 1e-6f) * g[lane];
    if (hh < 4 || (hh >= 6 && hh < 10)) y *= 0.125f * 1.4426950408889634f;
    if (lat) {
      float yp = xor16_partner(y, lane);
      y = ((lane & 31) < 16) ? (y * cs - yp * sn) : (y * cs + yp * sn);
    } else {
      if (hh == 4 || hh == 5) p->out[O_AK + ((size_t)(b * 2 + l) * 256 + t) * 128 + (hh - 4) * 64 + lane] = y;
      if (hh >= 10) p->out[O_DK + ((size_t)(b * 2 + l) * 256 + t) * 128 + (hh - 10) * 64 + lane] = y;
    }
    R[col + lane] = f2bf(y);
  }
  if (lat) {
    const int bl = (row - 8192) >> 12, tl = (row - 8192) & 4095;
    u16* VT = (u16*)(p->ws + WS_VT) + (size_t)lane * 4608 + 512 + tl;
#pragma unroll
    for (int q = 0; q < 4; ++q)
      VT[(size_t)(((q >> 1) * 2 + bl) * 2 + (q & 1)) * 64 * 4608] = f2bf(vv4[q]);
  }
  if (!lat) {
    size_t o = ((size_t)(b * 2 + l) * 256 + t) * 128;
    p->out[O_AV + o + lane] = vv4[0]; p->out[O_AV + o + 64 + lane] = vv4[1];
    p->out[O_DV + o + lane] = vv4[2]; p->out[O_DV + o + 64 + lane] = vv4[3];
  }
}
DI void prep_item(KP p, int l, int item) {
  const int tid = ltid(), lane = tid & 63, wave = tid >> 6;
  const int row0 = item * 8 + wave * 2;
  u16* R0 = (u16*)(p->ws + WS_INPROJ) + (size_t)row0 * LDI;
  u16* R1 = R0 + LDI;
  float hv0[12], vv0[4], hv1[12], vv1[4];
  prep_load(R0, lane, hv0, vv0); prep_load(R1, lane, hv1, vv1);
  prep_token(p, l, row0, lane, R0, hv0, vv0);
  prep_token(p, l, row0 + 1, lane, R1, hv1, vv1);
}

DI void kvc_item(KP p, int l, int item) {
  u16* KC = (u16*)(p->ws + WS_KC);
#pragma unroll
  for (int it = 0; it < 8; ++it) {
    int idx4 = item * 2048 + it * 256 + ltid();
    int e = idx4 * 4;
    int d = e & 63, key = (e >> 6) & 511, sel = e >> 15;
    int kv = sel & 1, kvh = (sel >> 1) & 1, b = (sel >> 2) & 1, mixer = sel >> 3;
    const float* srcb = mixer ? (kv ? p->in[6] : p->in[5]) : (kv ? p->in[4] : p->in[3]);
    const float* src = srcb + ((size_t)((b * 2 + l) * 512 + key) * 2 + kvh) * 64 + d;
    float4 v = *(const float4*)src;
    *(uint2*)(KC + e) = make_uint2(pack2(v.x, v.y), pack2(v.z, v.w));
    if (kv) {
      u16* VT = (u16*)(p->ws + WS_VT) + ((size_t)((mixer * 2 + b) * 2 + kvh) * 64 + d) * 4608 + key;
      VT[0] = f2bf(v.x); VT[4608] = f2bf(v.y); VT[2 * 4608] = f2bf(v.z); VT[3 * 4608] = f2bf(v.w);
    }
  }
}

DI void attn_item(KP p, int l, int it, unsigned char* smem) {
  u16* sK = (u16*)smem;
  u16* sVt = sK + 64 * 72;
  const int tid = ltid(), lane = tid & 63, wave = tid >> 6, lq = lane & 15, quad = lane >> 4;
  int kind, b, qh, qb;
  if (it < 512) { kind = it >> 8; int r = it & 255; b = r >> 7; qh = (r >> 5) & 3; qb = r & 31; }
  else { int r = it - 512; kind = 2 + (r >> 8); r &= 255; b = r >> 3; qh = (r >> 1) & 3; qb = r & 1; }
  const bool isD = (kind == 0 || kind == 3), lat = kind < 2;
  const int seqrow0 = lat ? 8192 + b * 4096 : b * 256;
  const int q0 = qb * 128, kvh = qh >> 1;
  const int qcol = (isD ? C_DQ : C_AQ) + qh * 64, kcol = (isD ? C_DK : C_AK) + kvh * 64, vcol = (isD ? C_DV : C_AV) + kvh * 64;
  const int ocol = (isD ? 768 : 0) + qh * 64;
  const int ncache = lat ? 8 : 0;
  int kt_lo = 0, kt_hi = lat ? 64 : 4;
  if (kind == 1) { kt_lo = max(0, 2 * qb - 2); kt_hi = min(64, 2 * qb + 4); }
  const int ntiles = ncache + kt_hi - kt_lo;
  const bool band = (kind == 1);
  const u16* INP = (const u16*)(p->ws + WS_INPROJ);
  const u16* KCk = (const u16*)(p->ws + WS_KC) + (size_t)((((isD ? 1 : 0) * 2 + b) * 2 + kvh) * 2) * 512 * 64;
  const u16* KCv = KCk + 512 * 64;
  const float sinkv = isD ? -1e30f : p->in[17][l * 4 + qh] * 1.4426950408889634f;

  bf16x8 qf[2][2];
#pragma unroll
  for (int nt = 0; nt < 2; ++nt)
#pragma unroll
    for (int s = 0; s < 2; ++s) qf[nt][s] = ld8(INP + (size_t)(seqrow0 + q0 + wave * 32 + nt * 16 + lq) * LDI + qcol + s * 32 + quad * 8);
  float mrun[2], lsum[2];
  f32x4 oacc[4][2];
#pragma unroll
  for (int nt = 0; nt < 2; ++nt) { mrun[nt] = sinkv; lsum[nt] = (!isD && quad == 0) ? 1.f : 0.f; }
#pragma unroll
  for (int dt = 0; dt < 4; ++dt)
#pragma unroll
    for (int nt = 0; nt < 2; ++nt) oacc[dt][nt] = f32x4{0.f, 0.f, 0.f, 0.f};

  const int key = tid >> 2, seg = (tid & 3) * 16;
  struct KVReg { u32x4 k[2], v[2]; };
  KVReg R0, R1;
  const u16* VTp = (const u16*)(p->ws + WS_VT) + ((size_t)(((isD ? 1 : 0) * 2 + b) * 2 + kvh) * 64 + key) * 4608 + seg;
  auto tile_ptrs = [&](int t, const u16*& kp, const u16*& vp) {
    if (t < ncache) { kp = KCk + (size_t)(t * 64 + key) * 64 + seg; vp = VTp + t * 64; }
    else {
      const u16* rowp = INP + (size_t)(seqrow0 + (kt_lo + t - ncache) * 64 + key) * LDI; kp = rowp + kcol + seg;
      vp = lat ? VTp + 512 + (kt_lo + t - ncache) * 64 : rowp + vcol + seg;
    }
  };
  auto kvload = [&](int t, KVReg& R) {
    const u16 *kp, *vp; tile_ptrs(t, kp, vp);
    R.k[0] = *(const u32x4*)kp; R.k[1] = *(const u32x4*)(kp + 8); R.v[0] = *(const u32x4*)vp; R.v[1] = *(const u32x4*)(vp + 8);
  };
  kvload(0, R0);
  if (ntiles > 1) kvload(1, R1);
  auto step = [&](int t, KVReg& R) {
    __syncthreads();
    *(u32x4*)(sK + key * 72 + seg) = R.k[0]; *(u32x4*)(sK + key * 72 + seg + 8) = R.k[1];
    if (lat) {
      u16* vrow = sVt + key * 72 + (seg & 32) + ((seg >> 4) & 1) * 4;
      *(uint2*)(vrow + 0) = make_uint2(R.v[0].x, R.v[0].y); *(uint2*)(vrow + 8) = make_uint2(R.v[0].z, R.v[0].w);
      *(uint2*)(vrow + 16) = make_uint2(R.v[1].x, R.v[1].y); *(uint2*)(vrow + 24) = make_uint2(R.v[1].z, R.v[1].w);
    } else {
      unsigned vv[8] = {R.v[0].x, R.v[0].y, R.v[0].z, R.v[0].w, R.v[1].x, R.v[1].y, R.v[1].z, R.v[1].w};
      const int kpos = (key & 32) + ((key >> 2) & 3) * 8 + ((key >> 4) & 1) * 4 + (key & 3);
#pragma unroll
      for (int e = 0; e < 8; ++e) { sVt[(seg + 2 * e) * 72 + kpos] = (u16)(vv[e] & 0xffffu); sVt[(seg + 2 * e + 1) * 72 + kpos] = (u16)(vv[e] >> 16); }
    }
    __syncthreads();
    if (t + 2 < ntiles) kvload(t + 2, R);
    f32x4 sacc[4][2];
#pragma unroll
    for (int mt = 0; mt < 4; ++mt) {
      sacc[mt][0] = f32x4{0.f, 0.f, 0.f, 0.f}; sacc[mt][1] = f32x4{0.f, 0.f, 0.f, 0.f};
#pragma unroll
      for (int s = 0; s < 2; ++s) {
        bf16x8 ka = ld8(sK + (mt * 16 + lq) * 72 + s * 32 + quad * 8);
        sacc[mt][0] = MFMA16(ka, qf[0][s], sacc[mt][0]);
        sacc[mt][1] = MFMA16(ka, qf[1][s], sacc[mt][1]);
      }
    }
    const bool masked_tile = band && t >= ncache;
    const int kbase = (kt_lo + t - ncache) * 64;
    bf16x8 pf[2][2];
#pragma unroll
    for (int nt = 0; nt < 2; ++nt) {
      const int qi = q0 + wave * 32 + nt * 16 + lq;
      float tmax = -1e30f;
#pragma unroll
      for (int mt = 0; mt < 4; ++mt)
#pragma unroll
        for (int r = 0; r < 4; ++r) {
          float sv_ = sacc[mt][nt][r];
          if (masked_tile) { int kj = kbase + mt * 16 + quad * 4 + r; int dlt = qi - kj; if (dlt > 128 || dlt < -128) sv_ = -1e30f; }
          sacc[mt][nt][r] = sv_; tmax = fmaxf(tmax, sv_);
        }
      tmax = xrow32_max(xrow16_max(tmax));
      const float mold = mrun[nt];
      const float mnew = fmaxf(mold, tmax);
      float ps = 0.f;
#pragma unroll
      for (int mt = 0; mt < 4; ++mt)
#pragma unroll
        for (int r = 0; r < 4; ++r) { float e = __builtin_amdgcn_exp2f(sacc[mt][nt][r] - mnew); sacc[mt][nt][r] = e; ps += e; }
      if (__any(mnew != mold)) {
        const float alpha = __builtin_amdgcn_exp2f(mold - mnew);
        lsum[nt] *= alpha;
#pragma unroll
        for (int dt = 0; dt < 4; ++dt)
#pragma unroll
          for (int r = 0; r < 4; ++r) oacc[dt][nt][r] *= alpha;
      }
      lsum[nt] += ps; mrun[nt] = mnew;
      pf[nt][0] = pack8(sacc[0][nt], sacc[1][nt]);
      pf[nt][1] = pack8(sacc[2][nt], sacc[3][nt]);
    }
#pragma unroll
    for (int dt = 0; dt < 4; ++dt)
#pragma unroll
      for (int s2 = 0; s2 < 2; ++s2) {
        bf16x8 va = ld8(sVt + (dt * 16 + lq) * 72 + s2 * 32 + quad * 8);
        oacc[dt][0] = MFMA16(va, pf[0][s2], oacc[dt][0]);
        oacc[dt][1] = MFMA16(va, pf[1][s2], oacc[dt][1]);
      }
  };
  for (int t = 0; t < ntiles; t += 2) { step(t, R0); if (t + 1 < ntiles) step(t + 1, R1); }
  u16* BR = (u16*)(p->ws + WS_BRANCH);
#pragma unroll
  for (int nt = 0; nt < 2; ++nt) {
    float lt = xrow32_sum(xrow16_sum(lsum[nt]));
    const float inv = __builtin_amdgcn_rcpf(lt);
    const size_t row = seqrow0 + q0 + wave * 32 + nt * 16 + lq;
#pragma unroll
    for (int dt = 0; dt < 4; ++dt)
      *(uint2*)(BR + row * 1024 + ocol + dt * 16 + quad * 4) = make_uint2(pack2(oacc[dt][nt][0] * inv, oacc[dt][nt][1] * inv), pack2(oacc[dt][nt][2] * inv, oacc[dt][nt][3] * inv));
  }
  __syncthreads();
}

DI int lru_xoff(int t, int c) { return t * 256 + (c ^ ((t & 7) << 3)); }
template <bool FINAL>
DI void lru_item(KP p, int l, int ci, unsigned char* smem) {
  u16* sxb = (u16*)smem;
  u16* sla = sxb + 32 * 256;
  u16* sbv = sla + 32 * 256;
  u16* shf = sbv + 32 * 256;
  const int tid = ltid(), ch = tid, lane = tid & 63, n = tid >> 6, lq = lane & 15, quad = lane >> 4;
  const int r0 = ci * 32;
  const bool lat = r0 >= 8192;
  int b, T, seqrow0;
  if (!lat) { b = r0 >> 8; T = 256; seqrow0 = b * 256; } else { b = (r0 - 8192) >> 12; T = 4096; seqrow0 = 8192 + b * 4096; }
  const int t0 = r0 - seqrow0;
  const u16* INP = (const u16*)(p->ws + WS_INPROJ);
  __syncthreads();
  {
    const float* cw = p->in[18] + l * 4 * 256;
    const float w0 = cw[ch], w1 = cw[256 + ch], w2 = cw[512 + ch], w3 = cw[768 + ch], cb = p->in[19][l * 256 + ch];
    auto ld = [&](int t) -> float { return (t >= 0 && t < T) ? bf2f(INP[(size_t)(seqrow0 + t) * LDI + C_LX + ch]) : 0.f; };
    float xin[35];
#pragma unroll
    for (int q = 0; q < 35; ++q) xin[q] = ld(t0 - 2 + q);
#pragma unroll
    for (int t = 0; t < 32; ++t) sxb[lru_xoff(t, ch)] = f2bf(xin[t] * w0 + xin[t + 1] * w1 + xin[t + 2] * w2 + xin[t + 3] * w3 + cb);
  }
  __syncthreads();
  const int nch = T / 32, c = t0 / 32;
  float* LC = (float*)(p->ws + WS_LRUC);
  bf16x8 af[2][2];
#pragma unroll
  for (int mt = 0; mt < 2; ++mt)
#pragma unroll
    for (int s2 = 0; s2 < 2; ++s2) af[mt][s2] = ld8(sxb + lru_xoff(mt * 16 + lq, n * 64 + s2 * 32 + quad * 8));
  for (int dir = 0; dir < 2; ++dir) {
    bf16x8 wf[2][4][2];
    {
      const u32x4* WF = (const u32x4*)(p->ws + WS_LRUW);
#pragma unroll
      for (int g = 0; g < 2; ++g)
#pragma unroll
        for (int j = 0; j < 4; ++j)
#pragma unroll
          for (int s2 = 0; s2 < 2; ++s2)
            wf[g][j][s2] = __builtin_bit_cast(bf16x8, WF[(size_t)((((((l * 2 + dir) * 2 + g) * 4 + n) * 4 + j) * 2 + s2)) * 64 + lane]);
    }
#pragma unroll
    for (int j = 0; j < 4; ++j) {
      f32x4 acc[2][2];
#pragma unroll
      for (int g = 0; g < 2; ++g) {
        f32x4 a0 = {0.f, 0.f, 0.f, 0.f}, a1 = {0.f, 0.f, 0.f, 0.f};
#pragma unroll
        for (int s2 = 0; s2 < 2; ++s2) { a0 = MFMA16(af[0][s2], wf[g][j][s2], a0); a1 = MFMA16(af[1][s2], wf[g][j][s2], a1); }
        acc[g][0] = a0; acc[g][1] = a1;
      }
      const int cc = n * 64 + j * 16 + lq;
      const float br = p->in[21][(l * 2 + dir) * 256 + cc], bi = p->in[23][(l * 2 + dir) * 256 + cc];
      const float sp = softplusf_(-p->in[24][(l * 2 + dir) * 256 + cc]);
#pragma unroll
      for (int mt = 0; mt < 2; ++mt)
#pragma unroll
        for (int r = 0; r < 4; ++r) {
          const int t = mt * 16 + quad * 4 + r;
          const float la = -8.f * sigm(acc[0][mt][r] + br) * sp;
          const float xt = bf2f(sxb[lru_xoff(t, cc)]);
          const float bb = __builtin_amdgcn_sqrtf(1.f - __expf(2.f * la)) * sigm(acc[1][mt][r] + bi) * xt;
          sla[t * 256 + cc] = f2bf(la); sbv[t * 256 + cc] = f2bf(bb);
        }
    }
    __syncthreads();
    float h = 0.f, lasum = 0.f;
    if (FINAL) {
      h = lat ? p->in[7][((b * 2 + l) * 2 + dir) * 256 + ch] : 0.f;
      const int ncar = dir == 0 ? c : nch - 1 - c;
      const int cstart = dir == 0 ? ci - c : ci - c + nch - 1, cstep = dir == 0 ? 1 : -1;
      for (int q0 = 0; q0 < ncar; q0 += 16) {
        float ca[16], chh[16];
#pragma unroll
        for (int q = 0; q < 16; ++q) {
          const int qq = q0 + q < ncar ? q0 + q : ncar - 1;
          const float* C = LC + ((size_t)((cstart + cstep * qq) * 2 + dir) * 2) * 256;
          ca[q] = C[ch]; chh[q] = C[256 + ch];
        }
#pragma unroll
        for (int q = 0; q < 16; ++q) if (q0 + q < ncar) h = ca[q] * h + chh[q];
      }
    }
#pragma unroll 1
    for (int s8 = 0; s8 < 32; s8 += 16) {
      float gv[16];
      if (FINAL && dir == 1) {
#pragma unroll
        for (int q = 0; q < 16; ++q) gv[q] = bf2f(INP[(size_t)(r0 + 31 - s8 - q) * LDI + C_LG + ch]);
      }
#pragma unroll
      for (int q = 0; q < 16; ++q) {
        const int st = s8 + q;
        const int t = dir == 0 ? st : 31 - st;
        const float la = bf2f(sla[t * 256 + ch]);
        h = __expf(la) * h + bf2f(sbv[t * 256 + ch]);
        lasum += la;
        if (FINAL) {
          if (dir == 0) shf[t * 256 + ch] = f2bf(h);
          else ((u16*)(p->ws + WS_BRANCH))[(size_t)(r0 + t) * 1024 + 256 + ch] = f2bf((bf2f(shf[t * 256 + ch]) + h) * gelu_tanh(gv[q]));
        }
      }
    }
    if (!FINAL) { float* C = LC + ((size_t)(ci * 2 + dir) * 2) * 256; C[ch] = __expf(lasum); C[256 + ch] = h; }
    else if (!lat) {
      if (dir == 0 && c == nch - 1) p->out[O_LRU + ((size_t)(b * 2 + l) * 2 + 0) * 256 + ch] = h;
      if (dir == 1 && c == 0) p->out[O_LRU + ((size_t)(b * 2 + l) * 2 + 1) * 256 + ch] = h;
    }
    __syncthreads();
  }
}

template <int DIR, bool ISW>
DI void gdn_solve(const float* L, const u16* src, const float* sb_, const float* se_, u16* UW) {
  float sol[64];
#pragma unroll
  for (int i = 0; i < 64; ++i) {
    float s = bf2f(src[(DIR == 0 ? i : 63 - i) * 72]) * sb_[i];
    if (ISW) s *= se_[i];
    float s0 = 0.f, s1 = 0.f, s2 = 0.f, s3 = 0.f;
#pragma unroll
    for (int j4 = 0; j4 < (i + 3) / 4; ++j4) {
      float4 lv = *(const float4*)(L + i * 64 + j4 * 4);
      if (j4 * 4 + 0 < i) s0 += lv.x * sol[j4 * 4 + 0];
      if (j4 * 4 + 1 < i) s1 += lv.y * sol[j4 * 4 + 1];
      if (j4 * 4 + 2 < i) s2 += lv.z * sol[j4 * 4 + 2];
      if (j4 * 4 + 3 < i) s3 += lv.w * sol[j4 * 4 + 3];
      if ((j4 & 3) == 3) asm volatile("" ::: "memory");
    }
    s -= (s0 + s1) + (s2 + s3);
    sol[i] = s;
    UW[i * 128] = f2bf(s);
    asm volatile("" ::: "memory");
  }
}

DI void gdn1_item(KP p, int l, int item, unsigned char* smem) {
  const int cgi = item >> 2, hd = item & 3;
  u16* sq = (u16*)smem; u16* sk = sq + 64 * 72; u16* sv = sk + 64 * 72;
  float* sL = (float*)(smem + 27648);
  float* sgc = (float*)(smem + 60416);
  float* sbeta = sgc + 128;
  float* sge = sbeta + 128;
  const int tid = ltid(), lane = tid & 63, wave = tid >> 6, lq = lane & 15, quad = lane >> 4;
  const int r0 = cgi * 64;
  const bool lat = r0 >= 8192;
  int T, seqrow0;
  if (!lat) { T = 256; seqrow0 = (r0 >> 8) * 256; } else { T = 4096; seqrow0 = 8192 + ((r0 - 8192) >> 12) * 4096; }
  const int t0 = r0 - seqrow0;
  const u16* INP = (const u16*)(p->ws + WS_INPROJ);
  u16* QHAT = (u16*)(p->ws + WS_QHAT) + (size_t)item * 4096;
  {
    const int d = lane, tb = wave * 16;
#pragma unroll
    for (int mat = 0; mat < 3; ++mat) {
      const int col = C_GQ + mat * 256 + hd * 64 + d, wc = mat * 256 + hd * 64 + d;
      const float* cw = p->in[25] + (size_t)l * 4 * 768;
      const float w0 = cw[wc], w1 = cw[768 + wc], w2 = cw[1536 + wc], w3 = cw[2304 + wc];
      auto ld = [&](int t) -> float { return (t >= 0 && t < T) ? bf2f(INP[(size_t)(seqrow0 + t) * LDI + col]) : 0.f; };
      float xin[19];
#pragma unroll
      for (int q = 0; q < 19; ++q) xin[q] = ld(t0 + tb - 2 + q);
      u16* dst = mat == 0 ? sq : (mat == 1 ? sk : sv);
#pragma unroll
      for (int tt = 0; tt < 16; ++tt) {
        const int t = tb + tt;
        float v = siluf_(xin[tt] * w0 + xin[tt + 1] * w1 + xin[tt + 2] * w2 + xin[tt + 3] * w3);
        if (mat < 2) { float ss = wave_sum(v * v); v *= rsqrtf(ss + 1e-6f) * (mat == 0 ? 0.125f : 1.f); }
        u16 hb = f2bf(v);
        dst[t * 72 + d] = hb;
        if (mat == 0) QHAT[t * 64 + d] = hb;
      }
    }
  }
  if (tid < 128) {
    const int dir = tid >> 6, c = tid & 63;
    const int tok = dir == 0 ? c : 63 - c;
    const u16* R = INP + (size_t)(r0 + tok) * LDI;
    const float ga = bf2f(R[C_GA + dir * 4 + hd]), gb = bf2f(R[C_GB + dir * 4 + hd]);
    const float g = -__expf(p->in[26][(l * 2 + dir) * 4 + hd]) * softplusf_(ga + p->in[27][(l * 2 + dir) * 4 + hd]);
    float gc = g;
#pragma unroll
    for (int o = 1; o < 64; o <<= 1) { float tt = __shfl_up(gc, o, 64); if (lane >= o) gc += tt; }
    const float glast = __shfl(gc, 63, 64);
    sgc[dir * 64 + c] = gc; sbeta[dir * 64 + c] = sigm(gb); sge[dir * 64 + c] = __expf(gc);
    float* gv = (float*)(p->ws + WS_GVEC) + (size_t)(item * 2 + dir) * 256;
    gv[c] = __expf(gc); gv[64 + c] = __expf(glast - gc); if (c == 0) gv[128] = __expf(glast);
  }
  __syncthreads();
  {
    const int dk = tid >> 2, c0 = (tid & 3) * 16;
    unsigned w[8];
#pragma unroll
    for (int e = 0; e < 8; ++e) w[e] = (unsigned)sk[(c0 + 2 * e) * 72 + dk] | ((unsigned)sk[(c0 + 2 * e + 1) * 72 + dk] << 16);
    u16* KT = (u16*)(p->ws + WS_KT) + (size_t)item * 4096 + dk * 64 + c0;
    *(u32x4*)KT = mku4(w[0], w[1], w[2], w[3]); *(u32x4*)(KT + 8) = mku4(w[4], w[5], w[6], w[7]);
  }
  {
    const int i0 = wave * 16;
    f32x4 akk[4], aqk[4];
#pragma unroll
    for (int nt = 0; nt < 4; ++nt) { akk[nt] = f32x4{0.f, 0.f, 0.f, 0.f}; aqk[nt] = f32x4{0.f, 0.f, 0.f, 0.f}; }
#pragma unroll
    for (int s = 0; s < 2; ++s) {
      bf16x8 ak = ld8(sk + (i0 + lq) * 72 + s * 32 + quad * 8), aq = ld8(sq + (i0 + lq) * 72 + s * 32 + quad * 8);
#pragma unroll
      for (int nt = 0; nt < 4; ++nt) { bf16x8 bk = ld8(sk + (nt * 16 + lq) * 72 + s * 32 + quad * 8); akk[nt] = MFMA16(bk, ak, akk[nt]); aqk[nt] = MFMA16(bk, aq, aqk[nt]); }
    }
    u16* QKf = (u16*)(p->ws + WS_QK) + (size_t)(item * 2 + 0) * 4096;
    u16* QKb = (u16*)(p->ws + WS_QK) + (size_t)(item * 2 + 1) * 4096;
    const int i = i0 + lq, ib = 63 - i;
    const float gci = sgc[i], gcbi = sgc[64 + ib], bti = sbeta[i], btbi = sbeta[64 + ib];
#pragma unroll
    for (int nt = 0; nt < 4; ++nt) {
      const int j0 = nt * 16 + quad * 4;
      const float4 gcj = *(const float4*)(sgc + j0), gcbj = *(const float4*)(sgc + 64 + 60 - j0);
      const float gj[4] = {gcj.x, gcj.y, gcj.z, gcj.w};
      const float gbj[4] = {gcbj.w, gcbj.z, gcbj.y, gcbj.x};
      float qf[4], qb[4];
#pragma unroll
      for (int r = 0; r < 4; ++r) {
        const int j = j0 + r, jb = 63 - j;
        const float kkv = akk[nt][r], qkv = aqk[nt][r];
        const float ef = (j <= i) ? __expf(gci - gj[r]) : 0.f;
        const float eb = (j >= i) ? __expf(gcbi - gbj[r]) : 0.f;
        if (j < i) sL[i * 64 + j] = bti * kkv * ef;
        if (j > i) sL[4096 + ib * 64 + jb] = btbi * kkv * eb;
        qf[r] = qkv * ef; qb[r] = qkv * eb;
      }
      *(uint2*)(QKf + i * 64 + j0) = make_uint2(pack2(qf[0], qf[1]), pack2(qf[2], qf[3]));
      *(uint2*)(QKb + ib * 64 + 60 - j0) = make_uint2(pack2(qb[3], qb[2]), pack2(qb[1], qb[0]));
    }
  }
  __syncthreads();
  {
    const int col = tid & 127;
    u16* UW = (u16*)(p->ws + WS_UW) + (size_t)(item * 2 + (tid >> 7)) * 8192 + col;
    for (int rep = 0; rep < NREP(2); ++rep) {
    if (tid < 128) { if (col < 64) gdn_solve<0, false>(sL, sv + col, sbeta, sge, UW); else gdn_solve<0, true>(sL, sk + (col - 64), sbeta, sge, UW); }
    else { if (col < 64) gdn_solve<1, false>(sL + 4096, sv + col, sbeta + 64, sge + 64, UW); else gdn_solve<1, true>(sL + 4096, sk + (col - 64), sbeta + 64, sge + 64, UW); }
    }
  }
  __syncthreads();
}

DI void gdn2_item(KP p, int l, int item, unsigned char* smem) {
  u16* sW = (u16*)smem; u16* sKT = sW + 64 * 72; u16* sU = sKT + 64 * 72;
  float* sg = (float*)(smem + 27648);
  const int tid = ltid(), lane = tid & 63, wave = tid >> 6, lq = lane & 15, quad = lane >> 4;
  int b, hd, dir; bool lat;
  if (item < 16) { lat = true; b = item >> 3; hd = (item >> 1) & 3; dir = item & 1; }
  else { lat = false; int r = item - 16; b = r >> 3; hd = (r >> 1) & 3; dir = r & 1; }
  const int nch = lat ? 64 : 4, cg0 = lat ? 128 + b * 64 : b * 4;
  f32x4 st[4];
#pragma unroll
  for (int kt = 0; kt < 4; ++kt)
#pragma unroll
    for (int r = 0; r < 4; ++r)
      st[kt][r] = lat ? p->in[8][((size_t)(((b * 2 + l) * 2 + dir) * 4 + hd) * 64 + kt * 16 + quad * 4 + r) * 64 + wave * 16 + lq] : 0.f;
  const int lrow = tid >> 2, seg = (tid & 3) * 16;
  struct GReg { u32x4 U[2], W[2], KT[2]; float g; };
  GReg R0, R1;
  u16* UWb = (u16*)(p->ws + WS_UW);
  const u16* KTb = (const u16*)(p->ws + WS_KT);
  const float* GV = (const float*)(p->ws + WS_GVEC);
  auto gload = [&](int n, GReg& R) {
    const int cgi = dir == 0 ? cg0 + n : cg0 + nch - 1 - n;
    const size_t prob = (size_t)cgi * 4 + hd, pd = prob * 2 + dir;
    const u16* u = UWb + (pd * 64 + lrow) * 128 + seg;
    R.U[0] = *(const u32x4*)u; R.U[1] = *(const u32x4*)(u + 8); R.W[0] = *(const u32x4*)(u + 64); R.W[1] = *(const u32x4*)(u + 72);
    const u16* kt = KTb + (prob * 64 + lrow) * 64 + (dir ? 48 - seg : seg);
    u32x4 a = *(const u32x4*)kt, bb = *(const u32x4*)(kt + 8);
    if (dir) { R.KT[0] = rev8(bb); R.KT[1] = rev8(a); } else { R.KT[0] = a; R.KT[1] = bb; }
    R.g = GV[pd * 256 + (tid & 255)];
  };
  gload(0, R0); gload(1, R1);
  auto step = [&](int n, GReg& R) {
    const int cgi = dir == 0 ? cg0 + n : cg0 + nch - 1 - n;
    const size_t pd = ((size_t)cgi * 4 + hd) * 2 + dir;
    __syncthreads();
    *(u32x4*)(sW + lrow * 72 + seg) = R.W[0]; *(u32x4*)(sW + lrow * 72 + seg + 8) = R.W[1];
    *(u32x4*)(sKT + lrow * 72 + seg) = R.KT[0]; *(u32x4*)(sKT + lrow * 72 + seg + 8) = R.KT[1];
    *(u32x4*)(sU + lrow * 72 + seg) = R.U[0]; *(u32x4*)(sU + lrow * 72 + seg + 8) = R.U[1];
    sg[tid] = R.g;
    __syncthreads();
    if (n + 2 < nch) gload(n + 2, R);
    u32x4* FR = (u32x4*)(UWb + pd * 8192);
    const float elast = sg[128];
    bf16x8 sB[2] = {pack8(st[0], st[1]), pack8(st[2], st[3])};
    FR[(0 * 4 + wave) * 64 + lane] = __builtin_bit_cast(u32x4, sB[0]);
    FR[(1 * 4 + wave) * 64 + lane] = __builtin_bit_cast(u32x4, sB[1]);
    f32x4 vn[4];
#pragma unroll
    for (int mt = 0; mt < 4; ++mt) {
      f32x4 acc = {0.f, 0.f, 0.f, 0.f};
#pragma unroll
      for (int s2 = 0; s2 < 2; ++s2) acc = MFMA16(ldperm(sW + (mt * 16 + lq) * 72 + s2 * 32 + quad * 4), sB[s2], acc);
#pragma unroll
      for (int r = 0; r < 4; ++r) vn[mt][r] = bf2f(sU[(mt * 16 + quad * 4 + r) * 72 + wave * 16 + lq]) - acc[r];
    }
    bf16x8 vB[2] = {pack8(vn[0], vn[1]), pack8(vn[2], vn[3])};
    FR[512 + (0 * 4 + wave) * 64 + lane] = __builtin_bit_cast(u32x4, vB[0]);
    FR[512 + (1 * 4 + wave) * 64 + lane] = __builtin_bit_cast(u32x4, vB[1]);
#pragma unroll
    for (int mt = 0; mt < 4; ++mt)
#pragma unroll
      for (int r = 0; r < 4; ++r) vn[mt][r] *= sg[64 + mt * 16 + quad * 4 + r];
    bf16x8 vsB[2] = {pack8(vn[0], vn[1]), pack8(vn[2], vn[3])};
#pragma unroll
    for (int kt = 0; kt < 4; ++kt) {
      f32x4 acc = {0.f, 0.f, 0.f, 0.f};
#pragma unroll
      for (int s2 = 0; s2 < 2; ++s2) acc = MFMA16(ldperm(sKT + (kt * 16 + lq) * 72 + s2 * 32 + quad * 4), vsB[s2], acc);
#pragma unroll
      for (int r = 0; r < 4; ++r) st[kt][r] = elast * st[kt][r] + acc[r];
    }
  };
  for (int n = 0; n < nch; n += 2) { step(n, R0); step(n + 1, R1); }
  if (!lat) {
#pragma unroll
    for (int kt = 0; kt < 4; ++kt)
#pragma unroll
      for (int r = 0; r < 4; ++r)
        p->out[O_GDN + ((size_t)(((b * 2 + l) * 2 + dir) * 4 + hd) * 64 + kt * 16 + quad * 4 + r) * 64 + wave * 16 + lq] = st[kt][r];
  }
  __syncthreads();
}

DI void gdnfin_item(KP p, int l, int item, unsigned char* smem) {
  u16* sQ = (u16*)smem; u16* sQK = sQ + 64 * 72;
  float* so = (float*)(smem + 3 * 64 * 72 * 2);
  float* seg_ = so + 64 * 65;
  const int cgi = item >> 2, hd = item & 3;
  const int tid = ltid(), lane = tid & 63, wave = tid >> 6, lq = lane & 15, quad = lane >> 4;
  const int lrow = tid >> 2, seg = (tid & 3) * 16;
  __syncthreads();
  {
    const u16* q = (const u16*)(p->ws + WS_QHAT) + ((size_t)item * 64 + lrow) * 64 + seg;
    *(u32x4*)(sQ + lrow * 72 + seg) = *(const u32x4*)q; *(u32x4*)(sQ + lrow * 72 + seg + 8) = *(const u32x4*)(q + 8);
#pragma unroll
    for (int dir = 0; dir < 2; ++dir) {
      const u16* qk = (const u16*)(p->ws + WS_QK) + ((size_t)(item * 2 + dir) * 64 + lrow) * 64 + seg;
      *(u32x4*)(sQK + (dir * 64 + lrow) * 72 + seg) = *(const u32x4*)qk; *(u32x4*)(sQK + (dir * 64 + lrow) * 72 + seg + 8) = *(const u32x4*)(qk + 8);
    }
    if (tid < 128) seg_[tid] = ((const float*)(p->ws + WS_GVEC))[(size_t)(item * 2 + (tid >> 6)) * 256 + (tid & 63)];
  }
  __syncthreads();
#pragma unroll
  for (int dir = 0; dir < 2; ++dir) {
    const u32x4* FR = (const u32x4*)((const u16*)(p->ws + WS_UW) + (size_t)(item * 2 + dir) * 8192);
    bf16x8 sfr[2], vfr[2];
#pragma unroll
    for (int s2 = 0; s2 < 2; ++s2) {
      sfr[s2] = __builtin_bit_cast(bf16x8, FR[(s2 * 4 + wave) * 64 + lane]);
      vfr[s2] = __builtin_bit_cast(bf16x8, FR[512 + (s2 * 4 + wave) * 64 + lane]);
    }
#pragma unroll
    for (int mt = 0; mt < 4; ++mt) {
      f32x4 acc = {0.f, 0.f, 0.f, 0.f};
      const int qrow = dir ? 63 - (mt * 16 + lq) : mt * 16 + lq;
#pragma unroll
      for (int s2 = 0; s2 < 2; ++s2) acc = MFMA16(ldperm(sQ + qrow * 72 + s2 * 32 + quad * 4), sfr[s2], acc);
#pragma unroll
      for (int r = 0; r < 4; ++r) acc[r] *= seg_[dir * 64 + mt * 16 + quad * 4 + r];
#pragma unroll
      for (int s2 = 0; s2 < 2; ++s2) acc = MFMA16(ldperm(sQK + (dir * 64 + mt * 16 + lq) * 72 + s2 * 32 + quad * 4), vfr[s2], acc);
#pragma unroll
      for (int r = 0; r < 4; ++r) {
        const int c = mt * 16 + quad * 4 + r;
        const int tk = dir ? 63 - c : c;
        float* d = so + tk * 65 + wave * 16 + lq;
        if (dir == 0) *d = acc[r]; else *d += acc[r];
      }
    }
    __syncthreads();
  }
  const float gn = p->in[28][l * 64 + lane];
  float zv[16];
#pragma unroll
  for (int q = 0; q < 16; ++q)
    zv[q] = bf2f(((const u16*)(p->ws + WS_INPROJ))[((size_t)cgi * 64 + wave * 16 + q) * LDI + C_GZ + hd * 64 + lane]);
#pragma unroll
  for (int q = 0; q < 16; ++q) {
    const int c = wave * 16 + q;
    const size_t row = (size_t)cgi * 64 + c;
    float o = so[c * 65 + lane];
    float ss = wave_sum(o * o);
    float y = o * rsqrtf(ss * (1.f / 64.f) + 1e-6f) * gn * siluf_(zv[q]);
    ((u16*)(p->ws + WS_BRANCH))[row * 1024 + 512 + hd * 64 + lane] = f2bf(y);
  }
}

#define XB_TMO      128
#define XB_XCNT(j)  (256  + 64 * (j))
#define XB_XSUB(j)  (1280 + 64 * (j))
#define XB_XGEN(j)  (2304 + 64 * (j))
#define XB_TOP      3328
#define XB_TOPGEN   3392
#define XB_SPIN_CAP (1u << 20)
#define LAS __attribute__((address_space(3)))
DI unsigned xb_ld(unsigned* q) { return __hip_atomic_load(q, __ATOMIC_RELAXED, __HIP_MEMORY_SCOPE_AGENT); }
DI unsigned xb_add(unsigned* q, unsigned v) { return __hip_atomic_fetch_add(q, v, __ATOMIC_RELAXED, __HIP_MEMORY_SCOPE_AGENT); }
DI unsigned xb_xcc_id() { return (unsigned)__builtin_amdgcn_s_getreg((3 << 11) | 20) & 0xFu; }
#define XB_SPIN(cond, bar) do { unsigned _sp = 0; while (cond) { __builtin_amdgcn_s_sleep(1); \
    if ((++_sp & 255u) == 0u) { if (xb_ld(&(bar)[XB_TMO])) break; if (_sp > XB_SPIN_CAP) { atomicAdd(&(bar)[XB_TMO], 1u); break; } } } } while (0)
DI void xcd_barrier_complete(unsigned* bar, unsigned x, unsigned& nloc, unsigned& nx) {
  const unsigned G = gridDim.x;
  unsigned sum, cnt, mine, sp = 0u;
  for (;;) {
    sum = 0u; cnt = 0u; mine = 0u;
#pragma unroll
    for (unsigned j = 0; j < 16; ++j) { const unsigned c = xb_ld(&bar[XB_XCNT(j)]); sum += c; cnt += (c > 0u) ? 1u : 0u; mine = (j == x) ? c : mine; }
    if (sum == G) break;
    __builtin_amdgcn_s_sleep(1);
    if ((++sp & 255u) == 0u) { if (xb_ld(&bar[XB_TMO])) break; if (sp > XB_SPIN_CAP) { atomicAdd(&bar[XB_TMO], 1u); break; } }
  }
  nloc = mine > 0u ? mine : 1u; nx = cnt > 0u ? cnt : 1u;
}
DI void xcd_barrier(unsigned* bar, volatile LAS unsigned* st) {
  asm volatile("s_waitcnt vmcnt(0)" ::: "memory");
  __syncthreads();
  if (ltid() == 0) {
    const unsigned x = xb_xcc_id();
    __builtin_amdgcn_s_waitcnt(0);
    unsigned nloc = st[0], nx = st[1];
    if (nloc == 0u) { xcd_barrier_complete(bar, x, nloc, nx); st[0] = nloc; st[1] = nx; }
    const unsigned old = xb_add(&bar[XB_XSUB(x)], 1u);
    const unsigned gen = old / nloc;
    if (old + 1u == (gen + 1u) * nloc) {
      __builtin_amdgcn_fence(__ATOMIC_RELEASE, "agent");
      asm volatile("s_waitcnt vmcnt(0)" ::: "memory");
      const unsigned og = xb_add(&bar[XB_TOP], 1u);
      const unsigned tg = og / nx;
      if (og + 1u == (tg + 1u) * nx) xb_add(&bar[XB_TOPGEN], 1u);
      else XB_SPIN(xb_ld(&bar[XB_TOPGEN]) == tg, bar);
      __builtin_amdgcn_fence(__ATOMIC_ACQUIRE, "agent");
      xb_add(&bar[XB_XGEN(x)], 1u);
      asm volatile("s_waitcnt vmcnt(0)" ::: "memory");
    } else {
      XB_SPIN(xb_ld(&bar[XB_XGEN(x)]) == gen, bar);
      __builtin_amdgcn_fence(__ATOMIC_ACQUIRE, "agent");
      asm volatile("s_waitcnt vmcnt(0)" ::: "memory");
    }
  }
  __syncthreads();
}


#define FOR_TILES(MTI, NTI, SM, SN, CALL)                                                      \
  do {                                                                                         \
    if (G % 8 != 0) { for (int it_ = B; it_ < (MTI) * (NTI); it_ += G) { const int mt = it_ / (NTI), nt = it_ % (NTI); CALL; } } \
    else {                                                                                     \
      const int xcd_ = B & 7, j_ = B >> 3, J_ = G >> 3;                                        \
      const int nsm_ = ((MTI) + (SM) - 1) / (SM), nsn_ = ((NTI) + (SN) - 1) / (SN);            \
      const int st_ = (SM) * (SN), mysup_ = (nsm_ * nsn_ - xcd_ + 7) / 8;                      \
        \
                                  \
      for (int u_ = j_; u_ < mysup_ * st_; u_ += J_) {                                         \
        const int s_ = xcd_ + 8 * (u_ / st_), t_ = u_ % st_;                                   \
        const int sm_ = s_ / nsn_, sn_ = s_ % nsn_;                                            \
        const int mt = sm_ * (SM) + t_ / (SN), nt = sn_ * (SN) + t_ % (SN);                    \
        if (mt < (MTI) && nt < (NTI)) { CALL; }                                                \
      }                                                                                        \
    }                                                                                          \
  } while (0)

constexpr int NPHASE = 21;
__global__ void __launch_bounds__(256, 2) mk(Params p_unused, int ph_lo, int ph_hi) {
  extern __shared__ __attribute__((aligned(1024))) unsigned char smem[];
  int& s_item = *(int*)(smem + SMEM_BYTES);
  u32x4& xb_words = *(u32x4*)(smem + SMEM_BYTES + 16);
  const int G = gridDim.x, B = blockIdx.x;
  const bool fused = ph_hi - ph_lo > 1;
  if (fused) {
    if (ltid() == 0) { xb_words = u32x4{0u, 0u, 0u, 0u}; (void)xb_add(&((unsigned*)(((KP)__builtin_amdgcn_kernarg_segment_ptr())->ws + WS_BAR))[XB_XCNT(xb_xcc_id())], 1u); }
    __syncthreads();
  }
  for (int ph = ph_lo; ph < ph_hi; ++ph) {
    KP p = (KP)__builtin_amdgcn_kernarg_segment_ptr();
    asm volatile("" : "+s"(p));
    if (ph == 0) {
      for (int it = B; it < 192 + 64; it += G) { if (it < 192) mod_item(p, it, smem); else lruw_item(p, it - 192); }
    } else {
      const int l = (ph - 1) / 10, sub = (ph - 1) % 10;
      switch (sub) {
        case 0:
          for (int it = B; it < 2048 + CONV_ITEMS; it += G) { if (it < 2048) norm_item<0>(p, l, it); else convert_item(p, l, it - 2048, smem); }
          break;
        case 1: FOR_TILES(128, 21, 8, 7, inproj_item(p, mt, nt, smem)); break;
        case 2:
          for (int it = B; it < 1024 + 512 + 64 + 2048; it += G) {
            if (it < 1024) { for (int rep = 0; rep < NREP(4); ++rep) gdn1_item(p, l, it, smem); }
            else if (it < 1536) { for (int rep = 0; rep < NREP(5); ++rep) lru_item<false>(p, l, it - 1024, smem); }
            else if (it < 1600) { if (PHON(6)) kvc_item(p, l, it - 1536); }
            else if (PHON(6)) prep_item(p, l, it - 1600);
          }
          break;
        case 3: {
          int* ctr = (int*)(p->ws + WS_CTR) + l;
          for (;;) {
            __syncthreads();
            if (ltid() == 0) s_item = atomicAdd(ctr, 1);
            __syncthreads();
            const int it = s_item;
            if (it >= 16 + 256 + 256 + 256 + 512 + 512) break;
            if (it < 16) gdn2_item(p, l, it, smem);
            else if (it < 272) { for (int rep = 0; rep < NREP(8); ++rep) attn_item(p, l, it - 16, smem); }
            else if (it < 528) gdn2_item(p, l, it - 272 + 16, smem);
            else if (it < 784) { for (int rep = 0; rep < NREP(8); ++rep) attn_item(p, l, it - 528 + 256, smem); }
            else if (it < 1296) { for (int rep = 0; rep < NREP(9); ++rep) lru_item<true>(p, l, it - 784, smem); }
            else for (int rep = 0; rep < NREP(8); ++rep) attn_item(p, l, it - 1296 + 512, smem);
          }
        } break;
        case 4: for (int it = B; it < 1024; it += G) gdnfin_item(p, l, it, smem); break;
        case 5: for (int rep = 0; rep < NREP(11); ++rep) FOR_TILES(128, 8, 8, 8, merge_item(p, l, mt, nt, smem)); break;
        case 6: FOR_TILES(128, 8, 8, 8, wout_item(p, l, mt, nt, smem)); break;
        case 7: for (int it = B; it < 2048; it += G) norm_item<1>(p, l, it); break;
        case 8: FOR_TILES(128, 32, 8, 8, w1_item(p, mt, nt, smem)); break;
        case 9: FOR_TILES(128, 8, 8, 8, w2_item(p, l, mt, nt, smem)); break;
      }
    }
    if (ph + 1 < ph_hi) {
      if (ph_hi > NPHASE) cg::this_grid().sync();
      else for (int rep = 0; rep < NREP(1); ++rep) xcd_barrier((unsigned*)(p->ws + WS_BAR), (volatile LAS unsigned*)&xb_words);
    }
  }
}

extern "C" void kernel_launch(void* const* d_in, const int* in_sizes, int n_in, void* d_out, int out_size, void* d_ws, size_t ws_size, hipStream_t stream) {
  static int grid_blocks = 0;
  if (!grid_blocks) {
    int dev = 0, cus = 0, per_cu = 0;
    (void)hipGetDevice(&dev);
    (void)hipDeviceGetAttribute(&cus, hipDeviceAttributeMultiprocessorCount, dev);
    if (hipFuncSetAttribute((const void*)mk, hipFuncAttributeMaxDynamicSharedMemorySize, DYN_LDS) != hipSuccess) fprintf(stderr, "kernel_launch: hipFuncSetAttribute failed\n");
    (void)hipOccupancyMaxActiveBlocksPerMultiprocessor(&per_cu, mk, 256, DYN_LDS);
    if (per_cu < 1) per_cu = 1;
    if (per_cu > 2) per_cu = 2;
    grid_blocks = cus * per_cu;
    if (ws_size < WS_END) fprintf(stderr, "kernel_launch: workspace too small: %zu < %zu\n", ws_size, (size_t)WS_END);
  }
  if (hipMemsetAsync((char*)d_ws + WS_CTR, 0, 256 + 3456 * 4 + 256, stream) != hipSuccess) fprintf(stderr, "kernel_launch: memset failed\n");
  Params p{};
  for (int i = 0; i < 37; ++i) p.in[i] = (const float*)d_in[i];
  p.out = (float*)d_out; p.ws = (unsigned char*)d_ws;
#if MULTI_LAUNCH
  for (int ph = 0; ph < NPHASE; ++ph) hipLaunchKernelGGL(mk, dim3(grid_blocks), dim3(256), DYN_LDS, stream, p, ph, ph + 1);
#else
  int lo = 0, hi = NPHASE;
  void* args[] = {&p, &lo, &hi};
  hipError_t e = hipLaunchCooperativeKernel((void*)mk, dim3(grid_blocks), dim3(256), args, DYN_LDS, stream);
  if (e != hipSuccess) fprintf(stderr, "cooperative launch failed: %s (grid %d)\n", hipGetErrorString(e), grid_blocks);
#endif
}
```
